# Optimizing an MI355X kernel written in HIP

```python
import jax, jax.numpy as jnp
from jax import lax
import numpy as np

D_MODEL = 1024
BATCH = 16
SEQ = 4096
DEPTH = 2

N_META = 16

HEAD_DIM = 64
RWKV_HEADS = 8
RWKV_WIDTH = RWKV_HEADS * HEAD_DIM
DECAY_LORA = 64
ICLR_LORA = 64
GATE_LORA = 160
GN_EPS = 64e-5

MLA_HEADS = 8
QK_NOPE_DIM = 64
QK_ROPE_DIM = 32
V_HEAD_DIM = 64
Q_LORA_RANK = 256
KV_LORA_RANK = 256
ROPE_THETA = 10000.0
ATTN_BLOCK = 128
MLA_WIDTH = MLA_HEADS * V_HEAD_DIM

D_FF = 2816
CONV_WIDTH = 3

N_BRANCHES = 2
RWKV_COLS = 3 * RWKV_WIDTH + DECAY_LORA + ICLR_LORA + GATE_LORA
MLA_COLS = Q_LORA_RANK + KV_LORA_RANK + QK_ROPE_DIM
GATE_COLS = N_BRANCHES * D_MODEL
IN_COLS = RWKV_COLS + MLA_COLS + GATE_COLS

DEEPNORM_ALPHA = float((2 * DEPTH) ** 0.25)
DEEPNORM_BETA = float((8 * DEPTH) ** -0.25)
LN_EPS = 1e-5
RMS_EPS = 1e-6

kernel_name = "hybrid_rwkv7_mla_convffn_deepnorm"


def _layer_norm(x, g, b):
    xf = x.astype(jnp.float32)
    mu = jnp.mean(xf, axis=-1, keepdims=True)
    var = jnp.mean(jnp.square(xf - mu), axis=-1, keepdims=True)
    return ((xf - mu) * lax.rsqrt(var + LN_EPS) * g + b).astype(x.dtype)


def _rms_norm(x, g):
    xf = x.astype(jnp.float32)
    return (xf * lax.rsqrt(jnp.mean(jnp.square(xf), axis=-1, keepdims=True) + RMS_EPS) * g).astype(x.dtype)


def _shift(x, n):
    return jnp.pad(x, ((0, 0), (n, 0), (0, 0)))[:, : x.shape[1]]


def _rope(x, pos):
    half = x.shape[-1] // 2
    inv_freq = ROPE_THETA ** (-jnp.arange(half, dtype=jnp.float32) / half)
    ang = pos.astype(jnp.float32)[:, None] * inv_freq[None, :]
    cos = jnp.cos(ang)[None, :, None, :]
    sin = jnp.sin(ang)[None, :, None, :]
    x1 = x[..., :half].astype(jnp.float32)
    x2 = x[..., half:].astype(jnp.float32)
    return jnp.concatenate([x1 * cos - x2 * sin, x1 * sin + x2 * cos], axis=-1).astype(x.dtype)


def _wkv7_scan(r, decay, k, v, kk, a):
    B, T, H, N = r.shape

    def step(S, inp):
        r_t, w_t, k_t, v_t, kk_t, a_t = inp
        s_kk = jnp.einsum('bhvk,bhk->bhv', S, kk_t)
        S = (S * w_t[:, :, None, :]
             - s_kk[..., :, None] * (kk_t * a_t)[:, :, None, :]
             + v_t[..., :, None] * k_t[:, :, None, :])
        y_t = jnp.einsum('bhvk,bhk->bhv', S, r_t)
        return S, y_t

    xs = tuple(jnp.moveaxis(t, 1, 0) for t in (r, decay, k, v, kk, a))
    S0 = jnp.zeros((B, H, N, N), dtype=r.dtype)
    _, y = lax.scan(step, S0, xs)
    return jnp.moveaxis(y, 0, 1)


def _rwkv7_mix(p, mu, w0, w_lora_up, a0, a_lora_up, g_lora_up, k_k, k_a, r_k, lnx_g, lnx_b):
    B, T, _ = p.shape
    p = p + (_shift(p, 1) - p) * mu
    splits = np.cumsum([RWKV_WIDTH, RWKV_WIDTH, RWKV_WIDTH, DECAY_LORA, ICLR_LORA]).tolist()
    r, k, v, wd, ad, gd = jnp.split(p, splits, axis=-1)
    w_raw = -jax.nn.softplus(-(w0 + jnp.tanh(wd) @ w_lora_up)) - 0.5
    decay = jnp.exp(-jnp.exp(w_raw.astype(jnp.float32))).astype(p.dtype)
    a = jax.nn.sigmoid(a0 + ad @ a_lora_up)
    g = jax.nn.sigmoid(gd) @ g_lora_up

    def heads(t):
        return t.reshape(B, T, RWKV_HEADS, HEAD_DIM)

    kk = heads(k * k_k).astype(jnp.float32)
    kk = (kk / jnp.maximum(jnp.sqrt(jnp.sum(kk * kk, axis=-1, keepdims=True)), 1e-12)).astype(p.dtype)
    k = k * (1.0 + (a - 1.0) * k_a)
    r_h, k_h, v_h, a_h, w_h = heads(r), heads(k), heads(v), heads(a), heads(decay)
    y = _wkv7_scan(r_h, w_h, k_h, v_h, kk, a_h)
    yf = y.astype(jnp.float32)
    ym = jnp.mean(yf, axis=-1, keepdims=True)
    yv = jnp.mean(jnp.square(yf - ym), axis=-1, keepdims=True)
    yn = ((yf - ym) * lax.rsqrt(yv + GN_EPS)).reshape(B, T, RWKV_WIDTH) * lnx_g + lnx_b
    yn = yn.astype(p.dtype)
    bonus = (jnp.sum(r_h * k_h * r_k, axis=-1, keepdims=True) * v_h).reshape(B, T, RWKV_WIDTH)
    return (yn + bonus) * g


def _causal_attention(q, k, v):
    T = q.shape[1]
    scale = 1.0 / float(np.sqrt(q.shape[-1]))
    bounds = [(0, N_META)] + [(s, min(s + ATTN_BLOCK, T)) for s in range(N_META, T, ATTN_BLOCK)]
    outs = []
    for s, e in bounds:
        sc = jnp.einsum('bqhd,bkhd->bhqk', q[:, s:e], k[:, :e],
                        preferred_element_type=jnp.float32) * scale
        causal = jnp.arange(e)[None, :] <= jnp.arange(s, e)[:, None]
        sc = jnp.where(causal[None, None], sc, -jnp.inf)
        probs = jax.nn.softmax(sc, axis=-1).astype(v.dtype)
        outs.append(jnp.einsum('bhqk,bkhd->bqhd', probs, v[:, :e]))
    return jnp.concatenate(outs, axis=1)


def _mla(p, pos, q_norm_g, w_uq, kv_norm_g, w_uk, w_uv):
    B, T, _ = p.shape
    cq, ckv, kr = jnp.split(p, [Q_LORA_RANK, Q_LORA_RANK + KV_LORA_RANK], axis=-1)
    q = (_rms_norm(cq, q_norm_g) @ w_uq).reshape(B, T, MLA_HEADS, QK_NOPE_DIM + QK_ROPE_DIM)
    q = jnp.concatenate([q[..., :QK_NOPE_DIM], _rope(q[..., QK_NOPE_DIM:], pos)], axis=-1)
    ckv = _rms_norm(ckv, kv_norm_g)
    k_nope = (ckv @ w_uk).reshape(B, T, MLA_HEADS, QK_NOPE_DIM)
    v = (ckv @ w_uv).reshape(B, T, MLA_HEADS, V_HEAD_DIM)
    k_rope = _rope(kr[:, :, None, :], pos)
    k = jnp.concatenate([k_nope, jnp.broadcast_to(k_rope, (B, T, MLA_HEADS, QK_ROPE_DIM))], axis=-1)
    return _causal_attention(q, k, v).reshape(B, T, MLA_WIDTH)


def _conv_ffn(x, w_up, conv_w, conv_b, w_down):
    u = x @ w_up
    u = sum(conv_w[CONV_WIDTH - 1 - j] * _shift(u, j) for j in range(CONV_WIDTH)) + conv_b
    gate, val = jnp.split(u, 2, axis=-1)
    return (jax.nn.silu(gate) * val) @ w_down


def setup_inputs(seed: int = 0) -> dict:
    key = jax.random.key(seed)
    ks = iter(list(jax.random.split(key, 48)))
    L = DEPTH
    beta = DEEPNORM_BETA

    def nrm(shape, scale):
        return scale * jax.random.normal(next(ks), shape, jnp.float32)

    def gain(shape):
        return 1.0 + nrm(shape, 0.02)

    def unif(shape, lo, hi):
        return jax.random.uniform(next(ks), shape, jnp.float32, lo, hi)

    return {
        'x': nrm((BATCH, SEQ, D_MODEL), 1.0),
        'meta_tokens': nrm((N_META, D_MODEL), 1.0),
        'ln_in_g': gain((D_MODEL,)),
        'ln_in_b': nrm((D_MODEL,), 0.02),
        'w_in': nrm((L, D_MODEL, IN_COLS), D_MODEL ** -0.5),
        'mu_shift': unif((L, RWKV_COLS), 0.0, 1.0),
        'w0': unif((L, RWKV_WIDTH), -5.0, 1.0),
        'w_lora_up': nrm((L, DECAY_LORA, RWKV_WIDTH), 0.1),
        'a0': nrm((L, RWKV_WIDTH), 0.5),
        'a_lora_up': nrm((L, ICLR_LORA, RWKV_WIDTH), 0.1),
        'g_lora_up': nrm((L, GATE_LORA, RWKV_WIDTH), GATE_LORA ** -0.5),
        'k_k': 0.85 + nrm((L, RWKV_WIDTH), 0.02),
        'k_a': gain((L, RWKV_WIDTH)),
        'r_k': nrm((L, RWKV_HEADS, HEAD_DIM), 0.1),
        'lnx_g': gain((L, RWKV_WIDTH)),
        'lnx_b': nrm((L, RWKV_WIDTH), 0.02),
        'q_norm_g': gain((L, Q_LORA_RANK)),
        'w_uq': nrm((L, Q_LORA_RANK, MLA_HEADS * (QK_NOPE_DIM + QK_ROPE_DIM)), Q_LORA_RANK ** -0.5),
        'kv_norm_g': gain((L, KV_LORA_RANK)),
        'w_uk': nrm((L, KV_LORA_RANK, MLA_HEADS * QK_NOPE_DIM), KV_LORA_RANK ** -0.5),
        'w_uv': nrm((L, KV_LORA_RANK, MLA_HEADS * V_HEAD_DIM), KV_LORA_RANK ** -0.5),
        'w_proj_rwkv': nrm((L, RWKV_WIDTH, D_MODEL), beta * RWKV_WIDTH ** -0.5),
        'w_proj_mla': nrm((L, MLA_WIDTH, D_MODEL), beta * MLA_WIDTH ** -0.5),
        'w_out': nrm((L, D_MODEL, D_MODEL), beta * D_MODEL ** -0.5),
        'ln1_g': gain((L, D_MODEL)),
        'ln1_b': nrm((L, D_MODEL), 0.02),
        'w_up': nrm((L, D_MODEL, 2 * D_FF), D_MODEL ** -0.5),
        'conv_w': nrm((L, CONV_WIDTH, 2 * D_FF), CONV_WIDTH ** -0.5),
        'conv_b': nrm((L, 2 * D_FF), 0.02),
        'w_down': nrm((L, D_FF, D_MODEL), beta * D_FF ** -0.5),
        'ln2_g': gain((L, D_MODEL)),
        'ln2_b': nrm((L, D_MODEL), 0.02),
    }


def reference(x, meta_tokens, ln_in_g, ln_in_b, w_in, mu_shift, w0, w_lora_up, a0, a_lora_up,
              g_lora_up, k_k, k_a, r_k, lnx_g, lnx_b, q_norm_g, w_uq, kv_norm_g, w_uk, w_uv,
              w_proj_rwkv, w_proj_mla, w_out, ln1_g, ln1_b, w_up, conv_w, conv_b, w_down,
              ln2_g, ln2_b):
    B = x.shape[0]
    meta = jnp.broadcast_to(meta_tokens[None].astype(x.dtype), (B, N_META, D_MODEL))
    h = jnp.concatenate([meta, x], axis=1)
    T = h.shape[1]
    pos = jnp.arange(T, dtype=jnp.int32)
    h = _layer_norm(h, ln_in_g, ln_in_b)
    for l in range(DEPTH):
        p = h @ w_in[l]
        p_rwkv, p_mla, p_gate = jnp.split(p, [RWKV_COLS, RWKV_COLS + MLA_COLS], axis=-1)
        y_rwkv = _rwkv7_mix(p_rwkv, mu_shift[l], w0[l], w_lora_up[l], a0[l], a_lora_up[l],
                            g_lora_up[l], k_k[l], k_a[l], r_k[l], lnx_g[l], lnx_b[l])
        y_mla = _mla(p_mla, pos, q_norm_g[l], w_uq[l], kv_norm_g[l], w_uk[l], w_uv[l])
        gate_rwkv, gate_mla = jnp.split(jax.nn.sigmoid(p_gate), N_BRANCHES, axis=-1)
        mixed = gate_rwkv * (y_rwkv @ w_proj_rwkv[l]) + gate_mla * (y_mla @ w_proj_mla[l])
        h = _layer_norm(DEEPNORM_ALPHA * h + mixed @ w_out[l], ln1_g[l], ln1_b[l])
        f = _conv_ffn(h, w_up[l], conv_w[l], conv_b[l], w_down[l])
        h = _layer_norm(DEEPNORM_ALPHA * h + f, ln2_g[l], ln2_b[l])
    return h[:, N_META:]
```

```cpp
#include <hip/hip_runtime.h>
#include <hip/hip_cooperative_groups.h>
#include <cstdio>
#include <cstring>
namespace cg = cooperative_groups;

#ifndef PHMASK
#define PHMASK 0xFFFF
#endif
typedef unsigned short u16;
using bf16x8 = __attribute__((ext_vector_type(8))) short;
using f32x4 = __attribute__((ext_vector_type(4))) float;

constexpr int B_ = 16, SEQ_ = 4096, NMETA_ = 16, T_ = 4112, M_ = B_ * T_, D_ = 1024;
constexpr int PC_ = 2368;
constexpr int PMLA_ = 1824, PKV_ = 2080, PKR_ = 2336;
constexpr int DFF_ = 2816;
constexpr float ALPHA_ = 1.4142135623730951f;

constexpr size_t OFF_H = 0;
constexpr size_t OFF_P = OFF_H + (size_t)M_ * 1024 * 4;
constexpr size_t OFF_DEC = OFF_P + (size_t)M_ * PC_ * 2;
constexpr size_t OFF_AA = OFF_DEC + (size_t)M_ * 512 * 4;
constexpr size_t OFF_GG = OFF_AA + (size_t)M_ * 512 * 2;
constexpr size_t OFF_Q = OFF_GG + (size_t)M_ * 512 * 2;
constexpr size_t OFF_W = OFF_Q + (size_t)M_ * 768 * 2;
constexpr size_t W_IN = 0;
constexpr size_t W_G = W_IN + (size_t)2432 * 1024;
constexpr size_t W_LW = W_G + (size_t)2048 * 1024;
constexpr size_t W_LA = W_LW + (size_t)512 * 64;
constexpr size_t W_LG = W_LA + (size_t)512 * 64;
constexpr size_t W_UQ = W_LG + (size_t)512 * 192;
constexpr size_t W_UK = W_UQ + (size_t)768 * 256;
constexpr size_t W_UV = W_UK + (size_t)512 * 256;
constexpr size_t W_PR = W_UV + (size_t)512 * 256;
constexpr size_t W_PM = W_PR + (size_t)1024 * 512;
constexpr size_t W_OUT = W_PM + (size_t)1024 * 512;
constexpr size_t W_UP = W_OUT + (size_t)1024 * 1024;
constexpr size_t W_DN = W_UP + (size_t)5632 * 1024;
constexpr size_t W_LAYER = W_DN + (size_t)1024 * 2816;
constexpr size_t OFF_ROPE = OFF_W + 2 * W_LAYER * 2;
constexpr size_t OFF_CTR = OFF_ROPE + (size_t)T_ * 16 * 8;
constexpr size_t WS_TOTAL = OFF_CTR + 256;

struct Job { const float* src; u16* dst; int ld, c0, K, Kpad, Nv, Np, mode, tile0; };
struct Params {
  const float* in[32];
  float* out;
  char* ws;
  Job jobs[26];
  int nconv;
  int pad0;
};

__constant__ double ROPE_C[16] = {0.15915494309189535, 0.08949940160889101, 0.050329212104487035, 0.0283021958306234,
                                  0.015915494309189534, 0.008949940160889102, 0.005032921210448704, 0.00283021958306234,
                                  0.0015915494309189536, 0.0008949940160889102, 0.0005032921210448703, 0.00028302195830623395,
                                  0.00015915494309189535, 8.949940160889102e-05, 5.0329212104487035e-05, 2.8302195830623396e-05};

__device__ __forceinline__ u16 f2bf(float f) {
  unsigned u = __float_as_uint(f);
  u += 0x7fffu + ((u >> 16) & 1u);
  return (u16)(u >> 16);
}
__device__ __forceinline__ float bf2f(unsigned h) { return __uint_as_float(h << 16); }
__device__ __forceinline__ unsigned pk2(float a, float b) { return (unsigned)f2bf(a) | ((unsigned)f2bf(b) << 16); }
__device__ __forceinline__ float bflo(unsigned w) { return __uint_as_float(w << 16); }
__device__ __forceinline__ float bfhi(unsigned w) { return __uint_as_float(w & 0xffff0000u); }
__device__ __forceinline__ float sigmoidf_(float x) { return 1.0f / (1.0f + __expf(-x)); }

template <int CTRL>
__device__ __forceinline__ float dppf(float x) {
  return __int_as_float(__builtin_amdgcn_update_dpp(0, __float_as_int(x), CTRL, 0xF, 0xF, true));
}
__device__ __forceinline__ float sum8(float x) {
  x += dppf<0xB1>(x);
  x += dppf<0x4E>(x);
  x += dppf<0x141>(x);
  return x;
}
__device__ __forceinline__ float sum16(float x) {
  x = sum8(x);
  x += dppf<0x140>(x);
  return x;
}
__device__ __forceinline__ float wave_sum(float x) {
#pragma unroll
  for (int o = 32; o > 0; o >>= 1) x += __shfl_xor(x, o);
  return x;
}

constexpr int BM = 128, BN = 128, BK = 64, LDT = 72;
constexpr int SMEM_BYTES = 2 * (BM + BN) * LDT * 2;

template <int MODE>
struct AL {
  const void* base;
  int ld;
  int row0;
  int t0;
  int kvalid;
  const float* mu;
  int fn;
  struct Raw { uint4 x, y; };
  __device__ __forceinline__ Raw fetch(int r, int k) const {
    Raw w;
    w.x = make_uint4(0, 0, 0, 0);
    w.y = make_uint4(0, 0, 0, 0);
    if (MODE == 0) {
      const float* p = (const float*)base + (size_t)(row0 + r) * ld + k;
      w.x = *(const uint4*)p;
      w.y = *(const uint4*)(p + 4);
    } else if (MODE == 1) {
      const u16* p = (const u16*)base + (size_t)(row0 + r) * ld + k;
      w.x = *(const uint4*)p;
    } else if (MODE == 2) {
      int t = t0 + r;
      if (t >= 0 && t < T_) {
        const float* p = (const float*)base + (size_t)(row0 + t) * ld + k;
        w.x = *(const uint4*)p;
        w.y = *(const uint4*)(p + 4);
      }
    } else {
      int row = row0 + r;
      int t = row % T_;
      if (k < kvalid) {
        const u16* p = (const u16*)base + (size_t)row * ld + k;
        w.x = *(const uint4*)p;
        if (t > 0) w.y = *(const uint4*)(p - ld);
      }
    }
    return w;
  }
  __device__ __forceinline__ uint4 cvt(const Raw& w, int k) const {
    if (MODE == 0 || MODE == 2) {
      uint4 o;
      o.x = pk2(__uint_as_float(w.x.x), __uint_as_float(w.x.y));
      o.y = pk2(__uint_as_float(w.x.z), __uint_as_float(w.x.w));
      o.z = pk2(__uint_as_float(w.y.x), __uint_as_float(w.y.y));
      o.w = pk2(__uint_as_float(w.y.z), __uint_as_float(w.y.w));
      return o;
    } else if (MODE == 1) {
      return w.x;
    } else {
      if (k >= kvalid) return make_uint4(0, 0, 0, 0);
      unsigned cw[4] = {w.x.x, w.x.y, w.x.z, w.x.w};
      unsigned pw[4] = {w.y.x, w.y.y, w.y.z, w.y.w};
      unsigned ow[4];
#pragma unroll
      for (int e = 0; e < 4; e++) {
        float x0 = bflo(cw[e]), x1 = bfhi(cw[e]);
        float p0 = bflo(pw[e]), p1 = bfhi(pw[e]);
        float v0 = x0 + (p0 - x0) * mu[k + 2 * e];
        float v1 = x1 + (p1 - x1) * mu[k + 2 * e + 1];
        if (fn == 0) {
          v0 = 1.0f - 2.0f / (__expf(2.0f * v0) + 1.0f);
          v1 = 1.0f - 2.0f / (__expf(2.0f * v1) + 1.0f);
        } else if (fn == 2) {
          v0 = sigmoidf_(v0);
          v1 = sigmoidf_(v1);
        }
        ow[e] = pk2(v0, v1);
      }
      return make_uint4(ow[0], ow[1], ow[2], ow[3]);
    }
  }
};

template <int NI>
__device__ __forceinline__ void zero_acc(f32x4 (&acc)[4][NI]) {
#pragma unroll
  for (int i = 0; i < 4; i++)
#pragma unroll
    for (int j = 0; j < NI; j++) acc[i][j] = f32x4{0.f, 0.f, 0.f, 0.f};
}

#define REP4(X) X(0) X(1) X(2) X(3)
template <class ALT, int NI>
__device__ __forceinline__ void gemm_loop(f32x4 (&acc)[4][NI], const ALT& al, const u16* __restrict__ Bt, int ldb, int n0,
                                          int K, char* smem) {
  const int tid = threadIdx.x, lane = tid & 63, wave = tid >> 6;
  const int wr = wave >> 1, wc = wave & 1, fr = lane & 15, fq = lane >> 4;
  const int lr = tid >> 3, lk = (tid & 7) * 8;
  u16* sa = (u16*)smem;
  u16* sb = sa + 2 * BM * LDT;
  typename ALT::Raw ra0, ra1, ra2, ra3;
  uint4 rb0 = make_uint4(0,0,0,0), rb1 = rb0, rb2 = rb0, rb3 = rb0;
  const u16* bp = Bt + (size_t)(n0 + lr) * ldb + lk;
#define GL_FETCH(i) ra##i = al.fetch(lr + 32 * i, kf); if (i < NI) rb##i = *(const uint4*)(bp + (size_t)(32 * i) * ldb + kb);
#define GL_STORE(i) *(uint4*)(a_ + (lr + 32 * i) * LDT + lk) = al.cvt(ra##i, kt * BK + lk); if (i < NI) *(uint4*)(b_ + (lr + 32 * i) * LDT + lk) = rb##i;
  {
    const int kf = lk, kb = 0;
    REP4(GL_FETCH)
  }
  const int nk = K / BK;
  for (int kt = 0; kt < nk; kt++) {
    u16* a_ = sa + (kt & 1) * BM * LDT;
    u16* b_ = sb + (kt & 1) * BN * LDT;
    REP4(GL_STORE)
    __syncthreads();
    if (kt + 1 < nk) {
      const int kf = (kt + 1) * BK + lk, kb = (kt + 1) * BK;
      REP4(GL_FETCH)
    }
#pragma unroll
    for (int ks = 0; ks < 2; ks++) {
      bf16x8 af[4], bf[NI];
#pragma unroll
      for (int i = 0; i < 4; i++) af[i] = *(const bf16x8*)(a_ + (wr * 64 + i * 16 + fr) * LDT + ks * 32 + fq * 8);
#pragma unroll
      for (int i = 0; i < NI; i++) bf[i] = *(const bf16x8*)(b_ + (wc * (NI * 16) + i * 16 + fr) * LDT + ks * 32 + fq * 8);
#pragma unroll
      for (int mi = 0; mi < 4; mi++)
#pragma unroll
        for (int ni = 0; ni < NI; ni++)
          acc[mi][ni] = __builtin_amdgcn_mfma_f32_16x16x32_bf16(af[mi], bf[ni], acc[mi][ni], 0, 0, 0);
    }
  }
  __syncthreads();
#undef GL_FETCH
#undef GL_STORE
}

#define ACC_COORDS                                              \
  const int tid = threadIdx.x, lane = tid & 63, wave = tid >> 6; \
  const int wr = wave >> 1, wc = wave & 1, fr = lane & 15, fq = lane >> 4;

__device__ __forceinline__ void conv_tile(const Params& p, int t, char* smem) {
  int j = 0;
#pragma unroll 1
  for (int i = 1; i < 26; i++)
    if (t >= p.jobs[i].tile0) j = i;
  const Job& jb = p.jobs[j];
  float(*tile)[33] = (float(*)[33])smem;
  int local = t - jb.tile0;
  int nkt = jb.Kpad >> 5;
  int kt = local % nkt, nt = local / nkt;
  int tx = threadIdx.x & 31, ty = threadIdx.x >> 5;
  int n = nt * 32 + tx;
  int col;
  if (jb.mode == 0) col = jb.c0 + n;
  else { int jn = n >> 7, i = n & 127; col = (i < 64) ? (64 * jn + i) : (DFF_ + 64 * jn + (i - 64)); }
#pragma unroll
  for (int i = 0; i < 4; i++) {
    int k = kt * 32 + ty + 8 * i;
    float v = 0.f;
    if (k < jb.K && n < jb.Nv) v = jb.src[(size_t)k * jb.ld + col];
    tile[ty + 8 * i][tx] = v;
  }
  __syncthreads();
#pragma unroll
  for (int i = 0; i < 4; i++) {
    int nn = nt * 32 + ty + 8 * i;
    int k = kt * 32 + tx;
    jb.dst[(size_t)nn * jb.Kpad + k] = f2bf(tile[tx][ty + 8 * i]);
  }
  __syncthreads();
}

__device__ __forceinline__ void ln_row(const float* __restrict__ src, const float* __restrict__ g,
                                       const float* __restrict__ b, float* __restrict__ dst, int lane) {
  float4 v[4];
  float s = 0.f;
#pragma unroll
  for (int i = 0; i < 4; i++) {
    v[i] = *(const float4*)(src + i * 256 + lane * 4);
    s += v[i].x + v[i].y + v[i].z + v[i].w;
  }
  float mean = wave_sum(s) * (1.0f / 1024.0f);
  float q = 0.f;
#pragma unroll
  for (int i = 0; i < 4; i++) {
    float a = v[i].x - mean, b2 = v[i].y - mean, c = v[i].z - mean, d = v[i].w - mean;
    q += a * a + b2 * b2 + c * c + d * d;
  }
  float rstd = rsqrtf(wave_sum(q) * (1.0f / 1024.0f) + 1e-5f);
#pragma unroll
  for (int i = 0; i < 4; i++) {
    float4 gg = *(const float4*)(g + i * 256 + lane * 4);
    float4 bb = *(const float4*)(b + i * 256 + lane * 4);
    float4 o;
    o.x = (v[i].x - mean) * rstd * gg.x + bb.x;
    o.y = (v[i].y - mean) * rstd * gg.y + bb.y;
    o.z = (v[i].z - mean) * rstd * gg.z + bb.z;
    o.w = (v[i].w - mean) * rstd * gg.w + bb.w;
    *(float4*)(dst + i * 256 + lane * 4) = o;
  }
}

struct ScanIn {
  float kk[16][64], wr[16][64], w[16][64], kt[16][64], kka[16][64], v[16][64], g[16][64];
  float c[16][4];
};
struct ScanRaw { uint2 r, k, v, rp, kp, vp, a, g; float4 dec; };

__device__ __forceinline__ ScanRaw scan_fetch(const u16* __restrict__ P, const float* __restrict__ DEC,
                                              const u16* __restrict__ AA, const u16* __restrict__ GG, int rowbase, int t,
                                              int hc) {
  ScanRaw w;
  size_t row = (size_t)(rowbase + t);
  const u16* pp = P + row * PC_ + hc;
  w.r = *(const uint2*)(pp);
  w.k = *(const uint2*)(pp + 512);
  w.v = *(const uint2*)(pp + 1024);
  if (t > 0) {
    w.rp = *(const uint2*)(pp - PC_);
    w.kp = *(const uint2*)(pp - PC_ + 512);
    w.vp = *(const uint2*)(pp - PC_ + 1024);
  } else {
    w.rp = make_uint2(0, 0); w.kp = make_uint2(0, 0); w.vp = make_uint2(0, 0);
  }
  w.dec = *(const float4*)(DEC + row * 512 + hc);
  w.a = *(const uint2*)(AA + row * 512 + hc);
  w.g = *(const uint2*)(GG + row * 512 + hc);
  return w;
}

__device__ __forceinline__ void unpack4(uint2 u, float (&o)[4]) {
  o[0] = bflo(u.x); o[1] = bfhi(u.x); o[2] = bflo(u.y); o[3] = bfhi(u.y);
}

__device__ __forceinline__ void scan_unit(const Params& p, int l, int bh, char* smem) {
  const int tid = threadIdx.x, lane = tid & 63, wave = tid >> 6;
  const int b = bh >> 3, h = bh & 7;
  const int rowbase = b * T_;
  const u16* P = (const u16*)(p.ws + OFF_P);
  const float* DEC = (const float*)(p.ws + OFF_DEC);
  const u16* AA = (const u16*)(p.ws + OFF_AA);
  const u16* GG = (const u16*)(p.ws + OFF_GG);
  u16* YR = (u16*)p.out + (size_t)2 * M_ * 512;
  ScanIn* in = (ScanIn*)smem;
  float(*ybuf)[64] = (float(*)[64])(smem + 2 * sizeof(ScanIn));
  const int tl = tid >> 4, kq = tid & 15, hc = h * 64 + kq * 4;
  float mu_r[4], mu_k[4], mu_v[4], kkw[4], kaw[4], rkw[4], lg[4], lb[4];
  {
    const float* mu = p.in[5] + (size_t)l * 1824;
#pragma unroll
    for (int e = 0; e < 4; e++) {
      mu_r[e] = mu[hc + e];
      mu_k[e] = mu[512 + hc + e];
      mu_v[e] = mu[1024 + hc + e];
      kkw[e] = p.in[11][l * 512 + hc + e];
      kaw[e] = p.in[12][l * 512 + hc + e];
      rkw[e] = p.in[13][l * 512 + hc + e];
      lg[e] = p.in[14][l * 512 + hc + e];
      lb[e] = p.in[15][l * 512 + hc + e];
    }
  }
  const int rp = lane >> 3, ks = lane & 7, row0 = wave * 16 + rp * 2;
  float S[2][8];
#pragma unroll
  for (int i = 0; i < 2; i++)
#pragma unroll
    for (int e = 0; e < 8; e++) S[i][e] = 0.f;

  auto stage = [&](const ScanRaw& w, ScanIn& dst) {
    float r[4], k[4], v[4], rq[4], kp[4], vp[4], a[4], g[4];
    unpack4(w.r, r); unpack4(w.k, k); unpack4(w.v, v);
    unpack4(w.rp, rq); unpack4(w.kp, kp); unpack4(w.vp, vp);
    unpack4(w.a, a); unpack4(w.g, g);
    float dec[4] = {w.dec.x, w.dec.y, w.dec.z, w.dec.w};
    float kkr[4], ss = 0.f;
#pragma unroll
    for (int e = 0; e < 4; e++) {
      r[e] = r[e] + (rq[e] - r[e]) * mu_r[e];
      k[e] = k[e] + (kp[e] - k[e]) * mu_k[e];
      v[e] = v[e] + (vp[e] - v[e]) * mu_v[e];
      kkr[e] = k[e] * kkw[e];
      ss += kkr[e] * kkr[e];
    }
    ss = sum16(ss);
    float inv = 1.0f / fmaxf(sqrtf(ss), 1e-12f);
    float c1 = 0.f, c2 = 0.f, c3 = 0.f;
    float kk[4], ktl[4], kka[4], wr[4];
#pragma unroll
    for (int e = 0; e < 4; e++) {
      kk[e] = kkr[e] * inv;
      ktl[e] = k[e] * (1.0f + (a[e] - 1.0f) * kaw[e]);
      kka[e] = kk[e] * a[e];
      wr[e] = dec[e] * r[e];
      c1 += kka[e] * r[e];
      c2 += ktl[e] * r[e];
      c3 += r[e] * ktl[e] * rkw[e];
    }
    c1 = sum16(c1); c2 = sum16(c2); c3 = sum16(c3);
    *(float4*)&dst.kk[tl][kq * 4] = make_float4(kk[0], kk[1], kk[2], kk[3]);
    *(float4*)&dst.wr[tl][kq * 4] = make_float4(wr[0], wr[1], wr[2], wr[3]);
    *(float4*)&dst.w[tl][kq * 4] = make_float4(dec[0], dec[1], dec[2], dec[3]);
    *(float4*)&dst.kt[tl][kq * 4] = make_float4(ktl[0], ktl[1], ktl[2], ktl[3]);
    *(float4*)&dst.kka[tl][kq * 4] = make_float4(kka[0], kka[1], kka[2], kka[3]);
    *(float4*)&dst.v[tl][kq * 4] = make_float4(v[0], v[1], v[2], v[3]);
    *(float4*)&dst.g[tl][kq * 4] = make_float4(g[0], g[1], g[2], g[3]);
    if (kq == 0) *(float4*)&dst.c[tl][0] = make_float4(c1, c2, c3, 0.f);
  };

  {
    ScanRaw w0 = scan_fetch(P, DEC, AA, GG, rowbase, tl, hc);
    stage(w0, in[0]);
  }
  __syncthreads();
  constexpr int NCH = T_ / 16;
  for (int c = 0; c < NCH; c++) {
    ScanIn& cur = in[c & 1];
    ScanRaw nx;
    const bool have_next = (c + 1 < NCH);
    if (have_next) nx = scan_fetch(P, DEC, AA, GG, rowbase, (c + 1) * 16 + tl, hc);
#pragma unroll 2
    for (int s = 0; s < 16; s++) {
      float kk[8], wr[8], w[8], kt[8], kka[8];
      *(float4*)&kk[0] = *(const float4*)&cur.kk[s][ks * 8];
      *(float4*)&kk[4] = *(const float4*)&cur.kk[s][ks * 8 + 4];
      *(float4*)&wr[0] = *(const float4*)&cur.wr[s][ks * 8];
      *(float4*)&wr[4] = *(const float4*)&cur.wr[s][ks * 8 + 4];
      *(float4*)&w[0] = *(const float4*)&cur.w[s][ks * 8];
      *(float4*)&w[4] = *(const float4*)&cur.w[s][ks * 8 + 4];
      *(float4*)&kt[0] = *(const float4*)&cur.kt[s][ks * 8];
      *(float4*)&kt[4] = *(const float4*)&cur.kt[s][ks * 8 + 4];
      *(float4*)&kka[0] = *(const float4*)&cur.kka[s][ks * 8];
      *(float4*)&kka[4] = *(const float4*)&cur.kka[s][ks * 8 + 4];
      float2 vv = *(const float2*)&cur.v[s][row0];
      float2 cc = *(const float2*)&cur.c[s][0];
      float vr[2] = {vv.x, vv.y};
      float d1[2], d2[2];
#pragma unroll
      for (int i = 0; i < 2; i++) {
        float a0 = 0.f, a1 = 0.f, b0 = 0.f, b1 = 0.f;
#pragma unroll
        for (int e = 0; e < 8; e += 2) {
          a0 = fmaf(S[i][e], kk[e], a0);
          a1 = fmaf(S[i][e + 1], kk[e + 1], a1);
          b0 = fmaf(S[i][e], wr[e], b0);
          b1 = fmaf(S[i][e + 1], wr[e + 1], b1);
        }
        d1[i] = sum8(a0 + a1);
        d2[i] = sum8(b0 + b1);
      }
#pragma unroll
      for (int i = 0; i < 2; i++) {
        float skk = d1[i];
        float y = d2[i] - skk * cc.x + vr[i] * cc.y;
        if (ks == 0) ybuf[s][row0 + i] = y;
#pragma unroll
        for (int e = 0; e < 8; e++) S[i][e] = fmaf(S[i][e], w[e], fmaf(-skk, kka[e], vr[i] * kt[e]));
      }
    }
    __syncthreads();
    {
      float4 y4 = *(const float4*)&ybuf[tl][kq * 4];
      float y[4] = {y4.x, y4.y, y4.z, y4.w};
      float mean = sum16(y[0] + y[1] + y[2] + y[3]) * (1.0f / 64.0f);
      float q = 0.f;
#pragma unroll
      for (int e = 0; e < 4; e++) { y[e] -= mean; q += y[e] * y[e]; }
      float rstd = rsqrtf(sum16(q) * (1.0f / 64.0f) + 64e-5f);
      float c3 = cur.c[tl][2];
      float4 v4 = *(const float4*)&cur.v[tl][kq * 4];
      float4 g4 = *(const float4*)&cur.g[tl][kq * 4];
      float vv[4] = {v4.x, v4.y, v4.z, v4.w};
      float gg[4] = {g4.x, g4.y, g4.z, g4.w};
      float o[4];
#pragma unroll
      for (int e = 0; e < 4; e++) o[e] = (y[e] * rstd * lg[e] + lb[e] + c3 * vv[e]) * gg[e];
      size_t row = (size_t)(rowbase + c * 16 + tl);
      *(uint2*)(YR + row * 512 + hc) = make_uint2(pk2(o[0], o[1]), pk2(o[2], o[3]));
    }
    if (have_next) stage(nx, in[(c + 1) & 1]);
    __syncthreads();
  }
}

constexpr int KLD = 104, VLD = 72;
struct AttnSmem { u16 k[2][64 * KLD]; u16 v[2][64 * VLD]; };

__device__ __forceinline__ void attn_unit(const Params& p, int bh, int qi, char* smem) {
  const int tid = threadIdx.x, lane = tid & 63, wave = tid >> 6;
  const int fr = lane & 15, fq = lane >> 4;
  const int b = bh >> 3, h = bh & 7;
  const int rowbase = b * T_;
  u16* P = (u16*)(p.ws + OFF_P);
  const u16* Q = (const u16*)(p.ws + OFF_Q);
  const u16* KN = (const u16*)p.out;
  const u16* VT = (const u16*)p.out + (size_t)M_ * 512;
  const float2* ROPE = (const float2*)(p.ws + OFF_ROPE);
  AttnSmem* sm = (AttnSmem*)smem;
  const int qs = (qi == 0) ? 0 : 16 + (qi - 1) * 128;
  const int qn = (qi == 0) ? 16 : 128;
  const int q0 = qs + wave * 32;
  const bool wave_valid = (wave * 32 < qn);
  const int nkt = (qs + qn - 1) / 64 + 1;

  bf16x8 qf[2][3];
#pragma unroll
  for (int qb = 0; qb < 2; qb++) {
    int query = min(q0 + qb * 16 + fr, T_ - 1);
    const u16* qp = Q + (size_t)(rowbase + query) * 768 + h * 96;
    uint4 a0 = *(const uint4*)(qp + fq * 8);
    uint4 a1 = *(const uint4*)(qp + 32 + fq * 8);
    uint4 own = *(const uint4*)(qp + 64 + fq * 8);
    uint4 oth = *(const uint4*)(qp + 64 + (fq ^ 2) * 8);
    unsigned ow[4] = {own.x, own.y, own.z, own.w};
    unsigned tw[4] = {oth.x, oth.y, oth.z, oth.w};
    unsigned rw[4];
    const float2* rp = ROPE + (size_t)query * 16 + (fq & 1) * 8;
#pragma unroll
    for (int e = 0; e < 4; e++) {
      float2 cs0 = rp[2 * e], cs1 = rp[2 * e + 1];
      float o0 = bflo(ow[e]), o1 = bfhi(ow[e]);
      float t0 = bflo(tw[e]), t1 = bfhi(tw[e]);
      float r0, r1;
      if (fq < 2) { r0 = o0 * cs0.x - t0 * cs0.y; r1 = o1 * cs1.x - t1 * cs1.y; }
      else { r0 = t0 * cs0.y + o0 * cs0.x; r1 = t1 * cs1.y + o1 * cs1.x; }
      rw[e] = pk2(r0, r1);
    }
    uint4 a2 = make_uint4(rw[0], rw[1], rw[2], rw[3]);
    qf[qb][0] = *(bf16x8*)&a0;
    qf[qb][1] = *(bf16x8*)&a1;
    qf[qb][2] = *(bf16x8*)&a2;
  }

  f32x4 O[4][2];
#pragma unroll
  for (int i = 0; i < 4; i++)
#pragma unroll
    for (int j = 0; j < 2; j++) O[i][j] = f32x4{0.f, 0.f, 0.f, 0.f};
  float mrun[2] = {-1e30f, -1e30f}, lrun[2] = {0.f, 0.f};
  const float sc = 1.4426950408889634f / 9.797958971132712f;

  uint4 rk[3], rv[2];
  auto fetch_tile = [&](int kt) {
#pragma unroll
    for (int i = 0; i < 3; i++) {
      int c = tid + 256 * i;
      int key = c / 12, cc = c % 12;
      int t = kt * 64 + key;
      uint4 val = make_uint4(0, 0, 0, 0);
      if (t < T_) {
        size_t row = (size_t)(rowbase + t);
        if (cc < 8) val = *(const uint4*)(KN + row * 512 + h * 64 + cc * 8);
        else val = *(const uint4*)(P + row * PC_ + PKR_ + (cc - 8) * 8);
      }
      rk[i] = val;
    }
#pragma unroll
    for (int i = 0; i < 2; i++) {
      int c = tid + 256 * i;
      int dv = c >> 3, cc = c & 7;
      int t = kt * 64 + cc * 8;
      uint4 val = make_uint4(0, 0, 0, 0);
      if (t < T_) val = *(const uint4*)(VT + ((size_t)bh * 64 + dv) * T_ + t);
      rv[i] = val;
    }
  };
  auto store_tile = [&](int buf) {
#pragma unroll
    for (int i = 0; i < 3; i++) {
      int c = tid + 256 * i;
      int key = c / 12, cc = c % 12;
      *(uint4*)(&sm->k[buf][key * KLD + cc * 8]) = rk[i];
    }
#pragma unroll
    for (int i = 0; i < 2; i++) {
      int c = tid + 256 * i;
      int dv = c >> 3, cc = c & 7;
      *(uint4*)(&sm->v[buf][dv * VLD + cc * 8]) = rv[i];
    }
  };

  fetch_tile(0);
  for (int kt = 0; kt < nkt; kt++) {
    const int buf = kt & 1;
    store_tile(buf);
    __syncthreads();
    if (kt + 1 < nkt) fetch_tile(kt + 1);
    if (wave_valid && kt * 64 <= q0 + 31) {
      const u16* Ks = sm->k[buf];
      const u16* Vs = sm->v[buf];
      f32x4 s[4][2];
#pragma unroll
      for (int i = 0; i < 4; i++)
#pragma unroll
        for (int j = 0; j < 2; j++) s[i][j] = f32x4{0.f, 0.f, 0.f, 0.f};
#pragma unroll
      for (int ks = 0; ks < 3; ks++)
#pragma unroll
        for (int kb = 0; kb < 4; kb++) {
          bf16x8 kf = *(const bf16x8*)(Ks + (kb * 16 + fr) * KLD + ks * 32 + fq * 8);
#pragma unroll
          for (int qb = 0; qb < 2; qb++) s[kb][qb] = __builtin_amdgcn_mfma_f32_16x16x32_bf16(kf, qf[qb][ks], s[kb][qb], 0, 0, 0);
        }
      const bool need_mask = (kt * 64 + 63 > q0);
      unsigned pfw[2][2][4];
#pragma unroll
      for (int qb = 0; qb < 2; qb++) {
        const int query = q0 + qb * 16 + fr;
        float mx = -1e30f;
#pragma unroll
        for (int kb = 0; kb < 4; kb++)
#pragma unroll
          for (int j = 0; j < 4; j++) {
            float v = s[kb][qb][j] * sc;
            if (need_mask) {
              int key = kt * 64 + kb * 16 + fq * 4 + j;
              if (key > query) v = -1e30f;
            }
            s[kb][qb][j] = v;
            mx = fmaxf(mx, v);
          }
        mx = fmaxf(mx, __shfl_xor(mx, 16));
        mx = fmaxf(mx, __shfl_xor(mx, 32));
        float mnew = fmaxf(mrun[qb], mx);
        float alpha = exp2f(mrun[qb] - mnew);
        mrun[qb] = mnew;
        float ps = 0.f;
#pragma unroll
        for (int kb = 0; kb < 4; kb++) {
          float p0 = exp2f(s[kb][qb][0] - mnew), p1 = exp2f(s[kb][qb][1] - mnew);
          float p2 = exp2f(s[kb][qb][2] - mnew), p3 = exp2f(s[kb][qb][3] - mnew);
          ps += (p0 + p1) + (p2 + p3);
          pfw[qb][kb >> 1][(kb & 1) * 2 + 0] = pk2(p0, p1);
          pfw[qb][kb >> 1][(kb & 1) * 2 + 1] = pk2(p2, p3);
        }
        lrun[qb] = lrun[qb] * alpha + ps;
#pragma unroll
        for (int dvb = 0; dvb < 4; dvb++) {
          O[dvb][qb][0] *= alpha; O[dvb][qb][1] *= alpha; O[dvb][qb][2] *= alpha; O[dvb][qb][3] *= alpha;
        }
      }
#pragma unroll
      for (int s2 = 0; s2 < 2; s2++)
#pragma unroll
        for (int dvb = 0; dvb < 4; dvb++) {
          const u16* vp = Vs + (dvb * 16 + fr) * VLD + s2 * 32 + fq * 4;
          uint2 v0 = *(const uint2*)vp;
          uint2 v1 = *(const uint2*)(vp + 16);
          uint4 vv = make_uint4(v0.x, v0.y, v1.x, v1.y);
          bf16x8 vf = *(bf16x8*)&vv;
#pragma unroll
          for (int qb = 0; qb < 2; qb++) {
            uint4 pw = make_uint4(pfw[qb][s2][0], pfw[qb][s2][1], pfw[qb][s2][2], pfw[qb][s2][3]);
            O[dvb][qb] = __builtin_amdgcn_mfma_f32_16x16x32_bf16(vf, *(bf16x8*)&pw, O[dvb][qb], 0, 0, 0);
          }
        }
    }
  }
  __syncthreads();
  if (wave_valid) {
#pragma unroll
    for (int qb = 0; qb < 2; qb++) {
      float l = lrun[qb];
      l += __shfl_xor(l, 16);
      l += __shfl_xor(l, 32);
      float inv = 1.0f / l;
      int query = q0 + qb * 16 + fr;
      if (query < qs + qn) {
        u16* op = P + (size_t)(rowbase + query) * PC_ + PMLA_ + h * 64 + fq * 4;
#pragma unroll
        for (int dvb = 0; dvb < 4; dvb++) {
          *(uint2*)(op + dvb * 16) =
              make_uint2(pk2(O[dvb][qb][0] * inv, O[dvb][qb][1] * inv), pk2(O[dvb][qb][2] * inv, O[dvb][qb][3] * inv));
        }
      }
    }
  }
}

__global__ void __launch_bounds__(256, 1) mega(Params p) {
  cg::grid_group grid = cg::this_grid();
  __shared__ __attribute__((aligned(16))) char smem[SMEM_BYTES];
  __shared__ int s_unit;
  const int tid = threadIdx.x, lane = tid & 63, wave = tid >> 6;
  const int nblk = gridDim.x;
  float* H = (float*)(p.ws + OFF_H);
  u16* P = (u16*)(p.ws + OFF_P);
  float* DEC = (float*)(p.ws + OFF_DEC);
  u16* AA = (u16*)(p.ws + OFF_AA);
  u16* GG = (u16*)(p.ws + OFF_GG);
  u16* Q = (u16*)(p.ws + OFF_Q);
  u16* MIX = (u16*)(p.ws + OFF_DEC);
  u16* ACT = (u16*)(p.ws + OFF_P);
  float2* ROPE = (float2*)(p.ws + OFF_ROPE);
  int* CTR = (int*)(p.ws + OFF_CTR);
  u16* KN = (u16*)p.out;
  u16* VT = KN + (size_t)M_ * 512;
  u16* YR = VT + (size_t)M_ * 512;

  for (int t = blockIdx.x; t < p.nconv; t += nblk) conv_tile(p, t, smem);
  for (int i = blockIdx.x * 256 + tid; i < T_ * 16; i += nblk * 256) {
    int t = i >> 4, f = i & 15;
    double rev = (double)t * ROPE_C[f];
    rev -= floor(rev);
    float r = (float)rev;
    ROPE[i] = make_float2(__builtin_amdgcn_cosf(r), __builtin_amdgcn_sinf(r));
  }
  for (int row = blockIdx.x * 4 + wave; row < M_; row += nblk * 4) {
    int b = row / T_, t = row % T_;
    const float* src = (t < NMETA_) ? (p.in[1] + (size_t)t * 1024) : (p.in[0] + ((size_t)b * SEQ_ + (t - NMETA_)) * 1024);
    ln_row(src, p.in[2], p.in[3], H + (size_t)row * 1024, lane);
  }
  if (blockIdx.x == 0 && tid == 0) { CTR[0] = 0; CTR[1] = 0; }
  grid.sync();

  for (int l = 0; l < 2; l++) {
    const u16* WL = (const u16*)(p.ws + OFF_W) + (size_t)l * W_LAYER;
    if (PHMASK & 1)
    for (int tile = blockIdx.x; tile < 514 * 19; tile += nblk) {
      int mt = tile / 19, nt = tile % 19;
      f32x4 acc[4][4];
      zero_acc(acc);
      AL<0> al{H, 1024, mt * 128, 0, 0, nullptr, 0};
      gemm_loop(acc, al, WL + W_IN, 1024, nt * 128, 1024, smem);
      ACC_COORDS
#pragma unroll
      for (int mi = 0; mi < 4; mi++)
#pragma unroll
        for (int ni = 0; ni < 4; ni++) {
          int col = nt * 128 + wc * 64 + ni * 16 + fr;
          if (col < PC_) {
#pragma unroll
            for (int j = 0; j < 4; j++) {
              int row = mt * 128 + wr * 64 + mi * 16 + fq * 4 + j;
              P[(size_t)row * PC_ + col] = f2bf(acc[mi][ni][j]);
            }
          }
        }
    }
    grid.sync();
    if (PHMASK & 2)
    {
      const float* qg = p.in[16] + l * 256;
      const float* kvg = p.in[18] + l * 256;
      for (int row = blockIdx.x * 4 + wave; row < M_; row += nblk * 4) {
        u16* pr = P + (size_t)row * PC_;
        uint2 cq = *(const uint2*)(pr + PMLA_ + lane * 4);
        uint2 ckv = *(const uint2*)(pr + PKV_ + lane * 4);
        float a[4], c[4];
        unpack4(cq, a);
        unpack4(ckv, c);
        float s1 = a[0] * a[0] + a[1] * a[1] + a[2] * a[2] + a[3] * a[3];
        float s2 = c[0] * c[0] + c[1] * c[1] + c[2] * c[2] + c[3] * c[3];
        s1 = wave_sum(s1);
        s2 = wave_sum(s2);
        float r1 = rsqrtf(s1 * (1.0f / 256.0f) + 1e-6f), r2 = rsqrtf(s2 * (1.0f / 256.0f) + 1e-6f);
        float4 g1 = *(const float4*)(qg + lane * 4), g2 = *(const float4*)(kvg + lane * 4);
        *(uint2*)(pr + PMLA_ + lane * 4) = make_uint2(pk2(a[0] * r1 * g1.x, a[1] * r1 * g1.y), pk2(a[2] * r1 * g1.z, a[3] * r1 * g1.w));
        *(uint2*)(pr + PKV_ + lane * 4) = make_uint2(pk2(c[0] * r2 * g2.x, c[1] * r2 * g2.y), pk2(c[2] * r2 * g2.z, c[3] * r2 * g2.w));
        if (lane < 16) {
          int t = row % T_;
          float x1 = bf2f(pr[PKR_ + lane]), x2 = bf2f(pr[PKR_ + 16 + lane]);
          float2 cs = ROPE[t * 16 + lane];
          pr[PKR_ + lane] = f2bf(x1 * cs.x - x2 * cs.y);
          pr[PKR_ + 16 + lane] = f2bf(x1 * cs.y + x2 * cs.x);
        }
      }
      const float* mu = p.in[5] + (size_t)l * 1824;
      for (int tile = blockIdx.x; tile < 514 * 12; tile += nblk) {
        int mt = tile / 12, sub = tile % 12, which = sub >> 2, nt = sub & 3;
        f32x4 acc[4][4];
        zero_acc(acc);
        ACC_COORDS
        if (which == 0) {
          AL<3> al{P + 1536, PC_, mt * 128, 0, 64, mu + 1536, 0};
          gemm_loop(acc, al, WL + W_LW, 64, nt * 128, 64, smem);
          const float* w0 = p.in[6] + l * 512;
#pragma unroll
          for (int mi = 0; mi < 4; mi++)
#pragma unroll
            for (int ni = 0; ni < 4; ni++) {
              int col = nt * 128 + wc * 64 + ni * 16 + fr;
              float w0c = w0[col];
#pragma unroll
              for (int j = 0; j < 4; j++) {
                int row = mt * 128 + wr * 64 + mi * 16 + fq * 4 + j;
                float x = -(acc[mi][ni][j] + w0c);
                float sp = fmaxf(x, 0.f) + log1pf(__expf(-fabsf(x)));
                float wraw = -sp - 0.5f;
                DEC[(size_t)row * 512 + col] = __expf(-__expf(wraw));
              }
            }
        } else if (which == 1) {
          AL<3> al{P + 1600, PC_, mt * 128, 0, 64, mu + 1600, 1};
          gemm_loop(acc, al, WL + W_LA, 64, nt * 128, 64, smem);
          const float* a0 = p.in[8] + l * 512;
#pragma unroll
          for (int mi = 0; mi < 4; mi++)
#pragma unroll
            for (int ni = 0; ni < 4; ni++) {
              int col = nt * 128 + wc * 64 + ni * 16 + fr;
              float a0c = a0[col];
#pragma unroll
              for (int j = 0; j < 4; j++) {
                int row = mt * 128 + wr * 64 + mi * 16 + fq * 4 + j;
                AA[(size_t)row * 512 + col] = f2bf(sigmoidf_(acc[mi][ni][j] + a0c));
              }
            }
        } else {
          AL<3> al{P + 1664, PC_, mt * 128, 0, 160, mu + 1664, 2};
          gemm_loop(acc, al, WL + W_LG, 192, nt * 128, 192, smem);
#pragma unroll
          for (int mi = 0; mi < 4; mi++)
#pragma unroll
            for (int ni = 0; ni < 4; ni++) {
              int col = nt * 128 + wc * 64 + ni * 16 + fr;
#pragma unroll
              for (int j = 0; j < 4; j++) {
                int row = mt * 128 + wr * 64 + mi * 16 + fq * 4 + j;
                GG[(size_t)row * 512 + col] = f2bf(acc[mi][ni][j]);
              }
            }
        }
      }
    }
    grid.sync();
    if (PHMASK & 4)
    for (int tile = blockIdx.x; tile < 514 * 14; tile += nblk) {
      int mt = tile / 14, sub = tile % 14;
      f32x4 acc[4][4];
      zero_acc(acc);
      ACC_COORDS
      if (sub < 6) {
        AL<1> al{P + PMLA_, PC_, mt * 128, 0, 0, nullptr, 0};
        gemm_loop(acc, al, WL + W_UQ, 256, sub * 128, 256, smem);
#pragma unroll
        for (int mi = 0; mi < 4; mi++)
#pragma unroll
          for (int ni = 0; ni < 4; ni++) {
            int col = sub * 128 + wc * 64 + ni * 16 + fr;
#pragma unroll
            for (int j = 0; j < 4; j++) {
              int row = mt * 128 + wr * 64 + mi * 16 + fq * 4 + j;
              Q[(size_t)row * 768 + col] = f2bf(acc[mi][ni][j]);
            }
          }
      } else if (sub < 10) {
        int nt = sub - 6;
        AL<1> al{P + PKV_, PC_, mt * 128, 0, 0, nullptr, 0};
        gemm_loop(acc, al, WL + W_UK, 256, nt * 128, 256, smem);
#pragma unroll
        for (int mi = 0; mi < 4; mi++)
#pragma unroll
          for (int ni = 0; ni < 4; ni++) {
            int col = nt * 128 + wc * 64 + ni * 16 + fr;
#pragma unroll
            for (int j = 0; j < 4; j++) {
              int row = mt * 128 + wr * 64 + mi * 16 + fq * 4 + j;
              KN[(size_t)row * 512 + col] = f2bf(acc[mi][ni][j]);
            }
          }
      } else {
        int nt = sub - 10;
        AL<1> al{P + PKV_, PC_, mt * 128, 0, 0, nullptr, 0};
        gemm_loop(acc, al, WL + W_UV, 256, nt * 128, 256, smem);
#pragma unroll
        for (int mi = 0; mi < 4; mi++)
#pragma unroll
          for (int ni = 0; ni < 4; ni++) {
            int col = nt * 128 + wc * 64 + ni * 16 + fr;
            int row = mt * 128 + wr * 64 + mi * 16 + fq * 4;
            int b = row / T_, t = row % T_;
            size_t o = ((size_t)(b * 512 + col)) * T_ + t;
            *(uint2*)(VT + o) = make_uint2(pk2(acc[mi][ni][0], acc[mi][ni][1]), pk2(acc[mi][ni][2], acc[mi][ni][3]));
          }
      }
    }
    grid.sync();
    if (PHMASK & 8)
    {
      const int total = 128 + 33 * 128;
      while (true) {
        if (tid == 0) s_unit = atomicAdd(&CTR[l], 1);
        __syncthreads();
        int u = s_unit;
        __syncthreads();
        if (u >= total) break;
        if (u < 128) { if (PHMASK & 8) scan_unit(p, l, u, smem); }
        else {
          int v = u - 128;
          if (PHMASK & 512) attn_unit(p, v & 127, 32 - (v >> 7), smem);
        }
        __syncthreads();
      }
    }
    grid.sync();
    if (PHMASK & 16)
    for (int tile = blockIdx.x; tile < 514 * 16; tile += nblk) {
      int mt = tile >> 4, nt = tile & 15;
      f32x4 acc[4][2], tac[4][2];
      unsigned sg[4][2][2];
      ACC_COORDS
      AL<0> alh{H, 1024, mt * 128, 0, 0, nullptr, 0};
      zero_acc(acc);
      gemm_loop(acc, alh, WL + W_G, 1024, nt * 64, 1024, smem);
#pragma unroll
      for (int mi = 0; mi < 4; mi++)
#pragma unroll
        for (int ni = 0; ni < 2; ni++) {
          sg[mi][ni][0] = pk2(sigmoidf_(acc[mi][ni][0]), sigmoidf_(acc[mi][ni][1]));
          sg[mi][ni][1] = pk2(sigmoidf_(acc[mi][ni][2]), sigmoidf_(acc[mi][ni][3]));
        }
      zero_acc(acc);
      {
        AL<1> aly{YR, 512, mt * 128, 0, 0, nullptr, 0};
        gemm_loop(acc, aly, WL + W_PR, 512, nt * 64, 512, smem);
      }
#pragma unroll
      for (int mi = 0; mi < 4; mi++)
#pragma unroll
        for (int ni = 0; ni < 2; ni++) {
          tac[mi][ni][0] = bflo(sg[mi][ni][0]) * acc[mi][ni][0];
          tac[mi][ni][1] = bfhi(sg[mi][ni][0]) * acc[mi][ni][1];
          tac[mi][ni][2] = bflo(sg[mi][ni][1]) * acc[mi][ni][2];
          tac[mi][ni][3] = bfhi(sg[mi][ni][1]) * acc[mi][ni][3];
        }
      zero_acc(acc);
      gemm_loop(acc, alh, WL + W_G, 1024, 1024 + nt * 64, 1024, smem);
#pragma unroll
      for (int mi = 0; mi < 4; mi++)
#pragma unroll
        for (int ni = 0; ni < 2; ni++) {
          sg[mi][ni][0] = pk2(sigmoidf_(acc[mi][ni][0]), sigmoidf_(acc[mi][ni][1]));
          sg[mi][ni][1] = pk2(sigmoidf_(acc[mi][ni][2]), sigmoidf_(acc[mi][ni][3]));
        }
      zero_acc(acc);
      {
        AL<1> alm{P + PMLA_, PC_, mt * 128, 0, 0, nullptr, 0};
        gemm_loop(acc, alm, WL + W_PM, 512, nt * 64, 512, smem);
      }
#pragma unroll
      for (int mi = 0; mi < 4; mi++)
#pragma unroll
        for (int ni = 0; ni < 2; ni++) {
          int col = nt * 64 + wc * 32 + ni * 16 + fr;
          int row = mt * 128 + wr * 64 + mi * 16 + fq * 4;
          float o0 = tac[mi][ni][0] + bflo(sg[mi][ni][0]) * acc[mi][ni][0];
          float o1 = tac[mi][ni][1] + bfhi(sg[mi][ni][0]) * acc[mi][ni][1];
          float o2 = tac[mi][ni][2] + bflo(sg[mi][ni][1]) * acc[mi][ni][2];
          float o3 = tac[mi][ni][3] + bfhi(sg[mi][ni][1]) * acc[mi][ni][3];
          MIX[(size_t)(row + 0) * 1024 + col] = f2bf(o0);
          MIX[(size_t)(row + 1) * 1024 + col] = f2bf(o1);
          MIX[(size_t)(row + 2) * 1024 + col] = f2bf(o2);
          MIX[(size_t)(row + 3) * 1024 + col] = f2bf(o3);
        }
    }
    grid.sync();
    if (PHMASK & 32)
    for (int tile = blockIdx.x; tile < 514 * 8; tile += nblk) {
      int mt = tile >> 3, nt = tile & 7;
      f32x4 acc[4][4];
      zero_acc(acc);
      ACC_COORDS
      AL<1> al{MIX, 1024, mt * 128, 0, 0, nullptr, 0};
      gemm_loop(acc, al, WL + W_OUT, 1024, nt * 128, 1024, smem);
#pragma unroll
      for (int mi = 0; mi < 4; mi++)
#pragma unroll
        for (int ni = 0; ni < 4; ni++) {
          int col = nt * 128 + wc * 64 + ni * 16 + fr;
#pragma unroll
          for (int j = 0; j < 4; j++) {
            int row = mt * 128 + wr * 64 + mi * 16 + fq * 4 + j;
            float* hp = H + (size_t)row * 1024 + col;
            *hp = ALPHA_ * (*hp) + acc[mi][ni][j];
          }
        }
    }
    grid.sync();
    if (PHMASK & 64)
    for (int row = blockIdx.x * 4 + wave; row < M_; row += nblk * 4)
      ln_row(H + (size_t)row * 1024, p.in[24] + l * 1024, p.in[25] + l * 1024, H + (size_t)row * 1024, lane);
    grid.sync();
    if (PHMASK & 128)
    {
      const float* cw = p.in[27] + (size_t)l * 3 * 5632;
      const float* cb = p.in[28] + (size_t)l * 5632;
      for (int tile = blockIdx.x; tile < 16 * 33 * 44; tile += nblk) {
        int nt = tile % 44, rest = tile / 44, it = rest % 33, b = rest / 33;
        int t0 = 126 * it - 2;
        f32x4 acc[4][4];
        zero_acc(acc);
        AL<2> al{H, 1024, b * T_, t0, 0, nullptr, 0};
        gemm_loop(acc, al, WL + W_UP, 1024, nt * 128, 1024, smem);
        ACC_COORDS
        float(*ut)[132] = (float(*)[132])smem;
#pragma unroll
        for (int mi = 0; mi < 4; mi++)
#pragma unroll
          for (int ni = 0; ni < 4; ni++)
#pragma unroll
            for (int j = 0; j < 4; j++) ut[wr * 64 + mi * 16 + fq * 4 + j][wc * 64 + ni * 16 + fr] = acc[mi][ni][j];
        __syncthreads();
        {
          int c = tid & 63, rg = tid >> 6;
          int gcol = nt * 64 + c, vcol = DFF_ + nt * 64 + c;
          float g0 = cw[gcol], g1 = cw[5632 + gcol], g2 = cw[2 * 5632 + gcol], gb = cb[gcol];
          float v0 = cw[vcol], v1 = cw[5632 + vcol], v2 = cw[2 * 5632 + vcol], vb = cb[vcol];
          int rs = 2 + rg * 32, re = min(rs + 32, 128);
          float ga = ut[rs - 2][c], gbp = ut[rs - 1][c];
          float va = ut[rs - 2][64 + c], vbp = ut[rs - 1][64 + c];
          for (int r = rs; r < re; r++) {
            float gc = ut[r][c], vc = ut[r][64 + c];
            int t = t0 + r;
            if (t < T_) {
              float gate = g0 * ga + g1 * gbp + g2 * gc + gb;
              float val = v0 * va + v1 * vbp + v2 * vc + vb;
              float a = gate * sigmoidf_(gate) * val;
              ACT[(size_t)(b * T_ + t) * DFF_ + gcol] = f2bf(a);
            }
            ga = gbp; gbp = gc; va = vbp; vbp = vc;
          }
        }
        __syncthreads();
      }
    }
    grid.sync();
    if (PHMASK & 256)
    for (int tile = blockIdx.x; tile < 514 * 8; tile += nblk) {
      int mt = tile >> 3, nt = tile & 7;
      f32x4 acc[4][4];
      zero_acc(acc);
      ACC_COORDS
      AL<1> al{ACT, DFF_, mt * 128, 0, 0, nullptr, 0};
      gemm_loop(acc, al, WL + W_DN, DFF_, nt * 128, DFF_, smem);
#pragma unroll
      for (int mi = 0; mi < 4; mi++)
#pragma unroll
        for (int ni = 0; ni < 4; ni++) {
          int col = nt * 128 + wc * 64 + ni * 16 + fr;
#pragma unroll
          for (int j = 0; j < 4; j++) {
            int row = mt * 128 + wr * 64 + mi * 16 + fq * 4 + j;
            float* hp = H + (size_t)row * 1024 + col;
            *hp = ALPHA_ * (*hp) + acc[mi][ni][j];
          }
        }
    }
    grid.sync();
    if (l == 0) {
      for (int row = blockIdx.x * 4 + wave; row < M_; row += nblk * 4)
        ln_row(H + (size_t)row * 1024, p.in[30], p.in[31], H + (size_t)row * 1024, lane);
      grid.sync();
    } else {
      for (int row = blockIdx.x * 4 + wave; row < M_; row += nblk * 4) {
        int b = row / T_, t = row % T_;
        if (t >= NMETA_)
          ln_row(H + (size_t)row * 1024, p.in[30] + 1024, p.in[31] + 1024, p.out + ((size_t)b * SEQ_ + (t - NMETA_)) * 1024, lane);
      }
    }
  }
}

extern "C" void kernel_launch(void* const* d_in, const int* in_sizes, int n_in, void* d_out, int out_size, void* d_ws,
                              size_t ws_size, hipStream_t stream) {
  static int grid_blocks = 0;
  if (!grid_blocks) {
    int dev = 0, cus = 0, per_cu = 0;
    hipGetDevice(&dev);
    hipDeviceGetAttribute(&cus, hipDeviceAttributeMultiprocessorCount, dev);
    hipOccupancyMaxActiveBlocksPerMultiprocessor(&per_cu, mega, 256, 0);
    if (per_cu > 2) per_cu = 2;
    grid_blocks = cus * per_cu;
  }
  if (ws_size < WS_TOTAL) fprintf(stderr, "workspace too small: %zu < %zu\n", ws_size, (size_t)WS_TOTAL);
  Params p;
  memset(&p, 0, sizeof(p));
  for (int i = 0; i < 32; i++) p.in[i] = (const float*)d_in[i];
  p.out = (float*)d_out;
  p.ws = (char*)d_ws;
  u16* wb = (u16*)((char*)d_ws + OFF_W);
  int nj = 0, tiles = 0;
  auto add = [&](const float* src, size_t dst_off, int ld, int c0, int K, int Kpad, int Nv, int Np, int mode) {
    Job& j = p.jobs[nj++];
    j.src = src; j.dst = wb + dst_off; j.ld = ld; j.c0 = c0; j.K = K; j.Kpad = Kpad; j.Nv = Nv; j.Np = Np; j.mode = mode;
    j.tile0 = tiles;
    tiles += (Kpad / 32) * (Np / 32);
  };
  for (int l = 0; l < 2; l++) {
    size_t o = (size_t)l * W_LAYER;
    const float* w_in = (const float*)d_in[4] + (size_t)l * 1024 * 4416;
    add(w_in, o + W_IN, 4416, 0, 1024, 1024, 2368, 2432, 0);
    add(w_in, o + W_G, 4416, 2368, 1024, 1024, 2048, 2048, 0);
    add((const float*)d_in[7] + (size_t)l * 64 * 512, o + W_LW, 512, 0, 64, 64, 512, 512, 0);
    add((const float*)d_in[9] + (size_t)l * 64 * 512, o + W_LA, 512, 0, 64, 64, 512, 512, 0);
    add((const float*)d_in[10] + (size_t)l * 160 * 512, o + W_LG, 512, 0, 160, 192, 512, 512, 0);
    add((const float*)d_in[17] + (size_t)l * 256 * 768, o + W_UQ, 768, 0, 256, 256, 768, 768, 0);
    add((const float*)d_in[19] + (size_t)l * 256 * 512, o + W_UK, 512, 0, 256, 256, 512, 512, 0);
    add((const float*)d_in[20] + (size_t)l * 256 * 512, o + W_UV, 512, 0, 256, 256, 512, 512, 0);
    add((const float*)d_in[21] + (size_t)l * 512 * 1024, o + W_PR, 1024, 0, 512, 512, 1024, 1024, 0);
    add((const float*)d_in[22] + (size_t)l * 512 * 1024, o + W_PM, 1024, 0, 512, 512, 1024, 1024, 0);
    add((const float*)d_in[23] + (size_t)l * 1024 * 1024, o + W_OUT, 1024, 0, 1024, 1024, 1024, 1024, 0);
    add((const float*)d_in[26] + (size_t)l * 1024 * 5632, o + W_UP, 5632, 0, 1024, 1024, 5632, 5632, 1);
    add((const float*)d_in[29] + (size_t)l * 2816 * 1024, o + W_DN, 1024, 0, 2816, 2816, 1024, 1024, 0);
  }
  p.nconv = tiles;
  void* args[] = {&p};
  hipError_t e = hipLaunchCooperativeKernel((void*)mega, dim3(grid_blocks), dim3(256), args, 0, stream);
  if (e != hipSuccess) fprintf(stderr, "cooperative launch failed: %s (grid %d)\n", hipGetErrorString(e), grid_blocks);
}
```

```cpp
#include <hip/hip_runtime.h>
#include <hip/hip_cooperative_groups.h>
#include <cstdio>
#include <cstring>
namespace cg = cooperative_groups;

#ifndef PHMASK
#define PHMASK 0xFFFF
#endif
typedef unsigned short u16;
using bf16x8 = __attribute__((ext_vector_type(8))) short;
using f32x4 = __attribute__((ext_vector_type(4))) float;

constexpr int B_ = 16, SEQ_ = 4096, NMETA_ = 16, T_ = 4112, M_ = B_ * T_, D_ = 1024;
constexpr int PC_ = 2368;
constexpr int PMLA_ = 1824, PKV_ = 2080, PKR_ = 2336;
constexpr int DFF_ = 2816;
constexpr float ALPHA_ = 1.4142135623730951f;

constexpr size_t OFF_H = 0;
constexpr size_t OFF_P = OFF_H + (size_t)M_ * 1024 * 4;
constexpr size_t OFF_DEC = OFF_P + (size_t)M_ * PC_ * 2;
constexpr size_t OFF_AA = OFF_DEC + (size_t)M_ * 512 * 4;
constexpr size_t OFF_GG = OFF_AA + (size_t)M_ * 512 * 2;
constexpr size_t OFF_Q = OFF_GG + (size_t)M_ * 512 * 2;
constexpr size_t OFF_W = OFF_Q + (size_t)M_ * 768 * 2;
constexpr size_t W_IN = 0;
constexpr size_t W_G = W_IN + (size_t)2432 * 1024;
constexpr size_t W_LW = W_G + (size_t)2048 * 1024;
constexpr size_t W_LA = W_LW + (size_t)512 * 64;
constexpr size_t W_LG = W_LA + (size_t)512 * 64;
constexpr size_t W_UQ = W_LG + (size_t)512 * 192;
constexpr size_t W_UK = W_UQ + (size_t)768 * 256;
constexpr size_t W_UV = W_UK + (size_t)512 * 256;
constexpr size_t W_PR = W_UV + (size_t)512 * 256;
constexpr size_t W_PM = W_PR + (size_t)1024 * 512;
constexpr size_t W_OUT = W_PM + (size_t)1024 * 512;
constexpr size_t W_UP = W_OUT + (size_t)1024 * 1024;
constexpr size_t W_DN = W_UP + (size_t)5632 * 1024;
constexpr size_t W_LAYER = W_DN + (size_t)1024 * 2816;
constexpr size_t OFF_ROPE = OFF_W + 2 * W_LAYER * 2;
constexpr size_t OFF_CTR = OFF_ROPE + (size_t)T_ * 16 * 8;
constexpr size_t WS_TOTAL = OFF_CTR + 256;

struct Job { const float* src; u16* dst; int ld, c0, K, Kpad, Nv, Np, mode, tile0; };
struct Params {
  const float* in[32];
  float* out;
  char* ws;
  Job jobs[26];
  int nconv;
  int pad0;
};

__constant__ double ROPE_C[16] = {0.15915494309189535, 0.08949940160889101, 0.050329212104487035, 0.0283021958306234,
                                  0.015915494309189534, 0.008949940160889102, 0.005032921210448704, 0.00283021958306234,
                                  0.0015915494309189536, 0.0008949940160889102, 0.0005032921210448703, 0.00028302195830623395,
                                  0.00015915494309189535, 8.949940160889102e-05, 5.0329212104487035e-05, 2.8302195830623396e-05};

typedef __bf16 bf16x2_t __attribute__((ext_vector_type(2)));
typedef float f32x2_t __attribute__((ext_vector_type(2)));
__device__ __forceinline__ unsigned pk2(float a, float b) {
  f32x2_t v = {a, b};
  bf16x2_t r = __builtin_convertvector(v, bf16x2_t);
  return *(unsigned*)&r;
}
__device__ __forceinline__ u16 f2bf(float f) { return (u16)(pk2(f, 0.f) & 0xffffu); }
__device__ __forceinline__ float bf2f(unsigned h) { return __uint_as_float(h << 16); }
__device__ __forceinline__ float bflo(unsigned w) { return __uint_as_float(w << 16); }
__device__ __forceinline__ float bfhi(unsigned w) { return __uint_as_float(w & 0xffff0000u); }
__device__ __forceinline__ float sigmoidf_(float x) { return 1.0f / (1.0f + __expf(-x)); }

__device__ __forceinline__ int launder(int x) { asm volatile("" : "+v"(x)); return x; }
#define PHASE_TID const int tid = launder(tid0); const int lane = tid & 63, wave = tid >> 6; (void)lane; (void)wave;
template <int CTRL>
__device__ __forceinline__ float dppf(float x) {
  return __int_as_float(__builtin_amdgcn_update_dpp(0, __float_as_int(x), CTRL, 0xF, 0xF, true));
}
__device__ __forceinline__ float sum8(float x) {
  x += dppf<0xB1>(x);
  x += dppf<0x4E>(x);
  x += dppf<0x141>(x);
  return x;
}
__device__ __forceinline__ float sum16(float x) {
  x = sum8(x);
  x += dppf<0x140>(x);
  return x;
}
__device__ __forceinline__ float wave_sum(float x) {
#pragma unroll
  for (int o = 32; o > 0; o >>= 1) x += __shfl_xor(x, o);
  return x;
}

constexpr int BM = 128, BN = 128, BK = 64, LDT = 72;
constexpr int SMEM_BYTES = 2 * (BM + BN) * LDT * 2;

template <int MODE>
struct AL {
  const void* base;
  int ld;
  int row0;
  int t0;
  int kvalid;
  const float* mu;
  int fn;
  struct Raw { uint4 x, y; };
  __device__ __forceinline__ Raw fetch(int r, int k) const {
    Raw w;
    w.x = make_uint4(0, 0, 0, 0);
    w.y = make_uint4(0, 0, 0, 0);
    if (MODE == 0) {
      const float* p = (const float*)base + (size_t)(row0 + r) * ld + k;
      w.x = *(const uint4*)p;
      w.y = *(const uint4*)(p + 4);
    } else if (MODE == 1) {
      const u16* p = (const u16*)base + (size_t)(row0 + r) * ld + k;
      w.x = *(const uint4*)p;
    } else if (MODE == 2) {
      int t = t0 + r;
      if (t >= 0 && t < T_) {
        const float* p = (const float*)base + (size_t)(row0 + t) * ld + k;
        w.x = *(const uint4*)p;
        w.y = *(const uint4*)(p + 4);
      }
    } else {
      int row = row0 + r;
      int t = row % T_;
      if (k < kvalid) {
        const u16* p = (const u16*)base + (size_t)row * ld + k;
        w.x = *(const uint4*)p;
        if (t > 0) w.y = *(const uint4*)(p - ld);
      }
    }
    return w;
  }
  __device__ __forceinline__ uint4 cvt(const Raw& w, int k) const {
    if (MODE == 0 || MODE == 2) {
      uint4 o;
      o.x = pk2(__uint_as_float(w.x.x), __uint_as_float(w.x.y));
      o.y = pk2(__uint_as_float(w.x.z), __uint_as_float(w.x.w));
      o.z = pk2(__uint_as_float(w.y.x), __uint_as_float(w.y.y));
      o.w = pk2(__uint_as_float(w.y.z), __uint_as_float(w.y.w));
      return o;
    } else if (MODE == 1) {
      return w.x;
    } else {
      if (k >= kvalid) return make_uint4(0, 0, 0, 0);
      unsigned cw[4] = {w.x.x, w.x.y, w.x.z, w.x.w};
      unsigned pw[4] = {w.y.x, w.y.y, w.y.z, w.y.w};
      unsigned ow[4];
#pragma unroll
      for (int e = 0; e < 4; e++) {
        float x0 = bflo(cw[e]), x1 = bfhi(cw[e]);
        float p0 = bflo(pw[e]), p1 = bfhi(pw[e]);
        float v0 = x0 + (p0 - x0) * mu[k + 2 * e];
        float v1 = x1 + (p1 - x1) * mu[k + 2 * e + 1];
        if (fn == 0) {
          v0 = 1.0f - 2.0f / (__expf(2.0f * v0) + 1.0f);
          v1 = 1.0f - 2.0f / (__expf(2.0f * v1) + 1.0f);
        } else if (fn == 2) {
          v0 = sigmoidf_(v0);
          v1 = sigmoidf_(v1);
        }
        ow[e] = pk2(v0, v1);
      }
      return make_uint4(ow[0], ow[1], ow[2], ow[3]);
    }
  }
};

template <int NI>
__device__ __forceinline__ void zero_acc(f32x4 (&acc)[4][NI]) {
#pragma unroll
  for (int i = 0; i < 4; i++)
#pragma unroll
    for (int j = 0; j < NI; j++) acc[i][j] = f32x4{0.f, 0.f, 0.f, 0.f};
}

#define REP4(X) X(0) X(1) X(2) X(3)
template <class ALT, int NI>
__device__ __forceinline__ void gemm_loop(f32x4 (&acc)[4][NI], const ALT& al, const u16* __restrict__ Bt, int ldb, int n0,
                                          int K, char* smem, const int tid) {
  const int lane = tid & 63, wave = tid >> 6;
  const int wr = wave >> 1, wc = wave & 1, fr = lane & 15, fq = lane >> 4;
  const int lr = tid >> 3, lk = (tid & 7) * 8;
  u16* sa = (u16*)smem;
  u16* sb = sa + 2 * BM * LDT;
  typename ALT::Raw ra0, ra1, ra2, ra3;
  uint4 rb0 = make_uint4(0,0,0,0), rb1 = rb0, rb2 = rb0, rb3 = rb0;
  const u16* bp = Bt + (size_t)(n0 + lr) * ldb + lk;
#define GL_FETCH(i) ra##i = al.fetch(lr + 32 * i, kf); if (i < NI) rb##i = *(const uint4*)(bp + (size_t)(32 * i) * ldb + kb);
#define GL_STORE(i) *(uint4*)(a_ + (lr + 32 * i) * LDT + lk) = al.cvt(ra##i, kt * BK + lk); if (i < NI) *(uint4*)(b_ + (lr + 32 * i) * LDT + lk) = rb##i;
  {
    const int kf = lk, kb = 0;
    REP4(GL_FETCH)
  }
  const int nk = K / BK;
  for (int kt = 0; kt < nk; kt++) {
    u16* a_ = sa + (kt & 1) * BM * LDT;
    u16* b_ = sb + (kt & 1) * BN * LDT;
    REP4(GL_STORE)
    __syncthreads();
    if (kt + 1 < nk) {
      const int kf = (kt + 1) * BK + lk, kb = (kt + 1) * BK;
      REP4(GL_FETCH)
    }
#pragma unroll
    for (int ks = 0; ks < 2; ks++) {
      bf16x8 af[4], bf[NI];
#pragma unroll
      for (int i = 0; i < 4; i++) af[i] = *(const bf16x8*)(a_ + (wr * 64 + i * 16 + fr) * LDT + ks * 32 + fq * 8);
#pragma unroll
      for (int i = 0; i < NI; i++) bf[i] = *(const bf16x8*)(b_ + (wc * (NI * 16) + i * 16 + fr) * LDT + ks * 32 + fq * 8);
#pragma unroll
      for (int mi = 0; mi < 4; mi++)
#pragma unroll
        for (int ni = 0; ni < NI; ni++)
          acc[mi][ni] = __builtin_amdgcn_mfma_f32_16x16x32_bf16(af[mi], bf[ni], acc[mi][ni], 0, 0, 0);
    }
  }
  __syncthreads();
#undef GL_FETCH
#undef GL_STORE
}

#define ACC_COORDS const int wr = wave >> 1, wc = wave & 1, fr = lane & 15, fq = lane >> 4;

__device__ __forceinline__ void conv_tile(const Params& p, int t, char* smem, const int tid) {
  int j = 0;
#pragma unroll 1
  for (int i = 1; i < 26; i++)
    if (t >= p.jobs[i].tile0) j = i;
  const Job& jb = p.jobs[j];
  float(*tile)[33] = (float(*)[33])smem;
  int local = t - jb.tile0;
  int nkt = jb.Kpad >> 5;
  int kt = local % nkt, nt = local / nkt;
  int tx = tid & 31, ty = tid >> 5;
  int n = nt * 32 + tx;
  int col;
  if (jb.mode == 0) col = jb.c0 + n;
  else { int jn = n >> 7, i = n & 127; col = (i < 64) ? (64 * jn + i) : (DFF_ + 64 * jn + (i - 64)); }
#pragma unroll
  for (int i = 0; i < 4; i++) {
    int k = kt * 32 + ty + 8 * i;
    float v = 0.f;
    if (k < jb.K && n < jb.Nv) v = jb.src[(size_t)k * jb.ld + col];
    tile[ty + 8 * i][tx] = v;
  }
  __syncthreads();
#pragma unroll
  for (int i = 0; i < 4; i++) {
    int nn = nt * 32 + ty + 8 * i;
    int k = kt * 32 + tx;
    jb.dst[(size_t)nn * jb.Kpad + k] = f2bf(tile[tx][ty + 8 * i]);
  }
  __syncthreads();
}

__device__ __forceinline__ void ln_row(const float* __restrict__ src, const float* __restrict__ g,
                                       const float* __restrict__ b, float* __restrict__ dst, int lane) {
  float4 v[4];
  float s = 0.f;
#pragma unroll
  for (int i = 0; i < 4; i++) {
    v[i] = *(const float4*)(src + i * 256 + lane * 4);
    s += v[i].x + v[i].y + v[i].z + v[i].w;
  }
  float mean = wave_sum(s) * (1.0f / 1024.0f);
  float q = 0.f;
#pragma unroll
  for (int i = 0; i < 4; i++) {
    float a = v[i].x - mean, b2 = v[i].y - mean, c = v[i].z - mean, d = v[i].w - mean;
    q += a * a + b2 * b2 + c * c + d * d;
  }
  float rstd = rsqrtf(wave_sum(q) * (1.0f / 1024.0f) + 1e-5f);
#pragma unroll
  for (int i = 0; i < 4; i++) {
    float4 gg = *(const float4*)(g + i * 256 + lane * 4);
    float4 bb = *(const float4*)(b + i * 256 + lane * 4);
    float4 o;
    o.x = (v[i].x - mean) * rstd * gg.x + bb.x;
    o.y = (v[i].y - mean) * rstd * gg.y + bb.y;
    o.z = (v[i].z - mean) * rstd * gg.z + bb.z;
    o.w = (v[i].w - mean) * rstd * gg.w + bb.w;
    *(float4*)(dst + i * 256 + lane * 4) = o;
  }
}

struct ScanIn {
  float kk[16][64], wr[16][64], w[16][64], kt[16][64], kka[16][64], v[16][64], g[16][64];
  float c[16][4];
};
struct ScanRaw { uint2 r, k, v, rp, kp, vp, a, g; float4 dec; };

__device__ __forceinline__ ScanRaw scan_fetch(const u16* __restrict__ P, const float* __restrict__ DEC,
                                              const u16* __restrict__ AA, const u16* __restrict__ GG, int rowbase, int t,
                                              int hc) {
  ScanRaw w;
  size_t row = (size_t)(rowbase + t);
  const u16* pp = P + row * PC_ + hc;
  w.r = *(const uint2*)(pp);
  w.k = *(const uint2*)(pp + 512);
  w.v = *(const uint2*)(pp + 1024);
  if (t > 0) {
    w.rp = *(const uint2*)(pp - PC_);
    w.kp = *(const uint2*)(pp - PC_ + 512);
    w.vp = *(const uint2*)(pp - PC_ + 1024);
  } else {
    w.rp = make_uint2(0, 0); w.kp = make_uint2(0, 0); w.vp = make_uint2(0, 0);
  }
  w.dec = *(const float4*)(DEC + row * 512 + hc);
  w.a = *(const uint2*)(AA + row * 512 + hc);
  w.g = *(const uint2*)(GG + row * 512 + hc);
  return w;
}

__device__ __forceinline__ void unpack4(uint2 u, float (&o)[4]) {
  o[0] = bflo(u.x); o[1] = bfhi(u.x); o[2] = bflo(u.y); o[3] = bfhi(u.y);
}

__device__ __forceinline__ void scan_unit(const Params& p, int l, int bh, char* smem, const int tid) {
  const int lane = tid & 63, wave = tid >> 6;
  const int b = bh >> 3, h = bh & 7;
  const int rowbase = b * T_;
  const u16* P = (const u16*)(p.ws + OFF_P);
  const float* DEC = (const float*)(p.ws + OFF_DEC);
  const u16* AA = (const u16*)(p.ws + OFF_AA);
  const u16* GG = (const u16*)(p.ws + OFF_GG);
  u16* YR = (u16*)p.out + (size_t)2 * M_ * 512;
  ScanIn* in = (ScanIn*)smem;
  float(*ybuf)[64] = (float(*)[64])(smem + 2 * sizeof(ScanIn));
  const int tl = tid >> 4, kq = tid & 15, hc = h * 64 + kq * 4;
  float mu_r[4], mu_k[4], mu_v[4], kkw[4], kaw[4], rkw[4], lg[4], lb[4];
  {
    const float* mu = p.in[5] + (size_t)l * 1824;
#pragma unroll
    for (int e = 0; e < 4; e++) {
      mu_r[e] = mu[hc + e];
      mu_k[e] = mu[512 + hc + e];
      mu_v[e] = mu[1024 + hc + e];
      kkw[e] = p.in[11][l * 512 + hc + e];
      kaw[e] = p.in[12][l * 512 + hc + e];
      rkw[e] = p.in[13][l * 512 + hc + e];
      lg[e] = p.in[14][l * 512 + hc + e];
      lb[e] = p.in[15][l * 512 + hc + e];
    }
  }
  const int rp = lane >> 3, ks = lane & 7, row0 = wave * 16 + rp * 2;
  float S[2][8];
#pragma unroll
  for (int i = 0; i < 2; i++)
#pragma unroll
    for (int e = 0; e < 8; e++) S[i][e] = 0.f;

  auto stage = [&](const ScanRaw& w, ScanIn& dst) {
    float r[4], k[4], v[4], rq[4], kp[4], vp[4], a[4], g[4];
    unpack4(w.r, r); unpack4(w.k, k); unpack4(w.v, v);
    unpack4(w.rp, rq); unpack4(w.kp, kp); unpack4(w.vp, vp);
    unpack4(w.a, a); unpack4(w.g, g);
    float dec[4] = {w.dec.x, w.dec.y, w.dec.z, w.dec.w};
    float kkr[4], ss = 0.f;
#pragma unroll
    for (int e = 0; e < 4; e++) {
      r[e] = r[e] + (rq[e] - r[e]) * mu_r[e];
      k[e] = k[e] + (kp[e] - k[e]) * mu_k[e];
      v[e] = v[e] + (vp[e] - v[e]) * mu_v[e];
      kkr[e] = k[e] * kkw[e];
      ss += kkr[e] * kkr[e];
    }
    ss = sum16(ss);
    float inv = 1.0f / fmaxf(sqrtf(ss), 1e-12f);
    float c1 = 0.f, c2 = 0.f, c3 = 0.f;
    float kk[4], ktl[4], kka[4], wr[4];
#pragma unroll
    for (int e = 0; e < 4; e++) {
      kk[e] = kkr[e] * inv;
      ktl[e] = k[e] * (1.0f + (a[e] - 1.0f) * kaw[e]);
      kka[e] = kk[e] * a[e];
      wr[e] = dec[e] * r[e];
      c1 += kka[e] * r[e];
      c2 += ktl[e] * r[e];
      c3 += r[e] * ktl[e] * rkw[e];
    }
    c1 = sum16(c1); c2 = sum16(c2); c3 = sum16(c3);
    *(float4*)&dst.kk[tl][kq * 4] = make_float4(kk[0], kk[1], kk[2], kk[3]);
    *(float4*)&dst.wr[tl][kq * 4] = make_float4(wr[0], wr[1], wr[2], wr[3]);
    *(float4*)&dst.w[tl][kq * 4] = make_float4(dec[0], dec[1], dec[2], dec[3]);
    *(float4*)&dst.kt[tl][kq * 4] = make_float4(ktl[0], ktl[1], ktl[2], ktl[3]);
    *(float4*)&dst.kka[tl][kq * 4] = make_float4(kka[0], kka[1], kka[2], kka[3]);
    *(float4*)&dst.v[tl][kq * 4] = make_float4(v[0], v[1], v[2], v[3]);
    *(float4*)&dst.g[tl][kq * 4] = make_float4(g[0], g[1], g[2], g[3]);
    if (kq == 0) *(float4*)&dst.c[tl][0] = make_float4(c1, c2, c3, 0.f);
  };

  {
    ScanRaw w0 = scan_fetch(P, DEC, AA, GG, rowbase, tl, hc);
    stage(w0, in[0]);
  }
  __syncthreads();
  constexpr int NCH = T_ / 16;
  for (int c = 0; c < NCH; c++) {
    ScanIn& cur = in[c & 1];
    ScanRaw nx;
    const bool have_next = (c + 1 < NCH);
    if (have_next) nx = scan_fetch(P, DEC, AA, GG, rowbase, (c + 1) * 16 + tl, hc);
#pragma unroll 2
    for (int s = 0; s < 16; s++) {
      float kk[8], wr[8], w[8], kt[8], kka[8];
      *(float4*)&kk[0] = *(const float4*)&cur.kk[s][ks * 8];
      *(float4*)&kk[4] = *(const float4*)&cur.kk[s][ks * 8 + 4];
      *(float4*)&wr[0] = *(const float4*)&cur.wr[s][ks * 8];
      *(float4*)&wr[4] = *(const float4*)&cur.wr[s][ks * 8 + 4];
      *(float4*)&w[0] = *(const float4*)&cur.w[s][ks * 8];
      *(float4*)&w[4] = *(const float4*)&cur.w[s][ks * 8 + 4];
      *(float4*)&kt[0] = *(const float4*)&cur.kt[s][ks * 8];
      *(float4*)&kt[4] = *(const float4*)&cur.kt[s][ks * 8 + 4];
      *(float4*)&kka[0] = *(const float4*)&cur.kka[s][ks * 8];
      *(float4*)&kka[4] = *(const float4*)&cur.kka[s][ks * 8 + 4];
      float2 vv = *(const float2*)&cur.v[s][row0];
      float2 cc = *(const float2*)&cur.c[s][0];
      float vr[2] = {vv.x, vv.y};
      float d1[2], d2[2];
#pragma unroll
      for (int i = 0; i < 2; i++) {
        float a0 = 0.f, a1 = 0.f, b0 = 0.f, b1 = 0.f;
#pragma unroll
        for (int e = 0; e < 8; e += 2) {
          a0 = fmaf(S[i][e], kk[e], a0);
          a1 = fmaf(S[i][e + 1], kk[e + 1], a1);
          b0 = fmaf(S[i][e], wr[e], b0);
          b1 = fmaf(S[i][e + 1], wr[e + 1], b1);
        }
        d1[i] = sum8(a0 + a1);
        d2[i] = sum8(b0 + b1);
      }
#pragma unroll
      for (int i = 0; i < 2; i++) {
        float skk = d1[i];
        float y = d2[i] - skk * cc.x + vr[i] * cc.y;
        if (ks == 0) ybuf[s][row0 + i] = y;
#pragma unroll
        for (int e = 0; e < 8; e++) S[i][e] = fmaf(S[i][e], w[e], fmaf(-skk, kka[e], vr[i] * kt[e]));
      }
    }
    __syncthreads();
    {
      float4 y4 = *(const float4*)&ybuf[tl][kq * 4];
      float y[4] = {y4.x, y4.y, y4.z, y4.w};
      float mean = sum16(y[0] + y[1] + y[2] + y[3]) * (1.0f / 64.0f);
      float q = 0.f;
#pragma unroll
      for (int e = 0; e < 4; e++) { y[e] -= mean; q += y[e] * y[e]; }
      float rstd = rsqrtf(sum16(q) * (1.0f / 64.0f) + 64e-5f);
      float c3 = cur.c[tl][2];
      float4 v4 = *(const float4*)&cur.v[tl][kq * 4];
      float4 g4 = *(const float4*)&cur.g[tl][kq * 4];
      float vv[4] = {v4.x, v4.y, v4.z, v4.w};
      float gg[4] = {g4.x, g4.y, g4.z, g4.w};
      float o[4];
#pragma unroll
      for (int e = 0; e < 4; e++) o[e] = (y[e] * rstd * lg[e] + lb[e] + c3 * vv[e]) * gg[e];
      size_t row = (size_t)(rowbase + c * 16 + tl);
      *(uint2*)(YR + row * 512 + hc) = make_uint2(pk2(o[0], o[1]), pk2(o[2], o[3]));
    }
    if (have_next) stage(nx, in[(c + 1) & 1]);
    __syncthreads();
  }
}

constexpr int KLD = 104, VLD = 72;
struct AttnSmem { u16 k[2][64 * KLD]; u16 v[2][64 * VLD]; };

__device__ __forceinline__ void attn_unit(const Params& p, int bh, int qi, char* smem, const int tid) {
  const int lane = tid & 63, wave = tid >> 6;
  const int fr = lane & 15, fq = lane >> 4;
  const int b = bh >> 3, h = bh & 7;
  const int rowbase = b * T_;
  u16* P = (u16*)(p.ws + OFF_P);
  const u16* Q = (const u16*)(p.ws + OFF_Q);
  const u16* KN = (const u16*)p.out;
  const u16* VT = (const u16*)p.out + (size_t)M_ * 512;
  const float2* ROPE = (const float2*)(p.ws + OFF_ROPE);
  AttnSmem* sm = (AttnSmem*)smem;
  const int qs = (qi == 0) ? 0 : 16 + (qi - 1) * 128;
  const int qn = (qi == 0) ? 16 : 128;
  const int q0 = qs + wave * 32;
  const bool wave_valid = (wave * 32 < qn);
  const int nkt = (qs + qn - 1) / 64 + 1;

  bf16x8 qf[2][3];
#pragma unroll
  for (int qb = 0; qb < 2; qb++) {
    int query = min(q0 + qb * 16 + fr, T_ - 1);
    const u16* qp = Q + (size_t)(rowbase + query) * 768 + h * 96;
    uint4 a0 = *(const uint4*)(qp + fq * 8);
    uint4 a1 = *(const uint4*)(qp + 32 + fq * 8);
    uint4 own = *(const uint4*)(qp + 64 + fq * 8);
    uint4 oth = *(const uint4*)(qp + 64 + (fq ^ 2) * 8);
    unsigned ow[4] = {own.x, own.y, own.z, own.w};
    unsigned tw[4] = {oth.x, oth.y, oth.z, oth.w};
    unsigned rw[4];
    const float2* rp = ROPE + (size_t)query * 16 + (fq & 1) * 8;
#pragma unroll
    for (int e = 0; e < 4; e++) {
      float2 cs0 = rp[2 * e], cs1 = rp[2 * e + 1];
      float o0 = bflo(ow[e]), o1 = bfhi(ow[e]);
      float t0 = bflo(tw[e]), t1 = bfhi(tw[e]);
      float r0, r1;
      if (fq < 2) { r0 = o0 * cs0.x - t0 * cs0.y; r1 = o1 * cs1.x - t1 * cs1.y; }
      else { r0 = t0 * cs0.y + o0 * cs0.x; r1 = t1 * cs1.y + o1 * cs1.x; }
      rw[e] = pk2(r0, r1);
    }
    uint4 a2 = make_uint4(rw[0], rw[1], rw[2], rw[3]);
    qf[qb][0] = *(bf16x8*)&a0;
    qf[qb][1] = *(bf16x8*)&a1;
    qf[qb][2] = *(bf16x8*)&a2;
  }

  f32x4 O[4][2];
#pragma unroll
  for (int i = 0; i < 4; i++)
#pragma unroll
    for (int j = 0; j < 2; j++) O[i][j] = f32x4{0.f, 0.f, 0.f, 0.f};
  float mrun[2] = {-1e30f, -1e30f}, lrun[2] = {0.f, 0.f};
  const float sc = 1.4426950408889634f / 9.797958971132712f;

  uint4 rk[3], rv[2];
  auto fetch_tile = [&](int kt) {
#pragma unroll
    for (int i = 0; i < 3; i++) {
      int c = tid + 256 * i;
      int key = c / 12, cc = c % 12;
      int t = kt * 64 + key;
      uint4 val = make_uint4(0, 0, 0, 0);
      if (t < T_) {
        size_t row = (size_t)(rowbase + t);
        if (cc < 8) val = *(const uint4*)(KN + row * 512 + h * 64 + cc * 8);
        else val = *(const uint4*)(P + row * PC_ + PKR_ + (cc - 8) * 8);
      }
      rk[i] = val;
    }
#pragma unroll
    for (int i = 0; i < 2; i++) {
      int c = tid + 256 * i;
      int dv = c >> 3, cc = c & 7;
      int t = kt * 64 + cc * 8;
      uint4 val = make_uint4(0, 0, 0, 0);
      if (t < T_) val = *(const uint4*)(VT + ((size_t)bh * 64 + dv) * T_ + t);
      rv[i] = val;
    }
  };
  auto store_tile = [&](int buf) {
#pragma unroll
    for (int i = 0; i < 3; i++) {
      int c = tid + 256 * i;
      int key = c / 12, cc = c % 12;
      *(uint4*)(&sm->k[buf][key * KLD + cc * 8]) = rk[i];
    }
#pragma unroll
    for (int i = 0; i < 2; i++) {
      int c = tid + 256 * i;
      int dv = c >> 3, cc = c & 7;
      *(uint4*)(&sm->v[buf][dv * VLD + cc * 8]) = rv[i];
    }
  };

  fetch_tile(0);
  for (int kt = 0; kt < nkt; kt++) {
    const int buf = kt & 1;
    store_tile(buf);
    __syncthreads();
    if (kt + 1 < nkt) fetch_tile(kt + 1);
    if (wave_valid && kt * 64 <= q0 + 31) {
      const u16* Ks = sm->k[buf];
      const u16* Vs = sm->v[buf];
      f32x4 s[4][2];
#pragma unroll
      for (int i = 0; i < 4; i++)
#pragma unroll
        for (int j = 0; j < 2; j++) s[i][j] = f32x4{0.f, 0.f, 0.f, 0.f};
#pragma unroll
      for (int ks = 0; ks < 3; ks++)
#pragma unroll
        for (int kb = 0; kb < 4; kb++) {
          bf16x8 kf = *(const bf16x8*)(Ks + (kb * 16 + fr) * KLD + ks * 32 + fq * 8);
#pragma unroll
          for (int qb = 0; qb < 2; qb++) s[kb][qb] = __builtin_amdgcn_mfma_f32_16x16x32_bf16(kf, qf[qb][ks], s[kb][qb], 0, 0, 0);
        }
      const bool need_mask = (kt * 64 + 63 > q0);
      unsigned pfw[2][2][4];
#pragma unroll
      for (int qb = 0; qb < 2; qb++) {
        const int query = q0 + qb * 16 + fr;
        float mx = -1e30f;
#pragma unroll
        for (int kb = 0; kb < 4; kb++)
#pragma unroll
          for (int j = 0; j < 4; j++) {
            float v = s[kb][qb][j] * sc;
            if (need_mask) {
              int key = kt * 64 + kb * 16 + fq * 4 + j;
              if (key > query) v = -1e30f;
            }
            s[kb][qb][j] = v;
            mx = fmaxf(mx, v);
          }
        mx = fmaxf(mx, __shfl_xor(mx, 16));
        mx = fmaxf(mx, __shfl_xor(mx, 32));
        float mnew = fmaxf(mrun[qb], mx);
        float alpha = exp2f(mrun[qb] - mnew);
        mrun[qb] = mnew;
        float ps = 0.f;
#pragma unroll
        for (int kb = 0; kb < 4; kb++) {
          float p0 = exp2f(s[kb][qb][0] - mnew), p1 = exp2f(s[kb][qb][1] - mnew);
          float p2 = exp2f(s[kb][qb][2] - mnew), p3 = exp2f(s[kb][qb][3] - mnew);
          ps += (p0 + p1) + (p2 + p3);
          pfw[qb][kb >> 1][(kb & 1) * 2 + 0] = pk2(p0, p1);
          pfw[qb][kb >> 1][(kb & 1) * 2 + 1] = pk2(p2, p3);
        }
        lrun[qb] = lrun[qb] * alpha + ps;
#pragma unroll
        for (int dvb = 0; dvb < 4; dvb++) {
          O[dvb][qb][0] *= alpha; O[dvb][qb][1] *= alpha; O[dvb][qb][2] *= alpha; O[dvb][qb][3] *= alpha;
        }
      }
#pragma unroll
      for (int s2 = 0; s2 < 2; s2++)
#pragma unroll
        for (int dvb = 0; dvb < 4; dvb++) {
          const u16* vp = Vs + (dvb * 16 + fr) * VLD + s2 * 32 + fq * 4;
          uint2 v0 = *(const uint2*)vp;
          uint2 v1 = *(const uint2*)(vp + 16);
          uint4 vv = make_uint4(v0.x, v0.y, v1.x, v1.y);
          bf16x8 vf = *(bf16x8*)&vv;
#pragma unroll
          for (int qb = 0; qb < 2; qb++) {
            uint4 pw = make_uint4(pfw[qb][s2][0], pfw[qb][s2][1], pfw[qb][s2][2], pfw[qb][s2][3]);
            O[dvb][qb] = __builtin_amdgcn_mfma_f32_16x16x32_bf16(vf, *(bf16x8*)&pw, O[dvb][qb], 0, 0, 0);
          }
        }
    }
  }
  __syncthreads();
  if (wave_valid) {
#pragma unroll
    for (int qb = 0; qb < 2; qb++) {
      float l = lrun[qb];
      l += __shfl_xor(l, 16);
      l += __shfl_xor(l, 32);
      float inv = 1.0f / l;
      int query = q0 + qb * 16 + fr;
      if (query < qs + qn) {
        u16* op = P + (size_t)(rowbase + query) * PC_ + PMLA_ + h * 64 + fq * 4;
#pragma unroll
        for (int dvb = 0; dvb < 4; dvb++) {
          *(uint2*)(op + dvb * 16) =
              make_uint2(pk2(O[dvb][qb][0] * inv, O[dvb][qb][1] * inv), pk2(O[dvb][qb][2] * inv, O[dvb][qb][3] * inv));
        }
      }
    }
  }
}

__global__ void __launch_bounds__(256, 2) mega(Params p) {
  cg::grid_group grid = cg::this_grid();
  __shared__ __attribute__((aligned(16))) char smem[SMEM_BYTES];
  __shared__ int s_unit;
  const int tid0 = threadIdx.x;
  const int nblk = gridDim.x;
  float* H = (float*)(p.ws + OFF_H);
  u16* P = (u16*)(p.ws + OFF_P);
  float* DEC = (float*)(p.ws + OFF_DEC);
  u16* AA = (u16*)(p.ws + OFF_AA);
  u16* GG = (u16*)(p.ws + OFF_GG);
  u16* Q = (u16*)(p.ws + OFF_Q);
  u16* MIX = (u16*)(p.ws + OFF_DEC);
  u16* ACT = (u16*)(p.ws + OFF_P);
  float2* ROPE = (float2*)(p.ws + OFF_ROPE);
  int* CTR = (int*)(p.ws + OFF_CTR);
  u16* KN = (u16*)p.out;
  u16* VT = KN + (size_t)M_ * 512;
  u16* YR = VT + (size_t)M_ * 512;

  {
  PHASE_TID
  for (int t = blockIdx.x; t < p.nconv; t += nblk) conv_tile(p, t, smem, tid);
  for (int i = blockIdx.x * 256 + tid; i < T_ * 16; i += nblk * 256) {
    int t = i >> 4, f = i & 15;
    double rev = (double)t * ROPE_C[f];
    rev -= floor(rev);
    float r = (float)rev;
    ROPE[i] = make_float2(__builtin_amdgcn_cosf(r), __builtin_amdgcn_sinf(r));
  }
  for (int row = blockIdx.x * 4 + wave; row < M_; row += nblk * 4) {
    int b = row / T_, t = row % T_;
    const float* src = (t < NMETA_) ? (p.in[1] + (size_t)t * 1024) : (p.in[0] + ((size_t)b * SEQ_ + (t - NMETA_)) * 1024);
    ln_row(src, p.in[2], p.in[3], H + (size_t)row * 1024, lane);
  }
  if (blockIdx.x == 0 && tid == 0) { CTR[0] = 0; CTR[1] = 0; }
  }
  grid.sync();

  for (int l = 0; l < 2; l++) {
    const u16* WL = (const u16*)(p.ws + OFF_W) + (size_t)l * W_LAYER;
    if (PHMASK & 1) {
    PHASE_TID
    for (int tile = blockIdx.x; tile < 514 * 19; tile += nblk) {
      int mt = tile / 19, nt = tile % 19;
      f32x4 acc[4][4];
      zero_acc(acc);
      AL<0> al{H, 1024, mt * 128, 0, 0, nullptr, 0};
      gemm_loop(acc, al, WL + W_IN, 1024, nt * 128, 1024, smem, tid);
      ACC_COORDS
#pragma unroll
      for (int mi = 0; mi < 4; mi++)
#pragma unroll
        for (int ni = 0; ni < 4; ni++) {
          int col = nt * 128 + wc * 64 + ni * 16 + fr;
          if (col < PC_) {
#pragma unroll
            for (int j = 0; j < 4; j++) {
              int row = mt * 128 + wr * 64 + mi * 16 + fq * 4 + j;
              P[(size_t)row * PC_ + col] = f2bf(acc[mi][ni][j]);
            }
          }
        }
    }
    }
    grid.sync();
    if (PHMASK & 2) {
    PHASE_TID
    {
      const float* qg = p.in[16] + l * 256;
      const float* kvg = p.in[18] + l * 256;
      for (int row = blockIdx.x * 4 + wave; row < M_; row += nblk * 4) {
        u16* pr = P + (size_t)row * PC_;
        uint2 cq = *(const uint2*)(pr + PMLA_ + lane * 4);
        uint2 ckv = *(const uint2*)(pr + PKV_ + lane * 4);
        float a[4], c[4];
        unpack4(cq, a);
        unpack4(ckv, c);
        float s1 = a[0] * a[0] + a[1] * a[1] + a[2] * a[2] + a[3] * a[3];
        float s2 = c[0] * c[0] + c[1] * c[1] + c[2] * c[2] + c[3] * c[3];
        s1 = wave_sum(s1);
        s2 = wave_sum(s2);
        float r1 = rsqrtf(s1 * (1.0f / 256.0f) + 1e-6f), r2 = rsqrtf(s2 * (1.0f / 256.0f) + 1e-6f);
        float4 g1 = *(const float4*)(qg + lane * 4), g2 = *(const float4*)(kvg + lane * 4);
        *(uint2*)(pr + PMLA_ + lane * 4) = make_uint2(pk2(a[0] * r1 * g1.x, a[1] * r1 * g1.y), pk2(a[2] * r1 * g1.z, a[3] * r1 * g1.w));
        *(uint2*)(pr + PKV_ + lane * 4) = make_uint2(pk2(c[0] * r2 * g2.x, c[1] * r2 * g2.y), pk2(c[2] * r2 * g2.z, c[3] * r2 * g2.w));
        if (lane < 16) {
          int t = row % T_;
          float x1 = bf2f(pr[PKR_ + lane]), x2 = bf2f(pr[PKR_ + 16 + lane]);
          float2 cs = ROPE[t * 16 + lane];
          pr[PKR_ + lane] = f2bf(x1 * cs.x - x2 * cs.y);
          pr[PKR_ + 16 + lane] = f2bf(x1 * cs.y + x2 * cs.x);
        }
      }
      const float* mu = p.in[5] + (size_t)l * 1824;
      for (int tile = blockIdx.x; tile < 514 * 12; tile += nblk) {
        int mt = tile / 12, sub = tile % 12, which = sub >> 2, nt = sub & 3;
        f32x4 acc[4][4];
        zero_acc(acc);
        ACC_COORDS
        if (which == 0) {
          AL<3> al{P + 1536, PC_, mt * 128, 0, 64, mu + 1536, 0};
          gemm_loop(acc, al, WL + W_LW, 64, nt * 128, 64, smem, tid);
          const float* w0 = p.in[6] + l * 512;
#pragma unroll
          for (int mi = 0; mi < 4; mi++)
#pragma unroll
            for (int ni = 0; ni < 4; ni++) {
              int col = nt * 128 + wc * 64 + ni * 16 + fr;
              float w0c = w0[col];
#pragma unroll
              for (int j = 0; j < 4; j++) {
                int row = mt * 128 + wr * 64 + mi * 16 + fq * 4 + j;
                float x = -(acc[mi][ni][j] + w0c);
                float sp = fmaxf(x, 0.f) + log1pf(__expf(-fabsf(x)));
                float wraw = -sp - 0.5f;
                DEC[(size_t)row * 512 + col] = __expf(-__expf(wraw));
              }
            }
        } else if (which == 1) {
          AL<3> al{P + 1600, PC_, mt * 128, 0, 64, mu + 1600, 1};
          gemm_loop(acc, al, WL + W_LA, 64, nt * 128, 64, smem, tid);
          const float* a0 = p.in[8] + l * 512;
#pragma unroll
          for (int mi = 0; mi < 4; mi++)
#pragma unroll
            for (int ni = 0; ni < 4; ni++) {
              int col = nt * 128 + wc * 64 + ni * 16 + fr;
              float a0c = a0[col];
#pragma unroll
              for (int j = 0; j < 4; j++) {
                int row = mt * 128 + wr * 64 + mi * 16 + fq * 4 + j;
                AA[(size_t)row * 512 + col] = f2bf(sigmoidf_(acc[mi][ni][j] + a0c));
              }
            }
        } else {
          AL<3> al{P + 1664, PC_, mt * 128, 0, 160, mu + 1664, 2};
          gemm_loop(acc, al, WL + W_LG, 192, nt * 128, 192, smem, tid);
#pragma unroll
          for (int mi = 0; mi < 4; mi++)
#pragma unroll
            for (int ni = 0; ni < 4; ni++) {
              int col = nt * 128 + wc * 64 + ni * 16 + fr;
#pragma unroll
              for (int j = 0; j < 4; j++) {
                int row = mt * 128 + wr * 64 + mi * 16 + fq * 4 + j;
                GG[(size_t)row * 512 + col] = f2bf(acc[mi][ni][j]);
              }
            }
        }
      }
    }
    }
    grid.sync();
    if (PHMASK & 4) {
    PHASE_TID
    for (int tile = blockIdx.x; tile < 514 * 14; tile += nblk) {
      int mt = tile / 14, sub = tile % 14;
      f32x4 acc[4][4];
      zero_acc(acc);
      ACC_COORDS
      if (sub < 6) {
        AL<1> al{P + PMLA_, PC_, mt * 128, 0, 0, nullptr, 0};
        gemm_loop(acc, al, WL + W_UQ, 256, sub * 128, 256, smem, tid);
#pragma unroll
        for (int mi = 0; mi < 4; mi++)
#pragma unroll
          for (int ni = 0; ni < 4; ni++) {
            int col = sub * 128 + wc * 64 + ni * 16 + fr;
#pragma unroll
            for (int j = 0; j < 4; j++) {
              int row = mt * 128 + wr * 64 + mi * 16 + fq * 4 + j;
              Q[(size_t)row * 768 + col] = f2bf(acc[mi][ni][j]);
            }
          }
      } else if (sub < 10) {
        int nt = sub - 6;
        AL<1> al{P + PKV_, PC_, mt * 128, 0, 0, nullptr, 0};
        gemm_loop(acc, al, WL + W_UK, 256, nt * 128, 256, smem, tid);
#pragma unroll
        for (int mi = 0; mi < 4; mi++)
#pragma unroll
          for (int ni = 0; ni < 4; ni++) {
            int col = nt * 128 + wc * 64 + ni * 16 + fr;
#pragma unroll
            for (int j = 0; j < 4; j++) {
              int row = mt * 128 + wr * 64 + mi * 16 + fq * 4 + j;
              KN[(size_t)row * 512 + col] = f2bf(acc[mi][ni][j]);
            }
          }
      } else {
        int nt = sub - 10;
        AL<1> al{P + PKV_, PC_, mt * 128, 0, 0, nullptr, 0};
        gemm_loop(acc, al, WL + W_UV, 256, nt * 128, 256, smem, tid);
#pragma unroll
        for (int mi = 0; mi < 4; mi++)
#pragma unroll
          for (int ni = 0; ni < 4; ni++) {
            int col = nt * 128 + wc * 64 + ni * 16 + fr;
            int row = mt * 128 + wr * 64 + mi * 16 + fq * 4;
            int b = row / T_, t = row % T_;
            size_t o = ((size_t)(b * 512 + col)) * T_ + t;
            *(uint2*)(VT + o) = make_uint2(pk2(acc[mi][ni][0], acc[mi][ni][1]), pk2(acc[mi][ni][2], acc[mi][ni][3]));
          }
      }
    }
    }
    grid.sync();
    if (PHMASK & 8) {
    PHASE_TID
    {
      const int total = 128 + 33 * 128;
      while (true) {
        if (tid == 0) s_unit = atomicAdd(&CTR[l], 1);
        __syncthreads();
        int u = s_unit;
        __syncthreads();
        if (u >= total) break;
        if (u < 128) { if (PHMASK & 8) scan_unit(p, l, u, smem, tid); }
        else {
          int v = u - 128;
          if (PHMASK & 512) attn_unit(p, v & 127, 32 - (v >> 7), smem, tid);
        }
        __syncthreads();
      }
    }
    }
    grid.sync();
    if (PHMASK & 16) {
    PHASE_TID
    for (int tile = blockIdx.x; tile < 514 * 16; tile += nblk) {
      int mt = tile >> 4, nt = tile & 15;
      f32x4 acc[4][2], tac[4][2];
      unsigned sg[4][2][2];
      ACC_COORDS
      AL<0> alh{H, 1024, mt * 128, 0, 0, nullptr, 0};
      zero_acc(acc);
      gemm_loop(acc, alh, WL + W_G, 1024, nt * 64, 1024, smem, tid);
#pragma unroll
      for (int mi = 0; mi < 4; mi++)
#pragma unroll
        for (int ni = 0; ni < 2; ni++) {
          sg[mi][ni][0] = pk2(sigmoidf_(acc[mi][ni][0]), sigmoidf_(acc[mi][ni][1]));
          sg[mi][ni][1] = pk2(sigmoidf_(acc[mi][ni][2]), sigmoidf_(acc[mi][ni][3]));
        }
      zero_acc(acc);
      {
        AL<1> aly{YR, 512, mt * 128, 0, 0, nullptr, 0};
        gemm_loop(acc, aly, WL + W_PR, 512, nt * 64, 512, smem, tid);
      }
#pragma unroll
      for (int mi = 0; mi < 4; mi++)
#pragma unroll
        for (int ni = 0; ni < 2; ni++) {
          tac[mi][ni][0] = bflo(sg[mi][ni][0]) * acc[mi][ni][0];
          tac[mi][ni][1] = bfhi(sg[mi][ni][0]) * acc[mi][ni][1];
          tac[mi][ni][2] = bflo(sg[mi][ni][1]) * acc[mi][ni][2];
          tac[mi][ni][3] = bfhi(sg[mi][ni][1]) * acc[mi][ni][3];
        }
      zero_acc(acc);
      gemm_loop(acc, alh, WL + W_G, 1024, 1024 + nt * 64, 1024, smem, tid);
#pragma unroll
      for (int mi = 0; mi < 4; mi++)
#pragma unroll
        for (int ni = 0; ni < 2; ni++) {
          sg[mi][ni][0] = pk2(sigmoidf_(acc[mi][ni][0]), sigmoidf_(acc[mi][ni][1]));
          sg[mi][ni][1] = pk2(sigmoidf_(acc[mi][ni][2]), sigmoidf_(acc[mi][ni][3]));
        }
      zero_acc(acc);
      {
        AL<1> alm{P + PMLA_, PC_, mt * 128, 0, 0, nullptr, 0};
        gemm_loop(acc, alm, WL + W_PM, 512, nt * 64, 512, smem, tid);
      }
#pragma unroll
      for (int mi = 0; mi < 4; mi++)
#pragma unroll
        for (int ni = 0; ni < 2; ni++) {
          int col = nt * 64 + wc * 32 + ni * 16 + fr;
          int row = mt * 128 + wr * 64 + mi * 16 + fq * 4;
          float o0 = tac[mi][ni][0] + bflo(sg[mi][ni][0]) * acc[mi][ni][0];
          float o1 = tac[mi][ni][1] + bfhi(sg[mi][ni][0]) * acc[mi][ni][1];
          float o2 = tac[mi][ni][2] + bflo(sg[mi][ni][1]) * acc[mi][ni][2];
          float o3 = tac[mi][ni][3] + bfhi(sg[mi][ni][1]) * acc[mi][ni][3];
          MIX[(size_t)(row + 0) * 1024 + col] = f2bf(o0);
          MIX[(size_t)(row + 1) * 1024 + col] = f2bf(o1);
          MIX[(size_t)(row + 2) * 1024 + col] = f2bf(o2);
          MIX[(size_t)(row + 3) * 1024 + col] = f2bf(o3);
        }
    }
    }
    grid.sync();
    if (PHMASK & 32) {
    PHASE_TID
    for (int tile = blockIdx.x; tile < 514 * 8; tile += nblk) {
      int mt = tile >> 3, nt = tile & 7;
      f32x4 acc[4][4];
      zero_acc(acc);
      ACC_COORDS
      AL<1> al{MIX, 1024, mt * 128, 0, 0, nullptr, 0};
      gemm_loop(acc, al, WL + W_OUT, 1024, nt * 128, 1024, smem, tid);
#pragma unroll
      for (int mi = 0; mi < 4; mi++)
#pragma unroll
        for (int ni = 0; ni < 4; ni++) {
          int col = nt * 128 + wc * 64 + ni * 16 + fr;
#pragma unroll
          for (int j = 0; j < 4; j++) {
            int row = mt * 128 + wr * 64 + mi * 16 + fq * 4 + j;
            float* hp = H + (size_t)row * 1024 + col;
            *hp = ALPHA_ * (*hp) + acc[mi][ni][j];
          }
        }
    }
    }
    grid.sync();
    if (PHMASK & 64) {
    PHASE_TID
    for (int row = blockIdx.x * 4 + wave; row < M_; row += nblk * 4)
      ln_row(H + (size_t)row * 1024, p.in[24] + l * 1024, p.in[25] + l * 1024, H + (size_t)row * 1024, lane);
    }
    grid.sync();
    if (PHMASK & 128) {
    PHASE_TID
    {
      const float* cw = p.in[27] + (size_t)l * 3 * 5632;
      const float* cb = p.in[28] + (size_t)l * 5632;
      for (int tile = blockIdx.x; tile < 16 * 33 * 44; tile += nblk) {
        int nt = tile % 44, rest = tile / 44, it = rest % 33, b = rest / 33;
        int t0 = 126 * it - 2;
        f32x4 acc[4][4];
        zero_acc(acc);
        AL<2> al{H, 1024, b * T_, t0, 0, nullptr, 0};
        gemm_loop(acc, al, WL + W_UP, 1024, nt * 128, 1024, smem, tid);
        ACC_COORDS
        float(*ut)[132] = (float(*)[132])smem;
#pragma unroll
        for (int mi = 0; mi < 4; mi++)
#pragma unroll
          for (int ni = 0; ni < 4; ni++)
#pragma unroll
            for (int j = 0; j < 4; j++) ut[wr * 64 + mi * 16 + fq * 4 + j][wc * 64 + ni * 16 + fr] = acc[mi][ni][j];
        __syncthreads();
        {
          int c = tid & 63, rg = tid >> 6;
          int gcol = nt * 64 + c, vcol = DFF_ + nt * 64 + c;
          float g0 = cw[gcol], g1 = cw[5632 + gcol], g2 = cw[2 * 5632 + gcol], gb = cb[gcol];
          float v0 = cw[vcol], v1 = cw[5632 + vcol], v2 = cw[2 * 5632 + vcol], vb = cb[vcol];
          int rs = 2 + rg * 32, re = min(rs + 32, 128);
          float ga = ut[rs - 2][c], gbp = ut[rs - 1][c];
          float va = ut[rs - 2][64 + c], vbp = ut[rs - 1][64 + c];
          for (int r = rs; r < re; r++) {
            float gc = ut[r][c], vc = ut[r][64 + c];
            int t = t0 + r;
            if (t < T_) {
              float gate = g0 * ga + g1 * gbp + g2 * gc + gb;
              float val = v0 * va + v1 * vbp + v2 * vc + vb;
              float a = gate * sigmoidf_(gate) * val;
              ACT[(size_t)(b * T_ + t) * DFF_ + gcol] = f2bf(a);
            }
            ga = gbp; gbp = gc; va = vbp; vbp = vc;
          }
        }
        __syncthreads();
      }
    }
    }
    grid.sync();
    if (PHMASK & 256) {
    PHASE_TID
    for (int tile = blockIdx.x; tile < 514 * 8; tile += nblk) {
      int mt = tile >> 3, nt = tile & 7;
      f32x4 acc[4][4];
      zero_acc(acc);
      ACC_COORDS
      AL<1> al{ACT, DFF_, mt * 128, 0, 0, nullptr, 0};
      gemm_loop(acc, al, WL + W_DN, DFF_, nt * 128, DFF_, smem, tid);
#pragma unroll
      for (int mi = 0; mi < 4; mi++)
#pragma unroll
        for (int ni = 0; ni < 4; ni++) {
          int col = nt * 128 + wc * 64 + ni * 16 + fr;
#pragma unroll
          for (int j = 0; j < 4; j++) {
            int row = mt * 128 + wr * 64 + mi * 16 + fq * 4 + j;
            float* hp = H + (size_t)row * 1024 + col;
            *hp = ALPHA_ * (*hp) + acc[mi][ni][j];
          }
        }
    }
    }
    grid.sync();
    {
    PHASE_TID
    if (l == 0) {
      for (int row = blockIdx.x * 4 + wave; row < M_; row += nblk * 4)
        ln_row(H + (size_t)row * 1024, p.in[30], p.in[31], H + (size_t)row * 1024, lane);
      grid.sync();
    } else {
      for (int row = blockIdx.x * 4 + wave; row < M_; row += nblk * 4) {
        int b = row / T_, t = row % T_;
        if (t >= NMETA_)
          ln_row(H + (size_t)row * 1024, p.in[30] + 1024, p.in[31] + 1024, p.out + ((size_t)b * SEQ_ + (t - NMETA_)) * 1024, lane);
      }
    }
    }
  }
}

extern "C" void kernel_launch(void* const* d_in, const int* in_sizes, int n_in, void* d_out, int out_size, void* d_ws,
                              size_t ws_size, hipStream_t stream) {
  static int grid_blocks = 0;
  if (!grid_blocks) {
    int dev = 0, cus = 0, per_cu = 0;
    hipGetDevice(&dev);
    hipDeviceGetAttribute(&cus, hipDeviceAttributeMultiprocessorCount, dev);
    hipOccupancyMaxActiveBlocksPerMultiprocessor(&per_cu, mega, 256, 0);
    if (per_cu > 2) per_cu = 2;
    grid_blocks = cus * per_cu;
  }
  if (ws_size < WS_TOTAL) fprintf(stderr, "workspace too small: %zu < %zu\n", ws_size, (size_t)WS_TOTAL);
  Params p;
  memset(&p, 0, sizeof(p));
  for (int i = 0; i < 32; i++) p.in[i] = (const float*)d_in[i];
  p.out = (float*)d_out;
  p.ws = (char*)d_ws;
  u16* wb = (u16*)((char*)d_ws + OFF_W);
  int nj = 0, tiles = 0;
  auto add = [&](const float* src, size_t dst_off, int ld, int c0, int K, int Kpad, int Nv, int Np, int mode) {
    Job& j = p.jobs[nj++];
    j.src = src; j.dst = wb + dst_off; j.ld = ld; j.c0 = c0; j.K = K; j.Kpad = Kpad; j.Nv = Nv; j.Np = Np; j.mode = mode;
    j.tile0 = tiles;
    tiles += (Kpad / 32) * (Np / 32);
  };
  for (int l = 0; l < 2; l++) {
    size_t o = (size_t)l * W_LAYER;
    const float* w_in = (const float*)d_in[4] + (size_t)l * 1024 * 4416;
    add(w_in, o + W_IN, 4416, 0, 1024, 1024, 2368, 2432, 0);
    add(w_in, o + W_G, 4416, 2368, 1024, 1024, 2048, 2048, 0);
    add((const float*)d_in[7] + (size_t)l * 64 * 512, o + W_LW, 512, 0, 64, 64, 512, 512, 0);
    add((const float*)d_in[9] + (size_t)l * 64 * 512, o + W_LA, 512, 0, 64, 64, 512, 512, 0);
    add((const float*)d_in[10] + (size_t)l * 160 * 512, o + W_LG, 512, 0, 160, 192, 512, 512, 0);
    add((const float*)d_in[17] + (size_t)l * 256 * 768, o + W_UQ, 768, 0, 256, 256, 768, 768, 0);
    add((const float*)d_in[19] + (size_t)l * 256 * 512, o + W_UK, 512, 0, 256, 256, 512, 512, 0);
    add((const float*)d_in[20] + (size_t)l * 256 * 512, o + W_UV, 512, 0, 256, 256, 512, 512, 0);
    add((const float*)d_in[21] + (size_t)l * 512 * 1024, o + W_PR, 1024, 0, 512, 512, 1024, 1024, 0);
    add((const float*)d_in[22] + (size_t)l * 512 * 1024, o + W_PM, 1024, 0, 512, 512, 1024, 1024, 0);
    add((const float*)d_in[23] + (size_t)l * 1024 * 1024, o + W_OUT, 1024, 0, 1024, 1024, 1024, 1024, 0);
    add((const float*)d_in[26] + (size_t)l * 1024 * 5632, o + W_UP, 5632, 0, 1024, 1024, 5632, 5632, 1);
    add((const float*)d_in[29] + (size_t)l * 2816 * 1024, o + W_DN, 1024, 0, 2816, 2816, 1024, 1024, 0);
  }
  p.nconv = tiles;
  void* args[] = {&p};
  hipError_t e = hipLaunchCooperativeKernel((void*)mega, dim3(grid_blocks), dim3(256), args, 0, stream);
  if (e != hipSuccess) fprintf(stderr, "cooperative launch failed: %s (grid %d)\n", hipGetErrorString(e), grid_blocks);
}
```

```cpp
#include <hip/hip_runtime.h>
#include <hip/hip_cooperative_groups.h>
#include <cstdio>
#include <cstring>
namespace cg = cooperative_groups;

#ifndef PHMASK
#define PHMASK 0xFFFF
#endif
#ifndef PROBE_FI
#define PROBE_FI 0
#endif
#ifndef REPMASK
#define REPMASK 0
#endif
typedef unsigned short u16;
using bf16x8 = __attribute__((ext_vector_type(8))) short;
using f32x4 = __attribute__((ext_vector_type(4))) float;

constexpr int B_ = 16, SEQ_ = 4096, NMETA_ = 16, T_ = 4112, M_ = B_ * T_, D_ = 1024;
constexpr int PC_ = 2368;
constexpr int PMLA_ = 1824, PKV_ = 2080, PKR_ = 2336;
constexpr int DFF_ = 2816;
constexpr float ALPHA_ = 1.4142135623730951f;

constexpr size_t OFF_H = 0;
constexpr size_t OFF_P = OFF_H + (size_t)M_ * 1024 * 4;
constexpr size_t OFF_DEC = OFF_P + (size_t)M_ * PC_ * 2;
constexpr size_t OFF_AA = OFF_DEC + (size_t)M_ * 512 * 4;
constexpr size_t OFF_GG = OFF_AA + (size_t)M_ * 512 * 2;
constexpr size_t OFF_Q = OFF_GG + (size_t)M_ * 512 * 2;
constexpr size_t OFF_W = OFF_Q + (size_t)M_ * 768 * 2;
constexpr size_t W_IN = 0;
constexpr size_t W_G = W_IN + (size_t)2432 * 1024;
constexpr size_t W_LW = W_G + (size_t)2048 * 1024;
constexpr size_t W_LA = W_LW + (size_t)512 * 64;
constexpr size_t W_LG = W_LA + (size_t)512 * 64;
constexpr size_t W_UQ = W_LG + (size_t)512 * 192;
constexpr size_t W_UK = W_UQ + (size_t)768 * 256;
constexpr size_t W_UV = W_UK + (size_t)512 * 256;
constexpr size_t W_PR = W_UV + (size_t)512 * 256;
constexpr size_t W_PM = W_PR + (size_t)1024 * 512;
constexpr size_t W_OUT = W_PM + (size_t)1024 * 512;
constexpr size_t W_UP = W_OUT + (size_t)1024 * 1024;
constexpr size_t W_DN = W_UP + (size_t)5632 * 1024;
constexpr size_t W_LAYER = W_DN + (size_t)1024 * 2816;
constexpr size_t OFF_ROPE = OFF_W + 2 * W_LAYER * 2;
constexpr size_t OFF_CTR = OFF_ROPE + (size_t)T_ * 16 * 8;
constexpr size_t OFF_ZERO = OFF_CTR + 256;
constexpr size_t OFF_BAR = OFF_ZERO + 8192;
constexpr size_t OFF_HB2 = OFF_BAR + 16384;
constexpr size_t WS_TOTAL = OFF_HB2 + (size_t)512 * 1024 * 2;
constexpr int HB_SPLIT = 65280;

struct Job { const float* src; u16* dst; int ld, c0, K, Kpad, Nv, Np, mode, tile0; };
struct Params {
  const float* in[32];
  float* out;
  char* ws;
  Job jobs[26];
  int nconv;
  int pad0;
};

__constant__ double ROPE_C[16] = {0.15915494309189535, 0.08949940160889101, 0.050329212104487035, 0.0283021958306234,
                                  0.015915494309189534, 0.008949940160889102, 0.005032921210448704, 0.00283021958306234,
                                  0.0015915494309189536, 0.0008949940160889102, 0.0005032921210448703, 0.00028302195830623395,
                                  0.00015915494309189535, 8.949940160889102e-05, 5.0329212104487035e-05, 2.8302195830623396e-05};

__device__ __forceinline__ int launder(int x) { asm volatile("" : "+v"(x)); return x; }
typedef __bf16 bf16x2_t __attribute__((ext_vector_type(2)));
typedef float f32x2_t __attribute__((ext_vector_type(2)));
__device__ __forceinline__ unsigned pk2(float a, float b) {
  f32x2_t v = {a, b};
  bf16x2_t r = __builtin_convertvector(v, bf16x2_t);
  return *(unsigned*)&r;
}
__device__ __forceinline__ u16 f2bf(float f) { return (u16)(pk2(f, 0.f) & 0xffffu); }
__device__ __forceinline__ float bf2f(unsigned h) { return __uint_as_float(h << 16); }
__device__ __forceinline__ float bflo(unsigned w) { return __uint_as_float(w << 16); }
__device__ __forceinline__ float bfhi(unsigned w) { return __uint_as_float(w & 0xffff0000u); }
__device__ __forceinline__ float sigmoidf_(float x) { return 1.0f / (1.0f + __expf(-x)); }

__device__ __forceinline__ int fresh_lane() { int x; asm volatile("v_mbcnt_lo_u32_b32 %0, -1, 0\n\tv_mbcnt_hi_u32_b32 %0, -1, %0" : "=v"(x)); return x; }
#define PHASE_TID const int tid = wave0 * 64 + fresh_lane(); const int lane = tid & 63, wave = tid >> 6; (void)lane; (void)wave;
template <int CTRL>
__device__ __forceinline__ float dppf(float x) {
  return __int_as_float(__builtin_amdgcn_update_dpp(0, __float_as_int(x), CTRL, 0xF, 0xF, true));
}
__device__ __forceinline__ float sum8(float x) {
  x += dppf<0xB1>(x);
  x += dppf<0x4E>(x);
  x += dppf<0x141>(x);
  return x;
}
__device__ __forceinline__ float sum16(float x) {
  x = sum8(x);
  x += dppf<0x140>(x);
  return x;
}
__device__ __forceinline__ float shx(float x, int lane, int o) {
  return __int_as_float(__builtin_amdgcn_ds_bpermute((lane ^ o) << 2, __float_as_int(x)));
}
__device__ __forceinline__ float wave_sum(float x, int lane) {
  x = sum16(x);
  x += shx(x, lane, 16);
  x += shx(x, lane, 32);
  return x;
}

constexpr int BM = 128, BN = 128, BK = 64, LDT = 64;
constexpr int SMEM_BYTES = 73728;

template <int MODE>
struct AL {
  const void* base;
  int ld;
  int row0;
  int t0;
  int kvalid;
  const float* mu;
  int fn;
  struct Raw { uint4 x, y; };
  __device__ __forceinline__ Raw fetch(int r, int k) const {
    Raw w;
    { unsigned z = (MODE == 3) ? (unsigned)launder(0) : 0u; w.x = make_uint4(z, z, z, z); w.y = w.x; }
    if (MODE == 0) {
      const float* p = (const float*)base + (size_t)(row0 + r) * ld + k;
      w.x = *(const uint4*)p;
      w.y = *(const uint4*)(p + 4);
    } else if (MODE == 1) {
      const u16* p = (const u16*)base + (size_t)(row0 + r) * ld + k;
      w.x = *(const uint4*)p;
    } else if (MODE == 4) {
      const float* p = (const float*)base + (size_t)(row0 + r) * ld + k;
      float4 a = *(const float4*)p, b = *(const float4*)(p + 4);
      w.x = make_uint4(pk2(a.x, a.y), pk2(a.z, a.w), pk2(b.x, b.y), pk2(b.z, b.w));
    } else if (MODE == 2) {
      int t = t0 + r;
      if (t >= 0 && t < T_) {
        const float* p = (const float*)base + (size_t)(row0 + t) * ld + k;
        w.x = *(const uint4*)p;
        w.y = *(const uint4*)(p + 4);
      }
    } else {
      int row = row0 + r;
      int t = row % T_;
      if (k < kvalid) {
        const u16* p = (const u16*)base + (size_t)row * ld + k;
        w.x = *(const uint4*)p;
        if (t > 0) w.y = *(const uint4*)(p - ld);
      }
    }
    return w;
  }
  __device__ __forceinline__ uint4 cvt(const Raw& w, int k) const {
    if (MODE == 0 || MODE == 2) {
      uint4 o;
      o.x = pk2(__uint_as_float(w.x.x), __uint_as_float(w.x.y));
      o.y = pk2(__uint_as_float(w.x.z), __uint_as_float(w.x.w));
      o.z = pk2(__uint_as_float(w.y.x), __uint_as_float(w.y.y));
      o.w = pk2(__uint_as_float(w.y.z), __uint_as_float(w.y.w));
      return o;
    } else if (MODE == 1 || MODE == 4) {
      return w.x;
    } else {
      if (k >= kvalid) { unsigned z = (unsigned)launder(0); return make_uint4(z, z, z, z); }
      unsigned cw[4] = {w.x.x, w.x.y, w.x.z, w.x.w};
      unsigned pw[4] = {w.y.x, w.y.y, w.y.z, w.y.w};
      unsigned ow[4];
#pragma unroll
      for (int e = 0; e < 4; e++) {
        float x0 = bflo(cw[e]), x1 = bfhi(cw[e]);
        float p0 = bflo(pw[e]), p1 = bfhi(pw[e]);
        float v0 = x0 + (p0 - x0) * mu[k + 2 * e];
        float v1 = x1 + (p1 - x1) * mu[k + 2 * e + 1];
        if (fn == 0) {
          v0 = 1.0f - 2.0f / (__expf(2.0f * v0) + 1.0f);
          v1 = 1.0f - 2.0f / (__expf(2.0f * v1) + 1.0f);
        } else if (fn == 2) {
          v0 = sigmoidf_(v0);
          v1 = sigmoidf_(v1);
        }
        ow[e] = pk2(v0, v1);
      }
      return make_uint4(ow[0], ow[1], ow[2], ow[3]);
    }
  }
};

template <int NI>
__device__ __forceinline__ void zero_acc(f32x4 (&acc)[4][NI]) {
#pragma unroll
  for (int i = 0; i < 4; i++)
#pragma unroll
    for (int j = 0; j < NI; j++) acc[i][j] = f32x4{0.f, 0.f, 0.f, 0.f};
}

#define REP4(X) X(0) X(1) X(2) X(3)
template <class ALT, int NI>
__device__ __forceinline__ void gemm_loop(f32x4 (&acc)[4][NI], const ALT& al, const u16* __restrict__ Bt, int ldb, int n0,
                                          int K, char* smem, const int tid) {
  const int lane = tid & 63, wave = tid >> 6;
  const int wr = wave >> 1, wc = wave & 1, fr = lane & 15, fq = lane >> 4;
  const int lr = tid >> 3, lk = (tid & 7) * 8, lsw = ((tid & 7) ^ (lr & 7)) * 8;
  u16* sa = (u16*)smem;
  u16* sb = sa + 2 * BM * LDT;
  typename ALT::Raw ra0, ra1, ra2, ra3;
  uint4 rb0 = make_uint4(0,0,0,0), rb1 = rb0, rb2 = rb0, rb3 = rb0;
  const u16* bp = Bt + (size_t)(n0 + lr) * ldb + lk;
#define GL_FETCH(i) ra##i = al.fetch(lr + 32 * i, kf); if (i < NI) rb##i = *(const uint4*)(bp + (size_t)(32 * i) * ldb + kb);
#define GL_STORE(i) *(uint4*)(a_ + (lr + 32 * i) * LDT + lsw) = al.cvt(ra##i, kt * BK + lk); if (i < NI) *(uint4*)(b_ + (lr + 32 * i) * LDT + lsw) = rb##i;
  {
    const int kf = lk, kb = 0;
    REP4(GL_FETCH)
  }
  const int nk = K / BK;
  for (int kt = 0; kt < nk; kt++) {
    u16* a_ = sa + (kt & 1) * BM * LDT;
    u16* b_ = sb + (kt & 1) * BN * LDT;
    REP4(GL_STORE)
    __syncthreads();
    if (kt + 1 < nk) {
      const int kf = (kt + 1) * BK + lk, kb = (kt + 1) * BK;
      REP4(GL_FETCH)
    }
#pragma unroll
    for (int ks = 0; ks < 2; ks++) {
      bf16x8 af[4], bf[NI];
#pragma unroll
      for (int i = 0; i < 4; i++) af[i] = *(const bf16x8*)(a_ + (wr * 64 + i * 16 + fr) * LDT + (((ks * 4 + fq) ^ (fr & 7)) * 8));
#pragma unroll
      for (int i = 0; i < NI; i++) bf[i] = *(const bf16x8*)(b_ + (wc * (NI * 16) + i * 16 + fr) * LDT + (((ks * 4 + fq) ^ (fr & 7)) * 8));
#pragma unroll
      for (int mi = 0; mi < 4; mi++)
#pragma unroll
        for (int ni = 0; ni < NI; ni++)
          acc[mi][ni] = __builtin_amdgcn_mfma_f32_16x16x32_bf16(af[mi], bf[ni], acc[mi][ni], 0, 0, 0);
    }
  }
  __syncthreads();
#undef GL_FETCH
#undef GL_STORE
}


struct ADma { const u16* base; int ld; int row0; int t0; const u16* zero; int mode; const char* wsb; };
constexpr int G3_STAGE = 12288;

template <int NI>
__device__ __forceinline__ void gemm3(f32x4 (&acc)[8][NI], const ADma& a, const u16* __restrict__ Bt, int ldb, int n0, int K,
                                      char* smem, const int tid) {
  const int lane = tid & 63, wave = tid >> 6;
  const int wr = wave >> 1, wc = wave & 1, fr = lane & 15, fq = lane >> 4;
  const int kc8 = ((lane & 3) ^ ((4 - (lane >> 4)) & 3)) * 8;
  const int psw = (fq ^ ((4 - (fr >> 2)) & 3)) * 8;
  u16* sm = (u16*)smem;
  const u16* ap0 = nullptr;
  unsigned ao0 = 0, ao1 = 0, ao2 = 0, ao3 = 0;
  if (a.mode == 0) {
    ap0 = a.base + (size_t)(a.row0 + wave * 64 + (lane >> 2)) * a.ld + kc8;
  } else {
    const unsigned bo = (unsigned)((const char*)a.base - a.wsb), zo = (unsigned)((const char*)a.zero - a.wsb) + kc8 * 2;
#define G3_AP(j)                                                                          \
    {                                                                                     \
      int t = a.t0 + wave * 64 + j * 16 + (lane >> 2);                                    \
      ao##j = (t >= 0 && t < T_) ? bo + (unsigned)(((a.row0 + t) * a.ld + kc8) * 2) : zo; \
    }
    REP4(G3_AP)
#undef G3_AP
  }
  const u16* bp0 = Bt + (size_t)(n0 + wave * (8 * NI) + (lane >> 2)) * ldb + kc8;
  const size_t astep = (size_t)16 * a.ld;
  const size_t bstep = (size_t)16 * ldb;
#define G3_ISSUE(j)                                                                                                              \
  __builtin_amdgcn_global_load_lds((a.mode == 0) ? (const unsigned*)(ap0 + j * astep + kof) : (const unsigned*)(a.wsb + ao##j + kof * 2), (unsigned*)(st_ + (wave * 64 + j * 16) * 32 + lane * 8), 16, 0, 0); \
  if (2 * j < NI) __builtin_amdgcn_global_load_lds((const unsigned*)(bp0 + j * bstep + kof), (unsigned*)(st_ + 8192 + (wave * (8 * NI) + j * 16) * 32 + lane * 8), 16, 0, 0);
  const int nk = K / 32;
  asm volatile("s_waitcnt vmcnt(0)" ::: "memory");
  {
    const int kof = 0;
    u16* st_ = sm;
    REP4(G3_ISSUE)
  }
  if (nk > 1) {
    const int kof = 32;
    u16* st_ = sm + G3_STAGE;
    REP4(G3_ISSUE)
  }
  int cur = 0, nxt = 2;
  const unsigned lds0 = (unsigned)(size_t)(__attribute__((address_space(3))) char*)smem;
  const unsigned aoff = lds0 + (unsigned)(((wr * 128 + fr) * 32 + psw) * 2);
  const unsigned boff = lds0 + 16384u + (unsigned)(((wc * (NI * 16) + fr) * 32 + psw) * 2);
#define G3_DSR(dst, addr, off) asm volatile("ds_read_b128 %0, %1 offset:" #off : "=v"(dst) : "v"(addr))
  for (int kt = 0; kt < nk; kt++) {
    if (kt + 1 < nk) {
      if (NI == 4) asm volatile("s_waitcnt vmcnt(6)" ::: "memory");
      else asm volatile("s_waitcnt vmcnt(5)" ::: "memory");
    } else {
      asm volatile("s_waitcnt vmcnt(0)" ::: "memory");
    }
    __builtin_amdgcn_s_barrier();
    if (kt + 2 < nk) {
      const int kof = (kt + 2) * 32;
      u16* st_ = sm + nxt * G3_STAGE;
      REP4(G3_ISSUE)
    }
    const unsigned aaddr = aoff + (unsigned)cur * (G3_STAGE * 2);
    const unsigned baddr = boff + (unsigned)cur * (G3_STAGE * 2);
    bf16x8 af[8], bf[NI];
    G3_DSR(af[0], aaddr, 0); G3_DSR(af[1], aaddr, 1024); G3_DSR(af[2], aaddr, 2048); G3_DSR(af[3], aaddr, 3072);
    G3_DSR(af[4], aaddr, 4096); G3_DSR(af[5], aaddr, 5120); G3_DSR(af[6], aaddr, 6144); G3_DSR(af[7], aaddr, 7168);
    G3_DSR(bf[0], baddr, 0); G3_DSR(bf[1], baddr, 1024);
    if (NI == 4) {
      G3_DSR(bf[NI - 2], baddr, 2048); G3_DSR(bf[NI - 1], baddr, 3072);
      asm volatile("s_waitcnt lgkmcnt(0)"
                   : "+v"(af[0]), "+v"(af[1]), "+v"(af[2]), "+v"(af[3]), "+v"(af[4]), "+v"(af[5]), "+v"(af[6]), "+v"(af[7]),
                     "+v"(bf[0]), "+v"(bf[1]), "+v"(bf[NI - 2]), "+v"(bf[NI - 1]));
    } else {
      asm volatile("s_waitcnt lgkmcnt(0)"
                   : "+v"(af[0]), "+v"(af[1]), "+v"(af[2]), "+v"(af[3]), "+v"(af[4]), "+v"(af[5]), "+v"(af[6]), "+v"(af[7]),
                     "+v"(bf[0]), "+v"(bf[1]));
    }
#pragma unroll
    for (int mi = 0; mi < 8; mi++)
#pragma unroll
      for (int ni = 0; ni < NI; ni++)
        acc[mi][ni] = __builtin_amdgcn_mfma_f32_16x16x32_bf16(af[mi], bf[ni], acc[mi][ni], 0, 0, 0);
    cur = (cur == 2) ? 0 : cur + 1;
    nxt = (nxt == 2) ? 0 : nxt + 1;
  }
  asm volatile("s_waitcnt lgkmcnt(0)" ::: "memory");
  __syncthreads();
#undef G3_DSR
#undef G3_ISSUE
}

template <int NI>
__device__ __forceinline__ void zero_acc8(f32x4 (&acc)[8][NI]) {
#pragma unroll
  for (int i = 0; i < 8; i++)
#pragma unroll
    for (int j = 0; j < NI; j++) acc[i][j] = f32x4{0.f, 0.f, 0.f, 0.f};
}


__device__ __forceinline__ bool map_tile(int i, int nblk, int MT, int NT, int& mt, int& nt) {
  const int locs = nblk >> 3;
  const int xcd = blockIdx.x & 7, loc = blockIdx.x >> 3;
  const int q = (i * 8 + xcd) * locs + loc;
  if (q >= MT * NT) return false;
  const int nfull = NT >> 3, per = MT * 8;
  if (q < nfull * per) {
    int pp = q / per, r = q - pp * per;
    mt = r >> 3;
    nt = pp * 8 + (r & 7);
  } else {
    int r = q - nfull * per;
    int w = NT - nfull * 8;
    mt = r / w;
    nt = nfull * 8 + (r - mt * w);
  }
  return true;
}

#define ACC_COORDS const int wr = wave >> 1, wc = wave & 1, fr = lane & 15, fq = lane >> 4;

__device__ __forceinline__ void conv_tile(const Params& p, int t, char* smem, const int tid) {
  int j = 0;
#pragma unroll 1
  for (int i = 1; i < 26; i++)
    if (t >= p.jobs[i].tile0) j = i;
  const Job& jb = p.jobs[j];
  float(*tile)[33] = (float(*)[33])smem;
  int local = t - jb.tile0;
  int nkt = jb.Kpad >> 5;
  int kt = local % nkt, nt = local / nkt;
  int tx = tid & 31, ty = tid >> 5;
  int n = nt * 32 + tx;
  int col;
  if (jb.mode == 0) col = jb.c0 + n;
  else { int jn = n >> 7, i = n & 127; col = (i < 64) ? (64 * jn + i) : (DFF_ + 64 * jn + (i - 64)); }
#pragma unroll
  for (int i = 0; i < 4; i++) {
    int k = kt * 32 + ty + 8 * i;
    float v = 0.f;
    if (k < jb.K && n < jb.Nv) v = jb.src[(size_t)k * jb.ld + col];
    tile[ty + 8 * i][tx] = v;
  }
  __syncthreads();
#pragma unroll
  for (int i = 0; i < 4; i++) {
    int nn = nt * 32 + ty + 8 * i;
    int k = kt * 32 + tx;
    jb.dst[(size_t)nn * jb.Kpad + k] = f2bf(tile[tx][ty + 8 * i]);
  }
  __syncthreads();
}

__device__ __forceinline__ void ln_row(const float* __restrict__ src, const float* __restrict__ g,
                                       const float* __restrict__ b, float* __restrict__ dst, int lane, u16* __restrict__ dstb = nullptr) {
  float4 v[4];
  float s = 0.f;
#pragma unroll
  for (int i = 0; i < 4; i++) {
    v[i] = *(const float4*)(src + i * 256 + lane * 4);
    s += v[i].x + v[i].y + v[i].z + v[i].w;
  }
  float mean = wave_sum(s, lane) * (1.0f / 1024.0f);
  float q = 0.f;
#pragma unroll
  for (int i = 0; i < 4; i++) {
    float a = v[i].x - mean, b2 = v[i].y - mean, c = v[i].z - mean, d = v[i].w - mean;
    q += a * a + b2 * b2 + c * c + d * d;
  }
  float rstd = rsqrtf(wave_sum(q, lane) * (1.0f / 1024.0f) + 1e-5f);
#pragma unroll
  for (int i = 0; i < 4; i++) {
    float4 gg = *(const float4*)(g + i * 256 + lane * 4);
    float4 bb = *(const float4*)(b + i * 256 + lane * 4);
    float4 o;
    o.x = (v[i].x - mean) * rstd * gg.x + bb.x;
    o.y = (v[i].y - mean) * rstd * gg.y + bb.y;
    o.z = (v[i].z - mean) * rstd * gg.z + bb.z;
    o.w = (v[i].w - mean) * rstd * gg.w + bb.w;
    *(float4*)(dst + i * 256 + lane * 4) = o;
    if (dstb) *(uint2*)(dstb + i * 256 + lane * 4) = make_uint2(pk2(o.x, o.y), pk2(o.z, o.w));
  }
}

struct ScanIn {
  float kk[16][64], wr[16][64], w[16][64], kt[16][64], kka[16][64], v[16][64], g[16][64];
  float c[16][4];
};
struct ScanRaw { uint2 r, k, v, rp, kp, vp, a, g; float4 dec; };

__device__ __forceinline__ ScanRaw scan_fetch(const u16* __restrict__ P, const float* __restrict__ DEC,
                                              const u16* __restrict__ AA, const u16* __restrict__ GG, int rowbase, int t,
                                              int hc) {
  ScanRaw w;
  size_t row = (size_t)(rowbase + t);
  const u16* pp = P + row * PC_ + hc;
  w.r = *(const uint2*)(pp);
  w.k = *(const uint2*)(pp + 512);
  w.v = *(const uint2*)(pp + 1024);
  if (t > 0) {
    w.rp = *(const uint2*)(pp - PC_);
    w.kp = *(const uint2*)(pp - PC_ + 512);
    w.vp = *(const uint2*)(pp - PC_ + 1024);
  } else {
    w.rp = make_uint2(0, 0); w.kp = make_uint2(0, 0); w.vp = make_uint2(0, 0);
  }
  w.dec = *(const float4*)(DEC + row * 512 + hc);
  w.a = *(const uint2*)(AA + row * 512 + hc);
  w.g = *(const uint2*)(GG + row * 512 + hc);
  return w;
}

__device__ __forceinline__ void unpack4(uint2 u, float (&o)[4]) {
  o[0] = bflo(u.x); o[1] = bfhi(u.x); o[2] = bflo(u.y); o[3] = bfhi(u.y);
}

__device__ __forceinline__ void scan_unit(const Params& p, int l, int bh, char* smem, const int tid) {
  const int lane = tid & 63, wave = tid >> 6;
  const int b = bh >> 3, h = bh & 7;
  const int rowbase = b * T_;
  const u16* P = (const u16*)(p.ws + OFF_P);
  const float* DEC = (const float*)(p.ws + OFF_DEC);
  const u16* AA = (const u16*)(p.ws + OFF_AA);
  const u16* GG = (const u16*)(p.ws + OFF_GG);
  u16* YR = (u16*)(p.ws + OFF_AA);
  ScanIn* in = (ScanIn*)smem;
  float(*ybuf)[64] = (float(*)[64])(smem + 2 * sizeof(ScanIn));
  const int tl = tid >> 4, kq = tid & 15, hc = h * 64 + kq * 4;
  float mu_r[4], mu_k[4], mu_v[4], kkw[4], kaw[4], omk[4], rkw[4], lg[4], lb[4];
  {
    const float* mu = p.in[5] + (size_t)l * 1824;
#pragma unroll
    for (int e = 0; e < 4; e++) {
      mu_r[e] = mu[hc + e];
      mu_k[e] = mu[512 + hc + e];
      mu_v[e] = mu[1024 + hc + e];
      kkw[e] = p.in[11][l * 512 + hc + e];
      kaw[e] = p.in[12][l * 512 + hc + e];
      omk[e] = 1.0f - kaw[e];
      rkw[e] = p.in[13][l * 512 + hc + e];
      lg[e] = p.in[14][l * 512 + hc + e];
      lb[e] = p.in[15][l * 512 + hc + e];
    }
  }
  const int rp = lane >> 3, ks = lane & 7, row0 = wave * 16 + rp * 2;
  float S[2][8];
#pragma unroll
  for (int i = 0; i < 2; i++)
#pragma unroll
    for (int e = 0; e < 8; e++) S[i][e] = 0.f;

  auto stage = [&](const ScanRaw& w, ScanIn& dst) {
    float r[4], k[4], v[4], rq[4], kp[4], vp[4], a[4], g[4];
    unpack4(w.r, r); unpack4(w.k, k); unpack4(w.v, v);
    unpack4(w.rp, rq); unpack4(w.kp, kp); unpack4(w.vp, vp);
    unpack4(w.a, a); unpack4(w.g, g);
    float dec[4] = {w.dec.x, w.dec.y, w.dec.z, w.dec.w};
    float kkr[4], ss = 0.f;
#pragma unroll
    for (int e = 0; e < 4; e++) {
      r[e] = r[e] + (rq[e] - r[e]) * mu_r[e];
      k[e] = k[e] + (kp[e] - k[e]) * mu_k[e];
      v[e] = v[e] + (vp[e] - v[e]) * mu_v[e];
      kkr[e] = k[e] * kkw[e];
      ss += kkr[e] * kkr[e];
    }
    ss = sum16(ss);
    float inv = 1.0f / fmaxf(sqrtf(ss), 1e-12f);
    float c1 = 0.f, c2 = 0.f, c3 = 0.f;
    float kk[4], ktl[4], kka[4], wr[4];
#pragma unroll
    for (int e = 0; e < 4; e++) {
      kk[e] = kkr[e] * inv;
      ktl[e] = k[e] * fmaf(a[e], kaw[e], omk[e]);
      kka[e] = kk[e] * a[e];
      wr[e] = dec[e] * r[e];
      c1 += kka[e] * r[e];
      c2 += ktl[e] * r[e];
      c3 += r[e] * ktl[e] * rkw[e];
    }
    c1 = sum16(c1); c2 = sum16(c2); c3 = sum16(c3);
    *(float4*)&dst.kk[tl][kq * 4] = make_float4(kk[0], kk[1], kk[2], kk[3]);
    *(float4*)&dst.wr[tl][kq * 4] = make_float4(wr[0], wr[1], wr[2], wr[3]);
    *(float4*)&dst.w[tl][kq * 4] = make_float4(dec[0], dec[1], dec[2], dec[3]);
    *(float4*)&dst.kt[tl][kq * 4] = make_float4(ktl[0], ktl[1], ktl[2], ktl[3]);
    *(float4*)&dst.kka[tl][kq * 4] = make_float4(kka[0], kka[1], kka[2], kka[3]);
    *(float4*)&dst.v[tl][kq * 4] = make_float4(v[0], v[1], v[2], v[3]);
    *(float4*)&dst.g[tl][kq * 4] = make_float4(g[0], g[1], g[2], g[3]);
    if (kq == 0) *(float4*)&dst.c[tl][0] = make_float4(c1, c2, c3, 0.f);
  };

  {
    ScanRaw w0 = scan_fetch(P, DEC, AA, GG, rowbase, tl, hc);
    stage(w0, in[0]);
  }
  __syncthreads();
  constexpr int NCH = T_ / 16;
  for (int c = 0; c < NCH; c++) {
    ScanIn& cur = in[c & 1];
    ScanRaw nx;
    const bool have_next = (c + 1 < NCH);
    if (have_next) nx = scan_fetch(P, DEC, AA, GG, rowbase, (c + 1) * 16 + tl, hc);
#pragma unroll 2
    for (int s = 0; s < 16; s++) {
      float kk[8], wr[8], w[8], kt[8], kka[8];
      *(float4*)&kk[0] = *(const float4*)&cur.kk[s][ks * 8];
      *(float4*)&kk[4] = *(const float4*)&cur.kk[s][ks * 8 + 4];
      *(float4*)&wr[0] = *(const float4*)&cur.wr[s][ks * 8];
      *(float4*)&wr[4] = *(const float4*)&cur.wr[s][ks * 8 + 4];
      *(float4*)&w[0] = *(const float4*)&cur.w[s][ks * 8];
      *(float4*)&w[4] = *(const float4*)&cur.w[s][ks * 8 + 4];
      *(float4*)&kt[0] = *(const float4*)&cur.kt[s][ks * 8];
      *(float4*)&kt[4] = *(const float4*)&cur.kt[s][ks * 8 + 4];
      *(float4*)&kka[0] = *(const float4*)&cur.kka[s][ks * 8];
      *(float4*)&kka[4] = *(const float4*)&cur.kka[s][ks * 8 + 4];
      float2 vv = *(const float2*)&cur.v[s][row0];
      float2 cc = *(const float2*)&cur.c[s][0];
      float vr[2] = {vv.x, vv.y};
      float d1[2], d2[2];
#pragma unroll
      for (int i = 0; i < 2; i++) {
        float a0 = 0.f, a1 = 0.f, b0 = 0.f, b1 = 0.f;
#pragma unroll
        for (int e = 0; e < 8; e += 2) {
          a0 = fmaf(S[i][e], kk[e], a0);
          a1 = fmaf(S[i][e + 1], kk[e + 1], a1);
          b0 = fmaf(S[i][e], wr[e], b0);
          b1 = fmaf(S[i][e + 1], wr[e + 1], b1);
        }
        d1[i] = sum8(a0 + a1);
        d2[i] = sum8(b0 + b1);
      }
#pragma unroll
      for (int i = 0; i < 2; i++) {
        float skk = d1[i];
        float y = d2[i] - skk * cc.x + vr[i] * cc.y;
        if (ks == 0) ybuf[s][row0 + i] = y;
#pragma unroll
        for (int e = 0; e < 8; e++) S[i][e] = fmaf(S[i][e], w[e], fmaf(-skk, kka[e], vr[i] * kt[e]));
      }
    }
    __syncthreads();
    {
      float4 y4 = *(const float4*)&ybuf[tl][kq * 4];
      float y[4] = {y4.x, y4.y, y4.z, y4.w};
      float mean = sum16(y[0] + y[1] + y[2] + y[3]) * (1.0f / 64.0f);
      float q = 0.f;
#pragma unroll
      for (int e = 0; e < 4; e++) { y[e] -= mean; q += y[e] * y[e]; }
      float rstd = rsqrtf(sum16(q) * (1.0f / 64.0f) + 64e-5f);
      float c3 = cur.c[tl][2];
      float4 v4 = *(const float4*)&cur.v[tl][kq * 4];
      float4 g4 = *(const float4*)&cur.g[tl][kq * 4];
      float vv[4] = {v4.x, v4.y, v4.z, v4.w};
      float gg[4] = {g4.x, g4.y, g4.z, g4.w};
      float o[4];
#pragma unroll
      for (int e = 0; e < 4; e++) o[e] = (y[e] * rstd * lg[e] + lb[e] + c3 * vv[e]) * gg[e];
      size_t row = (size_t)(rowbase + c * 16 + tl);
      *(uint2*)(YR + row * 512 + hc) = make_uint2(pk2(o[0], o[1]), pk2(o[2], o[3]));
    }
    if (have_next) stage(nx, in[(c + 1) & 1]);
    __syncthreads();
  }
}

constexpr int KLD = 104, VLD = 72;
struct AttnSmem { u16 k[2][64 * KLD]; u16 v[2][64 * VLD]; };

__device__ __forceinline__ void attn_unit(const Params& p, int bh, int qi, char* smem, const int tid) {
  const int lane = tid & 63, wave = tid >> 6;
  const int fr = lane & 15, fq = lane >> 4;
  const int b = bh >> 3, h = bh & 7;
  const int rowbase = b * T_;
  u16* P = (u16*)(p.ws + OFF_P);
  const u16* Q = (const u16*)(p.ws + OFF_Q);
  const u16* KN = (const u16*)p.out;
  const u16* VT = (const u16*)p.out + (size_t)M_ * 512;
  const float2* ROPE = (const float2*)(p.ws + OFF_ROPE);
  AttnSmem* sm = (AttnSmem*)smem;
  const int qs = (qi == 0) ? 0 : 16 + (qi - 1) * 128;
  const int qn = (qi == 0) ? 16 : 128;
  const int q0 = qs + wave * 32;
  const bool wave_valid = (wave * 32 < qn);
  const int nkt = (qs + qn - 1) / 64 + 1;

  bf16x8 qf[2][3];
#pragma unroll
  for (int qb = 0; qb < 2; qb++) {
    int query = min(q0 + qb * 16 + fr, T_ - 1);
    const u16* qp = Q + (size_t)(rowbase + query) * 768 + h * 96;
    uint4 a0 = *(const uint4*)(qp + fq * 8);
    uint4 a1 = *(const uint4*)(qp + 32 + fq * 8);
    uint4 own = *(const uint4*)(qp + 64 + fq * 8);
    uint4 oth = *(const uint4*)(qp + 64 + (fq ^ 2) * 8);
    unsigned ow[4] = {own.x, own.y, own.z, own.w};
    unsigned tw[4] = {oth.x, oth.y, oth.z, oth.w};
    unsigned rw[4];
    const float2* rp = ROPE + (size_t)query * 16 + (fq & 1) * 8;
#pragma unroll
    for (int e = 0; e < 4; e++) {
      float2 cs0 = rp[2 * e], cs1 = rp[2 * e + 1];
      float o0 = bflo(ow[e]), o1 = bfhi(ow[e]);
      float t0 = bflo(tw[e]), t1 = bfhi(tw[e]);
      float r0, r1;
      if (fq < 2) { r0 = o0 * cs0.x - t0 * cs0.y; r1 = o1 * cs1.x - t1 * cs1.y; }
      else { r0 = t0 * cs0.y + o0 * cs0.x; r1 = t1 * cs1.y + o1 * cs1.x; }
      rw[e] = pk2(r0, r1);
    }
    uint4 a2 = make_uint4(rw[0], rw[1], rw[2], rw[3]);
    qf[qb][0] = *(bf16x8*)&a0;
    qf[qb][1] = *(bf16x8*)&a1;
    qf[qb][2] = *(bf16x8*)&a2;
  }

  f32x4 O[4][2];
#pragma unroll
  for (int i = 0; i < 4; i++)
#pragma unroll
    for (int j = 0; j < 2; j++) O[i][j] = f32x4{0.f, 0.f, 0.f, 0.f};
  float mrun[2] = {-1e30f, -1e30f}, lrun[2] = {0.f, 0.f};
  const float sc = 1.4426950408889634f / 9.797958971132712f;

  uint4 rk[3], rv[2];
  auto fetch_tile = [&](int kt) {
#pragma unroll
    for (int i = 0; i < 3; i++) {
      int c = tid + 256 * i;
      int key = c / 12, cc = c % 12;
      int t = kt * 64 + key;
      uint4 val = make_uint4(0, 0, 0, 0);
      if (t < T_) {
        size_t row = (size_t)(rowbase + t);
        if (cc < 8) val = *(const uint4*)(KN + row * 512 + h * 64 + cc * 8);
        else val = *(const uint4*)(P + row * PC_ + PKR_ + (cc - 8) * 8);
      }
      rk[i] = val;
    }
#pragma unroll
    for (int i = 0; i < 2; i++) {
      int c = tid + 256 * i;
      int dv = c >> 3, cc = c & 7;
      int t = kt * 64 + cc * 8;
      uint4 val = make_uint4(0, 0, 0, 0);
      if (t < T_) val = *(const uint4*)(VT + ((size_t)bh * 64 + dv) * T_ + t);
      rv[i] = val;
    }
  };
  auto store_tile = [&](int buf) {
#pragma unroll
    for (int i = 0; i < 3; i++) {
      int c = tid + 256 * i;
      int key = c / 12, cc = c % 12;
      *(uint4*)(&sm->k[buf][key * KLD + cc * 8]) = rk[i];
    }
#pragma unroll
    for (int i = 0; i < 2; i++) {
      int c = tid + 256 * i;
      int dv = c >> 3, cc = c & 7;
      *(uint4*)(&sm->v[buf][dv * VLD + cc * 8]) = rv[i];
    }
  };

  fetch_tile(0);
  for (int kt = 0; kt < nkt; kt++) {
    const int buf = kt & 1;
    store_tile(buf);
    __syncthreads();
    if (kt + 1 < nkt) fetch_tile(kt + 1);
    if (wave_valid && kt * 64 <= q0 + 31) {
      const u16* Ks = sm->k[buf];
      const u16* Vs = sm->v[buf];
      f32x4 s[4][2];
#pragma unroll
      for (int i = 0; i < 4; i++)
#pragma unroll
        for (int j = 0; j < 2; j++) s[i][j] = f32x4{0.f, 0.f, 0.f, 0.f};
#pragma unroll
      for (int ks = 0; ks < 3; ks++)
#pragma unroll
        for (int kb = 0; kb < 4; kb++) {
          bf16x8 kf = *(const bf16x8*)(Ks + (kb * 16 + fr) * KLD + ks * 32 + fq * 8);
#pragma unroll
          for (int qb = 0; qb < 2; qb++) s[kb][qb] = __builtin_amdgcn_mfma_f32_16x16x32_bf16(kf, qf[qb][ks], s[kb][qb], 0, 0, 0);
        }
      const bool need_mask = (kt * 64 + 63 > q0);
      unsigned pfw[2][2][4];
#pragma unroll
      for (int qb = 0; qb < 2; qb++) {
        const int query = q0 + qb * 16 + fr;
        float mx = -1e30f;
#pragma unroll
        for (int kb = 0; kb < 4; kb++)
#pragma unroll
          for (int j = 0; j < 4; j++) {
            float v = s[kb][qb][j] * sc;
            if (need_mask) {
              int key = kt * 64 + kb * 16 + fq * 4 + j;
              if (key > query) v = -1e30f;
            }
            s[kb][qb][j] = v;
            mx = fmaxf(mx, v);
          }
        mx = fmaxf(mx, shx(mx, lane, 16));
        mx = fmaxf(mx, shx(mx, lane, 32));
        float mnew = fmaxf(mrun[qb], mx);
        float alpha = exp2f(mrun[qb] - mnew);
        mrun[qb] = mnew;
        float ps = 0.f;
#pragma unroll
        for (int kb = 0; kb < 4; kb++) {
          float p0 = exp2f(s[kb][qb][0] - mnew), p1 = exp2f(s[kb][qb][1] - mnew);
          float p2 = exp2f(s[kb][qb][2] - mnew), p3 = exp2f(s[kb][qb][3] - mnew);
          ps += (p0 + p1) + (p2 + p3);
          pfw[qb][kb >> 1][(kb & 1) * 2 + 0] = pk2(p0, p1);
          pfw[qb][kb >> 1][(kb & 1) * 2 + 1] = pk2(p2, p3);
        }
        lrun[qb] = lrun[qb] * alpha + ps;
#pragma unroll
        for (int dvb = 0; dvb < 4; dvb++) {
          O[dvb][qb][0] *= alpha; O[dvb][qb][1] *= alpha; O[dvb][qb][2] *= alpha; O[dvb][qb][3] *= alpha;
        }
      }
#pragma unroll
      for (int s2 = 0; s2 < 2; s2++)
#pragma unroll
        for (int dvb = 0; dvb < 4; dvb++) {
          const u16* vp = Vs + (dvb * 16 + fr) * VLD + s2 * 32 + fq * 4;
          uint2 v0 = *(const uint2*)vp;
          uint2 v1 = *(const uint2*)(vp + 16);
          uint4 vv = make_uint4(v0.x, v0.y, v1.x, v1.y);
          bf16x8 vf = *(bf16x8*)&vv;
#pragma unroll
          for (int qb = 0; qb < 2; qb++) {
            uint4 pw = make_uint4(pfw[qb][s2][0], pfw[qb][s2][1], pfw[qb][s2][2], pfw[qb][s2][3]);
            O[dvb][qb] = __builtin_amdgcn_mfma_f32_16x16x32_bf16(vf, *(bf16x8*)&pw, O[dvb][qb], 0, 0, 0);
          }
        }
    }
  }
  __syncthreads();
  if (wave_valid) {
#pragma unroll
    for (int qb = 0; qb < 2; qb++) {
      float l = lrun[qb];
      l += shx(l, lane, 16);
      l += shx(l, lane, 32);
      float inv = 1.0f / l;
      int query = q0 + qb * 16 + fr;
      if (query < qs + qn) {
        u16* op = P + (size_t)(rowbase + query) * PC_ + PMLA_ + h * 64 + fq * 4;
#pragma unroll
        for (int dvb = 0; dvb < 4; dvb++) {
          *(uint2*)(op + dvb * 16) =
              make_uint2(pk2(O[dvb][qb][0] * inv, O[dvb][qb][1] * inv), pk2(O[dvb][qb][2] * inv, O[dvb][qb][3] * inv));
        }
      }
    }
  }
}

#define XB_TMO      128
#define XB_XCNT(j)  (256  + 64 * (j))
#define XB_XSUB(j)  (1280 + 64 * (j))
#define XB_XGEN(j)  (2304 + 64 * (j))
#define XB_TOP      3328
#define XB_TOPGEN   3392
#define XCD_BAR_WORDS 3456
#define XB_SPIN_CAP (1u << 18)
#define LAS __attribute__((address_space(3)))

__device__ __forceinline__ unsigned xb_ld(unsigned* p)              { return __hip_atomic_load(p, __ATOMIC_RELAXED, __HIP_MEMORY_SCOPE_AGENT); }
__device__ __forceinline__ unsigned xb_add(unsigned* p, unsigned v) { return __hip_atomic_fetch_add(p, v, __ATOMIC_RELAXED, __HIP_MEMORY_SCOPE_AGENT); }
__device__ __forceinline__ unsigned xb_xcc_id() { return (unsigned)__builtin_amdgcn_s_getreg((3 << 11) | 20) & 0xFu; }
#define XB_SPIN(cond, bar) do { unsigned _sp = 0; while (cond) { __builtin_amdgcn_s_sleep(1); \
    if ((++_sp & 255u) == 0u) { if (xb_ld(&(bar)[XB_TMO])) break; if (_sp > XB_SPIN_CAP) { atomicAdd(&(bar)[XB_TMO], 1u); break; } } } } while (0)

struct XcdBarrier {
    unsigned* bar; unsigned x;
    volatile LAS unsigned* st;
};

__device__ __forceinline__ XcdBarrier xcd_barrier_post(unsigned* bar, volatile LAS unsigned* st) {
    XcdBarrier b; b.bar = bar; b.x = xb_xcc_id(); b.st = st;
    if (threadIdx.x == 0) (void)xb_add(&bar[XB_XCNT(b.x)], 1u);
    return b;
}
__device__ __forceinline__ void xcd_barrier_complete(unsigned* bar, unsigned x, unsigned& nloc, unsigned& nx) {
    const unsigned G = gridDim.x * gridDim.y * gridDim.z;
    unsigned sum, cnt, mine, sp = 0u;
    for (;;) {
        sum = 0u; cnt = 0u; mine = 0u;
#pragma unroll
        for (unsigned j = 0; j < 16; ++j) { const unsigned c = xb_ld(&bar[XB_XCNT(j)]); sum += c; cnt += (c > 0u) ? 1u : 0u; mine = (j == x) ? c : mine; }
        if (sum == G) break;
        __builtin_amdgcn_s_sleep(1);
        if ((++sp & 255u) == 0u) { if (xb_ld(&bar[XB_TMO])) break; if (sp > XB_SPIN_CAP) { atomicAdd(&bar[XB_TMO], 1u); break; } }
    }
    nloc = mine > 0u ? mine : 1u; nx = cnt > 0u ? cnt : 1u;
}

__device__ __forceinline__ void xcd_barrier(const XcdBarrier& b, const int tid_) {
    asm volatile("s_waitcnt vmcnt(0)" ::: "memory");
    __syncthreads();
    if (tid_ == 0) {
        unsigned* bar = b.bar;
        __builtin_amdgcn_s_waitcnt(0);
        unsigned nloc = b.st[0], nx = b.st[1];
        if (nloc == 0u) { xcd_barrier_complete(bar, b.x, nloc, nx); b.st[0] = nloc; b.st[1] = nx; }
        const unsigned old = xb_add(&bar[XB_XSUB(b.x)], 1u);
        const unsigned gen = old / nloc;
        if (old + 1u == (gen + 1u) * nloc) {
            __builtin_amdgcn_fence(__ATOMIC_RELEASE, "agent");
            asm volatile("s_waitcnt vmcnt(0)" ::: "memory");
            const unsigned og = xb_add(&bar[XB_TOP], 1u);
            const unsigned tg = og / nx;
            if (og + 1u == (tg + 1u) * nx) xb_add(&bar[XB_TOPGEN], 1u);
            else XB_SPIN(xb_ld(&bar[XB_TOPGEN]) == tg, bar);
            __builtin_amdgcn_fence(__ATOMIC_ACQUIRE, "agent");
            xb_add(&bar[XB_XGEN(b.x)], 1u);
            asm volatile("s_waitcnt vmcnt(0)" ::: "memory");
        } else {
            XB_SPIN(xb_ld(&bar[XB_XGEN(b.x)]) == gen, bar);
            __builtin_amdgcn_fence(__ATOMIC_ACQUIRE, "agent");
            asm volatile("s_waitcnt vmcnt(0)" ::: "memory");
        }
    }
    __syncthreads();
}


__global__ void __launch_bounds__(256, 2) mega(Params p) {
  cg::grid_group grid = cg::this_grid();
  __shared__ __attribute__((aligned(16))) char smem[SMEM_BYTES];
  __shared__ int s_unit;
  __shared__ uint4 xb_words;
  if (threadIdx.x == 0) xb_words = make_uint4(0u, 0u, 0u, 0u);
  __syncthreads();
  (void)xcd_barrier_post((unsigned*)(p.ws + OFF_BAR), (volatile LAS unsigned*)&xb_words);
#define XB_SYNC() do { XcdBarrier xb_; xb_.bar = (unsigned*)(p.ws + OFF_BAR); xb_.x = xb_xcc_id(); xb_.st = (volatile LAS unsigned*)&xb_words; xcd_barrier(xb_, wave0 * 64 + fresh_lane()); } while (0)
  int wave0 = __builtin_amdgcn_readfirstlane((int)(threadIdx.x >> 6));
  asm volatile("" : "+s"(wave0));
  const int nblk = gridDim.x;
  float* H = (float*)(p.ws + OFF_H);
  u16* P = (u16*)(p.ws + OFF_P);
  float* DEC = (float*)(p.ws + OFF_DEC);
  u16* AA = (u16*)(p.ws + OFF_AA);
  u16* GG = (u16*)(p.ws + OFF_GG);
  u16* Q = (u16*)(p.ws + OFF_Q);
  u16* MIX = (u16*)(p.ws + OFF_DEC);
  u16* HB1 = (u16*)p.out + (size_t)2 * M_ * 512;
  u16* HB2 = (u16*)(p.ws + OFF_HB2);
  u16* HBH = (u16*)(p.ws + OFF_AA);
  const u16* ZERO = (const u16*)(p.ws + OFF_ZERO);
  u16* ACT = (u16*)(p.ws + OFF_P);
  float2* ROPE = (float2*)(p.ws + OFF_ROPE);
  int* CTR = (int*)(p.ws + OFF_CTR);
  u16* KN = (u16*)p.out;
  u16* VT = KN + (size_t)M_ * 512;
  u16* YR = AA;

  {
  PHASE_TID
  for (int t = blockIdx.x; t < p.nconv; t += nblk) conv_tile(p, t, smem, tid);
  for (int i = blockIdx.x * 256 + tid; i < T_ * 16; i += nblk * 256) {
    int t = i >> 4, f = i & 15;
    double rev = (double)t * ROPE_C[f];
    rev -= floor(rev);
    float r = (float)rev;
    ROPE[i] = make_float2(__builtin_amdgcn_cosf(r), __builtin_amdgcn_sinf(r));
  }
  for (int row = blockIdx.x * 4 + wave; row < M_; row += nblk * 4) {
    int b = row / T_, t = row % T_;
    const float* src = (t < NMETA_) ? (p.in[1] + (size_t)t * 1024) : (p.in[0] + ((size_t)b * SEQ_ + (t - NMETA_)) * 1024);
    ln_row(src, p.in[2], p.in[3], H + (size_t)row * 1024, lane, (row < HB_SPLIT) ? HB1 + (size_t)row * 1024 : HB2 + (size_t)(row - HB_SPLIT) * 1024);
  }
  if (blockIdx.x == 0 && tid < 16) CTR[tid] = 0;
  if (blockIdx.x == 1) { for (int i = tid; i < 2048; i += 256) ((unsigned*)(p.ws + OFF_ZERO))[i] = 0u; }
  }
  grid.sync();

#pragma unroll 1
  for (int ph_ = 0; ph_ < 20; ph_++) {
    const int l = ph_ / 10, kph = ph_ - l * 10;
    const u16* WL = (const u16*)(p.ws + OFF_W) + (size_t)l * W_LAYER;
    if (kph == 0) {
    PHASE_TID
    for (int it_ = 0; it_ * nblk < 257 * 19; it_++) {
      int mt, nt;
      if (!map_tile(it_, nblk, 257, 19, mt, nt)) continue;
      f32x4 acc[8][4];
      zero_acc8(acc);
      ADma al = ADma{(mt < 255) ? HB1 : HB2, 1024, (mt < 255) ? mt * 256 : mt * 256 - HB_SPLIT, 0, ZERO, 0};
      gemm3(acc, al, WL + W_IN, 1024, nt * 128, 1024, smem, tid);
      ACC_COORDS
#pragma unroll
      for (int mi = 0; mi < 8; mi++)
#pragma unroll
        for (int ni = 0; ni < 4; ni++) {
          int col = nt * 128 + wc * 64 + ni * 16 + fr;
          if (col < PC_) {
#pragma unroll
            for (int j = 0; j < 4; j++) {
              int row = mt * 256 + wr * 128 + mi * 16 + fq * 4 + j;
              P[(size_t)row * PC_ + col] = f2bf(acc[mi][ni][j]);
            }
          }
        }
    }
    }
    if (kph == 1) {
    PHASE_TID
    {
      const float* qg = p.in[16] + l * 256;
      const float* kvg = p.in[18] + l * 256;
      for (int row = blockIdx.x * 4 + wave; row < M_; row += nblk * 4) {
        u16* pr = P + (size_t)row * PC_;
        uint2 cq = *(const uint2*)(pr + PMLA_ + lane * 4);
        uint2 ckv = *(const uint2*)(pr + PKV_ + lane * 4);
        float a[4], c[4];
        unpack4(cq, a);
        unpack4(ckv, c);
        float s1 = a[0] * a[0] + a[1] * a[1] + a[2] * a[2] + a[3] * a[3];
        float s2 = c[0] * c[0] + c[1] * c[1] + c[2] * c[2] + c[3] * c[3];
        s1 = wave_sum(s1, lane);
        s2 = wave_sum(s2, lane);
        float r1 = rsqrtf(s1 * (1.0f / 256.0f) + 1e-6f), r2 = rsqrtf(s2 * (1.0f / 256.0f) + 1e-6f);
        float4 g1 = *(const float4*)(qg + lane * 4), g2 = *(const float4*)(kvg + lane * 4);
        *(uint2*)(pr + PMLA_ + lane * 4) = make_uint2(pk2(a[0] * r1 * g1.x, a[1] * r1 * g1.y), pk2(a[2] * r1 * g1.z, a[3] * r1 * g1.w));
        *(uint2*)(pr + PKV_ + lane * 4) = make_uint2(pk2(c[0] * r2 * g2.x, c[1] * r2 * g2.y), pk2(c[2] * r2 * g2.z, c[3] * r2 * g2.w));
        if (lane < 16) {
          int t = row % T_;
          float x1 = bf2f(pr[PKR_ + lane]), x2 = bf2f(pr[PKR_ + 16 + lane]);
          float2 cs = ROPE[t * 16 + lane];
          pr[PKR_ + lane] = f2bf(x1 * cs.x - x2 * cs.y);
          pr[PKR_ + 16 + lane] = f2bf(x1 * cs.y + x2 * cs.x);
        }
      }
      const float* mu = p.in[5] + (size_t)l * 1824;
      for (int tile = blockIdx.x; tile < 514 * 12; tile += nblk) {
        int mt = tile / 12, sub = tile % 12, which = sub >> 2, nt = sub & 3;
        f32x4 acc[4][4];
        zero_acc(acc);
        ACC_COORDS
        if (which == 0) {
          AL<3> al{P + 1536, PC_, mt * 128, 0, 64, mu + 1536, 0};
          gemm_loop(acc, al, WL + W_LW, 64, nt * 128, 64, smem, tid);
          const float* w0 = p.in[6] + l * 512;
#pragma unroll
          for (int mi = 0; mi < 4; mi++)
#pragma unroll
            for (int ni = 0; ni < 4; ni++) {
              int col = nt * 128 + wc * 64 + ni * 16 + fr;
              float w0c = w0[col];
#pragma unroll
              for (int j = 0; j < 4; j++) {
                int row = mt * 128 + wr * 64 + mi * 16 + fq * 4 + j;
                float x = -(acc[mi][ni][j] + w0c);
                float sp = fmaxf(x, 0.f) + log1pf(__expf(-fabsf(x)));
                float wraw = -sp - 0.5f;
                DEC[(size_t)row * 512 + col] = __expf(-__expf(wraw));
              }
            }
        } else if (which == 1) {
          AL<3> al{P + 1600, PC_, mt * 128, 0, 64, mu + 1600, 1};
          gemm_loop(acc, al, WL + W_LA, 64, nt * 128, 64, smem, tid);
          const float* a0 = p.in[8] + l * 512;
#pragma unroll
          for (int mi = 0; mi < 4; mi++)
#pragma unroll
            for (int ni = 0; ni < 4; ni++) {
              int col = nt * 128 + wc * 64 + ni * 16 + fr;
              float a0c = a0[col];
#pragma unroll
              for (int j = 0; j < 4; j++) {
                int row = mt * 128 + wr * 64 + mi * 16 + fq * 4 + j;
                AA[(size_t)row * 512 + col] = f2bf(sigmoidf_(acc[mi][ni][j] + a0c));
              }
            }
        } else {
          AL<3> al{P + 1664, PC_, mt * 128, 0, 160, mu + 1664, 2};
          gemm_loop(acc, al, WL + W_LG, 192, nt * 128, 192, smem, tid);
#pragma unroll
          for (int mi = 0; mi < 4; mi++)
#pragma unroll
            for (int ni = 0; ni < 4; ni++) {
              int col = nt * 128 + wc * 64 + ni * 16 + fr;
#pragma unroll
              for (int j = 0; j < 4; j++) {
                int row = mt * 128 + wr * 64 + mi * 16 + fq * 4 + j;
                GG[(size_t)row * 512 + col] = f2bf(acc[mi][ni][j]);
              }
            }
        }
      }
    }
    }
    if (kph == 2) {
    PHASE_TID
    for (int it_ = 0; it_ * nblk < 257 * 14; it_++) {
      int mt, sub;
      if (!map_tile(it_, nblk, 257, 14, mt, sub)) continue;
      f32x4 acc[8][4];
      zero_acc8(acc);
      ACC_COORDS
      if (sub < 6) {
        ADma al{P + PMLA_, PC_, mt * 256, 0, ZERO, 0};
        gemm3(acc, al, WL + W_UQ, 256, sub * 128, 256, smem, tid);
#pragma unroll
        for (int mi = 0; mi < 8; mi++)
#pragma unroll
          for (int ni = 0; ni < 4; ni++) {
            int col = sub * 128 + wc * 64 + ni * 16 + fr;
#pragma unroll
            for (int j = 0; j < 4; j++) {
              int row = mt * 256 + wr * 128 + mi * 16 + fq * 4 + j;
              Q[(size_t)row * 768 + col] = f2bf(acc[mi][ni][j]);
            }
          }
      } else if (sub < 10) {
        int nt = sub - 6;
        ADma al{P + PKV_, PC_, mt * 256, 0, ZERO, 0};
        gemm3(acc, al, WL + W_UK, 256, nt * 128, 256, smem, tid);
#pragma unroll
        for (int mi = 0; mi < 8; mi++)
#pragma unroll
          for (int ni = 0; ni < 4; ni++) {
            int col = nt * 128 + wc * 64 + ni * 16 + fr;
#pragma unroll
            for (int j = 0; j < 4; j++) {
              int row = mt * 256 + wr * 128 + mi * 16 + fq * 4 + j;
              KN[(size_t)row * 512 + col] = f2bf(acc[mi][ni][j]);
            }
          }
      } else {
        int nt = sub - 10;
        ADma al{P + PKV_, PC_, mt * 256, 0, ZERO, 0};
        gemm3(acc, al, WL + W_UV, 256, nt * 128, 256, smem, tid);
#pragma unroll
        for (int mi = 0; mi < 8; mi++)
#pragma unroll
          for (int ni = 0; ni < 4; ni++) {
            int col = nt * 128 + wc * 64 + ni * 16 + fr;
            int row = mt * 256 + wr * 128 + mi * 16 + fq * 4;
            int b = row / T_, t = row % T_;
            size_t o = ((size_t)(b * 512 + col)) * T_ + t;
            *(uint2*)(VT + o) = make_uint2(pk2(acc[mi][ni][0], acc[mi][ni][1]), pk2(acc[mi][ni][2], acc[mi][ni][3]));
          }
      }
    }
    }
    if (kph == 3) {
    PHASE_TID
    {
      const int xcd = blockIdx.x & 7;
      const int total = 16 + 16 * 33;
      while (true) {
        if (tid == 0) s_unit = atomicAdd(&CTR[l * 8 + xcd], 1);
        __syncthreads();
        int u = s_unit;
        __syncthreads();
        if (u >= total) break;
        if (u < 16) scan_unit(p, l, xcd * 16 + u, smem, tid);
        else {
          int v = u - 16;
          int g = v / 66, w = v - g * 66;
          attn_unit(p, xcd * 16 + g * 2 + (w & 1), 32 - (w >> 1), smem, tid);
        }
        __syncthreads();
      }
    }
    }
    if (kph == 4) {
    PHASE_TID
    for (int it_ = 0; it_ * nblk < 257 * 16; it_++) {
      int mt, nt;
      if (!map_tile(it_, nblk, 257, 16, mt, nt)) continue;
      f32x4 acc[8][2];
      unsigned sg[8][2][2];
      ADma alh = ADma{(mt < 255) ? HB1 : HB2, 1024, (mt < 255) ? mt * 256 : mt * 256 - HB_SPLIT, 0, ZERO, 0};
      zero_acc8(acc);
      const int tid1 = launder(tid);
      gemm3(acc, alh, WL + W_G, 1024, nt * 64, 1024, smem, tid1);
#pragma unroll
      for (int mi = 0; mi < 8; mi++)
#pragma unroll
        for (int ni = 0; ni < 2; ni++) {
          sg[mi][ni][0] = pk2(sigmoidf_(acc[mi][ni][0]), sigmoidf_(acc[mi][ni][1]));
          sg[mi][ni][1] = pk2(sigmoidf_(acc[mi][ni][2]), sigmoidf_(acc[mi][ni][3]));
        }
      zero_acc8(acc);
      {
        ADma aly{YR, 512, mt * 256, 0, ZERO, 0};
        const int tid2 = launder(tid);
      gemm3(acc, aly, WL + W_PR, 512, nt * 64, 512, smem, tid2);
      }
{ const int tidq = launder(tid); const int lane = tidq & 63, wave = tidq >> 6; ACC_COORDS
#pragma unroll
      for (int mi = 0; mi < 8; mi++)
#pragma unroll
        for (int ni = 0; ni < 2; ni++) {
          int col = nt * 64 + wc * 32 + ni * 16 + fr;
          int row = mt * 256 + wr * 128 + mi * 16 + fq * 4;
          MIX[(size_t)(row + 0) * 1024 + col] = f2bf(bflo(sg[mi][ni][0]) * acc[mi][ni][0]);
          MIX[(size_t)(row + 1) * 1024 + col] = f2bf(bfhi(sg[mi][ni][0]) * acc[mi][ni][1]);
          MIX[(size_t)(row + 2) * 1024 + col] = f2bf(bflo(sg[mi][ni][1]) * acc[mi][ni][2]);
          MIX[(size_t)(row + 3) * 1024 + col] = f2bf(bfhi(sg[mi][ni][1]) * acc[mi][ni][3]);
        }
      }
      zero_acc8(acc);
      const int tid3 = launder(tid);
      gemm3(acc, alh, WL + W_G, 1024, 1024 + nt * 64, 1024, smem, tid3);
#pragma unroll
      for (int mi = 0; mi < 8; mi++)
#pragma unroll
        for (int ni = 0; ni < 2; ni++) {
          sg[mi][ni][0] = pk2(sigmoidf_(acc[mi][ni][0]), sigmoidf_(acc[mi][ni][1]));
          sg[mi][ni][1] = pk2(sigmoidf_(acc[mi][ni][2]), sigmoidf_(acc[mi][ni][3]));
        }
      zero_acc8(acc);
      {
        ADma alm{P + PMLA_, PC_, mt * 256, 0, ZERO, 0};
        const int tid4 = launder(tid);
      gemm3(acc, alm, WL + W_PM, 512, nt * 64, 512, smem, tid4);
      }
{ const int tidq = launder(tid); const int lane = tidq & 63, wave = tidq >> 6; ACC_COORDS
#pragma unroll
      for (int mi = 0; mi < 8; mi++)
#pragma unroll
        for (int ni = 0; ni < 2; ni++) {
          int col = nt * 64 + wc * 32 + ni * 16 + fr;
          int row = mt * 256 + wr * 128 + mi * 16 + fq * 4;
          float o0 = bf2f(MIX[(size_t)(row + 0) * 1024 + col]) + bflo(sg[mi][ni][0]) * acc[mi][ni][0];
          float o1 = bf2f(MIX[(size_t)(row + 1) * 1024 + col]) + bfhi(sg[mi][ni][0]) * acc[mi][ni][1];
          float o2 = bf2f(MIX[(size_t)(row + 2) * 1024 + col]) + bflo(sg[mi][ni][1]) * acc[mi][ni][2];
          float o3 = bf2f(MIX[(size_t)(row + 3) * 1024 + col]) + bfhi(sg[mi][ni][1]) * acc[mi][ni][3];
          MIX[(size_t)(row + 0) * 1024 + col] = f2bf(o0);
          MIX[(size_t)(row + 1) * 1024 + col] = f2bf(o1);
          MIX[(size_t)(row + 2) * 1024 + col] = f2bf(o2);
          MIX[(size_t)(row + 3) * 1024 + col] = f2bf(o3);
        }
      }
    }
    }
    if (kph == 5) {
    PHASE_TID
    for (int prb_ = (PROBE_FI ? 0 : 1); prb_ < 2; prb_++)
    for (int it_ = 0; it_ * nblk < 257 * 8; it_++) {
      int mt, nt;
      if (!map_tile(it_, nblk, 257, 8, mt, nt)) continue;
      f32x4 acc[8][4];
      zero_acc8(acc);
      ACC_COORDS
      ADma al{MIX, 1024, mt * 256, 0, ZERO, 0};
      gemm3(acc, al, WL + W_OUT, 1024, nt * 128, 1024, smem, tid);
#pragma unroll
      for (int mi = 0; mi < 8; mi++)
#pragma unroll
        for (int ni = 0; ni < 4; ni++) {
          int col = nt * 128 + wc * 64 + ni * 16 + fr;
#pragma unroll
          for (int j = 0; j < 4; j++) {
            int row = mt * 256 + wr * 128 + mi * 16 + fq * 4 + j;
            float* hp = H + (size_t)row * 1024 + col;
            float* dp = (prb_ == 0) ? (p.out + (size_t)(row & 65535) * 1024 + col) : hp;
            *dp = ALPHA_ * (*hp) + acc[mi][ni][j];
          }
        }
    }
    }
    if (kph == 6) {
    PHASE_TID
    for (int row = blockIdx.x * 4 + wave; row < M_; row += nblk * 4)
      ln_row(H + (size_t)row * 1024, p.in[24] + l * 1024, p.in[25] + l * 1024, H + (size_t)row * 1024, lane, HBH + (size_t)row * 1024);
    }
    if (kph == 7) {
    PHASE_TID
    {
      const float* cw = p.in[27] + (size_t)l * 3 * 5632;
      const float* cb = p.in[28] + (size_t)l * 5632;
      for (int it_ = 0; it_ * nblk < 272 * 44; it_++) {
        int rest, nt;
        if (!map_tile(it_, nblk, 272, 44, rest, nt)) continue;
        int it = rest % 17, b = rest / 17;
        int t0 = 254 * it - 2;
        f32x4 acc[8][4];
        zero_acc8(acc);
        ADma al{HBH, 1024, b * T_, t0, ZERO, 1, p.ws};
        gemm3(acc, al, WL + W_UP, 1024, nt * 128, 1024, smem, tid);
        ACC_COORDS
        float(*ut)[132] = (float(*)[132])smem;
        const int tidh = launder(tid);
        const int c = tidh & 63, rg = tidh >> 6;
        const int gcol = nt * 64 + c, vcol = DFF_ + nt * 64 + c;
        const float g0 = cw[gcol], g1 = cw[5632 + gcol], g2 = cw[2 * 5632 + gcol], gb = cb[gcol];
        const float v0 = cw[vcol], v1 = cw[5632 + vcol], v2 = cw[2 * 5632 + vcol], vb = cb[vcol];
#pragma unroll 1
        for (int half = 0; half < 2; half++) {
          float carry = 0.f;
          if (half == 1) carry = ut[126 + (tid >> 7)][tid & 127];
          __syncthreads();
          if (half == 1) ut[tid >> 7][tid & 127] = carry;
          if (wr == half) {
#pragma unroll
            for (int mi = 0; mi < 8; mi++)
#pragma unroll
              for (int ni = 0; ni < 4; ni++)
#pragma unroll
                for (int j = 0; j < 4; j++) ut[half * 2 + mi * 16 + fq * 4 + j][wc * 64 + ni * 16 + fr] = acc[mi][ni][j];
          }
          __syncthreads();
          const int nq = half ? 130 : 128;
          int qs = 2 + rg * 32, qe = min(qs + 32, nq);
          float ga = ut[qs - 2][c], gbp = ut[qs - 1][c];
          float va = ut[qs - 2][64 + c], vbp = ut[qs - 1][64 + c];
          for (int q = qs; q < qe; q++) {
            float gc = ut[q][c], vc = ut[q][64 + c];
            int t = t0 + half * 126 + q;
            if (t < T_) {
              float gate = g0 * ga + g1 * gbp + g2 * gc + gb;
              float val = v0 * va + v1 * vbp + v2 * vc + vb;
              float av = gate * sigmoidf_(gate) * val;
              ACT[(size_t)(b * T_ + t) * DFF_ + gcol] = f2bf(av);
            }
            ga = gbp; gbp = gc; va = vbp; vbp = vc;
          }
        }
        __syncthreads();
      }
    }
    }
    if (kph == 8) {
    PHASE_TID
    for (int prb_ = (PROBE_FI ? 0 : 1); prb_ < 2; prb_++)
    for (int it_ = 0; it_ * nblk < 257 * 8; it_++) {
      int mt, nt;
      if (!map_tile(it_, nblk, 257, 8, mt, nt)) continue;
      f32x4 acc[8][4];
      zero_acc8(acc);
      ACC_COORDS
      ADma al{ACT, DFF_, mt * 256, 0, ZERO, 0};
      gemm3(acc, al, WL + W_DN, DFF_, nt * 128, DFF_, smem, tid);
#pragma unroll
      for (int mi = 0; mi < 8; mi++)
#pragma unroll
        for (int ni = 0; ni < 4; ni++) {
          int col = nt * 128 + wc * 64 + ni * 16 + fr;
#pragma unroll
          for (int j = 0; j < 4; j++) {
            int row = mt * 256 + wr * 128 + mi * 16 + fq * 4 + j;
            float* hp = H + (size_t)row * 1024 + col;
            float* dp = (prb_ == 0) ? (p.out + (size_t)(row & 65535) * 1024 + col) : hp;
            *dp = ALPHA_ * (*hp) + acc[mi][ni][j];
          }
        }
    }
    }
    if (kph == 9) {
    PHASE_TID
    if (l == 0) {
      for (int row = blockIdx.x * 4 + wave; row < M_; row += nblk * 4)
        ln_row(H + (size_t)row * 1024, p.in[30], p.in[31], H + (size_t)row * 1024, lane, (row < HB_SPLIT) ? HB1 + (size_t)row * 1024 : HB2 + (size_t)(row - HB_SPLIT) * 1024);
    } else {
      for (int row = blockIdx.x * 4 + wave; row < M_; row += nblk * 4) {
        int b = row / T_, t = row % T_;
        if (t >= NMETA_)
          ln_row(H + (size_t)row * 1024, p.in[30] + 1024, p.in[31] + 1024, p.out + ((size_t)b * SEQ_ + (t - NMETA_)) * 1024, lane);
      }
    }
    }
    if (ph_ != 19) XB_SYNC();
  }
}

extern "C" void kernel_launch(void* const* d_in, const int* in_sizes, int n_in, void* d_out, int out_size, void* d_ws,
                              size_t ws_size, hipStream_t stream) {
  static int grid_blocks = 0;
  if (!grid_blocks) {
    int dev = 0, cus = 0, per_cu = 0;
    hipGetDevice(&dev);
    hipDeviceGetAttribute(&cus, hipDeviceAttributeMultiprocessorCount, dev);
    hipOccupancyMaxActiveBlocksPerMultiprocessor(&per_cu, mega, 256, 0);
    if (per_cu > 2) per_cu = 2;
    grid_blocks = cus * per_cu;
  }
  if (ws_size < WS_TOTAL) fprintf(stderr, "workspace too small: %zu < %zu\n", ws_size, (size_t)WS_TOTAL);
  Params p;
  memset(&p, 0, sizeof(p));
  for (int i = 0; i < 32; i++) p.in[i] = (const float*)d_in[i];
  p.out = (float*)d_out;
  p.ws = (char*)d_ws;
  u16* wb = (u16*)((char*)d_ws + OFF_W);
  int nj = 0, tiles = 0;
  auto add = [&](const float* src, size_t dst_off, int ld, int c0, int K, int Kpad, int Nv, int Np, int mode) {
    Job& j = p.jobs[nj++];
    j.src = src; j.dst = wb + dst_off; j.ld = ld; j.c0 = c0; j.K = K; j.Kpad = Kpad; j.Nv = Nv; j.Np = Np; j.mode = mode;
    j.tile0 = tiles;
    tiles += (Kpad / 32) * (Np / 32);
  };
  for (int l = 0; l < 2; l++) {
    size_t o = (size_t)l * W_LAYER;
    const float* w_in = (const float*)d_in[4] + (size_t)l * 1024 * 4416;
    add(w_in, o + W_IN, 4416, 0, 1024, 1024, 2368, 2432, 0);
    add(w_in, o + W_G, 4416, 2368, 1024, 1024, 2048, 2048, 0);
    add((const float*)d_in[7] + (size_t)l * 64 * 512, o + W_LW, 512, 0, 64, 64, 512, 512, 0);
    add((const float*)d_in[9] + (size_t)l * 64 * 512, o + W_LA, 512, 0, 64, 64, 512, 512, 0);
    add((const float*)d_in[10] + (size_t)l * 160 * 512, o + W_LG, 512, 0, 160, 192, 512, 512, 0);
    add((const float*)d_in[17] + (size_t)l * 256 * 768, o + W_UQ, 768, 0, 256, 256, 768, 768, 0);
    add((const float*)d_in[19] + (size_t)l * 256 * 512, o + W_UK, 512, 0, 256, 256, 512, 512, 0);
    add((const float*)d_in[20] + (size_t)l * 256 * 512, o + W_UV, 512, 0, 256, 256, 512, 512, 0);
    add((const float*)d_in[21] + (size_t)l * 512 * 1024, o + W_PR, 1024, 0, 512, 512, 1024, 1024, 0);
    add((const float*)d_in[22] + (size_t)l * 512 * 1024, o + W_PM, 1024, 0, 512, 512, 1024, 1024, 0);
    add((const float*)d_in[23] + (size_t)l * 1024 * 1024, o + W_OUT, 1024, 0, 1024, 1024, 1024, 1024, 0);
    add((const float*)d_in[26] + (size_t)l * 1024 * 5632, o + W_UP, 5632, 0, 1024, 1024, 5632, 5632, 1);
    add((const float*)d_in[29] + (size_t)l * 2816 * 1024, o + W_DN, 1024, 0, 2816, 2816, 1024, 1024, 0);
  }
  p.nconv = tiles;
  hipMemsetAsync((char*)d_ws + OFF_BAR, 0, 16384, stream);
  void* args[] = {&p};
  hipError_t e = hipLaunchCooperativeKernel((void*)mega, dim3(grid_blocks), dim3(256), args, 0, stream);
  if (e != hipSuccess) fprintf(stderr, "cooperative launch failed: %s (grid %d)\n", hipGetErrorString(e), grid_blocks);
}
```

```cpp
#include <hip/hip_runtime.h>
#include <hip/hip_cooperative_groups.h>
#include <cstdio>
#include <cstring>
namespace cg = cooperative_groups;

#ifndef PHMASK
#define PHMASK 0xFFFF
#endif
#ifndef PROBE_HOT
#define PROBE_HOT 0
#endif
#ifndef PROBE_FI
#define PROBE_FI 0
#endif
#ifndef REPMASK
#define REPMASK 0
#endif
typedef unsigned short u16;
using bf16x8 = __attribute__((ext_vector_type(8))) short;
using f32x4 = __attribute__((ext_vector_type(4))) float;

constexpr int B_ = 16, SEQ_ = 4096, NMETA_ = 16, T_ = 4112, M_ = B_ * T_, D_ = 1024;
constexpr int PC_ = 2368;
constexpr int PMLA_ = 1824, PKV_ = 2080, PKR_ = 2336;
constexpr int DFF_ = 2816;
constexpr float ALPHA_ = 1.4142135623730951f;

constexpr size_t OFF_H = 0;
constexpr size_t OFF_P = OFF_H + (size_t)M_ * 1024 * 4;
constexpr size_t OFF_DEC = OFF_P + (size_t)M_ * PC_ * 2;
constexpr size_t OFF_AA = OFF_DEC + (size_t)M_ * 512 * 4;
constexpr size_t OFF_GG = OFF_AA + (size_t)M_ * 512 * 2;
constexpr size_t OFF_Q = OFF_GG + (size_t)M_ * 512 * 2;
constexpr size_t OFF_W = OFF_Q + (size_t)M_ * 768 * 2;
constexpr size_t W_IN = 0;
constexpr size_t W_G = W_IN + (size_t)2432 * 1024;
constexpr size_t W_LW = W_G + (size_t)2048 * 1024;
constexpr size_t W_LA = W_LW + (size_t)512 * 64;
constexpr size_t W_LG = W_LA + (size_t)512 * 64;
constexpr size_t W_UQ = W_LG + (size_t)512 * 192;
constexpr size_t W_UK = W_UQ + (size_t)768 * 256;
constexpr size_t W_UV = W_UK + (size_t)512 * 256;
constexpr size_t W_PR = W_UV + (size_t)512 * 256;
constexpr size_t W_PM = W_PR + (size_t)1024 * 512;
constexpr size_t W_OUT = W_PM + (size_t)1024 * 512;
constexpr size_t W_UP = W_OUT + (size_t)1024 * 1024;
constexpr size_t W_DN = W_UP + (size_t)5632 * 1024;
constexpr size_t W_LAYER = W_DN + (size_t)1024 * 2816;
constexpr size_t OFF_ROPE = OFF_W + 2 * W_LAYER * 2;
constexpr size_t OFF_CTR = OFF_ROPE + (size_t)T_ * 16 * 8;
constexpr size_t OFF_ZERO = OFF_CTR + 256;
constexpr size_t OFF_BAR = OFF_ZERO + 8192;
constexpr size_t OFF_HB2 = OFF_BAR + 16384;
constexpr size_t WS_TOTAL = OFF_HB2 + (size_t)512 * 1024 * 2;
constexpr int HB_SPLIT = 65280;

struct Job { const float* src; u16* dst; int ld, c0, K, Kpad, Nv, Np, mode, tile0; };
struct Params {
  const float* in[32];
  float* out;
  char* ws;
  Job jobs[26];
  int nconv;
  int pad0;
};

__constant__ double ROPE_C[16] = {0.15915494309189535, 0.08949940160889101, 0.050329212104487035, 0.0283021958306234,
                                  0.015915494309189534, 0.008949940160889102, 0.005032921210448704, 0.00283021958306234,
                                  0.0015915494309189536, 0.0008949940160889102, 0.0005032921210448703, 0.00028302195830623395,
                                  0.00015915494309189535, 8.949940160889102e-05, 5.0329212104487035e-05, 2.8302195830623396e-05};

__device__ __forceinline__ int launder(int x) { asm volatile("" : "+v"(x)); return x; }
typedef __bf16 bf16x2_t __attribute__((ext_vector_type(2)));
typedef float f32x2_t __attribute__((ext_vector_type(2)));
__device__ __forceinline__ unsigned pk2(float a, float b) {
  f32x2_t v = {a, b};
  bf16x2_t r = __builtin_convertvector(v, bf16x2_t);
  return *(unsigned*)&r;
}
__device__ __forceinline__ u16 f2bf(float f) { return (u16)(pk2(f, 0.f) & 0xffffu); }
__device__ __forceinline__ float bf2f(unsigned h) { return __uint_as_float(h << 16); }
__device__ __forceinline__ float bflo(unsigned w) { return __uint_as_float(w << 16); }
__device__ __forceinline__ float bfhi(unsigned w) { return __uint_as_float(w & 0xffff0000u); }
__device__ __forceinline__ float sigmoidf_(float x) { return 1.0f / (1.0f + __expf(-x)); }

__device__ __forceinline__ int fresh_lane() { int x; asm volatile("v_mbcnt_lo_u32_b32 %0, -1, 0\n\tv_mbcnt_hi_u32_b32 %0, -1, %0" : "=v"(x)); return x; }
#define PHASE_TID const int tid = wave0 * 64 + fresh_lane(); const int lane = tid & 63, wave = tid >> 6; (void)lane; (void)wave;
template <int CTRL>
__device__ __forceinline__ float dppf(float x) {
  return __int_as_float(__builtin_amdgcn_update_dpp(0, __float_as_int(x), CTRL, 0xF, 0xF, true));
}
__device__ __forceinline__ float sum8(float x) {
  x += dppf<0xB1>(x);
  x += dppf<0x4E>(x);
  x += dppf<0x141>(x);
  return x;
}
__device__ __forceinline__ float sum16(float x) {
  x = sum8(x);
  x += dppf<0x140>(x);
  return x;
}
__device__ __forceinline__ float shx(float x, int lane, int o) {
  return __int_as_float(__builtin_amdgcn_ds_bpermute((lane ^ o) << 2, __float_as_int(x)));
}
__device__ __forceinline__ float wave_sum(float x, int lane) {
  x = sum16(x);
  x += shx(x, lane, 16);
  x += shx(x, lane, 32);
  return x;
}

constexpr int BM = 128, BN = 128, BK = 64, LDT = 64;
constexpr int SMEM_BYTES = 73728;

template <int MODE>
struct AL {
  const void* base;
  int ld;
  int row0;
  int t0;
  int kvalid;
  const float* mu;
  int fn;
  struct Raw { uint4 x, y; };
  __device__ __forceinline__ Raw fetch(int r, int k) const {
    Raw w;
    { unsigned z = (MODE == 3) ? (unsigned)launder(0) : 0u; w.x = make_uint4(z, z, z, z); w.y = w.x; }
    if (MODE == 0) {
      const float* p = (const float*)base + (size_t)(row0 + r) * ld + k;
      w.x = *(const uint4*)p;
      w.y = *(const uint4*)(p + 4);
    } else if (MODE == 1) {
      const u16* p = (const u16*)base + (size_t)(row0 + r) * ld + k;
      w.x = *(const uint4*)p;
    } else if (MODE == 4) {
      const float* p = (const float*)base + (size_t)(row0 + r) * ld + k;
      float4 a = *(const float4*)p, b = *(const float4*)(p + 4);
      w.x = make_uint4(pk2(a.x, a.y), pk2(a.z, a.w), pk2(b.x, b.y), pk2(b.z, b.w));
    } else if (MODE == 2) {
      int t = t0 + r;
      if (t >= 0 && t < T_) {
        const float* p = (const float*)base + (size_t)(row0 + t) * ld + k;
        w.x = *(const uint4*)p;
        w.y = *(const uint4*)(p + 4);
      }
    } else {
      int row = row0 + r;
      int t = row % T_;
      if (k < kvalid) {
        const u16* p = (const u16*)base + (size_t)row * ld + k;
        w.x = *(const uint4*)p;
        if (t > 0) w.y = *(const uint4*)(p - ld);
      }
    }
    return w;
  }
  __device__ __forceinline__ uint4 cvt(const Raw& w, int k) const {
    if (MODE == 0 || MODE == 2) {
      uint4 o;
      o.x = pk2(__uint_as_float(w.x.x), __uint_as_float(w.x.y));
      o.y = pk2(__uint_as_float(w.x.z), __uint_as_float(w.x.w));
      o.z = pk2(__uint_as_float(w.y.x), __uint_as_float(w.y.y));
      o.w = pk2(__uint_as_float(w.y.z), __uint_as_float(w.y.w));
      return o;
    } else if (MODE == 1 || MODE == 4) {
      return w.x;
    } else {
      if (k >= kvalid) { unsigned z = (unsigned)launder(0); return make_uint4(z, z, z, z); }
      unsigned cw[4] = {w.x.x, w.x.y, w.x.z, w.x.w};
      unsigned pw[4] = {w.y.x, w.y.y, w.y.z, w.y.w};
      unsigned ow[4];
#pragma unroll
      for (int e = 0; e < 4; e++) {
        float x0 = bflo(cw[e]), x1 = bfhi(cw[e]);
        float p0 = bflo(pw[e]), p1 = bfhi(pw[e]);
        float v0 = x0 + (p0 - x0) * mu[k + 2 * e];
        float v1 = x1 + (p1 - x1) * mu[k + 2 * e + 1];
        if (fn == 0) {
          v0 = 1.0f - 2.0f / (__expf(2.0f * v0) + 1.0f);
          v1 = 1.0f - 2.0f / (__expf(2.0f * v1) + 1.0f);
        } else if (fn == 2) {
          v0 = sigmoidf_(v0);
          v1 = sigmoidf_(v1);
        }
        ow[e] = pk2(v0, v1);
      }
      return make_uint4(ow[0], ow[1], ow[2], ow[3]);
    }
  }
};

template <int NI>
__device__ __forceinline__ void zero_acc(f32x4 (&acc)[4][NI]) {
#pragma unroll
  for (int i = 0; i < 4; i++)
#pragma unroll
    for (int j = 0; j < NI; j++) acc[i][j] = f32x4{0.f, 0.f, 0.f, 0.f};
}

#define REP4(X) X(0) X(1) X(2) X(3)
template <class ALT, int NI>
__device__ __forceinline__ void gemm_loop(f32x4 (&acc)[4][NI], const ALT& al, const u16* __restrict__ Bt, int ldb, int n0,
                                          int K, char* smem, const int tid) {
  const int lane = tid & 63, wave = tid >> 6;
  const int wr = wave >> 1, wc = wave & 1, fr = lane & 15, fq = lane >> 4;
  const int lr = tid >> 3, lk = (tid & 7) * 8, lsw = ((tid & 7) ^ (lr & 7)) * 8;
  u16* sa = (u16*)smem;
  u16* sb = sa + 2 * BM * LDT;
  typename ALT::Raw ra0, ra1, ra2, ra3;
  uint4 rb0 = make_uint4(0,0,0,0), rb1 = rb0, rb2 = rb0, rb3 = rb0;
  const u16* bp = Bt + (size_t)(n0 + lr) * ldb + lk;
#define GL_FETCH(i) ra##i = al.fetch(lr + 32 * i, kf); if (i < NI) rb##i = *(const uint4*)(bp + (size_t)(32 * i) * ldb + kb);
#define GL_STORE(i) *(uint4*)(a_ + (lr + 32 * i) * LDT + lsw) = al.cvt(ra##i, kt * BK + lk); if (i < NI) *(uint4*)(b_ + (lr + 32 * i) * LDT + lsw) = rb##i;
  {
    const int kf = lk, kb = 0;
    REP4(GL_FETCH)
  }
  const int nk = K / BK;
  for (int kt = 0; kt < nk; kt++) {
    u16* a_ = sa + (kt & 1) * BM * LDT;
    u16* b_ = sb + (kt & 1) * BN * LDT;
    REP4(GL_STORE)
    __syncthreads();
    if (kt + 1 < nk) {
      const int kf = (kt + 1) * BK + lk, kb = (kt + 1) * BK;
      REP4(GL_FETCH)
    }
#pragma unroll
    for (int ks = 0; ks < 2; ks++) {
      bf16x8 af[4], bf[NI];
#pragma unroll
      for (int i = 0; i < 4; i++) af[i] = *(const bf16x8*)(a_ + (wr * 64 + i * 16 + fr) * LDT + (((ks * 4 + fq) ^ (fr & 7)) * 8));
#pragma unroll
      for (int i = 0; i < NI; i++) bf[i] = *(const bf16x8*)(b_ + (wc * (NI * 16) + i * 16 + fr) * LDT + (((ks * 4 + fq) ^ (fr & 7)) * 8));
#pragma unroll
      for (int mi = 0; mi < 4; mi++)
#pragma unroll
        for (int ni = 0; ni < NI; ni++)
          acc[mi][ni] = __builtin_amdgcn_mfma_f32_16x16x32_bf16(af[mi], bf[ni], acc[mi][ni], 0, 0, 0);
    }
  }
  __syncthreads();
#undef GL_FETCH
#undef GL_STORE
}


struct ADma { const u16* base; int ld; int row0; int t0; const u16* zero; int mode; const char* wsb; };
constexpr int G3_STAGE = 12288;

template <int NI, bool SWAP = true>
__device__ __forceinline__ void gemm3(f32x4 (&acc)[8][NI], const ADma& a, const u16* __restrict__ Bt, int ldb, int n0, int K,
                                      char* smem, const int tid) {
  const int lane = tid & 63, wave = tid >> 6;
  const int wr = wave >> 1, wc = wave & 1, fr = lane & 15, fq = lane >> 4;
  const int kc8 = ((lane & 3) ^ ((4 - (lane >> 4)) & 3)) * 8;
  const int psw = (fq ^ ((4 - (fr >> 2)) & 3)) * 8;
  u16* sm = (u16*)smem;
  const u16* ap0 = nullptr;
  unsigned ao0 = 0, ao1 = 0, ao2 = 0, ao3 = 0;
  if (a.mode == 0) {
    ap0 = a.base + (size_t)(a.row0 + wave * 64 + (lane >> 2)) * a.ld + kc8;
  } else {
    const unsigned bo = (unsigned)((const char*)a.base - a.wsb), zo = (unsigned)((const char*)a.zero - a.wsb) + kc8 * 2;
#define G3_AP(j)                                                                          \
    {                                                                                     \
      int t = a.t0 + wave * 64 + j * 16 + (lane >> 2);                                    \
      ao##j = (t >= 0 && t < T_) ? bo + (unsigned)(((a.row0 + t) * a.ld + kc8) * 2) : zo; \
    }
    REP4(G3_AP)
#undef G3_AP
  }
  const u16* bp0 = Bt + (size_t)(n0 + wave * (8 * NI) + (lane >> 2)) * ldb + kc8;
  const size_t astep = (size_t)16 * a.ld;
  const size_t bstep = (size_t)16 * ldb;
#define G3_ISSUE(j)                                                                                                              \
  __builtin_amdgcn_global_load_lds((a.mode == 0) ? (const unsigned*)(ap0 + j * astep + kof) : (const unsigned*)(a.wsb + ao##j + kof * 2), (unsigned*)(st_ + (wave * 64 + j * 16) * 32 + lane * 8), 16, 0, 0); \
  if (2 * j < NI) __builtin_amdgcn_global_load_lds((const unsigned*)(bp0 + j * bstep + kof), (unsigned*)(st_ + 8192 + (wave * (8 * NI) + j * 16) * 32 + lane * 8), 16, 0, 0);
  const int nk = K / 32;
  asm volatile("s_waitcnt vmcnt(0)" ::: "memory");
  {
    const int kof = 0;
    u16* st_ = sm;
    REP4(G3_ISSUE)
  }
  if (nk > 1) {
    const int kof = 32;
    u16* st_ = sm + G3_STAGE;
    REP4(G3_ISSUE)
  }
  int cur = 0, nxt = 2;
  const unsigned lds0 = (unsigned)(size_t)(__attribute__((address_space(3))) char*)smem;
  const unsigned aoff = lds0 + (unsigned)(((wr * 128 + fr) * 32 + psw) * 2);
  const unsigned boff = lds0 + 16384u + (unsigned)(((wc * (NI * 16) + fr) * 32 + psw) * 2);
#define G3_DSR(dst, addr, off) asm volatile("ds_read_b128 %0, %1 offset:" #off : "=v"(dst) : "v"(addr))
  for (int kt = 0; kt < nk; kt++) {
    if (kt + 1 < nk) {
      if (NI == 4) asm volatile("s_waitcnt vmcnt(6)" ::: "memory");
      else asm volatile("s_waitcnt vmcnt(5)" ::: "memory");
    } else {
      asm volatile("s_waitcnt vmcnt(0)" ::: "memory");
    }
    __builtin_amdgcn_s_barrier();
    if (kt + 2 < nk) {
      const int kof = (kt + 2) * 32;
      u16* st_ = sm + nxt * G3_STAGE;
      REP4(G3_ISSUE)
    }
    const unsigned aaddr = aoff + (unsigned)cur * (G3_STAGE * 2);
    const unsigned baddr = boff + (unsigned)cur * (G3_STAGE * 2);
    bf16x8 af[8], bf[NI];
    G3_DSR(af[0], aaddr, 0); G3_DSR(af[1], aaddr, 1024); G3_DSR(af[2], aaddr, 2048); G3_DSR(af[3], aaddr, 3072);
    G3_DSR(bf[0], baddr, 0); G3_DSR(bf[1], baddr, 1024);
    if (NI == 4) { G3_DSR(bf[NI - 2], baddr, 2048); G3_DSR(bf[NI - 1], baddr, 3072); }
    G3_DSR(af[4], aaddr, 4096); G3_DSR(af[5], aaddr, 5120); G3_DSR(af[6], aaddr, 6144); G3_DSR(af[7], aaddr, 7168);
    if (NI == 4) {
      asm volatile("s_waitcnt lgkmcnt(4)"
                   : "+v"(af[0]), "+v"(af[1]), "+v"(af[2]), "+v"(af[3]), "+v"(bf[0]), "+v"(bf[1]), "+v"(bf[NI - 2]), "+v"(bf[NI - 1]));
    } else {
      asm volatile("s_waitcnt lgkmcnt(4)" : "+v"(af[0]), "+v"(af[1]), "+v"(af[2]), "+v"(af[3]), "+v"(bf[0]), "+v"(bf[1]));
    }
#pragma unroll
    for (int mi = 0; mi < 4; mi++)
#pragma unroll
      for (int ni = 0; ni < NI; ni++)
        acc[mi][ni] = SWAP ? __builtin_amdgcn_mfma_f32_16x16x32_bf16(bf[ni], af[mi], acc[mi][ni], 0, 0, 0)
                           : __builtin_amdgcn_mfma_f32_16x16x32_bf16(af[mi], bf[ni], acc[mi][ni], 0, 0, 0);
    asm volatile("s_waitcnt lgkmcnt(0)" : "+v"(af[4]), "+v"(af[5]), "+v"(af[6]), "+v"(af[7]));
#pragma unroll
    for (int mi = 4; mi < 8; mi++)
#pragma unroll
      for (int ni = 0; ni < NI; ni++)
        acc[mi][ni] = SWAP ? __builtin_amdgcn_mfma_f32_16x16x32_bf16(bf[ni], af[mi], acc[mi][ni], 0, 0, 0)
                           : __builtin_amdgcn_mfma_f32_16x16x32_bf16(af[mi], bf[ni], acc[mi][ni], 0, 0, 0);
    cur = (cur == 2) ? 0 : cur + 1;
    nxt = (nxt == 2) ? 0 : nxt + 1;
  }
  asm volatile("s_waitcnt lgkmcnt(0)" ::: "memory");
  __syncthreads();
#undef G3_DSR
#undef G3_ISSUE
}

template <int NI>
__device__ __forceinline__ void zero_acc8(f32x4 (&acc)[8][NI]) {
#pragma unroll
  for (int i = 0; i < 8; i++)
#pragma unroll
    for (int j = 0; j < NI; j++) acc[i][j] = f32x4{0.f, 0.f, 0.f, 0.f};
}


__device__ __forceinline__ bool map_tile(int i, int nblk, int MT, int NT, int& mt, int& nt) {
  const int locs = nblk >> 3;
  const int xcd = blockIdx.x & 7, loc = blockIdx.x >> 3;
  const int q = (i * 8 + xcd) * locs + loc;
  if (q >= MT * NT) return false;
  const int nfull = NT >> 3, per = MT * 8;
  if (q < nfull * per) {
    int pp = q / per, r = q - pp * per;
    mt = r >> 3;
    nt = pp * 8 + (r & 7);
  } else {
    int r = q - nfull * per;
    int w = NT - nfull * 8;
    mt = r / w;
    nt = nfull * 8 + (r - mt * w);
  }
  return true;
}

#define ACC_COORDS const int wr = wave >> 1, wc = wave & 1, fr = lane & 15, fq = lane >> 4;

__device__ __forceinline__ void conv_tile(const Params& p, int t, char* smem, const int tid) {
  int j = 0;
#pragma unroll 1
  for (int i = 1; i < 26; i++)
    if (t >= p.jobs[i].tile0) j = i;
  const Job& jb = p.jobs[j];
  float(*tile)[33] = (float(*)[33])smem;
  int local = t - jb.tile0;
  int nkt = jb.Kpad >> 5;
  int kt = local % nkt, nt = local / nkt;
  int tx = tid & 31, ty = tid >> 5;
  int n = nt * 32 + tx;
  int col;
  if (jb.mode == 0) col = jb.c0 + n;
  else { int jn = n >> 7, i = n & 127; col = (i < 64) ? (64 * jn + i) : (DFF_ + 64 * jn + (i - 64)); }
#pragma unroll
  for (int i = 0; i < 4; i++) {
    int k = kt * 32 + ty + 8 * i;
    float v = 0.f;
    if (k < jb.K && n < jb.Nv) v = jb.src[(size_t)k * jb.ld + col];
    tile[ty + 8 * i][tx] = v;
  }
  __syncthreads();
#pragma unroll
  for (int i = 0; i < 4; i++) {
    int nn = nt * 32 + ty + 8 * i;
    int k = kt * 32 + tx;
    jb.dst[(size_t)nn * jb.Kpad + k] = f2bf(tile[tx][ty + 8 * i]);
  }
  __syncthreads();
}

__device__ __forceinline__ void ln_row(const float* __restrict__ src, const float* __restrict__ g,
                                       const float* __restrict__ b, float* __restrict__ dst, int lane, u16* __restrict__ dstb = nullptr) {
  float4 v[4];
  float s = 0.f;
#pragma unroll
  for (int i = 0; i < 4; i++) {
    v[i] = *(const float4*)(src + i * 256 + lane * 4);
    s += v[i].x + v[i].y + v[i].z + v[i].w;
  }
  float mean = wave_sum(s, lane) * (1.0f / 1024.0f);
  float q = 0.f;
#pragma unroll
  for (int i = 0; i < 4; i++) {
    float a = v[i].x - mean, b2 = v[i].y - mean, c = v[i].z - mean, d = v[i].w - mean;
    q += a * a + b2 * b2 + c * c + d * d;
  }
  float rstd = rsqrtf(wave_sum(q, lane) * (1.0f / 1024.0f) + 1e-5f);
#pragma unroll
  for (int i = 0; i < 4; i++) {
    float4 gg = *(const float4*)(g + i * 256 + lane * 4);
    float4 bb = *(const float4*)(b + i * 256 + lane * 4);
    float4 o;
    o.x = (v[i].x - mean) * rstd * gg.x + bb.x;
    o.y = (v[i].y - mean) * rstd * gg.y + bb.y;
    o.z = (v[i].z - mean) * rstd * gg.z + bb.z;
    o.w = (v[i].w - mean) * rstd * gg.w + bb.w;
    *(float4*)(dst + i * 256 + lane * 4) = o;
    if (dstb) *(uint2*)(dstb + i * 256 + lane * 4) = make_uint2(pk2(o.x, o.y), pk2(o.z, o.w));
  }
}

__device__ __forceinline__ void ln_row2(const float* __restrict__ srcA, const float* __restrict__ srcB, const float* __restrict__ g,
                                        const float* __restrict__ b, float* dstA, float* dstB, int lane, u16* dbA, u16* dbB) {
  float4 va[4], vb[4];
  float sa = 0.f, sb = 0.f;
#pragma unroll
  for (int i = 0; i < 4; i++) {
    va[i] = *(const float4*)(srcA + i * 256 + lane * 4);
    vb[i] = *(const float4*)(srcB + i * 256 + lane * 4);
  }
#pragma unroll
  for (int i = 0; i < 4; i++) {
    sa += va[i].x + va[i].y + va[i].z + va[i].w;
    sb += vb[i].x + vb[i].y + vb[i].z + vb[i].w;
  }
  const float ma = wave_sum(sa, lane) * (1.0f / 1024.0f), mb = wave_sum(sb, lane) * (1.0f / 1024.0f);
  float qa = 0.f, qb = 0.f;
#pragma unroll
  for (int i = 0; i < 4; i++) {
    va[i].x -= ma; va[i].y -= ma; va[i].z -= ma; va[i].w -= ma;
    vb[i].x -= mb; vb[i].y -= mb; vb[i].z -= mb; vb[i].w -= mb;
    qa += va[i].x * va[i].x + va[i].y * va[i].y + va[i].z * va[i].z + va[i].w * va[i].w;
    qb += vb[i].x * vb[i].x + vb[i].y * vb[i].y + vb[i].z * vb[i].z + vb[i].w * vb[i].w;
  }
  const float ra = rsqrtf(wave_sum(qa, lane) * (1.0f / 1024.0f) + 1e-5f), rb = rsqrtf(wave_sum(qb, lane) * (1.0f / 1024.0f) + 1e-5f);
#pragma unroll
  for (int i = 0; i < 4; i++) {
    float4 gg = *(const float4*)(g + i * 256 + lane * 4);
    float4 bb = *(const float4*)(b + i * 256 + lane * 4);
    float4 oa, ob;
    oa.x = va[i].x * ra * gg.x + bb.x; oa.y = va[i].y * ra * gg.y + bb.y; oa.z = va[i].z * ra * gg.z + bb.z; oa.w = va[i].w * ra * gg.w + bb.w;
    ob.x = vb[i].x * rb * gg.x + bb.x; ob.y = vb[i].y * rb * gg.y + bb.y; ob.z = vb[i].z * rb * gg.z + bb.z; ob.w = vb[i].w * rb * gg.w + bb.w;
    *(float4*)(dstA + i * 256 + lane * 4) = oa;
    *(float4*)(dstB + i * 256 + lane * 4) = ob;
    if (dbA) {
      *(uint2*)(dbA + i * 256 + lane * 4) = make_uint2(pk2(oa.x, oa.y), pk2(oa.z, oa.w));
      *(uint2*)(dbB + i * 256 + lane * 4) = make_uint2(pk2(ob.x, ob.y), pk2(ob.z, ob.w));
    }
  }
}

struct ScanIn {
  float kk[16][64], wr[16][64], w[16][64], kt[16][64], kka[16][64], v[16][64], g[16][64];
  float c[16][4];
};
struct ScanRaw { uint2 r, k, v, rp, kp, vp, a, g; float4 dec; };

__device__ __forceinline__ ScanRaw scan_fetch(const u16* __restrict__ P, const float* __restrict__ DEC,
                                              const u16* __restrict__ AA, const u16* __restrict__ GG, int rowbase, int t,
                                              int hc) {
  ScanRaw w;
  size_t row = (size_t)(rowbase + t);
  const u16* pp = P + row * PC_ + hc;
  w.r = *(const uint2*)(pp);
  w.k = *(const uint2*)(pp + 512);
  w.v = *(const uint2*)(pp + 1024);
  if (t > 0) {
    w.rp = *(const uint2*)(pp - PC_);
    w.kp = *(const uint2*)(pp - PC_ + 512);
    w.vp = *(const uint2*)(pp - PC_ + 1024);
  } else {
    w.rp = make_uint2(0, 0); w.kp = make_uint2(0, 0); w.vp = make_uint2(0, 0);
  }
  w.dec = *(const float4*)(DEC + row * 512 + hc);
  w.a = *(const uint2*)(AA + row * 512 + hc);
  w.g = *(const uint2*)(GG + row * 512 + hc);
  return w;
}

__device__ __forceinline__ void unpack4(uint2 u, float (&o)[4]) {
  o[0] = bflo(u.x); o[1] = bfhi(u.x); o[2] = bflo(u.y); o[3] = bfhi(u.y);
}

__device__ __forceinline__ void scan_unit(const Params& p, int l, int bh, char* smem, const int tid) {
  const int lane = tid & 63, wave = tid >> 6;
  const int b = bh >> 3, h = bh & 7;
  const int rowbase = b * T_;
  const u16* P = (const u16*)(p.ws + OFF_P);
  const float* DEC = (const float*)(p.ws + OFF_DEC);
  const u16* AA = (const u16*)(p.ws + OFF_AA);
  const u16* GG = (const u16*)(p.ws + OFF_GG);
  u16* YR = (u16*)(p.ws + OFF_AA);
  ScanIn* in = (ScanIn*)smem;
  float(*ybuf)[64] = (float(*)[64])(smem + 2 * sizeof(ScanIn));
  const int tl = tid >> 4, kq = tid & 15, hc = h * 64 + kq * 4;
  float(*cst)[64] = (float(*)[64])(smem + 2 * sizeof(ScanIn) + 16 * 64 * 4);
  if (tid < 64) {
    const float* mu = p.in[5] + (size_t)l * 1824;
    const int ch = h * 64 + tid;
    cst[0][tid] = mu[ch];
    cst[1][tid] = mu[512 + ch];
    cst[2][tid] = mu[1024 + ch];
    cst[3][tid] = p.in[11][l * 512 + ch];
    float ka_ = p.in[12][l * 512 + ch];
    cst[4][tid] = ka_;
    cst[5][tid] = 1.0f - ka_;
    cst[6][tid] = p.in[13][l * 512 + ch];
    cst[7][tid] = p.in[14][l * 512 + ch];
    cst[8][tid] = p.in[15][l * 512 + ch];
  }
  __syncthreads();
  const int rp = lane >> 3, ks = lane & 7, row0 = wave * 16 + rp * 2;
  typedef float f2s __attribute__((ext_vector_type(2)));
  f2s S2[2][4];
#pragma unroll
  for (int i = 0; i < 2; i++)
#pragma unroll
    for (int e = 0; e < 4; e++) S2[i][e] = f2s{0.f, 0.f};

  auto stage = [&](const ScanRaw& w, ScanIn& dst) {
    float r[4], k[4], v[4], rq[4], kp[4], vp[4], a[4], g[4];
    unpack4(w.r, r); unpack4(w.k, k); unpack4(w.v, v);
    unpack4(w.rp, rq); unpack4(w.kp, kp); unpack4(w.vp, vp);
    unpack4(w.a, a); unpack4(w.g, g);
    float dec[4] = {w.dec.x, w.dec.y, w.dec.z, w.dec.w};
    float mu_r[4], mu_k[4], mu_v[4], kkw[4], kaw[4], omk[4], rkw[4];
    *(float4*)mu_r = *(const float4*)&cst[0][kq * 4]; *(float4*)mu_k = *(const float4*)&cst[1][kq * 4];
    *(float4*)mu_v = *(const float4*)&cst[2][kq * 4]; *(float4*)kkw = *(const float4*)&cst[3][kq * 4];
    *(float4*)kaw = *(const float4*)&cst[4][kq * 4]; *(float4*)omk = *(const float4*)&cst[5][kq * 4];
    *(float4*)rkw = *(const float4*)&cst[6][kq * 4];
    float kkr[4], ss = 0.f;
#pragma unroll
    for (int e = 0; e < 4; e++) {
      r[e] = r[e] + (rq[e] - r[e]) * mu_r[e];
      k[e] = k[e] + (kp[e] - k[e]) * mu_k[e];
      v[e] = v[e] + (vp[e] - v[e]) * mu_v[e];
      kkr[e] = k[e] * kkw[e];
      ss += kkr[e] * kkr[e];
    }
    ss = sum16(ss);
    float inv = 1.0f / fmaxf(sqrtf(ss), 1e-12f);
    float c1 = 0.f, c2 = 0.f, c3 = 0.f;
    float kk[4], ktl[4], kka[4], wr[4];
#pragma unroll
    for (int e = 0; e < 4; e++) {
      kk[e] = kkr[e] * inv;
      ktl[e] = k[e] * fmaf(a[e], kaw[e], omk[e]);
      kka[e] = kk[e] * a[e];
      wr[e] = dec[e] * r[e];
      c1 += kka[e] * r[e];
      c2 += ktl[e] * r[e];
      c3 += r[e] * ktl[e] * rkw[e];
    }
    c1 = sum16(c1); c2 = sum16(c2); c3 = sum16(c3);
    *(float4*)&dst.kk[tl][kq * 4] = make_float4(kk[0], kk[1], kk[2], kk[3]);
    *(float4*)&dst.wr[tl][kq * 4] = make_float4(wr[0], wr[1], wr[2], wr[3]);
    *(float4*)&dst.w[tl][kq * 4] = make_float4(dec[0], dec[1], dec[2], dec[3]);
    *(float4*)&dst.kt[tl][kq * 4] = make_float4(ktl[0], ktl[1], ktl[2], ktl[3]);
    *(float4*)&dst.kka[tl][kq * 4] = make_float4(kka[0], kka[1], kka[2], kka[3]);
    *(float4*)&dst.v[tl][kq * 4] = make_float4(v[0], v[1], v[2], v[3]);
    *(float4*)&dst.g[tl][kq * 4] = make_float4(g[0], g[1], g[2], g[3]);
    if (kq == 0) *(float4*)&dst.c[tl][0] = make_float4(c1, c2, c3, 0.f);
  };

  {
    ScanRaw w0 = scan_fetch(P, DEC, AA, GG, rowbase, tl, hc);
    stage(w0, in[0]);
  }
  __syncthreads();
  constexpr int NCH = T_ / 16;
  for (int c = 0; c < NCH; c++) {
    ScanIn& cur = in[c & 1];
    ScanRaw nx;
    const bool have_next = (c + 1 < NCH);
    if (have_next) nx = scan_fetch(P, DEC, AA, GG, rowbase, (c + 1) * 16 + tl, hc);
    {
      typedef float f2 __attribute__((ext_vector_type(2)));
      struct StepIn { float4 kk0, kk1, wr0, wr1, w0, w1, kt0, kt1, ka0, ka1; float2 vv, cc; };
      auto ldstep = [&](int s) {
        StepIn r;
        r.kk0 = *(const float4*)&cur.kk[s][ks * 8]; r.kk1 = *(const float4*)&cur.kk[s][ks * 8 + 4];
        r.wr0 = *(const float4*)&cur.wr[s][ks * 8]; r.wr1 = *(const float4*)&cur.wr[s][ks * 8 + 4];
        r.w0 = *(const float4*)&cur.w[s][ks * 8];   r.w1 = *(const float4*)&cur.w[s][ks * 8 + 4];
        r.kt0 = *(const float4*)&cur.kt[s][ks * 8]; r.kt1 = *(const float4*)&cur.kt[s][ks * 8 + 4];
        r.ka0 = *(const float4*)&cur.kka[s][ks * 8]; r.ka1 = *(const float4*)&cur.kka[s][ks * 8 + 4];
        r.vv = *(const float2*)&cur.v[s][row0];
        r.cc = *(const float2*)&cur.c[s][0];
        return r;
      };
#pragma unroll 1
      for (int s4 = 0; s4 < 16; s4 += 4) {
      float yv[4][2];
#pragma unroll
      for (int u = 0; u < 4; u++) {
        const int s = s4 + u;
        const StepIn in_ = ldstep(s);
        const f2 kk[4] = {{in_.kk0.x, in_.kk0.y}, {in_.kk0.z, in_.kk0.w}, {in_.kk1.x, in_.kk1.y}, {in_.kk1.z, in_.kk1.w}};
        const f2 wr[4] = {{in_.wr0.x, in_.wr0.y}, {in_.wr0.z, in_.wr0.w}, {in_.wr1.x, in_.wr1.y}, {in_.wr1.z, in_.wr1.w}};
        const f2 w[4] = {{in_.w0.x, in_.w0.y}, {in_.w0.z, in_.w0.w}, {in_.w1.x, in_.w1.y}, {in_.w1.z, in_.w1.w}};
        const f2 kt[4] = {{in_.kt0.x, in_.kt0.y}, {in_.kt0.z, in_.kt0.w}, {in_.kt1.x, in_.kt1.y}, {in_.kt1.z, in_.kt1.w}};
        const f2 ka[4] = {{in_.ka0.x, in_.ka0.y}, {in_.ka0.z, in_.ka0.w}, {in_.ka1.x, in_.ka1.y}, {in_.ka1.z, in_.ka1.w}};
        const float vr[2] = {in_.vv.x, in_.vv.y};
        float d1[2], d2[2];
#pragma unroll
        for (int i = 0; i < 2; i++) {
          f2 a = S2[i][0] * kk[0] + S2[i][1] * kk[1];
          f2 a2 = S2[i][2] * kk[2] + S2[i][3] * kk[3];
          f2 bq = S2[i][0] * wr[0] + S2[i][1] * wr[1];
          f2 b2 = S2[i][2] * wr[2] + S2[i][3] * wr[3];
          a += a2; bq += b2;
          d1[i] = a.x + a.y;
          d2[i] = bq.x + bq.y;
        }
        d1[0] = sum8(d1[0]); d1[1] = sum8(d1[1]); d2[0] = sum8(d2[0]); d2[1] = sum8(d2[1]);
#pragma unroll
        for (int i = 0; i < 2; i++) {
          const float skk = d1[i];
          yv[u][i] = d2[i] - skk * in_.cc.x + vr[i] * in_.cc.y;
          const f2 nsk = {-skk, -skk}, vv2 = {vr[i], vr[i]};
#pragma unroll
          for (int e = 0; e < 4; e++) S2[i][e] = S2[i][e] * w[e] + (nsk * ka[e] + vv2 * kt[e]);
        }
      }
      if (ks == 0) {
#pragma unroll
        for (int u = 0; u < 4; u++) *(float2*)&ybuf[s4 + u][row0] = make_float2(yv[u][0], yv[u][1]);
      }
      }
    }
    __syncthreads();
    {
      float4 y4 = *(const float4*)&ybuf[tl][kq * 4];
      float y[4] = {y4.x, y4.y, y4.z, y4.w};
      float mean = sum16(y[0] + y[1] + y[2] + y[3]) * (1.0f / 64.0f);
      float q = 0.f;
#pragma unroll
      for (int e = 0; e < 4; e++) { y[e] -= mean; q += y[e] * y[e]; }
      float rstd = rsqrtf(sum16(q) * (1.0f / 64.0f) + 64e-5f);
      float c3 = cur.c[tl][2];
      float4 v4 = *(const float4*)&cur.v[tl][kq * 4];
      float4 g4 = *(const float4*)&cur.g[tl][kq * 4];
      float vv[4] = {v4.x, v4.y, v4.z, v4.w};
      float gg[4] = {g4.x, g4.y, g4.z, g4.w};
      float o[4], lg[4], lb[4];
      *(float4*)lg = *(const float4*)&cst[7][kq * 4]; *(float4*)lb = *(const float4*)&cst[8][kq * 4];
#pragma unroll
      for (int e = 0; e < 4; e++) o[e] = (y[e] * rstd * lg[e] + lb[e] + c3 * vv[e]) * gg[e];
      size_t row = (size_t)(rowbase + c * 16 + tl);
      *(uint2*)(YR + row * 512 + hc) = make_uint2(pk2(o[0], o[1]), pk2(o[2], o[3]));
    }
    if (have_next) stage(nx, in[(c + 1) & 1]);
    __syncthreads();
  }
}

constexpr int KLD = 104, VLD = 72;
struct AttnSmem { u16 k[2][64 * KLD]; u16 v[2][64 * VLD]; };

__device__ __forceinline__ void attn_unit(const Params& p, int bh, int qi, char* smem, const int tid) {
  const int lane = tid & 63, wave = tid >> 6;
  const int fr = lane & 15, fq = lane >> 4;
  const int b = bh >> 3, h = bh & 7;
  const int rowbase = b * T_;
  u16* P = (u16*)(p.ws + OFF_P);
  const u16* Q = (const u16*)(p.ws + OFF_Q);
  const u16* KN = (const u16*)p.out;
  const u16* VT = (const u16*)p.out + (size_t)M_ * 512;
  const float2* ROPE = (const float2*)(p.ws + OFF_ROPE);
  AttnSmem* sm = (AttnSmem*)smem;
  const int qs = (qi == 0) ? 0 : 16 + (qi - 1) * 128;
  const int qn = (qi == 0) ? 16 : 128;
  const int q0 = qs + wave * 32;
  const bool wave_valid = (wave * 32 < qn);
  const int nkt = (qs + qn - 1) / 64 + 1;

  bf16x8 qf[2][3];
#pragma unroll
  for (int qb = 0; qb < 2; qb++) {
    int query = min(q0 + qb * 16 + fr, T_ - 1);
    const u16* qp = Q + (size_t)(rowbase + query) * 768 + h * 96;
    uint4 a0 = *(const uint4*)(qp + fq * 8);
    uint4 a1 = *(const uint4*)(qp + 32 + fq * 8);
    uint4 own = *(const uint4*)(qp + 64 + fq * 8);
    uint4 oth = *(const uint4*)(qp + 64 + (fq ^ 2) * 8);
    unsigned ow[4] = {own.x, own.y, own.z, own.w};
    unsigned tw[4] = {oth.x, oth.y, oth.z, oth.w};
    unsigned rw[4];
    const float2* rp = ROPE + (size_t)query * 16 + (fq & 1) * 8;
#pragma unroll
    for (int e = 0; e < 4; e++) {
      float2 cs0 = rp[2 * e], cs1 = rp[2 * e + 1];
      float o0 = bflo(ow[e]), o1 = bfhi(ow[e]);
      float t0 = bflo(tw[e]), t1 = bfhi(tw[e]);
      float r0, r1;
      if (fq < 2) { r0 = o0 * cs0.x - t0 * cs0.y; r1 = o1 * cs1.x - t1 * cs1.y; }
      else { r0 = t0 * cs0.y + o0 * cs0.x; r1 = t1 * cs1.y + o1 * cs1.x; }
      rw[e] = pk2(r0, r1);
    }
    uint4 a2 = make_uint4(rw[0], rw[1], rw[2], rw[3]);
    qf[qb][0] = *(bf16x8*)&a0;
    qf[qb][1] = *(bf16x8*)&a1;
    qf[qb][2] = *(bf16x8*)&a2;
  }

  f32x4 O[4][2];
#pragma unroll
  for (int i = 0; i < 4; i++)
#pragma unroll
    for (int j = 0; j < 2; j++) O[i][j] = f32x4{0.f, 0.f, 0.f, 0.f};
  float mrun[2] = {-1e30f, -1e30f}, lrun[2] = {0.f, 0.f};
  const float sc = 1.4426950408889634f / 9.797958971132712f;

  uint4 rk[3], rv[2];
  auto fetch_tile = [&](int kt) {
#pragma unroll
    for (int i = 0; i < 3; i++) {
      int c = tid + 256 * i;
      int key = c / 12, cc = c % 12;
      int t = kt * 64 + key;
      uint4 val = make_uint4(0, 0, 0, 0);
      if (t < T_) {
        size_t row = (size_t)(rowbase + t);
        if (cc < 8) val = *(const uint4*)(KN + row * 512 + h * 64 + cc * 8);
        else val = *(const uint4*)(P + row * PC_ + PKR_ + (cc - 8) * 8);
      }
      rk[i] = val;
    }
#pragma unroll
    for (int i = 0; i < 2; i++) {
      int c = tid + 256 * i;
      int dv = c >> 3, cc = c & 7;
      int t = kt * 64 + cc * 8;
      uint4 val = make_uint4(0, 0, 0, 0);
      if (t < T_) val = *(const uint4*)(VT + ((size_t)bh * 64 + dv) * T_ + t);
      rv[i] = val;
    }
  };
  auto store_tile = [&](int buf) {
#pragma unroll
    for (int i = 0; i < 3; i++) {
      int c = tid + 256 * i;
      int key = c / 12, cc = c % 12;
      *(uint4*)(&sm->k[buf][key * KLD + cc * 8]) = rk[i];
    }
#pragma unroll
    for (int i = 0; i < 2; i++) {
      int c = tid + 256 * i;
      int dv = c >> 3, cc = c & 7;
      *(uint4*)(&sm->v[buf][dv * VLD + cc * 8]) = rv[i];
    }
  };

  fetch_tile(0);
  for (int kt = 0; kt < nkt; kt++) {
    const int buf = kt & 1;
    store_tile(buf);
    __syncthreads();
    if (kt + 1 < nkt) fetch_tile(kt + 1);
    if (wave_valid && kt * 64 <= q0 + 31) {
      const u16* Ks = sm->k[buf];
      const u16* Vs = sm->v[buf];
      f32x4 s[4][2];
#pragma unroll
      for (int i = 0; i < 4; i++)
#pragma unroll
        for (int j = 0; j < 2; j++) s[i][j] = f32x4{0.f, 0.f, 0.f, 0.f};
#pragma unroll
      for (int ks = 0; ks < 3; ks++)
#pragma unroll
        for (int kb = 0; kb < 4; kb++) {
          bf16x8 kf = *(const bf16x8*)(Ks + (kb * 16 + fr) * KLD + ks * 32 + fq * 8);
#pragma unroll
          for (int qb = 0; qb < 2; qb++) s[kb][qb] = __builtin_amdgcn_mfma_f32_16x16x32_bf16(kf, qf[qb][ks], s[kb][qb], 0, 0, 0);
        }
      const bool need_mask = (kt * 64 + 63 > q0);
      unsigned pfw[2][2][4];
#pragma unroll
      for (int qb = 0; qb < 2; qb++) {
        const int query = q0 + qb * 16 + fr;
        float mx = -1e30f;
        if (need_mask) {
#pragma unroll
          for (int kb = 0; kb < 4; kb++)
#pragma unroll
            for (int j = 0; j < 4; j++) {
              int key = kt * 64 + kb * 16 + fq * 4 + j;
              if (key > query) s[kb][qb][j] = -1e30f;
            }
        }
#pragma unroll
        for (int kb = 0; kb < 4; kb++)
          mx = fmaxf(mx, fmaxf(fmaxf(s[kb][qb][0], s[kb][qb][1]), fmaxf(s[kb][qb][2], s[kb][qb][3])));
        mx = fmaxf(mx, shx(mx, lane, 16));
        mx = fmaxf(mx, shx(mx, lane, 32));
        const float mold = mrun[qb];
        const float mnew = fmaxf(mold, mx * sc);
        mrun[qb] = mnew;
        float ps = 0.f;
#pragma unroll
        for (int kb = 0; kb < 4; kb++) {
          float p0 = __builtin_amdgcn_exp2f(fmaf(s[kb][qb][0], sc, -mnew)), p1 = __builtin_amdgcn_exp2f(fmaf(s[kb][qb][1], sc, -mnew));
          float p2 = __builtin_amdgcn_exp2f(fmaf(s[kb][qb][2], sc, -mnew)), p3 = __builtin_amdgcn_exp2f(fmaf(s[kb][qb][3], sc, -mnew));
          ps += (p0 + p1) + (p2 + p3);
          pfw[qb][kb >> 1][(kb & 1) * 2 + 0] = pk2(p0, p1);
          pfw[qb][kb >> 1][(kb & 1) * 2 + 1] = pk2(p2, p3);
        }
        if (__builtin_amdgcn_ballot_w64(mnew != mold) != 0) {
          const float alpha = __builtin_amdgcn_exp2f(mold - mnew);
          lrun[qb] *= alpha;
#pragma unroll
          for (int dvb = 0; dvb < 4; dvb++) {
            O[dvb][qb][0] *= alpha; O[dvb][qb][1] *= alpha; O[dvb][qb][2] *= alpha; O[dvb][qb][3] *= alpha;
          }
        }
        lrun[qb] += ps;
      }
#pragma unroll
      for (int s2 = 0; s2 < 2; s2++)
#pragma unroll
        for (int dvb = 0; dvb < 4; dvb++) {
          const u16* vp = Vs + (dvb * 16 + fr) * VLD + s2 * 32 + fq * 4;
          uint2 v0 = *(const uint2*)vp;
          uint2 v1 = *(const uint2*)(vp + 16);
          uint4 vv = make_uint4(v0.x, v0.y, v1.x, v1.y);
          bf16x8 vf = *(bf16x8*)&vv;
#pragma unroll
          for (int qb = 0; qb < 2; qb++) {
            uint4 pw = make_uint4(pfw[qb][s2][0], pfw[qb][s2][1], pfw[qb][s2][2], pfw[qb][s2][3]);
            O[dvb][qb] = __builtin_amdgcn_mfma_f32_16x16x32_bf16(vf, *(bf16x8*)&pw, O[dvb][qb], 0, 0, 0);
          }
        }
    }
  }
  __syncthreads();
  if (wave_valid) {
#pragma unroll
    for (int qb = 0; qb < 2; qb++) {
      float l = lrun[qb];
      l += shx(l, lane, 16);
      l += shx(l, lane, 32);
      float inv = 1.0f / l;
      int query = q0 + qb * 16 + fr;
      if (query < qs + qn) {
        u16* op = P + (size_t)(rowbase + query) * PC_ + PMLA_ + h * 64 + fq * 4;
#pragma unroll
        for (int dvb = 0; dvb < 4; dvb++) {
          *(uint2*)(op + dvb * 16) =
              make_uint2(pk2(O[dvb][qb][0] * inv, O[dvb][qb][1] * inv), pk2(O[dvb][qb][2] * inv, O[dvb][qb][3] * inv));
        }
      }
    }
  }
}

#define XB_TMO      128
#define XB_XCNT(j)  (256  + 64 * (j))
#define XB_XSUB(j)  (1280 + 64 * (j))
#define XB_XGEN(j)  (2304 + 64 * (j))
#define XB_TOP      3328
#define XB_TOPGEN   3392
#define XCD_BAR_WORDS 3456
#define XB_SPIN_CAP (1u << 18)
#define LAS __attribute__((address_space(3)))

__device__ __forceinline__ unsigned xb_ld(unsigned* p)              { return __hip_atomic_load(p, __ATOMIC_RELAXED, __HIP_MEMORY_SCOPE_AGENT); }
__device__ __forceinline__ unsigned xb_add(unsigned* p, unsigned v) { return __hip_atomic_fetch_add(p, v, __ATOMIC_RELAXED, __HIP_MEMORY_SCOPE_AGENT); }
__device__ __forceinline__ unsigned xb_xcc_id() { return (unsigned)__builtin_amdgcn_s_getreg((3 << 11) | 20) & 0xFu; }
#define XB_SPIN(cond, bar) do { unsigned _sp = 0; while (cond) { __builtin_amdgcn_s_sleep(1); \
    if ((++_sp & 255u) == 0u) { if (xb_ld(&(bar)[XB_TMO])) break; if (_sp > XB_SPIN_CAP) { atomicAdd(&(bar)[XB_TMO], 1u); break; } } } } while (0)

struct XcdBarrier {
    unsigned* bar; unsigned x;
    volatile LAS unsigned* st;
};

__device__ __forceinline__ XcdBarrier xcd_barrier_post(unsigned* bar, volatile LAS unsigned* st) {
    XcdBarrier b; b.bar = bar; b.x = xb_xcc_id(); b.st = st;
    if (threadIdx.x == 0) (void)xb_add(&bar[XB_XCNT(b.x)], 1u);
    return b;
}
__device__ __forceinline__ void xcd_barrier_complete(unsigned* bar, unsigned x, unsigned& nloc, unsigned& nx) {
    const unsigned G = gridDim.x * gridDim.y * gridDim.z;
    unsigned sum, cnt, mine, sp = 0u;
    for (;;) {
        sum = 0u; cnt = 0u; mine = 0u;
#pragma unroll
        for (unsigned j = 0; j < 16; ++j) { const unsigned c = xb_ld(&bar[XB_XCNT(j)]); sum += c; cnt += (c > 0u) ? 1u : 0u; mine = (j == x) ? c : mine; }
        if (sum == G) break;
        __builtin_amdgcn_s_sleep(1);
        if ((++sp & 255u) == 0u) { if (xb_ld(&bar[XB_TMO])) break; if (sp > XB_SPIN_CAP) { atomicAdd(&bar[XB_TMO], 1u); break; } }
    }
    nloc = mine > 0u ? mine : 1u; nx = cnt > 0u ? cnt : 1u;
}

__device__ __forceinline__ void xcd_barrier(const XcdBarrier& b, const int tid_) {
    asm volatile("s_waitcnt vmcnt(0)" ::: "memory");
    __syncthreads();
    if (tid_ == 0) {
        unsigned* bar = b.bar;
        __builtin_amdgcn_s_waitcnt(0);
        unsigned nloc = b.st[0], nx = b.st[1];
        if (nloc == 0u) { xcd_barrier_complete(bar, b.x, nloc, nx); b.st[0] = nloc; b.st[1] = nx; }
        const unsigned old = xb_add(&bar[XB_XSUB(b.x)], 1u);
        const unsigned gen = old / nloc;
        if (old + 1u == (gen + 1u) * nloc) {
            __builtin_amdgcn_fence(__ATOMIC_RELEASE, "agent");
            asm volatile("s_waitcnt vmcnt(0)" ::: "memory");
            const unsigned og = xb_add(&bar[XB_TOP], 1u);
            const unsigned tg = og / nx;
            if (og + 1u == (tg + 1u) * nx) xb_add(&bar[XB_TOPGEN], 1u);
            else XB_SPIN(xb_ld(&bar[XB_TOPGEN]) == tg, bar);
            __builtin_amdgcn_fence(__ATOMIC_ACQUIRE, "agent");
            xb_add(&bar[XB_XGEN(b.x)], 1u);
            asm volatile("s_waitcnt vmcnt(0)" ::: "memory");
        } else {
            XB_SPIN(xb_ld(&bar[XB_XGEN(b.x)]) == gen, bar);
            __builtin_amdgcn_fence(__ATOMIC_ACQUIRE, "agent");
            asm volatile("s_waitcnt vmcnt(0)" ::: "memory");
        }
    }
    __syncthreads();
}


__global__ void __launch_bounds__(256, 2) mega(Params p) {
  cg::grid_group grid = cg::this_grid();
  __shared__ __attribute__((aligned(16))) char smem[SMEM_BYTES];
  __shared__ int s_unit;
  __shared__ uint4 xb_words;
  if (threadIdx.x == 0) xb_words = make_uint4(0u, 0u, 0u, 0u);
  __syncthreads();
  (void)xcd_barrier_post((unsigned*)(p.ws + OFF_BAR), (volatile LAS unsigned*)&xb_words);
#define XB_SYNC() do { XcdBarrier xb_; xb_.bar = (unsigned*)(p.ws + OFF_BAR); xb_.x = xb_xcc_id(); xb_.st = (volatile LAS unsigned*)&xb_words; xcd_barrier(xb_, wave0 * 64 + fresh_lane()); } while (0)
  int wave0 = __builtin_amdgcn_readfirstlane((int)(threadIdx.x >> 6));
  asm volatile("" : "+s"(wave0));
  const int nblk = gridDim.x;
  float* H = (float*)(p.ws + OFF_H);
  u16* P = (u16*)(p.ws + OFF_P);
  float* DEC = (float*)(p.ws + OFF_DEC);
  u16* AA = (u16*)(p.ws + OFF_AA);
  u16* GG = (u16*)(p.ws + OFF_GG);
  u16* Q = (u16*)(p.ws + OFF_Q);
  u16* MIX = (u16*)(p.ws + OFF_DEC);
  u16* HB1 = (u16*)p.out + (size_t)2 * M_ * 512;
  u16* HB2 = (u16*)(p.ws + OFF_HB2);
  u16* HBH = (u16*)(p.ws + OFF_AA);
  const u16* ZERO = (const u16*)(p.ws + OFF_ZERO);
  u16* ACT = (u16*)(p.ws + OFF_P);
  float2* ROPE = (float2*)(p.ws + OFF_ROPE);
  int* CTR = (int*)(p.ws + OFF_CTR);
  u16* KN = (u16*)p.out;
  u16* VT = KN + (size_t)M_ * 512;
  u16* YR = AA;

  {
  PHASE_TID
  for (int t = blockIdx.x; t < p.nconv; t += nblk) conv_tile(p, t, smem, tid);
  for (int i = blockIdx.x * 256 + tid; i < T_ * 16; i += nblk * 256) {
    int t = i >> 4, f = i & 15;
    double rev = (double)t * ROPE_C[f];
    rev -= floor(rev);
    float r = (float)rev;
    ROPE[i] = make_float2(__builtin_amdgcn_cosf(r), __builtin_amdgcn_sinf(r));
  }
  for (int row = blockIdx.x * 4 + wave; row < M_; row += nblk * 4) {
    int b = row / T_, t = row % T_;
    const float* src = (t < NMETA_) ? (p.in[1] + (size_t)t * 1024) : (p.in[0] + ((size_t)b * SEQ_ + (t - NMETA_)) * 1024);
    ln_row(src, p.in[2], p.in[3], H + (size_t)row * 1024, lane, (row < HB_SPLIT) ? HB1 + (size_t)row * 1024 : HB2 + (size_t)(row - HB_SPLIT) * 1024);
  }
  if (blockIdx.x == 0 && tid < 16) CTR[tid] = 0;
  if (blockIdx.x == 1) { for (int i = tid; i < 2048; i += 256) ((unsigned*)(p.ws + OFF_ZERO))[i] = 0u; }
  }
  grid.sync();

#pragma unroll 1
  for (int ph_ = 0; ph_ < 20; ph_++) {
    const int l = ph_ / 10, kph = ph_ - l * 10;
    const u16* WL = (const u16*)(p.ws + OFF_W) + (size_t)l * W_LAYER;
    if (kph == 0) {
    PHASE_TID
    for (int it_ = 0; it_ * nblk < 257 * 19; it_++) {
      int mt, nt;
      if (!map_tile(it_, nblk, 257, 19, mt, nt)) continue;
      f32x4 acc[8][4];
      zero_acc8(acc);
      ADma al = ADma{(mt < 255) ? HB1 : HB2, 1024, (mt < 255) ? mt * 256 : mt * 256 - HB_SPLIT, 0, ZERO, 0};
      gemm3(acc, al, WL + W_IN, 1024, nt * 128, 1024, smem, tid);
      ACC_COORDS
#pragma unroll
      for (int mi = 0; mi < 8; mi++)
#pragma unroll
        for (int ni = 0; ni < 4; ni++) {
          int col = nt * 128 + wc * 64 + ni * 16 + fq * 4;
          int row = mt * 256 + wr * 128 + mi * 16 + fr;
          if (col < PC_)
            *(uint2*)(P + (size_t)row * PC_ + col) = make_uint2(pk2(acc[mi][ni][0], acc[mi][ni][1]), pk2(acc[mi][ni][2], acc[mi][ni][3]));
        }
    }
    }
    if (kph == 1) {
    PHASE_TID
    {
      const float* qg = p.in[16] + l * 256;
      const float* kvg = p.in[18] + l * 256;
      for (int row = blockIdx.x * 4 + wave; row < M_; row += nblk * 4) {
        u16* pr = P + (size_t)row * PC_;
        uint2 cq = *(const uint2*)(pr + PMLA_ + lane * 4);
        uint2 ckv = *(const uint2*)(pr + PKV_ + lane * 4);
        float a[4], c[4];
        unpack4(cq, a);
        unpack4(ckv, c);
        float s1 = a[0] * a[0] + a[1] * a[1] + a[2] * a[2] + a[3] * a[3];
        float s2 = c[0] * c[0] + c[1] * c[1] + c[2] * c[2] + c[3] * c[3];
        s1 = wave_sum(s1, lane);
        s2 = wave_sum(s2, lane);
        float r1 = rsqrtf(s1 * (1.0f / 256.0f) + 1e-6f), r2 = rsqrtf(s2 * (1.0f / 256.0f) + 1e-6f);
        float4 g1 = *(const float4*)(qg + lane * 4), g2 = *(const float4*)(kvg + lane * 4);
        *(uint2*)(pr + PMLA_ + lane * 4) = make_uint2(pk2(a[0] * r1 * g1.x, a[1] * r1 * g1.y), pk2(a[2] * r1 * g1.z, a[3] * r1 * g1.w));
        *(uint2*)(pr + PKV_ + lane * 4) = make_uint2(pk2(c[0] * r2 * g2.x, c[1] * r2 * g2.y), pk2(c[2] * r2 * g2.z, c[3] * r2 * g2.w));
        if (lane < 16) {
          int t = row % T_;
          float x1 = bf2f(pr[PKR_ + lane]), x2 = bf2f(pr[PKR_ + 16 + lane]);
          float2 cs = ROPE[t * 16 + lane];
          pr[PKR_ + lane] = f2bf(x1 * cs.x - x2 * cs.y);
          pr[PKR_ + 16 + lane] = f2bf(x1 * cs.y + x2 * cs.x);
        }
      }
      const float* mu = p.in[5] + (size_t)l * 1824;
      for (int tile = blockIdx.x; tile < 514 * 12; tile += nblk) {
        int mt = tile / 12, sub = tile % 12, which = sub >> 2, nt = sub & 3;
        f32x4 acc[4][4];
        zero_acc(acc);
        ACC_COORDS
        if (which == 0) {
          AL<3> al{P + 1536, PC_, mt * 128, 0, 64, mu + 1536, 0};
          gemm_loop(acc, al, WL + W_LW, 64, nt * 128, 64, smem, tid);
          const float* w0 = p.in[6] + l * 512;
#pragma unroll
          for (int mi = 0; mi < 4; mi++)
#pragma unroll
            for (int ni = 0; ni < 4; ni++) {
              int col = nt * 128 + wc * 64 + ni * 16 + fr;
              float w0c = w0[col];
#pragma unroll
              for (int j = 0; j < 4; j++) {
                int row = mt * 128 + wr * 64 + mi * 16 + fq * 4 + j;
                float x = -(acc[mi][ni][j] + w0c);
                float sp = fmaxf(x, 0.f) + log1pf(__expf(-fabsf(x)));
                float wraw = -sp - 0.5f;
                DEC[(size_t)row * 512 + col] = __expf(-__expf(wraw));
              }
            }
        } else if (which == 1) {
          AL<3> al{P + 1600, PC_, mt * 128, 0, 64, mu + 1600, 1};
          gemm_loop(acc, al, WL + W_LA, 64, nt * 128, 64, smem, tid);
          const float* a0 = p.in[8] + l * 512;
#pragma unroll
          for (int mi = 0; mi < 4; mi++)
#pragma unroll
            for (int ni = 0; ni < 4; ni++) {
              int col = nt * 128 + wc * 64 + ni * 16 + fr;
              float a0c = a0[col];
#pragma unroll
              for (int j = 0; j < 4; j++) {
                int row = mt * 128 + wr * 64 + mi * 16 + fq * 4 + j;
                AA[(size_t)row * 512 + col] = f2bf(sigmoidf_(acc[mi][ni][j] + a0c));
              }
            }
        } else {
          AL<3> al{P + 1664, PC_, mt * 128, 0, 160, mu + 1664, 2};
          gemm_loop(acc, al, WL + W_LG, 192, nt * 128, 192, smem, tid);
#pragma unroll
          for (int mi = 0; mi < 4; mi++)
#pragma unroll
            for (int ni = 0; ni < 4; ni++) {
              int col = nt * 128 + wc * 64 + ni * 16 + fr;
#pragma unroll
              for (int j = 0; j < 4; j++) {
                int row = mt * 128 + wr * 64 + mi * 16 + fq * 4 + j;
                GG[(size_t)row * 512 + col] = f2bf(acc[mi][ni][j]);
              }
            }
        }
      }
    }
    }
    if (kph == 2) {
    PHASE_TID
    for (int it_ = 0; it_ * nblk < 257 * 14; it_++) {
      int mt, sub;
      if (!map_tile(it_, nblk, 257, 14, mt, sub)) continue;
      f32x4 acc[8][4];
      zero_acc8(acc);
      ACC_COORDS
      if (sub < 6) {
        ADma al{P + PMLA_, PC_, mt * 256, 0, ZERO, 0};
        gemm3(acc, al, WL + W_UQ, 256, sub * 128, 256, smem, tid);
#pragma unroll
        for (int mi = 0; mi < 8; mi++)
#pragma unroll
          for (int ni = 0; ni < 4; ni++) {
            int col = sub * 128 + wc * 64 + ni * 16 + fq * 4;
            int row = mt * 256 + wr * 128 + mi * 16 + fr;
            *(uint2*)(Q + (size_t)row * 768 + col) = make_uint2(pk2(acc[mi][ni][0], acc[mi][ni][1]), pk2(acc[mi][ni][2], acc[mi][ni][3]));
          }
      } else if (sub < 10) {
        int nt = sub - 6;
        ADma al{P + PKV_, PC_, mt * 256, 0, ZERO, 0};
        gemm3(acc, al, WL + W_UK, 256, nt * 128, 256, smem, tid);
#pragma unroll
        for (int mi = 0; mi < 8; mi++)
#pragma unroll
          for (int ni = 0; ni < 4; ni++) {
            int col = nt * 128 + wc * 64 + ni * 16 + fq * 4;
            int row = mt * 256 + wr * 128 + mi * 16 + fr;
            *(uint2*)(KN + (size_t)row * 512 + col) = make_uint2(pk2(acc[mi][ni][0], acc[mi][ni][1]), pk2(acc[mi][ni][2], acc[mi][ni][3]));
          }
      } else {
        int nt = sub - 10;
        ADma al{P + PKV_, PC_, mt * 256, 0, ZERO, 0};
        gemm3<4, false>(acc, al, WL + W_UV, 256, nt * 128, 256, smem, tid);
#pragma unroll
        for (int mi = 0; mi < 8; mi++)
#pragma unroll
          for (int ni = 0; ni < 4; ni++) {
            int col = nt * 128 + wc * 64 + ni * 16 + fr;
            int row = mt * 256 + wr * 128 + mi * 16 + fq * 4;
            int b = row / T_, t = row % T_;
            size_t o = ((size_t)(b * 512 + col)) * T_ + t;
            *(uint2*)(VT + o) = make_uint2(pk2(acc[mi][ni][0], acc[mi][ni][1]), pk2(acc[mi][ni][2], acc[mi][ni][3]));
          }
      }
    }
    }
    if (kph == 3) {
    PHASE_TID
    {
      const int xcd = blockIdx.x & 7;
      const int total = 16 + 16 * 33;
      while (true) {
        if (tid == 0) s_unit = atomicAdd(&CTR[l * 8 + xcd], 1);
        __syncthreads();
        int u = s_unit;
        __syncthreads();
        if (u >= total) break;
        const int tidu = launder(tid);
        if (u < 16) scan_unit(p, l, xcd * 16 + u, smem, tidu);
        else {
          int v = u - 16;
          int g = v / 66, w = v - g * 66;
          attn_unit(p, xcd * 16 + g * 2 + (w & 1), 32 - (w >> 1), smem, tidu);
        }
        __syncthreads();
      }
    }
    }
    if (kph == 4) {
    PHASE_TID
    for (int it_ = 0; it_ * nblk < 257 * 16; it_++) {
      int mt, nt;
      if (!map_tile(it_, nblk, 257, 16, mt, nt)) continue;
      f32x4 acc[8][2];
      unsigned sg[8][2][2];
      ADma alh = ADma{(mt < 255) ? HB1 : HB2, 1024, (mt < 255) ? mt * 256 : mt * 256 - HB_SPLIT, 0, ZERO, 0};
      zero_acc8(acc);
      const int tid1 = launder(tid);
      gemm3(acc, alh, WL + W_G, 1024, nt * 64, 1024, smem, tid1);
#pragma unroll
      for (int mi = 0; mi < 8; mi++)
#pragma unroll
        for (int ni = 0; ni < 2; ni++) {
          sg[mi][ni][0] = pk2(sigmoidf_(acc[mi][ni][0]), sigmoidf_(acc[mi][ni][1]));
          sg[mi][ni][1] = pk2(sigmoidf_(acc[mi][ni][2]), sigmoidf_(acc[mi][ni][3]));
        }
      zero_acc8(acc);
      {
        ADma aly{YR, 512, mt * 256, 0, ZERO, 0};
        const int tid2 = launder(tid);
      gemm3(acc, aly, WL + W_PR, 512, nt * 64, 512, smem, tid2);
      }
{ const int tidq = launder(tid); const int lane = tidq & 63, wave = tidq >> 6; ACC_COORDS
#pragma unroll
      for (int mi = 0; mi < 8; mi++)
#pragma unroll
        for (int ni = 0; ni < 2; ni++) {
          int col = nt * 64 + wc * 32 + ni * 16 + fq * 4;
          int row = mt * 256 + wr * 128 + mi * 16 + fr;
          *(uint2*)(MIX + (size_t)row * 1024 + col) = make_uint2(pk2(bflo(sg[mi][ni][0]) * acc[mi][ni][0], bfhi(sg[mi][ni][0]) * acc[mi][ni][1]),
                                                                 pk2(bflo(sg[mi][ni][1]) * acc[mi][ni][2], bfhi(sg[mi][ni][1]) * acc[mi][ni][3]));
        }
      }
      zero_acc8(acc);
      const int tid3 = launder(tid);
      gemm3(acc, alh, WL + W_G, 1024, 1024 + nt * 64, 1024, smem, tid3);
#pragma unroll
      for (int mi = 0; mi < 8; mi++)
#pragma unroll
        for (int ni = 0; ni < 2; ni++) {
          sg[mi][ni][0] = pk2(sigmoidf_(acc[mi][ni][0]), sigmoidf_(acc[mi][ni][1]));
          sg[mi][ni][1] = pk2(sigmoidf_(acc[mi][ni][2]), sigmoidf_(acc[mi][ni][3]));
        }
      zero_acc8(acc);
      {
        ADma alm{P + PMLA_, PC_, mt * 256, 0, ZERO, 0};
        const int tid4 = launder(tid);
      gemm3(acc, alm, WL + W_PM, 512, nt * 64, 512, smem, tid4);
      }
{ const int tidq = launder(tid); const int lane = tidq & 63, wave = tidq >> 6; ACC_COORDS
#pragma unroll
      for (int mi = 0; mi < 8; mi++)
#pragma unroll
        for (int ni = 0; ni < 2; ni++) {
          int col = nt * 64 + wc * 32 + ni * 16 + fq * 4;
          int row = mt * 256 + wr * 128 + mi * 16 + fr;
          uint2 pm = *(const uint2*)(MIX + (size_t)row * 1024 + col);
          float o0 = bflo(pm.x) + bflo(sg[mi][ni][0]) * acc[mi][ni][0];
          float o1 = bfhi(pm.x) + bfhi(sg[mi][ni][0]) * acc[mi][ni][1];
          float o2 = bflo(pm.y) + bflo(sg[mi][ni][1]) * acc[mi][ni][2];
          float o3 = bfhi(pm.y) + bfhi(sg[mi][ni][1]) * acc[mi][ni][3];
          *(uint2*)(MIX + (size_t)row * 1024 + col) = make_uint2(pk2(o0, o1), pk2(o2, o3));
        }
      }
    }
    }
    if (kph == 5) {
    PHASE_TID
    for (int prb_ = (PROBE_FI ? 0 : 1); prb_ < 2; prb_++)
    for (int it_ = 0; it_ * nblk < 257 * 8; it_++) {
      int mt, nt;
      if (!map_tile(it_, nblk, 257, 8, mt, nt)) continue;
      f32x4 acc[8][4];
      zero_acc8(acc);
      ACC_COORDS
      ADma al{MIX, 1024, mt * 256, 0, ZERO, 0};
      gemm3(acc, al, WL + W_OUT, 1024, nt * 128, 1024, smem, tid);
#pragma unroll
      for (int mi = 0; mi < 8; mi++)
#pragma unroll
        for (int ni = 0; ni < 4; ni++) {
          int col = nt * 128 + wc * 64 + ni * 16 + fq * 4;
          int row = mt * 256 + wr * 128 + mi * 16 + fr;
          float* hp = H + (size_t)row * 1024 + col;
          float* dp = (prb_ == 0) ? (p.out + (size_t)(row & 65535) * 1024 + col) : hp;
          float4 hv = *(const float4*)hp;
          hv.x = ALPHA_ * hv.x + acc[mi][ni][0];
          hv.y = ALPHA_ * hv.y + acc[mi][ni][1];
          hv.z = ALPHA_ * hv.z + acc[mi][ni][2];
          hv.w = ALPHA_ * hv.w + acc[mi][ni][3];
          *(float4*)dp = hv;
        }
    }
    }
    if (kph == 6) {
    PHASE_TID
    for (int row = (blockIdx.x * 4 + wave) * 2; row < M_; row += nblk * 8)
      ln_row2(H + (size_t)row * 1024, H + (size_t)(row + 1) * 1024, p.in[24] + l * 1024, p.in[25] + l * 1024, H + (size_t)row * 1024, H + (size_t)(row + 1) * 1024, lane, HBH + (size_t)row * 1024, HBH + (size_t)(row + 1) * 1024);
    }
    if (kph == 7) {
    PHASE_TID
    {
      const float* cw = p.in[27] + (size_t)l * 3 * 5632;
      const float* cb = p.in[28] + (size_t)l * 5632;
#if PROBE_HOT
      for (int it_ = 0; it_ * nblk < 272 * 44; it_++) {
        int rest, nt;
        if (!map_tile(it_, nblk, 272, 44, rest, nt)) continue;
        f32x4 acc[8][4];
        zero_acc8(acc);
#if PROBE_HOT == 1
        ADma al{HBH, 1024, 0, 0, ZERO, 1, p.ws};
        gemm3(acc, al, WL + W_UP, 1024, 0, 1024, smem, tid);
#else
        int it = rest % 17, b = rest / 17;
        ADma al{HBH, 1024, b * T_, 254 * it - 2, ZERO, 1, p.ws};
        gemm3(acc, al, WL + W_UP, 1024, nt * 128, 1024, smem, tid);
#endif
        float sacc = 0.f;
#pragma unroll
        for (int mi = 0; mi < 8; mi++)
#pragma unroll
          for (int ni = 0; ni < 4; ni++) sacc += acc[mi][ni][0] + acc[mi][ni][1] + acc[mi][ni][2] + acc[mi][ni][3];
        if (sacc == 12345.678f) ACT[tid] = 0;
      }
#endif
      for (int it_ = 0; it_ * nblk < 272 * 44; it_++) {
        int rest, nt;
        if (!map_tile(it_, nblk, 272, 44, rest, nt)) continue;
        int it = rest % 17, b = rest / 17;
        int t0 = 254 * it - 2;
        f32x4 acc[8][4];
        zero_acc8(acc);
        ADma al{HBH, 1024, b * T_, t0, ZERO, 1, p.ws};
        gemm3(acc, al, WL + W_UP, 1024, nt * 128, 1024, smem, launder(tid));
        ACC_COORDS
        float(*ut)[132] = (float(*)[132])smem;
        const int tidh = launder(tid);
        const int c = tidh & 63, rg = tidh >> 6;
        const int gcol = nt * 64 + c, vcol = DFF_ + nt * 64 + c;
        const float g0 = cw[gcol], g1 = cw[5632 + gcol], g2 = cw[2 * 5632 + gcol], gb = cb[gcol];
        const float v0 = cw[vcol], v1 = cw[5632 + vcol], v2 = cw[2 * 5632 + vcol], vb = cb[vcol];
#pragma unroll 1
        for (int half = 0; half < 2; half++) {
          float carry = 0.f;
          if (half == 1) carry = ut[126 + (tid >> 7)][tid & 127];
          __syncthreads();
          if (half == 1) ut[tid >> 7][tid & 127] = carry;
          if (wr == half) {
#pragma unroll
            for (int mi = 0; mi < 8; mi++)
#pragma unroll
              for (int ni = 0; ni < 4; ni++)
                *(float4*)&ut[half * 2 + mi * 16 + fr][wc * 64 + ni * 16 + fq * 4] = make_float4(acc[mi][ni][0], acc[mi][ni][1], acc[mi][ni][2], acc[mi][ni][3]);
          }
          __syncthreads();
          const int nq = half ? 130 : 128;
          int qs = 2 + rg * 32, qe = min(qs + 32, nq);
          float ga = ut[qs - 2][c], gbp = ut[qs - 1][c];
          float va = ut[qs - 2][64 + c], vbp = ut[qs - 1][64 + c];
          for (int q = qs; q < qe; q++) {
            float gc = ut[q][c], vc = ut[q][64 + c];
            int t = t0 + half * 126 + q;
            if (t < T_) {
              float gate = g0 * ga + g1 * gbp + g2 * gc + gb;
              float val = v0 * va + v1 * vbp + v2 * vc + vb;
              float av = gate * sigmoidf_(gate) * val;
              ACT[(size_t)(b * T_ + t) * DFF_ + gcol] = f2bf(av);
            }
            ga = gbp; gbp = gc; va = vbp; vbp = vc;
          }
        }
        __syncthreads();
      }
    }
    }
    if (kph == 8) {
    PHASE_TID
    for (int prb_ = (PROBE_FI ? 0 : 1); prb_ < 2; prb_++)
    for (int it_ = 0; it_ * nblk < 257 * 8; it_++) {
      int mt, nt;
      if (!map_tile(it_, nblk, 257, 8, mt, nt)) continue;
      f32x4 acc[8][4];
      zero_acc8(acc);
      ACC_COORDS
      ADma al{ACT, DFF_, mt * 256, 0, ZERO, 0};
      gemm3(acc, al, WL + W_DN, DFF_, nt * 128, DFF_, smem, tid);
#pragma unroll
      for (int mi = 0; mi < 8; mi++)
#pragma unroll
        for (int ni = 0; ni < 4; ni++) {
          int col = nt * 128 + wc * 64 + ni * 16 + fq * 4;
          int row = mt * 256 + wr * 128 + mi * 16 + fr;
          float* hp = H + (size_t)row * 1024 + col;
          float* dp = (prb_ == 0) ? (p.out + (size_t)(row & 65535) * 1024 + col) : hp;
          float4 hv = *(const float4*)hp;
          hv.x = ALPHA_ * hv.x + acc[mi][ni][0];
          hv.y = ALPHA_ * hv.y + acc[mi][ni][1];
          hv.z = ALPHA_ * hv.z + acc[mi][ni][2];
          hv.w = ALPHA_ * hv.w + acc[mi][ni][3];
          *(float4*)dp = hv;
        }
    }
    }
    if (kph == 9) {
    PHASE_TID
    if (l == 0) {
      for (int row = (blockIdx.x * 4 + wave) * 2; row < M_; row += nblk * 8) {
        u16* hb = (row < HB_SPLIT) ? HB1 + (size_t)row * 1024 : HB2 + (size_t)(row - HB_SPLIT) * 1024;
        ln_row2(H + (size_t)row * 1024, H + (size_t)(row + 1) * 1024, p.in[30], p.in[31], H + (size_t)row * 1024, H + (size_t)(row + 1) * 1024, lane, hb, hb + 1024);
      }
    } else {
      for (int row = (blockIdx.x * 4 + wave) * 2; row < M_; row += nblk * 8) {
        int b = row / T_, t = row % T_;
        if (t >= NMETA_) {
          float* o = p.out + ((size_t)b * SEQ_ + (t - NMETA_)) * 1024;
          ln_row2(H + (size_t)row * 1024, H + (size_t)(row + 1) * 1024, p.in[30] + 1024, p.in[31] + 1024, o, o + 1024, lane, nullptr, nullptr);
        }
      }
    }
    }
    if (ph_ != 19) XB_SYNC();
  }
}

extern "C" void kernel_launch(void* const* d_in, const int* in_sizes, int n_in, void* d_out, int out_size, void* d_ws,
                              size_t ws_size, hipStream_t stream) {
  static int grid_blocks = 0;
  if (!grid_blocks) {
    int dev = 0, cus = 0, per_cu = 0;
    hipGetDevice(&dev);
    hipDeviceGetAttribute(&cus, hipDeviceAttributeMultiprocessorCount, dev);
    hipOccupancyMaxActiveBlocksPerMultiprocessor(&per_cu, mega, 256, 0);
    if (per_cu > 2) per_cu = 2;
    grid_blocks = cus * per_cu;
  }
  if (ws_size < WS_TOTAL) fprintf(stderr, "workspace too small: %zu < %zu\n", ws_size, (size_t)WS_TOTAL);
  Params p;
  memset(&p, 0, sizeof(p));
  for (int i = 0; i < 32; i++) p.in[i] = (const float*)d_in[i];
  p.out = (float*)d_out;
  p.ws = (char*)d_ws;
  u16* wb = (u16*)((char*)d_ws + OFF_W);
  int nj = 0, tiles = 0;
  auto add = [&](const float* src, size_t dst_off, int ld, int c0, int K, int Kpad, int Nv, int Np, int mode) {
    Job& j = p.jobs[nj++];
    j.src = src; j.dst = wb + dst_off; j.ld = ld; j.c0 = c0; j.K = K; j.Kpad = Kpad; j.Nv = Nv; j.Np = Np; j.mode = mode;
    j.tile0 = tiles;
    tiles += (Kpad / 32) * (Np / 32);
  };
  for (int l = 0; l < 2; l++) {
    size_t o = (size_t)l * W_LAYER;
    const float* w_in = (const float*)d_in[4] + (size_t)l * 1024 * 4416;
    add(w_in, o + W_IN, 4416, 0, 1024, 1024, 2368, 2432, 0);
    add(w_in, o + W_G, 4416, 2368, 1024, 1024, 2048, 2048, 0);
    add((const float*)d_in[7] + (size_t)l * 64 * 512, o + W_LW, 512, 0, 64, 64, 512, 512, 0);
    add((const float*)d_in[9] + (size_t)l * 64 * 512, o + W_LA, 512, 0, 64, 64, 512, 512, 0);
    add((const float*)d_in[10] + (size_t)l * 160 * 512, o + W_LG, 512, 0, 160, 192, 512, 512, 0);
    add((const float*)d_in[17] + (size_t)l * 256 * 768, o + W_UQ, 768, 0, 256, 256, 768, 768, 0);
    add((const float*)d_in[19] + (size_t)l * 256 * 512, o + W_UK, 512, 0, 256, 256, 512, 512, 0);
    add((const float*)d_in[20] + (size_t)l * 256 * 512, o + W_UV, 512, 0, 256, 256, 512, 512, 0);
    add((const float*)d_in[21] + (size_t)l * 512 * 1024, o + W_PR, 1024, 0, 512, 512, 1024, 1024, 0);
    add((const float*)d_in[22] + (size_t)l * 512 * 1024, o + W_PM, 1024, 0, 512, 512, 1024, 1024, 0);
    add((const float*)d_in[23] + (size_t)l * 1024 * 1024, o + W_OUT, 1024, 0, 1024, 1024, 1024, 1024, 0);
    add((const float*)d_in[26] + (size_t)l * 1024 * 5632, o + W_UP, 5632, 0, 1024, 1024, 5632, 5632, 1);
    add((const float*)d_in[29] + (size_t)l * 2816 * 1024, o + W_DN, 1024, 0, 2816, 2816, 1024, 1024, 0);
  }
  p.nconv = tiles;
  hipMemsetAsync((char*)d_ws + OFF_BAR, 0, 16384, stream);
  void* args[] = {&p};
  hipError_t e = hipLaunchCooperativeKernel((void*)mega, dim3(grid_blocks), dim3(256), args, 0, stream);
  if (e != hipSuccess) fprintf(stderr, "cooperative launch failed: %s (grid %d)\n", hipGetErrorString(e), grid_blocks);
}
```

```cpp
#include <hip/hip_runtime.h>
#include <hip/hip_cooperative_groups.h>
#include <cstdio>
#include <cstring>
namespace cg = cooperative_groups;

#ifndef PHMASK
#define PHMASK 0xFFFF
#endif
#ifndef PROBE_HOT
#define PROBE_HOT 0
#endif
#ifndef PROBE_FI
#define PROBE_FI 0
#endif
#ifndef REPMASK
#define REPMASK 0
#endif
typedef unsigned short u16;
using bf16x8 = __attribute__((ext_vector_type(8))) short;
using f32x4 = __attribute__((ext_vector_type(4))) float;

constexpr int B_ = 16, SEQ_ = 4096, NMETA_ = 16, T_ = 4112, M_ = B_ * T_, D_ = 1024;
constexpr int PC_ = 2368;
constexpr int PMLA_ = 1824, PKV_ = 2080, PKR_ = 2336;
constexpr int DFF_ = 2816;
constexpr float ALPHA_ = 1.4142135623730951f;

constexpr size_t OFF_H = 0;
constexpr size_t OFF_P = OFF_H + (size_t)M_ * 1024 * 4;
constexpr size_t OFF_DEC = OFF_P + (size_t)M_ * PC_ * 2;
constexpr size_t OFF_AA = OFF_DEC + (size_t)M_ * 512 * 4;
constexpr size_t OFF_GG = OFF_AA + (size_t)M_ * 512 * 2;
constexpr size_t OFF_Q = OFF_GG + (size_t)M_ * 512 * 2;
constexpr size_t OFF_W = OFF_Q + (size_t)M_ * 768 * 2;
constexpr size_t W_IN = 0;
constexpr size_t W_G = W_IN + (size_t)2432 * 1024;
constexpr size_t W_LW = W_G + (size_t)2048 * 1024;
constexpr size_t W_LA = W_LW + (size_t)512 * 64;
constexpr size_t W_LG = W_LA + (size_t)512 * 64;
constexpr size_t W_UQ = W_LG + (size_t)512 * 192;
constexpr size_t W_UK = W_UQ + (size_t)768 * 256;
constexpr size_t W_UV = W_UK + (size_t)512 * 256;
constexpr size_t W_PR = W_UV + (size_t)512 * 256;
constexpr size_t W_PM = W_PR + (size_t)1024 * 512;
constexpr size_t W_OUT = W_PM + (size_t)1024 * 512;
constexpr size_t W_UP = W_OUT + (size_t)1024 * 1024;
constexpr size_t W_DN = W_UP + (size_t)5632 * 1024;
constexpr size_t W_LAYER = W_DN + (size_t)1024 * 2816;
constexpr size_t OFF_ROPE = OFF_W + 2 * W_LAYER * 2;
constexpr size_t OFF_CTR = OFF_ROPE + (size_t)T_ * 16 * 8;
constexpr size_t OFF_ZERO = OFF_CTR + 256;
constexpr size_t OFF_BAR = OFF_ZERO + 8192;
constexpr size_t OFF_HB2 = OFF_BAR + 16384;
constexpr size_t WS_TOTAL = OFF_HB2 + (size_t)512 * 1024 * 2;
constexpr int HB_SPLIT = 65280;

struct Job { const float* src; u16* dst; int ld, c0, K, Kpad, Nv, Np, mode, tile0; };
struct Params {
  const float* in[32];
  float* out;
  char* ws;
  Job jobs[26];
  int nconv;
  int pad0;
};

__constant__ double ROPE_C[16] = {0.15915494309189535, 0.08949940160889101, 0.050329212104487035, 0.0283021958306234,
                                  0.015915494309189534, 0.008949940160889102, 0.005032921210448704, 0.00283021958306234,
                                  0.0015915494309189536, 0.0008949940160889102, 0.0005032921210448703, 0.00028302195830623395,
                                  0.00015915494309189535, 8.949940160889102e-05, 5.0329212104487035e-05, 2.8302195830623396e-05};

__device__ __forceinline__ int launder(int x) { asm volatile("" : "+v"(x)); return x; }
typedef __bf16 bf16x2_t __attribute__((ext_vector_type(2)));
typedef float f32x2_t __attribute__((ext_vector_type(2)));
__device__ __forceinline__ unsigned pk2(float a, float b) {
  f32x2_t v = {a, b};
  bf16x2_t r = __builtin_convertvector(v, bf16x2_t);
  return *(unsigned*)&r;
}
__device__ __forceinline__ u16 f2bf(float f) { return (u16)(pk2(f, 0.f) & 0xffffu); }
__device__ __forceinline__ float bf2f(unsigned h) { return __uint_as_float(h << 16); }
__device__ __forceinline__ float bflo(unsigned w) { return __uint_as_float(w << 16); }
__device__ __forceinline__ float bfhi(unsigned w) { return __uint_as_float(w & 0xffff0000u); }
__device__ __forceinline__ float sigmoidf_(float x) { return 1.0f / (1.0f + __expf(-x)); }

__device__ __forceinline__ int fresh_lane() { int x; asm volatile("v_mbcnt_lo_u32_b32 %0, -1, 0\n\tv_mbcnt_hi_u32_b32 %0, -1, %0" : "=v"(x)); return x; }
#define PHASE_TID const int tid = wave0 * 64 + fresh_lane(); const int lane = tid & 63, wave = tid >> 6; (void)lane; (void)wave;
template <int CTRL>
__device__ __forceinline__ float dppf(float x) {
  return __int_as_float(__builtin_amdgcn_update_dpp(0, __float_as_int(x), CTRL, 0xF, 0xF, true));
}
__device__ __forceinline__ float sum8(float x) {
  x += dppf<0xB1>(x);
  x += dppf<0x4E>(x);
  x += dppf<0x141>(x);
  return x;
}
__device__ __forceinline__ float sum16(float x) {
  x = sum8(x);
  x += dppf<0x140>(x);
  return x;
}
__device__ __forceinline__ float shx(float x, int lane, int o) {
  return __int_as_float(__builtin_amdgcn_ds_bpermute((lane ^ o) << 2, __float_as_int(x)));
}
__device__ __forceinline__ float wave_sum(float x, int lane) {
  x = sum16(x);
  x += shx(x, lane, 16);
  x += shx(x, lane, 32);
  return x;
}

constexpr int BM = 128, BN = 128, BK = 64, LDT = 64;
constexpr int SMEM_BYTES = 73728;

template <int MODE>
struct AL {
  const void* base;
  int ld;
  int row0;
  int t0;
  int kvalid;
  const float* mu;
  int fn;
  struct Raw { uint4 x, y; };
  __device__ __forceinline__ Raw fetch(int r, int k) const {
    Raw w;
    { unsigned z = (MODE == 3) ? (unsigned)launder(0) : 0u; w.x = make_uint4(z, z, z, z); w.y = w.x; }
    if (MODE == 0) {
      const float* p = (const float*)base + (size_t)(row0 + r) * ld + k;
      w.x = *(const uint4*)p;
      w.y = *(const uint4*)(p + 4);
    } else if (MODE == 1) {
      const u16* p = (const u16*)base + (size_t)(row0 + r) * ld + k;
      w.x = *(const uint4*)p;
    } else if (MODE == 4) {
      const float* p = (const float*)base + (size_t)(row0 + r) * ld + k;
      float4 a = *(const float4*)p, b = *(const float4*)(p + 4);
      w.x = make_uint4(pk2(a.x, a.y), pk2(a.z, a.w), pk2(b.x, b.y), pk2(b.z, b.w));
    } else if (MODE == 2) {
      int t = t0 + r;
      if (t >= 0 && t < T_) {
        const float* p = (const float*)base + (size_t)(row0 + t) * ld + k;
        w.x = *(const uint4*)p;
        w.y = *(const uint4*)(p + 4);
      }
    } else {
      int row = row0 + r;
      int t = row % T_;
      if (k < kvalid) {
        const u16* p = (const u16*)base + (size_t)row * ld + k;
        w.x = *(const uint4*)p;
        if (t > 0) w.y = *(const uint4*)(p - ld);
      }
    }
    return w;
  }
  __device__ __forceinline__ uint4 cvt(const Raw& w, int k) const {
    if (MODE == 0 || MODE == 2) {
      uint4 o;
      o.x = pk2(__uint_as_float(w.x.x), __uint_as_float(w.x.y));
      o.y = pk2(__uint_as_float(w.x.z), __uint_as_float(w.x.w));
      o.z = pk2(__uint_as_float(w.y.x), __uint_as_float(w.y.y));
      o.w = pk2(__uint_as_float(w.y.z), __uint_as_float(w.y.w));
      return o;
    } else if (MODE == 1 || MODE == 4) {
      return w.x;
    } else {
      if (k >= kvalid) { unsigned z = (unsigned)launder(0); return make_uint4(z, z, z, z); }
      unsigned cw[4] = {w.x.x, w.x.y, w.x.z, w.x.w};
      unsigned pw[4] = {w.y.x, w.y.y, w.y.z, w.y.w};
      unsigned ow[4];
#pragma unroll
      for (int e = 0; e < 4; e++) {
        float x0 = bflo(cw[e]), x1 = bfhi(cw[e]);
        float p0 = bflo(pw[e]), p1 = bfhi(pw[e]);
        float v0 = x0 + (p0 - x0) * mu[k + 2 * e];
        float v1 = x1 + (p1 - x1) * mu[k + 2 * e + 1];
        if (fn == 0) {
          v0 = 1.0f - 2.0f / (__expf(2.0f * v0) + 1.0f);
          v1 = 1.0f - 2.0f / (__expf(2.0f * v1) + 1.0f);
        } else if (fn == 2) {
          v0 = sigmoidf_(v0);
          v1 = sigmoidf_(v1);
        }
        ow[e] = pk2(v0, v1);
      }
      return make_uint4(ow[0], ow[1], ow[2], ow[3]);
    }
  }
};

template <int NI>
__device__ __forceinline__ void zero_acc(f32x4 (&acc)[4][NI]) {
#pragma unroll
  for (int i = 0; i < 4; i++)
#pragma unroll
    for (int j = 0; j < NI; j++) acc[i][j] = f32x4{0.f, 0.f, 0.f, 0.f};
}

#define REP4(X) X(0) X(1) X(2) X(3)
template <class ALT, int NI>
__device__ __forceinline__ void gemm_loop(f32x4 (&acc)[4][NI], const ALT& al, const u16* __restrict__ Bt, int ldb, int n0,
                                          int K, char* smem, const int tid) {
  const int lane = tid & 63, wave = tid >> 6;
  const int wr = wave >> 1, wc = wave & 1, fr = lane & 15, fq = lane >> 4;
  const int lr = tid >> 3, lk = (tid & 7) * 8, lsw = ((tid & 7) ^ (lr & 7)) * 8;
  u16* sa = (u16*)smem;
  u16* sb = sa + 2 * BM * LDT;
  typename ALT::Raw ra0, ra1, ra2, ra3;
  uint4 rb0 = make_uint4(0,0,0,0), rb1 = rb0, rb2 = rb0, rb3 = rb0;
  const u16* bp = Bt + (size_t)(n0 + lr) * ldb + lk;
#define GL_FETCH(i) ra##i = al.fetch(lr + 32 * i, kf); if (i < NI) rb##i = *(const uint4*)(bp + (size_t)(32 * i) * ldb + kb);
#define GL_STORE(i) *(uint4*)(a_ + (lr + 32 * i) * LDT + lsw) = al.cvt(ra##i, kt * BK + lk); if (i < NI) *(uint4*)(b_ + (lr + 32 * i) * LDT + lsw) = rb##i;
  {
    const int kf = lk, kb = 0;
    REP4(GL_FETCH)
  }
  const int nk = K / BK;
  for (int kt = 0; kt < nk; kt++) {
    u16* a_ = sa + (kt & 1) * BM * LDT;
    u16* b_ = sb + (kt & 1) * BN * LDT;
    REP4(GL_STORE)
    __syncthreads();
    if (kt + 1 < nk) {
      const int kf = (kt + 1) * BK + lk, kb = (kt + 1) * BK;
      REP4(GL_FETCH)
    }
#pragma unroll
    for (int ks = 0; ks < 2; ks++) {
      bf16x8 af[4], bf[NI];
#pragma unroll
      for (int i = 0; i < 4; i++) af[i] = *(const bf16x8*)(a_ + (wr * 64 + i * 16 + fr) * LDT + (((ks * 4 + fq) ^ (fr & 7)) * 8));
#pragma unroll
      for (int i = 0; i < NI; i++) bf[i] = *(const bf16x8*)(b_ + (wc * (NI * 16) + i * 16 + fr) * LDT + (((ks * 4 + fq) ^ (fr & 7)) * 8));
#pragma unroll
      for (int mi = 0; mi < 4; mi++)
#pragma unroll
        for (int ni = 0; ni < NI; ni++)
          acc[mi][ni] = __builtin_amdgcn_mfma_f32_16x16x32_bf16(af[mi], bf[ni], acc[mi][ni], 0, 0, 0);
    }
  }
  __syncthreads();
#undef GL_FETCH
#undef GL_STORE
}


struct ADma { const u16* base; int ld; int row0; int t0; const u16* zero; int mode; const char* wsb; };
constexpr int G3_STAGE = 12288;

template <int NI, bool SWAP = true>
__device__ __forceinline__ void gemm3(f32x4 (&acc)[8][NI], const ADma& a, const u16* __restrict__ Bt, int ldb, int n0, int K,
                                      char* smem, const int tid) {
  const int lane = tid & 63, wave = tid >> 6;
  const int wr = wave >> 1, wc = wave & 1, fr = lane & 15, fq = lane >> 4;
  const int kc8 = ((lane & 3) ^ ((4 - (lane >> 4)) & 3)) * 8;
  const int psw = (fq ^ ((4 - (fr >> 2)) & 3)) * 8;
  u16* sm = (u16*)smem;
  const u16* ap0 = nullptr;
  unsigned ao0 = 0, ao1 = 0, ao2 = 0, ao3 = 0;
  if (a.mode == 0) {
    ap0 = a.base + (size_t)(a.row0 + wave * 64 + (lane >> 2)) * a.ld + kc8;
  } else {
    const unsigned bo = (unsigned)((const char*)a.base - a.wsb), zo = (unsigned)((const char*)a.zero - a.wsb) + kc8 * 2;
#define G3_AP(j)                                                                          \
    {                                                                                     \
      int t = a.t0 + wave * 64 + j * 16 + (lane >> 2);                                    \
      ao##j = (t >= 0 && t < T_) ? bo + (unsigned)(((a.row0 + t) * a.ld + kc8) * 2) : zo; \
    }
    REP4(G3_AP)
#undef G3_AP
  }
  const u16* bp0 = Bt + (size_t)(n0 + wave * (8 * NI) + (lane >> 2)) * ldb + kc8;
  const size_t astep = (size_t)16 * a.ld;
  const size_t bstep = (size_t)16 * ldb;
#define G3_ISSUE(j)                                                                                                              \
  __builtin_amdgcn_global_load_lds((a.mode == 0) ? (const unsigned*)(ap0 + j * astep + kof) : (const unsigned*)(a.wsb + ao##j + kof * 2), (unsigned*)(st_ + (wave * 64 + j * 16) * 32 + lane * 8), 16, 0, 0); \
  if (2 * j < NI) __builtin_amdgcn_global_load_lds((const unsigned*)(bp0 + j * bstep + kof), (unsigned*)(st_ + 8192 + (wave * (8 * NI) + j * 16) * 32 + lane * 8), 16, 0, 0);
  const int nk = K / 32;
  asm volatile("s_waitcnt vmcnt(0)" ::: "memory");
  {
    const int kof = 0;
    u16* st_ = sm;
    REP4(G3_ISSUE)
  }
  if (nk > 1) {
    const int kof = 32;
    u16* st_ = sm + G3_STAGE;
    REP4(G3_ISSUE)
  }
  int cur = 0, nxt = 2;
  const unsigned lds0 = (unsigned)(size_t)(__attribute__((address_space(3))) char*)smem;
  const unsigned aoff = lds0 + (unsigned)(((wr * 128 + fr) * 32 + psw) * 2);
  const unsigned boff = lds0 + 16384u + (unsigned)(((wc * (NI * 16) + fr) * 32 + psw) * 2);
#define G3_DSR(dst, addr, off) asm volatile("ds_read_b128 %0, %1 offset:" #off : "=v"(dst) : "v"(addr))
  for (int kt = 0; kt < nk; kt++) {
    if (kt + 1 < nk) {
      if (NI == 4) asm volatile("s_waitcnt vmcnt(6)" ::: "memory");
      else asm volatile("s_waitcnt vmcnt(5)" ::: "memory");
    } else {
      asm volatile("s_waitcnt vmcnt(0)" ::: "memory");
    }
    __builtin_amdgcn_s_barrier();
    if (kt + 2 < nk) {
      const int kof = (kt + 2) * 32;
      u16* st_ = sm + nxt * G3_STAGE;
      REP4(G3_ISSUE)
    }
    const unsigned aaddr = aoff + (unsigned)cur * (G3_STAGE * 2);
    const unsigned baddr = boff + (unsigned)cur * (G3_STAGE * 2);
    bf16x8 af[8], bf[NI];
    G3_DSR(af[0], aaddr, 0); G3_DSR(af[1], aaddr, 1024); G3_DSR(af[2], aaddr, 2048); G3_DSR(af[3], aaddr, 3072);
    G3_DSR(bf[0], baddr, 0); G3_DSR(bf[1], baddr, 1024);
    if (NI == 4) { G3_DSR(bf[NI - 2], baddr, 2048); G3_DSR(bf[NI - 1], baddr, 3072); }
    G3_DSR(af[4], aaddr, 4096); G3_DSR(af[5], aaddr, 5120); G3_DSR(af[6], aaddr, 6144); G3_DSR(af[7], aaddr, 7168);
    if (NI == 4) {
      asm volatile("s_waitcnt lgkmcnt(4)"
                   : "+v"(af[0]), "+v"(af[1]), "+v"(af[2]), "+v"(af[3]), "+v"(bf[0]), "+v"(bf[1]), "+v"(bf[NI - 2]), "+v"(bf[NI - 1]));
    } else {
      asm volatile("s_waitcnt lgkmcnt(4)" : "+v"(af[0]), "+v"(af[1]), "+v"(af[2]), "+v"(af[3]), "+v"(bf[0]), "+v"(bf[1]));
    }
#pragma unroll
    for (int mi = 0; mi < 4; mi++)
#pragma unroll
      for (int ni = 0; ni < NI; ni++)
        acc[mi][ni] = SWAP ? __builtin_amdgcn_mfma_f32_16x16x32_bf16(bf[ni], af[mi], acc[mi][ni], 0, 0, 0)
                           : __builtin_amdgcn_mfma_f32_16x16x32_bf16(af[mi], bf[ni], acc[mi][ni], 0, 0, 0);
    asm volatile("s_waitcnt lgkmcnt(0)" : "+v"(af[4]), "+v"(af[5]), "+v"(af[6]), "+v"(af[7]));
#pragma unroll
    for (int mi = 4; mi < 8; mi++)
#pragma unroll
      for (int ni = 0; ni < NI; ni++)
        acc[mi][ni] = SWAP ? __builtin_amdgcn_mfma_f32_16x16x32_bf16(bf[ni], af[mi], acc[mi][ni], 0, 0, 0)
                           : __builtin_amdgcn_mfma_f32_16x16x32_bf16(af[mi], bf[ni], acc[mi][ni], 0, 0, 0);
    cur = (cur == 2) ? 0 : cur + 1;
    nxt = (nxt == 2) ? 0 : nxt + 1;
  }
  asm volatile("s_waitcnt lgkmcnt(0)" ::: "memory");
  __syncthreads();
#undef G3_DSR
#undef G3_ISSUE
}

template <int NI>
__device__ __forceinline__ void zero_acc8(f32x4 (&acc)[8][NI]) {
#pragma unroll
  for (int i = 0; i < 8; i++)
#pragma unroll
    for (int j = 0; j < NI; j++) acc[i][j] = f32x4{0.f, 0.f, 0.f, 0.f};
}


__device__ __forceinline__ bool map_tile(int i, int nblk, int MT, int NT, int& mt, int& nt) {
  const int locs = nblk >> 3;
  const int xcd = blockIdx.x & 7, loc = blockIdx.x >> 3;
  const int q = (i * 8 + xcd) * locs + loc;
  if (q >= MT * NT) return false;
  const int nfull = NT >> 3, per = MT * 8;
  if (q < nfull * per) {
    int pp = q / per, r = q - pp * per;
    mt = r >> 3;
    nt = pp * 8 + (r & 7);
  } else {
    int r = q - nfull * per;
    int w = NT - nfull * 8;
    mt = r / w;
    nt = nfull * 8 + (r - mt * w);
  }
  return true;
}

#define ACC_COORDS const int wr = wave >> 1, wc = wave & 1, fr = lane & 15, fq = lane >> 4;

__device__ __forceinline__ void conv_tile(const Params& p, int t, char* smem, const int tid) {
  int j = 0;
#pragma unroll 1
  for (int i = 1; i < 26; i++)
    if (t >= p.jobs[i].tile0) j = i;
  const Job& jb = p.jobs[j];
  float(*tile)[33] = (float(*)[33])smem;
  int local = t - jb.tile0;
  int nkt = jb.Kpad >> 5;
  int kt = local % nkt, nt = local / nkt;
  int tx = tid & 31, ty = tid >> 5;
  int n = nt * 32 + tx;
  int col;
  if (jb.mode == 0) col = jb.c0 + n;
  else { int jn = n >> 7, i = n & 127; col = (i < 64) ? (64 * jn + i) : (DFF_ + 64 * jn + (i - 64)); }
#pragma unroll
  for (int i = 0; i < 4; i++) {
    int k = kt * 32 + ty + 8 * i;
    float v = 0.f;
    if (k < jb.K && n < jb.Nv) v = jb.src[(size_t)k * jb.ld + col];
    tile[ty + 8 * i][tx] = v;
  }
  __syncthreads();
#pragma unroll
  for (int i = 0; i < 4; i++) {
    int nn = nt * 32 + ty + 8 * i;
    int k = kt * 32 + tx;
    jb.dst[(size_t)nn * jb.Kpad + k] = f2bf(tile[tx][ty + 8 * i]);
  }
  __syncthreads();
}

__device__ __forceinline__ void ln_row(const float* __restrict__ src, const float* __restrict__ g,
                                       const float* __restrict__ b, float* __restrict__ dst, int lane, u16* __restrict__ dstb = nullptr) {
  float4 v[4];
  float s = 0.f;
#pragma unroll
  for (int i = 0; i < 4; i++) {
    v[i] = *(const float4*)(src + i * 256 + lane * 4);
    s += v[i].x + v[i].y + v[i].z + v[i].w;
  }
  float mean = wave_sum(s, lane) * (1.0f / 1024.0f);
  float q = 0.f;
#pragma unroll
  for (int i = 0; i < 4; i++) {
    float a = v[i].x - mean, b2 = v[i].y - mean, c = v[i].z - mean, d = v[i].w - mean;
    q += a * a + b2 * b2 + c * c + d * d;
  }
  float rstd = rsqrtf(wave_sum(q, lane) * (1.0f / 1024.0f) + 1e-5f);
#pragma unroll
  for (int i = 0; i < 4; i++) {
    float4 gg = *(const float4*)(g + i * 256 + lane * 4);
    float4 bb = *(const float4*)(b + i * 256 + lane * 4);
    float4 o;
    o.x = (v[i].x - mean) * rstd * gg.x + bb.x;
    o.y = (v[i].y - mean) * rstd * gg.y + bb.y;
    o.z = (v[i].z - mean) * rstd * gg.z + bb.z;
    o.w = (v[i].w - mean) * rstd * gg.w + bb.w;
    *(float4*)(dst + i * 256 + lane * 4) = o;
    if (dstb) *(uint2*)(dstb + i * 256 + lane * 4) = make_uint2(pk2(o.x, o.y), pk2(o.z, o.w));
  }
}

__device__ __forceinline__ void ln_row2(const float* __restrict__ srcA, const float* __restrict__ srcB, const float* __restrict__ g,
                                        const float* __restrict__ b, float* dstA, float* dstB, int lane, u16* dbA, u16* dbB) {
  float4 va[4], vb[4];
  float sa = 0.f, sb = 0.f;
#pragma unroll
  for (int i = 0; i < 4; i++) {
    va[i] = *(const float4*)(srcA + i * 256 + lane * 4);
    vb[i] = *(const float4*)(srcB + i * 256 + lane * 4);
  }
#pragma unroll
  for (int i = 0; i < 4; i++) {
    sa += va[i].x + va[i].y + va[i].z + va[i].w;
    sb += vb[i].x + vb[i].y + vb[i].z + vb[i].w;
  }
  const float ma = wave_sum(sa, lane) * (1.0f / 1024.0f), mb = wave_sum(sb, lane) * (1.0f / 1024.0f);
  float qa = 0.f, qb = 0.f;
#pragma unroll
  for (int i = 0; i < 4; i++) {
    va[i].x -= ma; va[i].y -= ma; va[i].z -= ma; va[i].w -= ma;
    vb[i].x -= mb; vb[i].y -= mb; vb[i].z -= mb; vb[i].w -= mb;
    qa += va[i].x * va[i].x + va[i].y * va[i].y + va[i].z * va[i].z + va[i].w * va[i].w;
    qb += vb[i].x * vb[i].x + vb[i].y * vb[i].y + vb[i].z * vb[i].z + vb[i].w * vb[i].w;
  }
  const float ra = rsqrtf(wave_sum(qa, lane) * (1.0f / 1024.0f) + 1e-5f), rb = rsqrtf(wave_sum(qb, lane) * (1.0f / 1024.0f) + 1e-5f);
#pragma unroll
  for (int i = 0; i < 4; i++) {
    float4 gg = *(const float4*)(g + i * 256 + lane * 4);
    float4 bb = *(const float4*)(b + i * 256 + lane * 4);
    float4 oa, ob;
    oa.x = va[i].x * ra * gg.x + bb.x; oa.y = va[i].y * ra * gg.y + bb.y; oa.z = va[i].z * ra * gg.z + bb.z; oa.w = va[i].w * ra * gg.w + bb.w;
    ob.x = vb[i].x * rb * gg.x + bb.x; ob.y = vb[i].y * rb * gg.y + bb.y; ob.z = vb[i].z * rb * gg.z + bb.z; ob.w = vb[i].w * rb * gg.w + bb.w;
    *(float4*)(dstA + i * 256 + lane * 4) = oa;
    *(float4*)(dstB + i * 256 + lane * 4) = ob;
    if (dbA) {
      *(uint2*)(dbA + i * 256 + lane * 4) = make_uint2(pk2(oa.x, oa.y), pk2(oa.z, oa.w));
      *(uint2*)(dbB + i * 256 + lane * 4) = make_uint2(pk2(ob.x, ob.y), pk2(ob.z, ob.w));
    }
  }
}

struct ScanIn {
  float kk[16][64], wr[16][64], w[16][64], kt[16][64], kka[16][64], v[16][64], g[16][64];
  float c[16][4];
};
struct ScanRaw { uint2 r, k, v, rp, kp, vp, a, g; float4 dec; };

__device__ __forceinline__ ScanRaw scan_fetch(const u16* __restrict__ P, const float* __restrict__ DEC,
                                              const u16* __restrict__ AA, const u16* __restrict__ GG, int rowbase, int t,
                                              int hc) {
  ScanRaw w;
  size_t row = (size_t)(rowbase + t);
  const u16* pp = P + row * PC_ + hc;
  w.r = *(const uint2*)(pp);
  w.k = *(const uint2*)(pp + 512);
  w.v = *(const uint2*)(pp + 1024);
  if (t > 0) {
    w.rp = *(const uint2*)(pp - PC_);
    w.kp = *(const uint2*)(pp - PC_ + 512);
    w.vp = *(const uint2*)(pp - PC_ + 1024);
  } else {
    w.rp = make_uint2(0, 0); w.kp = make_uint2(0, 0); w.vp = make_uint2(0, 0);
  }
  w.dec = *(const float4*)(DEC + row * 512 + hc);
  w.a = *(const uint2*)(AA + row * 512 + hc);
  w.g = *(const uint2*)(GG + row * 512 + hc);
  return w;
}

__device__ __forceinline__ void unpack4(uint2 u, float (&o)[4]) {
  o[0] = bflo(u.x); o[1] = bfhi(u.x); o[2] = bflo(u.y); o[3] = bfhi(u.y);
}

__device__ __forceinline__ void scan_unit(const Params& p, int l, int bh, char* smem, const int tid) {
  const int lane = tid & 63, wave = tid >> 6;
  const int b = bh >> 3, h = bh & 7;
  const int rowbase = b * T_;
  const u16* P = (const u16*)(p.ws + OFF_P);
  const float* DEC = (const float*)(p.ws + OFF_DEC);
  const u16* AA = (const u16*)(p.ws + OFF_AA);
  const u16* GG = (const u16*)(p.ws + OFF_GG);
  u16* YR = (u16*)(p.ws + OFF_AA);
  ScanIn* in = (ScanIn*)smem;
  float(*ybuf)[64] = (float(*)[64])(smem + 2 * sizeof(ScanIn));
  const int tl = tid >> 4, kq = tid & 15, hc = h * 64 + kq * 4;
  float(*cst)[64] = (float(*)[64])(smem + 2 * sizeof(ScanIn) + 16 * 64 * 4);
  if (tid < 64) {
    const float* mu = p.in[5] + (size_t)l * 1824;
    const int ch = h * 64 + tid;
    cst[0][tid] = mu[ch];
    cst[1][tid] = mu[512 + ch];
    cst[2][tid] = mu[1024 + ch];
    cst[3][tid] = p.in[11][l * 512 + ch];
    float ka_ = p.in[12][l * 512 + ch];
    cst[4][tid] = ka_;
    cst[5][tid] = 1.0f - ka_;
    cst[6][tid] = p.in[13][l * 512 + ch];
    cst[7][tid] = p.in[14][l * 512 + ch];
    cst[8][tid] = p.in[15][l * 512 + ch];
  }
  __syncthreads();
  const int rp = lane >> 3, ks = lane & 7, row0 = wave * 16 + rp * 2;
  typedef float f2s __attribute__((ext_vector_type(2)));
  f2s S2[2][4];
#pragma unroll
  for (int i = 0; i < 2; i++)
#pragma unroll
    for (int e = 0; e < 4; e++) S2[i][e] = f2s{0.f, 0.f};

  auto stage = [&](const ScanRaw& w, ScanIn& dst) {
    float r[4], k[4], v[4], rq[4], kp[4], vp[4], a[4], g[4];
    unpack4(w.r, r); unpack4(w.k, k); unpack4(w.v, v);
    unpack4(w.rp, rq); unpack4(w.kp, kp); unpack4(w.vp, vp);
    unpack4(w.a, a); unpack4(w.g, g);
    float dec[4] = {w.dec.x, w.dec.y, w.dec.z, w.dec.w};
    float mu_r[4], mu_k[4], mu_v[4], kkw[4], kaw[4], omk[4], rkw[4];
    *(float4*)mu_r = *(const float4*)&cst[0][kq * 4]; *(float4*)mu_k = *(const float4*)&cst[1][kq * 4];
    *(float4*)mu_v = *(const float4*)&cst[2][kq * 4]; *(float4*)kkw = *(const float4*)&cst[3][kq * 4];
    *(float4*)kaw = *(const float4*)&cst[4][kq * 4]; *(float4*)omk = *(const float4*)&cst[5][kq * 4];
    *(float4*)rkw = *(const float4*)&cst[6][kq * 4];
    float kkr[4], ss = 0.f;
#pragma unroll
    for (int e = 0; e < 4; e++) {
      r[e] = r[e] + (rq[e] - r[e]) * mu_r[e];
      k[e] = k[e] + (kp[e] - k[e]) * mu_k[e];
      v[e] = v[e] + (vp[e] - v[e]) * mu_v[e];
      kkr[e] = k[e] * kkw[e];
      ss += kkr[e] * kkr[e];
    }
    ss = sum16(ss);
    float inv = 1.0f / fmaxf(sqrtf(ss), 1e-12f);
    float c1 = 0.f, c2 = 0.f, c3 = 0.f;
    float kk[4], ktl[4], kka[4], wr[4];
#pragma unroll
    for (int e = 0; e < 4; e++) {
      kk[e] = kkr[e] * inv;
      ktl[e] = k[e] * fmaf(a[e], kaw[e], omk[e]);
      kka[e] = kk[e] * a[e];
      wr[e] = dec[e] * r[e];
      c1 += kka[e] * r[e];
      c2 += ktl[e] * r[e];
      c3 += r[e] * ktl[e] * rkw[e];
    }
    c1 = sum16(c1); c2 = sum16(c2); c3 = sum16(c3);
    *(float4*)&dst.kk[tl][kq * 4] = make_float4(kk[0], kk[1], kk[2], kk[3]);
    *(float4*)&dst.wr[tl][kq * 4] = make_float4(wr[0], wr[1], wr[2], wr[3]);
    *(float4*)&dst.w[tl][kq * 4] = make_float4(dec[0], dec[1], dec[2], dec[3]);
    *(float4*)&dst.kt[tl][kq * 4] = make_float4(ktl[0], ktl[1], ktl[2], ktl[3]);
    *(float4*)&dst.kka[tl][kq * 4] = make_float4(kka[0], kka[1], kka[2], kka[3]);
    *(float4*)&dst.v[tl][kq * 4] = make_float4(v[0], v[1], v[2], v[3]);
    *(float4*)&dst.g[tl][kq * 4] = make_float4(g[0], g[1], g[2], g[3]);
    if (kq == 0) *(float4*)&dst.c[tl][0] = make_float4(c1, c2, c3, 0.f);
  };

  {
    ScanRaw w0 = scan_fetch(P, DEC, AA, GG, rowbase, tl, hc);
    stage(w0, in[0]);
  }
  __syncthreads();
  constexpr int NCH = T_ / 16;
  for (int c = 0; c < NCH; c++) {
    ScanIn& cur = in[c & 1];
    ScanRaw nx;
    const bool have_next = (c + 1 < NCH);
    if (have_next) nx = scan_fetch(P, DEC, AA, GG, rowbase, (c + 1) * 16 + tl, hc);
    {
      typedef float f2 __attribute__((ext_vector_type(2)));
      struct StepA { float4 kk0, kk1, wr0, wr1; };
      struct StepIn { float4 kk0, kk1, wr0, wr1, w0, w1, kt0, kt1, ka0, ka1; float2 vv, cc; };
      auto ldA = [&](int s) {
        StepA r;
        r.kk0 = *(const float4*)&cur.kk[s][ks * 8]; r.kk1 = *(const float4*)&cur.kk[s][ks * 8 + 4];
        r.wr0 = *(const float4*)&cur.wr[s][ks * 8]; r.wr1 = *(const float4*)&cur.wr[s][ks * 8 + 4];
        return r;
      };
      StepA nxa = ldA(0);
#pragma unroll 1
      for (int s4 = 0; s4 < 16; s4 += 4) {
      float yv[4][2];
#pragma unroll
      for (int u = 0; u < 4; u++) {
        const int s = s4 + u;
        StepIn in_;
        in_.kk0 = nxa.kk0; in_.kk1 = nxa.kk1; in_.wr0 = nxa.wr0; in_.wr1 = nxa.wr1;
        in_.vv = *(const float2*)&cur.v[s][row0];
        in_.cc = *(const float2*)&cur.c[s][0];
        in_.w0 = *(const float4*)&cur.w[s][ks * 8];   in_.w1 = *(const float4*)&cur.w[s][ks * 8 + 4];
        in_.kt0 = *(const float4*)&cur.kt[s][ks * 8]; in_.kt1 = *(const float4*)&cur.kt[s][ks * 8 + 4];
        in_.ka0 = *(const float4*)&cur.kka[s][ks * 8]; in_.ka1 = *(const float4*)&cur.kka[s][ks * 8 + 4];
        nxa = ldA((s + 1) & 15);
        const f2 kk[4] = {{in_.kk0.x, in_.kk0.y}, {in_.kk0.z, in_.kk0.w}, {in_.kk1.x, in_.kk1.y}, {in_.kk1.z, in_.kk1.w}};
        const f2 wr[4] = {{in_.wr0.x, in_.wr0.y}, {in_.wr0.z, in_.wr0.w}, {in_.wr1.x, in_.wr1.y}, {in_.wr1.z, in_.wr1.w}};
        const f2 w[4] = {{in_.w0.x, in_.w0.y}, {in_.w0.z, in_.w0.w}, {in_.w1.x, in_.w1.y}, {in_.w1.z, in_.w1.w}};
        const f2 kt[4] = {{in_.kt0.x, in_.kt0.y}, {in_.kt0.z, in_.kt0.w}, {in_.kt1.x, in_.kt1.y}, {in_.kt1.z, in_.kt1.w}};
        const f2 ka[4] = {{in_.ka0.x, in_.ka0.y}, {in_.ka0.z, in_.ka0.w}, {in_.ka1.x, in_.ka1.y}, {in_.ka1.z, in_.ka1.w}};
        const float vr[2] = {in_.vv.x, in_.vv.y};
        float d1[2], d2[2];
#pragma unroll
        for (int i = 0; i < 2; i++) {
          f2 a = S2[i][0] * kk[0] + S2[i][1] * kk[1];
          f2 a2 = S2[i][2] * kk[2] + S2[i][3] * kk[3];
          f2 bq = S2[i][0] * wr[0] + S2[i][1] * wr[1];
          f2 b2 = S2[i][2] * wr[2] + S2[i][3] * wr[3];
          a += a2; bq += b2;
          d1[i] = a.x + a.y;
          d2[i] = bq.x + bq.y;
        }
        d1[0] = sum8(d1[0]); d1[1] = sum8(d1[1]); d2[0] = sum8(d2[0]); d2[1] = sum8(d2[1]);
#pragma unroll
        for (int i = 0; i < 2; i++) {
          const float skk = d1[i];
          yv[u][i] = d2[i] - skk * in_.cc.x + vr[i] * in_.cc.y;
          const f2 nsk = {-skk, -skk}, vv2 = {vr[i], vr[i]};
#pragma unroll
          for (int e = 0; e < 4; e++) S2[i][e] = S2[i][e] * w[e] + (nsk * ka[e] + vv2 * kt[e]);
        }
      }
      if (ks == 0) {
#pragma unroll
        for (int u = 0; u < 4; u++) *(float2*)&ybuf[s4 + u][row0] = make_float2(yv[u][0], yv[u][1]);
      }
      }
    }
    __syncthreads();
    {
      float4 y4 = *(const float4*)&ybuf[tl][kq * 4];
      float y[4] = {y4.x, y4.y, y4.z, y4.w};
      float mean = sum16(y[0] + y[1] + y[2] + y[3]) * (1.0f / 64.0f);
      float q = 0.f;
#pragma unroll
      for (int e = 0; e < 4; e++) { y[e] -= mean; q += y[e] * y[e]; }
      float rstd = rsqrtf(sum16(q) * (1.0f / 64.0f) + 64e-5f);
      float c3 = cur.c[tl][2];
      float4 v4 = *(const float4*)&cur.v[tl][kq * 4];
      float4 g4 = *(const float4*)&cur.g[tl][kq * 4];
      float vv[4] = {v4.x, v4.y, v4.z, v4.w};
      float gg[4] = {g4.x, g4.y, g4.z, g4.w};
      float o[4], lg[4], lb[4];
      *(float4*)lg = *(const float4*)&cst[7][kq * 4]; *(float4*)lb = *(const float4*)&cst[8][kq * 4];
#pragma unroll
      for (int e = 0; e < 4; e++) o[e] = (y[e] * rstd * lg[e] + lb[e] + c3 * vv[e]) * gg[e];
      size_t row = (size_t)(rowbase + c * 16 + tl);
      *(uint2*)(YR + row * 512 + hc) = make_uint2(pk2(o[0], o[1]), pk2(o[2], o[3]));
    }
    if (have_next) stage(nx, in[(c + 1) & 1]);
    __syncthreads();
  }
}

constexpr int KLD = 104, VLD = 72;
struct AttnSmem { u16 k[2][64 * KLD]; u16 v[2][64 * VLD]; };

__device__ __forceinline__ void attn_unit(const Params& p, int bh, int qi, char* smem, const int tid) {
  const int lane = tid & 63, wave = tid >> 6;
  const int fr = lane & 15, fq = lane >> 4;
  const int b = bh >> 3, h = bh & 7;
  const int rowbase = b * T_;
  u16* P = (u16*)(p.ws + OFF_P);
  const u16* Q = (const u16*)(p.ws + OFF_Q);
  const u16* KN = (const u16*)p.out;
  const u16* VT = (const u16*)p.out + (size_t)M_ * 512;
  const float2* ROPE = (const float2*)(p.ws + OFF_ROPE);
  AttnSmem* sm = (AttnSmem*)smem;
  const int qs = (qi == 0) ? 0 : 16 + (qi - 1) * 128;
  const int qn = (qi == 0) ? 16 : 128;
  const int q0 = qs + wave * 32;
  const bool wave_valid = (wave * 32 < qn);
  const int nkt = (qs + qn - 1) / 64 + 1;

  bf16x8 qf[2][3];
#pragma unroll
  for (int qb = 0; qb < 2; qb++) {
    int query = min(q0 + qb * 16 + fr, T_ - 1);
    const u16* qp = Q + (size_t)(rowbase + query) * 768 + h * 96;
    uint4 a0 = *(const uint4*)(qp + fq * 8);
    uint4 a1 = *(const uint4*)(qp + 32 + fq * 8);
    uint4 own = *(const uint4*)(qp + 64 + fq * 8);
    uint4 oth = *(const uint4*)(qp + 64 + (fq ^ 2) * 8);
    unsigned ow[4] = {own.x, own.y, own.z, own.w};
    unsigned tw[4] = {oth.x, oth.y, oth.z, oth.w};
    unsigned rw[4];
    const float2* rp = ROPE + (size_t)query * 16 + (fq & 1) * 8;
#pragma unroll
    for (int e = 0; e < 4; e++) {
      float2 cs0 = rp[2 * e], cs1 = rp[2 * e + 1];
      float o0 = bflo(ow[e]), o1 = bfhi(ow[e]);
      float t0 = bflo(tw[e]), t1 = bfhi(tw[e]);
      float r0, r1;
      if (fq < 2) { r0 = o0 * cs0.x - t0 * cs0.y; r1 = o1 * cs1.x - t1 * cs1.y; }
      else { r0 = t0 * cs0.y + o0 * cs0.x; r1 = t1 * cs1.y + o1 * cs1.x; }
      rw[e] = pk2(r0, r1);
    }
    uint4 a2 = make_uint4(rw[0], rw[1], rw[2], rw[3]);
    qf[qb][0] = *(bf16x8*)&a0;
    qf[qb][1] = *(bf16x8*)&a1;
    qf[qb][2] = *(bf16x8*)&a2;
  }

  f32x4 O[4][2];
#pragma unroll
  for (int i = 0; i < 4; i++)
#pragma unroll
    for (int j = 0; j < 2; j++) O[i][j] = f32x4{0.f, 0.f, 0.f, 0.f};
  float mrun[2] = {-1e30f, -1e30f}, lrun[2] = {0.f, 0.f};
  const float sc = 1.4426950408889634f / 9.797958971132712f;

  uint4 rk[3], rv[2];
  auto fetch_tile = [&](int kt) {
#pragma unroll
    for (int i = 0; i < 3; i++) {
      int c = tid + 256 * i;
      int key = c / 12, cc = c % 12;
      int t = kt * 64 + key;
      uint4 val = make_uint4(0, 0, 0, 0);
      if (t < T_) {
        size_t row = (size_t)(rowbase + t);
        if (cc < 8) val = *(const uint4*)(KN + row * 512 + h * 64 + cc * 8);
        else val = *(const uint4*)(P + row * PC_ + PKR_ + (cc - 8) * 8);
      }
      rk[i] = val;
    }
#pragma unroll
    for (int i = 0; i < 2; i++) {
      int c = tid + 256 * i;
      int dv = c >> 3, cc = c & 7;
      int t = kt * 64 + cc * 8;
      uint4 val = make_uint4(0, 0, 0, 0);
      if (t < T_) val = *(const uint4*)(VT + ((size_t)bh * 64 + dv) * T_ + t);
      rv[i] = val;
    }
  };
  auto store_tile = [&](int buf) {
#pragma unroll
    for (int i = 0; i < 3; i++) {
      int c = tid + 256 * i;
      int key = c / 12, cc = c % 12;
      *(uint4*)(&sm->k[buf][key * KLD + cc * 8]) = rk[i];
    }
#pragma unroll
    for (int i = 0; i < 2; i++) {
      int c = tid + 256 * i;
      int dv = c >> 3, cc = c & 7;
      *(uint4*)(&sm->v[buf][dv * VLD + cc * 8]) = rv[i];
    }
  };

  fetch_tile(0);
  for (int kt = 0; kt < nkt; kt++) {
    const int buf = kt & 1;
    store_tile(buf);
    __syncthreads();
    if (kt + 1 < nkt) fetch_tile(kt + 1);
    if (wave_valid && kt * 64 <= q0 + 31) {
      const u16* Ks = sm->k[buf];
      const u16* Vs = sm->v[buf];
      f32x4 s[4][2];
#pragma unroll
      for (int i = 0; i < 4; i++)
#pragma unroll
        for (int j = 0; j < 2; j++) s[i][j] = f32x4{0.f, 0.f, 0.f, 0.f};
#pragma unroll
      for (int ks = 0; ks < 3; ks++)
#pragma unroll
        for (int kb = 0; kb < 4; kb++) {
          bf16x8 kf = *(const bf16x8*)(Ks + (kb * 16 + fr) * KLD + ks * 32 + fq * 8);
#pragma unroll
          for (int qb = 0; qb < 2; qb++) s[kb][qb] = __builtin_amdgcn_mfma_f32_16x16x32_bf16(kf, qf[qb][ks], s[kb][qb], 0, 0, 0);
        }
      const bool need_mask = (kt * 64 + 63 > q0);
      unsigned pfw[2][2][4];
#pragma unroll
      for (int qb = 0; qb < 2; qb++) {
        const int query = q0 + qb * 16 + fr;
        float mx = -1e30f;
        if (need_mask) {
#pragma unroll
          for (int kb = 0; kb < 4; kb++)
#pragma unroll
            for (int j = 0; j < 4; j++) {
              int key = kt * 64 + kb * 16 + fq * 4 + j;
              if (key > query) s[kb][qb][j] = -1e30f;
            }
        }
#pragma unroll
        for (int kb = 0; kb < 4; kb++)
          mx = fmaxf(mx, fmaxf(fmaxf(s[kb][qb][0], s[kb][qb][1]), fmaxf(s[kb][qb][2], s[kb][qb][3])));
        mx = fmaxf(mx, shx(mx, lane, 16));
        mx = fmaxf(mx, shx(mx, lane, 32));
        const float mold = mrun[qb];
        const float mnew = fmaxf(mold, mx * sc);
        mrun[qb] = mnew;
        float ps = 0.f;
#pragma unroll
        for (int kb = 0; kb < 4; kb++) {
          float p0 = __builtin_amdgcn_exp2f(fmaf(s[kb][qb][0], sc, -mnew)), p1 = __builtin_amdgcn_exp2f(fmaf(s[kb][qb][1], sc, -mnew));
          float p2 = __builtin_amdgcn_exp2f(fmaf(s[kb][qb][2], sc, -mnew)), p3 = __builtin_amdgcn_exp2f(fmaf(s[kb][qb][3], sc, -mnew));
          ps += (p0 + p1) + (p2 + p3);
          pfw[qb][kb >> 1][(kb & 1) * 2 + 0] = pk2(p0, p1);
          pfw[qb][kb >> 1][(kb & 1) * 2 + 1] = pk2(p2, p3);
        }
        if (__builtin_amdgcn_ballot_w64(mnew != mold) != 0) {
          const float alpha = __builtin_amdgcn_exp2f(mold - mnew);
          lrun[qb] *= alpha;
#pragma unroll
          for (int dvb = 0; dvb < 4; dvb++) {
            O[dvb][qb][0] *= alpha; O[dvb][qb][1] *= alpha; O[dvb][qb][2] *= alpha; O[dvb][qb][3] *= alpha;
          }
        }
        lrun[qb] += ps;
      }
#pragma unroll
      for (int s2 = 0; s2 < 2; s2++)
#pragma unroll
        for (int dvb = 0; dvb < 4; dvb++) {
          const u16* vp = Vs + (dvb * 16 + fr) * VLD + s2 * 32 + fq * 4;
          uint2 v0 = *(const uint2*)vp;
          uint2 v1 = *(const uint2*)(vp + 16);
          uint4 vv = make_uint4(v0.x, v0.y, v1.x, v1.y);
          bf16x8 vf = *(bf16x8*)&vv;
#pragma unroll
          for (int qb = 0; qb < 2; qb++) {
            uint4 pw = make_uint4(pfw[qb][s2][0], pfw[qb][s2][1], pfw[qb][s2][2], pfw[qb][s2][3]);
            O[dvb][qb] = __builtin_amdgcn_mfma_f32_16x16x32_bf16(vf, *(bf16x8*)&pw, O[dvb][qb], 0, 0, 0);
          }
        }
    }
  }
  __syncthreads();
  if (wave_valid) {
#pragma unroll
    for (int qb = 0; qb < 2; qb++) {
      float l = lrun[qb];
      l += shx(l, lane, 16);
      l += shx(l, lane, 32);
      float inv = 1.0f / l;
      int query = q0 + qb * 16 + fr;
      if (query < qs + qn) {
        u16* op = P + (size_t)(rowbase + query) * PC_ + PMLA_ + h * 64 + fq * 4;
#pragma unroll
        for (int dvb = 0; dvb < 4; dvb++) {
          *(uint2*)(op + dvb * 16) =
              make_uint2(pk2(O[dvb][qb][0] * inv, O[dvb][qb][1] * inv), pk2(O[dvb][qb][2] * inv, O[dvb][qb][3] * inv));
        }
      }
    }
  }
}

#define XB_TMO      128
#define XB_XCNT(j)  (256  + 64 * (j))
#define XB_XSUB(j)  (1280 + 64 * (j))
#define XB_XGEN(j)  (2304 + 64 * (j))
#define XB_TOP      3328
#define XB_TOPGEN   3392
#define XCD_BAR_WORDS 3456
#define XB_SPIN_CAP (1u << 18)
#define LAS __attribute__((address_space(3)))

__device__ __forceinline__ unsigned xb_ld(unsigned* p)              { return __hip_atomic_load(p, __ATOMIC_RELAXED, __HIP_MEMORY_SCOPE_AGENT); }
__device__ __forceinline__ unsigned xb_add(unsigned* p, unsigned v) { return __hip_atomic_fetch_add(p, v, __ATOMIC_RELAXED, __HIP_MEMORY_SCOPE_AGENT); }
__device__ __forceinline__ unsigned xb_xcc_id() { return (unsigned)__builtin_amdgcn_s_getreg((3 << 11) | 20) & 0xFu; }
#define XB_SPIN(cond, bar) do { unsigned _sp = 0; while (cond) { __builtin_amdgcn_s_sleep(1); \
    if ((++_sp & 255u) == 0u) { if (xb_ld(&(bar)[XB_TMO])) break; if (_sp > XB_SPIN_CAP) { atomicAdd(&(bar)[XB_TMO], 1u); break; } } } } while (0)

struct XcdBarrier {
    unsigned* bar; unsigned x;
    volatile LAS unsigned* st;
};

__device__ __forceinline__ XcdBarrier xcd_barrier_post(unsigned* bar, volatile LAS unsigned* st) {
    XcdBarrier b; b.bar = bar; b.x = xb_xcc_id(); b.st = st;
    if (threadIdx.x == 0) (void)xb_add(&bar[XB_XCNT(b.x)], 1u);
    return b;
}
__device__ __forceinline__ void xcd_barrier_complete(unsigned* bar, unsigned x, unsigned& nloc, unsigned& nx) {
    const unsigned G = gridDim.x * gridDim.y * gridDim.z;
    unsigned sum, cnt, mine, sp = 0u;
    for (;;) {
        sum = 0u; cnt = 0u; mine = 0u;
#pragma unroll
        for (unsigned j = 0; j < 16; ++j) { const unsigned c = xb_ld(&bar[XB_XCNT(j)]); sum += c; cnt += (c > 0u) ? 1u : 0u; mine = (j == x) ? c : mine; }
        if (sum == G) break;
        __builtin_amdgcn_s_sleep(1);
        if ((++sp & 255u) == 0u) { if (xb_ld(&bar[XB_TMO])) break; if (sp > XB_SPIN_CAP) { atomicAdd(&bar[XB_TMO], 1u); break; } }
    }
    nloc = mine > 0u ? mine : 1u; nx = cnt > 0u ? cnt : 1u;
}

__device__ __forceinline__ void xcd_barrier(const XcdBarrier& b, const int tid_) {
    asm volatile("s_waitcnt vmcnt(0)" ::: "memory");
    __syncthreads();
    if (tid_ == 0) {
        unsigned* bar = b.bar;
        __builtin_amdgcn_s_waitcnt(0);
        unsigned nloc = b.st[0], nx = b.st[1];
        if (nloc == 0u) { xcd_barrier_complete(bar, b.x, nloc, nx); b.st[0] = nloc; b.st[1] = nx; }
        const unsigned old = xb_add(&bar[XB_XSUB(b.x)], 1u);
        const unsigned gen = old / nloc;
        if (old + 1u == (gen + 1u) * nloc) {
            __builtin_amdgcn_fence(__ATOMIC_RELEASE, "agent");
            asm volatile("s_waitcnt vmcnt(0)" ::: "memory");
            const unsigned og = xb_add(&bar[XB_TOP], 1u);
            const unsigned tg = og / nx;
            if (og + 1u == (tg + 1u) * nx) xb_add(&bar[XB_TOPGEN], 1u);
            else XB_SPIN(xb_ld(&bar[XB_TOPGEN]) == tg, bar);
            __builtin_amdgcn_fence(__ATOMIC_ACQUIRE, "agent");
            xb_add(&bar[XB_XGEN(b.x)], 1u);
            asm volatile("s_waitcnt vmcnt(0)" ::: "memory");
        } else {
            XB_SPIN(xb_ld(&bar[XB_XGEN(b.x)]) == gen, bar);
            __builtin_amdgcn_fence(__ATOMIC_ACQUIRE, "agent");
            asm volatile("s_waitcnt vmcnt(0)" ::: "memory");
        }
    }
    __syncthreads();
}


__global__ void __launch_bounds__(256, 2) mega(Params p) {
  cg::grid_group grid = cg::this_grid();
  __shared__ __attribute__((aligned(16))) char smem[SMEM_BYTES];
  __shared__ int s_unit;
  __shared__ uint4 xb_words;
  if (threadIdx.x == 0) xb_words = make_uint4(0u, 0u, 0u, 0u);
  __syncthreads();
  (void)xcd_barrier_post((unsigned*)(p.ws + OFF_BAR), (volatile LAS unsigned*)&xb_words);
#define XB_SYNC() do { XcdBarrier xb_; xb_.bar = (unsigned*)(p.ws + OFF_BAR); xb_.x = xb_xcc_id(); xb_.st = (volatile LAS unsigned*)&xb_words; xcd_barrier(xb_, wave0 * 64 + fresh_lane()); } while (0)
  int wave0 = __builtin_amdgcn_readfirstlane((int)(threadIdx.x >> 6));
  asm volatile("" : "+s"(wave0));
  const int nblk = gridDim.x;
  float* H = (float*)(p.ws + OFF_H);
  u16* P = (u16*)(p.ws + OFF_P);
  float* DEC = (float*)(p.ws + OFF_DEC);
  u16* AA = (u16*)(p.ws + OFF_AA);
  u16* GG = (u16*)(p.ws + OFF_GG);
  u16* Q = (u16*)(p.ws + OFF_Q);
  u16* MIX = (u16*)(p.ws + OFF_DEC);
  u16* HB1 = (u16*)p.out + (size_t)2 * M_ * 512;
  u16* HB2 = (u16*)(p.ws + OFF_HB2);
  u16* HBH = (u16*)(p.ws + OFF_AA);
  const u16* ZERO = (const u16*)(p.ws + OFF_ZERO);
  u16* ACT = (u16*)(p.ws + OFF_P);
  float2* ROPE = (float2*)(p.ws + OFF_ROPE);
  int* CTR = (int*)(p.ws + OFF_CTR);
  u16* KN = (u16*)p.out;
  u16* VT = KN + (size_t)M_ * 512;
  u16* YR = AA;

  {
  PHASE_TID
  for (int t = blockIdx.x; t < p.nconv; t += nblk) conv_tile(p, t, smem, tid);
  for (int i = blockIdx.x * 256 + tid; i < T_ * 16; i += nblk * 256) {
    int t = i >> 4, f = i & 15;
    double rev = (double)t * ROPE_C[f];
    rev -= floor(rev);
    float r = (float)rev;
    ROPE[i] = make_float2(__builtin_amdgcn_cosf(r), __builtin_amdgcn_sinf(r));
  }
  for (int row = blockIdx.x * 4 + wave; row < M_; row += nblk * 4) {
    int b = row / T_, t = row % T_;
    const float* src = (t < NMETA_) ? (p.in[1] + (size_t)t * 1024) : (p.in[0] + ((size_t)b * SEQ_ + (t - NMETA_)) * 1024);
    ln_row(src, p.in[2], p.in[3], H + (size_t)row * 1024, lane, (row < HB_SPLIT) ? HB1 + (size_t)row * 1024 : HB2 + (size_t)(row - HB_SPLIT) * 1024);
  }
  if (blockIdx.x == 0 && tid < 16) CTR[tid] = 0;
  if (blockIdx.x == 1) { for (int i = tid; i < 2048; i += 256) ((unsigned*)(p.ws + OFF_ZERO))[i] = 0u; }
  }
  grid.sync();

#pragma unroll 1
  for (int ph_ = 0; ph_ < 20; ph_++) {
    const int l = ph_ / 10, kph = ph_ - l * 10;
    const u16* WL = (const u16*)(p.ws + OFF_W) + (size_t)l * W_LAYER;
    if (kph == 0) {
    PHASE_TID
    for (int it_ = 0; it_ * nblk < 257 * 19; it_++) {
      int mt, nt;
      if (!map_tile(it_, nblk, 257, 19, mt, nt)) continue;
      f32x4 acc[8][4];
      zero_acc8(acc);
      ADma al = ADma{(mt < 255) ? HB1 : HB2, 1024, (mt < 255) ? mt * 256 : mt * 256 - HB_SPLIT, 0, ZERO, 0};
      gemm3(acc, al, WL + W_IN, 1024, nt * 128, 1024, smem, tid);
      ACC_COORDS
#pragma unroll
      for (int mi = 0; mi < 8; mi++)
#pragma unroll
        for (int ni = 0; ni < 4; ni++) {
          int col = nt * 128 + wc * 64 + ni * 16 + fq * 4;
          int row = mt * 256 + wr * 128 + mi * 16 + fr;
          if (col < PC_)
            *(uint2*)(P + (size_t)row * PC_ + col) = make_uint2(pk2(acc[mi][ni][0], acc[mi][ni][1]), pk2(acc[mi][ni][2], acc[mi][ni][3]));
        }
    }
    }
    if (kph == 1) {
    PHASE_TID
    {
      const float* qg = p.in[16] + l * 256;
      const float* kvg = p.in[18] + l * 256;
      for (int row = blockIdx.x * 4 + wave; row < M_; row += nblk * 4) {
        u16* pr = P + (size_t)row * PC_;
        uint2 cq = *(const uint2*)(pr + PMLA_ + lane * 4);
        uint2 ckv = *(const uint2*)(pr + PKV_ + lane * 4);
        float a[4], c[4];
        unpack4(cq, a);
        unpack4(ckv, c);
        float s1 = a[0] * a[0] + a[1] * a[1] + a[2] * a[2] + a[3] * a[3];
        float s2 = c[0] * c[0] + c[1] * c[1] + c[2] * c[2] + c[3] * c[3];
        s1 = wave_sum(s1, lane);
        s2 = wave_sum(s2, lane);
        float r1 = rsqrtf(s1 * (1.0f / 256.0f) + 1e-6f), r2 = rsqrtf(s2 * (1.0f / 256.0f) + 1e-6f);
        float4 g1 = *(const float4*)(qg + lane * 4), g2 = *(const float4*)(kvg + lane * 4);
        *(uint2*)(pr + PMLA_ + lane * 4) = make_uint2(pk2(a[0] * r1 * g1.x, a[1] * r1 * g1.y), pk2(a[2] * r1 * g1.z, a[3] * r1 * g1.w));
        *(uint2*)(pr + PKV_ + lane * 4) = make_uint2(pk2(c[0] * r2 * g2.x, c[1] * r2 * g2.y), pk2(c[2] * r2 * g2.z, c[3] * r2 * g2.w));
        if (lane < 16) {
          int t = row % T_;
          float x1 = bf2f(pr[PKR_ + lane]), x2 = bf2f(pr[PKR_ + 16 + lane]);
          float2 cs = ROPE[t * 16 + lane];
          pr[PKR_ + lane] = f2bf(x1 * cs.x - x2 * cs.y);
          pr[PKR_ + 16 + lane] = f2bf(x1 * cs.y + x2 * cs.x);
        }
      }
      const float* mu = p.in[5] + (size_t)l * 1824;
      for (int tile = blockIdx.x; tile < 514 * 12; tile += nblk) {
        int mt = tile / 12, sub = tile % 12, which = sub >> 2, nt = sub & 3;
        f32x4 acc[4][4];
        zero_acc(acc);
        ACC_COORDS
        if (which == 0) {
          AL<3> al{P + 1536, PC_, mt * 128, 0, 64, mu + 1536, 0};
          gemm_loop(acc, al, WL + W_LW, 64, nt * 128, 64, smem, tid);
          const float* w0 = p.in[6] + l * 512;
#pragma unroll
          for (int mi = 0; mi < 4; mi++)
#pragma unroll
            for (int ni = 0; ni < 4; ni++) {
              int col = nt * 128 + wc * 64 + ni * 16 + fr;
              float w0c = w0[col];
#pragma unroll
              for (int j = 0; j < 4; j++) {
                int row = mt * 128 + wr * 64 + mi * 16 + fq * 4 + j;
                float x = -(acc[mi][ni][j] + w0c);
                float sp = fmaxf(x, 0.f) + log1pf(__expf(-fabsf(x)));
                float wraw = -sp - 0.5f;
                DEC[(size_t)row * 512 + col] = __expf(-__expf(wraw));
              }
            }
        } else if (which == 1) {
          AL<3> al{P + 1600, PC_, mt * 128, 0, 64, mu + 1600, 1};
          gemm_loop(acc, al, WL + W_LA, 64, nt * 128, 64, smem, tid);
          const float* a0 = p.in[8] + l * 512;
#pragma unroll
          for (int mi = 0; mi < 4; mi++)
#pragma unroll
            for (int ni = 0; ni < 4; ni++) {
              int col = nt * 128 + wc * 64 + ni * 16 + fr;
              float a0c = a0[col];
#pragma unroll
              for (int j = 0; j < 4; j++) {
                int row = mt * 128 + wr * 64 + mi * 16 + fq * 4 + j;
                AA[(size_t)row * 512 + col] = f2bf(sigmoidf_(acc[mi][ni][j] + a0c));
              }
            }
        } else {
          AL<3> al{P + 1664, PC_, mt * 128, 0, 160, mu + 1664, 2};
          gemm_loop(acc, al, WL + W_LG, 192, nt * 128, 192, smem, tid);
#pragma unroll
          for (int mi = 0; mi < 4; mi++)
#pragma unroll
            for (int ni = 0; ni < 4; ni++) {
              int col = nt * 128 + wc * 64 + ni * 16 + fr;
#pragma unroll
              for (int j = 0; j < 4; j++) {
                int row = mt * 128 + wr * 64 + mi * 16 + fq * 4 + j;
                GG[(size_t)row * 512 + col] = f2bf(acc[mi][ni][j]);
              }
            }
        }
      }
    }
    }
    if (kph == 2) {
    PHASE_TID
    for (int it_ = 0; it_ * nblk < 257 * 14; it_++) {
      int mt, sub;
      if (!map_tile(it_, nblk, 257, 14, mt, sub)) continue;
      f32x4 acc[8][4];
      zero_acc8(acc);
      ACC_COORDS
      if (sub < 6) {
        ADma al{P + PMLA_, PC_, mt * 256, 0, ZERO, 0};
        gemm3(acc, al, WL + W_UQ, 256, sub * 128, 256, smem, tid);
#pragma unroll
        for (int mi = 0; mi < 8; mi++)
#pragma unroll
          for (int ni = 0; ni < 4; ni++) {
            int col = sub * 128 + wc * 64 + ni * 16 + fq * 4;
            int row = mt * 256 + wr * 128 + mi * 16 + fr;
            *(uint2*)(Q + (size_t)row * 768 + col) = make_uint2(pk2(acc[mi][ni][0], acc[mi][ni][1]), pk2(acc[mi][ni][2], acc[mi][ni][3]));
          }
      } else if (sub < 10) {
        int nt = sub - 6;
        ADma al{P + PKV_, PC_, mt * 256, 0, ZERO, 0};
        gemm3(acc, al, WL + W_UK, 256, nt * 128, 256, smem, tid);
#pragma unroll
        for (int mi = 0; mi < 8; mi++)
#pragma unroll
          for (int ni = 0; ni < 4; ni++) {
            int col = nt * 128 + wc * 64 + ni * 16 + fq * 4;
            int row = mt * 256 + wr * 128 + mi * 16 + fr;
            *(uint2*)(KN + (size_t)row * 512 + col) = make_uint2(pk2(acc[mi][ni][0], acc[mi][ni][1]), pk2(acc[mi][ni][2], acc[mi][ni][3]));
          }
      } else {
        int nt = sub - 10;
        ADma al{P + PKV_, PC_, mt * 256, 0, ZERO, 0};
        gemm3<4, false>(acc, al, WL + W_UV, 256, nt * 128, 256, smem, tid);
#pragma unroll
        for (int mi = 0; mi < 8; mi++)
#pragma unroll
          for (int ni = 0; ni < 4; ni++) {
            int col = nt * 128 + wc * 64 + ni * 16 + fr;
            int row = mt * 256 + wr * 128 + mi * 16 + fq * 4;
            int b = row / T_, t = row % T_;
            size_t o = ((size_t)(b * 512 + col)) * T_ + t;
            *(uint2*)(VT + o) = make_uint2(pk2(acc[mi][ni][0], acc[mi][ni][1]), pk2(acc[mi][ni][2], acc[mi][ni][3]));
          }
      }
    }
    }
    if (kph == 3) {
    PHASE_TID
    {
      const int xcd = blockIdx.x & 7, loc = blockIdx.x >> 3;
      const int total = 16 * 33;
      const bool scan_wg = (loc < 16), partner = (loc >= (nblk >> 4) && loc < (nblk >> 4) + 16);
      if (scan_wg) {
        scan_unit(p, l, xcd * 16 + loc, smem, launder(tid));
        __syncthreads();
      }
      if (!partner) {
        while (true) {
          if (tid == 0) s_unit = atomicAdd(&CTR[l * 8 + xcd], 1);
          __syncthreads();
          int v = s_unit;
          __syncthreads();
          if (v >= total) break;
          const int tidu = launder(tid);
          int g = v / 66, w = v - g * 66;
          attn_unit(p, xcd * 16 + g * 2 + (w & 1), 32 - (w >> 1), smem, tidu);
          __syncthreads();
        }
      }
    }
    }
    if (kph == 4) {
    PHASE_TID
    for (int it_ = 0; it_ * nblk < 257 * 16; it_++) {
      int mt, nt;
      if (!map_tile(it_, nblk, 257, 16, mt, nt)) continue;
      f32x4 acc[8][2];
      unsigned sg[8][2][2];
      ADma alh = ADma{(mt < 255) ? HB1 : HB2, 1024, (mt < 255) ? mt * 256 : mt * 256 - HB_SPLIT, 0, ZERO, 0};
      zero_acc8(acc);
      const int tid1 = launder(tid);
      gemm3(acc, alh, WL + W_G, 1024, nt * 64, 1024, smem, tid1);
#pragma unroll
      for (int mi = 0; mi < 8; mi++)
#pragma unroll
        for (int ni = 0; ni < 2; ni++) {
          sg[mi][ni][0] = pk2(sigmoidf_(acc[mi][ni][0]), sigmoidf_(acc[mi][ni][1]));
          sg[mi][ni][1] = pk2(sigmoidf_(acc[mi][ni][2]), sigmoidf_(acc[mi][ni][3]));
        }
      zero_acc8(acc);
      {
        ADma aly{YR, 512, mt * 256, 0, ZERO, 0};
        const int tid2 = launder(tid);
      gemm3(acc, aly, WL + W_PR, 512, nt * 64, 512, smem, tid2);
      }
{ const int tidq = launder(tid); const int lane = tidq & 63, wave = tidq >> 6; ACC_COORDS
#pragma unroll
      for (int mi = 0; mi < 8; mi++)
#pragma unroll
        for (int ni = 0; ni < 2; ni++) {
          int col = nt * 64 + wc * 32 + ni * 16 + fq * 4;
          int row = mt * 256 + wr * 128 + mi * 16 + fr;
          *(uint2*)(MIX + (size_t)row * 1024 + col) = make_uint2(pk2(bflo(sg[mi][ni][0]) * acc[mi][ni][0], bfhi(sg[mi][ni][0]) * acc[mi][ni][1]),
                                                                 pk2(bflo(sg[mi][ni][1]) * acc[mi][ni][2], bfhi(sg[mi][ni][1]) * acc[mi][ni][3]));
        }
      }
      zero_acc8(acc);
      const int tid3 = launder(tid);
      gemm3(acc, alh, WL + W_G, 1024, 1024 + nt * 64, 1024, smem, tid3);
#pragma unroll
      for (int mi = 0; mi < 8; mi++)
#pragma unroll
        for (int ni = 0; ni < 2; ni++) {
          sg[mi][ni][0] = pk2(sigmoidf_(acc[mi][ni][0]), sigmoidf_(acc[mi][ni][1]));
          sg[mi][ni][1] = pk2(sigmoidf_(acc[mi][ni][2]), sigmoidf_(acc[mi][ni][3]));
        }
      zero_acc8(acc);
      {
        ADma alm{P + PMLA_, PC_, mt * 256, 0, ZERO, 0};
        const int tid4 = launder(tid);
      gemm3(acc, alm, WL + W_PM, 512, nt * 64, 512, smem, tid4);
      }
{ const int tidq = launder(tid); const int lane = tidq & 63, wave = tidq >> 6; ACC_COORDS
#pragma unroll
      for (int mi = 0; mi < 8; mi++)
#pragma unroll
        for (int ni = 0; ni < 2; ni++) {
          int col = nt * 64 + wc * 32 + ni * 16 + fq * 4;
          int row = mt * 256 + wr * 128 + mi * 16 + fr;
          uint2 pm = *(const uint2*)(MIX + (size_t)row * 1024 + col);
          float o0 = bflo(pm.x) + bflo(sg[mi][ni][0]) * acc[mi][ni][0];
          float o1 = bfhi(pm.x) + bfhi(sg[mi][ni][0]) * acc[mi][ni][1];
          float o2 = bflo(pm.y) + bflo(sg[mi][ni][1]) * acc[mi][ni][2];
          float o3 = bfhi(pm.y) + bfhi(sg[mi][ni][1]) * acc[mi][ni][3];
          *(uint2*)(MIX + (size_t)row * 1024 + col) = make_uint2(pk2(o0, o1), pk2(o2, o3));
        }
      }
    }
    }
    if (kph == 5) {
    PHASE_TID
    for (int prb_ = (PROBE_FI ? 0 : 1); prb_ < 2; prb_++)
    for (int it_ = 0; it_ * nblk < 257 * 8; it_++) {
      int mt, nt;
      if (!map_tile(it_, nblk, 257, 8, mt, nt)) continue;
      f32x4 acc[8][4];
      zero_acc8(acc);
      ACC_COORDS
      ADma al{MIX, 1024, mt * 256, 0, ZERO, 0};
      gemm3(acc, al, WL + W_OUT, 1024, nt * 128, 1024, smem, tid);
#pragma unroll
      for (int mi = 0; mi < 8; mi++)
#pragma unroll
        for (int ni = 0; ni < 4; ni++) {
          int col = nt * 128 + wc * 64 + ni * 16 + fq * 4;
          int row = mt * 256 + wr * 128 + mi * 16 + fr;
          float* hp = H + (size_t)row * 1024 + col;
          float* dp = (prb_ == 0) ? (p.out + (size_t)(row & 65535) * 1024 + col) : hp;
          float4 hv = *(const float4*)hp;
          hv.x = ALPHA_ * hv.x + acc[mi][ni][0];
          hv.y = ALPHA_ * hv.y + acc[mi][ni][1];
          hv.z = ALPHA_ * hv.z + acc[mi][ni][2];
          hv.w = ALPHA_ * hv.w + acc[mi][ni][3];
          *(float4*)dp = hv;
        }
    }
    }
    if (kph == 6) {
    PHASE_TID
    for (int row = (blockIdx.x * 4 + wave) * 2; row < M_; row += nblk * 8)
      ln_row2(H + (size_t)row * 1024, H + (size_t)(row + 1) * 1024, p.in[24] + l * 1024, p.in[25] + l * 1024, H + (size_t)row * 1024, H + (size_t)(row + 1) * 1024, lane, HBH + (size_t)row * 1024, HBH + (size_t)(row + 1) * 1024);
    }
    if (kph == 7) {
    PHASE_TID
    {
      const float* cw = p.in[27] + (size_t)l * 3 * 5632;
      const float* cb = p.in[28] + (size_t)l * 5632;
#if PROBE_HOT
      for (int it_ = 0; it_ * nblk < 272 * 44; it_++) {
        int rest, nt;
        if (!map_tile(it_, nblk, 272, 44, rest, nt)) continue;
        f32x4 acc[8][4];
        zero_acc8(acc);
#if PROBE_HOT == 1
        ADma al{HBH, 1024, 0, 0, ZERO, 1, p.ws};
        gemm3(acc, al, WL + W_UP, 1024, 0, 1024, smem, tid);
#else
        int it = rest % 17, b = rest / 17;
        ADma al{HBH, 1024, b * T_, 254 * it - 2, ZERO, 1, p.ws};
        gemm3(acc, al, WL + W_UP, 1024, nt * 128, 1024, smem, tid);
#endif
        float sacc = 0.f;
#pragma unroll
        for (int mi = 0; mi < 8; mi++)
#pragma unroll
          for (int ni = 0; ni < 4; ni++) sacc += acc[mi][ni][0] + acc[mi][ni][1] + acc[mi][ni][2] + acc[mi][ni][3];
        if (sacc == 12345.678f) ACT[tid] = 0;
      }
#endif
      for (int it_ = 0; it_ * nblk < 272 * 44; it_++) {
        int rest, nt;
        if (!map_tile(it_, nblk, 272, 44, rest, nt)) continue;
        int it = rest % 17, b = rest / 17;
        int t0 = 254 * it - 2;
        f32x4 acc[8][4];
        zero_acc8(acc);
        ADma al{HBH, 1024, b * T_, t0, ZERO, 1, p.ws};
        gemm3(acc, al, WL + W_UP, 1024, nt * 128, 1024, smem, launder(tid));
        ACC_COORDS
        float(*ut)[132] = (float(*)[132])smem;
        const int tidh = launder(tid);
        const int c = tidh & 63, rg = tidh >> 6;
        const int gcol = nt * 64 + c, vcol = DFF_ + nt * 64 + c;
        const float g0 = cw[gcol], g1 = cw[5632 + gcol], g2 = cw[2 * 5632 + gcol], gb = cb[gcol];
        const float v0 = cw[vcol], v1 = cw[5632 + vcol], v2 = cw[2 * 5632 + vcol], vb = cb[vcol];
#pragma unroll 1
        for (int half = 0; half < 2; half++) {
          float carry = 0.f;
          if (half == 1) carry = ut[126 + (tid >> 7)][tid & 127];
          __syncthreads();
          if (half == 1) ut[tid >> 7][tid & 127] = carry;
          if (wr == half) {
#pragma unroll
            for (int mi = 0; mi < 8; mi++)
#pragma unroll
              for (int ni = 0; ni < 4; ni++)
                *(float4*)&ut[half * 2 + mi * 16 + fr][wc * 64 + ni * 16 + fq * 4] = make_float4(acc[mi][ni][0], acc[mi][ni][1], acc[mi][ni][2], acc[mi][ni][3]);
          }
          __syncthreads();
          const int nq = half ? 130 : 128;
          int qs = 2 + rg * 32, qe = min(qs + 32, nq);
          float ga = ut[qs - 2][c], gbp = ut[qs - 1][c];
          float va = ut[qs - 2][64 + c], vbp = ut[qs - 1][64 + c];
          for (int q = qs; q < qe; q++) {
            float gc = ut[q][c], vc = ut[q][64 + c];
            int t = t0 + half * 126 + q;
            if (t < T_) {
              float gate = g0 * ga + g1 * gbp + g2 * gc + gb;
              float val = v0 * va + v1 * vbp + v2 * vc + vb;
              float av = gate * sigmoidf_(gate) * val;
              ACT[(size_t)(b * T_ + t) * DFF_ + gcol] = f2bf(av);
            }
            ga = gbp; gbp = gc; va = vbp; vbp = vc;
          }
        }
        __syncthreads();
      }
    }
    }
    if (kph == 8) {
    PHASE_TID
    for (int prb_ = (PROBE_FI ? 0 : 1); prb_ < 2; prb_++)
    for (int it_ = 0; it_ * nblk < 257 * 8; it_++) {
      int mt, nt;
      if (!map_tile(it_, nblk, 257, 8, mt, nt)) continue;
      f32x4 acc[8][4];
      zero_acc8(acc);
      ACC_COORDS
      ADma al{ACT, DFF_, mt * 256, 0, ZERO, 0};
      gemm3(acc, al, WL + W_DN, DFF_, nt * 128, DFF_, smem, tid);
#pragma unroll
      for (int mi = 0; mi < 8; mi++)
#pragma unroll
        for (int ni = 0; ni < 4; ni++) {
          int col = nt * 128 + wc * 64 + ni * 16 + fq * 4;
          int row = mt * 256 + wr * 128 + mi * 16 + fr;
          float* hp = H + (size_t)row * 1024 + col;
          float* dp = (prb_ == 0) ? (p.out + (size_t)(row & 65535) * 1024 + col) : hp;
          float4 hv = *(const float4*)hp;
          hv.x = ALPHA_ * hv.x + acc[mi][ni][0];
          hv.y = ALPHA_ * hv.y + acc[mi][ni][1];
          hv.z = ALPHA_ * hv.z + acc[mi][ni][2];
          hv.w = ALPHA_ * hv.w + acc[mi][ni][3];
          *(float4*)dp = hv;
        }
    }
    }
    if (kph == 9) {
    PHASE_TID
    if (l == 0) {
      for (int row = (blockIdx.x * 4 + wave) * 2; row < M_; row += nblk * 8) {
        u16* hb = (row < HB_SPLIT) ? HB1 + (size_t)row * 1024 : HB2 + (size_t)(row - HB_SPLIT) * 1024;
        ln_row2(H + (size_t)row * 1024, H + (size_t)(row + 1) * 1024, p.in[30], p.in[31], H + (size_t)row * 1024, H + (size_t)(row + 1) * 1024, lane, hb, hb + 1024);
      }
    } else {
      for (int row = (blockIdx.x * 4 + wave) * 2; row < M_; row += nblk * 8) {
        int b = row / T_, t = row % T_;
        if (t >= NMETA_) {
          float* o = p.out + ((size_t)b * SEQ_ + (t - NMETA_)) * 1024;
          ln_row2(H + (size_t)row * 1024, H + (size_t)(row + 1) * 1024, p.in[30] + 1024, p.in[31] + 1024, o, o + 1024, lane, nullptr, nullptr);
        }
      }
    }
    }
    if (ph_ != 19) XB_SYNC();
  }
}

extern "C" void kernel_launch(void* const* d_in, const int* in_sizes, int n_in, void* d_out, int out_size, void* d_ws,
                              size_t ws_size, hipStream_t stream) {
  static int grid_blocks = 0;
  if (!grid_blocks) {
    int dev = 0, cus = 0, per_cu = 0;
    hipGetDevice(&dev);
    hipDeviceGetAttribute(&cus, hipDeviceAttributeMultiprocessorCount, dev);
    hipOccupancyMaxActiveBlocksPerMultiprocessor(&per_cu, mega, 256, 0);
    if (per_cu > 2) per_cu = 2;
    grid_blocks = cus * per_cu;
  }
  if (ws_size < WS_TOTAL) fprintf(stderr, "workspace too small: %zu < %zu\n", ws_size, (size_t)WS_TOTAL);
  Params p;
  memset(&p, 0, sizeof(p));
  for (int i = 0; i < 32; i++) p.in[i] = (const float*)d_in[i];
  p.out = (float*)d_out;
  p.ws = (char*)d_ws;
  u16* wb = (u16*)((char*)d_ws + OFF_W);
  int nj = 0, tiles = 0;
  auto add = [&](const float* src, size_t dst_off, int ld, int c0, int K, int Kpad, int Nv, int Np, int mode) {
    Job& j = p.jobs[nj++];
    j.src = src; j.dst = wb + dst_off; j.ld = ld; j.c0 = c0; j.K = K; j.Kpad = Kpad; j.Nv = Nv; j.Np = Np; j.mode = mode;
    j.tile0 = tiles;
    tiles += (Kpad / 32) * (Np / 32);
  };
  for (int l = 0; l < 2; l++) {
    size_t o = (size_t)l * W_LAYER;
    const float* w_in = (const float*)d_in[4] + (size_t)l * 1024 * 4416;
    add(w_in, o + W_IN, 4416, 0, 1024, 1024, 2368, 2432, 0);
    add(w_in, o + W_G, 4416, 2368, 1024, 1024, 2048, 2048, 0);
    add((const float*)d_in[7] + (size_t)l * 64 * 512, o + W_LW, 512, 0, 64, 64, 512, 512, 0);
    add((const float*)d_in[9] + (size_t)l * 64 * 512, o + W_LA, 512, 0, 64, 64, 512, 512, 0);
    add((const float*)d_in[10] + (size_t)l * 160 * 512, o + W_LG, 512, 0, 160, 192, 512, 512, 0);
    add((const float*)d_in[17] + (size_t)l * 256 * 768, o + W_UQ, 768, 0, 256, 256, 768, 768, 0);
    add((const float*)d_in[19] + (size_t)l * 256 * 512, o + W_UK, 512, 0, 256, 256, 512, 512, 0);
    add((const float*)d_in[20] + (size_t)l * 256 * 512, o + W_UV, 512, 0, 256, 256, 512, 512, 0);
    add((const float*)d_in[21] + (size_t)l * 512 * 1024, o + W_PR, 1024, 0, 512, 512, 1024, 1024, 0);
    add((const float*)d_in[22] + (size_t)l * 512 * 1024, o + W_PM, 1024, 0, 512, 512, 1024, 1024, 0);
    add((const float*)d_in[23] + (size_t)l * 1024 * 1024, o + W_OUT, 1024, 0, 1024, 1024, 1024, 1024, 0);
    add((const float*)d_in[26] + (size_t)l * 1024 * 5632, o + W_UP, 5632, 0, 1024, 1024, 5632, 5632, 1);
    add((const float*)d_in[29] + (size_t)l * 2816 * 1024, o + W_DN, 1024, 0, 2816, 2816, 1024, 1024, 0);
  }
  p.nconv = tiles;
  hipMemsetAsync((char*)d_ws + OFF_BAR, 0, 16384, stream);
  void* args[] = {&p};
  hipError_t e = hipLaunchCooperativeKernel((void*)mega, dim3(grid_blocks), dim3(256), args, 0, stream);
  if (e != hipSuccess) fprintf(stderr, "cooperative launch failed: %s (grid %d)\n", hipGetErrorString(e), grid_blocks);
}
```

```cpp
#include <hip/hip_runtime.h>
#include <hip/hip_cooperative_groups.h>
#include <cstdio>
#include <cstring>
namespace cg = cooperative_groups;

#ifndef PHMASK
#define PHMASK 0xFFFF
#endif
#ifndef PROBE_HOT
#define PROBE_HOT 0
#endif
#ifndef PROBE_FI
#define PROBE_FI 0
#endif
#ifndef REPMASK
#define REPMASK 0
#endif
typedef unsigned short u16;
using bf16x8 = __attribute__((ext_vector_type(8))) short;
using f32x4 = __attribute__((ext_vector_type(4))) float;

constexpr int B_ = 16, SEQ_ = 4096, NMETA_ = 16, T_ = 4112, M_ = B_ * T_, D_ = 1024;
constexpr int PC_ = 2368;
constexpr int PMLA_ = 1824, PKV_ = 2080, PKR_ = 2336;
constexpr int DFF_ = 2816;
constexpr float ALPHA_ = 1.4142135623730951f;

constexpr size_t OFF_H = 0;
constexpr size_t OFF_P = OFF_H + (size_t)M_ * 1024 * 4;
constexpr size_t OFF_DEC = OFF_P + (size_t)M_ * PC_ * 2;
constexpr size_t OFF_AA = OFF_DEC + (size_t)M_ * 512 * 4;
constexpr size_t OFF_GG = OFF_AA + (size_t)M_ * 512 * 2;
constexpr size_t OFF_Q = OFF_GG + (size_t)M_ * 512 * 2;
constexpr size_t OFF_W = OFF_Q + (size_t)M_ * 768 * 2;
constexpr size_t W_IN = 0;
constexpr size_t W_G = W_IN + (size_t)2432 * 1024;
constexpr size_t W_LW = W_G + (size_t)2048 * 1024;
constexpr size_t W_LA = W_LW + (size_t)512 * 64;
constexpr size_t W_LG = W_LA + (size_t)512 * 64;
constexpr size_t W_UQ = W_LG + (size_t)512 * 192;
constexpr size_t W_UK = W_UQ + (size_t)768 * 256;
constexpr size_t W_UV = W_UK + (size_t)512 * 256;
constexpr size_t W_PR = W_UV + (size_t)512 * 256;
constexpr size_t W_PM = W_PR + (size_t)1024 * 512;
constexpr size_t W_OUT = W_PM + (size_t)1024 * 512;
constexpr size_t W_UP = W_OUT + (size_t)1024 * 1024;
constexpr size_t W_DN = W_UP + (size_t)5632 * 1024;
constexpr size_t W_LAYER = W_DN + (size_t)1024 * 2816;
constexpr size_t OFF_ROPE = OFF_W + 2 * W_LAYER * 2;
constexpr size_t OFF_CTR = OFF_ROPE + (size_t)T_ * 16 * 8;
constexpr size_t OFF_ZERO = OFF_CTR + 256;
constexpr size_t OFF_BAR = OFF_ZERO + 8192;
constexpr size_t OFF_HB2 = OFF_BAR + 16384;
constexpr size_t WS_TOTAL = OFF_HB2 + (size_t)512 * 1024 * 2;
constexpr int HB_SPLIT = 65280;

struct Job { const float* src; u16* dst; int ld, c0, K, Kpad, Nv, Np, mode, tile0; };
struct Params {
  const float* in[32];
  float* out;
  char* ws;
  Job jobs[26];
  int nconv;
  int pad0;
};

__constant__ double ROPE_C[16] = {0.15915494309189535, 0.08949940160889101, 0.050329212104487035, 0.0283021958306234,
                                  0.015915494309189534, 0.008949940160889102, 0.005032921210448704, 0.00283021958306234,
                                  0.0015915494309189536, 0.0008949940160889102, 0.0005032921210448703, 0.00028302195830623395,
                                  0.00015915494309189535, 8.949940160889102e-05, 5.0329212104487035e-05, 2.8302195830623396e-05};

__device__ __forceinline__ int launder(int x) { asm volatile("" : "+v"(x)); return x; }
typedef __bf16 bf16x2_t __attribute__((ext_vector_type(2)));
typedef float f32x2_t __attribute__((ext_vector_type(2)));
__device__ __forceinline__ unsigned pk2(float a, float b) {
  f32x2_t v = {a, b};
  bf16x2_t r = __builtin_convertvector(v, bf16x2_t);
  return *(unsigned*)&r;
}
__device__ __forceinline__ u16 f2bf(float f) { return (u16)(pk2(f, 0.f) & 0xffffu); }
__device__ __forceinline__ float bf2f(unsigned h) { return __uint_as_float(h << 16); }
__device__ __forceinline__ float bflo(unsigned w) { return __uint_as_float(w << 16); }
__device__ __forceinline__ float bfhi(unsigned w) { return __uint_as_float(w & 0xffff0000u); }
__device__ __forceinline__ float sigmoidf_(float x) { return 1.0f / (1.0f + __expf(-x)); }

__device__ __forceinline__ int fresh_lane() { int x; asm volatile("v_mbcnt_lo_u32_b32 %0, -1, 0\n\tv_mbcnt_hi_u32_b32 %0, -1, %0" : "=v"(x)); return x; }
#define PHASE_TID const int tid = wave0 * 64 + fresh_lane(); const int lane = tid & 63, wave = tid >> 6; (void)lane; (void)wave;
template <int CTRL>
__device__ __forceinline__ float dppf(float x) {
  return __int_as_float(__builtin_amdgcn_update_dpp(0, __float_as_int(x), CTRL, 0xF, 0xF, true));
}
__device__ __forceinline__ float sum8(float x) {
  x += dppf<0xB1>(x);
  x += dppf<0x4E>(x);
  x += dppf<0x141>(x);
  return x;
}
__device__ __forceinline__ float sum16(float x) {
  x = sum8(x);
  x += dppf<0x140>(x);
  return x;
}
__device__ __forceinline__ float shx(float x, int lane, int o) {
  return __int_as_float(__builtin_amdgcn_ds_bpermute((lane ^ o) << 2, __float_as_int(x)));
}
__device__ __forceinline__ float wave_sum(float x, int lane) {
  x = sum16(x);
  x += shx(x, lane, 16);
  x += shx(x, lane, 32);
  return x;
}

constexpr int BM = 128, BN = 128, BK = 64, LDT = 64;
constexpr int SMEM_BYTES = 73728;

template <int MODE>
struct AL {
  const void* base;
  int ld;
  int row0;
  int t0;
  int kvalid;
  const float* mu;
  int fn;
  struct Raw { uint4 x, y; };
  __device__ __forceinline__ Raw fetch(int r, int k) const {
    Raw w;
    { unsigned z = (MODE == 3) ? (unsigned)launder(0) : 0u; w.x = make_uint4(z, z, z, z); w.y = w.x; }
    if (MODE == 0) {
      const float* p = (const float*)base + (size_t)(row0 + r) * ld + k;
      w.x = *(const uint4*)p;
      w.y = *(const uint4*)(p + 4);
    } else if (MODE == 1) {
      const u16* p = (const u16*)base + (size_t)(row0 + r) * ld + k;
      w.x = *(const uint4*)p;
    } else if (MODE == 4) {
      const float* p = (const float*)base + (size_t)(row0 + r) * ld + k;
      float4 a = *(const float4*)p, b = *(const float4*)(p + 4);
      w.x = make_uint4(pk2(a.x, a.y), pk2(a.z, a.w), pk2(b.x, b.y), pk2(b.z, b.w));
    } else if (MODE == 2) {
      int t = t0 + r;
      if (t >= 0 && t < T_) {
        const float* p = (const float*)base + (size_t)(row0 + t) * ld + k;
        w.x = *(const uint4*)p;
        w.y = *(const uint4*)(p + 4);
      }
    } else {
      int row = row0 + r;
      int t = row % T_;
      if (k < kvalid) {
        const u16* p = (const u16*)base + (size_t)row * ld + k;
        w.x = *(const uint4*)p;
        if (t > 0) w.y = *(const uint4*)(p - ld);
      }
    }
    return w;
  }
  __device__ __forceinline__ uint4 cvt(const Raw& w, int k) const {
    if (MODE == 0 || MODE == 2) {
      uint4 o;
      o.x = pk2(__uint_as_float(w.x.x), __uint_as_float(w.x.y));
      o.y = pk2(__uint_as_float(w.x.z), __uint_as_float(w.x.w));
      o.z = pk2(__uint_as_float(w.y.x), __uint_as_float(w.y.y));
      o.w = pk2(__uint_as_float(w.y.z), __uint_as_float(w.y.w));
      return o;
    } else if (MODE == 1 || MODE == 4) {
      return w.x;
    } else {
      if (k >= kvalid) { unsigned z = (unsigned)launder(0); return make_uint4(z, z, z, z); }
      unsigned cw[4] = {w.x.x, w.x.y, w.x.z, w.x.w};
      unsigned pw[4] = {w.y.x, w.y.y, w.y.z, w.y.w};
      unsigned ow[4];
#pragma unroll
      for (int e = 0; e < 4; e++) {
        float x0 = bflo(cw[e]), x1 = bfhi(cw[e]);
        float p0 = bflo(pw[e]), p1 = bfhi(pw[e]);
        float v0 = x0 + (p0 - x0) * mu[k + 2 * e];
        float v1 = x1 + (p1 - x1) * mu[k + 2 * e + 1];
        if (fn == 0) {
          v0 = 1.0f - 2.0f / (__expf(2.0f * v0) + 1.0f);
          v1 = 1.0f - 2.0f / (__expf(2.0f * v1) + 1.0f);
        } else if (fn == 2) {
          v0 = sigmoidf_(v0);
          v1 = sigmoidf_(v1);
        }
        ow[e] = pk2(v0, v1);
      }
      return make_uint4(ow[0], ow[1], ow[2], ow[3]);
    }
  }
};

template <int NI>
__device__ __forceinline__ void zero_acc(f32x4 (&acc)[4][NI]) {
#pragma unroll
  for (int i = 0; i < 4; i++)
#pragma unroll
    for (int j = 0; j < NI; j++) acc[i][j] = f32x4{0.f, 0.f, 0.f, 0.f};
}

#define REP4(X) X(0) X(1) X(2) X(3)
template <class ALT, int NI>
__device__ __forceinline__ void gemm_loop(f32x4 (&acc)[4][NI], const ALT& al, const u16* __restrict__ Bt, int ldb, int n0,
                                          int K, char* smem, const int tid) {
  const int lane = tid & 63, wave = tid >> 6;
  const int wr = wave >> 1, wc = wave & 1, fr = lane & 15, fq = lane >> 4;
  const int lr = tid >> 3, lk = (tid & 7) * 8, lsw = ((tid & 7) ^ (lr & 7)) * 8;
  u16* sa = (u16*)smem;
  u16* sb = sa + 2 * BM * LDT;
  typename ALT::Raw ra0, ra1, ra2, ra3;
  uint4 rb0 = make_uint4(0,0,0,0), rb1 = rb0, rb2 = rb0, rb3 = rb0;
  const u16* bp = Bt + (size_t)(n0 + lr) * ldb + lk;
#define GL_FETCH(i) ra##i = al.fetch(lr + 32 * i, kf); if (i < NI) rb##i = *(const uint4*)(bp + (size_t)(32 * i) * ldb + kb);
#define GL_STORE(i) *(uint4*)(a_ + (lr + 32 * i) * LDT + lsw) = al.cvt(ra##i, kt * BK + lk); if (i < NI) *(uint4*)(b_ + (lr + 32 * i) * LDT + lsw) = rb##i;
  {
    const int kf = lk, kb = 0;
    REP4(GL_FETCH)
  }
  const int nk = K / BK;
  for (int kt = 0; kt < nk; kt++) {
    u16* a_ = sa + (kt & 1) * BM * LDT;
    u16* b_ = sb + (kt & 1) * BN * LDT;
    REP4(GL_STORE)
    __syncthreads();
    if (kt + 1 < nk) {
      const int kf = (kt + 1) * BK + lk, kb = (kt + 1) * BK;
      REP4(GL_FETCH)
    }
#pragma unroll
    for (int ks = 0; ks < 2; ks++) {
      bf16x8 af[4], bf[NI];
#pragma unroll
      for (int i = 0; i < 4; i++) af[i] = *(const bf16x8*)(a_ + (wr * 64 + i * 16 + fr) * LDT + (((ks * 4 + fq) ^ (fr & 7)) * 8));
#pragma unroll
      for (int i = 0; i < NI; i++) bf[i] = *(const bf16x8*)(b_ + (wc * (NI * 16) + i * 16 + fr) * LDT + (((ks * 4 + fq) ^ (fr & 7)) * 8));
#pragma unroll
      for (int mi = 0; mi < 4; mi++)
#pragma unroll
        for (int ni = 0; ni < NI; ni++)
          acc[mi][ni] = __builtin_amdgcn_mfma_f32_16x16x32_bf16(af[mi], bf[ni], acc[mi][ni], 0, 0, 0);
    }
  }
  __syncthreads();
#undef GL_FETCH
#undef GL_STORE
}


struct ADma { const u16* base; int ld; int row0; int t0; const u16* zero; int mode; const char* wsb; };
constexpr int G3_STAGE = 12288;

template <int NI, bool SWAP = true>
__device__ __forceinline__ void gemm3(f32x4 (&acc)[8][NI], const ADma& a, const u16* __restrict__ Bt, int ldb, int n0, int K,
                                      char* smem, const int tid) {
  const int lane = tid & 63, wave = tid >> 6;
  const int wr = wave >> 1, wc = wave & 1, fr = lane & 15, fq = lane >> 4;
  const int kc8 = ((lane & 3) ^ ((4 - (lane >> 4)) & 3)) * 8;
  const int psw = (fq ^ ((4 - (fr >> 2)) & 3)) * 8;
  u16* sm = (u16*)smem;
  const u16* ap0 = nullptr;
  unsigned ao0 = 0, ao1 = 0, ao2 = 0, ao3 = 0;
  if (a.mode == 0) {
    ap0 = a.base + (size_t)(a.row0 + wave * 64 + (lane >> 2)) * a.ld + kc8;
  } else {
    const unsigned bo = (unsigned)((const char*)a.base - a.wsb), zo = (unsigned)((const char*)a.zero - a.wsb) + kc8 * 2;
#define G3_AP(j)                                                                          \
    {                                                                                     \
      int t = a.t0 + wave * 64 + j * 16 + (lane >> 2);                                    \
      ao##j = (t >= 0 && t < T_) ? bo + (unsigned)(((a.row0 + t) * a.ld + kc8) * 2) : zo; \
    }
    REP4(G3_AP)
#undef G3_AP
  }
  const u16* bp0 = Bt + (size_t)(n0 + wave * (8 * NI) + (lane >> 2)) * ldb + kc8;
  const size_t astep = (size_t)16 * a.ld;
  const size_t bstep = (size_t)16 * ldb;
#define G3_ISSUE(j)                                                                                                              \
  __builtin_amdgcn_global_load_lds((a.mode == 0) ? (const unsigned*)(ap0 + j * astep + kof) : (const unsigned*)(a.wsb + ao##j + kof * 2), (unsigned*)(st_ + (wave * 64 + j * 16) * 32 + lane * 8), 16, 0, 0); \
  if (2 * j < NI) __builtin_amdgcn_global_load_lds((const unsigned*)(bp0 + j * bstep + kof), (unsigned*)(st_ + 8192 + (wave * (8 * NI) + j * 16) * 32 + lane * 8), 16, 0, 0);
  const int nk = K / 32;
  asm volatile("s_waitcnt vmcnt(0)" ::: "memory");
  {
    const int kof = 0;
    u16* st_ = sm;
    REP4(G3_ISSUE)
  }
  if (nk > 1) {
    const int kof = 32;
    u16* st_ = sm + G3_STAGE;
    REP4(G3_ISSUE)
  }
  int cur = 0, nxt = 2;
  const unsigned lds0 = (unsigned)(size_t)(__attribute__((address_space(3))) char*)smem;
  const unsigned aoff = lds0 + (unsigned)(((wr * 128 + fr) * 32 + psw) * 2);
  const unsigned boff = lds0 + 16384u + (unsigned)(((wc * (NI * 16) + fr) * 32 + psw) * 2);
#define G3_DSR(dst, addr, off) asm volatile("ds_read_b128 %0, %1 offset:" #off : "=v"(dst) : "v"(addr))
  for (int kt = 0; kt < nk; kt++) {
    if (kt + 1 < nk) {
      if (NI == 4) asm volatile("s_waitcnt vmcnt(6)" ::: "memory");
      else asm volatile("s_waitcnt vmcnt(5)" ::: "memory");
    } else {
      asm volatile("s_waitcnt vmcnt(0)" ::: "memory");
    }
    __builtin_amdgcn_s_barrier();
    if (kt + 2 < nk) {
      const int kof = (kt + 2) * 32;
      u16* st_ = sm + nxt * G3_STAGE;
      REP4(G3_ISSUE)
    }
    const unsigned aaddr = aoff + (unsigned)cur * (G3_STAGE * 2);
    const unsigned baddr = boff + (unsigned)cur * (G3_STAGE * 2);
    bf16x8 af[8], bf[NI];
    G3_DSR(af[0], aaddr, 0); G3_DSR(af[1], aaddr, 1024); G3_DSR(af[2], aaddr, 2048); G3_DSR(af[3], aaddr, 3072);
    G3_DSR(bf[0], baddr, 0); G3_DSR(bf[1], baddr, 1024);
    if (NI == 4) { G3_DSR(bf[NI - 2], baddr, 2048); G3_DSR(bf[NI - 1], baddr, 3072); }
    G3_DSR(af[4], aaddr, 4096); G3_DSR(af[5], aaddr, 5120); G3_DSR(af[6], aaddr, 6144); G3_DSR(af[7], aaddr, 7168);
    if (NI == 4) {
      asm volatile("s_waitcnt lgkmcnt(4)"
                   : "+v"(af[0]), "+v"(af[1]), "+v"(af[2]), "+v"(af[3]), "+v"(bf[0]), "+v"(bf[1]), "+v"(bf[NI - 2]), "+v"(bf[NI - 1]));
    } else {
      asm volatile("s_waitcnt lgkmcnt(4)" : "+v"(af[0]), "+v"(af[1]), "+v"(af[2]), "+v"(af[3]), "+v"(bf[0]), "+v"(bf[1]));
    }
#pragma unroll
    for (int mi = 0; mi < 4; mi++)
#pragma unroll
      for (int ni = 0; ni < NI; ni++)
        acc[mi][ni] = SWAP ? __builtin_amdgcn_mfma_f32_16x16x32_bf16(bf[ni], af[mi], acc[mi][ni], 0, 0, 0)
                           : __builtin_amdgcn_mfma_f32_16x16x32_bf16(af[mi], bf[ni], acc[mi][ni], 0, 0, 0);
    asm volatile("s_waitcnt lgkmcnt(0)" : "+v"(af[4]), "+v"(af[5]), "+v"(af[6]), "+v"(af[7]));
#pragma unroll
    for (int mi = 4; mi < 8; mi++)
#pragma unroll
      for (int ni = 0; ni < NI; ni++)
        acc[mi][ni] = SWAP ? __builtin_amdgcn_mfma_f32_16x16x32_bf16(bf[ni], af[mi], acc[mi][ni], 0, 0, 0)
                           : __builtin_amdgcn_mfma_f32_16x16x32_bf16(af[mi], bf[ni], acc[mi][ni], 0, 0, 0);
    cur = (cur == 2) ? 0 : cur + 1;
    nxt = (nxt == 2) ? 0 : nxt + 1;
  }
  asm volatile("s_waitcnt lgkmcnt(0)" ::: "memory");
  __syncthreads();
#undef G3_DSR
#undef G3_ISSUE
}

template <int NI>
__device__ __forceinline__ void zero_acc8(f32x4 (&acc)[8][NI]) {
#pragma unroll
  for (int i = 0; i < 8; i++)
#pragma unroll
    for (int j = 0; j < NI; j++) acc[i][j] = f32x4{0.f, 0.f, 0.f, 0.f};
}


__device__ __forceinline__ bool map_tile(int i, int nblk, int MT, int NT, int& mt, int& nt) {
  const int locs = nblk >> 3;
  const int xcd = blockIdx.x & 7, loc = blockIdx.x >> 3;
  const int q = (i * 8 + xcd) * locs + loc;
  if (q >= MT * NT) return false;
  const int nfull = NT >> 3, per = MT * 8;
  if (q < nfull * per) {
    int pp = q / per, r = q - pp * per;
    mt = r >> 3;
    nt = pp * 8 + (r & 7);
  } else {
    int r = q - nfull * per;
    int w = NT - nfull * 8;
    mt = r / w;
    nt = nfull * 8 + (r - mt * w);
  }
  return true;
}

#define ACC_COORDS const int wr = wave >> 1, wc = wave & 1, fr = lane & 15, fq = lane >> 4;

__device__ __forceinline__ void conv_tile(const Params& p, int t, char* smem, const int tid) {
  int j = 0;
#pragma unroll 1
  for (int i = 1; i < 26; i++)
    if (t >= p.jobs[i].tile0) j = i;
  const Job& jb = p.jobs[j];
  float(*tile)[65] = (float(*)[65])smem;
  int local = t - jb.tile0;
  int nkt = jb.Kpad >> 6;
  int kt = local % nkt, nt = local / nkt;
  int tx = tid & 63, ty = tid >> 6;
  int n = nt * 64 + tx;
  int col;
  if (jb.mode == 0) col = jb.c0 + n;
  else { int jn = n >> 7, i = n & 127; col = (i < 64) ? (64 * jn + i) : (DFF_ + 64 * jn + (i - 64)); }
  const float* sp = jb.src + col;
  const int K = jb.K, ld = jb.ld;
  const bool nok = n < jb.Nv;
#pragma unroll
  for (int i = 0; i < 16; i++) {
    int k = kt * 64 + ty + 4 * i;
    tile[ty + 4 * i][tx] = (nok && k < K) ? sp[(size_t)k * ld] : 0.f;
  }
  __syncthreads();
#pragma unroll
  for (int i = 0; i < 16; i++) {
    int nn = nt * 64 + ty + 4 * i;
    int k = kt * 64 + tx;
    jb.dst[(size_t)nn * jb.Kpad + k] = f2bf(tile[tx][ty + 4 * i]);
  }
  __syncthreads();
}

__device__ __forceinline__ void ln_row(const float* __restrict__ src, const float* __restrict__ g,
                                       const float* __restrict__ b, float* __restrict__ dst, int lane, u16* __restrict__ dstb = nullptr) {
  float4 v[4];
  float s = 0.f;
#pragma unroll
  for (int i = 0; i < 4; i++) {
    v[i] = *(const float4*)(src + i * 256 + lane * 4);
    s += v[i].x + v[i].y + v[i].z + v[i].w;
  }
  float mean = wave_sum(s, lane) * (1.0f / 1024.0f);
  float q = 0.f;
#pragma unroll
  for (int i = 0; i < 4; i++) {
    float a = v[i].x - mean, b2 = v[i].y - mean, c = v[i].z - mean, d = v[i].w - mean;
    q += a * a + b2 * b2 + c * c + d * d;
  }
  float rstd = rsqrtf(wave_sum(q, lane) * (1.0f / 1024.0f) + 1e-5f);
#pragma unroll
  for (int i = 0; i < 4; i++) {
    float4 gg = *(const float4*)(g + i * 256 + lane * 4);
    float4 bb = *(const float4*)(b + i * 256 + lane * 4);
    float4 o;
    o.x = (v[i].x - mean) * rstd * gg.x + bb.x;
    o.y = (v[i].y - mean) * rstd * gg.y + bb.y;
    o.z = (v[i].z - mean) * rstd * gg.z + bb.z;
    o.w = (v[i].w - mean) * rstd * gg.w + bb.w;
    *(float4*)(dst + i * 256 + lane * 4) = o;
    if (dstb) *(uint2*)(dstb + i * 256 + lane * 4) = make_uint2(pk2(o.x, o.y), pk2(o.z, o.w));
  }
}

__device__ __forceinline__ void ln_row2(const float* __restrict__ srcA, const float* __restrict__ srcB, const float* __restrict__ g,
                                        const float* __restrict__ b, float* dstA, float* dstB, int lane, u16* dbA, u16* dbB) {
  float4 va[4], vb[4];
  float sa = 0.f, sb = 0.f;
#pragma unroll
  for (int i = 0; i < 4; i++) {
    va[i] = *(const float4*)(srcA + i * 256 + lane * 4);
    vb[i] = *(const float4*)(srcB + i * 256 + lane * 4);
  }
#pragma unroll
  for (int i = 0; i < 4; i++) {
    sa += va[i].x + va[i].y + va[i].z + va[i].w;
    sb += vb[i].x + vb[i].y + vb[i].z + vb[i].w;
  }
  const float ma = wave_sum(sa, lane) * (1.0f / 1024.0f), mb = wave_sum(sb, lane) * (1.0f / 1024.0f);
  float qa = 0.f, qb = 0.f;
#pragma unroll
  for (int i = 0; i < 4; i++) {
    va[i].x -= ma; va[i].y -= ma; va[i].z -= ma; va[i].w -= ma;
    vb[i].x -= mb; vb[i].y -= mb; vb[i].z -= mb; vb[i].w -= mb;
    qa += va[i].x * va[i].x + va[i].y * va[i].y + va[i].z * va[i].z + va[i].w * va[i].w;
    qb += vb[i].x * vb[i].x + vb[i].y * vb[i].y + vb[i].z * vb[i].z + vb[i].w * vb[i].w;
  }
  const float ra = rsqrtf(wave_sum(qa, lane) * (1.0f / 1024.0f) + 1e-5f), rb = rsqrtf(wave_sum(qb, lane) * (1.0f / 1024.0f) + 1e-5f);
#pragma unroll
  for (int i = 0; i < 4; i++) {
    float4 gg = *(const float4*)(g + i * 256 + lane * 4);
    float4 bb = *(const float4*)(b + i * 256 + lane * 4);
    float4 oa, ob;
    oa.x = va[i].x * ra * gg.x + bb.x; oa.y = va[i].y * ra * gg.y + bb.y; oa.z = va[i].z * ra * gg.z + bb.z; oa.w = va[i].w * ra * gg.w + bb.w;
    ob.x = vb[i].x * rb * gg.x + bb.x; ob.y = vb[i].y * rb * gg.y + bb.y; ob.z = vb[i].z * rb * gg.z + bb.z; ob.w = vb[i].w * rb * gg.w + bb.w;
    *(float4*)(dstA + i * 256 + lane * 4) = oa;
    *(float4*)(dstB + i * 256 + lane * 4) = ob;
    if (dbA) {
      *(uint2*)(dbA + i * 256 + lane * 4) = make_uint2(pk2(oa.x, oa.y), pk2(oa.z, oa.w));
      *(uint2*)(dbB + i * 256 + lane * 4) = make_uint2(pk2(ob.x, ob.y), pk2(ob.z, ob.w));
    }
  }
}

struct ScanIn {
  float kk[16][64], wr[16][64], w[16][64], kt[16][64], kka[16][64], v[16][64], g[16][64];
  float c[16][4];
};
struct ScanRaw { uint2 r, k, v, rp, kp, vp, a, g; float4 dec; };

__device__ __forceinline__ ScanRaw scan_fetch(const u16* __restrict__ P, const float* __restrict__ DEC,
                                              const u16* __restrict__ AA, const u16* __restrict__ GG, int rowbase, int t,
                                              int hc) {
  ScanRaw w;
  size_t row = (size_t)(rowbase + t);
  const u16* pp = P + row * PC_ + hc;
  w.r = *(const uint2*)(pp);
  w.k = *(const uint2*)(pp + 512);
  w.v = *(const uint2*)(pp + 1024);
  if (t > 0) {
    w.rp = *(const uint2*)(pp - PC_);
    w.kp = *(const uint2*)(pp - PC_ + 512);
    w.vp = *(const uint2*)(pp - PC_ + 1024);
  } else {
    w.rp = make_uint2(0, 0); w.kp = make_uint2(0, 0); w.vp = make_uint2(0, 0);
  }
  w.dec = *(const float4*)(DEC + row * 512 + hc);
  w.a = *(const uint2*)(AA + row * 512 + hc);
  w.g = *(const uint2*)(GG + row * 512 + hc);
  return w;
}

__device__ __forceinline__ void unpack4(uint2 u, float (&o)[4]) {
  o[0] = bflo(u.x); o[1] = bfhi(u.x); o[2] = bflo(u.y); o[3] = bfhi(u.y);
}

__device__ __forceinline__ void scan_unit(const Params& p, int l, int bh, char* smem, const int tid) {
  const int lane = tid & 63, wave = tid >> 6;
  const int b = bh >> 3, h = bh & 7;
  const int rowbase = b * T_;
  const u16* P = (const u16*)(p.ws + OFF_P);
  const float* DEC = (const float*)(p.ws + OFF_DEC);
  const u16* AA = (const u16*)(p.ws + OFF_AA);
  const u16* GG = (const u16*)(p.ws + OFF_GG);
  u16* YR = (u16*)(p.ws + OFF_AA);
  ScanIn* in = (ScanIn*)smem;
  float(*ybuf)[64] = (float(*)[64])(smem + 2 * sizeof(ScanIn));
  const int tl = tid >> 4, kq = tid & 15, hc = h * 64 + kq * 4;
  float(*cst)[64] = (float(*)[64])(smem + 2 * sizeof(ScanIn) + 16 * 64 * 4);
  if (tid < 64) {
    const float* mu = p.in[5] + (size_t)l * 1824;
    const int ch = h * 64 + tid;
    cst[0][tid] = mu[ch];
    cst[1][tid] = mu[512 + ch];
    cst[2][tid] = mu[1024 + ch];
    cst[3][tid] = p.in[11][l * 512 + ch];
    float ka_ = p.in[12][l * 512 + ch];
    cst[4][tid] = ka_;
    cst[5][tid] = 1.0f - ka_;
    cst[6][tid] = p.in[13][l * 512 + ch];
    cst[7][tid] = p.in[14][l * 512 + ch];
    cst[8][tid] = p.in[15][l * 512 + ch];
  }
  __syncthreads();
  const int rp = lane >> 3, ks = lane & 7, row0 = wave * 16 + rp * 2;
  typedef float f2s __attribute__((ext_vector_type(2)));
  f2s S2[2][4];
#pragma unroll
  for (int i = 0; i < 2; i++)
#pragma unroll
    for (int e = 0; e < 4; e++) S2[i][e] = f2s{0.f, 0.f};

  auto stage = [&](const ScanRaw& w, ScanIn& dst) {
    float r[4], k[4], v[4], rq[4], kp[4], vp[4], a[4], g[4];
    unpack4(w.r, r); unpack4(w.k, k); unpack4(w.v, v);
    unpack4(w.rp, rq); unpack4(w.kp, kp); unpack4(w.vp, vp);
    unpack4(w.a, a); unpack4(w.g, g);
    float dec[4] = {w.dec.x, w.dec.y, w.dec.z, w.dec.w};
    float mu_r[4], mu_k[4], mu_v[4], kkw[4], kaw[4], omk[4], rkw[4];
    *(float4*)mu_r = *(const float4*)&cst[0][kq * 4]; *(float4*)mu_k = *(const float4*)&cst[1][kq * 4];
    *(float4*)mu_v = *(const float4*)&cst[2][kq * 4]; *(float4*)kkw = *(const float4*)&cst[3][kq * 4];
    *(float4*)kaw = *(const float4*)&cst[4][kq * 4]; *(float4*)omk = *(const float4*)&cst[5][kq * 4];
    *(float4*)rkw = *(const float4*)&cst[6][kq * 4];
    float kkr[4], ss = 0.f;
#pragma unroll
    for (int e = 0; e < 4; e++) {
      r[e] = r[e] + (rq[e] - r[e]) * mu_r[e];
      k[e] = k[e] + (kp[e] - k[e]) * mu_k[e];
      v[e] = v[e] + (vp[e] - v[e]) * mu_v[e];
      kkr[e] = k[e] * kkw[e];
      ss += kkr[e] * kkr[e];
    }
    ss = sum16(ss);
    float inv = 1.0f / fmaxf(sqrtf(ss), 1e-12f);
    float c1 = 0.f, c2 = 0.f, c3 = 0.f;
    float kk[4], ktl[4], kka[4], wr[4];
#pragma unroll
    for (int e = 0; e < 4; e++) {
      kk[e] = kkr[e] * inv;
      ktl[e] = k[e] * fmaf(a[e], kaw[e], omk[e]);
      kka[e] = kk[e] * a[e];
      wr[e] = dec[e] * r[e];
      c1 += kka[e] * r[e];
      c2 += ktl[e] * r[e];
      c3 += r[e] * ktl[e] * rkw[e];
    }
    c1 = sum16(c1); c2 = sum16(c2); c3 = sum16(c3);
    *(float4*)&dst.kk[tl][kq * 4] = make_float4(kk[0], kk[1], kk[2], kk[3]);
    *(float4*)&dst.wr[tl][kq * 4] = make_float4(wr[0], wr[1], wr[2], wr[3]);
    *(float4*)&dst.w[tl][kq * 4] = make_float4(dec[0], dec[1], dec[2], dec[3]);
    *(float4*)&dst.kt[tl][kq * 4] = make_float4(ktl[0], ktl[1], ktl[2], ktl[3]);
    *(float4*)&dst.kka[tl][kq * 4] = make_float4(kka[0], kka[1], kka[2], kka[3]);
    *(float4*)&dst.v[tl][kq * 4] = make_float4(v[0], v[1], v[2], v[3]);
    *(float4*)&dst.g[tl][kq * 4] = make_float4(g[0], g[1], g[2], g[3]);
    if (kq == 0) *(float4*)&dst.c[tl][0] = make_float4(c1, c2, c3, 0.f);
  };

  {
    ScanRaw w0 = scan_fetch(P, DEC, AA, GG, rowbase, tl, hc);
    stage(w0, in[0]);
  }
  __syncthreads();
  constexpr int NCH = T_ / 16;
  for (int c = 0; c < NCH; c++) {
    ScanIn& cur = in[c & 1];
    ScanRaw nx;
    const bool have_next = (c + 1 < NCH);
    if (have_next) nx = scan_fetch(P, DEC, AA, GG, rowbase, (c + 1) * 16 + tl, hc);
    {
      typedef float f2 __attribute__((ext_vector_type(2)));
      struct StepA { float4 kk0, kk1, wr0, wr1; };
      struct StepIn { float4 kk0, kk1, wr0, wr1, w0, w1, kt0, kt1, ka0, ka1; float2 vv, cc; };
      auto ldA = [&](int s) {
        StepA r;
        r.kk0 = *(const float4*)&cur.kk[s][ks * 8]; r.kk1 = *(const float4*)&cur.kk[s][ks * 8 + 4];
        r.wr0 = *(const float4*)&cur.wr[s][ks * 8]; r.wr1 = *(const float4*)&cur.wr[s][ks * 8 + 4];
        return r;
      };
      StepA nxa = ldA(0);
#pragma unroll 1
      for (int s4 = 0; s4 < 16; s4 += 4) {
      float yv[4][2];
#pragma unroll
      for (int u = 0; u < 4; u++) {
        const int s = s4 + u;
        StepIn in_;
        in_.kk0 = nxa.kk0; in_.kk1 = nxa.kk1; in_.wr0 = nxa.wr0; in_.wr1 = nxa.wr1;
        in_.vv = *(const float2*)&cur.v[s][row0];
        in_.cc = *(const float2*)&cur.c[s][0];
        in_.w0 = *(const float4*)&cur.w[s][ks * 8];   in_.w1 = *(const float4*)&cur.w[s][ks * 8 + 4];
        in_.kt0 = *(const float4*)&cur.kt[s][ks * 8]; in_.kt1 = *(const float4*)&cur.kt[s][ks * 8 + 4];
        in_.ka0 = *(const float4*)&cur.kka[s][ks * 8]; in_.ka1 = *(const float4*)&cur.kka[s][ks * 8 + 4];
        nxa = ldA((s + 1) & 15);
        const f2 kk[4] = {{in_.kk0.x, in_.kk0.y}, {in_.kk0.z, in_.kk0.w}, {in_.kk1.x, in_.kk1.y}, {in_.kk1.z, in_.kk1.w}};
        const f2 wr[4] = {{in_.wr0.x, in_.wr0.y}, {in_.wr0.z, in_.wr0.w}, {in_.wr1.x, in_.wr1.y}, {in_.wr1.z, in_.wr1.w}};
        const f2 w[4] = {{in_.w0.x, in_.w0.y}, {in_.w0.z, in_.w0.w}, {in_.w1.x, in_.w1.y}, {in_.w1.z, in_.w1.w}};
        const f2 kt[4] = {{in_.kt0.x, in_.kt0.y}, {in_.kt0.z, in_.kt0.w}, {in_.kt1.x, in_.kt1.y}, {in_.kt1.z, in_.kt1.w}};
        const f2 ka[4] = {{in_.ka0.x, in_.ka0.y}, {in_.ka0.z, in_.ka0.w}, {in_.ka1.x, in_.ka1.y}, {in_.ka1.z, in_.ka1.w}};
        const float vr[2] = {in_.vv.x, in_.vv.y};
        float d1[2], d2[2];
#pragma unroll
        for (int i = 0; i < 2; i++) {
          f2 a = S2[i][0] * kk[0] + S2[i][1] * kk[1];
          f2 a2 = S2[i][2] * kk[2] + S2[i][3] * kk[3];
          f2 bq = S2[i][0] * wr[0] + S2[i][1] * wr[1];
          f2 b2 = S2[i][2] * wr[2] + S2[i][3] * wr[3];
          a += a2; bq += b2;
          d1[i] = a.x + a.y;
          d2[i] = bq.x + bq.y;
        }
        d1[0] = sum8(d1[0]); d1[1] = sum8(d1[1]); d2[0] = sum8(d2[0]); d2[1] = sum8(d2[1]);
#pragma unroll
        for (int i = 0; i < 2; i++) {
          const float skk = d1[i];
          yv[u][i] = d2[i] - skk * in_.cc.x + vr[i] * in_.cc.y;
          const f2 nsk = {-skk, -skk}, vv2 = {vr[i], vr[i]};
#pragma unroll
          for (int e = 0; e < 4; e++) S2[i][e] = S2[i][e] * w[e] + (nsk * ka[e] + vv2 * kt[e]);
        }
      }
      if (ks == 0) {
#pragma unroll
        for (int u = 0; u < 4; u++) *(float2*)&ybuf[s4 + u][row0] = make_float2(yv[u][0], yv[u][1]);
      }
      }
    }
    __syncthreads();
    {
      float4 y4 = *(const float4*)&ybuf[tl][kq * 4];
      float y[4] = {y4.x, y4.y, y4.z, y4.w};
      float mean = sum16(y[0] + y[1] + y[2] + y[3]) * (1.0f / 64.0f);
      float q = 0.f;
#pragma unroll
      for (int e = 0; e < 4; e++) { y[e] -= mean; q += y[e] * y[e]; }
      float rstd = rsqrtf(sum16(q) * (1.0f / 64.0f) + 64e-5f);
      float c3 = cur.c[tl][2];
      float4 v4 = *(const float4*)&cur.v[tl][kq * 4];
      float4 g4 = *(const float4*)&cur.g[tl][kq * 4];
      float vv[4] = {v4.x, v4.y, v4.z, v4.w};
      float gg[4] = {g4.x, g4.y, g4.z, g4.w};
      float o[4], lg[4], lb[4];
      *(float4*)lg = *(const float4*)&cst[7][kq * 4]; *(float4*)lb = *(const float4*)&cst[8][kq * 4];
#pragma unroll
      for (int e = 0; e < 4; e++) o[e] = (y[e] * rstd * lg[e] + lb[e] + c3 * vv[e]) * gg[e];
      size_t row = (size_t)(rowbase + c * 16 + tl);
      *(uint2*)(YR + row * 512 + hc) = make_uint2(pk2(o[0], o[1]), pk2(o[2], o[3]));
    }
    if (have_next) stage(nx, in[(c + 1) & 1]);
    __syncthreads();
  }
}

constexpr int KLD = 104, VLD = 72;
struct AttnSmem { u16 k[2][64 * KLD]; u16 v[2][64 * VLD]; };

__device__ __forceinline__ void attn_unit(const Params& p, int bh, int qi, char* smem, const int tid) {
  const int lane = tid & 63, wave = tid >> 6;
  const int fr = lane & 15, fq = lane >> 4;
  const int b = bh >> 3, h = bh & 7;
  const int rowbase = b * T_;
  u16* P = (u16*)(p.ws + OFF_P);
  const u16* Q = (const u16*)(p.ws + OFF_Q);
  const u16* KN = (const u16*)p.out;
  const u16* VT = (const u16*)p.out + (size_t)M_ * 512;
  const float2* ROPE = (const float2*)(p.ws + OFF_ROPE);
  AttnSmem* sm = (AttnSmem*)smem;
  const int qs = (qi == 0) ? 0 : 16 + (qi - 1) * 128;
  const int qn = (qi == 0) ? 16 : 128;
  const int q0 = qs + wave * 32;
  const bool wave_valid = (wave * 32 < qn);
  const int nkt = (qs + qn - 1) / 64 + 1;

  bf16x8 qf[2][3];
#pragma unroll
  for (int qb = 0; qb < 2; qb++) {
    int query = min(q0 + qb * 16 + fr, T_ - 1);
    const u16* qp = Q + (size_t)(rowbase + query) * 768 + h * 96;
    uint4 a0 = *(const uint4*)(qp + fq * 8);
    uint4 a1 = *(const uint4*)(qp + 32 + fq * 8);
    uint4 own = *(const uint4*)(qp + 64 + fq * 8);
    uint4 oth = *(const uint4*)(qp + 64 + (fq ^ 2) * 8);
    unsigned ow[4] = {own.x, own.y, own.z, own.w};
    unsigned tw[4] = {oth.x, oth.y, oth.z, oth.w};
    unsigned rw[4];
    const float2* rp = ROPE + (size_t)query * 16 + (fq & 1) * 8;
#pragma unroll
    for (int e = 0; e < 4; e++) {
      float2 cs0 = rp[2 * e], cs1 = rp[2 * e + 1];
      float o0 = bflo(ow[e]), o1 = bfhi(ow[e]);
      float t0 = bflo(tw[e]), t1 = bfhi(tw[e]);
      float r0, r1;
      if (fq < 2) { r0 = o0 * cs0.x - t0 * cs0.y; r1 = o1 * cs1.x - t1 * cs1.y; }
      else { r0 = t0 * cs0.y + o0 * cs0.x; r1 = t1 * cs1.y + o1 * cs1.x; }
      rw[e] = pk2(r0, r1);
    }
    uint4 a2 = make_uint4(rw[0], rw[1], rw[2], rw[3]);
    qf[qb][0] = *(bf16x8*)&a0;
    qf[qb][1] = *(bf16x8*)&a1;
    qf[qb][2] = *(bf16x8*)&a2;
  }

  f32x4 O[4][2];
#pragma unroll
  for (int i = 0; i < 4; i++)
#pragma unroll
    for (int j = 0; j < 2; j++) O[i][j] = f32x4{0.f, 0.f, 0.f, 0.f};
  float mrun[2] = {-1e30f, -1e30f}, lrun[2] = {0.f, 0.f};
  const float sc = 1.4426950408889634f / 9.797958971132712f;

  uint4 rk[3], rv[2];
  auto fetch_tile = [&](int kt) {
#pragma unroll
    for (int i = 0; i < 3; i++) {
      int c = tid + 256 * i;
      int key = c / 12, cc = c % 12;
      int t = kt * 64 + key;
      uint4 val = make_uint4(0, 0, 0, 0);
      if (t < T_) {
        size_t row = (size_t)(rowbase + t);
        if (cc < 8) val = *(const uint4*)(KN + row * 512 + h * 64 + cc * 8);
        else val = *(const uint4*)(P + row * PC_ + PKR_ + (cc - 8) * 8);
      }
      rk[i] = val;
    }
#pragma unroll
    for (int i = 0; i < 2; i++) {
      int c = tid + 256 * i;
      int dv = c >> 3, cc = c & 7;
      int t = kt * 64 + cc * 8;
      uint4 val = make_uint4(0, 0, 0, 0);
      if (t < T_) val = *(const uint4*)(VT + ((size_t)bh * 64 + dv) * T_ + t);
      rv[i] = val;
    }
  };
  auto store_tile = [&](int buf) {
#pragma unroll
    for (int i = 0; i < 3; i++) {
      int c = tid + 256 * i;
      int key = c / 12, cc = c % 12;
      *(uint4*)(&sm->k[buf][key * KLD + cc * 8]) = rk[i];
    }
#pragma unroll
    for (int i = 0; i < 2; i++) {
      int c = tid + 256 * i;
      int dv = c >> 3, cc = c & 7;
      *(uint4*)(&sm->v[buf][dv * VLD + cc * 8]) = rv[i];
    }
  };

  fetch_tile(0);
  for (int kt = 0; kt < nkt; kt++) {
    const int buf = kt & 1;
    store_tile(buf);
    __syncthreads();
    if (kt + 1 < nkt) fetch_tile(kt + 1);
    if (wave_valid && kt * 64 <= q0 + 31) {
      const u16* Ks = sm->k[buf];
      const u16* Vs = sm->v[buf];
      f32x4 s[4][2];
#pragma unroll
      for (int i = 0; i < 4; i++)
#pragma unroll
        for (int j = 0; j < 2; j++) s[i][j] = f32x4{0.f, 0.f, 0.f, 0.f};
#pragma unroll
      for (int ks = 0; ks < 3; ks++)
#pragma unroll
        for (int kb = 0; kb < 4; kb++) {
          bf16x8 kf = *(const bf16x8*)(Ks + (kb * 16 + fr) * KLD + ks * 32 + fq * 8);
#pragma unroll
          for (int qb = 0; qb < 2; qb++) s[kb][qb] = __builtin_amdgcn_mfma_f32_16x16x32_bf16(kf, qf[qb][ks], s[kb][qb], 0, 0, 0);
        }
      const bool need_mask = (kt * 64 + 63 > q0);
      unsigned pfw[2][2][4];
#pragma unroll
      for (int qb = 0; qb < 2; qb++) {
        const int query = q0 + qb * 16 + fr;
        float mx = -1e30f;
        if (need_mask) {
#pragma unroll
          for (int kb = 0; kb < 4; kb++)
#pragma unroll
            for (int j = 0; j < 4; j++) {
              int key = kt * 64 + kb * 16 + fq * 4 + j;
              if (key > query) s[kb][qb][j] = -1e30f;
            }
        }
#pragma unroll
        for (int kb = 0; kb < 4; kb++)
          mx = fmaxf(mx, fmaxf(fmaxf(s[kb][qb][0], s[kb][qb][1]), fmaxf(s[kb][qb][2], s[kb][qb][3])));
        mx = fmaxf(mx, shx(mx, lane, 16));
        mx = fmaxf(mx, shx(mx, lane, 32));
        const float mold = mrun[qb];
        const float mnew = fmaxf(mold, mx * sc);
        mrun[qb] = mnew;
        float ps = 0.f;
#pragma unroll
        for (int kb = 0; kb < 4; kb++) {
          float p0 = __builtin_amdgcn_exp2f(fmaf(s[kb][qb][0], sc, -mnew)), p1 = __builtin_amdgcn_exp2f(fmaf(s[kb][qb][1], sc, -mnew));
          float p2 = __builtin_amdgcn_exp2f(fmaf(s[kb][qb][2], sc, -mnew)), p3 = __builtin_amdgcn_exp2f(fmaf(s[kb][qb][3], sc, -mnew));
          ps += (p0 + p1) + (p2 + p3);
          pfw[qb][kb >> 1][(kb & 1) * 2 + 0] = pk2(p0, p1);
          pfw[qb][kb >> 1][(kb & 1) * 2 + 1] = pk2(p2, p3);
        }
        if (__builtin_amdgcn_ballot_w64(mnew != mold) != 0) {
          const float alpha = __builtin_amdgcn_exp2f(mold - mnew);
          lrun[qb] *= alpha;
#pragma unroll
          for (int dvb = 0; dvb < 4; dvb++) {
            O[dvb][qb][0] *= alpha; O[dvb][qb][1] *= alpha; O[dvb][qb][2] *= alpha; O[dvb][qb][3] *= alpha;
          }
        }
        lrun[qb] += ps;
      }
#pragma unroll
      for (int s2 = 0; s2 < 2; s2++)
#pragma unroll
        for (int dvb = 0; dvb < 4; dvb++) {
          const u16* vp = Vs + (dvb * 16 + fr) * VLD + s2 * 32 + fq * 4;
          uint2 v0 = *(const uint2*)vp;
          uint2 v1 = *(const uint2*)(vp + 16);
          uint4 vv = make_uint4(v0.x, v0.y, v1.x, v1.y);
          bf16x8 vf = *(bf16x8*)&vv;
#pragma unroll
          for (int qb = 0; qb < 2; qb++) {
            uint4 pw = make_uint4(pfw[qb][s2][0], pfw[qb][s2][1], pfw[qb][s2][2], pfw[qb][s2][3]);
            O[dvb][qb] = __builtin_amdgcn_mfma_f32_16x16x32_bf16(vf, *(bf16x8*)&pw, O[dvb][qb], 0, 0, 0);
          }
        }
    }
  }
  __syncthreads();
  if (wave_valid) {
#pragma unroll
    for (int qb = 0; qb < 2; qb++) {
      float l = lrun[qb];
      l += shx(l, lane, 16);
      l += shx(l, lane, 32);
      float inv = 1.0f / l;
      int query = q0 + qb * 16 + fr;
      if (query < qs + qn) {
        u16* op = P + (size_t)(rowbase + query) * PC_ + PMLA_ + h * 64 + fq * 4;
#pragma unroll
        for (int dvb = 0; dvb < 4; dvb++) {
          *(uint2*)(op + dvb * 16) =
              make_uint2(pk2(O[dvb][qb][0] * inv, O[dvb][qb][1] * inv), pk2(O[dvb][qb][2] * inv, O[dvb][qb][3] * inv));
        }
      }
    }
  }
}

#define XB_TMO      128
#define XB_XCNT(j)  (256  + 64 * (j))
#define XB_XSUB(j)  (1280 + 64 * (j))
#define XB_XGEN(j)  (2304 + 64 * (j))
#define XB_TOP      3328
#define XB_TOPGEN   3392
#define XCD_BAR_WORDS 3456
#define XB_SPIN_CAP (1u << 18)
#define LAS __attribute__((address_space(3)))

__device__ __forceinline__ unsigned xb_ld(unsigned* p)              { return __hip_atomic_load(p, __ATOMIC_RELAXED, __HIP_MEMORY_SCOPE_AGENT); }
__device__ __forceinline__ unsigned xb_add(unsigned* p, unsigned v) { return __hip_atomic_fetch_add(p, v, __ATOMIC_RELAXED, __HIP_MEMORY_SCOPE_AGENT); }
__device__ __forceinline__ unsigned xb_xcc_id() { return (unsigned)__builtin_amdgcn_s_getreg((3 << 11) | 20) & 0xFu; }
#define XB_SPIN(cond, bar) do { unsigned _sp = 0; while (cond) { __builtin_amdgcn_s_sleep(1); \
    if ((++_sp & 255u) == 0u) { if (xb_ld(&(bar)[XB_TMO])) break; if (_sp > XB_SPIN_CAP) { atomicAdd(&(bar)[XB_TMO], 1u); break; } } } } while (0)

struct XcdBarrier {
    unsigned* bar; unsigned x;
    volatile LAS unsigned* st;
};

__device__ __forceinline__ XcdBarrier xcd_barrier_post(unsigned* bar, volatile LAS unsigned* st) {
    XcdBarrier b; b.bar = bar; b.x = xb_xcc_id(); b.st = st;
    if (threadIdx.x == 0) (void)xb_add(&bar[XB_XCNT(b.x)], 1u);
    return b;
}
__device__ __forceinline__ void xcd_barrier_complete(unsigned* bar, unsigned x, unsigned& nloc, unsigned& nx) {
    const unsigned G = gridDim.x * gridDim.y * gridDim.z;
    unsigned sum, cnt, mine, sp = 0u;
    for (;;) {
        sum = 0u; cnt = 0u; mine = 0u;
#pragma unroll
        for (unsigned j = 0; j < 16; ++j) { const unsigned c = xb_ld(&bar[XB_XCNT(j)]); sum += c; cnt += (c > 0u) ? 1u : 0u; mine = (j == x) ? c : mine; }
        if (sum == G) break;
        __builtin_amdgcn_s_sleep(1);
        if ((++sp & 255u) == 0u) { if (xb_ld(&bar[XB_TMO])) break; if (sp > XB_SPIN_CAP) { atomicAdd(&bar[XB_TMO], 1u); break; } }
    }
    nloc = mine > 0u ? mine : 1u; nx = cnt > 0u ? cnt : 1u;
}

__device__ __forceinline__ void xcd_barrier(const XcdBarrier& b, const int tid_) {
    asm volatile("s_waitcnt vmcnt(0)" ::: "memory");
    __syncthreads();
    if (tid_ == 0) {
        unsigned* bar = b.bar;
        __builtin_amdgcn_s_waitcnt(0);
        unsigned nloc = b.st[0], nx = b.st[1];
        if (nloc == 0u) { xcd_barrier_complete(bar, b.x, nloc, nx); b.st[0] = nloc; b.st[1] = nx; }
        const unsigned old = xb_add(&bar[XB_XSUB(b.x)], 1u);
        const unsigned gen = old / nloc;
        if (old + 1u == (gen + 1u) * nloc) {
            __builtin_amdgcn_fence(__ATOMIC_RELEASE, "agent");
            asm volatile("s_waitcnt vmcnt(0)" ::: "memory");
            const unsigned og = xb_add(&bar[XB_TOP], 1u);
            const unsigned tg = og / nx;
            if (og + 1u == (tg + 1u) * nx) xb_add(&bar[XB_TOPGEN], 1u);
            else XB_SPIN(xb_ld(&bar[XB_TOPGEN]) == tg, bar);
            __builtin_amdgcn_fence(__ATOMIC_ACQUIRE, "agent");
            xb_add(&bar[XB_XGEN(b.x)], 1u);
            asm volatile("s_waitcnt vmcnt(0)" ::: "memory");
        } else {
            XB_SPIN(xb_ld(&bar[XB_XGEN(b.x)]) == gen, bar);
            __builtin_amdgcn_fence(__ATOMIC_ACQUIRE, "agent");
            asm volatile("s_waitcnt vmcnt(0)" ::: "memory");
        }
    }
    __syncthreads();
}


__global__ void __launch_bounds__(256, 2) mega(Params p) {
  cg::grid_group grid = cg::this_grid();
  __shared__ __attribute__((aligned(16))) char smem[SMEM_BYTES];
  __shared__ int s_unit;
  __shared__ uint4 xb_words;
  if (threadIdx.x == 0) xb_words = make_uint4(0u, 0u, 0u, 0u);
  __syncthreads();
  (void)xcd_barrier_post((unsigned*)(p.ws + OFF_BAR), (volatile LAS unsigned*)&xb_words);
#define XB_SYNC() do { XcdBarrier xb_; xb_.bar = (unsigned*)(p.ws + OFF_BAR); xb_.x = xb_xcc_id(); xb_.st = (volatile LAS unsigned*)&xb_words; xcd_barrier(xb_, wave0 * 64 + fresh_lane()); } while (0)
  int wave0 = __builtin_amdgcn_readfirstlane((int)(threadIdx.x >> 6));
  asm volatile("" : "+s"(wave0));
  const int nblk = gridDim.x;
  float* H = (float*)(p.ws + OFF_H);
  u16* P = (u16*)(p.ws + OFF_P);
  float* DEC = (float*)(p.ws + OFF_DEC);
  u16* AA = (u16*)(p.ws + OFF_AA);
  u16* GG = (u16*)(p.ws + OFF_GG);
  u16* Q = (u16*)(p.ws + OFF_Q);
  u16* MIX = (u16*)(p.ws + OFF_DEC);
  u16* HB1 = (u16*)p.out + (size_t)2 * M_ * 512;
  u16* HB2 = (u16*)(p.ws + OFF_HB2);
  u16* HBH = (u16*)(p.ws + OFF_AA);
  const u16* ZERO = (const u16*)(p.ws + OFF_ZERO);
  u16* ACT = (u16*)(p.ws + OFF_P);
  float2* ROPE = (float2*)(p.ws + OFF_ROPE);
  int* CTR = (int*)(p.ws + OFF_CTR);
  u16* KN = (u16*)p.out;
  u16* VT = KN + (size_t)M_ * 512;
  u16* YR = AA;

  {
  PHASE_TID
  for (int t = blockIdx.x; t < p.nconv; t += nblk) conv_tile(p, t, smem, tid);
  for (int i = blockIdx.x * 256 + tid; i < T_ * 16; i += nblk * 256) {
    int t = i >> 4, f = i & 15;
    double rev = (double)t * ROPE_C[f];
    rev -= floor(rev);
    float r = (float)rev;
    ROPE[i] = make_float2(__builtin_amdgcn_cosf(r), __builtin_amdgcn_sinf(r));
  }
  for (int row = (blockIdx.x * 4 + wave) * 2; row < M_; row += nblk * 8) {
    int b = row / T_, t = row % T_;
    const float* srcA = (t < NMETA_) ? (p.in[1] + (size_t)t * 1024) : (p.in[0] + ((size_t)b * SEQ_ + (t - NMETA_)) * 1024);
    u16* hb = (row < HB_SPLIT) ? HB1 + (size_t)row * 1024 : HB2 + (size_t)(row - HB_SPLIT) * 1024;
    ln_row2(srcA, srcA + 1024, p.in[2], p.in[3], H + (size_t)row * 1024, H + (size_t)(row + 1) * 1024, lane, hb, hb + 1024);
  }
  if (blockIdx.x == 0 && tid < 16) CTR[tid] = 0;
  if (blockIdx.x == 1) { for (int i = tid; i < 2048; i += 256) ((unsigned*)(p.ws + OFF_ZERO))[i] = 0u; }
  }
  grid.sync();

#pragma unroll 1
  for (int ph_ = 0; ph_ < 20; ph_++) {
    const int l = ph_ / 10, kph = ph_ - l * 10;
    const u16* WL = (const u16*)(p.ws + OFF_W) + (size_t)l * W_LAYER;
    if (kph == 0) {
    PHASE_TID
    for (int it_ = 0; it_ * nblk < 257 * 19; it_++) {
      int mt, nt;
      if (!map_tile(it_, nblk, 257, 19, mt, nt)) continue;
      f32x4 acc[8][4];
      zero_acc8(acc);
      ADma al = ADma{(mt < 255) ? HB1 : HB2, 1024, (mt < 255) ? mt * 256 : mt * 256 - HB_SPLIT, 0, ZERO, 0};
      gemm3(acc, al, WL + W_IN, 1024, nt * 128, 1024, smem, tid);
      ACC_COORDS
#pragma unroll
      for (int mi = 0; mi < 8; mi++)
#pragma unroll
        for (int ni = 0; ni < 4; ni++) {
          int col = nt * 128 + wc * 64 + ni * 16 + fq * 4;
          int row = mt * 256 + wr * 128 + mi * 16 + fr;
          if (col < PC_)
            *(uint2*)(P + (size_t)row * PC_ + col) = make_uint2(pk2(acc[mi][ni][0], acc[mi][ni][1]), pk2(acc[mi][ni][2], acc[mi][ni][3]));
        }
    }
    }
    if (kph == 1) {
    PHASE_TID
    {
      const float* qg = p.in[16] + l * 256;
      const float* kvg = p.in[18] + l * 256;
      for (int row = blockIdx.x * 4 + wave; row < M_; row += nblk * 4) {
        u16* pr = P + (size_t)row * PC_;
        uint2 cq = *(const uint2*)(pr + PMLA_ + lane * 4);
        uint2 ckv = *(const uint2*)(pr + PKV_ + lane * 4);
        float a[4], c[4];
        unpack4(cq, a);
        unpack4(ckv, c);
        float s1 = a[0] * a[0] + a[1] * a[1] + a[2] * a[2] + a[3] * a[3];
        float s2 = c[0] * c[0] + c[1] * c[1] + c[2] * c[2] + c[3] * c[3];
        s1 = wave_sum(s1, lane);
        s2 = wave_sum(s2, lane);
        float r1 = rsqrtf(s1 * (1.0f / 256.0f) + 1e-6f), r2 = rsqrtf(s2 * (1.0f / 256.0f) + 1e-6f);
        float4 g1 = *(const float4*)(qg + lane * 4), g2 = *(const float4*)(kvg + lane * 4);
        *(uint2*)(pr + PMLA_ + lane * 4) = make_uint2(pk2(a[0] * r1 * g1.x, a[1] * r1 * g1.y), pk2(a[2] * r1 * g1.z, a[3] * r1 * g1.w));
        *(uint2*)(pr + PKV_ + lane * 4) = make_uint2(pk2(c[0] * r2 * g2.x, c[1] * r2 * g2.y), pk2(c[2] * r2 * g2.z, c[3] * r2 * g2.w));
        if (lane < 16) {
          int t = row % T_;
          float x1 = bf2f(pr[PKR_ + lane]), x2 = bf2f(pr[PKR_ + 16 + lane]);
          float2 cs = ROPE[t * 16 + lane];
          pr[PKR_ + lane] = f2bf(x1 * cs.x - x2 * cs.y);
          pr[PKR_ + 16 + lane] = f2bf(x1 * cs.y + x2 * cs.x);
        }
      }
      const float* mu = p.in[5] + (size_t)l * 1824;
      for (int tile = blockIdx.x; tile < 514 * 12; tile += nblk) {
        int mt = tile / 12, sub = tile % 12, which = sub >> 2, nt = sub & 3;
        f32x4 acc[4][4];
        zero_acc(acc);
        ACC_COORDS
        if (which == 0) {
          AL<3> al{P + 1536, PC_, mt * 128, 0, 64, mu + 1536, 0};
          gemm_loop(acc, al, WL + W_LW, 64, nt * 128, 64, smem, tid);
          const float* w0 = p.in[6] + l * 512;
#pragma unroll
          for (int mi = 0; mi < 4; mi++)
#pragma unroll
            for (int ni = 0; ni < 4; ni++) {
              int col = nt * 128 + wc * 64 + ni * 16 + fr;
              float w0c = w0[col];
#pragma unroll
              for (int j = 0; j < 4; j++) {
                int row = mt * 128 + wr * 64 + mi * 16 + fq * 4 + j;
                float x = -(acc[mi][ni][j] + w0c);
                float sp = fmaxf(x, 0.f) + log1pf(__expf(-fabsf(x)));
                float wraw = -sp - 0.5f;
                DEC[(size_t)row * 512 + col] = __expf(-__expf(wraw));
              }
            }
        } else if (which == 1) {
          AL<3> al{P + 1600, PC_, mt * 128, 0, 64, mu + 1600, 1};
          gemm_loop(acc, al, WL + W_LA, 64, nt * 128, 64, smem, tid);
          const float* a0 = p.in[8] + l * 512;
#pragma unroll
          for (int mi = 0; mi < 4; mi++)
#pragma unroll
            for (int ni = 0; ni < 4; ni++) {
              int col = nt * 128 + wc * 64 + ni * 16 + fr;
              float a0c = a0[col];
#pragma unroll
              for (int j = 0; j < 4; j++) {
                int row = mt * 128 + wr * 64 + mi * 16 + fq * 4 + j;
                AA[(size_t)row * 512 + col] = f2bf(sigmoidf_(acc[mi][ni][j] + a0c));
              }
            }
        } else {
          AL<3> al{P + 1664, PC_, mt * 128, 0, 160, mu + 1664, 2};
          gemm_loop(acc, al, WL + W_LG, 192, nt * 128, 192, smem, tid);
#pragma unroll
          for (int mi = 0; mi < 4; mi++)
#pragma unroll
            for (int ni = 0; ni < 4; ni++) {
              int col = nt * 128 + wc * 64 + ni * 16 + fr;
#pragma unroll
              for (int j = 0; j < 4; j++) {
                int row = mt * 128 + wr * 64 + mi * 16 + fq * 4 + j;
                GG[(size_t)row * 512 + col] = f2bf(acc[mi][ni][j]);
              }
            }
        }
      }
    }
    }
    if (kph == 2) {
    PHASE_TID
    for (int it_ = 0; it_ * nblk < 257 * 14; it_++) {
      int mt, sub;
      if (!map_tile(it_, nblk, 257, 14, mt, sub)) continue;
      f32x4 acc[8][4];
      zero_acc8(acc);
      ACC_COORDS
      if (sub < 6) {
        ADma al{P + PMLA_, PC_, mt * 256, 0, ZERO, 0};
        gemm3(acc, al, WL + W_UQ, 256, sub * 128, 256, smem, tid);
#pragma unroll
        for (int mi = 0; mi < 8; mi++)
#pragma unroll
          for (int ni = 0; ni < 4; ni++) {
            int col = sub * 128 + wc * 64 + ni * 16 + fq * 4;
            int row = mt * 256 + wr * 128 + mi * 16 + fr;
            *(uint2*)(Q + (size_t)row * 768 + col) = make_uint2(pk2(acc[mi][ni][0], acc[mi][ni][1]), pk2(acc[mi][ni][2], acc[mi][ni][3]));
          }
      } else if (sub < 10) {
        int nt = sub - 6;
        ADma al{P + PKV_, PC_, mt * 256, 0, ZERO, 0};
        gemm3(acc, al, WL + W_UK, 256, nt * 128, 256, smem, tid);
#pragma unroll
        for (int mi = 0; mi < 8; mi++)
#pragma unroll
          for (int ni = 0; ni < 4; ni++) {
            int col = nt * 128 + wc * 64 + ni * 16 + fq * 4;
            int row = mt * 256 + wr * 128 + mi * 16 + fr;
            *(uint2*)(KN + (size_t)row * 512 + col) = make_uint2(pk2(acc[mi][ni][0], acc[mi][ni][1]), pk2(acc[mi][ni][2], acc[mi][ni][3]));
          }
      } else {
        int nt = sub - 10;
        ADma al{P + PKV_, PC_, mt * 256, 0, ZERO, 0};
        gemm3<4, false>(acc, al, WL + W_UV, 256, nt * 128, 256, smem, tid);
#pragma unroll
        for (int mi = 0; mi < 8; mi++)
#pragma unroll
          for (int ni = 0; ni < 4; ni++) {
            int col = nt * 128 + wc * 64 + ni * 16 + fr;
            int row = mt * 256 + wr * 128 + mi * 16 + fq * 4;
            int b = row / T_, t = row % T_;
            size_t o = ((size_t)(b * 512 + col)) * T_ + t;
            *(uint2*)(VT + o) = make_uint2(pk2(acc[mi][ni][0], acc[mi][ni][1]), pk2(acc[mi][ni][2], acc[mi][ni][3]));
          }
      }
    }
    }
    if (kph == 3) {
    PHASE_TID
    {
      const int xcd = blockIdx.x & 7, loc = blockIdx.x >> 3;
      const int total = 16 * 33;
      const bool scan_wg = (loc < 16), partner = (loc >= (nblk >> 4) && loc < (nblk >> 4) + 16);
      if (scan_wg) {
        scan_unit(p, l, xcd * 16 + loc, smem, launder(tid));
        __syncthreads();
      }
      if (!partner) {
        while (true) {
          if (tid == 0) s_unit = atomicAdd(&CTR[l * 8 + xcd], 1);
          __syncthreads();
          int v = s_unit;
          __syncthreads();
          if (v >= total) break;
          const int tidu = launder(tid);
          int g = v / 66, w = v - g * 66;
          attn_unit(p, xcd * 16 + g * 2 + (w & 1), 32 - (w >> 1), smem, tidu);
          __syncthreads();
        }
      }
    }
    }
    if (kph == 4) {
    PHASE_TID
    for (int it_ = 0; it_ * nblk < 257 * 16; it_++) {
      int mt, nt;
      if (!map_tile(it_, nblk, 257, 16, mt, nt)) continue;
      f32x4 acc[8][2];
      unsigned sg[8][2][2];
      ADma alh = ADma{(mt < 255) ? HB1 : HB2, 1024, (mt < 255) ? mt * 256 : mt * 256 - HB_SPLIT, 0, ZERO, 0};
      zero_acc8(acc);
      const int tid1 = launder(tid);
      gemm3(acc, alh, WL + W_G, 1024, nt * 64, 1024, smem, tid1);
#pragma unroll
      for (int mi = 0; mi < 8; mi++)
#pragma unroll
        for (int ni = 0; ni < 2; ni++) {
          sg[mi][ni][0] = pk2(sigmoidf_(acc[mi][ni][0]), sigmoidf_(acc[mi][ni][1]));
          sg[mi][ni][1] = pk2(sigmoidf_(acc[mi][ni][2]), sigmoidf_(acc[mi][ni][3]));
        }
      zero_acc8(acc);
      {
        ADma aly{YR, 512, mt * 256, 0, ZERO, 0};
        const int tid2 = launder(tid);
      gemm3(acc, aly, WL + W_PR, 512, nt * 64, 512, smem, tid2);
      }
{ const int tidq = launder(tid); const int lane = tidq & 63, wave = tidq >> 6; ACC_COORDS
#pragma unroll
      for (int mi = 0; mi < 8; mi++)
#pragma unroll
        for (int ni = 0; ni < 2; ni++) {
          int col = nt * 64 + wc * 32 + ni * 16 + fq * 4;
          int row = mt * 256 + wr * 128 + mi * 16 + fr;
          *(uint2*)(MIX + (size_t)row * 1024 + col) = make_uint2(pk2(bflo(sg[mi][ni][0]) * acc[mi][ni][0], bfhi(sg[mi][ni][0]) * acc[mi][ni][1]),
                                                                 pk2(bflo(sg[mi][ni][1]) * acc[mi][ni][2], bfhi(sg[mi][ni][1]) * acc[mi][ni][3]));
        }
      }
      zero_acc8(acc);
      const int tid3 = launder(tid);
      gemm3(acc, alh, WL + W_G, 1024, 1024 + nt * 64, 1024, smem, tid3);
#pragma unroll
      for (int mi = 0; mi < 8; mi++)
#pragma unroll
        for (int ni = 0; ni < 2; ni++) {
          sg[mi][ni][0] = pk2(sigmoidf_(acc[mi][ni][0]), sigmoidf_(acc[mi][ni][1]));
          sg[mi][ni][1] = pk2(sigmoidf_(acc[mi][ni][2]), sigmoidf_(acc[mi][ni][3]));
        }
      zero_acc8(acc);
      {
        ADma alm{P + PMLA_, PC_, mt * 256, 0, ZERO, 0};
        const int tid4 = launder(tid);
      gemm3(acc, alm, WL + W_PM, 512, nt * 64, 512, smem, tid4);
      }
{ const int tidq = launder(tid); const int lane = tidq & 63, wave = tidq >> 6; ACC_COORDS
#pragma unroll
      for (int mi = 0; mi < 8; mi++)
#pragma unroll
        for (int ni = 0; ni < 2; ni++) {
          int col = nt * 64 + wc * 32 + ni * 16 + fq * 4;
          int row = mt * 256 + wr * 128 + mi * 16 + fr;
          uint2 pm = *(const uint2*)(MIX + (size_t)row * 1024 + col);
          float o0 = bflo(pm.x) + bflo(sg[mi][ni][0]) * acc[mi][ni][0];
          float o1 = bfhi(pm.x) + bfhi(sg[mi][ni][0]) * acc[mi][ni][1];
          float o2 = bflo(pm.y) + bflo(sg[mi][ni][1]) * acc[mi][ni][2];
          float o3 = bfhi(pm.y) + bfhi(sg[mi][ni][1]) * acc[mi][ni][3];
          *(uint2*)(MIX + (size_t)row * 1024 + col) = make_uint2(pk2(o0, o1), pk2(o2, o3));
        }
      }
    }
    }
    if (kph == 5) {
    PHASE_TID
    for (int prb_ = (PROBE_FI ? 0 : 1); prb_ < 2; prb_++)
    for (int it_ = 0; it_ * nblk < 257 * 8; it_++) {
      int mt, nt;
      if (!map_tile(it_, nblk, 257, 8, mt, nt)) continue;
      f32x4 acc[8][4];
      zero_acc8(acc);
      ACC_COORDS
      ADma al{MIX, 1024, mt * 256, 0, ZERO, 0};
      gemm3(acc, al, WL + W_OUT, 1024, nt * 128, 1024, smem, tid);
#pragma unroll
      for (int mi = 0; mi < 8; mi++)
#pragma unroll
        for (int ni = 0; ni < 4; ni++) {
          int col = nt * 128 + wc * 64 + ni * 16 + fq * 4;
          int row = mt * 256 + wr * 128 + mi * 16 + fr;
          float* hp = H + (size_t)row * 1024 + col;
          float* dp = (prb_ == 0) ? (p.out + (size_t)(row & 65535) * 1024 + col) : hp;
          float4 hv = *(const float4*)hp;
          hv.x = ALPHA_ * hv.x + acc[mi][ni][0];
          hv.y = ALPHA_ * hv.y + acc[mi][ni][1];
          hv.z = ALPHA_ * hv.z + acc[mi][ni][2];
          hv.w = ALPHA_ * hv.w + acc[mi][ni][3];
          *(float4*)dp = hv;
        }
    }
    }
    if (kph == 6) {
    PHASE_TID
    for (int row = (blockIdx.x * 4 + wave) * 2; row < M_; row += nblk * 8)
      ln_row2(H + (size_t)row * 1024, H + (size_t)(row + 1) * 1024, p.in[24] + l * 1024, p.in[25] + l * 1024, H + (size_t)row * 1024, H + (size_t)(row + 1) * 1024, lane, HBH + (size_t)row * 1024, HBH + (size_t)(row + 1) * 1024);
    }
    if (kph == 7) {
    PHASE_TID
    {
      const float* cw = p.in[27] + (size_t)l * 3 * 5632;
      const float* cb = p.in[28] + (size_t)l * 5632;
#if PROBE_HOT
      for (int it_ = 0; it_ * nblk < 272 * 44; it_++) {
        int rest, nt;
        if (!map_tile(it_, nblk, 272, 44, rest, nt)) continue;
        f32x4 acc[8][4];
        zero_acc8(acc);
#if PROBE_HOT == 1
        ADma al{HBH, 1024, 0, 0, ZERO, 1, p.ws};
        gemm3(acc, al, WL + W_UP, 1024, 0, 1024, smem, tid);
#else
        int it = rest % 17, b = rest / 17;
        ADma al{HBH, 1024, b * T_, 254 * it - 2, ZERO, 1, p.ws};
        gemm3(acc, al, WL + W_UP, 1024, nt * 128, 1024, smem, tid);
#endif
        float sacc = 0.f;
#pragma unroll
        for (int mi = 0; mi < 8; mi++)
#pragma unroll
          for (int ni = 0; ni < 4; ni++) sacc += acc[mi][ni][0] + acc[mi][ni][1] + acc[mi][ni][2] + acc[mi][ni][3];
        if (sacc == 12345.678f) ACT[tid] = 0;
      }
#endif
      for (int it_ = 0; it_ * nblk < 272 * 44; it_++) {
        int rest, nt;
        if (!map_tile(it_, nblk, 272, 44, rest, nt)) continue;
        int it = rest % 17, b = rest / 17;
        int t0 = 254 * it - 2;
        f32x4 acc[8][4];
        zero_acc8(acc);
        ADma al{HBH, 1024, b * T_, t0, ZERO, 1, p.ws};
        gemm3(acc, al, WL + W_UP, 1024, nt * 128, 1024, smem, launder(tid));
        ACC_COORDS
        float(*ut)[132] = (float(*)[132])smem;
        const int tidh = launder(tid);
        const int c = tidh & 63, rg = tidh >> 6;
        const int gcol = nt * 64 + c, vcol = DFF_ + nt * 64 + c;
        const float g0 = cw[gcol], g1 = cw[5632 + gcol], g2 = cw[2 * 5632 + gcol], gb = cb[gcol];
        const float v0 = cw[vcol], v1 = cw[5632 + vcol], v2 = cw[2 * 5632 + vcol], vb = cb[vcol];
#pragma unroll 1
        for (int half = 0; half < 2; half++) {
          float carry = 0.f;
          if (half == 1) carry = ut[126 + (tid >> 7)][tid & 127];
          __syncthreads();
          if (half == 1) ut[tid >> 7][tid & 127] = carry;
          if (wr == half) {
#pragma unroll
            for (int mi = 0; mi < 8; mi++)
#pragma unroll
              for (int ni = 0; ni < 4; ni++)
                *(float4*)&ut[half * 2 + mi * 16 + fr][wc * 64 + ni * 16 + fq * 4] = make_float4(acc[mi][ni][0], acc[mi][ni][1], acc[mi][ni][2], acc[mi][ni][3]);
          }
          __syncthreads();
          const int nq = half ? 130 : 128;
          int qs = 2 + rg * 32, qe = min(qs + 32, nq);
          float ga = ut[qs - 2][c], gbp = ut[qs - 1][c];
          float va = ut[qs - 2][64 + c], vbp = ut[qs - 1][64 + c];
          for (int q = qs; q < qe; q++) {
            float gc = ut[q][c], vc = ut[q][64 + c];
            int t = t0 + half * 126 + q;
            if (t < T_) {
              float gate = g0 * ga + g1 * gbp + g2 * gc + gb;
              float val = v0 * va + v1 * vbp + v2 * vc + vb;
              float av = gate * sigmoidf_(gate) * val;
              ACT[(size_t)(b * T_ + t) * DFF_ + gcol] = f2bf(av);
            }
            ga = gbp; gbp = gc; va = vbp; vbp = vc;
          }
        }
        __syncthreads();
      }
    }
    }
    if (kph == 8) {
    PHASE_TID
    for (int prb_ = (PROBE_FI ? 0 : 1); prb_ < 2; prb_++)
    for (int it_ = 0; it_ * nblk < 257 * 8; it_++) {
      int mt, nt;
      if (!map_tile(it_, nblk, 257, 8, mt, nt)) continue;
      f32x4 acc[8][4];
      zero_acc8(acc);
      ACC_COORDS
      ADma al{ACT, DFF_, mt * 256, 0, ZERO, 0};
      gemm3(acc, al, WL + W_DN, DFF_, nt * 128, DFF_, smem, tid);
#pragma unroll
      for (int mi = 0; mi < 8; mi++)
#pragma unroll
        for (int ni = 0; ni < 4; ni++) {
          int col = nt * 128 + wc * 64 + ni * 16 + fq * 4;
          int row = mt * 256 + wr * 128 + mi * 16 + fr;
          float* hp = H + (size_t)row * 1024 + col;
          float* dp = (prb_ == 0) ? (p.out + (size_t)(row & 65535) * 1024 + col) : hp;
          float4 hv = *(const float4*)hp;
          hv.x = ALPHA_ * hv.x + acc[mi][ni][0];
          hv.y = ALPHA_ * hv.y + acc[mi][ni][1];
          hv.z = ALPHA_ * hv.z + acc[mi][ni][2];
          hv.w = ALPHA_ * hv.w + acc[mi][ni][3];
          *(float4*)dp = hv;
        }
    }
    }
    if (kph == 9) {
    PHASE_TID
    if (l == 0) {
      for (int row = (blockIdx.x * 4 + wave) * 2; row < M_; row += nblk * 8) {
        u16* hb = (row < HB_SPLIT) ? HB1 + (size_t)row * 1024 : HB2 + (size_t)(row - HB_SPLIT) * 1024;
        ln_row2(H + (size_t)row * 1024, H + (size_t)(row + 1) * 1024, p.in[30], p.in[31], H + (size_t)row * 1024, H + (size_t)(row + 1) * 1024, lane, hb, hb + 1024);
      }
    } else {
      for (int row = (blockIdx.x * 4 + wave) * 2; row < M_; row += nblk * 8) {
        int b = row / T_, t = row % T_;
        if (t >= NMETA_) {
          float* o = p.out + ((size_t)b * SEQ_ + (t - NMETA_)) * 1024;
          ln_row2(H + (size_t)row * 1024, H + (size_t)(row + 1) * 1024, p.in[30] + 1024, p.in[31] + 1024, o, o + 1024, lane, nullptr, nullptr);
        }
      }
    }
    }
    if (ph_ != 19) XB_SYNC();
  }
}

extern "C" void kernel_launch(void* const* d_in, const int* in_sizes, int n_in, void* d_out, int out_size, void* d_ws,
                              size_t ws_size, hipStream_t stream) {
  static int grid_blocks = 0;
  if (!grid_blocks) {
    int dev = 0, cus = 0, per_cu = 0;
    hipGetDevice(&dev);
    hipDeviceGetAttribute(&cus, hipDeviceAttributeMultiprocessorCount, dev);
    hipOccupancyMaxActiveBlocksPerMultiprocessor(&per_cu, mega, 256, 0);
    if (per_cu > 2) per_cu = 2;
    grid_blocks = cus * per_cu;
  }
  if (ws_size < WS_TOTAL) fprintf(stderr, "workspace too small: %zu < %zu\n", ws_size, (size_t)WS_TOTAL);
  Params p;
  memset(&p, 0, sizeof(p));
  for (int i = 0; i < 32; i++) p.in[i] = (const float*)d_in[i];
  p.out = (float*)d_out;
  p.ws = (char*)d_ws;
  u16* wb = (u16*)((char*)d_ws + OFF_W);
  int nj = 0, tiles = 0;
  auto add = [&](const float* src, size_t dst_off, int ld, int c0, int K, int Kpad, int Nv, int Np, int mode) {
    Job& j = p.jobs[nj++];
    j.src = src; j.dst = wb + dst_off; j.ld = ld; j.c0 = c0; j.K = K; j.Kpad = Kpad; j.Nv = Nv; j.Np = Np; j.mode = mode;
    j.tile0 = tiles;
    tiles += (Kpad / 64) * (Np / 64);
  };
  for (int l = 0; l < 2; l++) {
    size_t o = (size_t)l * W_LAYER;
    const float* w_in = (const float*)d_in[4] + (size_t)l * 1024 * 4416;
    add(w_in, o + W_IN, 4416, 0, 1024, 1024, 2368, 2432, 0);
    add(w_in, o + W_G, 4416, 2368, 1024, 1024, 2048, 2048, 0);
    add((const float*)d_in[7] + (size_t)l * 64 * 512, o + W_LW, 512, 0, 64, 64, 512, 512, 0);
    add((const float*)d_in[9] + (size_t)l * 64 * 512, o + W_LA, 512, 0, 64, 64, 512, 512, 0);
    add((const float*)d_in[10] + (size_t)l * 160 * 512, o + W_LG, 512, 0, 160, 192, 512, 512, 0);
    add((const float*)d_in[17] + (size_t)l * 256 * 768, o + W_UQ, 768, 0, 256, 256, 768, 768, 0);
    add((const float*)d_in[19] + (size_t)l * 256 * 512, o + W_UK, 512, 0, 256, 256, 512, 512, 0);
    add((const float*)d_in[20] + (size_t)l * 256 * 512, o + W_UV, 512, 0, 256, 256, 512, 512, 0);
    add((const float*)d_in[21] + (size_t)l * 512 * 1024, o + W_PR, 1024, 0, 512, 512, 1024, 1024, 0);
    add((const float*)d_in[22] + (size_t)l * 512 * 1024, o + W_PM, 1024, 0, 512, 512, 1024, 1024, 0);
    add((const float*)d_in[23] + (size_t)l * 1024 * 1024, o + W_OUT, 1024, 0, 1024, 1024, 1024, 1024, 0);
    add((const float*)d_in[26] + (size_t)l * 1024 * 5632, o + W_UP, 5632, 0, 1024, 1024, 5632, 5632, 1);
    add((const float*)d_in[29] + (size_t)l * 2816 * 1024, o + W_DN, 1024, 0, 2816, 2816, 1024, 1024, 0);
  }
  p.nconv = tiles;
  hipMemsetAsync((char*)d_ws + OFF_BAR, 0, 16384, stream);
  void* args[] = {&p};
  hipError_t e = hipLaunchCooperativeKernel((void*)mega, dim3(grid_blocks), dim3(256), args, 0, stream);
  if (e != hipSuccess) fprintf(stderr, "cooperative launch failed: %s (grid %d)\n", hipGetErrorString(e), grid_blocks);
}
```

```cpp
#include <hip/hip_runtime.h>
#include <hip/hip_cooperative_groups.h>
#include <cstdio>
#include <cstring>
namespace cg = cooperative_groups;

#ifndef PHMASK
#define PHMASK 0xFFFF
#endif
#ifndef PROBE_HOT
#define PROBE_HOT 0
#endif
#ifndef PROBE_FI
#define PROBE_FI 0
#endif
#ifndef REPMASK
#define REPMASK 0
#endif
typedef unsigned short u16;
using bf16x8 = __attribute__((ext_vector_type(8))) short;
using f32x4 = __attribute__((ext_vector_type(4))) float;

constexpr int B_ = 16, SEQ_ = 4096, NMETA_ = 16, T_ = 4112, M_ = B_ * T_, D_ = 1024;
constexpr int PC_ = 2368;
constexpr int PMLA_ = 1824, PKV_ = 2080, PKR_ = 2336;
constexpr int DFF_ = 2816;
constexpr float ALPHA_ = 1.4142135623730951f;

constexpr size_t OFF_H = 0;
constexpr size_t OFF_P = OFF_H + (size_t)M_ * 1024 * 4;
constexpr size_t OFF_DEC = OFF_P + (size_t)M_ * PC_ * 2;
constexpr size_t OFF_AA = OFF_DEC + (size_t)M_ * 512 * 4;
constexpr size_t OFF_GG = OFF_AA + (size_t)M_ * 512 * 2;
constexpr size_t OFF_Q = OFF_GG + (size_t)M_ * 512 * 2;
constexpr size_t OFF_W = OFF_Q + (size_t)M_ * 768 * 2;
constexpr size_t W_IN = 0;
constexpr size_t W_G = W_IN + (size_t)2432 * 1024;
constexpr size_t W_LW = W_G + (size_t)2048 * 1024;
constexpr size_t W_LA = W_LW + (size_t)512 * 64;
constexpr size_t W_LG = W_LA + (size_t)512 * 64;
constexpr size_t W_UQ = W_LG + (size_t)512 * 192;
constexpr size_t W_UK = W_UQ + (size_t)768 * 256;
constexpr size_t W_UV = W_UK + (size_t)512 * 256;
constexpr size_t W_PR = W_UV + (size_t)512 * 256;
constexpr size_t W_PM = W_PR + (size_t)1024 * 512;
constexpr size_t W_OUT = W_PM + (size_t)1024 * 512;
constexpr size_t W_UP = W_OUT + (size_t)1024 * 1024;
constexpr size_t W_DN = W_UP + (size_t)5632 * 1024;
constexpr size_t W_LAYER = W_DN + (size_t)1024 * 2816;
constexpr size_t OFF_ROPE = OFF_W + 2 * W_LAYER * 2;
constexpr size_t OFF_CTR = OFF_ROPE + (size_t)T_ * 16 * 8;
constexpr size_t OFF_ZERO = OFF_CTR + 256;
constexpr size_t OFF_BAR = OFF_ZERO + 8192;
constexpr size_t OFF_HB2 = OFF_BAR + 16384;
constexpr size_t OFF_SCR = OFF_HB2 + (size_t)512 * 1024 * 2;
constexpr size_t WS_TOTAL = OFF_SCR + (size_t)1024 * 65536;
constexpr int HB_SPLIT = 65280;

struct Job { const float* src; u16* dst; int ld, c0, K, Kpad, Nv, Np, mode, tile0; };
struct Params {
  const float* in[32];
  float* out;
  char* ws;
  Job jobs[26];
  int nconv;
  int pad0;
};

__constant__ double ROPE_C[16] = {0.15915494309189535, 0.08949940160889101, 0.050329212104487035, 0.0283021958306234,
                                  0.015915494309189534, 0.008949940160889102, 0.005032921210448704, 0.00283021958306234,
                                  0.0015915494309189536, 0.0008949940160889102, 0.0005032921210448703, 0.00028302195830623395,
                                  0.00015915494309189535, 8.949940160889102e-05, 5.0329212104487035e-05, 2.8302195830623396e-05};

__device__ __forceinline__ int launder(int x) { asm volatile("" : "+v"(x)); return x; }
typedef __bf16 bf16x2_t __attribute__((ext_vector_type(2)));
typedef float f32x2_t __attribute__((ext_vector_type(2)));
__device__ __forceinline__ unsigned pk2(float a, float b) {
  f32x2_t v = {a, b};
  bf16x2_t r = __builtin_convertvector(v, bf16x2_t);
  return *(unsigned*)&r;
}
__device__ __forceinline__ u16 f2bf(float f) { return (u16)(pk2(f, 0.f) & 0xffffu); }
__device__ __forceinline__ float bf2f(unsigned h) { return __uint_as_float(h << 16); }
__device__ __forceinline__ float bflo(unsigned w) { return __uint_as_float(w << 16); }
__device__ __forceinline__ float bfhi(unsigned w) { return __uint_as_float(w & 0xffff0000u); }
__device__ __forceinline__ float sigmoidf_(float x) { return 1.0f / (1.0f + __expf(-x)); }

__device__ __forceinline__ int fresh_lane() { int x; asm volatile("v_mbcnt_lo_u32_b32 %0, -1, 0\n\tv_mbcnt_hi_u32_b32 %0, -1, %0" : "=v"(x)); return x; }
#define PHASE_TID const int tid = wave0 * 64 + fresh_lane(); const int lane = tid & 63, wave = tid >> 6; (void)lane; (void)wave;
template <int CTRL>
__device__ __forceinline__ float dppf(float x) {
  return __int_as_float(__builtin_amdgcn_update_dpp(0, __float_as_int(x), CTRL, 0xF, 0xF, true));
}
__device__ __forceinline__ float sum8(float x) {
  x += dppf<0xB1>(x);
  x += dppf<0x4E>(x);
  x += dppf<0x141>(x);
  return x;
}
__device__ __forceinline__ float sum16(float x) {
  x = sum8(x);
  x += dppf<0x140>(x);
  return x;
}
__device__ __forceinline__ float shx(float x, int lane, int o) {
  return __int_as_float(__builtin_amdgcn_ds_bpermute((lane ^ o) << 2, __float_as_int(x)));
}
__device__ __forceinline__ float wave_sum(float x, int lane) {
  x = sum16(x);
  x += shx(x, lane, 16);
  x += shx(x, lane, 32);
  return x;
}

constexpr int BM = 128, BN = 128, BK = 64, LDT = 64;
constexpr int SMEM_BYTES = 73728;

template <int MODE>
struct AL {
  const void* base;
  int ld;
  int row0;
  int t0;
  int kvalid;
  const float* mu;
  int fn;
  struct Raw { uint4 x, y; };
  __device__ __forceinline__ Raw fetch(int r, int k) const {
    Raw w;
    { unsigned z = (MODE == 3) ? (unsigned)launder(0) : 0u; w.x = make_uint4(z, z, z, z); w.y = w.x; }
    if (MODE == 0) {
      const float* p = (const float*)base + (size_t)(row0 + r) * ld + k;
      w.x = *(const uint4*)p;
      w.y = *(const uint4*)(p + 4);
    } else if (MODE == 1) {
      const u16* p = (const u16*)base + (size_t)(row0 + r) * ld + k;
      w.x = *(const uint4*)p;
    } else if (MODE == 4) {
      const float* p = (const float*)base + (size_t)(row0 + r) * ld + k;
      float4 a = *(const float4*)p, b = *(const float4*)(p + 4);
      w.x = make_uint4(pk2(a.x, a.y), pk2(a.z, a.w), pk2(b.x, b.y), pk2(b.z, b.w));
    } else if (MODE == 2) {
      int t = t0 + r;
      if (t >= 0 && t < T_) {
        const float* p = (const float*)base + (size_t)(row0 + t) * ld + k;
        w.x = *(const uint4*)p;
        w.y = *(const uint4*)(p + 4);
      }
    } else {
      int row = row0 + r;
      int t = row % T_;
      if (k < kvalid) {
        const u16* p = (const u16*)base + (size_t)row * ld + k;
        w.x = *(const uint4*)p;
        if (t > 0) w.y = *(const uint4*)(p - ld);
      }
    }
    return w;
  }
  __device__ __forceinline__ uint4 cvt(const Raw& w, int k) const {
    if (MODE == 0 || MODE == 2) {
      uint4 o;
      o.x = pk2(__uint_as_float(w.x.x), __uint_as_float(w.x.y));
      o.y = pk2(__uint_as_float(w.x.z), __uint_as_float(w.x.w));
      o.z = pk2(__uint_as_float(w.y.x), __uint_as_float(w.y.y));
      o.w = pk2(__uint_as_float(w.y.z), __uint_as_float(w.y.w));
      return o;
    } else if (MODE == 1 || MODE == 4) {
      return w.x;
    } else {
      if (k >= kvalid) { unsigned z = (unsigned)launder(0); return make_uint4(z, z, z, z); }
      unsigned cw[4] = {w.x.x, w.x.y, w.x.z, w.x.w};
      unsigned pw[4] = {w.y.x, w.y.y, w.y.z, w.y.w};
      unsigned ow[4];
#pragma unroll
      for (int e = 0; e < 4; e++) {
        float x0 = bflo(cw[e]), x1 = bfhi(cw[e]);
        float p0 = bflo(pw[e]), p1 = bfhi(pw[e]);
        float v0 = x0 + (p0 - x0) * mu[k + 2 * e];
        float v1 = x1 + (p1 - x1) * mu[k + 2 * e + 1];
        if (fn == 0) {
          v0 = 1.0f - 2.0f / (__expf(2.0f * v0) + 1.0f);
          v1 = 1.0f - 2.0f / (__expf(2.0f * v1) + 1.0f);
        } else if (fn == 2) {
          v0 = sigmoidf_(v0);
          v1 = sigmoidf_(v1);
        }
        ow[e] = pk2(v0, v1);
      }
      return make_uint4(ow[0], ow[1], ow[2], ow[3]);
    }
  }
};

template <int NI>
__device__ __forceinline__ void zero_acc(f32x4 (&acc)[4][NI]) {
#pragma unroll
  for (int i = 0; i < 4; i++)
#pragma unroll
    for (int j = 0; j < NI; j++) acc[i][j] = f32x4{0.f, 0.f, 0.f, 0.f};
}

#define REP4(X) X(0) X(1) X(2) X(3)
template <class ALT, int NI>
__device__ __forceinline__ void gemm_loop(f32x4 (&acc)[4][NI], const ALT& al, const u16* __restrict__ Bt, int ldb, int n0,
                                          int K, char* smem, const int tid) {
  const int lane = tid & 63, wave = tid >> 6;
  const int wr = wave >> 1, wc = wave & 1, fr = lane & 15, fq = lane >> 4;
  const int lr = tid >> 3, lk = (tid & 7) * 8, lsw = ((tid & 7) ^ (lr & 7)) * 8;
  u16* sa = (u16*)smem;
  u16* sb = sa + 2 * BM * LDT;
  typename ALT::Raw ra0, ra1, ra2, ra3;
  uint4 rb0 = make_uint4(0,0,0,0), rb1 = rb0, rb2 = rb0, rb3 = rb0;
  const u16* bp = Bt + (size_t)(n0 + lr) * ldb + lk;
#define GL_FETCH(i) ra##i = al.fetch(lr + 32 * i, kf); if (i < NI) rb##i = *(const uint4*)(bp + (size_t)(32 * i) * ldb + kb);
#define GL_STORE(i) *(uint4*)(a_ + (lr + 32 * i) * LDT + lsw) = al.cvt(ra##i, kt * BK + lk); if (i < NI) *(uint4*)(b_ + (lr + 32 * i) * LDT + lsw) = rb##i;
  {
    const int kf = lk, kb = 0;
    REP4(GL_FETCH)
  }
  const int nk = K / BK;
  for (int kt = 0; kt < nk; kt++) {
    u16* a_ = sa + (kt & 1) * BM * LDT;
    u16* b_ = sb + (kt & 1) * BN * LDT;
    REP4(GL_STORE)
    __syncthreads();
    if (kt + 1 < nk) {
      const int kf = (kt + 1) * BK + lk, kb = (kt + 1) * BK;
      REP4(GL_FETCH)
    }
#pragma unroll
    for (int ks = 0; ks < 2; ks++) {
      bf16x8 af[4], bf[NI];
#pragma unroll
      for (int i = 0; i < 4; i++) af[i] = *(const bf16x8*)(a_ + (wr * 64 + i * 16 + fr) * LDT + (((ks * 4 + fq) ^ (fr & 7)) * 8));
#pragma unroll
      for (int i = 0; i < NI; i++) bf[i] = *(const bf16x8*)(b_ + (wc * (NI * 16) + i * 16 + fr) * LDT + (((ks * 4 + fq) ^ (fr & 7)) * 8));
#pragma unroll
      for (int mi = 0; mi < 4; mi++)
#pragma unroll
        for (int ni = 0; ni < NI; ni++)
          acc[mi][ni] = __builtin_amdgcn_mfma_f32_16x16x32_bf16(af[mi], bf[ni], acc[mi][ni], 0, 0, 0);
    }
  }
  __syncthreads();
#undef GL_FETCH
#undef GL_STORE
}


struct ADma { const u16* base; int ld; int row0; int t0; const u16* zero; int mode; const char* wsb; };
constexpr int G3_STAGE = 12288;

template <int NI, bool SWAP = true>
__device__ __forceinline__ void gemm3(f32x4 (&acc)[8][NI], const ADma& a, const u16* __restrict__ Bt, int ldb, int n0, int K,
                                      char* smem, const int tid) {
  const int lane = tid & 63, wave = tid >> 6;
  const int wr = wave >> 1, wc = wave & 1, fr = lane & 15, fq = lane >> 4;
  const int kc8 = ((lane & 3) ^ ((4 - (lane >> 4)) & 3)) * 8;
  const int psw = (fq ^ ((4 - (fr >> 2)) & 3)) * 8;
  u16* sm = (u16*)smem;
  const u16* ap0 = nullptr;
  unsigned ao0 = 0, ao1 = 0, ao2 = 0, ao3 = 0;
  if (a.mode == 0) {
    ap0 = a.base + (size_t)(a.row0 + wave * 64 + (lane >> 2)) * a.ld + kc8;
  } else {
    const unsigned bo = (unsigned)((const char*)a.base - a.wsb), zo = (unsigned)((const char*)a.zero - a.wsb) + kc8 * 2;
#define G3_AP(j)                                                                          \
    {                                                                                     \
      int t = a.t0 + wave * 64 + j * 16 + (lane >> 2);                                    \
      ao##j = (t >= 0 && t < T_) ? bo + (unsigned)(((a.row0 + t) * a.ld + kc8) * 2) : zo; \
    }
    REP4(G3_AP)
#undef G3_AP
  }
  const u16* bp0 = Bt + (size_t)(n0 + wave * (8 * NI) + (lane >> 2)) * ldb + kc8;
  const size_t astep = (size_t)16 * a.ld;
  const size_t bstep = (size_t)16 * ldb;
#define G3_ISSUE(j)                                                                                                              \
  __builtin_amdgcn_global_load_lds((a.mode == 0) ? (const unsigned*)(ap0 + j * astep + kof) : (const unsigned*)(a.wsb + ao##j + kof * 2), (unsigned*)(st_ + (wave * 64 + j * 16) * 32 + lane * 8), 16, 0, 0); \
  if (2 * j < NI) __builtin_amdgcn_global_load_lds((const unsigned*)(bp0 + j * bstep + kof), (unsigned*)(st_ + 8192 + (wave * (8 * NI) + j * 16) * 32 + lane * 8), 16, 0, 0);
  const int nk = K / 32;
  asm volatile("s_waitcnt vmcnt(0)" ::: "memory");
  {
    const int kof = 0;
    u16* st_ = sm;
    REP4(G3_ISSUE)
  }
  if (nk > 1) {
    const int kof = 32;
    u16* st_ = sm + G3_STAGE;
    REP4(G3_ISSUE)
  }
  int cur = 0, nxt = 2;
  const unsigned lds0 = (unsigned)(size_t)(__attribute__((address_space(3))) char*)smem;
  const unsigned aoff = lds0 + (unsigned)(((wr * 128 + fr) * 32 + psw) * 2);
  const unsigned boff = lds0 + 16384u + (unsigned)(((wc * (NI * 16) + fr) * 32 + psw) * 2);
#define G3_DSR(dst, addr, off) asm volatile("ds_read_b128 %0, %1 offset:" #off : "=v"(dst) : "v"(addr))
  for (int kt = 0; kt < nk; kt++) {
    if (kt + 1 < nk) {
      if (NI == 4) asm volatile("s_waitcnt vmcnt(6)" ::: "memory");
      else asm volatile("s_waitcnt vmcnt(5)" ::: "memory");
    } else {
      asm volatile("s_waitcnt vmcnt(0)" ::: "memory");
    }
    __builtin_amdgcn_s_barrier();
    if (kt + 2 < nk) {
      const int kof = (kt + 2) * 32;
      u16* st_ = sm + nxt * G3_STAGE;
      REP4(G3_ISSUE)
    }
    const unsigned aaddr = aoff + (unsigned)cur * (G3_STAGE * 2);
    const unsigned baddr = boff + (unsigned)cur * (G3_STAGE * 2);
    bf16x8 af[8], bf[NI];
    G3_DSR(af[0], aaddr, 0); G3_DSR(af[1], aaddr, 1024); G3_DSR(af[2], aaddr, 2048); G3_DSR(af[3], aaddr, 3072);
    G3_DSR(bf[0], baddr, 0); G3_DSR(bf[1], baddr, 1024);
    if (NI == 4) { G3_DSR(bf[NI - 2], baddr, 2048); G3_DSR(bf[NI - 1], baddr, 3072); }
    G3_DSR(af[4], aaddr, 4096); G3_DSR(af[5], aaddr, 5120); G3_DSR(af[6], aaddr, 6144); G3_DSR(af[7], aaddr, 7168);
    if (NI == 4) {
      asm volatile("s_waitcnt lgkmcnt(4)"
                   : "+v"(af[0]), "+v"(af[1]), "+v"(af[2]), "+v"(af[3]), "+v"(bf[0]), "+v"(bf[1]), "+v"(bf[NI - 2]), "+v"(bf[NI - 1]));
    } else {
      asm volatile("s_waitcnt lgkmcnt(4)" : "+v"(af[0]), "+v"(af[1]), "+v"(af[2]), "+v"(af[3]), "+v"(bf[0]), "+v"(bf[1]));
    }
#pragma unroll
    for (int mi = 0; mi < 4; mi++)
#pragma unroll
      for (int ni = 0; ni < NI; ni++)
        acc[mi][ni] = SWAP ? __builtin_amdgcn_mfma_f32_16x16x32_bf16(bf[ni], af[mi], acc[mi][ni], 0, 0, 0)
                           : __builtin_amdgcn_mfma_f32_16x16x32_bf16(af[mi], bf[ni], acc[mi][ni], 0, 0, 0);
    asm volatile("s_waitcnt lgkmcnt(0)" : "+v"(af[4]), "+v"(af[5]), "+v"(af[6]), "+v"(af[7]));
#pragma unroll
    for (int mi = 4; mi < 8; mi++)
#pragma unroll
      for (int ni = 0; ni < NI; ni++)
        acc[mi][ni] = SWAP ? __builtin_amdgcn_mfma_f32_16x16x32_bf16(bf[ni], af[mi], acc[mi][ni], 0, 0, 0)
                           : __builtin_amdgcn_mfma_f32_16x16x32_bf16(af[mi], bf[ni], acc[mi][ni], 0, 0, 0);
    cur = (cur == 2) ? 0 : cur + 1;
    nxt = (nxt == 2) ? 0 : nxt + 1;
  }
  asm volatile("s_waitcnt lgkmcnt(0)" ::: "memory");
  __syncthreads();
#undef G3_DSR
#undef G3_ISSUE
}

template <int NI>
__device__ __forceinline__ void zero_acc8(f32x4 (&acc)[8][NI]) {
#pragma unroll
  for (int i = 0; i < 8; i++)
#pragma unroll
    for (int j = 0; j < NI; j++) acc[i][j] = f32x4{0.f, 0.f, 0.f, 0.f};
}


__device__ __forceinline__ bool map_tile(int i, int nblk, int MT, int NT, int& mt, int& nt) {
  const int locs = nblk >> 3;
  const int xcd = blockIdx.x & 7, loc = blockIdx.x >> 3;
  const int q = (i * 8 + xcd) * locs + loc;
  if (q >= MT * NT) return false;
  const int nfull = NT >> 3, per = MT * 8;
  if (q < nfull * per) {
    int pp = q / per, r = q - pp * per;
    mt = r >> 3;
    nt = pp * 8 + (r & 7);
  } else {
    int r = q - nfull * per;
    int w = NT - nfull * 8;
    mt = r / w;
    nt = nfull * 8 + (r - mt * w);
  }
  return true;
}

#define ACC_COORDS const int wr = wave >> 1, wc = wave & 1, fr = lane & 15, fq = lane >> 4;

__device__ __forceinline__ void conv_tile(const Params& p, int t, char* smem, const int tid) {
  int j = 0;
#pragma unroll 1
  for (int i = 1; i < 26; i++)
    if (t >= p.jobs[i].tile0) j = i;
  const Job& jb = p.jobs[j];
  float(*tile)[65] = (float(*)[65])smem;
  int local = t - jb.tile0;
  int nkt = jb.Kpad >> 6;
  int kt = local % nkt, nt = local / nkt;
  int tx = tid & 63, ty = tid >> 6;
  int n = nt * 64 + tx;
  int col;
  if (jb.mode == 0) col = jb.c0 + n;
  else { int jn = n >> 7, i = n & 127; col = (i < 64) ? (64 * jn + i) : (DFF_ + 64 * jn + (i - 64)); }
  const float* sp = jb.src + col;
  const int K = jb.K, ld = jb.ld;
  const bool nok = n < jb.Nv;
#pragma unroll
  for (int i = 0; i < 16; i++) {
    int k = kt * 64 + ty + 4 * i;
    tile[ty + 4 * i][tx] = (nok && k < K) ? sp[(size_t)k * ld] : 0.f;
  }
  __syncthreads();
#pragma unroll
  for (int i = 0; i < 16; i++) {
    int nn = nt * 64 + ty + 4 * i;
    int k = kt * 64 + tx;
    jb.dst[(size_t)nn * jb.Kpad + k] = f2bf(tile[tx][ty + 4 * i]);
  }
  __syncthreads();
}

__device__ __forceinline__ void ln_row(const float* __restrict__ src, const float* __restrict__ g,
                                       const float* __restrict__ b, float* __restrict__ dst, int lane, u16* __restrict__ dstb = nullptr) {
  float4 v[4];
  float s = 0.f;
#pragma unroll
  for (int i = 0; i < 4; i++) {
    v[i] = *(const float4*)(src + i * 256 + lane * 4);
    s += v[i].x + v[i].y + v[i].z + v[i].w;
  }
  float mean = wave_sum(s, lane) * (1.0f / 1024.0f);
  float q = 0.f;
#pragma unroll
  for (int i = 0; i < 4; i++) {
    float a = v[i].x - mean, b2 = v[i].y - mean, c = v[i].z - mean, d = v[i].w - mean;
    q += a * a + b2 * b2 + c * c + d * d;
  }
  float rstd = rsqrtf(wave_sum(q, lane) * (1.0f / 1024.0f) + 1e-5f);
#pragma unroll
  for (int i = 0; i < 4; i++) {
    float4 gg = *(const float4*)(g + i * 256 + lane * 4);
    float4 bb = *(const float4*)(b + i * 256 + lane * 4);
    float4 o;
    o.x = (v[i].x - mean) * rstd * gg.x + bb.x;
    o.y = (v[i].y - mean) * rstd * gg.y + bb.y;
    o.z = (v[i].z - mean) * rstd * gg.z + bb.z;
    o.w = (v[i].w - mean) * rstd * gg.w + bb.w;
    *(float4*)(dst + i * 256 + lane * 4) = o;
    if (dstb) *(uint2*)(dstb + i * 256 + lane * 4) = make_uint2(pk2(o.x, o.y), pk2(o.z, o.w));
  }
}

__device__ __forceinline__ void ln_row2(const float* __restrict__ srcA, const float* __restrict__ srcB, const float* __restrict__ g,
                                        const float* __restrict__ b, float* dstA, float* dstB, int lane, u16* dbA, u16* dbB) {
  float4 va[4], vb[4];
  float sa = 0.f, sb = 0.f;
#pragma unroll
  for (int i = 0; i < 4; i++) {
    va[i] = *(const float4*)(srcA + i * 256 + lane * 4);
    vb[i] = *(const float4*)(srcB + i * 256 + lane * 4);
  }
#pragma unroll
  for (int i = 0; i < 4; i++) {
    sa += va[i].x + va[i].y + va[i].z + va[i].w;
    sb += vb[i].x + vb[i].y + vb[i].z + vb[i].w;
  }
  const float ma = wave_sum(sa, lane) * (1.0f / 1024.0f), mb = wave_sum(sb, lane) * (1.0f / 1024.0f);
  float qa = 0.f, qb = 0.f;
#pragma unroll
  for (int i = 0; i < 4; i++) {
    va[i].x -= ma; va[i].y -= ma; va[i].z -= ma; va[i].w -= ma;
    vb[i].x -= mb; vb[i].y -= mb; vb[i].z -= mb; vb[i].w -= mb;
    qa += va[i].x * va[i].x + va[i].y * va[i].y + va[i].z * va[i].z + va[i].w * va[i].w;
    qb += vb[i].x * vb[i].x + vb[i].y * vb[i].y + vb[i].z * vb[i].z + vb[i].w * vb[i].w;
  }
  const float ra = rsqrtf(wave_sum(qa, lane) * (1.0f / 1024.0f) + 1e-5f), rb = rsqrtf(wave_sum(qb, lane) * (1.0f / 1024.0f) + 1e-5f);
#pragma unroll
  for (int i = 0; i < 4; i++) {
    float4 gg = *(const float4*)(g + i * 256 + lane * 4);
    float4 bb = *(const float4*)(b + i * 256 + lane * 4);
    float4 oa, ob;
    oa.x = va[i].x * ra * gg.x + bb.x; oa.y = va[i].y * ra * gg.y + bb.y; oa.z = va[i].z * ra * gg.z + bb.z; oa.w = va[i].w * ra * gg.w + bb.w;
    ob.x = vb[i].x * rb * gg.x + bb.x; ob.y = vb[i].y * rb * gg.y + bb.y; ob.z = vb[i].z * rb * gg.z + bb.z; ob.w = vb[i].w * rb * gg.w + bb.w;
    *(float4*)(dstA + i * 256 + lane * 4) = oa;
    *(float4*)(dstB + i * 256 + lane * 4) = ob;
    if (dbA) {
      *(uint2*)(dbA + i * 256 + lane * 4) = make_uint2(pk2(oa.x, oa.y), pk2(oa.z, oa.w));
      *(uint2*)(dbB + i * 256 + lane * 4) = make_uint2(pk2(ob.x, ob.y), pk2(ob.z, ob.w));
    }
  }
}

struct ScanIn {
  float kk[16][64], wr[16][64], w[16][64], kt[16][64], kka[16][64], v[16][64], g[16][64];
  float c[16][4];
};
struct ScanRaw { uint2 r, k, v, rp, kp, vp, a, g; float4 dec; };

__device__ __forceinline__ ScanRaw scan_fetch(const u16* __restrict__ P, const float* __restrict__ DEC,
                                              const u16* __restrict__ AA, const u16* __restrict__ GG, int rowbase, int t,
                                              int hc) {
  ScanRaw w;
  size_t row = (size_t)(rowbase + t);
  const u16* pp = P + row * PC_ + hc;
  w.r = *(const uint2*)(pp);
  w.k = *(const uint2*)(pp + 512);
  w.v = *(const uint2*)(pp + 1024);
  if (t > 0) {
    w.rp = *(const uint2*)(pp - PC_);
    w.kp = *(const uint2*)(pp - PC_ + 512);
    w.vp = *(const uint2*)(pp - PC_ + 1024);
  } else {
    w.rp = make_uint2(0, 0); w.kp = make_uint2(0, 0); w.vp = make_uint2(0, 0);
  }
  w.dec = *(const float4*)(DEC + row * 512 + hc);
  w.a = *(const uint2*)(AA + row * 512 + hc);
  w.g = *(const uint2*)(GG + row * 512 + hc);
  return w;
}

__device__ __forceinline__ void unpack4(uint2 u, float (&o)[4]) {
  o[0] = bflo(u.x); o[1] = bfhi(u.x); o[2] = bflo(u.y); o[3] = bfhi(u.y);
}

__device__ __forceinline__ void scan_unit(const Params& p, int l, int bh, char* smem, const int tid) {
  const int lane = tid & 63, wave = tid >> 6;
  const int b = bh >> 3, h = bh & 7;
  const int rowbase = b * T_;
  const u16* P = (const u16*)(p.ws + OFF_P);
  const float* DEC = (const float*)(p.ws + OFF_DEC);
  const u16* AA = (const u16*)(p.ws + OFF_AA);
  const u16* GG = (const u16*)(p.ws + OFF_GG);
  u16* YR = (u16*)(p.ws + OFF_AA);
  ScanIn* in = (ScanIn*)smem;
  float(*ybuf)[64] = (float(*)[64])(smem + 2 * sizeof(ScanIn));
  const int tl = tid >> 4, kq = tid & 15, hc = h * 64 + kq * 4;
  float(*cst)[64] = (float(*)[64])(smem + 2 * sizeof(ScanIn) + 16 * 64 * 4);
  if (tid < 64) {
    const float* mu = p.in[5] + (size_t)l * 1824;
    const int ch = h * 64 + tid;
    cst[0][tid] = mu[ch];
    cst[1][tid] = mu[512 + ch];
    cst[2][tid] = mu[1024 + ch];
    cst[3][tid] = p.in[11][l * 512 + ch];
    float ka_ = p.in[12][l * 512 + ch];
    cst[4][tid] = ka_;
    cst[5][tid] = 1.0f - ka_;
    cst[6][tid] = p.in[13][l * 512 + ch];
    cst[7][tid] = p.in[14][l * 512 + ch];
    cst[8][tid] = p.in[15][l * 512 + ch];
  }
  __syncthreads();
  const int rp = lane >> 3, ks = lane & 7, row0 = wave * 16 + rp * 2;
  typedef float f2s __attribute__((ext_vector_type(2)));
  f2s S2[2][4];
#pragma unroll
  for (int i = 0; i < 2; i++)
#pragma unroll
    for (int e = 0; e < 4; e++) S2[i][e] = f2s{0.f, 0.f};

  auto stage = [&](const ScanRaw& w, ScanIn& dst) {
    float r[4], k[4], v[4], rq[4], kp[4], vp[4], a[4], g[4];
    unpack4(w.r, r); unpack4(w.k, k); unpack4(w.v, v);
    unpack4(w.rp, rq); unpack4(w.kp, kp); unpack4(w.vp, vp);
    unpack4(w.a, a); unpack4(w.g, g);
    float dec[4] = {w.dec.x, w.dec.y, w.dec.z, w.dec.w};
    float mu_r[4], mu_k[4], mu_v[4], kkw[4], kaw[4], omk[4], rkw[4];
    *(float4*)mu_r = *(const float4*)&cst[0][kq * 4]; *(float4*)mu_k = *(const float4*)&cst[1][kq * 4];
    *(float4*)mu_v = *(const float4*)&cst[2][kq * 4]; *(float4*)kkw = *(const float4*)&cst[3][kq * 4];
    *(float4*)kaw = *(const float4*)&cst[4][kq * 4]; *(float4*)omk = *(const float4*)&cst[5][kq * 4];
    *(float4*)rkw = *(const float4*)&cst[6][kq * 4];
    float kkr[4], ss = 0.f;
#pragma unroll
    for (int e = 0; e < 4; e++) {
      r[e] = r[e] + (rq[e] - r[e]) * mu_r[e];
      k[e] = k[e] + (kp[e] - k[e]) * mu_k[e];
      v[e] = v[e] + (vp[e] - v[e]) * mu_v[e];
      kkr[e] = k[e] * kkw[e];
      ss += kkr[e] * kkr[e];
    }
    ss = sum16(ss);
    float inv = 1.0f / fmaxf(sqrtf(ss), 1e-12f);
    float c1 = 0.f, c2 = 0.f, c3 = 0.f;
    float kk[4], ktl[4], kka[4], wr[4];
#pragma unroll
    for (int e = 0; e < 4; e++) {
      kk[e] = kkr[e] * inv;
      ktl[e] = k[e] * fmaf(a[e], kaw[e], omk[e]);
      kka[e] = kk[e] * a[e];
      wr[e] = dec[e] * r[e];
      c1 += kka[e] * r[e];
      c2 += ktl[e] * r[e];
      c3 += r[e] * ktl[e] * rkw[e];
    }
    c1 = sum16(c1); c2 = sum16(c2); c3 = sum16(c3);
    *(float4*)&dst.kk[tl][kq * 4] = make_float4(kk[0], kk[1], kk[2], kk[3]);
    *(float4*)&dst.wr[tl][kq * 4] = make_float4(wr[0], wr[1], wr[2], wr[3]);
    *(float4*)&dst.w[tl][kq * 4] = make_float4(dec[0], dec[1], dec[2], dec[3]);
    *(float4*)&dst.kt[tl][kq * 4] = make_float4(ktl[0], ktl[1], ktl[2], ktl[3]);
    *(float4*)&dst.kka[tl][kq * 4] = make_float4(kka[0], kka[1], kka[2], kka[3]);
    *(float4*)&dst.v[tl][kq * 4] = make_float4(v[0], v[1], v[2], v[3]);
    *(float4*)&dst.g[tl][kq * 4] = make_float4(g[0], g[1], g[2], g[3]);
    if (kq == 0) *(float4*)&dst.c[tl][0] = make_float4(c1, c2, c3, 0.f);
  };

  {
    ScanRaw w0 = scan_fetch(P, DEC, AA, GG, rowbase, tl, hc);
    stage(w0, in[0]);
  }
  __syncthreads();
  constexpr int NCH = T_ / 16;
  for (int c = 0; c < NCH; c++) {
    ScanIn& cur = in[c & 1];
    ScanRaw nx;
    const bool have_next = (c + 1 < NCH);
    if (have_next) nx = scan_fetch(P, DEC, AA, GG, rowbase, (c + 1) * 16 + tl, hc);
    {
      typedef float f2 __attribute__((ext_vector_type(2)));
      struct StepA { float4 kk0, kk1, wr0, wr1; };
      struct StepIn { float4 kk0, kk1, wr0, wr1, w0, w1, kt0, kt1, ka0, ka1; float2 vv, cc; };
      auto ldA = [&](int s) {
        StepA r;
        r.kk0 = *(const float4*)&cur.kk[s][ks * 8]; r.kk1 = *(const float4*)&cur.kk[s][ks * 8 + 4];
        r.wr0 = *(const float4*)&cur.wr[s][ks * 8]; r.wr1 = *(const float4*)&cur.wr[s][ks * 8 + 4];
        return r;
      };
      StepA nxa = ldA(0);
#pragma unroll 1
      for (int s4 = 0; s4 < 16; s4 += 4) {
      float yv[4][2];
#pragma unroll
      for (int u = 0; u < 4; u++) {
        const int s = s4 + u;
        StepIn in_;
        in_.kk0 = nxa.kk0; in_.kk1 = nxa.kk1; in_.wr0 = nxa.wr0; in_.wr1 = nxa.wr1;
        in_.vv = *(const float2*)&cur.v[s][row0];
        in_.cc = *(const float2*)&cur.c[s][0];
        in_.w0 = *(const float4*)&cur.w[s][ks * 8];   in_.w1 = *(const float4*)&cur.w[s][ks * 8 + 4];
        in_.kt0 = *(const float4*)&cur.kt[s][ks * 8]; in_.kt1 = *(const float4*)&cur.kt[s][ks * 8 + 4];
        in_.ka0 = *(const float4*)&cur.kka[s][ks * 8]; in_.ka1 = *(const float4*)&cur.kka[s][ks * 8 + 4];
        nxa = ldA((s + 1) & 15);
        const f2 kk[4] = {{in_.kk0.x, in_.kk0.y}, {in_.kk0.z, in_.kk0.w}, {in_.kk1.x, in_.kk1.y}, {in_.kk1.z, in_.kk1.w}};
        const f2 wr[4] = {{in_.wr0.x, in_.wr0.y}, {in_.wr0.z, in_.wr0.w}, {in_.wr1.x, in_.wr1.y}, {in_.wr1.z, in_.wr1.w}};
        const f2 w[4] = {{in_.w0.x, in_.w0.y}, {in_.w0.z, in_.w0.w}, {in_.w1.x, in_.w1.y}, {in_.w1.z, in_.w1.w}};
        const f2 kt[4] = {{in_.kt0.x, in_.kt0.y}, {in_.kt0.z, in_.kt0.w}, {in_.kt1.x, in_.kt1.y}, {in_.kt1.z, in_.kt1.w}};
        const f2 ka[4] = {{in_.ka0.x, in_.ka0.y}, {in_.ka0.z, in_.ka0.w}, {in_.ka1.x, in_.ka1.y}, {in_.ka1.z, in_.ka1.w}};
        const float vr[2] = {in_.vv.x, in_.vv.y};
        float d1[2], d2[2];
#pragma unroll
        for (int i = 0; i < 2; i++) {
          f2 a = S2[i][0] * kk[0] + S2[i][1] * kk[1];
          f2 a2 = S2[i][2] * kk[2] + S2[i][3] * kk[3];
          f2 bq = S2[i][0] * wr[0] + S2[i][1] * wr[1];
          f2 b2 = S2[i][2] * wr[2] + S2[i][3] * wr[3];
          a += a2; bq += b2;
          d1[i] = a.x + a.y;
          d2[i] = bq.x + bq.y;
        }
        d1[0] = sum8(d1[0]); d1[1] = sum8(d1[1]); d2[0] = sum8(d2[0]); d2[1] = sum8(d2[1]);
#pragma unroll
        for (int i = 0; i < 2; i++) {
          const float skk = d1[i];
          yv[u][i] = d2[i] - skk * in_.cc.x + vr[i] * in_.cc.y;
          const f2 nsk = {-skk, -skk}, vv2 = {vr[i], vr[i]};
#pragma unroll
          for (int e = 0; e < 4; e++) S2[i][e] = S2[i][e] * w[e] + (nsk * ka[e] + vv2 * kt[e]);
        }
      }
      if (ks == 0) {
#pragma unroll
        for (int u = 0; u < 4; u++) *(float2*)&ybuf[s4 + u][row0] = make_float2(yv[u][0], yv[u][1]);
      }
      }
    }
    __syncthreads();
    {
      float4 y4 = *(const float4*)&ybuf[tl][kq * 4];
      float y[4] = {y4.x, y4.y, y4.z, y4.w};
      float mean = sum16(y[0] + y[1] + y[2] + y[3]) * (1.0f / 64.0f);
      float q = 0.f;
#pragma unroll
      for (int e = 0; e < 4; e++) { y[e] -= mean; q += y[e] * y[e]; }
      float rstd = rsqrtf(sum16(q) * (1.0f / 64.0f) + 64e-5f);
      float c3 = cur.c[tl][2];
      float4 v4 = *(const float4*)&cur.v[tl][kq * 4];
      float4 g4 = *(const float4*)&cur.g[tl][kq * 4];
      float vv[4] = {v4.x, v4.y, v4.z, v4.w};
      float gg[4] = {g4.x, g4.y, g4.z, g4.w};
      float o[4], lg[4], lb[4];
      *(float4*)lg = *(const float4*)&cst[7][kq * 4]; *(float4*)lb = *(const float4*)&cst[8][kq * 4];
#pragma unroll
      for (int e = 0; e < 4; e++) o[e] = (y[e] * rstd * lg[e] + lb[e] + c3 * vv[e]) * gg[e];
      size_t row = (size_t)(rowbase + c * 16 + tl);
      *(uint2*)(YR + row * 512 + hc) = make_uint2(pk2(o[0], o[1]), pk2(o[2], o[3]));
    }
    if (have_next) stage(nx, in[(c + 1) & 1]);
    __syncthreads();
  }
}

constexpr int KLD = 104, VLD = 72;
struct AttnSmem { u16 k[2][64 * KLD]; u16 v[2][64 * VLD]; };

__device__ __forceinline__ void attn_unit(const Params& p, int bh, int qi, char* smem, const int tid) {
  const int lane = tid & 63, wave = tid >> 6;
  const int fr = lane & 15, fq = lane >> 4;
  const int b = bh >> 3, h = bh & 7;
  const int rowbase = b * T_;
  u16* P = (u16*)(p.ws + OFF_P);
  const u16* Q = (const u16*)(p.ws + OFF_Q);
  const u16* KN = (const u16*)p.out;
  const u16* VT = (const u16*)p.out + (size_t)M_ * 512;
  const float2* ROPE = (const float2*)(p.ws + OFF_ROPE);
  AttnSmem* sm = (AttnSmem*)smem;
  const int qs = (qi == 0) ? 0 : 16 + (qi - 1) * 128;
  const int qn = (qi == 0) ? 16 : 128;
  const int q0 = qs + wave * 32;
  const bool wave_valid = (wave * 32 < qn);
  const int nkt = (qs + qn - 1) / 64 + 1;

  bf16x8 qf[2][3];
#pragma unroll
  for (int qb = 0; qb < 2; qb++) {
    int query = min(q0 + qb * 16 + fr, T_ - 1);
    const u16* qp = Q + (size_t)(rowbase + query) * 768 + h * 96;
    uint4 a0 = *(const uint4*)(qp + fq * 8);
    uint4 a1 = *(const uint4*)(qp + 32 + fq * 8);
    uint4 own = *(const uint4*)(qp + 64 + fq * 8);
    uint4 oth = *(const uint4*)(qp + 64 + (fq ^ 2) * 8);
    unsigned ow[4] = {own.x, own.y, own.z, own.w};
    unsigned tw[4] = {oth.x, oth.y, oth.z, oth.w};
    unsigned rw[4];
    const float2* rp = ROPE + (size_t)query * 16 + (fq & 1) * 8;
#pragma unroll
    for (int e = 0; e < 4; e++) {
      float2 cs0 = rp[2 * e], cs1 = rp[2 * e + 1];
      float o0 = bflo(ow[e]), o1 = bfhi(ow[e]);
      float t0 = bflo(tw[e]), t1 = bfhi(tw[e]);
      float r0, r1;
      if (fq < 2) { r0 = o0 * cs0.x - t0 * cs0.y; r1 = o1 * cs1.x - t1 * cs1.y; }
      else { r0 = t0 * cs0.y + o0 * cs0.x; r1 = t1 * cs1.y + o1 * cs1.x; }
      rw[e] = pk2(r0, r1);
    }
    uint4 a2 = make_uint4(rw[0], rw[1], rw[2], rw[3]);
    qf[qb][0] = *(bf16x8*)&a0;
    qf[qb][1] = *(bf16x8*)&a1;
    qf[qb][2] = *(bf16x8*)&a2;
  }

  f32x4 O[4][2];
#pragma unroll
  for (int i = 0; i < 4; i++)
#pragma unroll
    for (int j = 0; j < 2; j++) O[i][j] = f32x4{0.f, 0.f, 0.f, 0.f};
  float mrun[2] = {-1e30f, -1e30f}, lrun[2] = {0.f, 0.f};
  const float sc = 1.4426950408889634f / 9.797958971132712f;

  uint4 rk[3], rv[2];
  auto fetch_tile = [&](int kt) {
#pragma unroll
    for (int i = 0; i < 3; i++) {
      int c = tid + 256 * i;
      int key = c / 12, cc = c % 12;
      int t = kt * 64 + key;
      uint4 val = make_uint4(0, 0, 0, 0);
      if (t < T_) {
        size_t row = (size_t)(rowbase + t);
        if (cc < 8) val = *(const uint4*)(KN + row * 512 + h * 64 + cc * 8);
        else val = *(const uint4*)(P + row * PC_ + PKR_ + (cc - 8) * 8);
      }
      rk[i] = val;
    }
#pragma unroll
    for (int i = 0; i < 2; i++) {
      int c = tid + 256 * i;
      int dv = c >> 3, cc = c & 7;
      int t = kt * 64 + cc * 8;
      uint4 val = make_uint4(0, 0, 0, 0);
      if (t < T_) val = *(const uint4*)(VT + ((size_t)bh * 64 + dv) * T_ + t);
      rv[i] = val;
    }
  };
  auto store_tile = [&](int buf) {
#pragma unroll
    for (int i = 0; i < 3; i++) {
      int c = tid + 256 * i;
      int key = c / 12, cc = c % 12;
      *(uint4*)(&sm->k[buf][key * KLD + cc * 8]) = rk[i];
    }
#pragma unroll
    for (int i = 0; i < 2; i++) {
      int c = tid + 256 * i;
      int dv = c >> 3, cc = c & 7;
      *(uint4*)(&sm->v[buf][dv * VLD + cc * 8]) = rv[i];
    }
  };

  fetch_tile(0);
  for (int kt = 0; kt < nkt; kt++) {
    const int buf = kt & 1;
    store_tile(buf);
    __syncthreads();
    if (kt + 1 < nkt) fetch_tile(kt + 1);
    if (wave_valid && kt * 64 <= q0 + 31) {
      const u16* Ks = sm->k[buf];
      const u16* Vs = sm->v[buf];
      f32x4 s[4][2];
#pragma unroll
      for (int i = 0; i < 4; i++)
#pragma unroll
        for (int j = 0; j < 2; j++) s[i][j] = f32x4{0.f, 0.f, 0.f, 0.f};
#pragma unroll
      for (int ks = 0; ks < 3; ks++)
#pragma unroll
        for (int kb = 0; kb < 4; kb++) {
          bf16x8 kf = *(const bf16x8*)(Ks + (kb * 16 + fr) * KLD + ks * 32 + fq * 8);
#pragma unroll
          for (int qb = 0; qb < 2; qb++) s[kb][qb] = __builtin_amdgcn_mfma_f32_16x16x32_bf16(kf, qf[qb][ks], s[kb][qb], 0, 0, 0);
        }
      const bool need_mask = (kt * 64 + 63 > q0);
      unsigned pfw[2][2][4];
#pragma unroll
      for (int qb = 0; qb < 2; qb++) {
        const int query = q0 + qb * 16 + fr;
        float mx = -1e30f;
        if (need_mask) {
#pragma unroll
          for (int kb = 0; kb < 4; kb++)
#pragma unroll
            for (int j = 0; j < 4; j++) {
              int key = kt * 64 + kb * 16 + fq * 4 + j;
              if (key > query) s[kb][qb][j] = -1e30f;
            }
        }
#pragma unroll
        for (int kb = 0; kb < 4; kb++)
          mx = fmaxf(mx, fmaxf(fmaxf(s[kb][qb][0], s[kb][qb][1]), fmaxf(s[kb][qb][2], s[kb][qb][3])));
        mx = fmaxf(mx, shx(mx, lane, 16));
        mx = fmaxf(mx, shx(mx, lane, 32));
        const float mold = mrun[qb];
        const float mnew = fmaxf(mold, mx * sc);
        mrun[qb] = mnew;
        float ps = 0.f;
#pragma unroll
        for (int kb = 0; kb < 4; kb++) {
          float p0 = __builtin_amdgcn_exp2f(fmaf(s[kb][qb][0], sc, -mnew)), p1 = __builtin_amdgcn_exp2f(fmaf(s[kb][qb][1], sc, -mnew));
          float p2 = __builtin_amdgcn_exp2f(fmaf(s[kb][qb][2], sc, -mnew)), p3 = __builtin_amdgcn_exp2f(fmaf(s[kb][qb][3], sc, -mnew));
          ps += (p0 + p1) + (p2 + p3);
          pfw[qb][kb >> 1][(kb & 1) * 2 + 0] = pk2(p0, p1);
          pfw[qb][kb >> 1][(kb & 1) * 2 + 1] = pk2(p2, p3);
        }
        if (__builtin_amdgcn_ballot_w64(mnew != mold) != 0) {
          const float alpha = __builtin_amdgcn_exp2f(mold - mnew);
          lrun[qb] *= alpha;
#pragma unroll
          for (int dvb = 0; dvb < 4; dvb++) {
            O[dvb][qb][0] *= alpha; O[dvb][qb][1] *= alpha; O[dvb][qb][2] *= alpha; O[dvb][qb][3] *= alpha;
          }
        }
        lrun[qb] += ps;
      }
#pragma unroll
      for (int s2 = 0; s2 < 2; s2++)
#pragma unroll
        for (int dvb = 0; dvb < 4; dvb++) {
          const u16* vp = Vs + (dvb * 16 + fr) * VLD + s2 * 32 + fq * 4;
          uint2 v0 = *(const uint2*)vp;
          uint2 v1 = *(const uint2*)(vp + 16);
          uint4 vv = make_uint4(v0.x, v0.y, v1.x, v1.y);
          bf16x8 vf = *(bf16x8*)&vv;
#pragma unroll
          for (int qb = 0; qb < 2; qb++) {
            uint4 pw = make_uint4(pfw[qb][s2][0], pfw[qb][s2][1], pfw[qb][s2][2], pfw[qb][s2][3]);
            O[dvb][qb] = __builtin_amdgcn_mfma_f32_16x16x32_bf16(vf, *(bf16x8*)&pw, O[dvb][qb], 0, 0, 0);
          }
        }
    }
  }
  __syncthreads();
  if (wave_valid) {
#pragma unroll
    for (int qb = 0; qb < 2; qb++) {
      float l = lrun[qb];
      l += shx(l, lane, 16);
      l += shx(l, lane, 32);
      float inv = 1.0f / l;
      int query = q0 + qb * 16 + fr;
      if (query < qs + qn) {
        u16* op = P + (size_t)(rowbase + query) * PC_ + PMLA_ + h * 64 + fq * 4;
#pragma unroll
        for (int dvb = 0; dvb < 4; dvb++) {
          *(uint2*)(op + dvb * 16) =
              make_uint2(pk2(O[dvb][qb][0] * inv, O[dvb][qb][1] * inv), pk2(O[dvb][qb][2] * inv, O[dvb][qb][3] * inv));
        }
      }
    }
  }
}

#define XB_TMO      128
#define XB_XCNT(j)  (256  + 64 * (j))
#define XB_XSUB(j)  (1280 + 64 * (j))
#define XB_XGEN(j)  (2304 + 64 * (j))
#define XB_TOP      3328
#define XB_TOPGEN   3392
#define XCD_BAR_WORDS 3456
#define XB_SPIN_CAP (1u << 18)
#define LAS __attribute__((address_space(3)))

__device__ __forceinline__ unsigned xb_ld(unsigned* p)              { return __hip_atomic_load(p, __ATOMIC_RELAXED, __HIP_MEMORY_SCOPE_AGENT); }
__device__ __forceinline__ unsigned xb_add(unsigned* p, unsigned v) { return __hip_atomic_fetch_add(p, v, __ATOMIC_RELAXED, __HIP_MEMORY_SCOPE_AGENT); }
__device__ __forceinline__ unsigned xb_xcc_id() { return (unsigned)__builtin_amdgcn_s_getreg((3 << 11) | 20) & 0xFu; }
#define XB_SPIN(cond, bar) do { unsigned _sp = 0; while (cond) { __builtin_amdgcn_s_sleep(1); \
    if ((++_sp & 255u) == 0u) { if (xb_ld(&(bar)[XB_TMO])) break; if (_sp > XB_SPIN_CAP) { atomicAdd(&(bar)[XB_TMO], 1u); break; } } } } while (0)

struct XcdBarrier {
    unsigned* bar; unsigned x;
    volatile LAS unsigned* st;
};

__device__ __forceinline__ XcdBarrier xcd_barrier_post(unsigned* bar, volatile LAS unsigned* st) {
    XcdBarrier b; b.bar = bar; b.x = xb_xcc_id(); b.st = st;
    if (threadIdx.x == 0) (void)xb_add(&bar[XB_XCNT(b.x)], 1u);
    return b;
}
__device__ __forceinline__ void xcd_barrier_complete(unsigned* bar, unsigned x, unsigned& nloc, unsigned& nx) {
    const unsigned G = gridDim.x * gridDim.y * gridDim.z;
    unsigned sum, cnt, mine, sp = 0u;
    for (;;) {
        sum = 0u; cnt = 0u; mine = 0u;
#pragma unroll
        for (unsigned j = 0; j < 16; ++j) { const unsigned c = xb_ld(&bar[XB_XCNT(j)]); sum += c; cnt += (c > 0u) ? 1u : 0u; mine = (j == x) ? c : mine; }
        if (sum == G) break;
        __builtin_amdgcn_s_sleep(1);
        if ((++sp & 255u) == 0u) { if (xb_ld(&bar[XB_TMO])) break; if (sp > XB_SPIN_CAP) { atomicAdd(&bar[XB_TMO], 1u); break; } }
    }
    nloc = mine > 0u ? mine : 1u; nx = cnt > 0u ? cnt : 1u;
}

__device__ __forceinline__ void xcd_barrier(const XcdBarrier& b, const int tid_) {
    asm volatile("s_waitcnt vmcnt(0)" ::: "memory");
    __syncthreads();
    if (tid_ == 0) {
        unsigned* bar = b.bar;
        __builtin_amdgcn_s_waitcnt(0);
        unsigned nloc = b.st[0], nx = b.st[1];
        if (nloc == 0u) { xcd_barrier_complete(bar, b.x, nloc, nx); b.st[0] = nloc; b.st[1] = nx; }
        const unsigned old = xb_add(&bar[XB_XSUB(b.x)], 1u);
        const unsigned gen = old / nloc;
        if (old + 1u == (gen + 1u) * nloc) {
            __builtin_amdgcn_fence(__ATOMIC_RELEASE, "agent");
            asm volatile("s_waitcnt vmcnt(0)" ::: "memory");
            const unsigned og = xb_add(&bar[XB_TOP], 1u);
            const unsigned tg = og / nx;
            if (og + 1u == (tg + 1u) * nx) xb_add(&bar[XB_TOPGEN], 1u);
            else XB_SPIN(xb_ld(&bar[XB_TOPGEN]) == tg, bar);
            __builtin_amdgcn_fence(__ATOMIC_ACQUIRE, "agent");
            xb_add(&bar[XB_XGEN(b.x)], 1u);
            asm volatile("s_waitcnt vmcnt(0)" ::: "memory");
        } else {
            XB_SPIN(xb_ld(&bar[XB_XGEN(b.x)]) == gen, bar);
            __builtin_amdgcn_fence(__ATOMIC_ACQUIRE, "agent");
            asm volatile("s_waitcnt vmcnt(0)" ::: "memory");
        }
    }
    __syncthreads();
}


__global__ void __launch_bounds__(256, 2) mega(Params p) {
  cg::grid_group grid = cg::this_grid();
  __shared__ __attribute__((aligned(16))) char smem[SMEM_BYTES];
  __shared__ int s_unit;
  __shared__ uint4 xb_words;
  if (threadIdx.x == 0) xb_words = make_uint4(0u, 0u, 0u, 0u);
  __syncthreads();
  (void)xcd_barrier_post((unsigned*)(p.ws + OFF_BAR), (volatile LAS unsigned*)&xb_words);
#define XB_SYNC() do { XcdBarrier xb_; xb_.bar = (unsigned*)(p.ws + OFF_BAR); xb_.x = xb_xcc_id(); xb_.st = (volatile LAS unsigned*)&xb_words; xcd_barrier(xb_, wave0 * 64 + fresh_lane()); } while (0)
  int wave0 = __builtin_amdgcn_readfirstlane((int)(threadIdx.x >> 6));
  asm volatile("" : "+s"(wave0));
  const int nblk = gridDim.x;
  float* H = (float*)(p.ws + OFF_H);
  u16* P = (u16*)(p.ws + OFF_P);
  float* DEC = (float*)(p.ws + OFF_DEC);
  u16* AA = (u16*)(p.ws + OFF_AA);
  u16* GG = (u16*)(p.ws + OFF_GG);
  u16* Q = (u16*)(p.ws + OFF_Q);
  u16* MIX = (u16*)(p.ws + OFF_DEC);
  u16* HB1 = (u16*)p.out + (size_t)2 * M_ * 512;
  u16* HB2 = (u16*)(p.ws + OFF_HB2);
  u16* HBH = (u16*)(p.ws + OFF_AA);
  const u16* ZERO = (const u16*)(p.ws + OFF_ZERO);
  u16* ACT = (u16*)(p.ws + OFF_P);
  float2* ROPE = (float2*)(p.ws + OFF_ROPE);
  int* CTR = (int*)(p.ws + OFF_CTR);
  u16* KN = (u16*)p.out;
  u16* VT = KN + (size_t)M_ * 512;
  u16* YR = AA;

  {
  PHASE_TID
  for (int t = blockIdx.x; t < p.nconv; t += nblk) conv_tile(p, t, smem, tid);
  for (int i = blockIdx.x * 256 + tid; i < T_ * 16; i += nblk * 256) {
    int t = i >> 4, f = i & 15;
    double rev = (double)t * ROPE_C[f];
    rev -= floor(rev);
    float r = (float)rev;
    ROPE[i] = make_float2(__builtin_amdgcn_cosf(r), __builtin_amdgcn_sinf(r));
  }
  for (int row = (blockIdx.x * 4 + wave) * 2; row < M_; row += nblk * 8) {
    int b = row / T_, t = row % T_;
    const float* srcA = (t < NMETA_) ? (p.in[1] + (size_t)t * 1024) : (p.in[0] + ((size_t)b * SEQ_ + (t - NMETA_)) * 1024);
    u16* hb = (row < HB_SPLIT) ? HB1 + (size_t)row * 1024 : HB2 + (size_t)(row - HB_SPLIT) * 1024;
    ln_row2(srcA, srcA + 1024, p.in[2], p.in[3], H + (size_t)row * 1024, H + (size_t)(row + 1) * 1024, lane, hb, hb + 1024);
  }
  if (blockIdx.x == 0 && tid < 16) CTR[tid] = 0;
  if (blockIdx.x == 1) { for (int i = tid; i < 2048; i += 256) ((unsigned*)(p.ws + OFF_ZERO))[i] = 0u; }
  }
  grid.sync();

#pragma unroll 1
  for (int ph_ = 0; ph_ < 20; ph_++) {
    const int l = ph_ / 10, kph = ph_ - l * 10;
    const u16* WL = (const u16*)(p.ws + OFF_W) + (size_t)l * W_LAYER;
    if (kph == 0) {
    PHASE_TID
    for (int it_ = 0; it_ * nblk < 257 * 19; it_++) {
      int mt, nt;
      if (!map_tile(it_, nblk, 257, 19, mt, nt)) continue;
      f32x4 acc[8][4];
      zero_acc8(acc);
      ADma al = ADma{(mt < 255) ? HB1 : HB2, 1024, (mt < 255) ? mt * 256 : mt * 256 - HB_SPLIT, 0, ZERO, 0};
      gemm3(acc, al, WL + W_IN, 1024, nt * 128, 1024, smem, tid);
      ACC_COORDS
#pragma unroll
      for (int mi = 0; mi < 8; mi++)
#pragma unroll
        for (int ni = 0; ni < 4; ni++) {
          int col = nt * 128 + wc * 64 + ni * 16 + fq * 4;
          int row = mt * 256 + wr * 128 + mi * 16 + fr;
          if (col < PC_)
            *(uint2*)(P + (size_t)row * PC_ + col) = make_uint2(pk2(acc[mi][ni][0], acc[mi][ni][1]), pk2(acc[mi][ni][2], acc[mi][ni][3]));
        }
    }
    }
    if (kph == 1) {
    PHASE_TID
    {
      const float* qg = p.in[16] + l * 256;
      const float* kvg = p.in[18] + l * 256;
      for (int row = blockIdx.x * 4 + wave; row < M_; row += nblk * 4) {
        u16* pr = P + (size_t)row * PC_;
        uint2 cq = *(const uint2*)(pr + PMLA_ + lane * 4);
        uint2 ckv = *(const uint2*)(pr + PKV_ + lane * 4);
        float a[4], c[4];
        unpack4(cq, a);
        unpack4(ckv, c);
        float s1 = a[0] * a[0] + a[1] * a[1] + a[2] * a[2] + a[3] * a[3];
        float s2 = c[0] * c[0] + c[1] * c[1] + c[2] * c[2] + c[3] * c[3];
        s1 = wave_sum(s1, lane);
        s2 = wave_sum(s2, lane);
        float r1 = rsqrtf(s1 * (1.0f / 256.0f) + 1e-6f), r2 = rsqrtf(s2 * (1.0f / 256.0f) + 1e-6f);
        float4 g1 = *(const float4*)(qg + lane * 4), g2 = *(const float4*)(kvg + lane * 4);
        *(uint2*)(pr + PMLA_ + lane * 4) = make_uint2(pk2(a[0] * r1 * g1.x, a[1] * r1 * g1.y), pk2(a[2] * r1 * g1.z, a[3] * r1 * g1.w));
        *(uint2*)(pr + PKV_ + lane * 4) = make_uint2(pk2(c[0] * r2 * g2.x, c[1] * r2 * g2.y), pk2(c[2] * r2 * g2.z, c[3] * r2 * g2.w));
        if (lane < 16) {
          int t = row % T_;
          float x1 = bf2f(pr[PKR_ + lane]), x2 = bf2f(pr[PKR_ + 16 + lane]);
          float2 cs = ROPE[t * 16 + lane];
          pr[PKR_ + lane] = f2bf(x1 * cs.x - x2 * cs.y);
          pr[PKR_ + 16 + lane] = f2bf(x1 * cs.y + x2 * cs.x);
        }
      }
      const float* mu = p.in[5] + (size_t)l * 1824;
      for (int tile = blockIdx.x; tile < 514 * 12; tile += nblk) {
        int mt = tile / 12, sub = tile % 12, which = sub >> 2, nt = sub & 3;
        f32x4 acc[4][4];
        zero_acc(acc);
        ACC_COORDS
        if (which == 0) {
          AL<3> al{P + 1536, PC_, mt * 128, 0, 64, mu + 1536, 0};
          gemm_loop(acc, al, WL + W_LW, 64, nt * 128, 64, smem, tid);
          const float* w0 = p.in[6] + l * 512;
#pragma unroll
          for (int mi = 0; mi < 4; mi++)
#pragma unroll
            for (int ni = 0; ni < 4; ni++) {
              int col = nt * 128 + wc * 64 + ni * 16 + fr;
              float w0c = w0[col];
#pragma unroll
              for (int j = 0; j < 4; j++) {
                int row = mt * 128 + wr * 64 + mi * 16 + fq * 4 + j;
                float x = -(acc[mi][ni][j] + w0c);
                float sp = fmaxf(x, 0.f) + log1pf(__expf(-fabsf(x)));
                float wraw = -sp - 0.5f;
                DEC[(size_t)row * 512 + col] = __expf(-__expf(wraw));
              }
            }
        } else if (which == 1) {
          AL<3> al{P + 1600, PC_, mt * 128, 0, 64, mu + 1600, 1};
          gemm_loop(acc, al, WL + W_LA, 64, nt * 128, 64, smem, tid);
          const float* a0 = p.in[8] + l * 512;
#pragma unroll
          for (int mi = 0; mi < 4; mi++)
#pragma unroll
            for (int ni = 0; ni < 4; ni++) {
              int col = nt * 128 + wc * 64 + ni * 16 + fr;
              float a0c = a0[col];
#pragma unroll
              for (int j = 0; j < 4; j++) {
                int row = mt * 128 + wr * 64 + mi * 16 + fq * 4 + j;
                AA[(size_t)row * 512 + col] = f2bf(sigmoidf_(acc[mi][ni][j] + a0c));
              }
            }
        } else {
          AL<3> al{P + 1664, PC_, mt * 128, 0, 160, mu + 1664, 2};
          gemm_loop(acc, al, WL + W_LG, 192, nt * 128, 192, smem, tid);
#pragma unroll
          for (int mi = 0; mi < 4; mi++)
#pragma unroll
            for (int ni = 0; ni < 4; ni++) {
              int col = nt * 128 + wc * 64 + ni * 16 + fr;
#pragma unroll
              for (int j = 0; j < 4; j++) {
                int row = mt * 128 + wr * 64 + mi * 16 + fq * 4 + j;
                GG[(size_t)row * 512 + col] = f2bf(acc[mi][ni][j]);
              }
            }
        }
      }
    }
    }
    if (kph == 2) {
    PHASE_TID
    for (int it_ = 0; it_ * nblk < 257 * 14; it_++) {
      int mt, sub;
      if (!map_tile(it_, nblk, 257, 14, mt, sub)) continue;
      f32x4 acc[8][4];
      zero_acc8(acc);
      ACC_COORDS
      if (sub < 6) {
        ADma al{P + PMLA_, PC_, mt * 256, 0, ZERO, 0};
        gemm3(acc, al, WL + W_UQ, 256, sub * 128, 256, smem, tid);
#pragma unroll
        for (int mi = 0; mi < 8; mi++)
#pragma unroll
          for (int ni = 0; ni < 4; ni++) {
            int col = sub * 128 + wc * 64 + ni * 16 + fq * 4;
            int row = mt * 256 + wr * 128 + mi * 16 + fr;
            *(uint2*)(Q + (size_t)row * 768 + col) = make_uint2(pk2(acc[mi][ni][0], acc[mi][ni][1]), pk2(acc[mi][ni][2], acc[mi][ni][3]));
          }
      } else if (sub < 10) {
        int nt = sub - 6;
        ADma al{P + PKV_, PC_, mt * 256, 0, ZERO, 0};
        gemm3(acc, al, WL + W_UK, 256, nt * 128, 256, smem, tid);
#pragma unroll
        for (int mi = 0; mi < 8; mi++)
#pragma unroll
          for (int ni = 0; ni < 4; ni++) {
            int col = nt * 128 + wc * 64 + ni * 16 + fq * 4;
            int row = mt * 256 + wr * 128 + mi * 16 + fr;
            *(uint2*)(KN + (size_t)row * 512 + col) = make_uint2(pk2(acc[mi][ni][0], acc[mi][ni][1]), pk2(acc[mi][ni][2], acc[mi][ni][3]));
          }
      } else {
        int nt = sub - 10;
        ADma al{P + PKV_, PC_, mt * 256, 0, ZERO, 0};
        gemm3<4, false>(acc, al, WL + W_UV, 256, nt * 128, 256, smem, tid);
#pragma unroll
        for (int mi = 0; mi < 8; mi++)
#pragma unroll
          for (int ni = 0; ni < 4; ni++) {
            int col = nt * 128 + wc * 64 + ni * 16 + fr;
            int row = mt * 256 + wr * 128 + mi * 16 + fq * 4;
            int b = row / T_, t = row % T_;
            size_t o = ((size_t)(b * 512 + col)) * T_ + t;
            *(uint2*)(VT + o) = make_uint2(pk2(acc[mi][ni][0], acc[mi][ni][1]), pk2(acc[mi][ni][2], acc[mi][ni][3]));
          }
      }
    }
    }
    if (kph == 3) {
    PHASE_TID
    {
      const int xcd = blockIdx.x & 7, loc = blockIdx.x >> 3;
      const int total = 16 * 33;
      const bool scan_wg = (loc < 16), partner = (loc >= (nblk >> 4) && loc < (nblk >> 4) + 16);
      if (scan_wg) {
        scan_unit(p, l, xcd * 16 + loc, smem, launder(tid));
        __syncthreads();
      }
      if (!partner) {
        while (true) {
          if (tid == 0) s_unit = atomicAdd(&CTR[l * 8 + xcd], 1);
          __syncthreads();
          int v = s_unit;
          __syncthreads();
          if (v >= total) break;
          const int tidu = launder(tid);
          int g = v / 66, w = v - g * 66;
          attn_unit(p, xcd * 16 + g * 2 + (w & 1), 32 - (w >> 1), smem, tidu);
          __syncthreads();
        }
      }
    }
    }
    if (kph == 4) {
    PHASE_TID
    {
    u16* scr = (u16*)(p.ws + OFF_SCR) + (size_t)blockIdx.x * 32768;
    for (int it_ = 0; it_ * nblk < 256 * 8; it_++) {
      int mt, nt;
      if (!map_tile(it_, nblk, 256, 8, mt, nt)) continue;
      f32x4 acc[8][4];
      ADma alh = ADma{(mt < 255) ? HB1 : HB2, 1024, (mt < 255) ? mt * 256 : mt * 256 - HB_SPLIT, 0, ZERO, 0};
      zero_acc8(acc);
      gemm3(acc, alh, WL + W_G, 1024, nt * 128, 1024, smem, launder(tid));
      { const int tq_ = launder(tid); const int lane = tq_ & 63, wave = tq_ >> 6; ACC_COORDS
#pragma unroll
        for (int mi = 0; mi < 8; mi++)
#pragma unroll
          for (int ni = 0; ni < 4; ni++) {
            int col = nt * 128 + wc * 64 + ni * 16 + fq * 4;
            int row = mt * 256 + wr * 128 + mi * 16 + fr;
            *(uint2*)(MIX + (size_t)row * 1024 + col) = make_uint2(pk2(sigmoidf_(acc[mi][ni][0]), sigmoidf_(acc[mi][ni][1])),
                                                                   pk2(sigmoidf_(acc[mi][ni][2]), sigmoidf_(acc[mi][ni][3])));
          }
      }
      zero_acc8(acc);
      {
        ADma aly{YR, 512, mt * 256, 0, ZERO, 0};
        gemm3(acc, aly, WL + W_PR, 512, nt * 128, 512, smem, launder(tid));
      }
      { const int tq_ = launder(tid); const int lane = tq_ & 63, wave = tq_ >> 6; ACC_COORDS
#pragma unroll
        for (int mi = 0; mi < 8; mi++)
#pragma unroll
          for (int ni = 0; ni < 4; ni++) {
            int col = nt * 128 + wc * 64 + ni * 16 + fq * 4;
            int row = mt * 256 + wr * 128 + mi * 16 + fr;
            u16* mp = MIX + (size_t)row * 1024 + col;
            uint2 s = *(const uint2*)mp;
            *(uint2*)mp = make_uint2(pk2(bflo(s.x) * acc[mi][ni][0], bfhi(s.x) * acc[mi][ni][1]), pk2(bflo(s.y) * acc[mi][ni][2], bfhi(s.y) * acc[mi][ni][3]));
          }
      }
      zero_acc8(acc);
      gemm3(acc, alh, WL + W_G, 1024, 1024 + nt * 128, 1024, smem, launder(tid));
      { const int tq_ = launder(tid); const int lane = tq_ & 63, wave = tq_ >> 6; ACC_COORDS
#pragma unroll
        for (int mi = 0; mi < 8; mi++)
#pragma unroll
          for (int ni = 0; ni < 4; ni++) {
            int cl = wc * 64 + ni * 16 + fq * 4, rl = wr * 128 + mi * 16 + fr;
            *(uint2*)(scr + rl * 128 + cl) = make_uint2(pk2(sigmoidf_(acc[mi][ni][0]), sigmoidf_(acc[mi][ni][1])),
                                                        pk2(sigmoidf_(acc[mi][ni][2]), sigmoidf_(acc[mi][ni][3])));
          }
      }
      zero_acc8(acc);
      {
        ADma alm{P + PMLA_, PC_, mt * 256, 0, ZERO, 0};
        gemm3(acc, alm, WL + W_PM, 512, nt * 128, 512, smem, launder(tid));
      }
      { const int tq_ = launder(tid); const int lane = tq_ & 63, wave = tq_ >> 6; ACC_COORDS
#pragma unroll
        for (int mi = 0; mi < 8; mi++)
#pragma unroll
          for (int ni = 0; ni < 4; ni++) {
            int cl = wc * 64 + ni * 16 + fq * 4, rl = wr * 128 + mi * 16 + fr;
            u16* mp = MIX + (size_t)(mt * 256 + rl) * 1024 + nt * 128 + cl;
            uint2 t1 = *(const uint2*)mp;
            uint2 s = *(const uint2*)(scr + rl * 128 + cl);
            float o0 = bflo(t1.x) + bflo(s.x) * acc[mi][ni][0];
            float o1 = bfhi(t1.x) + bfhi(s.x) * acc[mi][ni][1];
            float o2 = bflo(t1.y) + bflo(s.y) * acc[mi][ni][2];
            float o3 = bfhi(t1.y) + bfhi(s.y) * acc[mi][ni][3];
            *(uint2*)mp = make_uint2(pk2(o0, o1), pk2(o2, o3));
          }
      }
    }
    }
    if (blockIdx.x < 16) {
      const int mt = 256, nt = blockIdx.x;
      f32x4 acc[8][2];
      unsigned sg[8][2][2];
      ADma alh = ADma{(mt < 255) ? HB1 : HB2, 1024, (mt < 255) ? mt * 256 : mt * 256 - HB_SPLIT, 0, ZERO, 0};
      zero_acc8(acc);
      const int tid1 = launder(tid);
      gemm3(acc, alh, WL + W_G, 1024, nt * 64, 1024, smem, tid1);
#pragma unroll
      for (int mi = 0; mi < 8; mi++)
#pragma unroll
        for (int ni = 0; ni < 2; ni++) {
          sg[mi][ni][0] = pk2(sigmoidf_(acc[mi][ni][0]), sigmoidf_(acc[mi][ni][1]));
          sg[mi][ni][1] = pk2(sigmoidf_(acc[mi][ni][2]), sigmoidf_(acc[mi][ni][3]));
        }
      zero_acc8(acc);
      {
        ADma aly{YR, 512, mt * 256, 0, ZERO, 0};
        const int tid2 = launder(tid);
      gemm3(acc, aly, WL + W_PR, 512, nt * 64, 512, smem, tid2);
      }
{ const int tidq = launder(tid); const int lane = tidq & 63, wave = tidq >> 6; ACC_COORDS
#pragma unroll
      for (int mi = 0; mi < 8; mi++)
#pragma unroll
        for (int ni = 0; ni < 2; ni++) {
          int col = nt * 64 + wc * 32 + ni * 16 + fq * 4;
          int row = mt * 256 + wr * 128 + mi * 16 + fr;
          *(uint2*)(MIX + (size_t)row * 1024 + col) = make_uint2(pk2(bflo(sg[mi][ni][0]) * acc[mi][ni][0], bfhi(sg[mi][ni][0]) * acc[mi][ni][1]),
                                                                 pk2(bflo(sg[mi][ni][1]) * acc[mi][ni][2], bfhi(sg[mi][ni][1]) * acc[mi][ni][3]));
        }
      }
      zero_acc8(acc);
      const int tid3 = launder(tid);
      gemm3(acc, alh, WL + W_G, 1024, 1024 + nt * 64, 1024, smem, tid3);
#pragma unroll
      for (int mi = 0; mi < 8; mi++)
#pragma unroll
        for (int ni = 0; ni < 2; ni++) {
          sg[mi][ni][0] = pk2(sigmoidf_(acc[mi][ni][0]), sigmoidf_(acc[mi][ni][1]));
          sg[mi][ni][1] = pk2(sigmoidf_(acc[mi][ni][2]), sigmoidf_(acc[mi][ni][3]));
        }
      zero_acc8(acc);
      {
        ADma alm{P + PMLA_, PC_, mt * 256, 0, ZERO, 0};
        const int tid4 = launder(tid);
      gemm3(acc, alm, WL + W_PM, 512, nt * 64, 512, smem, tid4);
      }
{ const int tidq = launder(tid); const int lane = tidq & 63, wave = tidq >> 6; ACC_COORDS
#pragma unroll
      for (int mi = 0; mi < 8; mi++)
#pragma unroll
        for (int ni = 0; ni < 2; ni++) {
          int col = nt * 64 + wc * 32 + ni * 16 + fq * 4;
          int row = mt * 256 + wr * 128 + mi * 16 + fr;
          uint2 pm = *(const uint2*)(MIX + (size_t)row * 1024 + col);
          float o0 = bflo(pm.x) + bflo(sg[mi][ni][0]) * acc[mi][ni][0];
          float o1 = bfhi(pm.x) + bfhi(sg[mi][ni][0]) * acc[mi][ni][1];
          float o2 = bflo(pm.y) + bflo(sg[mi][ni][1]) * acc[mi][ni][2];
          float o3 = bfhi(pm.y) + bfhi(sg[mi][ni][1]) * acc[mi][ni][3];
          *(uint2*)(MIX + (size_t)row * 1024 + col) = make_uint2(pk2(o0, o1), pk2(o2, o3));
        }
      }
    }
    }
    if (kph == 5) {
    PHASE_TID
    for (int prb_ = (PROBE_FI ? 0 : 1); prb_ < 2; prb_++)
    for (int it_ = 0; it_ * nblk < 256 * 8; it_++) {
      int mt, nt;
      if (!map_tile(it_, nblk, 256, 8, mt, nt)) continue;
      f32x4 acc[8][4];
      zero_acc8(acc);
      ACC_COORDS
      ADma al{MIX, 1024, mt * 256, 0, ZERO, 0};
      gemm3(acc, al, WL + W_OUT, 1024, nt * 128, 1024, smem, tid);
#pragma unroll
      for (int mi = 0; mi < 8; mi++)
#pragma unroll
        for (int ni = 0; ni < 4; ni++) {
          int col = nt * 128 + wc * 64 + ni * 16 + fq * 4;
          int row = mt * 256 + wr * 128 + mi * 16 + fr;
          float* hp = H + (size_t)row * 1024 + col;
          float* dp = (prb_ == 0) ? (p.out + (size_t)(row & 65535) * 1024 + col) : hp;
          float4 hv = *(const float4*)hp;
          hv.x = ALPHA_ * hv.x + acc[mi][ni][0];
          hv.y = ALPHA_ * hv.y + acc[mi][ni][1];
          hv.z = ALPHA_ * hv.z + acc[mi][ni][2];
          hv.w = ALPHA_ * hv.w + acc[mi][ni][3];
          *(float4*)dp = hv;
        }
    }
    if (blockIdx.x < 16) {
      const int mt = 256, n0 = blockIdx.x * 64;
      f32x4 acc[8][2];
      zero_acc8(acc);
      ADma al{MIX, 1024, mt * 256, 0, ZERO, 0};
      gemm3(acc, al, WL + W_OUT, 1024, n0, 1024, smem, launder(tid));
      const int tq_ = launder(tid);
      const int lane = tq_ & 63, wave = tq_ >> 6;
      ACC_COORDS
#pragma unroll
      for (int mi = 0; mi < 8; mi++)
#pragma unroll
        for (int ni = 0; ni < 2; ni++) {
          int col = n0 + wc * 32 + ni * 16 + fq * 4;
          int row = mt * 256 + wr * 128 + mi * 16 + fr;
          float* hp = H + (size_t)row * 1024 + col;
          float4 hv = *(const float4*)hp;
          hv.x = ALPHA_ * hv.x + acc[mi][ni][0];
          hv.y = ALPHA_ * hv.y + acc[mi][ni][1];
          hv.z = ALPHA_ * hv.z + acc[mi][ni][2];
          hv.w = ALPHA_ * hv.w + acc[mi][ni][3];
          *(float4*)hp = hv;
        }
    }
    }
    if (kph == 6) {
    PHASE_TID
    for (int row = (blockIdx.x * 4 + wave) * 2; row < M_; row += nblk * 8)
      ln_row2(H + (size_t)row * 1024, H + (size_t)(row + 1) * 1024, p.in[24] + l * 1024, p.in[25] + l * 1024, H + (size_t)row * 1024, H + (size_t)(row + 1) * 1024, lane, HBH + (size_t)row * 1024, HBH + (size_t)(row + 1) * 1024);
    }
    if (kph == 7) {
    PHASE_TID
    {
      const float* cw = p.in[27] + (size_t)l * 3 * 5632;
      const float* cb = p.in[28] + (size_t)l * 5632;
#if PROBE_HOT
      for (int it_ = 0; it_ * nblk < 272 * 44; it_++) {
        int rest, nt;
        if (!map_tile(it_, nblk, 272, 44, rest, nt)) continue;
        f32x4 acc[8][4];
        zero_acc8(acc);
#if PROBE_HOT == 1
        ADma al{HBH, 1024, 0, 0, ZERO, 1, p.ws};
        gemm3(acc, al, WL + W_UP, 1024, 0, 1024, smem, tid);
#else
        int it = rest % 17, b = rest / 17;
        ADma al{HBH, 1024, b * T_, 254 * it - 2, ZERO, 1, p.ws};
        gemm3(acc, al, WL + W_UP, 1024, nt * 128, 1024, smem, tid);
#endif
        float sacc = 0.f;
#pragma unroll
        for (int mi = 0; mi < 8; mi++)
#pragma unroll
          for (int ni = 0; ni < 4; ni++) sacc += acc[mi][ni][0] + acc[mi][ni][1] + acc[mi][ni][2] + acc[mi][ni][3];
        if (sacc == 12345.678f) ACT[tid] = 0;
      }
#endif
      for (int it_ = 0; it_ * nblk < 272 * 44; it_++) {
        int rest, nt;
        if (!map_tile(it_, nblk, 272, 44, rest, nt)) continue;
        int it = rest % 17, b = rest / 17;
        int t0 = 254 * it - 2;
        f32x4 acc[8][4];
        zero_acc8(acc);
        ADma al{HBH, 1024, b * T_, t0, ZERO, 1, p.ws};
        gemm3(acc, al, WL + W_UP, 1024, nt * 128, 1024, smem, launder(tid));
        ACC_COORDS
        float(*ut)[132] = (float(*)[132])smem;
        const int tidh = launder(tid);
        const int c = tidh & 63, rg = tidh >> 6;
        const int gcol = nt * 64 + c, vcol = DFF_ + nt * 64 + c;
        const float g0 = cw[gcol], g1 = cw[5632 + gcol], g2 = cw[2 * 5632 + gcol], gb = cb[gcol];
        const float v0 = cw[vcol], v1 = cw[5632 + vcol], v2 = cw[2 * 5632 + vcol], vb = cb[vcol];
#pragma unroll 1
        for (int half = 0; half < 2; half++) {
          float carry = 0.f;
          if (half == 1) carry = ut[126 + (tid >> 7)][tid & 127];
          __syncthreads();
          if (half == 1) ut[tid >> 7][tid & 127] = carry;
          if (wr == half) {
#pragma unroll
            for (int mi = 0; mi < 8; mi++)
#pragma unroll
              for (int ni = 0; ni < 4; ni++)
                *(float4*)&ut[half * 2 + mi * 16 + fr][wc * 64 + ni * 16 + fq * 4] = make_float4(acc[mi][ni][0], acc[mi][ni][1], acc[mi][ni][2], acc[mi][ni][3]);
          }
          __syncthreads();
          const int nq = half ? 130 : 128;
          int qs = 2 + rg * 32, qe = min(qs + 32, nq);
          float ga = ut[qs - 2][c], gbp = ut[qs - 1][c];
          float va = ut[qs - 2][64 + c], vbp = ut[qs - 1][64 + c];
          for (int q = qs; q < qe; q++) {
            float gc = ut[q][c], vc = ut[q][64 + c];
            int t = t0 + half * 126 + q;
            if (t < T_) {
              float gate = g0 * ga + g1 * gbp + g2 * gc + gb;
              float val = v0 * va + v1 * vbp + v2 * vc + vb;
              float av = gate * sigmoidf_(gate) * val;
              ACT[(size_t)(b * T_ + t) * DFF_ + gcol] = f2bf(av);
            }
            ga = gbp; gbp = gc; va = vbp; vbp = vc;
          }
        }
        __syncthreads();
      }
    }
    }
    if (kph == 8) {
    PHASE_TID
    for (int prb_ = (PROBE_FI ? 0 : 1); prb_ < 2; prb_++)
    for (int it_ = 0; it_ * nblk < 256 * 8; it_++) {
      int mt, nt;
      if (!map_tile(it_, nblk, 256, 8, mt, nt)) continue;
      f32x4 acc[8][4];
      zero_acc8(acc);
      ACC_COORDS
      ADma al{ACT, DFF_, mt * 256, 0, ZERO, 0};
      gemm3(acc, al, WL + W_DN, DFF_, nt * 128, DFF_, smem, tid);
#pragma unroll
      for (int mi = 0; mi < 8; mi++)
#pragma unroll
        for (int ni = 0; ni < 4; ni++) {
          int col = nt * 128 + wc * 64 + ni * 16 + fq * 4;
          int row = mt * 256 + wr * 128 + mi * 16 + fr;
          float* hp = H + (size_t)row * 1024 + col;
          float* dp = (prb_ == 0) ? (p.out + (size_t)(row & 65535) * 1024 + col) : hp;
          float4 hv = *(const float4*)hp;
          hv.x = ALPHA_ * hv.x + acc[mi][ni][0];
          hv.y = ALPHA_ * hv.y + acc[mi][ni][1];
          hv.z = ALPHA_ * hv.z + acc[mi][ni][2];
          hv.w = ALPHA_ * hv.w + acc[mi][ni][3];
          *(float4*)dp = hv;
        }
    }
    if (blockIdx.x < 16) {
      const int mt = 256, n0 = blockIdx.x * 64;
      f32x4 acc[8][2];
      zero_acc8(acc);
      ADma al{ACT, DFF_, mt * 256, 0, ZERO, 0};
      gemm3(acc, al, WL + W_DN, DFF_, n0, DFF_, smem, launder(tid));
      const int tq_ = launder(tid);
      const int lane = tq_ & 63, wave = tq_ >> 6;
      ACC_COORDS
#pragma unroll
      for (int mi = 0; mi < 8; mi++)
#pragma unroll
        for (int ni = 0; ni < 2; ni++) {
          int col = n0 + wc * 32 + ni * 16 + fq * 4;
          int row = mt * 256 + wr * 128 + mi * 16 + fr;
          float* hp = H + (size_t)row * 1024 + col;
          float4 hv = *(const float4*)hp;
          hv.x = ALPHA_ * hv.x + acc[mi][ni][0];
          hv.y = ALPHA_ * hv.y + acc[mi][ni][1];
          hv.z = ALPHA_ * hv.z + acc[mi][ni][2];
          hv.w = ALPHA_ * hv.w + acc[mi][ni][3];
          *(float4*)hp = hv;
        }
    }
    }
    if (kph == 9) {
    PHASE_TID
    if (l == 0) {
      for (int row = (blockIdx.x * 4 + wave) * 2; row < M_; row += nblk * 8) {
        u16* hb = (row < HB_SPLIT) ? HB1 + (size_t)row * 1024 : HB2 + (size_t)(row - HB_SPLIT) * 1024;
        ln_row2(H + (size_t)row * 1024, H + (size_t)(row + 1) * 1024, p.in[30], p.in[31], H + (size_t)row * 1024, H + (size_t)(row + 1) * 1024, lane, hb, hb + 1024);
      }
    } else {
      for (int row = (blockIdx.x * 4 + wave) * 2; row < M_; row += nblk * 8) {
        int b = row / T_, t = row % T_;
        if (t >= NMETA_) {
          float* o = p.out + ((size_t)b * SEQ_ + (t - NMETA_)) * 1024;
          ln_row2(H + (size_t)row * 1024, H + (size_t)(row + 1) * 1024, p.in[30] + 1024, p.in[31] + 1024, o, o + 1024, lane, nullptr, nullptr);
        }
      }
    }
    }
    if (ph_ != 19) XB_SYNC();
  }
}

extern "C" void kernel_launch(void* const* d_in, const int* in_sizes, int n_in, void* d_out, int out_size, void* d_ws,
                              size_t ws_size, hipStream_t stream) {
  static int grid_blocks = 0;
  if (!grid_blocks) {
    int dev = 0, cus = 0, per_cu = 0;
    hipGetDevice(&dev);
    hipDeviceGetAttribute(&cus, hipDeviceAttributeMultiprocessorCount, dev);
    hipOccupancyMaxActiveBlocksPerMultiprocessor(&per_cu, mega, 256, 0);
    if (per_cu > 2) per_cu = 2;
    grid_blocks = cus * per_cu;
  }
  if (ws_size < WS_TOTAL) fprintf(stderr, "workspace too small: %zu < %zu\n", ws_size, (size_t)WS_TOTAL);
  Params p;
  memset(&p, 0, sizeof(p));
  for (int i = 0; i < 32; i++) p.in[i] = (const float*)d_in[i];
  p.out = (float*)d_out;
  p.ws = (char*)d_ws;
  u16* wb = (u16*)((char*)d_ws + OFF_W);
  int nj = 0, tiles = 0;
  auto add = [&](const float* src, size_t dst_off, int ld, int c0, int K, int Kpad, int Nv, int Np, int mode) {
    Job& j = p.jobs[nj++];
    j.src = src; j.dst = wb + dst_off; j.ld = ld; j.c0 = c0; j.K = K; j.Kpad = Kpad; j.Nv = Nv; j.Np = Np; j.mode = mode;
    j.tile0 = tiles;
    tiles += (Kpad / 64) * (Np / 64);
  };
  for (int l = 0; l < 2; l++) {
    size_t o = (size_t)l * W_LAYER;
    const float* w_in = (const float*)d_in[4] + (size_t)l * 1024 * 4416;
    add(w_in, o + W_IN, 4416, 0, 1024, 1024, 2368, 2432, 0);
    add(w_in, o + W_G, 4416, 2368, 1024, 1024, 2048, 2048, 0);
    add((const float*)d_in[7] + (size_t)l * 64 * 512, o + W_LW, 512, 0, 64, 64, 512, 512, 0);
    add((const float*)d_in[9] + (size_t)l * 64 * 512, o + W_LA, 512, 0, 64, 64, 512, 512, 0);
    add((const float*)d_in[10] + (size_t)l * 160 * 512, o + W_LG, 512, 0, 160, 192, 512, 512, 0);
    add((const float*)d_in[17] + (size_t)l * 256 * 768, o + W_UQ, 768, 0, 256, 256, 768, 768, 0);
    add((const float*)d_in[19] + (size_t)l * 256 * 512, o + W_UK, 512, 0, 256, 256, 512, 512, 0);
    add((const float*)d_in[20] + (size_t)l * 256 * 512, o + W_UV, 512, 0, 256, 256, 512, 512, 0);
    add((const float*)d_in[21] + (size_t)l * 512 * 1024, o + W_PR, 1024, 0, 512, 512, 1024, 1024, 0);
    add((const float*)d_in[22] + (size_t)l * 512 * 1024, o + W_PM, 1024, 0, 512, 512, 1024, 1024, 0);
    add((const float*)d_in[23] + (size_t)l * 1024 * 1024, o + W_OUT, 1024, 0, 1024, 1024, 1024, 1024, 0);
    add((const float*)d_in[26] + (size_t)l * 1024 * 5632, o + W_UP, 5632, 0, 1024, 1024, 5632, 5632, 1);
    add((const float*)d_in[29] + (size_t)l * 2816 * 1024, o + W_DN, 1024, 0, 2816, 2816, 1024, 1024, 0);
  }
  p.nconv = tiles;
  hipMemsetAsync((char*)d_ws + OFF_BAR, 0, 16384, stream);
  void* args[] = {&p};
  hipError_t e = hipLaunchCooperativeKernel((void*)mega, dim3(grid_blocks), dim3(256), args, 0, stream);
  if (e != hipSuccess) fprintf(stderr, "cooperative launch failed: %s (grid %d)\n", hipGetErrorString(e), grid_blocks);
}
```

```cpp
#include <hip/hip_runtime.h>
#include <hip/hip_cooperative_groups.h>
#include <cstdio>
#include <cstring>
namespace cg = cooperative_groups;

#ifndef PHMASK
#define PHMASK 0xFFFF
#endif
#ifndef PROBE_HOT
#define PROBE_HOT 0
#endif
#ifndef PROBE_FI
#define PROBE_FI 0
#endif
#ifndef REPMASK
#define REPMASK 0
#endif
typedef unsigned short u16;
using bf16x8 = __attribute__((ext_vector_type(8))) short;
using f32x4 = __attribute__((ext_vector_type(4))) float;

constexpr int B_ = 16, SEQ_ = 4096, NMETA_ = 16, T_ = 4112, M_ = B_ * T_, D_ = 1024;
constexpr int PC_ = 2368;
constexpr int PMLA_ = 1824, PKV_ = 2080, PKR_ = 2336;
constexpr int DFF_ = 2816;
constexpr float ALPHA_ = 1.4142135623730951f;

constexpr size_t OFF_H = 0;
constexpr size_t OFF_P = OFF_H + (size_t)M_ * 1024 * 4;
constexpr size_t OFF_DEC = OFF_P + (size_t)M_ * PC_ * 2;
constexpr size_t OFF_AA = OFF_DEC + (size_t)M_ * 512 * 4;
constexpr size_t OFF_GG = OFF_AA + (size_t)M_ * 512 * 2;
constexpr size_t OFF_Q = OFF_GG + (size_t)M_ * 512 * 2;
constexpr size_t OFF_W = OFF_Q + (size_t)M_ * 768 * 2;
constexpr size_t W_IN = 0;
constexpr size_t W_G = W_IN + (size_t)2432 * 1024;
constexpr size_t W_LW = W_G + (size_t)2048 * 1024;
constexpr size_t W_LA = W_LW + (size_t)512 * 64;
constexpr size_t W_LG = W_LA + (size_t)512 * 64;
constexpr size_t W_UQ = W_LG + (size_t)512 * 192;
constexpr size_t W_UK = W_UQ + (size_t)768 * 256;
constexpr size_t W_UV = W_UK + (size_t)512 * 256;
constexpr size_t W_PR = W_UV + (size_t)512 * 256;
constexpr size_t W_PM = W_PR + (size_t)1024 * 512;
constexpr size_t W_OUT = W_PM + (size_t)1024 * 512;
constexpr size_t W_UP = W_OUT + (size_t)1024 * 1024;
constexpr size_t W_DN = W_UP + (size_t)5632 * 1024;
constexpr size_t W_LAYER = W_DN + (size_t)1024 * 2816;
constexpr size_t OFF_ROPE = OFF_W + 2 * W_LAYER * 2;
constexpr size_t OFF_CTR = OFF_ROPE + (size_t)T_ * 16 * 8;
constexpr size_t OFF_ZERO = OFF_CTR + 256;
constexpr size_t OFF_BAR = OFF_ZERO + 8192;
constexpr size_t OFF_HB2 = OFF_BAR + 16384;
constexpr size_t OFF_SCR = OFF_HB2 + (size_t)512 * 1024 * 2;
constexpr size_t WS_TOTAL = OFF_SCR + (size_t)1024 * 65536;
constexpr int HB_SPLIT = 65280;

struct Job { const float* src; u16* dst; int ld, c0, K, Kpad, Nv, Np, mode, tile0; };
struct Params {
  const float* in[32];
  float* out;
  char* ws;
  Job jobs[26];
  int nconv;
  int pad0;
};

__constant__ double ROPE_C[16] = {0.15915494309189535, 0.08949940160889101, 0.050329212104487035, 0.0283021958306234,
                                  0.015915494309189534, 0.008949940160889102, 0.005032921210448704, 0.00283021958306234,
                                  0.0015915494309189536, 0.0008949940160889102, 0.0005032921210448703, 0.00028302195830623395,
                                  0.00015915494309189535, 8.949940160889102e-05, 5.0329212104487035e-05, 2.8302195830623396e-05};

__device__ __forceinline__ int launder(int x) { asm volatile("" : "+v"(x)); return x; }
typedef __bf16 bf16x2_t __attribute__((ext_vector_type(2)));
typedef float f32x2_t __attribute__((ext_vector_type(2)));
__device__ __forceinline__ unsigned pk2(float a, float b) {
  f32x2_t v = {a, b};
  bf16x2_t r = __builtin_convertvector(v, bf16x2_t);
  return *(unsigned*)&r;
}
__device__ __forceinline__ u16 f2bf(float f) { return (u16)(pk2(f, 0.f) & 0xffffu); }
__device__ __forceinline__ float bf2f(unsigned h) { return __uint_as_float(h << 16); }
__device__ __forceinline__ float bflo(unsigned w) { return __uint_as_float(w << 16); }
__device__ __forceinline__ float bfhi(unsigned w) { return __uint_as_float(w & 0xffff0000u); }
__device__ __forceinline__ float sigmoidf_(float x) { return 1.0f / (1.0f + __expf(-x)); }

__device__ __forceinline__ int fresh_lane() { int x; asm volatile("v_mbcnt_lo_u32_b32 %0, -1, 0\n\tv_mbcnt_hi_u32_b32 %0, -1, %0" : "=v"(x)); return x; }
#define PHASE_TID const int tid = wave0 * 64 + fresh_lane(); const int lane = tid & 63, wave = tid >> 6; (void)lane; (void)wave;
template <int CTRL>
__device__ __forceinline__ float dppf(float x) {
  return __int_as_float(__builtin_amdgcn_update_dpp(0, __float_as_int(x), CTRL, 0xF, 0xF, true));
}
__device__ __forceinline__ float sum8(float x) {
  x += dppf<0xB1>(x);
  x += dppf<0x4E>(x);
  x += dppf<0x141>(x);
  return x;
}
__device__ __forceinline__ float sum16(float x) {
  x = sum8(x);
  x += dppf<0x140>(x);
  return x;
}
__device__ __forceinline__ float shx(float x, int lane, int o) {
  return __int_as_float(__builtin_amdgcn_ds_bpermute((lane ^ o) << 2, __float_as_int(x)));
}
__device__ __forceinline__ float wave_sum(float x, int lane) {
  x = sum16(x);
  x += shx(x, lane, 16);
  x += shx(x, lane, 32);
  return x;
}

constexpr int BM = 128, BN = 128, BK = 64, LDT = 64;
constexpr int SMEM_BYTES = 73728;

template <int MODE>
struct AL {
  const void* base;
  int ld;
  int row0;
  int t0;
  int kvalid;
  const float* mu;
  int fn;
  struct Raw { uint4 x, y; };
  __device__ __forceinline__ Raw fetch(int r, int k) const {
    Raw w;
    { unsigned z = (MODE == 3) ? (unsigned)launder(0) : 0u; w.x = make_uint4(z, z, z, z); w.y = w.x; }
    if (MODE == 0) {
      const float* p = (const float*)base + (size_t)(row0 + r) * ld + k;
      w.x = *(const uint4*)p;
      w.y = *(const uint4*)(p + 4);
    } else if (MODE == 1) {
      const u16* p = (const u16*)base + (size_t)(row0 + r) * ld + k;
      w.x = *(const uint4*)p;
    } else if (MODE == 4) {
      const float* p = (const float*)base + (size_t)(row0 + r) * ld + k;
      float4 a = *(const float4*)p, b = *(const float4*)(p + 4);
      w.x = make_uint4(pk2(a.x, a.y), pk2(a.z, a.w), pk2(b.x, b.y), pk2(b.z, b.w));
    } else if (MODE == 2) {
      int t = t0 + r;
      if (t >= 0 && t < T_) {
        const float* p = (const float*)base + (size_t)(row0 + t) * ld + k;
        w.x = *(const uint4*)p;
        w.y = *(const uint4*)(p + 4);
      }
    } else {
      int row = row0 + r;
      int t = row % T_;
      if (k < kvalid) {
        const u16* p = (const u16*)base + (size_t)row * ld + k;
        w.x = *(const uint4*)p;
        if (t > 0) w.y = *(const uint4*)(p - ld);
      }
    }
    return w;
  }
  __device__ __forceinline__ uint4 cvt(const Raw& w, int k) const {
    if (MODE == 0 || MODE == 2) {
      uint4 o;
      o.x = pk2(__uint_as_float(w.x.x), __uint_as_float(w.x.y));
      o.y = pk2(__uint_as_float(w.x.z), __uint_as_float(w.x.w));
      o.z = pk2(__uint_as_float(w.y.x), __uint_as_float(w.y.y));
      o.w = pk2(__uint_as_float(w.y.z), __uint_as_float(w.y.w));
      return o;
    } else if (MODE == 1 || MODE == 4) {
      return w.x;
    } else {
      if (k >= kvalid) { unsigned z = (unsigned)launder(0); return make_uint4(z, z, z, z); }
      unsigned cw[4] = {w.x.x, w.x.y, w.x.z, w.x.w};
      unsigned pw[4] = {w.y.x, w.y.y, w.y.z, w.y.w};
      unsigned ow[4];
#pragma unroll
      for (int e = 0; e < 4; e++) {
        float x0 = bflo(cw[e]), x1 = bfhi(cw[e]);
        float p0 = bflo(pw[e]), p1 = bfhi(pw[e]);
        float v0 = x0 + (p0 - x0) * mu[k + 2 * e];
        float v1 = x1 + (p1 - x1) * mu[k + 2 * e + 1];
        if (fn == 0) {
          v0 = 1.0f - 2.0f / (__expf(2.0f * v0) + 1.0f);
          v1 = 1.0f - 2.0f / (__expf(2.0f * v1) + 1.0f);
        } else if (fn == 2) {
          v0 = sigmoidf_(v0);
          v1 = sigmoidf_(v1);
        }
        ow[e] = pk2(v0, v1);
      }
      return make_uint4(ow[0], ow[1], ow[2], ow[3]);
    }
  }
};

template <int NI>
__device__ __forceinline__ void zero_acc(f32x4 (&acc)[4][NI]) {
#pragma unroll
  for (int i = 0; i < 4; i++)
#pragma unroll
    for (int j = 0; j < NI; j++) acc[i][j] = f32x4{0.f, 0.f, 0.f, 0.f};
}

#define REP4(X) X(0) X(1) X(2) X(3)
template <class ALT, int NI>
__device__ __forceinline__ void gemm_loop(f32x4 (&acc)[4][NI], const ALT& al, const u16* __restrict__ Bt, int ldb, int n0,
                                          int K, char* smem, const int tid) {
  const int lane = tid & 63, wave = tid >> 6;
  const int wr = wave >> 1, wc = wave & 1, fr = lane & 15, fq = lane >> 4;
  const int lr = tid >> 3, lk = (tid & 7) * 8, lsw = ((tid & 7) ^ (lr & 7)) * 8;
  u16* sa = (u16*)smem;
  u16* sb = sa + 2 * BM * LDT;
  typename ALT::Raw ra0, ra1, ra2, ra3;
  uint4 rb0 = make_uint4(0,0,0,0), rb1 = rb0, rb2 = rb0, rb3 = rb0;
  const u16* bp = Bt + (size_t)(n0 + lr) * ldb + lk;
#define GL_FETCH(i) ra##i = al.fetch(lr + 32 * i, kf); if (i < NI) rb##i = *(const uint4*)(bp + (size_t)(32 * i) * ldb + kb);
#define GL_STORE(i) *(uint4*)(a_ + (lr + 32 * i) * LDT + lsw) = al.cvt(ra##i, kt * BK + lk); if (i < NI) *(uint4*)(b_ + (lr + 32 * i) * LDT + lsw) = rb##i;
  {
    const int kf = lk, kb = 0;
    REP4(GL_FETCH)
  }
  const int nk = K / BK;
  for (int kt = 0; kt < nk; kt++) {
    u16* a_ = sa + (kt & 1) * BM * LDT;
    u16* b_ = sb + (kt & 1) * BN * LDT;
    REP4(GL_STORE)
    __syncthreads();
    if (kt + 1 < nk) {
      const int kf = (kt + 1) * BK + lk, kb = (kt + 1) * BK;
      REP4(GL_FETCH)
    }
#pragma unroll
    for (int ks = 0; ks < 2; ks++) {
      bf16x8 af[4], bf[NI];
#pragma unroll
      for (int i = 0; i < 4; i++) af[i] = *(const bf16x8*)(a_ + (wr * 64 + i * 16 + fr) * LDT + (((ks * 4 + fq) ^ (fr & 7)) * 8));
#pragma unroll
      for (int i = 0; i < NI; i++) bf[i] = *(const bf16x8*)(b_ + (wc * (NI * 16) + i * 16 + fr) * LDT + (((ks * 4 + fq) ^ (fr & 7)) * 8));
#pragma unroll
      for (int mi = 0; mi < 4; mi++)
#pragma unroll
        for (int ni = 0; ni < NI; ni++)
          acc[mi][ni] = __builtin_amdgcn_mfma_f32_16x16x32_bf16(af[mi], bf[ni], acc[mi][ni], 0, 0, 0);
    }
  }
  __syncthreads();
#undef GL_FETCH
#undef GL_STORE
}


struct ADma { const u16* base; int ld; int row0; int t0; const u16* zero; int mode; const char* wsb; };
constexpr int G3_STAGE = 12288;

template <int NI, bool SWAP = true>
__device__ __forceinline__ void gemm3(f32x4 (&acc)[8][NI], const ADma& a, const u16* __restrict__ Bt, int ldb, int n0, int K,
                                      char* smem, const int tid) {
  const int lane = tid & 63, wave = tid >> 6;
  const int wr = wave >> 1, wc = wave & 1, fr = lane & 15, fq = lane >> 4;
  const int kc8 = ((lane & 3) ^ ((4 - (lane >> 4)) & 3)) * 8;
  const int psw = (fq ^ ((4 - (fr >> 2)) & 3)) * 8;
  u16* sm = (u16*)smem;
  const u16* ap0 = nullptr;
  unsigned ao0 = 0, ao1 = 0, ao2 = 0, ao3 = 0;
  if (a.mode == 0) {
    ap0 = a.base + (size_t)(a.row0 + wave * 64 + (lane >> 2)) * a.ld + kc8;
  } else {
    const unsigned bo = (unsigned)((const char*)a.base - a.wsb), zo = (unsigned)((const char*)a.zero - a.wsb) + kc8 * 2;
#define G3_AP(j)                                                                          \
    {                                                                                     \
      int t = a.t0 + wave * 64 + j * 16 + (lane >> 2);                                    \
      ao##j = (t >= 0 && t < T_) ? bo + (unsigned)(((a.row0 + t) * a.ld + kc8) * 2) : zo; \
    }
    REP4(G3_AP)
#undef G3_AP
  }
  const u16* bp0 = Bt + (size_t)(n0 + wave * (8 * NI) + (lane >> 2)) * ldb + kc8;
  const size_t astep = (size_t)16 * a.ld;
  const size_t bstep = (size_t)16 * ldb;
#define G3_ISSUE(j)                                                                                                              \
  __builtin_amdgcn_global_load_lds((a.mode == 0) ? (const unsigned*)(ap0 + j * astep + kof) : (const unsigned*)(a.wsb + ao##j + kof * 2), (unsigned*)(st_ + (wave * 64 + j * 16) * 32 + lane * 8), 16, 0, 0); \
  if (2 * j < NI) __builtin_amdgcn_global_load_lds((const unsigned*)(bp0 + j * bstep + kof), (unsigned*)(st_ + 8192 + (wave * (8 * NI) + j * 16) * 32 + lane * 8), 16, 0, 0);
  const int nk = K / 32;
  asm volatile("s_waitcnt vmcnt(0)" ::: "memory");
  {
    const int kof = 0;
    u16* st_ = sm;
    REP4(G3_ISSUE)
  }
  if (nk > 1) {
    const int kof = 32;
    u16* st_ = sm + G3_STAGE;
    REP4(G3_ISSUE)
  }
  int cur = 0, nxt = 2;
  const unsigned lds0 = (unsigned)(size_t)(__attribute__((address_space(3))) char*)smem;
  const unsigned aoff = lds0 + (unsigned)(((wr * 128 + fr) * 32 + psw) * 2);
  const unsigned boff = lds0 + 16384u + (unsigned)(((wc * (NI * 16) + fr) * 32 + psw) * 2);
#define G3_DSR(dst, addr, off) asm volatile("ds_read_b128 %0, %1 offset:" #off : "=v"(dst) : "v"(addr))
  for (int kt = 0; kt < nk; kt++) {
    if (kt + 1 < nk) {
      if (NI == 4) asm volatile("s_waitcnt vmcnt(6)" ::: "memory");
      else asm volatile("s_waitcnt vmcnt(5)" ::: "memory");
    } else {
      asm volatile("s_waitcnt vmcnt(0)" ::: "memory");
    }
    __builtin_amdgcn_s_barrier();
    if (kt + 2 < nk) {
      const int kof = (kt + 2) * 32;
      u16* st_ = sm + nxt * G3_STAGE;
      REP4(G3_ISSUE)
    }
    const unsigned aaddr = aoff + (unsigned)cur * (G3_STAGE * 2);
    const unsigned baddr = boff + (unsigned)cur * (G3_STAGE * 2);
    bf16x8 af[8], bf[NI];
    G3_DSR(af[0], aaddr, 0); G3_DSR(af[1], aaddr, 1024); G3_DSR(af[2], aaddr, 2048); G3_DSR(af[3], aaddr, 3072);
    G3_DSR(bf[0], baddr, 0); G3_DSR(bf[1], baddr, 1024);
    if (NI == 4) { G3_DSR(bf[NI - 2], baddr, 2048); G3_DSR(bf[NI - 1], baddr, 3072); }
    G3_DSR(af[4], aaddr, 4096); G3_DSR(af[5], aaddr, 5120); G3_DSR(af[6], aaddr, 6144); G3_DSR(af[7], aaddr, 7168);
    if (NI == 4) {
      asm volatile("s_waitcnt lgkmcnt(4)"
                   : "+v"(af[0]), "+v"(af[1]), "+v"(af[2]), "+v"(af[3]), "+v"(bf[0]), "+v"(bf[1]), "+v"(bf[NI - 2]), "+v"(bf[NI - 1]));
    } else {
      asm volatile("s_waitcnt lgkmcnt(4)" : "+v"(af[0]), "+v"(af[1]), "+v"(af[2]), "+v"(af[3]), "+v"(bf[0]), "+v"(bf[1]));
    }
#pragma unroll
    for (int mi = 0; mi < 4; mi++)
#pragma unroll
      for (int ni = 0; ni < NI; ni++)
        acc[mi][ni] = SWAP ? __builtin_amdgcn_mfma_f32_16x16x32_bf16(bf[ni], af[mi], acc[mi][ni], 0, 0, 0)
                           : __builtin_amdgcn_mfma_f32_16x16x32_bf16(af[mi], bf[ni], acc[mi][ni], 0, 0, 0);
    asm volatile("s_waitcnt lgkmcnt(0)" : "+v"(af[4]), "+v"(af[5]), "+v"(af[6]), "+v"(af[7]));
#pragma unroll
    for (int mi = 4; mi < 8; mi++)
#pragma unroll
      for (int ni = 0; ni < NI; ni++)
        acc[mi][ni] = SWAP ? __builtin_amdgcn_mfma_f32_16x16x32_bf16(bf[ni], af[mi], acc[mi][ni], 0, 0, 0)
                           : __builtin_amdgcn_mfma_f32_16x16x32_bf16(af[mi], bf[ni], acc[mi][ni], 0, 0, 0);
    cur = (cur == 2) ? 0 : cur + 1;
    nxt = (nxt == 2) ? 0 : nxt + 1;
  }
  asm volatile("s_waitcnt lgkmcnt(0)" ::: "memory");
  __syncthreads();
#undef G3_DSR
#undef G3_ISSUE
}

template <int NI>
__device__ __forceinline__ void zero_acc8(f32x4 (&acc)[8][NI]) {
#pragma unroll
  for (int i = 0; i < 8; i++)
#pragma unroll
    for (int j = 0; j < NI; j++) acc[i][j] = f32x4{0.f, 0.f, 0.f, 0.f};
}


__device__ __forceinline__ bool map_tile(int i, int nblk, int MT, int NT, int& mt, int& nt) {
  const int locs = nblk >> 3;
  const int xcd = blockIdx.x & 7, loc = blockIdx.x >> 3;
  const int q = (i * 8 + xcd) * locs + loc;
  if (q >= MT * NT) return false;
  const int nfull = NT >> 3, per = MT * 8;
  if (q < nfull * per) {
    int pp = q / per, r = q - pp * per;
    mt = r >> 3;
    nt = pp * 8 + (r & 7);
  } else {
    int r = q - nfull * per;
    int w = NT - nfull * 8;
    mt = r / w;
    nt = nfull * 8 + (r - mt * w);
  }
  return true;
}

#define ACC_COORDS const int wr = wave >> 1, wc = wave & 1, fr = lane & 15, fq = lane >> 4;

__device__ __forceinline__ void conv_tile(const Params& p, int t, char* smem, const int tid) {
  int j = 0;
#pragma unroll 1
  for (int i = 1; i < 26; i++)
    if (t >= p.jobs[i].tile0) j = i;
  const Job& jb = p.jobs[j];
  float(*tile)[65] = (float(*)[65])smem;
  int local = t - jb.tile0;
  int nkt = jb.Kpad >> 6;
  int kt = local % nkt, nt = local / nkt;
  int tx = tid & 63, ty = tid >> 6;
  int n = nt * 64 + tx;
  int col;
  if (jb.mode == 0) col = jb.c0 + n;
  else { int jn = n >> 7, i = n & 127; col = (i < 64) ? (64 * jn + i) : (DFF_ + 64 * jn + (i - 64)); }
  const float* sp = jb.src + col;
  const int K = jb.K, ld = jb.ld;
  const bool nok = n < jb.Nv;
#pragma unroll
  for (int i = 0; i < 16; i++) {
    int k = kt * 64 + ty + 4 * i;
    tile[ty + 4 * i][tx] = (nok && k < K) ? sp[(size_t)k * ld] : 0.f;
  }
  __syncthreads();
#pragma unroll
  for (int i = 0; i < 16; i++) {
    int nn = nt * 64 + ty + 4 * i;
    int k = kt * 64 + tx;
    jb.dst[(size_t)nn * jb.Kpad + k] = f2bf(tile[tx][ty + 4 * i]);
  }
  __syncthreads();
}

__device__ __forceinline__ void ln_row(const float* __restrict__ src, const float* __restrict__ g,
                                       const float* __restrict__ b, float* __restrict__ dst, int lane, u16* __restrict__ dstb = nullptr) {
  float4 v[4];
  float s = 0.f;
#pragma unroll
  for (int i = 0; i < 4; i++) {
    v[i] = *(const float4*)(src + i * 256 + lane * 4);
    s += v[i].x + v[i].y + v[i].z + v[i].w;
  }
  float mean = wave_sum(s, lane) * (1.0f / 1024.0f);
  float q = 0.f;
#pragma unroll
  for (int i = 0; i < 4; i++) {
    float a = v[i].x - mean, b2 = v[i].y - mean, c = v[i].z - mean, d = v[i].w - mean;
    q += a * a + b2 * b2 + c * c + d * d;
  }
  float rstd = rsqrtf(wave_sum(q, lane) * (1.0f / 1024.0f) + 1e-5f);
#pragma unroll
  for (int i = 0; i < 4; i++) {
    float4 gg = *(const float4*)(g + i * 256 + lane * 4);
    float4 bb = *(const float4*)(b + i * 256 + lane * 4);
    float4 o;
    o.x = (v[i].x - mean) * rstd * gg.x + bb.x;
    o.y = (v[i].y - mean) * rstd * gg.y + bb.y;
    o.z = (v[i].z - mean) * rstd * gg.z + bb.z;
    o.w = (v[i].w - mean) * rstd * gg.w + bb.w;
    *(float4*)(dst + i * 256 + lane * 4) = o;
    if (dstb) *(uint2*)(dstb + i * 256 + lane * 4) = make_uint2(pk2(o.x, o.y), pk2(o.z, o.w));
  }
}

__device__ __forceinline__ void ln_row2(const float* __restrict__ srcA, const float* __restrict__ srcB, const float* __restrict__ g,
                                        const float* __restrict__ b, float* dstA, float* dstB, int lane, u16* dbA, u16* dbB) {
  float4 va[4], vb[4];
  float sa = 0.f, sb = 0.f;
#pragma unroll
  for (int i = 0; i < 4; i++) {
    va[i] = *(const float4*)(srcA + i * 256 + lane * 4);
    vb[i] = *(const float4*)(srcB + i * 256 + lane * 4);
  }
#pragma unroll
  for (int i = 0; i < 4; i++) {
    sa += va[i].x + va[i].y + va[i].z + va[i].w;
    sb += vb[i].x + vb[i].y + vb[i].z + vb[i].w;
  }
  const float ma = wave_sum(sa, lane) * (1.0f / 1024.0f), mb = wave_sum(sb, lane) * (1.0f / 1024.0f);
  float qa = 0.f, qb = 0.f;
#pragma unroll
  for (int i = 0; i < 4; i++) {
    va[i].x -= ma; va[i].y -= ma; va[i].z -= ma; va[i].w -= ma;
    vb[i].x -= mb; vb[i].y -= mb; vb[i].z -= mb; vb[i].w -= mb;
    qa += va[i].x * va[i].x + va[i].y * va[i].y + va[i].z * va[i].z + va[i].w * va[i].w;
    qb += vb[i].x * vb[i].x + vb[i].y * vb[i].y + vb[i].z * vb[i].z + vb[i].w * vb[i].w;
  }
  const float ra = rsqrtf(wave_sum(qa, lane) * (1.0f / 1024.0f) + 1e-5f), rb = rsqrtf(wave_sum(qb, lane) * (1.0f / 1024.0f) + 1e-5f);
#pragma unroll
  for (int i = 0; i < 4; i++) {
    float4 gg = *(const float4*)(g + i * 256 + lane * 4);
    float4 bb = *(const float4*)(b + i * 256 + lane * 4);
    float4 oa, ob;
    oa.x = va[i].x * ra * gg.x + bb.x; oa.y = va[i].y * ra * gg.y + bb.y; oa.z = va[i].z * ra * gg.z + bb.z; oa.w = va[i].w * ra * gg.w + bb.w;
    ob.x = vb[i].x * rb * gg.x + bb.x; ob.y = vb[i].y * rb * gg.y + bb.y; ob.z = vb[i].z * rb * gg.z + bb.z; ob.w = vb[i].w * rb * gg.w + bb.w;
    *(float4*)(dstA + i * 256 + lane * 4) = oa;
    *(float4*)(dstB + i * 256 + lane * 4) = ob;
    if (dbA) {
      *(uint2*)(dbA + i * 256 + lane * 4) = make_uint2(pk2(oa.x, oa.y), pk2(oa.z, oa.w));
      *(uint2*)(dbB + i * 256 + lane * 4) = make_uint2(pk2(ob.x, ob.y), pk2(ob.z, ob.w));
    }
  }
}

struct ScanIn {
  float kk[16][64], wr[16][64], w[16][64], kt[16][64], kka[16][64], v[16][64], g[16][64];
  float c[16][4];
};
struct ScanRaw { uint2 r, k, v, rp, kp, vp, a, g; float4 dec; };

__device__ __forceinline__ ScanRaw scan_fetch(const u16* __restrict__ P, const float* __restrict__ DEC,
                                              const u16* __restrict__ AA, const u16* __restrict__ GG, int rowbase, int t,
                                              int hc) {
  ScanRaw w;
  size_t row = (size_t)(rowbase + t);
  const u16* pp = P + row * PC_ + hc;
  w.r = *(const uint2*)(pp);
  w.k = *(const uint2*)(pp + 512);
  w.v = *(const uint2*)(pp + 1024);
  if (t > 0) {
    w.rp = *(const uint2*)(pp - PC_);
    w.kp = *(const uint2*)(pp - PC_ + 512);
    w.vp = *(const uint2*)(pp - PC_ + 1024);
  } else {
    w.rp = make_uint2(0, 0); w.kp = make_uint2(0, 0); w.vp = make_uint2(0, 0);
  }
  w.dec = *(const float4*)(DEC + row * 512 + hc);
  w.a = *(const uint2*)(AA + row * 512 + hc);
  w.g = *(const uint2*)(GG + row * 512 + hc);
  return w;
}

__device__ __forceinline__ void unpack4(uint2 u, float (&o)[4]) {
  o[0] = bflo(u.x); o[1] = bfhi(u.x); o[2] = bflo(u.y); o[3] = bfhi(u.y);
}

__device__ __forceinline__ void scan_unit(const Params& p, int l, int bh, char* smem, const int tid) {
  const int lane = tid & 63, wave = tid >> 6;
  const int b = bh >> 3, h = bh & 7;
  const int rowbase = b * T_;
  const u16* P = (const u16*)(p.ws + OFF_P);
  const float* DEC = (const float*)(p.ws + OFF_DEC);
  const u16* AA = (const u16*)(p.ws + OFF_AA);
  const u16* GG = (const u16*)(p.ws + OFF_GG);
  u16* YR = (u16*)(p.ws + OFF_AA);
  ScanIn* in = (ScanIn*)smem;
  float(*ybuf)[64] = (float(*)[64])(smem + 2 * sizeof(ScanIn));
  const int tl = tid >> 4, kq = tid & 15, hc = h * 64 + kq * 4;
  float(*cst)[64] = (float(*)[64])(smem + 2 * sizeof(ScanIn) + 16 * 64 * 4);
  if (tid < 64) {
    const float* mu = p.in[5] + (size_t)l * 1824;
    const int ch = h * 64 + tid;
    cst[0][tid] = mu[ch];
    cst[1][tid] = mu[512 + ch];
    cst[2][tid] = mu[1024 + ch];
    cst[3][tid] = p.in[11][l * 512 + ch];
    float ka_ = p.in[12][l * 512 + ch];
    cst[4][tid] = ka_;
    cst[5][tid] = 1.0f - ka_;
    cst[6][tid] = p.in[13][l * 512 + ch];
    cst[7][tid] = p.in[14][l * 512 + ch];
    cst[8][tid] = p.in[15][l * 512 + ch];
  }
  __syncthreads();
  const int rp = lane >> 3, ks = lane & 7, row0 = wave * 16 + rp * 2;
  typedef float f2s __attribute__((ext_vector_type(2)));
  f2s S2[2][4];
#pragma unroll
  for (int i = 0; i < 2; i++)
#pragma unroll
    for (int e = 0; e < 4; e++) S2[i][e] = f2s{0.f, 0.f};

  auto stage = [&](const ScanRaw& w, ScanIn& dst) {
    float r[4], k[4], v[4], rq[4], kp[4], vp[4], a[4], g[4];
    unpack4(w.r, r); unpack4(w.k, k); unpack4(w.v, v);
    unpack4(w.rp, rq); unpack4(w.kp, kp); unpack4(w.vp, vp);
    unpack4(w.a, a); unpack4(w.g, g);
    float dec[4] = {w.dec.x, w.dec.y, w.dec.z, w.dec.w};
    float mu_r[4], mu_k[4], mu_v[4], kkw[4], kaw[4], omk[4], rkw[4];
    *(float4*)mu_r = *(const float4*)&cst[0][kq * 4]; *(float4*)mu_k = *(const float4*)&cst[1][kq * 4];
    *(float4*)mu_v = *(const float4*)&cst[2][kq * 4]; *(float4*)kkw = *(const float4*)&cst[3][kq * 4];
    *(float4*)kaw = *(const float4*)&cst[4][kq * 4]; *(float4*)omk = *(const float4*)&cst[5][kq * 4];
    *(float4*)rkw = *(const float4*)&cst[6][kq * 4];
    float kkr[4], ss = 0.f;
#pragma unroll
    for (int e = 0; e < 4; e++) {
      r[e] = r[e] + (rq[e] - r[e]) * mu_r[e];
      k[e] = k[e] + (kp[e] - k[e]) * mu_k[e];
      v[e] = v[e] + (vp[e] - v[e]) * mu_v[e];
      kkr[e] = k[e] * kkw[e];
      ss += kkr[e] * kkr[e];
    }
    ss = sum16(ss);
    float inv = 1.0f / fmaxf(sqrtf(ss), 1e-12f);
    float c1 = 0.f, c2 = 0.f, c3 = 0.f;
    float kk[4], ktl[4], kka[4], wr[4];
#pragma unroll
    for (int e = 0; e < 4; e++) {
      kk[e] = kkr[e] * inv;
      ktl[e] = k[e] * fmaf(a[e], kaw[e], omk[e]);
      kka[e] = kk[e] * a[e];
      wr[e] = dec[e] * r[e];
      c1 += kka[e] * r[e];
      c2 += ktl[e] * r[e];
      c3 += r[e] * ktl[e] * rkw[e];
    }
    c1 = sum16(c1); c2 = sum16(c2); c3 = sum16(c3);
    *(float4*)&dst.kk[tl][kq * 4] = make_float4(kk[0], kk[1], kk[2], kk[3]);
    *(float4*)&dst.wr[tl][kq * 4] = make_float4(wr[0], wr[1], wr[2], wr[3]);
    *(float4*)&dst.w[tl][kq * 4] = make_float4(dec[0], dec[1], dec[2], dec[3]);
    *(float4*)&dst.kt[tl][kq * 4] = make_float4(ktl[0], ktl[1], ktl[2], ktl[3]);
    *(float4*)&dst.kka[tl][kq * 4] = make_float4(kka[0], kka[1], kka[2], kka[3]);
    *(float4*)&dst.v[tl][kq * 4] = make_float4(v[0], v[1], v[2], v[3]);
    *(float4*)&dst.g[tl][kq * 4] = make_float4(g[0], g[1], g[2], g[3]);
    if (kq == 0) *(float4*)&dst.c[tl][0] = make_float4(c1, c2, c3, 0.f);
  };

  {
    ScanRaw w0 = scan_fetch(P, DEC, AA, GG, rowbase, tl, hc);
    stage(w0, in[0]);
  }
  __syncthreads();
  constexpr int NCH = T_ / 16;
  for (int c = 0; c < NCH; c++) {
    ScanIn& cur = in[c & 1];
    ScanRaw nx;
    const bool have_next = (c + 1 < NCH);
    if (have_next) nx = scan_fetch(P, DEC, AA, GG, rowbase, (c + 1) * 16 + tl, hc);
    {
      typedef float f2 __attribute__((ext_vector_type(2)));
      struct StepA { float4 kk0, kk1, wr0, wr1; };
      struct StepIn { float4 kk0, kk1, wr0, wr1, w0, w1, kt0, kt1, ka0, ka1; float2 vv, cc; };
      auto ldA = [&](int s) {
        StepA r;
        r.kk0 = *(const float4*)&cur.kk[s][ks * 8]; r.kk1 = *(const float4*)&cur.kk[s][ks * 8 + 4];
        r.wr0 = *(const float4*)&cur.wr[s][ks * 8]; r.wr1 = *(const float4*)&cur.wr[s][ks * 8 + 4];
        return r;
      };
      StepA nxa = ldA(0);
#pragma unroll 1
      for (int s4 = 0; s4 < 16; s4 += 4) {
      float yv[4][2];
#pragma unroll
      for (int u = 0; u < 4; u++) {
        const int s = s4 + u;
        StepIn in_;
        in_.kk0 = nxa.kk0; in_.kk1 = nxa.kk1; in_.wr0 = nxa.wr0; in_.wr1 = nxa.wr1;
        in_.vv = *(const float2*)&cur.v[s][row0];
        in_.cc = *(const float2*)&cur.c[s][0];
        in_.w0 = *(const float4*)&cur.w[s][ks * 8];   in_.w1 = *(const float4*)&cur.w[s][ks * 8 + 4];
        in_.kt0 = *(const float4*)&cur.kt[s][ks * 8]; in_.kt1 = *(const float4*)&cur.kt[s][ks * 8 + 4];
        in_.ka0 = *(const float4*)&cur.kka[s][ks * 8]; in_.ka1 = *(const float4*)&cur.kka[s][ks * 8 + 4];
        nxa = ldA((s + 1) & 15);
        const f2 kk[4] = {{in_.kk0.x, in_.kk0.y}, {in_.kk0.z, in_.kk0.w}, {in_.kk1.x, in_.kk1.y}, {in_.kk1.z, in_.kk1.w}};
        const f2 wr[4] = {{in_.wr0.x, in_.wr0.y}, {in_.wr0.z, in_.wr0.w}, {in_.wr1.x, in_.wr1.y}, {in_.wr1.z, in_.wr1.w}};
        const f2 w[4] = {{in_.w0.x, in_.w0.y}, {in_.w0.z, in_.w0.w}, {in_.w1.x, in_.w1.y}, {in_.w1.z, in_.w1.w}};
        const f2 kt[4] = {{in_.kt0.x, in_.kt0.y}, {in_.kt0.z, in_.kt0.w}, {in_.kt1.x, in_.kt1.y}, {in_.kt1.z, in_.kt1.w}};
        const f2 ka[4] = {{in_.ka0.x, in_.ka0.y}, {in_.ka0.z, in_.ka0.w}, {in_.ka1.x, in_.ka1.y}, {in_.ka1.z, in_.ka1.w}};
        const float vr[2] = {in_.vv.x, in_.vv.y};
        float d1[2], d2[2];
#pragma unroll
        for (int i = 0; i < 2; i++) {
          f2 a = S2[i][0] * kk[0] + S2[i][1] * kk[1];
          f2 a2 = S2[i][2] * kk[2] + S2[i][3] * kk[3];
          f2 bq = S2[i][0] * wr[0] + S2[i][1] * wr[1];
          f2 b2 = S2[i][2] * wr[2] + S2[i][3] * wr[3];
          a += a2; bq += b2;
          d1[i] = a.x + a.y;
          d2[i] = bq.x + bq.y;
        }
        d1[0] = sum8(d1[0]); d1[1] = sum8(d1[1]); d2[0] = sum8(d2[0]); d2[1] = sum8(d2[1]);
#pragma unroll
        for (int i = 0; i < 2; i++) {
          const float skk = d1[i];
          yv[u][i] = d2[i] - skk * in_.cc.x + vr[i] * in_.cc.y;
          const f2 nsk = {-skk, -skk}, vv2 = {vr[i], vr[i]};
#pragma unroll
          for (int e = 0; e < 4; e++) S2[i][e] = S2[i][e] * w[e] + (nsk * ka[e] + vv2 * kt[e]);
        }
      }
      if (ks == 0) {
#pragma unroll
        for (int u = 0; u < 4; u++) *(float2*)&ybuf[s4 + u][row0] = make_float2(yv[u][0], yv[u][1]);
      }
      }
    }
    __syncthreads();
    {
      float4 y4 = *(const float4*)&ybuf[tl][kq * 4];
      float y[4] = {y4.x, y4.y, y4.z, y4.w};
      float mean = sum16(y[0] + y[1] + y[2] + y[3]) * (1.0f / 64.0f);
      float q = 0.f;
#pragma unroll
      for (int e = 0; e < 4; e++) { y[e] -= mean; q += y[e] * y[e]; }
      float rstd = rsqrtf(sum16(q) * (1.0f / 64.0f) + 64e-5f);
      float c3 = cur.c[tl][2];
      float4 v4 = *(const float4*)&cur.v[tl][kq * 4];
      float4 g4 = *(const float4*)&cur.g[tl][kq * 4];
      float vv[4] = {v4.x, v4.y, v4.z, v4.w};
      float gg[4] = {g4.x, g4.y, g4.z, g4.w};
      float o[4], lg[4], lb[4];
      *(float4*)lg = *(const float4*)&cst[7][kq * 4]; *(float4*)lb = *(const float4*)&cst[8][kq * 4];
#pragma unroll
      for (int e = 0; e < 4; e++) o[e] = (y[e] * rstd * lg[e] + lb[e] + c3 * vv[e]) * gg[e];
      size_t row = (size_t)(rowbase + c * 16 + tl);
      *(uint2*)(YR + row * 512 + hc) = make_uint2(pk2(o[0], o[1]), pk2(o[2], o[3]));
    }
    if (have_next) stage(nx, in[(c + 1) & 1]);
    __syncthreads();
  }
}

constexpr int KLD = 104, VLD = 72;
struct AttnSmem { u16 k[2][64 * KLD]; u16 v[2][64 * VLD]; };

__device__ __forceinline__ void attn_unit(const Params& p, int bh, int qi, char* smem, const int tid) {
  const int lane = tid & 63, wave = tid >> 6;
  const int fr = lane & 15, fq = lane >> 4;
  const int b = bh >> 3, h = bh & 7;
  const int rowbase = b * T_;
  u16* P = (u16*)(p.ws + OFF_P);
  const u16* Q = (const u16*)(p.ws + OFF_Q);
  const u16* KN = (const u16*)p.out;
  const u16* VT = (const u16*)p.out + (size_t)M_ * 512;
  const float2* ROPE = (const float2*)(p.ws + OFF_ROPE);
  AttnSmem* sm = (AttnSmem*)smem;
  const int qs = (qi == 0) ? 0 : 16 + (qi - 1) * 128;
  const int qn = (qi == 0) ? 16 : 128;
  const int q0 = qs + wave * 32;
  const bool wave_valid = (wave * 32 < qn);
  const int nkt = (qs + qn - 1) / 64 + 1;

  bf16x8 qf[2][3];
#pragma unroll
  for (int qb = 0; qb < 2; qb++) {
    int query = min(q0 + qb * 16 + fr, T_ - 1);
    const u16* qp = Q + (size_t)(rowbase + query) * 768 + h * 96;
    uint4 a0 = *(const uint4*)(qp + fq * 8);
    uint4 a1 = *(const uint4*)(qp + 32 + fq * 8);
    uint4 own = *(const uint4*)(qp + 64 + fq * 8);
    uint4 oth = *(const uint4*)(qp + 64 + (fq ^ 2) * 8);
    unsigned ow[4] = {own.x, own.y, own.z, own.w};
    unsigned tw[4] = {oth.x, oth.y, oth.z, oth.w};
    unsigned rw[4];
    const float2* rp = ROPE + (size_t)query * 16 + (fq & 1) * 8;
#pragma unroll
    for (int e = 0; e < 4; e++) {
      float2 cs0 = rp[2 * e], cs1 = rp[2 * e + 1];
      float o0 = bflo(ow[e]), o1 = bfhi(ow[e]);
      float t0 = bflo(tw[e]), t1 = bfhi(tw[e]);
      float r0, r1;
      if (fq < 2) { r0 = o0 * cs0.x - t0 * cs0.y; r1 = o1 * cs1.x - t1 * cs1.y; }
      else { r0 = t0 * cs0.y + o0 * cs0.x; r1 = t1 * cs1.y + o1 * cs1.x; }
      rw[e] = pk2(r0, r1);
    }
    uint4 a2 = make_uint4(rw[0], rw[1], rw[2], rw[3]);
    qf[qb][0] = *(bf16x8*)&a0;
    qf[qb][1] = *(bf16x8*)&a1;
    qf[qb][2] = *(bf16x8*)&a2;
  }

  f32x4 O[4][2];
#pragma unroll
  for (int i = 0; i < 4; i++)
#pragma unroll
    for (int j = 0; j < 2; j++) O[i][j] = f32x4{0.f, 0.f, 0.f, 0.f};
  float mrun[2] = {-1e30f, -1e30f}, lrun[2] = {0.f, 0.f};
  const float sc = 1.4426950408889634f / 9.797958971132712f;

  uint4 rk[3], rv[2];
  auto fetch_tile = [&](int kt) {
#pragma unroll
    for (int i = 0; i < 3; i++) {
      int c = tid + 256 * i;
      int key = c / 12, cc = c % 12;
      int t = kt * 64 + key;
      uint4 val = make_uint4(0, 0, 0, 0);
      if (t < T_) {
        size_t row = (size_t)(rowbase + t);
        if (cc < 8) val = *(const uint4*)(KN + row * 512 + h * 64 + cc * 8);
        else val = *(const uint4*)(P + row * PC_ + PKR_ + (cc - 8) * 8);
      }
      rk[i] = val;
    }
#pragma unroll
    for (int i = 0; i < 2; i++) {
      int c = tid + 256 * i;
      int dv = c >> 3, cc = c & 7;
      int t = kt * 64 + cc * 8;
      uint4 val = make_uint4(0, 0, 0, 0);
      if (t < T_) val = *(const uint4*)(VT + ((size_t)bh * 64 + dv) * T_ + t);
      rv[i] = val;
    }
  };
  auto store_tile = [&](int buf) {
#pragma unroll
    for (int i = 0; i < 3; i++) {
      int c = tid + 256 * i;
      int key = c / 12, cc = c % 12;
      *(uint4*)(&sm->k[buf][key * KLD + cc * 8]) = rk[i];
    }
#pragma unroll
    for (int i = 0; i < 2; i++) {
      int c = tid + 256 * i;
      int dv = c >> 3, cc = c & 7;
      *(uint4*)(&sm->v[buf][dv * VLD + cc * 8]) = rv[i];
    }
  };

  fetch_tile(0);
  for (int kt = 0; kt < nkt; kt++) {
    const int buf = kt & 1;
    store_tile(buf);
    __syncthreads();
    if (kt + 1 < nkt) fetch_tile(kt + 1);
    if (wave_valid && kt * 64 <= q0 + 31) {
      const u16* Ks = sm->k[buf];
      const u16* Vs = sm->v[buf];
      f32x4 s[4][2];
#pragma unroll
      for (int i = 0; i < 4; i++)
#pragma unroll
        for (int j = 0; j < 2; j++) s[i][j] = f32x4{0.f, 0.f, 0.f, 0.f};
#pragma unroll
      for (int ks = 0; ks < 3; ks++)
#pragma unroll
        for (int kb = 0; kb < 4; kb++) {
          bf16x8 kf = *(const bf16x8*)(Ks + (kb * 16 + fr) * KLD + ks * 32 + fq * 8);
#pragma unroll
          for (int qb = 0; qb < 2; qb++) s[kb][qb] = __builtin_amdgcn_mfma_f32_16x16x32_bf16(kf, qf[qb][ks], s[kb][qb], 0, 0, 0);
        }
      const bool need_mask = (kt * 64 + 63 > q0);
      unsigned pfw[2][2][4];
#pragma unroll
      for (int qb = 0; qb < 2; qb++) {
        const int query = q0 + qb * 16 + fr;
        float mx = -1e30f;
        if (need_mask) {
#pragma unroll
          for (int kb = 0; kb < 4; kb++)
#pragma unroll
            for (int j = 0; j < 4; j++) {
              int key = kt * 64 + kb * 16 + fq * 4 + j;
              if (key > query) s[kb][qb][j] = -1e30f;
            }
        }
#pragma unroll
        for (int kb = 0; kb < 4; kb++)
          mx = fmaxf(mx, fmaxf(fmaxf(s[kb][qb][0], s[kb][qb][1]), fmaxf(s[kb][qb][2], s[kb][qb][3])));
        mx = fmaxf(mx, shx(mx, lane, 16));
        mx = fmaxf(mx, shx(mx, lane, 32));
        const float mold = mrun[qb];
        const float mnew = fmaxf(mold, mx * sc);
        mrun[qb] = mnew;
        float ps = 0.f;
#pragma unroll
        for (int kb = 0; kb < 4; kb++) {
          float p0 = __builtin_amdgcn_exp2f(fmaf(s[kb][qb][0], sc, -mnew)), p1 = __builtin_amdgcn_exp2f(fmaf(s[kb][qb][1], sc, -mnew));
          float p2 = __builtin_amdgcn_exp2f(fmaf(s[kb][qb][2], sc, -mnew)), p3 = __builtin_amdgcn_exp2f(fmaf(s[kb][qb][3], sc, -mnew));
          ps += (p0 + p1) + (p2 + p3);
          pfw[qb][kb >> 1][(kb & 1) * 2 + 0] = pk2(p0, p1);
          pfw[qb][kb >> 1][(kb & 1) * 2 + 1] = pk2(p2, p3);
        }
        if (__builtin_amdgcn_ballot_w64(mnew != mold) != 0) {
          const float alpha = __builtin_amdgcn_exp2f(mold - mnew);
          lrun[qb] *= alpha;
#pragma unroll
          for (int dvb = 0; dvb < 4; dvb++) {
            O[dvb][qb][0] *= alpha; O[dvb][qb][1] *= alpha; O[dvb][qb][2] *= alpha; O[dvb][qb][3] *= alpha;
          }
        }
        lrun[qb] += ps;
      }
#pragma unroll
      for (int s2 = 0; s2 < 2; s2++)
#pragma unroll
        for (int dvb = 0; dvb < 4; dvb++) {
          const u16* vp = Vs + (dvb * 16 + fr) * VLD + s2 * 32 + fq * 4;
          uint2 v0 = *(const uint2*)vp;
          uint2 v1 = *(const uint2*)(vp + 16);
          uint4 vv = make_uint4(v0.x, v0.y, v1.x, v1.y);
          bf16x8 vf = *(bf16x8*)&vv;
#pragma unroll
          for (int qb = 0; qb < 2; qb++) {
            uint4 pw = make_uint4(pfw[qb][s2][0], pfw[qb][s2][1], pfw[qb][s2][2], pfw[qb][s2][3]);
            O[dvb][qb] = __builtin_amdgcn_mfma_f32_16x16x32_bf16(vf, *(bf16x8*)&pw, O[dvb][qb], 0, 0, 0);
          }
        }
    }
  }
  __syncthreads();
  if (wave_valid) {
#pragma unroll
    for (int qb = 0; qb < 2; qb++) {
      float l = lrun[qb];
      l += shx(l, lane, 16);
      l += shx(l, lane, 32);
      float inv = 1.0f / l;
      int query = q0 + qb * 16 + fr;
      if (query < qs + qn) {
        u16* op = P + (size_t)(rowbase + query) * PC_ + PMLA_ + h * 64 + fq * 4;
#pragma unroll
        for (int dvb = 0; dvb < 4; dvb++) {
          *(uint2*)(op + dvb * 16) =
              make_uint2(pk2(O[dvb][qb][0] * inv, O[dvb][qb][1] * inv), pk2(O[dvb][qb][2] * inv, O[dvb][qb][3] * inv));
        }
      }
    }
  }
}

#define XB_TMO      128
#define XB_XCNT(j)  (256  + 64 * (j))
#define XB_XSUB(j)  (1280 + 64 * (j))
#define XB_XGEN(j)  (2304 + 64 * (j))
#define XB_TOP      3328
#define XB_TOPGEN   3392
#define XCD_BAR_WORDS 3456
#define XB_SPIN_CAP (1u << 18)
#define LAS __attribute__((address_space(3)))

__device__ __forceinline__ unsigned xb_ld(unsigned* p)              { return __hip_atomic_load(p, __ATOMIC_RELAXED, __HIP_MEMORY_SCOPE_AGENT); }
__device__ __forceinline__ unsigned xb_add(unsigned* p, unsigned v) { return __hip_atomic_fetch_add(p, v, __ATOMIC_RELAXED, __HIP_MEMORY_SCOPE_AGENT); }
__device__ __forceinline__ unsigned xb_xcc_id() { return (unsigned)__builtin_amdgcn_s_getreg((3 << 11) | 20) & 0xFu; }
#define XB_SPIN(cond, bar) do { unsigned _sp = 0; while (cond) { __builtin_amdgcn_s_sleep(1); \
    if ((++_sp & 255u) == 0u) { if (xb_ld(&(bar)[XB_TMO])) break; if (_sp > XB_SPIN_CAP) { atomicAdd(&(bar)[XB_TMO], 1u); break; } } } } while (0)

struct XcdBarrier {
    unsigned* bar; unsigned x;
    volatile LAS unsigned* st;
};

__device__ __forceinline__ XcdBarrier xcd_barrier_post(unsigned* bar, volatile LAS unsigned* st) {
    XcdBarrier b; b.bar = bar; b.x = xb_xcc_id(); b.st = st;
    if (threadIdx.x == 0) (void)xb_add(&bar[XB_XCNT(b.x)], 1u);
    return b;
}
__device__ __forceinline__ void xcd_barrier_complete(unsigned* bar, unsigned x, unsigned& nloc, unsigned& nx) {
    const unsigned G = gridDim.x * gridDim.y * gridDim.z;
    unsigned sum, cnt, mine, sp = 0u;
    for (;;) {
        sum = 0u; cnt = 0u; mine = 0u;
#pragma unroll
        for (unsigned j = 0; j < 16; ++j) { const unsigned c = xb_ld(&bar[XB_XCNT(j)]); sum += c; cnt += (c > 0u) ? 1u : 0u; mine = (j == x) ? c : mine; }
        if (sum == G) break;
        __builtin_amdgcn_s_sleep(1);
        if ((++sp & 255u) == 0u) { if (xb_ld(&bar[XB_TMO])) break; if (sp > XB_SPIN_CAP) { atomicAdd(&bar[XB_TMO], 1u); break; } }
    }
    nloc = mine > 0u ? mine : 1u; nx = cnt > 0u ? cnt : 1u;
}

__device__ __forceinline__ void xcd_barrier(const XcdBarrier& b, const int tid_) {
    asm volatile("s_waitcnt vmcnt(0)" ::: "memory");
    __syncthreads();
    if (tid_ == 0) {
        unsigned* bar = b.bar;
        __builtin_amdgcn_s_waitcnt(0);
        unsigned nloc = b.st[0], nx = b.st[1];
        if (nloc == 0u) { xcd_barrier_complete(bar, b.x, nloc, nx); b.st[0] = nloc; b.st[1] = nx; }
        const unsigned old = xb_add(&bar[XB_XSUB(b.x)], 1u);
        const unsigned gen = old / nloc;
        if (old + 1u == (gen + 1u) * nloc) {
            __builtin_amdgcn_fence(__ATOMIC_RELEASE, "agent");
            asm volatile("s_waitcnt vmcnt(0)" ::: "memory");
            const unsigned og = xb_add(&bar[XB_TOP], 1u);
            const unsigned tg = og / nx;
            if (og + 1u == (tg + 1u) * nx) xb_add(&bar[XB_TOPGEN], 1u);
            else XB_SPIN(xb_ld(&bar[XB_TOPGEN]) == tg, bar);
            __builtin_amdgcn_fence(__ATOMIC_ACQUIRE, "agent");
            xb_add(&bar[XB_XGEN(b.x)], 1u);
            asm volatile("s_waitcnt vmcnt(0)" ::: "memory");
        } else {
            XB_SPIN(xb_ld(&bar[XB_XGEN(b.x)]) == gen, bar);
            __builtin_amdgcn_fence(__ATOMIC_ACQUIRE, "agent");
            asm volatile("s_waitcnt vmcnt(0)" ::: "memory");
        }
    }
    __syncthreads();
}


__global__ void __launch_bounds__(256, 2) mega(Params p) {
  cg::grid_group grid = cg::this_grid();
  __shared__ __attribute__((aligned(16))) char smem[SMEM_BYTES];
  __shared__ int s_unit;
  __shared__ uint4 xb_words;
  if (threadIdx.x == 0) xb_words = make_uint4(0u, 0u, 0u, 0u);
  __syncthreads();
  (void)xcd_barrier_post((unsigned*)(p.ws + OFF_BAR), (volatile LAS unsigned*)&xb_words);
#define XB_SYNC() do { XcdBarrier xb_; xb_.bar = (unsigned*)(p.ws + OFF_BAR); xb_.x = xb_xcc_id(); xb_.st = (volatile LAS unsigned*)&xb_words; xcd_barrier(xb_, wave0 * 64 + fresh_lane()); } while (0)
  int wave0 = __builtin_amdgcn_readfirstlane((int)(threadIdx.x >> 6));
  asm volatile("" : "+s"(wave0));
  const int nblk = gridDim.x;
  float* H = (float*)(p.ws + OFF_H);
  u16* P = (u16*)(p.ws + OFF_P);
  float* DEC = (float*)(p.ws + OFF_DEC);
  u16* AA = (u16*)(p.ws + OFF_AA);
  u16* GG = (u16*)(p.ws + OFF_GG);
  u16* Q = (u16*)(p.ws + OFF_Q);
  u16* MIX = (u16*)(p.ws + OFF_DEC);
  u16* HB1 = (u16*)p.out + (size_t)2 * M_ * 512;
  u16* HB2 = (u16*)(p.ws + OFF_HB2);
  u16* HBH = (u16*)(p.ws + OFF_AA);
  const u16* ZERO = (const u16*)(p.ws + OFF_ZERO);
  u16* ACT = (u16*)(p.ws + OFF_P);
  float2* ROPE = (float2*)(p.ws + OFF_ROPE);
  int* CTR = (int*)(p.ws + OFF_CTR);
  u16* KN = (u16*)p.out;
  u16* VT = KN + (size_t)M_ * 512;
  u16* YR = AA;

  {
  PHASE_TID
  for (int t = blockIdx.x; t < p.nconv; t += nblk) conv_tile(p, t, smem, tid);
  for (int i = blockIdx.x * 256 + tid; i < T_ * 16; i += nblk * 256) {
    int t = i >> 4, f = i & 15;
    double rev = (double)t * ROPE_C[f];
    rev -= floor(rev);
    float r = (float)rev;
    ROPE[i] = make_float2(__builtin_amdgcn_cosf(r), __builtin_amdgcn_sinf(r));
  }
  for (int row = (blockIdx.x * 4 + wave) * 2; row < M_; row += nblk * 8) {
    int b = row / T_, t = row % T_;
    const float* srcA = (t < NMETA_) ? (p.in[1] + (size_t)t * 1024) : (p.in[0] + ((size_t)b * SEQ_ + (t - NMETA_)) * 1024);
    u16* hb = (row < HB_SPLIT) ? HB1 + (size_t)row * 1024 : HB2 + (size_t)(row - HB_SPLIT) * 1024;
    ln_row2(srcA, srcA + 1024, p.in[2], p.in[3], H + (size_t)row * 1024, H + (size_t)(row + 1) * 1024, lane, hb, hb + 1024);
  }
  if (blockIdx.x == 0 && tid < 16) CTR[tid] = 0;
  if (blockIdx.x == 1) { for (int i = tid; i < 2048; i += 256) ((unsigned*)(p.ws + OFF_ZERO))[i] = 0u; }
  }
  grid.sync();

#pragma unroll 1
  for (int ph_ = 0; ph_ < 20; ph_++) {
    const int l = ph_ / 10, kph = ph_ - l * 10;
    const u16* WL = (const u16*)(p.ws + OFF_W) + (size_t)l * W_LAYER;
    if (kph == 0) {
    PHASE_TID
    for (int it_ = 0; it_ * nblk < 257 * 19; it_++) {
      int mt, nt;
      if (!map_tile(it_, nblk, 257, 19, mt, nt)) continue;
      f32x4 acc[8][4];
      zero_acc8(acc);
      ADma al = ADma{(mt < 255) ? HB1 : HB2, 1024, (mt < 255) ? mt * 256 : mt * 256 - HB_SPLIT, 0, ZERO, 0};
      gemm3(acc, al, WL + W_IN, 1024, nt * 128, 1024, smem, tid);
      ACC_COORDS
#pragma unroll
      for (int mi = 0; mi < 8; mi++)
#pragma unroll
        for (int ni = 0; ni < 4; ni++) {
          int col = nt * 128 + wc * 64 + ni * 16 + fq * 4;
          int row = mt * 256 + wr * 128 + mi * 16 + fr;
          if (col < PC_)
            *(uint2*)(P + (size_t)row * PC_ + col) = make_uint2(pk2(acc[mi][ni][0], acc[mi][ni][1]), pk2(acc[mi][ni][2], acc[mi][ni][3]));
        }
    }
    }
    if (kph == 1) {
    PHASE_TID
    {
      const float* qg = p.in[16] + l * 256;
      const float* kvg = p.in[18] + l * 256;
      for (int row = blockIdx.x * 4 + wave; row < M_; row += nblk * 4) {
        u16* pr = P + (size_t)row * PC_;
        uint2 cq = *(const uint2*)(pr + PMLA_ + lane * 4);
        uint2 ckv = *(const uint2*)(pr + PKV_ + lane * 4);
        float a[4], c[4];
        unpack4(cq, a);
        unpack4(ckv, c);
        float s1 = a[0] * a[0] + a[1] * a[1] + a[2] * a[2] + a[3] * a[3];
        float s2 = c[0] * c[0] + c[1] * c[1] + c[2] * c[2] + c[3] * c[3];
        s1 = wave_sum(s1, lane);
        s2 = wave_sum(s2, lane);
        float r1 = rsqrtf(s1 * (1.0f / 256.0f) + 1e-6f), r2 = rsqrtf(s2 * (1.0f / 256.0f) + 1e-6f);
        float4 g1 = *(const float4*)(qg + lane * 4), g2 = *(const float4*)(kvg + lane * 4);
        *(uint2*)(pr + PMLA_ + lane * 4) = make_uint2(pk2(a[0] * r1 * g1.x, a[1] * r1 * g1.y), pk2(a[2] * r1 * g1.z, a[3] * r1 * g1.w));
        *(uint2*)(pr + PKV_ + lane * 4) = make_uint2(pk2(c[0] * r2 * g2.x, c[1] * r2 * g2.y), pk2(c[2] * r2 * g2.z, c[3] * r2 * g2.w));
        if (lane < 16) {
          int t = row % T_;
          float x1 = bf2f(pr[PKR_ + lane]), x2 = bf2f(pr[PKR_ + 16 + lane]);
          float2 cs = ROPE[t * 16 + lane];
          pr[PKR_ + lane] = f2bf(x1 * cs.x - x2 * cs.y);
          pr[PKR_ + 16 + lane] = f2bf(x1 * cs.y + x2 * cs.x);
        }
      }
      const float* mu = p.in[5] + (size_t)l * 1824;
      for (int tile = blockIdx.x; tile < 514 * 12; tile += nblk) {
        int mt = tile / 12, sub = tile % 12, which = sub >> 2, nt = sub & 3;
        f32x4 acc[4][4];
        zero_acc(acc);
        ACC_COORDS
        if (which == 0) {
          AL<3> al{P + 1536, PC_, mt * 128, 0, 64, mu + 1536, 0};
          gemm_loop(acc, al, WL + W_LW, 64, nt * 128, 64, smem, tid);
          const float* w0 = p.in[6] + l * 512;
#pragma unroll
          for (int mi = 0; mi < 4; mi++)
#pragma unroll
            for (int ni = 0; ni < 4; ni++) {
              int col = nt * 128 + wc * 64 + ni * 16 + fr;
              float w0c = w0[col];
#pragma unroll
              for (int j = 0; j < 4; j++) {
                int row = mt * 128 + wr * 64 + mi * 16 + fq * 4 + j;
                float x = -(acc[mi][ni][j] + w0c);
                float sp = fmaxf(x, 0.f) + __logf(1.0f + __expf(-fabsf(x)));
                float wraw = -sp - 0.5f;
                DEC[(size_t)row * 512 + col] = __expf(-__expf(wraw));
              }
            }
        } else if (which == 1) {
          AL<3> al{P + 1600, PC_, mt * 128, 0, 64, mu + 1600, 1};
          gemm_loop(acc, al, WL + W_LA, 64, nt * 128, 64, smem, tid);
          const float* a0 = p.in[8] + l * 512;
#pragma unroll
          for (int mi = 0; mi < 4; mi++)
#pragma unroll
            for (int ni = 0; ni < 4; ni++) {
              int col = nt * 128 + wc * 64 + ni * 16 + fr;
              float a0c = a0[col];
#pragma unroll
              for (int j = 0; j < 4; j++) {
                int row = mt * 128 + wr * 64 + mi * 16 + fq * 4 + j;
                AA[(size_t)row * 512 + col] = f2bf(sigmoidf_(acc[mi][ni][j] + a0c));
              }
            }
        } else {
          AL<3> al{P + 1664, PC_, mt * 128, 0, 160, mu + 1664, 2};
          gemm_loop(acc, al, WL + W_LG, 192, nt * 128, 192, smem, tid);
#pragma unroll
          for (int mi = 0; mi < 4; mi++)
#pragma unroll
            for (int ni = 0; ni < 4; ni++) {
              int col = nt * 128 + wc * 64 + ni * 16 + fr;
#pragma unroll
              for (int j = 0; j < 4; j++) {
                int row = mt * 128 + wr * 64 + mi * 16 + fq * 4 + j;
                GG[(size_t)row * 512 + col] = f2bf(acc[mi][ni][j]);
              }
            }
        }
      }
    }
    }
    if (kph == 2) {
    PHASE_TID
    for (int it_ = 0; it_ * nblk < 257 * 14; it_++) {
      int mt, sub;
      if (!map_tile(it_, nblk, 257, 14, mt, sub)) continue;
      f32x4 acc[8][4];
      zero_acc8(acc);
      ACC_COORDS
      if (sub < 6) {
        ADma al{P + PMLA_, PC_, mt * 256, 0, ZERO, 0};
        gemm3(acc, al, WL + W_UQ, 256, sub * 128, 256, smem, tid);
#pragma unroll
        for (int mi = 0; mi < 8; mi++)
#pragma unroll
          for (int ni = 0; ni < 4; ni++) {
            int col = sub * 128 + wc * 64 + ni * 16 + fq * 4;
            int row = mt * 256 + wr * 128 + mi * 16 + fr;
            *(uint2*)(Q + (size_t)row * 768 + col) = make_uint2(pk2(acc[mi][ni][0], acc[mi][ni][1]), pk2(acc[mi][ni][2], acc[mi][ni][3]));
          }
      } else if (sub < 10) {
        int nt = sub - 6;
        ADma al{P + PKV_, PC_, mt * 256, 0, ZERO, 0};
        gemm3(acc, al, WL + W_UK, 256, nt * 128, 256, smem, tid);
#pragma unroll
        for (int mi = 0; mi < 8; mi++)
#pragma unroll
          for (int ni = 0; ni < 4; ni++) {
            int col = nt * 128 + wc * 64 + ni * 16 + fq * 4;
            int row = mt * 256 + wr * 128 + mi * 16 + fr;
            *(uint2*)(KN + (size_t)row * 512 + col) = make_uint2(pk2(acc[mi][ni][0], acc[mi][ni][1]), pk2(acc[mi][ni][2], acc[mi][ni][3]));
          }
      } else {
        int nt = sub - 10;
        ADma al{P + PKV_, PC_, mt * 256, 0, ZERO, 0};
        gemm3<4, false>(acc, al, WL + W_UV, 256, nt * 128, 256, smem, tid);
#pragma unroll
        for (int mi = 0; mi < 8; mi++)
#pragma unroll
          for (int ni = 0; ni < 4; ni++) {
            int col = nt * 128 + wc * 64 + ni * 16 + fr;
            int row = mt * 256 + wr * 128 + mi * 16 + fq * 4;
            int b = row / T_, t = row % T_;
            size_t o = ((size_t)(b * 512 + col)) * T_ + t;
            *(uint2*)(VT + o) = make_uint2(pk2(acc[mi][ni][0], acc[mi][ni][1]), pk2(acc[mi][ni][2], acc[mi][ni][3]));
          }
      }
    }
    }
    if (kph == 3) {
    PHASE_TID
    {
      const int xcd = blockIdx.x & 7, loc = blockIdx.x >> 3;
      const int total = 16 * 33;
      const bool scan_wg = (loc < 16), partner = (loc >= (nblk >> 4) && loc < (nblk >> 4) + 16);
      if (scan_wg) {
        scan_unit(p, l, xcd * 16 + loc, smem, launder(tid));
        __syncthreads();
      }
      if (!partner) {
        while (true) {
          if (tid == 0) s_unit = atomicAdd(&CTR[l * 8 + xcd], 1);
          __syncthreads();
          int v = s_unit;
          __syncthreads();
          if (v >= total) break;
          const int tidu = launder(tid);
          int g = v / 66, w = v - g * 66;
          attn_unit(p, xcd * 16 + g * 2 + (w & 1), 32 - (w >> 1), smem, tidu);
          __syncthreads();
        }
      }
    }
    }
    if (kph == 4) {
    PHASE_TID
    {
    u16* scr = (u16*)(p.ws + OFF_SCR) + (size_t)blockIdx.x * 32768;
    for (int it_ = 0; it_ * nblk < 256 * 8; it_++) {
      int mt, nt;
      if (!map_tile(it_, nblk, 256, 8, mt, nt)) continue;
      f32x4 acc[8][4];
      ADma alh = ADma{(mt < 255) ? HB1 : HB2, 1024, (mt < 255) ? mt * 256 : mt * 256 - HB_SPLIT, 0, ZERO, 0};
      zero_acc8(acc);
      gemm3(acc, alh, WL + W_G, 1024, nt * 128, 1024, smem, launder(tid));
      { const int tq_ = launder(tid); const int lane = tq_ & 63, wave = tq_ >> 6; ACC_COORDS
#pragma unroll
        for (int mi = 0; mi < 8; mi++)
#pragma unroll
          for (int ni = 0; ni < 4; ni++) {
            int col = nt * 128 + wc * 64 + ni * 16 + fq * 4;
            int row = mt * 256 + wr * 128 + mi * 16 + fr;
            *(uint2*)(MIX + (size_t)row * 1024 + col) = make_uint2(pk2(sigmoidf_(acc[mi][ni][0]), sigmoidf_(acc[mi][ni][1])),
                                                                   pk2(sigmoidf_(acc[mi][ni][2]), sigmoidf_(acc[mi][ni][3])));
          }
      }
      zero_acc8(acc);
      {
        ADma aly{YR, 512, mt * 256, 0, ZERO, 0};
        gemm3(acc, aly, WL + W_PR, 512, nt * 128, 512, smem, launder(tid));
      }
      { const int tq_ = launder(tid); const int lane = tq_ & 63, wave = tq_ >> 6; ACC_COORDS
#pragma unroll
        for (int mi = 0; mi < 8; mi++)
#pragma unroll
          for (int ni = 0; ni < 4; ni++) {
            int col = nt * 128 + wc * 64 + ni * 16 + fq * 4;
            int row = mt * 256 + wr * 128 + mi * 16 + fr;
            u16* mp = MIX + (size_t)row * 1024 + col;
            uint2 s = *(const uint2*)mp;
            *(uint2*)mp = make_uint2(pk2(bflo(s.x) * acc[mi][ni][0], bfhi(s.x) * acc[mi][ni][1]), pk2(bflo(s.y) * acc[mi][ni][2], bfhi(s.y) * acc[mi][ni][3]));
          }
      }
      zero_acc8(acc);
      gemm3(acc, alh, WL + W_G, 1024, 1024 + nt * 128, 1024, smem, launder(tid));
      { const int tq_ = launder(tid); const int lane = tq_ & 63, wave = tq_ >> 6; ACC_COORDS
#pragma unroll
        for (int mi = 0; mi < 8; mi++)
#pragma unroll
          for (int ni = 0; ni < 4; ni++) {
            int cl = wc * 64 + ni * 16 + fq * 4, rl = wr * 128 + mi * 16 + fr;
            *(uint2*)(scr + rl * 128 + cl) = make_uint2(pk2(sigmoidf_(acc[mi][ni][0]), sigmoidf_(acc[mi][ni][1])),
                                                        pk2(sigmoidf_(acc[mi][ni][2]), sigmoidf_(acc[mi][ni][3])));
          }
      }
      zero_acc8(acc);
      {
        ADma alm{P + PMLA_, PC_, mt * 256, 0, ZERO, 0};
        gemm3(acc, alm, WL + W_PM, 512, nt * 128, 512, smem, launder(tid));
      }
      { const int tq_ = launder(tid); const int lane = tq_ & 63, wave = tq_ >> 6; ACC_COORDS
#pragma unroll
        for (int mi = 0; mi < 8; mi++)
#pragma unroll
          for (int ni = 0; ni < 4; ni++) {
            int cl = wc * 64 + ni * 16 + fq * 4, rl = wr * 128 + mi * 16 + fr;
            u16* mp = MIX + (size_t)(mt * 256 + rl) * 1024 + nt * 128 + cl;
            uint2 t1 = *(const uint2*)mp;
            uint2 s = *(const uint2*)(scr + rl * 128 + cl);
            float o0 = bflo(t1.x) + bflo(s.x) * acc[mi][ni][0];
            float o1 = bfhi(t1.x) + bfhi(s.x) * acc[mi][ni][1];
            float o2 = bflo(t1.y) + bflo(s.y) * acc[mi][ni][2];
            float o3 = bfhi(t1.y) + bfhi(s.y) * acc[mi][ni][3];
            *(uint2*)mp = make_uint2(pk2(o0, o1), pk2(o2, o3));
          }
      }
    }
    }
    if (blockIdx.x < 16) {
      const int mt = 256, nt = blockIdx.x;
      f32x4 acc[8][2];
      unsigned sg[8][2][2];
      ADma alh = ADma{(mt < 255) ? HB1 : HB2, 1024, (mt < 255) ? mt * 256 : mt * 256 - HB_SPLIT, 0, ZERO, 0};
      zero_acc8(acc);
      const int tid1 = launder(tid);
      gemm3(acc, alh, WL + W_G, 1024, nt * 64, 1024, smem, tid1);
#pragma unroll
      for (int mi = 0; mi < 8; mi++)
#pragma unroll
        for (int ni = 0; ni < 2; ni++) {
          sg[mi][ni][0] = pk2(sigmoidf_(acc[mi][ni][0]), sigmoidf_(acc[mi][ni][1]));
          sg[mi][ni][1] = pk2(sigmoidf_(acc[mi][ni][2]), sigmoidf_(acc[mi][ni][3]));
        }
      zero_acc8(acc);
      {
        ADma aly{YR, 512, mt * 256, 0, ZERO, 0};
        const int tid2 = launder(tid);
      gemm3(acc, aly, WL + W_PR, 512, nt * 64, 512, smem, tid2);
      }
{ const int tidq = launder(tid); const int lane = tidq & 63, wave = tidq >> 6; ACC_COORDS
#pragma unroll
      for (int mi = 0; mi < 8; mi++)
#pragma unroll
        for (int ni = 0; ni < 2; ni++) {
          int col = nt * 64 + wc * 32 + ni * 16 + fq * 4;
          int row = mt * 256 + wr * 128 + mi * 16 + fr;
          *(uint2*)(MIX + (size_t)row * 1024 + col) = make_uint2(pk2(bflo(sg[mi][ni][0]) * acc[mi][ni][0], bfhi(sg[mi][ni][0]) * acc[mi][ni][1]),
                                                                 pk2(bflo(sg[mi][ni][1]) * acc[mi][ni][2], bfhi(sg[mi][ni][1]) * acc[mi][ni][3]));
        }
      }
      zero_acc8(acc);
      const int tid3 = launder(tid);
      gemm3(acc, alh, WL + W_G, 1024, 1024 + nt * 64, 1024, smem, tid3);
#pragma unroll
      for (int mi = 0; mi < 8; mi++)
#pragma unroll
        for (int ni = 0; ni < 2; ni++) {
          sg[mi][ni][0] = pk2(sigmoidf_(acc[mi][ni][0]), sigmoidf_(acc[mi][ni][1]));
          sg[mi][ni][1] = pk2(sigmoidf_(acc[mi][ni][2]), sigmoidf_(acc[mi][ni][3]));
        }
      zero_acc8(acc);
      {
        ADma alm{P + PMLA_, PC_, mt * 256, 0, ZERO, 0};
        const int tid4 = launder(tid);
      gemm3(acc, alm, WL + W_PM, 512, nt * 64, 512, smem, tid4);
      }
{ const int tidq = launder(tid); const int lane = tidq & 63, wave = tidq >> 6; ACC_COORDS
#pragma unroll
      for (int mi = 0; mi < 8; mi++)
#pragma unroll
        for (int ni = 0; ni < 2; ni++) {
          int col = nt * 64 + wc * 32 + ni * 16 + fq * 4;
          int row = mt * 256 + wr * 128 + mi * 16 + fr;
          uint2 pm = *(const uint2*)(MIX + (size_t)row * 1024 + col);
          float o0 = bflo(pm.x) + bflo(sg[mi][ni][0]) * acc[mi][ni][0];
          float o1 = bfhi(pm.x) + bfhi(sg[mi][ni][0]) * acc[mi][ni][1];
          float o2 = bflo(pm.y) + bflo(sg[mi][ni][1]) * acc[mi][ni][2];
          float o3 = bfhi(pm.y) + bfhi(sg[mi][ni][1]) * acc[mi][ni][3];
          *(uint2*)(MIX + (size_t)row * 1024 + col) = make_uint2(pk2(o0, o1), pk2(o2, o3));
        }
      }
    }
    }
    if (kph == 5) {
    PHASE_TID
    for (int prb_ = (PROBE_FI ? 0 : 1); prb_ < 2; prb_++)
    for (int it_ = 0; it_ * nblk < 256 * 8; it_++) {
      int mt, nt;
      if (!map_tile(it_, nblk, 256, 8, mt, nt)) continue;
      f32x4 acc[8][4];
      zero_acc8(acc);
      ACC_COORDS
      ADma al{MIX, 1024, mt * 256, 0, ZERO, 0};
      gemm3(acc, al, WL + W_OUT, 1024, nt * 128, 1024, smem, tid);
#pragma unroll
      for (int mi = 0; mi < 8; mi++)
#pragma unroll
        for (int ni = 0; ni < 4; ni++) {
          int col = nt * 128 + wc * 64 + ni * 16 + fq * 4;
          int row = mt * 256 + wr * 128 + mi * 16 + fr;
          float* hp = H + (size_t)row * 1024 + col;
          float* dp = (prb_ == 0) ? (p.out + (size_t)(row & 65535) * 1024 + col) : hp;
          float4 hv = *(const float4*)hp;
          hv.x = ALPHA_ * hv.x + acc[mi][ni][0];
          hv.y = ALPHA_ * hv.y + acc[mi][ni][1];
          hv.z = ALPHA_ * hv.z + acc[mi][ni][2];
          hv.w = ALPHA_ * hv.w + acc[mi][ni][3];
          *(float4*)dp = hv;
        }
    }
    if (blockIdx.x < 16) {
      const int mt = 256, n0 = blockIdx.x * 64;
      f32x4 acc[8][2];
      zero_acc8(acc);
      ADma al{MIX, 1024, mt * 256, 0, ZERO, 0};
      gemm3(acc, al, WL + W_OUT, 1024, n0, 1024, smem, launder(tid));
      const int tq_ = launder(tid);
      const int lane = tq_ & 63, wave = tq_ >> 6;
      ACC_COORDS
#pragma unroll
      for (int mi = 0; mi < 8; mi++)
#pragma unroll
        for (int ni = 0; ni < 2; ni++) {
          int col = n0 + wc * 32 + ni * 16 + fq * 4;
          int row = mt * 256 + wr * 128 + mi * 16 + fr;
          float* hp = H + (size_t)row * 1024 + col;
          float4 hv = *(const float4*)hp;
          hv.x = ALPHA_ * hv.x + acc[mi][ni][0];
          hv.y = ALPHA_ * hv.y + acc[mi][ni][1];
          hv.z = ALPHA_ * hv.z + acc[mi][ni][2];
          hv.w = ALPHA_ * hv.w + acc[mi][ni][3];
          *(float4*)hp = hv;
        }
    }
    }
    if (kph == 6) {
    PHASE_TID
    for (int row = (blockIdx.x * 4 + wave) * 2; row < M_; row += nblk * 8)
      ln_row2(H + (size_t)row * 1024, H + (size_t)(row + 1) * 1024, p.in[24] + l * 1024, p.in[25] + l * 1024, H + (size_t)row * 1024, H + (size_t)(row + 1) * 1024, lane, HBH + (size_t)row * 1024, HBH + (size_t)(row + 1) * 1024);
    }
    if (kph == 7) {
    PHASE_TID
    {
      const float* cw = p.in[27] + (size_t)l * 3 * 5632;
      const float* cb = p.in[28] + (size_t)l * 5632;
#if PROBE_HOT
      for (int it_ = 0; it_ * nblk < 272 * 44; it_++) {
        int rest, nt;
        if (!map_tile(it_, nblk, 272, 44, rest, nt)) continue;
        f32x4 acc[8][4];
        zero_acc8(acc);
#if PROBE_HOT == 1
        ADma al{HBH, 1024, 0, 0, ZERO, 1, p.ws};
        gemm3(acc, al, WL + W_UP, 1024, 0, 1024, smem, tid);
#else
        int it = rest % 17, b = rest / 17;
        ADma al{HBH, 1024, b * T_, 254 * it - 2, ZERO, 1, p.ws};
        gemm3(acc, al, WL + W_UP, 1024, nt * 128, 1024, smem, tid);
#endif
        float sacc = 0.f;
#pragma unroll
        for (int mi = 0; mi < 8; mi++)
#pragma unroll
          for (int ni = 0; ni < 4; ni++) sacc += acc[mi][ni][0] + acc[mi][ni][1] + acc[mi][ni][2] + acc[mi][ni][3];
        if (sacc == 12345.678f) ACT[tid] = 0;
      }
#endif
      for (int it_ = 0; it_ * nblk < 272 * 44; it_++) {
        int rest, nt;
        if (!map_tile(it_, nblk, 272, 44, rest, nt)) continue;
        int it = rest % 17, b = rest / 17;
        int t0 = 254 * it - 2;
        f32x4 acc[8][4];
        zero_acc8(acc);
        ADma al{HBH, 1024, b * T_, t0, ZERO, 1, p.ws};
        gemm3(acc, al, WL + W_UP, 1024, nt * 128, 1024, smem, launder(tid));
        ACC_COORDS
        float(*ut)[132] = (float(*)[132])smem;
        const int tidh = launder(tid);
        const int c = tidh & 63, rg = tidh >> 6;
        const int gcol = nt * 64 + c, vcol = DFF_ + nt * 64 + c;
        const float g0 = cw[gcol], g1 = cw[5632 + gcol], g2 = cw[2 * 5632 + gcol], gb = cb[gcol];
        const float v0 = cw[vcol], v1 = cw[5632 + vcol], v2 = cw[2 * 5632 + vcol], vb = cb[vcol];
#pragma unroll 1
        for (int half = 0; half < 2; half++) {
          float carry = 0.f;
          if (half == 1) carry = ut[126 + (tid >> 7)][tid & 127];
          __syncthreads();
          if (half == 1) ut[tid >> 7][tid & 127] = carry;
          if (wr == half) {
#pragma unroll
            for (int mi = 0; mi < 8; mi++)
#pragma unroll
              for (int ni = 0; ni < 4; ni++)
                *(float4*)&ut[half * 2 + mi * 16 + fr][wc * 64 + ni * 16 + fq * 4] = make_float4(acc[mi][ni][0], acc[mi][ni][1], acc[mi][ni][2], acc[mi][ni][3]);
          }
          __syncthreads();
          const int nq = half ? 130 : 128;
          int qs = 2 + rg * 32, qe = min(qs + 32, nq);
          float ga = ut[qs - 2][c], gbp = ut[qs - 1][c];
          float va = ut[qs - 2][64 + c], vbp = ut[qs - 1][64 + c];
#pragma unroll 4
          for (int q = qs; q < qe; q++) {
            float gc = ut[q][c], vc = ut[q][64 + c];
            int t = t0 + half * 126 + q;
            if (t < T_) {
              float gate = g0 * ga + g1 * gbp + g2 * gc + gb;
              float val = v0 * va + v1 * vbp + v2 * vc + vb;
              float av = gate * sigmoidf_(gate) * val;
              ACT[(size_t)(b * T_ + t) * DFF_ + gcol] = f2bf(av);
            }
            ga = gbp; gbp = gc; va = vbp; vbp = vc;
          }
        }
        __syncthreads();
      }
    }
    }
    if (kph == 8) {
    PHASE_TID
    for (int prb_ = (PROBE_FI ? 0 : 1); prb_ < 2; prb_++)
    for (int it_ = 0; it_ * nblk < 256 * 8; it_++) {
      int mt, nt;
      if (!map_tile(it_, nblk, 256, 8, mt, nt)) continue;
      f32x4 acc[8][4];
      zero_acc8(acc);
      ACC_COORDS
      ADma al{ACT, DFF_, mt * 256, 0, ZERO, 0};
      gemm3(acc, al, WL + W_DN, DFF_, nt * 128, DFF_, smem, tid);
#pragma unroll
      for (int mi = 0; mi < 8; mi++)
#pragma unroll
        for (int ni = 0; ni < 4; ni++) {
          int col = nt * 128 + wc * 64 + ni * 16 + fq * 4;
          int row = mt * 256 + wr * 128 + mi * 16 + fr;
          float* hp = H + (size_t)row * 1024 + col;
          float* dp = (prb_ == 0) ? (p.out + (size_t)(row & 65535) * 1024 + col) : hp;
          float4 hv = *(const float4*)hp;
          hv.x = ALPHA_ * hv.x + acc[mi][ni][0];
          hv.y = ALPHA_ * hv.y + acc[mi][ni][1];
          hv.z = ALPHA_ * hv.z + acc[mi][ni][2];
          hv.w = ALPHA_ * hv.w + acc[mi][ni][3];
          *(float4*)dp = hv;
        }
    }
    if (blockIdx.x < 16) {
      const int mt = 256, n0 = blockIdx.x * 64;
      f32x4 acc[8][2];
      zero_acc8(acc);
      ADma al{ACT, DFF_, mt * 256, 0, ZERO, 0};
      gemm3(acc, al, WL + W_DN, DFF_, n0, DFF_, smem, launder(tid));
      const int tq_ = launder(tid);
      const int lane = tq_ & 63, wave = tq_ >> 6;
      ACC_COORDS
#pragma unroll
      for (int mi = 0; mi < 8; mi++)
#pragma unroll
        for (int ni = 0; ni < 2; ni++) {
          int col = n0 + wc * 32 + ni * 16 + fq * 4;
          int row = mt * 256 + wr * 128 + mi * 16 + fr;
          float* hp = H + (size_t)row * 1024 + col;
          float4 hv = *(const float4*)hp;
          hv.x = ALPHA_ * hv.x + acc[mi][ni][0];
          hv.y = ALPHA_ * hv.y + acc[mi][ni][1];
          hv.z = ALPHA_ * hv.z + acc[mi][ni][2];
          hv.w = ALPHA_ * hv.w + acc[mi][ni][3];
          *(float4*)hp = hv;
        }
    }
    }
    if (kph == 9) {
    PHASE_TID
    if (l == 0) {
      for (int row = (blockIdx.x * 4 + wave) * 2; row < M_; row += nblk * 8) {
        u16* hb = (row < HB_SPLIT) ? HB1 + (size_t)row * 1024 : HB2 + (size_t)(row - HB_SPLIT) * 1024;
        ln_row2(H + (size_t)row * 1024, H + (size_t)(row + 1) * 1024, p.in[30], p.in[31], H + (size_t)row * 1024, H + (size_t)(row + 1) * 1024, lane, hb, hb + 1024);
      }
    } else {
      for (int row = (blockIdx.x * 4 + wave) * 2; row < M_; row += nblk * 8) {
        int b = row / T_, t = row % T_;
        if (t >= NMETA_) {
          float* o = p.out + ((size_t)b * SEQ_ + (t - NMETA_)) * 1024;
          ln_row2(H + (size_t)row * 1024, H + (size_t)(row + 1) * 1024, p.in[30] + 1024, p.in[31] + 1024, o, o + 1024, lane, nullptr, nullptr);
        }
      }
    }
    }
    if (ph_ != 19) XB_SYNC();
  }
}

extern "C" void kernel_launch(void* const* d_in, const int* in_sizes, int n_in, void* d_out, int out_size, void* d_ws,
                              size_t ws_size, hipStream_t stream) {
  static int grid_blocks = 0;
  if (!grid_blocks) {
    int dev = 0, cus = 0, per_cu = 0;
    hipGetDevice(&dev);
    hipDeviceGetAttribute(&cus, hipDeviceAttributeMultiprocessorCount, dev);
    hipOccupancyMaxActiveBlocksPerMultiprocessor(&per_cu, mega, 256, 0);
    if (per_cu > 2) per_cu = 2;
    grid_blocks = cus * per_cu;
  }
  if (ws_size < WS_TOTAL) fprintf(stderr, "workspace too small: %zu < %zu\n", ws_size, (size_t)WS_TOTAL);
  Params p;
  memset(&p, 0, sizeof(p));
  for (int i = 0; i < 32; i++) p.in[i] = (const float*)d_in[i];
  p.out = (float*)d_out;
  p.ws = (char*)d_ws;
  u16* wb = (u16*)((char*)d_ws + OFF_W);
  int nj = 0, tiles = 0;
  auto add = [&](const float* src, size_t dst_off, int ld, int c0, int K, int Kpad, int Nv, int Np, int mode) {
    Job& j = p.jobs[nj++];
    j.src = src; j.dst = wb + dst_off; j.ld = ld; j.c0 = c0; j.K = K; j.Kpad = Kpad; j.Nv = Nv; j.Np = Np; j.mode = mode;
    j.tile0 = tiles;
    tiles += (Kpad / 64) * (Np / 64);
  };
  for (int l = 0; l < 2; l++) {
    size_t o = (size_t)l * W_LAYER;
    const float* w_in = (const float*)d_in[4] + (size_t)l * 1024 * 4416;
    add(w_in, o + W_IN, 4416, 0, 1024, 1024, 2368, 2432, 0);
    add(w_in, o + W_G, 4416, 2368, 1024, 1024, 2048, 2048, 0);
    add((const float*)d_in[7] + (size_t)l * 64 * 512, o + W_LW, 512, 0, 64, 64, 512, 512, 0);
    add((const float*)d_in[9] + (size_t)l * 64 * 512, o + W_LA, 512, 0, 64, 64, 512, 512, 0);
    add((const float*)d_in[10] + (size_t)l * 160 * 512, o + W_LG, 512, 0, 160, 192, 512, 512, 0);
    add((const float*)d_in[17] + (size_t)l * 256 * 768, o + W_UQ, 768, 0, 256, 256, 768, 768, 0);
    add((const float*)d_in[19] + (size_t)l * 256 * 512, o + W_UK, 512, 0, 256, 256, 512, 512, 0);
    add((const float*)d_in[20] + (size_t)l * 256 * 512, o + W_UV, 512, 0, 256, 256, 512, 512, 0);
    add((const float*)d_in[21] + (size_t)l * 512 * 1024, o + W_PR, 1024, 0, 512, 512, 1024, 1024, 0);
    add((const float*)d_in[22] + (size_t)l * 512 * 1024, o + W_PM, 1024, 0, 512, 512, 1024, 1024, 0);
    add((const float*)d_in[23] + (size_t)l * 1024 * 1024, o + W_OUT, 1024, 0, 1024, 1024, 1024, 1024, 0);
    add((const float*)d_in[26] + (size_t)l * 1024 * 5632, o + W_UP, 5632, 0, 1024, 1024, 5632, 5632, 1);
    add((const float*)d_in[29] + (size_t)l * 2816 * 1024, o + W_DN, 1024, 0, 2816, 2816, 1024, 1024, 0);
  }
  p.nconv = tiles;
  hipMemsetAsync((char*)d_ws + OFF_BAR, 0, 16384, stream);
  void* args[] = {&p};
  hipError_t e = hipLaunchCooperativeKernel((void*)mega, dim3(grid_blocks), dim3(256), args, 0, stream);
  if (e != hipSuccess) fprintf(stderr, "cooperative launch failed: %s (grid %d)\n", hipGetErrorString(e), grid_blocks);
}
```

```cpp
#include <hip/hip_runtime.h>
#include <hip/hip_cooperative_groups.h>
#include <cstdio>
#include <cstring>
namespace cg = cooperative_groups;

#ifndef PHMASK
#define PHMASK 0xFFFF
#endif
#ifndef PROBE_HOT
#define PROBE_HOT 0
#endif
#ifndef PROBE_FI
#define PROBE_FI 0
#endif
#ifndef REPMASK
#define REPMASK 0
#endif
typedef unsigned short u16;
using bf16x8 = __attribute__((ext_vector_type(8))) short;
using f32x4 = __attribute__((ext_vector_type(4))) float;

constexpr int B_ = 16, SEQ_ = 4096, NMETA_ = 16, T_ = 4112, M_ = B_ * T_, D_ = 1024;
constexpr int PC_ = 2368;
constexpr int PMLA_ = 1824, PKV_ = 2080, PKR_ = 2336;
constexpr int DFF_ = 2816;
constexpr float ALPHA_ = 1.4142135623730951f;

constexpr size_t OFF_H = 0;
constexpr size_t OFF_P = OFF_H + (size_t)M_ * 1024 * 4;
constexpr size_t OFF_DEC = OFF_P + (size_t)M_ * PC_ * 2;
constexpr size_t OFF_AA = OFF_DEC + (size_t)M_ * 512 * 4;
constexpr size_t OFF_GG = OFF_AA + (size_t)M_ * 512 * 2;
constexpr size_t OFF_Q = OFF_GG + (size_t)M_ * 512 * 2;
constexpr size_t OFF_W = OFF_Q + (size_t)M_ * 768 * 2;
constexpr size_t W_IN = 0;
constexpr size_t W_G = W_IN + (size_t)2432 * 1024;
constexpr size_t W_LW = W_G + (size_t)2048 * 1024;
constexpr size_t W_LA = W_LW + (size_t)512 * 64;
constexpr size_t W_LG = W_LA + (size_t)512 * 64;
constexpr size_t W_UQ = W_LG + (size_t)512 * 192;
constexpr size_t W_UK = W_UQ + (size_t)768 * 256;
constexpr size_t W_UV = W_UK + (size_t)512 * 256;
constexpr size_t W_PR = W_UV + (size_t)512 * 256;
constexpr size_t W_PM = W_PR + (size_t)1024 * 512;
constexpr size_t W_OUT = W_PM + (size_t)1024 * 512;
constexpr size_t W_UP = W_OUT + (size_t)1024 * 1024;
constexpr size_t W_DN = W_UP + (size_t)5632 * 1024;
constexpr size_t W_LAYER = W_DN + (size_t)1024 * 2816;
constexpr size_t OFF_ROPE = OFF_W + 2 * W_LAYER * 2;
constexpr size_t OFF_CTR = OFF_ROPE + (size_t)T_ * 16 * 8;
constexpr size_t OFF_ZERO = OFF_CTR + 256;
constexpr size_t OFF_BAR = OFF_ZERO + 8192;
constexpr size_t OFF_HB2 = OFF_BAR + 16384;
constexpr size_t OFF_SCR = OFF_HB2 + (size_t)512 * 1024 * 2;
constexpr size_t WS_TOTAL = OFF_SCR + (size_t)1024 * 65536;
constexpr int HB_SPLIT = 65280;

struct Job { const float* src; u16* dst; int ld, c0, K, Kpad, Nv, Np, mode, tile0; };
struct Params {
  const float* in[32];
  float* out;
  char* ws;
  Job jobs[26];
  int nconv;
  int pad0;
};

__constant__ double ROPE_C[16] = {0.15915494309189535, 0.08949940160889101, 0.050329212104487035, 0.0283021958306234,
                                  0.015915494309189534, 0.008949940160889102, 0.005032921210448704, 0.00283021958306234,
                                  0.0015915494309189536, 0.0008949940160889102, 0.0005032921210448703, 0.00028302195830623395,
                                  0.00015915494309189535, 8.949940160889102e-05, 5.0329212104487035e-05, 2.8302195830623396e-05};

__device__ __forceinline__ int launder(int x) { asm volatile("" : "+v"(x)); return x; }
typedef __bf16 bf16x2_t __attribute__((ext_vector_type(2)));
typedef float f32x2_t __attribute__((ext_vector_type(2)));
__device__ __forceinline__ unsigned pk2(float a, float b) {
  f32x2_t v = {a, b};
  bf16x2_t r = __builtin_convertvector(v, bf16x2_t);
  return *(unsigned*)&r;
}
__device__ __forceinline__ u16 f2bf(float f) { return (u16)(pk2(f, 0.f) & 0xffffu); }
__device__ __forceinline__ float bf2f(unsigned h) { return __uint_as_float(h << 16); }
__device__ __forceinline__ float bflo(unsigned w) { return __uint_as_float(w << 16); }
__device__ __forceinline__ float bfhi(unsigned w) { return __uint_as_float(w & 0xffff0000u); }
__device__ __forceinline__ float sigmoidf_(float x) { return __builtin_amdgcn_rcpf(1.0f + __expf(-x)); }

__device__ __forceinline__ int fresh_lane() { int x; asm volatile("v_mbcnt_lo_u32_b32 %0, -1, 0\n\tv_mbcnt_hi_u32_b32 %0, -1, %0" : "=v"(x)); return x; }
#define PHASE_TID const int tid = wave0 * 64 + fresh_lane(); const int lane = tid & 63, wave = tid >> 6; (void)lane; (void)wave;
template <int CTRL>
__device__ __forceinline__ float dppf(float x) {
  return __int_as_float(__builtin_amdgcn_update_dpp(0, __float_as_int(x), CTRL, 0xF, 0xF, true));
}
__device__ __forceinline__ float sum8(float x) {
  x += dppf<0xB1>(x);
  x += dppf<0x4E>(x);
  x += dppf<0x141>(x);
  return x;
}
__device__ __forceinline__ float sum16(float x) {
  x = sum8(x);
  x += dppf<0x140>(x);
  return x;
}
__device__ __forceinline__ float shx(float x, int lane, int o) {
  return __int_as_float(__builtin_amdgcn_ds_bpermute((lane ^ o) << 2, __float_as_int(x)));
}
__device__ __forceinline__ float wave_sum(float x, int lane) {
  x = sum16(x);
  x += shx(x, lane, 16);
  x += shx(x, lane, 32);
  return x;
}

constexpr int BM = 128, BN = 128, BK = 64, LDT = 64;
constexpr int SMEM_BYTES = 73728;

template <int MODE>
struct AL {
  const void* base;
  int ld;
  int row0;
  int t0;
  int kvalid;
  const float* mu;
  int fn;
  struct Raw { uint4 x, y; };
  __device__ __forceinline__ Raw fetch(int r, int k) const {
    Raw w;
    { unsigned z = (MODE == 3) ? (unsigned)launder(0) : 0u; w.x = make_uint4(z, z, z, z); w.y = w.x; }
    if (MODE == 0) {
      const float* p = (const float*)base + (size_t)(row0 + r) * ld + k;
      w.x = *(const uint4*)p;
      w.y = *(const uint4*)(p + 4);
    } else if (MODE == 1) {
      const u16* p = (const u16*)base + (size_t)(row0 + r) * ld + k;
      w.x = *(const uint4*)p;
    } else if (MODE == 4) {
      const float* p = (const float*)base + (size_t)(row0 + r) * ld + k;
      float4 a = *(const float4*)p, b = *(const float4*)(p + 4);
      w.x = make_uint4(pk2(a.x, a.y), pk2(a.z, a.w), pk2(b.x, b.y), pk2(b.z, b.w));
    } else if (MODE == 2) {
      int t = t0 + r;
      if (t >= 0 && t < T_) {
        const float* p = (const float*)base + (size_t)(row0 + t) * ld + k;
        w.x = *(const uint4*)p;
        w.y = *(const uint4*)(p + 4);
      }
    } else {
      int row = row0 + r;
      int t = row % T_;
      if (k < kvalid) {
        const u16* p = (const u16*)base + (size_t)row * ld + k;
        w.x = *(const uint4*)p;
        if (t > 0) w.y = *(const uint4*)(p - ld);
      }
    }
    return w;
  }
  __device__ __forceinline__ uint4 cvt(const Raw& w, int k) const {
    if (MODE == 0 || MODE == 2) {
      uint4 o;
      o.x = pk2(__uint_as_float(w.x.x), __uint_as_float(w.x.y));
      o.y = pk2(__uint_as_float(w.x.z), __uint_as_float(w.x.w));
      o.z = pk2(__uint_as_float(w.y.x), __uint_as_float(w.y.y));
      o.w = pk2(__uint_as_float(w.y.z), __uint_as_float(w.y.w));
      return o;
    } else if (MODE == 1 || MODE == 4) {
      return w.x;
    } else {
      if (k >= kvalid) { unsigned z = (unsigned)launder(0); return make_uint4(z, z, z, z); }
      unsigned cw[4] = {w.x.x, w.x.y, w.x.z, w.x.w};
      unsigned pw[4] = {w.y.x, w.y.y, w.y.z, w.y.w};
      unsigned ow[4];
#pragma unroll
      for (int e = 0; e < 4; e++) {
        float x0 = bflo(cw[e]), x1 = bfhi(cw[e]);
        float p0 = bflo(pw[e]), p1 = bfhi(pw[e]);
        float v0 = x0 + (p0 - x0) * mu[k + 2 * e];
        float v1 = x1 + (p1 - x1) * mu[k + 2 * e + 1];
        if (fn == 0) {
          v0 = 1.0f - 2.0f * __builtin_amdgcn_rcpf(__expf(2.0f * v0) + 1.0f);
          v1 = 1.0f - 2.0f * __builtin_amdgcn_rcpf(__expf(2.0f * v1) + 1.0f);
        } else if (fn == 2) {
          v0 = sigmoidf_(v0);
          v1 = sigmoidf_(v1);
        }
        ow[e] = pk2(v0, v1);
      }
      return make_uint4(ow[0], ow[1], ow[2], ow[3]);
    }
  }
};

template <int NI>
__device__ __forceinline__ void zero_acc(f32x4 (&acc)[4][NI]) {
#pragma unroll
  for (int i = 0; i < 4; i++)
#pragma unroll
    for (int j = 0; j < NI; j++) acc[i][j] = f32x4{0.f, 0.f, 0.f, 0.f};
}

#define REP4(X) X(0) X(1) X(2) X(3)
template <class ALT, int NI>
__device__ __forceinline__ void gemm_loop(f32x4 (&acc)[4][NI], const ALT& al, const u16* __restrict__ Bt, int ldb, int n0,
                                          int K, char* smem, const int tid) {
  const int lane = tid & 63, wave = tid >> 6;
  const int wr = wave >> 1, wc = wave & 1, fr = lane & 15, fq = lane >> 4;
  const int lr = tid >> 3, lk = (tid & 7) * 8, lsw = ((tid & 7) ^ (lr & 7)) * 8;
  u16* sa = (u16*)smem;
  u16* sb = sa + 2 * BM * LDT;
  typename ALT::Raw ra0, ra1, ra2, ra3;
  uint4 rb0 = make_uint4(0,0,0,0), rb1 = rb0, rb2 = rb0, rb3 = rb0;
  const u16* bp = Bt + (size_t)(n0 + lr) * ldb + lk;
#define GL_FETCH(i) ra##i = al.fetch(lr + 32 * i, kf); if (i < NI) rb##i = *(const uint4*)(bp + (size_t)(32 * i) * ldb + kb);
#define GL_STORE(i) *(uint4*)(a_ + (lr + 32 * i) * LDT + lsw) = al.cvt(ra##i, kt * BK + lk); if (i < NI) *(uint4*)(b_ + (lr + 32 * i) * LDT + lsw) = rb##i;
  {
    const int kf = lk, kb = 0;
    REP4(GL_FETCH)
  }
  const int nk = K / BK;
  for (int kt = 0; kt < nk; kt++) {
    u16* a_ = sa + (kt & 1) * BM * LDT;
    u16* b_ = sb + (kt & 1) * BN * LDT;
    REP4(GL_STORE)
    __syncthreads();
    if (kt + 1 < nk) {
      const int kf = (kt + 1) * BK + lk, kb = (kt + 1) * BK;
      REP4(GL_FETCH)
    }
#pragma unroll
    for (int ks = 0; ks < 2; ks++) {
      bf16x8 af[4], bf[NI];
#pragma unroll
      for (int i = 0; i < 4; i++) af[i] = *(const bf16x8*)(a_ + (wr * 64 + i * 16 + fr) * LDT + (((ks * 4 + fq) ^ (fr & 7)) * 8));
#pragma unroll
      for (int i = 0; i < NI; i++) bf[i] = *(const bf16x8*)(b_ + (wc * (NI * 16) + i * 16 + fr) * LDT + (((ks * 4 + fq) ^ (fr & 7)) * 8));
#pragma unroll
      for (int mi = 0; mi < 4; mi++)
#pragma unroll
        for (int ni = 0; ni < NI; ni++)
          acc[mi][ni] = __builtin_amdgcn_mfma_f32_16x16x32_bf16(af[mi], bf[ni], acc[mi][ni], 0, 0, 0);
    }
  }
  __syncthreads();
#undef GL_FETCH
#undef GL_STORE
}


struct ADma { const u16* base; int ld; int row0; int t0; const u16* zero; int mode; const char* wsb; };
constexpr int G3_STAGE = 12288;

template <int NI, bool SWAP = true>
__device__ __forceinline__ void gemm3(f32x4 (&acc)[8][NI], const ADma& a, const u16* __restrict__ Bt, int ldb, int n0, int K,
                                      char* smem, const int tid) {
  const int lane = tid & 63, wave = tid >> 6;
  const int wr = wave >> 1, wc = wave & 1, fr = lane & 15, fq = lane >> 4;
  const int kc8 = ((lane & 3) ^ ((4 - (lane >> 4)) & 3)) * 8;
  const int psw = (fq ^ ((4 - (fr >> 2)) & 3)) * 8;
  u16* sm = (u16*)smem;
  const u16* ap0 = nullptr;
  unsigned ao0 = 0, ao1 = 0, ao2 = 0, ao3 = 0;
  if (a.mode == 0) {
    ap0 = a.base + (size_t)(a.row0 + wave * 64 + (lane >> 2)) * a.ld + kc8;
  } else {
    const unsigned bo = (unsigned)((const char*)a.base - a.wsb), zo = (unsigned)((const char*)a.zero - a.wsb) + kc8 * 2;
#define G3_AP(j)                                                                          \
    {                                                                                     \
      int t = a.t0 + wave * 64 + j * 16 + (lane >> 2);                                    \
      ao##j = (t >= 0 && t < T_) ? bo + (unsigned)(((a.row0 + t) * a.ld + kc8) * 2) : zo; \
    }
    REP4(G3_AP)
#undef G3_AP
  }
  const u16* bp0 = Bt + (size_t)(n0 + wave * (8 * NI) + (lane >> 2)) * ldb + kc8;
  const size_t astep = (size_t)16 * a.ld;
  const size_t bstep = (size_t)16 * ldb;
#define G3_ISSUE(j)                                                                                                              \
  __builtin_amdgcn_global_load_lds((a.mode == 0) ? (const unsigned*)(ap0 + j * astep + kof) : (const unsigned*)(a.wsb + ao##j + kof * 2), (unsigned*)(st_ + (wave * 64 + j * 16) * 32 + lane * 8), 16, 0, 0); \
  if (2 * j < NI) __builtin_amdgcn_global_load_lds((const unsigned*)(bp0 + j * bstep + kof), (unsigned*)(st_ + 8192 + (wave * (8 * NI) + j * 16) * 32 + lane * 8), 16, 0, 0);
  const int nk = K / 32;
  asm volatile("s_waitcnt vmcnt(0)" ::: "memory");
  {
    const int kof = 0;
    u16* st_ = sm;
    REP4(G3_ISSUE)
  }
  if (nk > 1) {
    const int kof = 32;
    u16* st_ = sm + G3_STAGE;
    REP4(G3_ISSUE)
  }
  int cur = 0, nxt = 2;
  const unsigned lds0 = (unsigned)(size_t)(__attribute__((address_space(3))) char*)smem;
  const unsigned aoff = lds0 + (unsigned)(((wr * 128 + fr) * 32 + psw) * 2);
  const unsigned boff = lds0 + 16384u + (unsigned)(((wc * (NI * 16) + fr) * 32 + psw) * 2);
#define G3_DSR(dst, addr, off) asm volatile("ds_read_b128 %0, %1 offset:" #off : "=v"(dst) : "v"(addr))
  for (int kt = 0; kt < nk; kt++) {
    if (kt + 1 < nk) {
      if (NI == 4) asm volatile("s_waitcnt vmcnt(6)" ::: "memory");
      else asm volatile("s_waitcnt vmcnt(5)" ::: "memory");
    } else {
      asm volatile("s_waitcnt vmcnt(0)" ::: "memory");
    }
    __builtin_amdgcn_s_barrier();
    if (kt + 2 < nk) {
      const int kof = (kt + 2) * 32;
      u16* st_ = sm + nxt * G3_STAGE;
      REP4(G3_ISSUE)
    }
    const unsigned aaddr = aoff + (unsigned)cur * (G3_STAGE * 2);
    const unsigned baddr = boff + (unsigned)cur * (G3_STAGE * 2);
    bf16x8 af[8], bf[NI];
    G3_DSR(af[0], aaddr, 0); G3_DSR(af[1], aaddr, 1024); G3_DSR(af[2], aaddr, 2048); G3_DSR(af[3], aaddr, 3072);
    G3_DSR(bf[0], baddr, 0); G3_DSR(bf[1], baddr, 1024);
    if (NI == 4) { G3_DSR(bf[NI - 2], baddr, 2048); G3_DSR(bf[NI - 1], baddr, 3072); }
    G3_DSR(af[4], aaddr, 4096); G3_DSR(af[5], aaddr, 5120); G3_DSR(af[6], aaddr, 6144); G3_DSR(af[7], aaddr, 7168);
    if (NI == 4) {
      asm volatile("s_waitcnt lgkmcnt(4)"
                   : "+v"(af[0]), "+v"(af[1]), "+v"(af[2]), "+v"(af[3]), "+v"(bf[0]), "+v"(bf[1]), "+v"(bf[NI - 2]), "+v"(bf[NI - 1]));
    } else {
      asm volatile("s_waitcnt lgkmcnt(4)" : "+v"(af[0]), "+v"(af[1]), "+v"(af[2]), "+v"(af[3]), "+v"(bf[0]), "+v"(bf[1]));
    }
#pragma unroll
    for (int mi = 0; mi < 4; mi++)
#pragma unroll
      for (int ni = 0; ni < NI; ni++)
        acc[mi][ni] = SWAP ? __builtin_amdgcn_mfma_f32_16x16x32_bf16(bf[ni], af[mi], acc[mi][ni], 0, 0, 0)
                           : __builtin_amdgcn_mfma_f32_16x16x32_bf16(af[mi], bf[ni], acc[mi][ni], 0, 0, 0);
    asm volatile("s_waitcnt lgkmcnt(0)" : "+v"(af[4]), "+v"(af[5]), "+v"(af[6]), "+v"(af[7]));
#pragma unroll
    for (int mi = 4; mi < 8; mi++)
#pragma unroll
      for (int ni = 0; ni < NI; ni++)
        acc[mi][ni] = SWAP ? __builtin_amdgcn_mfma_f32_16x16x32_bf16(bf[ni], af[mi], acc[mi][ni], 0, 0, 0)
                           : __builtin_amdgcn_mfma_f32_16x16x32_bf16(af[mi], bf[ni], acc[mi][ni], 0, 0, 0);
    cur = (cur == 2) ? 0 : cur + 1;
    nxt = (nxt == 2) ? 0 : nxt + 1;
  }
  asm volatile("s_waitcnt lgkmcnt(0)" ::: "memory");
  __syncthreads();
#undef G3_DSR
#undef G3_ISSUE
}

template <int NI>
__device__ __forceinline__ void zero_acc8(f32x4 (&acc)[8][NI]) {
#pragma unroll
  for (int i = 0; i < 8; i++)
#pragma unroll
    for (int j = 0; j < NI; j++) acc[i][j] = f32x4{0.f, 0.f, 0.f, 0.f};
}


__device__ __forceinline__ bool map_tile(int i, int nblk, int MT, int NT, int& mt, int& nt) {
  const int locs = nblk >> 3;
  const int xcd = blockIdx.x & 7, loc = blockIdx.x >> 3;
  const int q = (i * 8 + xcd) * locs + loc;
  if (q >= MT * NT) return false;
  const int nfull = NT >> 3, per = MT * 8;
  if (q < nfull * per) {
    int pp = q / per, r = q - pp * per;
    mt = r >> 3;
    nt = pp * 8 + (r & 7);
  } else {
    int r = q - nfull * per;
    int w = NT - nfull * 8;
    mt = r / w;
    nt = nfull * 8 + (r - mt * w);
  }
  return true;
}

#define ACC_COORDS const int wr = wave >> 1, wc = wave & 1, fr = lane & 15, fq = lane >> 4;

__device__ __forceinline__ void conv_tile(const Params& p, int t, char* smem, const int tid) {
  int j = 0;
#pragma unroll 1
  for (int i = 1; i < 26; i++)
    if (t >= p.jobs[i].tile0) j = i;
  const Job& jb = p.jobs[j];
  float(*tile)[65] = (float(*)[65])smem;
  int local = t - jb.tile0;
  int nkt = jb.Kpad >> 6;
  int kt = local % nkt, nt = local / nkt;
  int tx = tid & 63, ty = tid >> 6;
  int n = nt * 64 + tx;
  int col;
  if (jb.mode == 0) col = jb.c0 + n;
  else { int jn = n >> 7, i = n & 127; col = (i < 64) ? (64 * jn + i) : (DFF_ + 64 * jn + (i - 64)); }
  const float* sp = jb.src + col;
  const int K = jb.K, ld = jb.ld;
  const bool nok = n < jb.Nv;
#pragma unroll
  for (int i = 0; i < 16; i++) {
    int k = kt * 64 + ty + 4 * i;
    tile[ty + 4 * i][tx] = (nok && k < K) ? sp[(size_t)k * ld] : 0.f;
  }
  __syncthreads();
#pragma unroll
  for (int i = 0; i < 16; i++) {
    int nn = nt * 64 + ty + 4 * i;
    int k = kt * 64 + tx;
    jb.dst[(size_t)nn * jb.Kpad + k] = f2bf(tile[tx][ty + 4 * i]);
  }
  __syncthreads();
}

__device__ __forceinline__ void ln_row(const float* __restrict__ src, const float* __restrict__ g,
                                       const float* __restrict__ b, float* __restrict__ dst, int lane, u16* __restrict__ dstb = nullptr) {
  float4 v[4];
  float s = 0.f;
#pragma unroll
  for (int i = 0; i < 4; i++) {
    v[i] = *(const float4*)(src + i * 256 + lane * 4);
    s += v[i].x + v[i].y + v[i].z + v[i].w;
  }
  float mean = wave_sum(s, lane) * (1.0f / 1024.0f);
  float q = 0.f;
#pragma unroll
  for (int i = 0; i < 4; i++) {
    float a = v[i].x - mean, b2 = v[i].y - mean, c = v[i].z - mean, d = v[i].w - mean;
    q += a * a + b2 * b2 + c * c + d * d;
  }
  float rstd = rsqrtf(wave_sum(q, lane) * (1.0f / 1024.0f) + 1e-5f);
#pragma unroll
  for (int i = 0; i < 4; i++) {
    float4 gg = *(const float4*)(g + i * 256 + lane * 4);
    float4 bb = *(const float4*)(b + i * 256 + lane * 4);
    float4 o;
    o.x = (v[i].x - mean) * rstd * gg.x + bb.x;
    o.y = (v[i].y - mean) * rstd * gg.y + bb.y;
    o.z = (v[i].z - mean) * rstd * gg.z + bb.z;
    o.w = (v[i].w - mean) * rstd * gg.w + bb.w;
    *(float4*)(dst + i * 256 + lane * 4) = o;
    if (dstb) *(uint2*)(dstb + i * 256 + lane * 4) = make_uint2(pk2(o.x, o.y), pk2(o.z, o.w));
  }
}

__device__ __forceinline__ void ln_row2(const float* __restrict__ srcA, const float* __restrict__ srcB, const float* __restrict__ g,
                                        const float* __restrict__ b, float* dstA, float* dstB, int lane, u16* dbA, u16* dbB) {
  float4 va[4], vb[4];
  float sa = 0.f, sb = 0.f;
#pragma unroll
  for (int i = 0; i < 4; i++) {
    va[i] = *(const float4*)(srcA + i * 256 + lane * 4);
    vb[i] = *(const float4*)(srcB + i * 256 + lane * 4);
  }
#pragma unroll
  for (int i = 0; i < 4; i++) {
    sa += va[i].x + va[i].y + va[i].z + va[i].w;
    sb += vb[i].x + vb[i].y + vb[i].z + vb[i].w;
  }
  const float ma = wave_sum(sa, lane) * (1.0f / 1024.0f), mb = wave_sum(sb, lane) * (1.0f / 1024.0f);
  float qa = 0.f, qb = 0.f;
#pragma unroll
  for (int i = 0; i < 4; i++) {
    va[i].x -= ma; va[i].y -= ma; va[i].z -= ma; va[i].w -= ma;
    vb[i].x -= mb; vb[i].y -= mb; vb[i].z -= mb; vb[i].w -= mb;
    qa += va[i].x * va[i].x + va[i].y * va[i].y + va[i].z * va[i].z + va[i].w * va[i].w;
    qb += vb[i].x * vb[i].x + vb[i].y * vb[i].y + vb[i].z * vb[i].z + vb[i].w * vb[i].w;
  }
  const float ra = rsqrtf(wave_sum(qa, lane) * (1.0f / 1024.0f) + 1e-5f), rb = rsqrtf(wave_sum(qb, lane) * (1.0f / 1024.0f) + 1e-5f);
#pragma unroll
  for (int i = 0; i < 4; i++) {
    float4 gg = *(const float4*)(g + i * 256 + lane * 4);
    float4 bb = *(const float4*)(b + i * 256 + lane * 4);
    float4 oa, ob;
    oa.x = va[i].x * ra * gg.x + bb.x; oa.y = va[i].y * ra * gg.y + bb.y; oa.z = va[i].z * ra * gg.z + bb.z; oa.w = va[i].w * ra * gg.w + bb.w;
    ob.x = vb[i].x * rb * gg.x + bb.x; ob.y = vb[i].y * rb * gg.y + bb.y; ob.z = vb[i].z * rb * gg.z + bb.z; ob.w = vb[i].w * rb * gg.w + bb.w;
    *(float4*)(dstA + i * 256 + lane * 4) = oa;
    *(float4*)(dstB + i * 256 + lane * 4) = ob;
    if (dbA) {
      *(uint2*)(dbA + i * 256 + lane * 4) = make_uint2(pk2(oa.x, oa.y), pk2(oa.z, oa.w));
      *(uint2*)(dbB + i * 256 + lane * 4) = make_uint2(pk2(ob.x, ob.y), pk2(ob.z, ob.w));
    }
  }
}

struct ScanIn {
  float kk[16][64], wr[16][64], w[16][64], kt[16][64], kka[16][64], v[16][64], g[16][64];
  float c[16][4];
};
struct ScanRaw { uint2 r, k, v, rp, kp, vp, a, g; float4 dec; };

__device__ __forceinline__ ScanRaw scan_fetch(const u16* __restrict__ P, const float* __restrict__ DEC,
                                              const u16* __restrict__ AA, const u16* __restrict__ GG, int rowbase, int t,
                                              int hc) {
  ScanRaw w;
  size_t row = (size_t)(rowbase + t);
  const u16* pp = P + row * PC_ + hc;
  w.r = *(const uint2*)(pp);
  w.k = *(const uint2*)(pp + 512);
  w.v = *(const uint2*)(pp + 1024);
  if (t > 0) {
    w.rp = *(const uint2*)(pp - PC_);
    w.kp = *(const uint2*)(pp - PC_ + 512);
    w.vp = *(const uint2*)(pp - PC_ + 1024);
  } else {
    w.rp = make_uint2(0, 0); w.kp = make_uint2(0, 0); w.vp = make_uint2(0, 0);
  }
  w.dec = *(const float4*)(DEC + row * 512 + hc);
  w.a = *(const uint2*)(AA + row * 512 + hc);
  w.g = *(const uint2*)(GG + row * 512 + hc);
  return w;
}

__device__ __forceinline__ void unpack4(uint2 u, float (&o)[4]) {
  o[0] = bflo(u.x); o[1] = bfhi(u.x); o[2] = bflo(u.y); o[3] = bfhi(u.y);
}

__device__ __forceinline__ void scan_unit(const Params& p, int l, int bh, char* smem, const int tid) {
  const int lane = tid & 63, wave = tid >> 6;
  const int b = bh >> 3, h = bh & 7;
  const int rowbase = b * T_;
  const u16* P = (const u16*)(p.ws + OFF_P);
  const float* DEC = (const float*)(p.ws + OFF_DEC);
  const u16* AA = (const u16*)(p.ws + OFF_AA);
  const u16* GG = (const u16*)(p.ws + OFF_GG);
  u16* YR = (u16*)(p.ws + OFF_AA);
  ScanIn* in = (ScanIn*)smem;
  float(*ybuf)[64] = (float(*)[64])(smem + 2 * sizeof(ScanIn));
  const int tl = tid >> 4, kq = tid & 15, hc = h * 64 + kq * 4;
  float(*cst)[64] = (float(*)[64])(smem + 2 * sizeof(ScanIn) + 16 * 64 * 4);
  if (tid < 64) {
    const float* mu = p.in[5] + (size_t)l * 1824;
    const int ch = h * 64 + tid;
    cst[0][tid] = mu[ch];
    cst[1][tid] = mu[512 + ch];
    cst[2][tid] = mu[1024 + ch];
    cst[3][tid] = p.in[11][l * 512 + ch];
    float ka_ = p.in[12][l * 512 + ch];
    cst[4][tid] = ka_;
    cst[5][tid] = 1.0f - ka_;
    cst[6][tid] = p.in[13][l * 512 + ch];
    cst[7][tid] = p.in[14][l * 512 + ch];
    cst[8][tid] = p.in[15][l * 512 + ch];
  }
  __syncthreads();
  const int rp = lane >> 3, ks = lane & 7, row0 = wave * 16 + rp * 2;
  typedef float f2s __attribute__((ext_vector_type(2)));
  f2s S2[2][4];
#pragma unroll
  for (int i = 0; i < 2; i++)
#pragma unroll
    for (int e = 0; e < 4; e++) S2[i][e] = f2s{0.f, 0.f};

  auto stage = [&](const ScanRaw& w, ScanIn& dst) {
    float r[4], k[4], v[4], rq[4], kp[4], vp[4], a[4], g[4];
    unpack4(w.r, r); unpack4(w.k, k); unpack4(w.v, v);
    unpack4(w.rp, rq); unpack4(w.kp, kp); unpack4(w.vp, vp);
    unpack4(w.a, a); unpack4(w.g, g);
    float dec[4] = {w.dec.x, w.dec.y, w.dec.z, w.dec.w};
    float mu_r[4], mu_k[4], mu_v[4], kkw[4], kaw[4], omk[4], rkw[4];
    *(float4*)mu_r = *(const float4*)&cst[0][kq * 4]; *(float4*)mu_k = *(const float4*)&cst[1][kq * 4];
    *(float4*)mu_v = *(const float4*)&cst[2][kq * 4]; *(float4*)kkw = *(const float4*)&cst[3][kq * 4];
    *(float4*)kaw = *(const float4*)&cst[4][kq * 4]; *(float4*)omk = *(const float4*)&cst[5][kq * 4];
    *(float4*)rkw = *(const float4*)&cst[6][kq * 4];
    float kkr[4], ss = 0.f;
#pragma unroll
    for (int e = 0; e < 4; e++) {
      r[e] = r[e] + (rq[e] - r[e]) * mu_r[e];
      k[e] = k[e] + (kp[e] - k[e]) * mu_k[e];
      v[e] = v[e] + (vp[e] - v[e]) * mu_v[e];
      kkr[e] = k[e] * kkw[e];
      ss += kkr[e] * kkr[e];
    }
    ss = sum16(ss);
    float inv = rsqrtf(fmaxf(ss, 1e-24f));
    float c1 = 0.f, c2 = 0.f, c3 = 0.f;
    float kk[4], ktl[4], kka[4], wr[4];
#pragma unroll
    for (int e = 0; e < 4; e++) {
      kk[e] = kkr[e] * inv;
      ktl[e] = k[e] * fmaf(a[e], kaw[e], omk[e]);
      kka[e] = kk[e] * a[e];
      wr[e] = dec[e] * r[e];
      c1 += kka[e] * r[e];
      c2 += ktl[e] * r[e];
      c3 += r[e] * ktl[e] * rkw[e];
    }
    c1 = sum16(c1); c2 = sum16(c2); c3 = sum16(c3);
    *(float4*)&dst.kk[tl][kq * 4] = make_float4(kk[0], kk[1], kk[2], kk[3]);
    *(float4*)&dst.wr[tl][kq * 4] = make_float4(wr[0], wr[1], wr[2], wr[3]);
    *(float4*)&dst.w[tl][kq * 4] = make_float4(dec[0], dec[1], dec[2], dec[3]);
    *(float4*)&dst.kt[tl][kq * 4] = make_float4(ktl[0], ktl[1], ktl[2], ktl[3]);
    *(float4*)&dst.kka[tl][kq * 4] = make_float4(kka[0], kka[1], kka[2], kka[3]);
    *(float4*)&dst.v[tl][kq * 4] = make_float4(v[0], v[1], v[2], v[3]);
    *(float4*)&dst.g[tl][kq * 4] = make_float4(g[0], g[1], g[2], g[3]);
    if (kq == 0) *(float4*)&dst.c[tl][0] = make_float4(c1, c2, c3, 0.f);
  };

  {
    ScanRaw w0 = scan_fetch(P, DEC, AA, GG, rowbase, tl, hc);
    stage(w0, in[0]);
  }
  __syncthreads();
  constexpr int NCH = T_ / 16;
  for (int c = 0; c < NCH; c++) {
    ScanIn& cur = in[c & 1];
    ScanRaw nx;
    const bool have_next = (c + 1 < NCH);
    if (have_next) nx = scan_fetch(P, DEC, AA, GG, rowbase, (c + 1) * 16 + tl, hc);
    {
      typedef float f2 __attribute__((ext_vector_type(2)));
      struct StepA { float4 kk0, kk1, wr0, wr1; };
      struct StepIn { float4 kk0, kk1, wr0, wr1, w0, w1, kt0, kt1, ka0, ka1; float2 vv, cc; };
      auto ldA = [&](int s) {
        StepA r;
        r.kk0 = *(const float4*)&cur.kk[s][ks * 8]; r.kk1 = *(const float4*)&cur.kk[s][ks * 8 + 4];
        r.wr0 = *(const float4*)&cur.wr[s][ks * 8]; r.wr1 = *(const float4*)&cur.wr[s][ks * 8 + 4];
        return r;
      };
      StepA nxa = ldA(0);
#pragma unroll 1
      for (int s4 = 0; s4 < 16; s4 += 4) {
      float yv[4][2];
#pragma unroll
      for (int u = 0; u < 4; u++) {
        const int s = s4 + u;
        StepIn in_;
        in_.kk0 = nxa.kk0; in_.kk1 = nxa.kk1; in_.wr0 = nxa.wr0; in_.wr1 = nxa.wr1;
        in_.vv = *(const float2*)&cur.v[s][row0];
        in_.cc = *(const float2*)&cur.c[s][0];
        in_.w0 = *(const float4*)&cur.w[s][ks * 8];   in_.w1 = *(const float4*)&cur.w[s][ks * 8 + 4];
        in_.kt0 = *(const float4*)&cur.kt[s][ks * 8]; in_.kt1 = *(const float4*)&cur.kt[s][ks * 8 + 4];
        in_.ka0 = *(const float4*)&cur.kka[s][ks * 8]; in_.ka1 = *(const float4*)&cur.kka[s][ks * 8 + 4];
        nxa = ldA((s + 1) & 15);
        const f2 kk[4] = {{in_.kk0.x, in_.kk0.y}, {in_.kk0.z, in_.kk0.w}, {in_.kk1.x, in_.kk1.y}, {in_.kk1.z, in_.kk1.w}};
        const f2 wr[4] = {{in_.wr0.x, in_.wr0.y}, {in_.wr0.z, in_.wr0.w}, {in_.wr1.x, in_.wr1.y}, {in_.wr1.z, in_.wr1.w}};
        const f2 w[4] = {{in_.w0.x, in_.w0.y}, {in_.w0.z, in_.w0.w}, {in_.w1.x, in_.w1.y}, {in_.w1.z, in_.w1.w}};
        const f2 kt[4] = {{in_.kt0.x, in_.kt0.y}, {in_.kt0.z, in_.kt0.w}, {in_.kt1.x, in_.kt1.y}, {in_.kt1.z, in_.kt1.w}};
        const f2 ka[4] = {{in_.ka0.x, in_.ka0.y}, {in_.ka0.z, in_.ka0.w}, {in_.ka1.x, in_.ka1.y}, {in_.ka1.z, in_.ka1.w}};
        const float vr[2] = {in_.vv.x, in_.vv.y};
        float d1[2], d2[2];
#pragma unroll
        for (int i = 0; i < 2; i++) {
          f2 a = S2[i][0] * kk[0] + S2[i][1] * kk[1];
          f2 a2 = S2[i][2] * kk[2] + S2[i][3] * kk[3];
          f2 bq = S2[i][0] * wr[0] + S2[i][1] * wr[1];
          f2 b2 = S2[i][2] * wr[2] + S2[i][3] * wr[3];
          a += a2; bq += b2;
          d1[i] = a.x + a.y;
          d2[i] = bq.x + bq.y;
        }
        d1[0] = sum8(d1[0]); d1[1] = sum8(d1[1]); d2[0] = sum8(d2[0]); d2[1] = sum8(d2[1]);
#pragma unroll
        for (int i = 0; i < 2; i++) {
          const float skk = d1[i];
          yv[u][i] = d2[i] - skk * in_.cc.x + vr[i] * in_.cc.y;
          const f2 nsk = {-skk, -skk}, vv2 = {vr[i], vr[i]};
#pragma unroll
          for (int e = 0; e < 4; e++) S2[i][e] = S2[i][e] * w[e] + (nsk * ka[e] + vv2 * kt[e]);
        }
      }
      if (ks == 0) {
#pragma unroll
        for (int u = 0; u < 4; u++) *(float2*)&ybuf[s4 + u][row0] = make_float2(yv[u][0], yv[u][1]);
      }
      }
    }
    __syncthreads();
    {
      float4 y4 = *(const float4*)&ybuf[tl][kq * 4];
      float y[4] = {y4.x, y4.y, y4.z, y4.w};
      float mean = sum16(y[0] + y[1] + y[2] + y[3]) * (1.0f / 64.0f);
      float q = 0.f;
#pragma unroll
      for (int e = 0; e < 4; e++) { y[e] -= mean; q += y[e] * y[e]; }
      float rstd = rsqrtf(sum16(q) * (1.0f / 64.0f) + 64e-5f);
      float c3 = cur.c[tl][2];
      float4 v4 = *(const float4*)&cur.v[tl][kq * 4];
      float4 g4 = *(const float4*)&cur.g[tl][kq * 4];
      float vv[4] = {v4.x, v4.y, v4.z, v4.w};
      float gg[4] = {g4.x, g4.y, g4.z, g4.w};
      float o[4], lg[4], lb[4];
      *(float4*)lg = *(const float4*)&cst[7][kq * 4]; *(float4*)lb = *(const float4*)&cst[8][kq * 4];
#pragma unroll
      for (int e = 0; e < 4; e++) o[e] = (y[e] * rstd * lg[e] + lb[e] + c3 * vv[e]) * gg[e];
      size_t row = (size_t)(rowbase + c * 16 + tl);
      *(uint2*)(YR + row * 512 + hc) = make_uint2(pk2(o[0], o[1]), pk2(o[2], o[3]));
    }
    if (have_next) stage(nx, in[(c + 1) & 1]);
    __syncthreads();
  }
}

constexpr int KLD = 104, VLD = 72;
struct AttnSmem { u16 k[2][64 * KLD]; u16 v[2][64 * VLD]; };

__device__ __forceinline__ void attn_unit(const Params& p, int bh, int qi, char* smem, const int tid) {
  const int lane = tid & 63, wave = tid >> 6;
  const int fr = lane & 15, fq = lane >> 4;
  const int b = bh >> 3, h = bh & 7;
  const int rowbase = b * T_;
  u16* P = (u16*)(p.ws + OFF_P);
  const u16* Q = (const u16*)(p.ws + OFF_Q);
  const u16* KN = (const u16*)p.out;
  const u16* VT = (const u16*)p.out + (size_t)M_ * 512;
  const float2* ROPE = (const float2*)(p.ws + OFF_ROPE);
  AttnSmem* sm = (AttnSmem*)smem;
  const int qs = (qi == 0) ? 0 : 16 + (qi - 1) * 128;
  const int qn = (qi == 0) ? 16 : 128;
  const int q0 = qs + wave * 32;
  const bool wave_valid = (wave * 32 < qn);
  const int nkt = (qs + qn - 1) / 64 + 1;

  bf16x8 qf[2][3];
#pragma unroll
  for (int qb = 0; qb < 2; qb++) {
    int query = min(q0 + qb * 16 + fr, T_ - 1);
    const u16* qp = Q + (size_t)(rowbase + query) * 768 + h * 96;
    uint4 a0 = *(const uint4*)(qp + fq * 8);
    uint4 a1 = *(const uint4*)(qp + 32 + fq * 8);
    uint4 own = *(const uint4*)(qp + 64 + fq * 8);
    uint4 oth = *(const uint4*)(qp + 64 + (fq ^ 2) * 8);
    unsigned ow[4] = {own.x, own.y, own.z, own.w};
    unsigned tw[4] = {oth.x, oth.y, oth.z, oth.w};
    unsigned rw[4];
    const float2* rp = ROPE + (size_t)query * 16 + (fq & 1) * 8;
#pragma unroll
    for (int e = 0; e < 4; e++) {
      float2 cs0 = rp[2 * e], cs1 = rp[2 * e + 1];
      float o0 = bflo(ow[e]), o1 = bfhi(ow[e]);
      float t0 = bflo(tw[e]), t1 = bfhi(tw[e]);
      float r0, r1;
      if (fq < 2) { r0 = o0 * cs0.x - t0 * cs0.y; r1 = o1 * cs1.x - t1 * cs1.y; }
      else { r0 = t0 * cs0.y + o0 * cs0.x; r1 = t1 * cs1.y + o1 * cs1.x; }
      rw[e] = pk2(r0, r1);
    }
    uint4 a2 = make_uint4(rw[0], rw[1], rw[2], rw[3]);
    qf[qb][0] = *(bf16x8*)&a0;
    qf[qb][1] = *(bf16x8*)&a1;
    qf[qb][2] = *(bf16x8*)&a2;
  }

  f32x4 O[4][2];
#pragma unroll
  for (int i = 0; i < 4; i++)
#pragma unroll
    for (int j = 0; j < 2; j++) O[i][j] = f32x4{0.f, 0.f, 0.f, 0.f};
  float mrun[2] = {-1e30f, -1e30f}, lrun[2] = {0.f, 0.f};
  const float sc = 1.4426950408889634f / 9.797958971132712f;

  uint4 rk[3], rv[2];
  auto fetch_tile = [&](int kt) {
#pragma unroll
    for (int i = 0; i < 3; i++) {
      int c = tid + 256 * i;
      int key = c / 12, cc = c % 12;
      int t = kt * 64 + key;
      uint4 val = make_uint4(0, 0, 0, 0);
      if (t < T_) {
        size_t row = (size_t)(rowbase + t);
        if (cc < 8) val = *(const uint4*)(KN + row * 512 + h * 64 + cc * 8);
        else val = *(const uint4*)(P + row * PC_ + PKR_ + (cc - 8) * 8);
      }
      rk[i] = val;
    }
#pragma unroll
    for (int i = 0; i < 2; i++) {
      int c = tid + 256 * i;
      int dv = c >> 3, cc = c & 7;
      int t = kt * 64 + cc * 8;
      uint4 val = make_uint4(0, 0, 0, 0);
      if (t < T_) val = *(const uint4*)(VT + ((size_t)bh * 64 + dv) * T_ + t);
      rv[i] = val;
    }
  };
  auto store_tile = [&](int buf) {
#pragma unroll
    for (int i = 0; i < 3; i++) {
      int c = tid + 256 * i;
      int key = c / 12, cc = c % 12;
      *(uint4*)(&sm->k[buf][key * KLD + cc * 8]) = rk[i];
    }
#pragma unroll
    for (int i = 0; i < 2; i++) {
      int c = tid + 256 * i;
      int dv = c >> 3, cc = c & 7;
      *(uint4*)(&sm->v[buf][dv * VLD + cc * 8]) = rv[i];
    }
  };

  fetch_tile(0);
  for (int kt = 0; kt < nkt; kt++) {
    const int buf = kt & 1;
    store_tile(buf);
    __syncthreads();
    if (kt + 1 < nkt) fetch_tile(kt + 1);
    if (wave_valid && kt * 64 <= q0 + 31) {
      const u16* Ks = sm->k[buf];
      const u16* Vs = sm->v[buf];
      f32x4 s[4][2];
#pragma unroll
      for (int i = 0; i < 4; i++)
#pragma unroll
        for (int j = 0; j < 2; j++) s[i][j] = f32x4{0.f, 0.f, 0.f, 0.f};
#pragma unroll
      for (int ks = 0; ks < 3; ks++)
#pragma unroll
        for (int kb = 0; kb < 4; kb++) {
          bf16x8 kf = *(const bf16x8*)(Ks + (kb * 16 + fr) * KLD + ks * 32 + fq * 8);
#pragma unroll
          for (int qb = 0; qb < 2; qb++) s[kb][qb] = __builtin_amdgcn_mfma_f32_16x16x32_bf16(kf, qf[qb][ks], s[kb][qb], 0, 0, 0);
        }
      const bool need_mask = (kt * 64 + 63 > q0);
      unsigned pfw[2][2][4];
#pragma unroll
      for (int qb = 0; qb < 2; qb++) {
        const int query = q0 + qb * 16 + fr;
        float mx = -1e30f;
        if (need_mask) {
#pragma unroll
          for (int kb = 0; kb < 4; kb++)
#pragma unroll
            for (int j = 0; j < 4; j++) {
              int key = kt * 64 + kb * 16 + fq * 4 + j;
              if (key > query) s[kb][qb][j] = -1e30f;
            }
        }
#pragma unroll
        for (int kb = 0; kb < 4; kb++)
          mx = fmaxf(mx, fmaxf(fmaxf(s[kb][qb][0], s[kb][qb][1]), fmaxf(s[kb][qb][2], s[kb][qb][3])));
        mx = fmaxf(mx, shx(mx, lane, 16));
        mx = fmaxf(mx, shx(mx, lane, 32));
        const float mold = mrun[qb];
        const float mnew = fmaxf(mold, mx * sc);
        mrun[qb] = mnew;
        float ps = 0.f;
#pragma unroll
        for (int kb = 0; kb < 4; kb++) {
          float p0 = __builtin_amdgcn_exp2f(fmaf(s[kb][qb][0], sc, -mnew)), p1 = __builtin_amdgcn_exp2f(fmaf(s[kb][qb][1], sc, -mnew));
          float p2 = __builtin_amdgcn_exp2f(fmaf(s[kb][qb][2], sc, -mnew)), p3 = __builtin_amdgcn_exp2f(fmaf(s[kb][qb][3], sc, -mnew));
          ps += (p0 + p1) + (p2 + p3);
          pfw[qb][kb >> 1][(kb & 1) * 2 + 0] = pk2(p0, p1);
          pfw[qb][kb >> 1][(kb & 1) * 2 + 1] = pk2(p2, p3);
        }
        if (__builtin_amdgcn_ballot_w64(mnew != mold) != 0) {
          const float alpha = __builtin_amdgcn_exp2f(mold - mnew);
          lrun[qb] *= alpha;
#pragma unroll
          for (int dvb = 0; dvb < 4; dvb++) {
            O[dvb][qb][0] *= alpha; O[dvb][qb][1] *= alpha; O[dvb][qb][2] *= alpha; O[dvb][qb][3] *= alpha;
          }
        }
        lrun[qb] += ps;
      }
#pragma unroll
      for (int s2 = 0; s2 < 2; s2++)
#pragma unroll
        for (int dvb = 0; dvb < 4; dvb++) {
          const u16* vp = Vs + (dvb * 16 + fr) * VLD + s2 * 32 + fq * 4;
          uint2 v0 = *(const uint2*)vp;
          uint2 v1 = *(const uint2*)(vp + 16);
          uint4 vv = make_uint4(v0.x, v0.y, v1.x, v1.y);
          bf16x8 vf = *(bf16x8*)&vv;
#pragma unroll
          for (int qb = 0; qb < 2; qb++) {
            uint4 pw = make_uint4(pfw[qb][s2][0], pfw[qb][s2][1], pfw[qb][s2][2], pfw[qb][s2][3]);
            O[dvb][qb] = __builtin_amdgcn_mfma_f32_16x16x32_bf16(vf, *(bf16x8*)&pw, O[dvb][qb], 0, 0, 0);
          }
        }
    }
  }
  __syncthreads();
  if (wave_valid) {
#pragma unroll
    for (int qb = 0; qb < 2; qb++) {
      float l = lrun[qb];
      l += shx(l, lane, 16);
      l += shx(l, lane, 32);
      float inv = 1.0f / l;
      int query = q0 + qb * 16 + fr;
      if (query < qs + qn) {
        u16* op = P + (size_t)(rowbase + query) * PC_ + PMLA_ + h * 64 + fq * 4;
#pragma unroll
        for (int dvb = 0; dvb < 4; dvb++) {
          *(uint2*)(op + dvb * 16) =
              make_uint2(pk2(O[dvb][qb][0] * inv, O[dvb][qb][1] * inv), pk2(O[dvb][qb][2] * inv, O[dvb][qb][3] * inv));
        }
      }
    }
  }
}

#define XB_TMO      128
#define XB_XCNT(j)  (256  + 64 * (j))
#define XB_XSUB(j)  (1280 + 64 * (j))
#define XB_XGEN(j)  (2304 + 64 * (j))
#define XB_TOP      3328
#define XB_TOPGEN   3392
#define XCD_BAR_WORDS 3456
#define XB_SPIN_CAP (1u << 18)
#define LAS __attribute__((address_space(3)))

__device__ __forceinline__ unsigned xb_ld(unsigned* p)              { return __hip_atomic_load(p, __ATOMIC_RELAXED, __HIP_MEMORY_SCOPE_AGENT); }
__device__ __forceinline__ unsigned xb_add(unsigned* p, unsigned v) { return __hip_atomic_fetch_add(p, v, __ATOMIC_RELAXED, __HIP_MEMORY_SCOPE_AGENT); }
__device__ __forceinline__ unsigned xb_xcc_id() { return (unsigned)__builtin_amdgcn_s_getreg((3 << 11) | 20) & 0xFu; }
#define XB_SPIN(cond, bar) do { unsigned _sp = 0; while (cond) { __builtin_amdgcn_s_sleep(1); \
    if ((++_sp & 255u) == 0u) { if (xb_ld(&(bar)[XB_TMO])) break; if (_sp > XB_SPIN_CAP) { atomicAdd(&(bar)[XB_TMO], 1u); break; } } } } while (0)

struct XcdBarrier {
    unsigned* bar; unsigned x;
    volatile LAS unsigned* st;
};

__device__ __forceinline__ XcdBarrier xcd_barrier_post(unsigned* bar, volatile LAS unsigned* st) {
    XcdBarrier b; b.bar = bar; b.x = xb_xcc_id(); b.st = st;
    if (threadIdx.x == 0) (void)xb_add(&bar[XB_XCNT(b.x)], 1u);
    return b;
}
__device__ __forceinline__ void xcd_barrier_complete(unsigned* bar, unsigned x, unsigned& nloc, unsigned& nx) {
    const unsigned G = gridDim.x * gridDim.y * gridDim.z;
    unsigned sum, cnt, mine, sp = 0u;
    for (;;) {
        sum = 0u; cnt = 0u; mine = 0u;
#pragma unroll
        for (unsigned j = 0; j < 16; ++j) { const unsigned c = xb_ld(&bar[XB_XCNT(j)]); sum += c; cnt += (c > 0u) ? 1u : 0u; mine = (j == x) ? c : mine; }
        if (sum == G) break;
        __builtin_amdgcn_s_sleep(1);
        if ((++sp & 255u) == 0u) { if (xb_ld(&bar[XB_TMO])) break; if (sp > XB_SPIN_CAP) { atomicAdd(&bar[XB_TMO], 1u); break; } }
    }
    nloc = mine > 0u ? mine : 1u; nx = cnt > 0u ? cnt : 1u;
}

__device__ __forceinline__ void xcd_barrier(const XcdBarrier& b, const int tid_) {
    asm volatile("s_waitcnt vmcnt(0)" ::: "memory");
    __syncthreads();
    if (tid_ == 0) {
        unsigned* bar = b.bar;
        __builtin_amdgcn_s_waitcnt(0);
        unsigned nloc = b.st[0], nx = b.st[1];
        if (nloc == 0u) { xcd_barrier_complete(bar, b.x, nloc, nx); b.st[0] = nloc; b.st[1] = nx; }
        const unsigned old = xb_add(&bar[XB_XSUB(b.x)], 1u);
        const unsigned gen = old / nloc;
        if (old + 1u == (gen + 1u) * nloc) {
            __builtin_amdgcn_fence(__ATOMIC_RELEASE, "agent");
            asm volatile("s_waitcnt vmcnt(0)" ::: "memory");
            const unsigned og = xb_add(&bar[XB_TOP], 1u);
            const unsigned tg = og / nx;
            if (og + 1u == (tg + 1u) * nx) xb_add(&bar[XB_TOPGEN], 1u);
            else XB_SPIN(xb_ld(&bar[XB_TOPGEN]) == tg, bar);
            __builtin_amdgcn_fence(__ATOMIC_ACQUIRE, "agent");
            xb_add(&bar[XB_XGEN(b.x)], 1u);
            asm volatile("s_waitcnt vmcnt(0)" ::: "memory");
        } else {
            XB_SPIN(xb_ld(&bar[XB_XGEN(b.x)]) == gen, bar);
            __builtin_amdgcn_fence(__ATOMIC_ACQUIRE, "agent");
            asm volatile("s_waitcnt vmcnt(0)" ::: "memory");
        }
    }
    __syncthreads();
}


__global__ void __launch_bounds__(256, 2) mega(Params p) {
  cg::grid_group grid = cg::this_grid();
  __shared__ __attribute__((aligned(16))) char smem[SMEM_BYTES];
  __shared__ int s_unit;
  __shared__ uint4 xb_words;
  if (threadIdx.x == 0) xb_words = make_uint4(0u, 0u, 0u, 0u);
  __syncthreads();
  (void)xcd_barrier_post((unsigned*)(p.ws + OFF_BAR), (volatile LAS unsigned*)&xb_words);
#define XB_SYNC() do { XcdBarrier xb_; xb_.bar = (unsigned*)(p.ws + OFF_BAR); xb_.x = xb_xcc_id(); xb_.st = (volatile LAS unsigned*)&xb_words; xcd_barrier(xb_, wave0 * 64 + fresh_lane()); } while (0)
  int wave0 = __builtin_amdgcn_readfirstlane((int)(threadIdx.x >> 6));
  asm volatile("" : "+s"(wave0));
  const int nblk = gridDim.x;
  float* H = (float*)(p.ws + OFF_H);
  u16* P = (u16*)(p.ws + OFF_P);
  float* DEC = (float*)(p.ws + OFF_DEC);
  u16* AA = (u16*)(p.ws + OFF_AA);
  u16* GG = (u16*)(p.ws + OFF_GG);
  u16* Q = (u16*)(p.ws + OFF_Q);
  u16* MIX = (u16*)(p.ws + OFF_DEC);
  u16* HB1 = (u16*)p.out + (size_t)2 * M_ * 512;
  u16* HB2 = (u16*)(p.ws + OFF_HB2);
  u16* HBH = (u16*)(p.ws + OFF_AA);
  const u16* ZERO = (const u16*)(p.ws + OFF_ZERO);
  u16* ACT = (u16*)(p.ws + OFF_P);
  float2* ROPE = (float2*)(p.ws + OFF_ROPE);
  int* CTR = (int*)(p.ws + OFF_CTR);
  u16* KN = (u16*)p.out;
  u16* VT = KN + (size_t)M_ * 512;
  u16* YR = AA;

  {
  PHASE_TID
  for (int t = blockIdx.x; t < p.nconv; t += nblk) conv_tile(p, t, smem, tid);
  for (int i = blockIdx.x * 256 + tid; i < T_ * 16; i += nblk * 256) {
    int t = i >> 4, f = i & 15;
    double rev = (double)t * ROPE_C[f];
    rev -= floor(rev);
    float r = (float)rev;
    ROPE[i] = make_float2(__builtin_amdgcn_cosf(r), __builtin_amdgcn_sinf(r));
  }
  for (int row = (blockIdx.x * 4 + wave) * 2; row < M_; row += nblk * 8) {
    int b = row / T_, t = row % T_;
    const float* srcA = (t < NMETA_) ? (p.in[1] + (size_t)t * 1024) : (p.in[0] + ((size_t)b * SEQ_ + (t - NMETA_)) * 1024);
    u16* hb = (row < HB_SPLIT) ? HB1 + (size_t)row * 1024 : HB2 + (size_t)(row - HB_SPLIT) * 1024;
    ln_row2(srcA, srcA + 1024, p.in[2], p.in[3], H + (size_t)row * 1024, H + (size_t)(row + 1) * 1024, lane, hb, hb + 1024);
  }
  if (blockIdx.x == 0 && tid < 16) CTR[tid] = 0;
  if (blockIdx.x == 1) { for (int i = tid; i < 2048; i += 256) ((unsigned*)(p.ws + OFF_ZERO))[i] = 0u; }
  }
  grid.sync();

#pragma unroll 1
  for (int ph_ = 0; ph_ < 20; ph_++) {
    const int l = ph_ / 10, kph = ph_ - l * 10;
    const u16* WL = (const u16*)(p.ws + OFF_W) + (size_t)l * W_LAYER;
    if (kph == 0) {
    PHASE_TID
    for (int it_ = 0; it_ * nblk < 257 * 19; it_++) {
      int mt, nt;
      if (!map_tile(it_, nblk, 257, 19, mt, nt)) continue;
      f32x4 acc[8][4];
      zero_acc8(acc);
      ADma al = ADma{(mt < 255) ? HB1 : HB2, 1024, (mt < 255) ? mt * 256 : mt * 256 - HB_SPLIT, 0, ZERO, 0};
      gemm3(acc, al, WL + W_IN, 1024, nt * 128, 1024, smem, tid);
      ACC_COORDS
#pragma unroll
      for (int mi = 0; mi < 8; mi++)
#pragma unroll
        for (int ni = 0; ni < 4; ni++) {
          int col = nt * 128 + wc * 64 + ni * 16 + fq * 4;
          int row = mt * 256 + wr * 128 + mi * 16 + fr;
          if (col < PC_)
            *(uint2*)(P + (size_t)row * PC_ + col) = make_uint2(pk2(acc[mi][ni][0], acc[mi][ni][1]), pk2(acc[mi][ni][2], acc[mi][ni][3]));
        }
    }
    }
    if (kph == 1) {
    PHASE_TID
    {
      const float* qg = p.in[16] + l * 256;
      const float* kvg = p.in[18] + l * 256;
      for (int row = blockIdx.x * 4 + wave; row < M_; row += nblk * 4) {
        u16* pr = P + (size_t)row * PC_;
        uint2 cq = *(const uint2*)(pr + PMLA_ + lane * 4);
        uint2 ckv = *(const uint2*)(pr + PKV_ + lane * 4);
        float a[4], c[4];
        unpack4(cq, a);
        unpack4(ckv, c);
        float s1 = a[0] * a[0] + a[1] * a[1] + a[2] * a[2] + a[3] * a[3];
        float s2 = c[0] * c[0] + c[1] * c[1] + c[2] * c[2] + c[3] * c[3];
        s1 = wave_sum(s1, lane);
        s2 = wave_sum(s2, lane);
        float r1 = rsqrtf(s1 * (1.0f / 256.0f) + 1e-6f), r2 = rsqrtf(s2 * (1.0f / 256.0f) + 1e-6f);
        float4 g1 = *(const float4*)(qg + lane * 4), g2 = *(const float4*)(kvg + lane * 4);
        *(uint2*)(pr + PMLA_ + lane * 4) = make_uint2(pk2(a[0] * r1 * g1.x, a[1] * r1 * g1.y), pk2(a[2] * r1 * g1.z, a[3] * r1 * g1.w));
        *(uint2*)(pr + PKV_ + lane * 4) = make_uint2(pk2(c[0] * r2 * g2.x, c[1] * r2 * g2.y), pk2(c[2] * r2 * g2.z, c[3] * r2 * g2.w));
        if (lane < 16) {
          int t = row % T_;
          float x1 = bf2f(pr[PKR_ + lane]), x2 = bf2f(pr[PKR_ + 16 + lane]);
          float2 cs = ROPE[t * 16 + lane];
          pr[PKR_ + lane] = f2bf(x1 * cs.x - x2 * cs.y);
          pr[PKR_ + 16 + lane] = f2bf(x1 * cs.y + x2 * cs.x);
        }
      }
      const float* mu = p.in[5] + (size_t)l * 1824;
      for (int tile = blockIdx.x; tile < 514 * 12; tile += nblk) {
        int mt = tile / 12, sub = tile % 12, which = sub >> 2, nt = sub & 3;
        f32x4 acc[4][4];
        zero_acc(acc);
        ACC_COORDS
        if (which == 0) {
          AL<3> al{P + 1536, PC_, mt * 128, 0, 64, mu + 1536, 0};
          gemm_loop(acc, al, WL + W_LW, 64, nt * 128, 64, smem, tid);
          const float* w0 = p.in[6] + l * 512;
#pragma unroll
          for (int mi = 0; mi < 4; mi++)
#pragma unroll
            for (int ni = 0; ni < 4; ni++) {
              int col = nt * 128 + wc * 64 + ni * 16 + fr;
              float w0c = w0[col];
#pragma unroll
              for (int j = 0; j < 4; j++) {
                int row = mt * 128 + wr * 64 + mi * 16 + fq * 4 + j;
                float x = -(acc[mi][ni][j] + w0c);
                float sp = fmaxf(x, 0.f) + __logf(1.0f + __expf(-fabsf(x)));
                float wraw = -sp - 0.5f;
                DEC[(size_t)row * 512 + col] = __expf(-__expf(wraw));
              }
            }
        } else if (which == 1) {
          AL<3> al{P + 1600, PC_, mt * 128, 0, 64, mu + 1600, 1};
          gemm_loop(acc, al, WL + W_LA, 64, nt * 128, 64, smem, tid);
          const float* a0 = p.in[8] + l * 512;
#pragma unroll
          for (int mi = 0; mi < 4; mi++)
#pragma unroll
            for (int ni = 0; ni < 4; ni++) {
              int col = nt * 128 + wc * 64 + ni * 16 + fr;
              float a0c = a0[col];
#pragma unroll
              for (int j = 0; j < 4; j++) {
                int row = mt * 128 + wr * 64 + mi * 16 + fq * 4 + j;
                AA[(size_t)row * 512 + col] = f2bf(sigmoidf_(acc[mi][ni][j] + a0c));
              }
            }
        } else {
          AL<3> al{P + 1664, PC_, mt * 128, 0, 160, mu + 1664, 2};
          gemm_loop(acc, al, WL + W_LG, 192, nt * 128, 192, smem, tid);
#pragma unroll
          for (int mi = 0; mi < 4; mi++)
#pragma unroll
            for (int ni = 0; ni < 4; ni++) {
              int col = nt * 128 + wc * 64 + ni * 16 + fr;
#pragma unroll
              for (int j = 0; j < 4; j++) {
                int row = mt * 128 + wr * 64 + mi * 16 + fq * 4 + j;
                GG[(size_t)row * 512 + col] = f2bf(acc[mi][ni][j]);
              }
            }
        }
      }
    }
    }
    if (kph == 2) {
    PHASE_TID
    for (int it_ = 0; it_ * nblk < 257 * 14; it_++) {
      int mt, sub;
      if (!map_tile(it_, nblk, 257, 14, mt, sub)) continue;
      f32x4 acc[8][4];
      zero_acc8(acc);
      ACC_COORDS
      if (sub < 6) {
        ADma al{P + PMLA_, PC_, mt * 256, 0, ZERO, 0};
        gemm3(acc, al, WL + W_UQ, 256, sub * 128, 256, smem, tid);
#pragma unroll
        for (int mi = 0; mi < 8; mi++)
#pragma unroll
          for (int ni = 0; ni < 4; ni++) {
            int col = sub * 128 + wc * 64 + ni * 16 + fq * 4;
            int row = mt * 256 + wr * 128 + mi * 16 + fr;
            *(uint2*)(Q + (size_t)row * 768 + col) = make_uint2(pk2(acc[mi][ni][0], acc[mi][ni][1]), pk2(acc[mi][ni][2], acc[mi][ni][3]));
          }
      } else if (sub < 10) {
        int nt = sub - 6;
        ADma al{P + PKV_, PC_, mt * 256, 0, ZERO, 0};
        gemm3(acc, al, WL + W_UK, 256, nt * 128, 256, smem, tid);
#pragma unroll
        for (int mi = 0; mi < 8; mi++)
#pragma unroll
          for (int ni = 0; ni < 4; ni++) {
            int col = nt * 128 + wc * 64 + ni * 16 + fq * 4;
            int row = mt * 256 + wr * 128 + mi * 16 + fr;
            *(uint2*)(KN + (size_t)row * 512 + col) = make_uint2(pk2(acc[mi][ni][0], acc[mi][ni][1]), pk2(acc[mi][ni][2], acc[mi][ni][3]));
          }
      } else {
        int nt = sub - 10;
        ADma al{P + PKV_, PC_, mt * 256, 0, ZERO, 0};
        gemm3<4, false>(acc, al, WL + W_UV, 256, nt * 128, 256, smem, tid);
#pragma unroll
        for (int mi = 0; mi < 8; mi++)
#pragma unroll
          for (int ni = 0; ni < 4; ni++) {
            int col = nt * 128 + wc * 64 + ni * 16 + fr;
            int row = mt * 256 + wr * 128 + mi * 16 + fq * 4;
            int b = row / T_, t = row % T_;
            size_t o = ((size_t)(b * 512 + col)) * T_ + t;
            *(uint2*)(VT + o) = make_uint2(pk2(acc[mi][ni][0], acc[mi][ni][1]), pk2(acc[mi][ni][2], acc[mi][ni][3]));
          }
      }
    }
    }
    if (kph == 3) {
    PHASE_TID
    {
      const int xcd = blockIdx.x & 7, loc = blockIdx.x >> 3;
      const int total = 16 * 33;
      const bool scan_wg = (loc < 16), partner = (loc >= (nblk >> 4) && loc < (nblk >> 4) + 16);
      if (scan_wg) {
        scan_unit(p, l, xcd * 16 + loc, smem, launder(tid));
        __syncthreads();
      }
      if (!partner) {
        while (true) {
          if (tid == 0) s_unit = atomicAdd(&CTR[l * 8 + xcd], 1);
          __syncthreads();
          int v = s_unit;
          __syncthreads();
          if (v >= total) break;
          const int tidu = launder(tid);
          int g = v / 66, w = v - g * 66;
          attn_unit(p, xcd * 16 + g * 2 + (w & 1), 32 - (w >> 1), smem, tidu);
          __syncthreads();
        }
      }
    }
    }
    if (kph == 4) {
    PHASE_TID
    {
    u16* scr = (u16*)(p.ws + OFF_SCR) + (size_t)blockIdx.x * 32768;
    for (int it_ = 0; it_ * nblk < 256 * 8; it_++) {
      int mt, nt;
      if (!map_tile(it_, nblk, 256, 8, mt, nt)) continue;
      f32x4 acc[8][4];
      ADma alh = ADma{(mt < 255) ? HB1 : HB2, 1024, (mt < 255) ? mt * 256 : mt * 256 - HB_SPLIT, 0, ZERO, 0};
      zero_acc8(acc);
      gemm3(acc, alh, WL + W_G, 1024, nt * 128, 1024, smem, launder(tid));
      { const int tq_ = launder(tid); const int lane = tq_ & 63, wave = tq_ >> 6; ACC_COORDS
#pragma unroll
        for (int mi = 0; mi < 8; mi++)
#pragma unroll
          for (int ni = 0; ni < 4; ni++) {
            int col = nt * 128 + wc * 64 + ni * 16 + fq * 4;
            int row = mt * 256 + wr * 128 + mi * 16 + fr;
            *(uint2*)(MIX + (size_t)row * 1024 + col) = make_uint2(pk2(sigmoidf_(acc[mi][ni][0]), sigmoidf_(acc[mi][ni][1])),
                                                                   pk2(sigmoidf_(acc[mi][ni][2]), sigmoidf_(acc[mi][ni][3])));
          }
      }
      zero_acc8(acc);
      {
        ADma aly{YR, 512, mt * 256, 0, ZERO, 0};
        gemm3(acc, aly, WL + W_PR, 512, nt * 128, 512, smem, launder(tid));
      }
      { const int tq_ = launder(tid); const int lane = tq_ & 63, wave = tq_ >> 6; ACC_COORDS
#pragma unroll
        for (int mi = 0; mi < 8; mi++)
#pragma unroll
          for (int ni = 0; ni < 4; ni++) {
            int col = nt * 128 + wc * 64 + ni * 16 + fq * 4;
            int row = mt * 256 + wr * 128 + mi * 16 + fr;
            u16* mp = MIX + (size_t)row * 1024 + col;
            uint2 s = *(const uint2*)mp;
            *(uint2*)mp = make_uint2(pk2(bflo(s.x) * acc[mi][ni][0], bfhi(s.x) * acc[mi][ni][1]), pk2(bflo(s.y) * acc[mi][ni][2], bfhi(s.y) * acc[mi][ni][3]));
          }
      }
      zero_acc8(acc);
      gemm3(acc, alh, WL + W_G, 1024, 1024 + nt * 128, 1024, smem, launder(tid));
      { const int tq_ = launder(tid); const int lane = tq_ & 63, wave = tq_ >> 6; ACC_COORDS
#pragma unroll
        for (int mi = 0; mi < 8; mi++)
#pragma unroll
          for (int ni = 0; ni < 4; ni++) {
            int cl = wc * 64 + ni * 16 + fq * 4, rl = wr * 128 + mi * 16 + fr;
            *(uint2*)(scr + rl * 128 + cl) = make_uint2(pk2(sigmoidf_(acc[mi][ni][0]), sigmoidf_(acc[mi][ni][1])),
                                                        pk2(sigmoidf_(acc[mi][ni][2]), sigmoidf_(acc[mi][ni][3])));
          }
      }
      zero_acc8(acc);
      {
        ADma alm{P + PMLA_, PC_, mt * 256, 0, ZERO, 0};
        gemm3(acc, alm, WL + W_PM, 512, nt * 128, 512, smem, launder(tid));
      }
      { const int tq_ = launder(tid); const int lane = tq_ & 63, wave = tq_ >> 6; ACC_COORDS
#pragma unroll
        for (int mi = 0; mi < 8; mi++)
#pragma unroll
          for (int ni = 0; ni < 4; ni++) {
            int cl = wc * 64 + ni * 16 + fq * 4, rl = wr * 128 + mi * 16 + fr;
            u16* mp = MIX + (size_t)(mt * 256 + rl) * 1024 + nt * 128 + cl;
            uint2 t1 = *(const uint2*)mp;
            uint2 s = *(const uint2*)(scr + rl * 128 + cl);
            float o0 = bflo(t1.x) + bflo(s.x) * acc[mi][ni][0];
            float o1 = bfhi(t1.x) + bfhi(s.x) * acc[mi][ni][1];
            float o2 = bflo(t1.y) + bflo(s.y) * acc[mi][ni][2];
            float o3 = bfhi(t1.y) + bfhi(s.y) * acc[mi][ni][3];
            *(uint2*)mp = make_uint2(pk2(o0, o1), pk2(o2, o3));
          }
      }
    }
    }
    if (blockIdx.x < 16) {
      const int mt = 256, nt = blockIdx.x;
      f32x4 acc[8][2];
      unsigned sg[8][2][2];
      ADma alh = ADma{(mt < 255) ? HB1 : HB2, 1024, (mt < 255) ? mt * 256 : mt * 256 - HB_SPLIT, 0, ZERO, 0};
      zero_acc8(acc);
      const int tid1 = launder(tid);
      gemm3(acc, alh, WL + W_G, 1024, nt * 64, 1024, smem, tid1);
#pragma unroll
      for (int mi = 0; mi < 8; mi++)
#pragma unroll
        for (int ni = 0; ni < 2; ni++) {
          sg[mi][ni][0] = pk2(sigmoidf_(acc[mi][ni][0]), sigmoidf_(acc[mi][ni][1]));
          sg[mi][ni][1] = pk2(sigmoidf_(acc[mi][ni][2]), sigmoidf_(acc[mi][ni][3]));
        }
      zero_acc8(acc);
      {
        ADma aly{YR, 512, mt * 256, 0, ZERO, 0};
        const int tid2 = launder(tid);
      gemm3(acc, aly, WL + W_PR, 512, nt * 64, 512, smem, tid2);
      }
{ const int tidq = launder(tid); const int lane = tidq & 63, wave = tidq >> 6; ACC_COORDS
#pragma unroll
      for (int mi = 0; mi < 8; mi++)
#pragma unroll
        for (int ni = 0; ni < 2; ni++) {
          int col = nt * 64 + wc * 32 + ni * 16 + fq * 4;
          int row = mt * 256 + wr * 128 + mi * 16 + fr;
          *(uint2*)(MIX + (size_t)row * 1024 + col) = make_uint2(pk2(bflo(sg[mi][ni][0]) * acc[mi][ni][0], bfhi(sg[mi][ni][0]) * acc[mi][ni][1]),
                                                                 pk2(bflo(sg[mi][ni][1]) * acc[mi][ni][2], bfhi(sg[mi][ni][1]) * acc[mi][ni][3]));
        }
      }
      zero_acc8(acc);
      const int tid3 = launder(tid);
      gemm3(acc, alh, WL + W_G, 1024, 1024 + nt * 64, 1024, smem, tid3);
#pragma unroll
      for (int mi = 0; mi < 8; mi++)
#pragma unroll
        for (int ni = 0; ni < 2; ni++) {
          sg[mi][ni][0] = pk2(sigmoidf_(acc[mi][ni][0]), sigmoidf_(acc[mi][ni][1]));
          sg[mi][ni][1] = pk2(sigmoidf_(acc[mi][ni][2]), sigmoidf_(acc[mi][ni][3]));
        }
      zero_acc8(acc);
      {
        ADma alm{P + PMLA_, PC_, mt * 256, 0, ZERO, 0};
        const int tid4 = launder(tid);
      gemm3(acc, alm, WL + W_PM, 512, nt * 64, 512, smem, tid4);
      }
{ const int tidq = launder(tid); const int lane = tidq & 63, wave = tidq >> 6; ACC_COORDS
#pragma unroll
      for (int mi = 0; mi < 8; mi++)
#pragma unroll
        for (int ni = 0; ni < 2; ni++) {
          int col = nt * 64 + wc * 32 + ni * 16 + fq * 4;
          int row = mt * 256 + wr * 128 + mi * 16 + fr;
          uint2 pm = *(const uint2*)(MIX + (size_t)row * 1024 + col);
          float o0 = bflo(pm.x) + bflo(sg[mi][ni][0]) * acc[mi][ni][0];
          float o1 = bfhi(pm.x) + bfhi(sg[mi][ni][0]) * acc[mi][ni][1];
          float o2 = bflo(pm.y) + bflo(sg[mi][ni][1]) * acc[mi][ni][2];
          float o3 = bfhi(pm.y) + bfhi(sg[mi][ni][1]) * acc[mi][ni][3];
          *(uint2*)(MIX + (size_t)row * 1024 + col) = make_uint2(pk2(o0, o1), pk2(o2, o3));
        }
      }
    }
    }
    if (kph == 5) {
    PHASE_TID
    for (int prb_ = (PROBE_FI ? 0 : 1); prb_ < 2; prb_++)
    for (int it_ = 0; it_ * nblk < 256 * 8; it_++) {
      int mt, nt;
      if (!map_tile(it_, nblk, 256, 8, mt, nt)) continue;
      f32x4 acc[8][4];
      zero_acc8(acc);
      ACC_COORDS
      ADma al{MIX, 1024, mt * 256, 0, ZERO, 0};
      gemm3(acc, al, WL + W_OUT, 1024, nt * 128, 1024, smem, tid);
#pragma unroll
      for (int mi = 0; mi < 8; mi++)
#pragma unroll
        for (int ni = 0; ni < 4; ni++) {
          int col = nt * 128 + wc * 64 + ni * 16 + fq * 4;
          int row = mt * 256 + wr * 128 + mi * 16 + fr;
          float* hp = H + (size_t)row * 1024 + col;
          float* dp = (prb_ == 0) ? (p.out + (size_t)(row & 65535) * 1024 + col) : hp;
          float4 hv = *(const float4*)hp;
          hv.x = ALPHA_ * hv.x + acc[mi][ni][0];
          hv.y = ALPHA_ * hv.y + acc[mi][ni][1];
          hv.z = ALPHA_ * hv.z + acc[mi][ni][2];
          hv.w = ALPHA_ * hv.w + acc[mi][ni][3];
          *(float4*)dp = hv;
        }
    }
    if (blockIdx.x < 16) {
      const int mt = 256, n0 = blockIdx.x * 64;
      f32x4 acc[8][2];
      zero_acc8(acc);
      ADma al{MIX, 1024, mt * 256, 0, ZERO, 0};
      gemm3(acc, al, WL + W_OUT, 1024, n0, 1024, smem, launder(tid));
      const int tq_ = launder(tid);
      const int lane = tq_ & 63, wave = tq_ >> 6;
      ACC_COORDS
#pragma unroll
      for (int mi = 0; mi < 8; mi++)
#pragma unroll
        for (int ni = 0; ni < 2; ni++) {
          int col = n0 + wc * 32 + ni * 16 + fq * 4;
          int row = mt * 256 + wr * 128 + mi * 16 + fr;
          float* hp = H + (size_t)row * 1024 + col;
          float4 hv = *(const float4*)hp;
          hv.x = ALPHA_ * hv.x + acc[mi][ni][0];
          hv.y = ALPHA_ * hv.y + acc[mi][ni][1];
          hv.z = ALPHA_ * hv.z + acc[mi][ni][2];
          hv.w = ALPHA_ * hv.w + acc[mi][ni][3];
          *(float4*)hp = hv;
        }
    }
    }
    if (kph == 6) {
    PHASE_TID
    for (int row = (blockIdx.x * 4 + wave) * 2; row < M_; row += nblk * 8)
      ln_row2(H + (size_t)row * 1024, H + (size_t)(row + 1) * 1024, p.in[24] + l * 1024, p.in[25] + l * 1024, H + (size_t)row * 1024, H + (size_t)(row + 1) * 1024, lane, HBH + (size_t)row * 1024, HBH + (size_t)(row + 1) * 1024);
    }
    if (kph == 7) {
    PHASE_TID
    {
      const float* cw = p.in[27] + (size_t)l * 3 * 5632;
      const float* cb = p.in[28] + (size_t)l * 5632;
#if PROBE_HOT
      for (int it_ = 0; it_ * nblk < 272 * 44; it_++) {
        int rest, nt;
        if (!map_tile(it_, nblk, 272, 44, rest, nt)) continue;
        f32x4 acc[8][4];
        zero_acc8(acc);
#if PROBE_HOT == 1
        ADma al{HBH, 1024, 0, 0, ZERO, 1, p.ws};
        gemm3(acc, al, WL + W_UP, 1024, 0, 1024, smem, tid);
#else
        int it = rest % 17, b = rest / 17;
        ADma al{HBH, 1024, b * T_, 254 * it - 2, ZERO, 1, p.ws};
        gemm3(acc, al, WL + W_UP, 1024, nt * 128, 1024, smem, tid);
#endif
        float sacc = 0.f;
#pragma unroll
        for (int mi = 0; mi < 8; mi++)
#pragma unroll
          for (int ni = 0; ni < 4; ni++) sacc += acc[mi][ni][0] + acc[mi][ni][1] + acc[mi][ni][2] + acc[mi][ni][3];
        if (sacc == 12345.678f) ACT[tid] = 0;
      }
#endif
      for (int it_ = 0; it_ * nblk < 272 * 44; it_++) {
        int rest, nt;
        if (!map_tile(it_, nblk, 272, 44, rest, nt)) continue;
        int it = rest % 17, b = rest / 17;
        int t0 = 254 * it - 2;
        f32x4 acc[8][4];
        zero_acc8(acc);
        ADma al{HBH, 1024, b * T_, t0, ZERO, 1, p.ws};
        gemm3(acc, al, WL + W_UP, 1024, nt * 128, 1024, smem, launder(tid));
        ACC_COORDS
        float(*ut)[132] = (float(*)[132])smem;
        const int tidh = launder(tid);
        const int c = tidh & 63, rg = tidh >> 6;
        const int gcol = nt * 64 + c, vcol = DFF_ + nt * 64 + c;
        const float g0 = cw[gcol], g1 = cw[5632 + gcol], g2 = cw[2 * 5632 + gcol], gb = cb[gcol];
        const float v0 = cw[vcol], v1 = cw[5632 + vcol], v2 = cw[2 * 5632 + vcol], vb = cb[vcol];
#pragma unroll 1
        for (int half = 0; half < 2; half++) {
          float carry = 0.f;
          if (half == 1) carry = ut[126 + (tid >> 7)][tid & 127];
          __syncthreads();
          if (half == 1) ut[tid >> 7][tid & 127] = carry;
          if (wr == half) {
#pragma unroll
            for (int mi = 0; mi < 8; mi++)
#pragma unroll
              for (int ni = 0; ni < 4; ni++)
                *(float4*)&ut[half * 2 + mi * 16 + fr][wc * 64 + ni * 16 + fq * 4] = make_float4(acc[mi][ni][0], acc[mi][ni][1], acc[mi][ni][2], acc[mi][ni][3]);
          }
          __syncthreads();
          const int nq = half ? 130 : 128;
          int qs = 2 + rg * 32, qe = min(qs + 32, nq);
          float ga = ut[qs - 2][c], gbp = ut[qs - 1][c];
          float va = ut[qs - 2][64 + c], vbp = ut[qs - 1][64 + c];
#pragma unroll 4
          for (int q = qs; q < qe; q++) {
            float gc = ut[q][c], vc = ut[q][64 + c];
            int t = t0 + half * 126 + q;
            if (t < T_) {
              float gate = g0 * ga + g1 * gbp + g2 * gc + gb;
              float val = v0 * va + v1 * vbp + v2 * vc + vb;
              float av = gate * sigmoidf_(gate) * val;
              ACT[(size_t)(b * T_ + t) * DFF_ + gcol] = f2bf(av);
            }
            ga = gbp; gbp = gc; va = vbp; vbp = vc;
          }
        }
        __syncthreads();
      }
    }
    }
    if (kph == 8) {
    PHASE_TID
    for (int prb_ = (PROBE_FI ? 0 : 1); prb_ < 2; prb_++)
    for (int it_ = 0; it_ * nblk < 256 * 8; it_++) {
      int mt, nt;
      if (!map_tile(it_, nblk, 256, 8, mt, nt)) continue;
      f32x4 acc[8][4];
      zero_acc8(acc);
      ACC_COORDS
      ADma al{ACT, DFF_, mt * 256, 0, ZERO, 0};
      gemm3(acc, al, WL + W_DN, DFF_, nt * 128, DFF_, smem, tid);
#pragma unroll
      for (int mi = 0; mi < 8; mi++)
#pragma unroll
        for (int ni = 0; ni < 4; ni++) {
          int col = nt * 128 + wc * 64 + ni * 16 + fq * 4;
          int row = mt * 256 + wr * 128 + mi * 16 + fr;
          float* hp = H + (size_t)row * 1024 + col;
          float* dp = (prb_ == 0) ? (p.out + (size_t)(row & 65535) * 1024 + col) : hp;
          float4 hv = *(const float4*)hp;
          hv.x = ALPHA_ * hv.x + acc[mi][ni][0];
          hv.y = ALPHA_ * hv.y + acc[mi][ni][1];
          hv.z = ALPHA_ * hv.z + acc[mi][ni][2];
          hv.w = ALPHA_ * hv.w + acc[mi][ni][3];
          *(float4*)dp = hv;
        }
    }
    if (blockIdx.x < 16) {
      const int mt = 256, n0 = blockIdx.x * 64;
      f32x4 acc[8][2];
      zero_acc8(acc);
      ADma al{ACT, DFF_, mt * 256, 0, ZERO, 0};
      gemm3(acc, al, WL + W_DN, DFF_, n0, DFF_, smem, launder(tid));
      const int tq_ = launder(tid);
      const int lane = tq_ & 63, wave = tq_ >> 6;
      ACC_COORDS
#pragma unroll
      for (int mi = 0; mi < 8; mi++)
#pragma unroll
        for (int ni = 0; ni < 2; ni++) {
          int col = n0 + wc * 32 + ni * 16 + fq * 4;
          int row = mt * 256 + wr * 128 + mi * 16 + fr;
          float* hp = H + (size_t)row * 1024 + col;
          float4 hv = *(const float4*)hp;
          hv.x = ALPHA_ * hv.x + acc[mi][ni][0];
          hv.y = ALPHA_ * hv.y + acc[mi][ni][1];
          hv.z = ALPHA_ * hv.z + acc[mi][ni][2];
          hv.w = ALPHA_ * hv.w + acc[mi][ni][3];
          *(float4*)hp = hv;
        }
    }
    }
    if (kph == 9) {
    PHASE_TID
    if (l == 0) {
      for (int row = (blockIdx.x * 4 + wave) * 2; row < M_; row += nblk * 8) {
        u16* hb = (row < HB_SPLIT) ? HB1 + (size_t)row * 1024 : HB2 + (size_t)(row - HB_SPLIT) * 1024;
        ln_row2(H + (size_t)row * 1024, H + (size_t)(row + 1) * 1024, p.in[30], p.in[31], H + (size_t)row * 1024, H + (size_t)(row + 1) * 1024, lane, hb, hb + 1024);
      }
    } else {
      for (int row = (blockIdx.x * 4 + wave) * 2; row < M_; row += nblk * 8) {
        int b = row / T_, t = row % T_;
        if (t >= NMETA_) {
          float* o = p.out + ((size_t)b * SEQ_ + (t - NMETA_)) * 1024;
          ln_row2(H + (size_t)row * 1024, H + (size_t)(row + 1) * 1024, p.in[30] + 1024, p.in[31] + 1024, o, o + 1024, lane, nullptr, nullptr);
        }
      }
    }
    }
    if (ph_ != 19) XB_SYNC();
  }
}

extern "C" void kernel_launch(void* const* d_in, const int* in_sizes, int n_in, void* d_out, int out_size, void* d_ws,
                              size_t ws_size, hipStream_t stream) {
  static int grid_blocks = 0;
  if (!grid_blocks) {
    int dev = 0, cus = 0, per_cu = 0;
    hipGetDevice(&dev);
    hipDeviceGetAttribute(&cus, hipDeviceAttributeMultiprocessorCount, dev);
    hipOccupancyMaxActiveBlocksPerMultiprocessor(&per_cu, mega, 256, 0);
    if (per_cu > 2) per_cu = 2;
    grid_blocks = cus * per_cu;
  }
  if (ws_size < WS_TOTAL) fprintf(stderr, "workspace too small: %zu < %zu\n", ws_size, (size_t)WS_TOTAL);
  Params p;
  memset(&p, 0, sizeof(p));
  for (int i = 0; i < 32; i++) p.in[i] = (const float*)d_in[i];
  p.out = (float*)d_out;
  p.ws = (char*)d_ws;
  u16* wb = (u16*)((char*)d_ws + OFF_W);
  int nj = 0, tiles = 0;
  auto add = [&](const float* src, size_t dst_off, int ld, int c0, int K, int Kpad, int Nv, int Np, int mode) {
    Job& j = p.jobs[nj++];
    j.src = src; j.dst = wb + dst_off; j.ld = ld; j.c0 = c0; j.K = K; j.Kpad = Kpad; j.Nv = Nv; j.Np = Np; j.mode = mode;
    j.tile0 = tiles;
    tiles += (Kpad / 64) * (Np / 64);
  };
  for (int l = 0; l < 2; l++) {
    size_t o = (size_t)l * W_LAYER;
    const float* w_in = (const float*)d_in[4] + (size_t)l * 1024 * 4416;
    add(w_in, o + W_IN, 4416, 0, 1024, 1024, 2368, 2432, 0);
    add(w_in, o + W_G, 4416, 2368, 1024, 1024, 2048, 2048, 0);
    add((const float*)d_in[7] + (size_t)l * 64 * 512, o + W_LW, 512, 0, 64, 64, 512, 512, 0);
    add((const float*)d_in[9] + (size_t)l * 64 * 512, o + W_LA, 512, 0, 64, 64, 512, 512, 0);
    add((const float*)d_in[10] + (size_t)l * 160 * 512, o + W_LG, 512, 0, 160, 192, 512, 512, 0);
    add((const float*)d_in[17] + (size_t)l * 256 * 768, o + W_UQ, 768, 0, 256, 256, 768, 768, 0);
    add((const float*)d_in[19] + (size_t)l * 256 * 512, o + W_UK, 512, 0, 256, 256, 512, 512, 0);
    add((const float*)d_in[20] + (size_t)l * 256 * 512, o + W_UV, 512, 0, 256, 256, 512, 512, 0);
    add((const float*)d_in[21] + (size_t)l * 512 * 1024, o + W_PR, 1024, 0, 512, 512, 1024, 1024, 0);
    add((const float*)d_in[22] + (size_t)l * 512 * 1024, o + W_PM, 1024, 0, 512, 512, 1024, 1024, 0);
    add((const float*)d_in[23] + (size_t)l * 1024 * 1024, o + W_OUT, 1024, 0, 1024, 1024, 1024, 1024, 0);
    add((const float*)d_in[26] + (size_t)l * 1024 * 5632, o + W_UP, 5632, 0, 1024, 1024, 5632, 5632, 1);
    add((const float*)d_in[29] + (size_t)l * 2816 * 1024, o + W_DN, 1024, 0, 2816, 2816, 1024, 1024, 0);
  }
  p.nconv = tiles;
  hipMemsetAsync((char*)d_ws + OFF_BAR, 0, 16384, stream);
  void* args[] = {&p};
  hipError_t e = hipLaunchCooperativeKernel((void*)mega, dim3(grid_blocks), dim3(256), args, 0, stream);
  if (e != hipSuccess) fprintf(stderr, "cooperative launch failed: %s (grid %d)\n", hipGetErrorString(e), grid_blocks);
}
```

```cpp
#include <hip/hip_runtime.h>
#include <hip/hip_cooperative_groups.h>
#include <cstdio>
#include <cstring>
namespace cg = cooperative_groups;

#ifndef PHMASK
#define PHMASK 0xFFFF
#endif
#ifndef PROBE_HOT
#define PROBE_HOT 0
#endif
#ifndef PROBE_FI
#define PROBE_FI 0
#endif
#ifndef REPMASK
#define REPMASK 0
#endif
typedef unsigned short u16;
using bf16x8 = __attribute__((ext_vector_type(8))) short;
using f32x4 = __attribute__((ext_vector_type(4))) float;

constexpr int B_ = 16, SEQ_ = 4096, NMETA_ = 16, T_ = 4112, M_ = B_ * T_, D_ = 1024;
constexpr int PC_ = 2368;
constexpr int PMLA_ = 1824, PKV_ = 2080, PKR_ = 2336;
constexpr int DFF_ = 2816;
constexpr float ALPHA_ = 1.4142135623730951f;

constexpr size_t OFF_H = 0;
constexpr size_t OFF_P = OFF_H + (size_t)M_ * 1024 * 4;
constexpr size_t OFF_DEC = OFF_P + (size_t)M_ * PC_ * 2;
constexpr size_t OFF_AA = OFF_DEC + (size_t)M_ * 512 * 4;
constexpr size_t OFF_GG = OFF_AA + (size_t)M_ * 512 * 2;
constexpr size_t OFF_Q = OFF_GG + (size_t)M_ * 512 * 2;
constexpr size_t OFF_W = OFF_Q + (size_t)M_ * 768 * 2;
constexpr size_t W_IN = 0;
constexpr size_t W_G = W_IN + (size_t)2432 * 1024;
constexpr size_t W_LW = W_G + (size_t)2048 * 1024;
constexpr size_t W_LA = W_LW + (size_t)512 * 64;
constexpr size_t W_LG = W_LA + (size_t)512 * 64;
constexpr size_t W_UQ = W_LG + (size_t)512 * 192;
constexpr size_t W_UK = W_UQ + (size_t)768 * 256;
constexpr size_t W_UV = W_UK + (size_t)512 * 256;
constexpr size_t W_PR = W_UV + (size_t)512 * 256;
constexpr size_t W_PM = W_PR + (size_t)1024 * 512;
constexpr size_t W_OUT = W_PM + (size_t)1024 * 512;
constexpr size_t W_UP = W_OUT + (size_t)1024 * 1024;
constexpr size_t W_DN = W_UP + (size_t)5632 * 1024;
constexpr size_t W_LAYER = W_DN + (size_t)1024 * 2816;
constexpr size_t OFF_ROPE = OFF_W + 2 * W_LAYER * 2;
constexpr size_t OFF_CTR = OFF_ROPE + (size_t)T_ * 16 * 8;
constexpr size_t OFF_ZERO = OFF_CTR + 256;
constexpr size_t OFF_BAR = OFF_ZERO + 8192;
constexpr size_t OFF_HB2 = OFF_BAR + 16384;
constexpr size_t OFF_SCR = OFF_HB2 + (size_t)512 * 1024 * 2;
constexpr size_t WS_TOTAL = OFF_SCR + (size_t)1024 * 65536;
constexpr int HB_SPLIT = 65280;

struct Job { const float* src; u16* dst; int ld, c0, K, Kpad, Nv, Np, mode, tile0; };
struct Params {
  const float* in[32];
  float* out;
  char* ws;
  Job jobs[26];
  int nconv;
  int pad0;
};

__constant__ double ROPE_C[16] = {0.15915494309189535, 0.08949940160889101, 0.050329212104487035, 0.0283021958306234,
                                  0.015915494309189534, 0.008949940160889102, 0.005032921210448704, 0.00283021958306234,
                                  0.0015915494309189536, 0.0008949940160889102, 0.0005032921210448703, 0.00028302195830623395,
                                  0.00015915494309189535, 8.949940160889102e-05, 5.0329212104487035e-05, 2.8302195830623396e-05};

__device__ __forceinline__ int launder(int x) { asm volatile("" : "+v"(x)); return x; }
typedef __bf16 bf16x2_t __attribute__((ext_vector_type(2)));
typedef float f32x2_t __attribute__((ext_vector_type(2)));
__device__ __forceinline__ unsigned pk2(float a, float b) {
  f32x2_t v = {a, b};
  bf16x2_t r = __builtin_convertvector(v, bf16x2_t);
  return *(unsigned*)&r;
}
__device__ __forceinline__ u16 f2bf(float f) { return (u16)(pk2(f, 0.f) & 0xffffu); }
__device__ __forceinline__ float bf2f(unsigned h) { return __uint_as_float(h << 16); }
__device__ __forceinline__ float bflo(unsigned w) { return __uint_as_float(w << 16); }
__device__ __forceinline__ float bfhi(unsigned w) { return __uint_as_float(w & 0xffff0000u); }
__device__ __forceinline__ float sigmoidf_(float x) { return __builtin_amdgcn_rcpf(1.0f + __expf(-x)); }

__device__ __forceinline__ int fresh_lane() { int x; asm volatile("v_mbcnt_lo_u32_b32 %0, -1, 0\n\tv_mbcnt_hi_u32_b32 %0, -1, %0" : "=v"(x)); return x; }
#define PHASE_TID const int tid = wave0 * 64 + fresh_lane(); const int lane = tid & 63, wave = tid >> 6; (void)lane; (void)wave;
template <int CTRL>
__device__ __forceinline__ float dppf(float x) {
  return __int_as_float(__builtin_amdgcn_update_dpp(0, __float_as_int(x), CTRL, 0xF, 0xF, true));
}
__device__ __forceinline__ float sum8(float x) {
  x += dppf<0xB1>(x);
  x += dppf<0x4E>(x);
  x += dppf<0x141>(x);
  return x;
}
__device__ __forceinline__ float sum16(float x) {
  x = sum8(x);
  x += dppf<0x140>(x);
  return x;
}
__device__ __forceinline__ float shx(float x, int lane, int o) {
  return __int_as_float(__builtin_amdgcn_ds_bpermute((lane ^ o) << 2, __float_as_int(x)));
}
__device__ __forceinline__ float wave_sum(float x, int lane) {
  x = sum16(x);
  x += shx(x, lane, 16);
  x += shx(x, lane, 32);
  return x;
}

constexpr int BM = 128, BN = 128, BK = 64, LDT = 64;
constexpr int SMEM_BYTES = 73728;

template <int MODE>
struct AL {
  const void* base;
  int ld;
  int row0;
  int t0;
  int kvalid;
  const float* mu;
  int fn;
  struct Raw { uint4 x, y; };
  __device__ __forceinline__ Raw fetch(int r, int k) const {
    Raw w;
    { unsigned z = (MODE == 3) ? (unsigned)launder(0) : 0u; w.x = make_uint4(z, z, z, z); w.y = w.x; }
    if (MODE == 0) {
      const float* p = (const float*)base + (size_t)(row0 + r) * ld + k;
      w.x = *(const uint4*)p;
      w.y = *(const uint4*)(p + 4);
    } else if (MODE == 1) {
      const u16* p = (const u16*)base + (size_t)(row0 + r) * ld + k;
      w.x = *(const uint4*)p;
    } else if (MODE == 4) {
      const float* p = (const float*)base + (size_t)(row0 + r) * ld + k;
      float4 a = *(const float4*)p, b = *(const float4*)(p + 4);
      w.x = make_uint4(pk2(a.x, a.y), pk2(a.z, a.w), pk2(b.x, b.y), pk2(b.z, b.w));
    } else if (MODE == 2) {
      int t = t0 + r;
      if (t >= 0 && t < T_) {
        const float* p = (const float*)base + (size_t)(row0 + t) * ld + k;
        w.x = *(const uint4*)p;
        w.y = *(const uint4*)(p + 4);
      }
    } else {
      int row = row0 + r;
      int t = row % T_;
      if (k < kvalid) {
        const u16* p = (const u16*)base + (size_t)row * ld + k;
        w.x = *(const uint4*)p;
        if (t > 0) w.y = *(const uint4*)(p - ld);
      }
    }
    return w;
  }
  __device__ __forceinline__ uint4 cvt(const Raw& w, int k) const {
    if (MODE == 0 || MODE == 2) {
      uint4 o;
      o.x = pk2(__uint_as_float(w.x.x), __uint_as_float(w.x.y));
      o.y = pk2(__uint_as_float(w.x.z), __uint_as_float(w.x.w));
      o.z = pk2(__uint_as_float(w.y.x), __uint_as_float(w.y.y));
      o.w = pk2(__uint_as_float(w.y.z), __uint_as_float(w.y.w));
      return o;
    } else if (MODE == 1 || MODE == 4) {
      return w.x;
    } else {
      if (k >= kvalid) { unsigned z = (unsigned)launder(0); return make_uint4(z, z, z, z); }
      unsigned cw[4] = {w.x.x, w.x.y, w.x.z, w.x.w};
      unsigned pw[4] = {w.y.x, w.y.y, w.y.z, w.y.w};
      unsigned ow[4];
#pragma unroll
      for (int e = 0; e < 4; e++) {
        float x0 = bflo(cw[e]), x1 = bfhi(cw[e]);
        float p0 = bflo(pw[e]), p1 = bfhi(pw[e]);
        float v0 = x0 + (p0 - x0) * mu[k + 2 * e];
        float v1 = x1 + (p1 - x1) * mu[k + 2 * e + 1];
        if (fn == 0) {
          v0 = 1.0f - 2.0f * __builtin_amdgcn_rcpf(__expf(2.0f * v0) + 1.0f);
          v1 = 1.0f - 2.0f * __builtin_amdgcn_rcpf(__expf(2.0f * v1) + 1.0f);
        } else if (fn == 2) {
          v0 = sigmoidf_(v0);
          v1 = sigmoidf_(v1);
        }
        ow[e] = pk2(v0, v1);
      }
      return make_uint4(ow[0], ow[1], ow[2], ow[3]);
    }
  }
};

template <int NI>
__device__ __forceinline__ void zero_acc(f32x4 (&acc)[4][NI]) {
#pragma unroll
  for (int i = 0; i < 4; i++)
#pragma unroll
    for (int j = 0; j < NI; j++) acc[i][j] = f32x4{0.f, 0.f, 0.f, 0.f};
}

#define REP4(X) X(0) X(1) X(2) X(3)
template <class ALT, int NI>
__device__ __forceinline__ void gemm_loop(f32x4 (&acc)[4][NI], const ALT& al, const u16* __restrict__ Bt, int ldb, int n0,
                                          int K, char* smem, const int tid) {
  const int lane = tid & 63, wave = tid >> 6;
  const int wr = wave >> 1, wc = wave & 1, fr = lane & 15, fq = lane >> 4;
  const int lr = tid >> 3, lk = (tid & 7) * 8, lsw = ((tid & 7) ^ (lr & 7)) * 8;
  u16* sa = (u16*)smem;
  u16* sb = sa + 2 * BM * LDT;
  typename ALT::Raw ra0, ra1, ra2, ra3;
  uint4 rb0 = make_uint4(0,0,0,0), rb1 = rb0, rb2 = rb0, rb3 = rb0;
  const u16* bp = Bt + (size_t)(n0 + lr) * ldb + lk;
#define GL_FETCH(i) ra##i = al.fetch(lr + 32 * i, kf); if (i < NI) rb##i = *(const uint4*)(bp + (size_t)(32 * i) * ldb + kb);
#define GL_STORE(i) *(uint4*)(a_ + (lr + 32 * i) * LDT + lsw) = al.cvt(ra##i, kt * BK + lk); if (i < NI) *(uint4*)(b_ + (lr + 32 * i) * LDT + lsw) = rb##i;
  {
    const int kf = lk, kb = 0;
    REP4(GL_FETCH)
  }
  const int nk = K / BK;
  for (int kt = 0; kt < nk; kt++) {
    u16* a_ = sa + (kt & 1) * BM * LDT;
    u16* b_ = sb + (kt & 1) * BN * LDT;
    REP4(GL_STORE)
    __syncthreads();
    if (kt + 1 < nk) {
      const int kf = (kt + 1) * BK + lk, kb = (kt + 1) * BK;
      REP4(GL_FETCH)
    }
#pragma unroll
    for (int ks = 0; ks < 2; ks++) {
      bf16x8 af[4], bf[NI];
#pragma unroll
      for (int i = 0; i < 4; i++) af[i] = *(const bf16x8*)(a_ + (wr * 64 + i * 16 + fr) * LDT + (((ks * 4 + fq) ^ (fr & 7)) * 8));
#pragma unroll
      for (int i = 0; i < NI; i++) bf[i] = *(const bf16x8*)(b_ + (wc * (NI * 16) + i * 16 + fr) * LDT + (((ks * 4 + fq) ^ (fr & 7)) * 8));
#pragma unroll
      for (int mi = 0; mi < 4; mi++)
#pragma unroll
        for (int ni = 0; ni < NI; ni++)
          acc[mi][ni] = __builtin_amdgcn_mfma_f32_16x16x32_bf16(af[mi], bf[ni], acc[mi][ni], 0, 0, 0);
    }
  }
  __syncthreads();
#undef GL_FETCH
#undef GL_STORE
}


struct ADma { const u16* base; int ld; int row0; int t0; const u16* zero; int mode; const char* wsb; };
constexpr int G3_STAGE = 12288;

template <int NI, bool SWAP = true>
__device__ __forceinline__ void gemm3(f32x4 (&acc)[8][NI], const ADma& a, const u16* __restrict__ Bt, int ldb, int n0, int K,
                                      char* smem, const int tid) {
  const int lane = tid & 63, wave = tid >> 6;
  const int wr = wave >> 1, wc = wave & 1, fr = lane & 15, fq = lane >> 4;
  const int kc8 = ((lane & 3) ^ ((4 - (lane >> 4)) & 3)) * 8;
  const int psw = (fq ^ ((4 - (fr >> 2)) & 3)) * 8;
  u16* sm = (u16*)smem;
  const u16* ap0 = nullptr;
  unsigned ao0 = 0, ao1 = 0, ao2 = 0, ao3 = 0;
  if (a.mode == 0) {
    ap0 = a.base + (size_t)(a.row0 + wave * 64 + (lane >> 2)) * a.ld + kc8;
  } else {
    const unsigned bo = (unsigned)((const char*)a.base - a.wsb), zo = (unsigned)((const char*)a.zero - a.wsb) + kc8 * 2;
#define G3_AP(j)                                                                          \
    {                                                                                     \
      int t = a.t0 + wave * 64 + j * 16 + (lane >> 2);                                    \
      ao##j = (t >= 0 && t < T_) ? bo + (unsigned)(((a.row0 + t) * a.ld + kc8) * 2) : zo; \
    }
    REP4(G3_AP)
#undef G3_AP
  }
  const u16* bp0 = Bt + (size_t)(n0 + wave * (8 * NI) + (lane >> 2)) * ldb + kc8;
  const size_t astep = (size_t)16 * a.ld;
  const size_t bstep = (size_t)16 * ldb;
#define G3_ISSUE(j)                                                                                                              \
  __builtin_amdgcn_global_load_lds((a.mode == 0) ? (const unsigned*)(ap0 + j * astep + kof) : (const unsigned*)(a.wsb + ao##j + kof * 2), (unsigned*)(st_ + (wave * 64 + j * 16) * 32 + lane * 8), 16, 0, 0); \
  if (2 * j < NI) __builtin_amdgcn_global_load_lds((const unsigned*)(bp0 + j * bstep + kof), (unsigned*)(st_ + 8192 + (wave * (8 * NI) + j * 16) * 32 + lane * 8), 16, 0, 0);
  const int nk = K / 32;
  asm volatile("s_waitcnt vmcnt(0)" ::: "memory");
  {
    const int kof = 0;
    u16* st_ = sm;
    REP4(G3_ISSUE)
  }
  if (nk > 1) {
    const int kof = 32;
    u16* st_ = sm + G3_STAGE;
    REP4(G3_ISSUE)
  }
  int cur = 0, nxt = 2;
  const unsigned lds0 = (unsigned)(size_t)(__attribute__((address_space(3))) char*)smem;
  const unsigned aoff = lds0 + (unsigned)(((wr * 128 + fr) * 32 + psw) * 2);
  const unsigned boff = lds0 + 16384u + (unsigned)(((wc * (NI * 16) + fr) * 32 + psw) * 2);
#define G3_DSR(dst, addr, off) asm volatile("ds_read_b128 %0, %1 offset:" #off : "=v"(dst) : "v"(addr))
  for (int kt = 0; kt < nk; kt++) {
    if (kt + 1 < nk) {
      if (NI == 4) asm volatile("s_waitcnt vmcnt(6)" ::: "memory");
      else asm volatile("s_waitcnt vmcnt(5)" ::: "memory");
    } else {
      asm volatile("s_waitcnt vmcnt(0)" ::: "memory");
    }
    __builtin_amdgcn_s_barrier();
    if (kt + 2 < nk) {
      const int kof = (kt + 2) * 32;
      u16* st_ = sm + nxt * G3_STAGE;
      REP4(G3_ISSUE)
    }
    const unsigned aaddr = aoff + (unsigned)cur * (G3_STAGE * 2);
    const unsigned baddr = boff + (unsigned)cur * (G3_STAGE * 2);
    bf16x8 af[8], bf[NI];
    G3_DSR(af[0], aaddr, 0); G3_DSR(af[1], aaddr, 1024); G3_DSR(af[2], aaddr, 2048); G3_DSR(af[3], aaddr, 3072);
    G3_DSR(bf[0], baddr, 0); G3_DSR(bf[1], baddr, 1024);
    if (NI == 4) { G3_DSR(bf[NI - 2], baddr, 2048); G3_DSR(bf[NI - 1], baddr, 3072); }
    G3_DSR(af[4], aaddr, 4096); G3_DSR(af[5], aaddr, 5120); G3_DSR(af[6], aaddr, 6144); G3_DSR(af[7], aaddr, 7168);
    if (NI == 4) {
      asm volatile("s_waitcnt lgkmcnt(4)"
                   : "+v"(af[0]), "+v"(af[1]), "+v"(af[2]), "+v"(af[3]), "+v"(bf[0]), "+v"(bf[1]), "+v"(bf[NI - 2]), "+v"(bf[NI - 1]));
    } else {
      asm volatile("s_waitcnt lgkmcnt(4)" : "+v"(af[0]), "+v"(af[1]), "+v"(af[2]), "+v"(af[3]), "+v"(bf[0]), "+v"(bf[1]));
    }
#pragma unroll
    for (int mi = 0; mi < 4; mi++)
#pragma unroll
      for (int ni = 0; ni < NI; ni++)
        acc[mi][ni] = SWAP ? __builtin_amdgcn_mfma_f32_16x16x32_bf16(bf[ni], af[mi], acc[mi][ni], 0, 0, 0)
                           : __builtin_amdgcn_mfma_f32_16x16x32_bf16(af[mi], bf[ni], acc[mi][ni], 0, 0, 0);
    asm volatile("s_waitcnt lgkmcnt(0)" : "+v"(af[4]), "+v"(af[5]), "+v"(af[6]), "+v"(af[7]));
#pragma unroll
    for (int mi = 4; mi < 8; mi++)
#pragma unroll
      for (int ni = 0; ni < NI; ni++)
        acc[mi][ni] = SWAP ? __builtin_amdgcn_mfma_f32_16x16x32_bf16(bf[ni], af[mi], acc[mi][ni], 0, 0, 0)
                           : __builtin_amdgcn_mfma_f32_16x16x32_bf16(af[mi], bf[ni], acc[mi][ni], 0, 0, 0);
    cur = (cur == 2) ? 0 : cur + 1;
    nxt = (nxt == 2) ? 0 : nxt + 1;
  }
  asm volatile("s_waitcnt lgkmcnt(0)" ::: "memory");
  __syncthreads();
#undef G3_DSR
#undef G3_ISSUE
}

template <int NI>
__device__ __forceinline__ void zero_acc8(f32x4 (&acc)[8][NI]) {
#pragma unroll
  for (int i = 0; i < 8; i++)
#pragma unroll
    for (int j = 0; j < NI; j++) acc[i][j] = f32x4{0.f, 0.f, 0.f, 0.f};
}


__device__ __forceinline__ bool map_tile(int i, int nblk, int MT, int NT, int& mt, int& nt) {
  const int locs = nblk >> 3;
  const int xcd = blockIdx.x & 7, loc = blockIdx.x >> 3;
  const int q = (i * 8 + xcd) * locs + loc;
  if (q >= MT * NT) return false;
  const int nfull = NT >> 3, per = MT * 8;
  if (q < nfull * per) {
    int pp = q / per, r = q - pp * per;
    mt = r >> 3;
    nt = pp * 8 + (r & 7);
  } else {
    int r = q - nfull * per;
    int w = NT - nfull * 8;
    mt = r / w;
    nt = nfull * 8 + (r - mt * w);
  }
  return true;
}

#define ACC_COORDS const int wr = wave >> 1, wc = wave & 1, fr = lane & 15, fq = lane >> 4;

__device__ __forceinline__ void conv_tile(const Params& p, int t, char* smem, const int tid) {
  int j = 0;
#pragma unroll 1
  for (int i = 1; i < 26; i++)
    if (t >= p.jobs[i].tile0) j = i;
  const Job& jb = p.jobs[j];
  float(*tile)[65] = (float(*)[65])smem;
  int local = t - jb.tile0;
  int nkt = jb.Kpad >> 6;
  int kt = local % nkt, nt = local / nkt;
  int tx = tid & 63, ty = tid >> 6;
  int n = nt * 64 + tx;
  int col;
  if (jb.mode == 0) col = jb.c0 + n;
  else { int jn = n >> 7, i = n & 127; col = (i < 64) ? (64 * jn + i) : (DFF_ + 64 * jn + (i - 64)); }
  const float* sp = jb.src + col;
  const int K = jb.K, ld = jb.ld;
  const bool nok = n < jb.Nv;
#pragma unroll
  for (int i = 0; i < 16; i++) {
    int k = kt * 64 + ty + 4 * i;
    tile[ty + 4 * i][tx] = (nok && k < K) ? sp[(size_t)k * ld] : 0.f;
  }
  __syncthreads();
#pragma unroll
  for (int i = 0; i < 16; i++) {
    int nn = nt * 64 + ty + 4 * i;
    int k = kt * 64 + tx;
    jb.dst[(size_t)nn * jb.Kpad + k] = f2bf(tile[tx][ty + 4 * i]);
  }
  __syncthreads();
}

__device__ __forceinline__ void ln_row(const float* __restrict__ src, const float* __restrict__ g,
                                       const float* __restrict__ b, float* __restrict__ dst, int lane, u16* __restrict__ dstb = nullptr) {
  float4 v[4];
  float s = 0.f;
#pragma unroll
  for (int i = 0; i < 4; i++) {
    v[i] = *(const float4*)(src + i * 256 + lane * 4);
    s += v[i].x + v[i].y + v[i].z + v[i].w;
  }
  float mean = wave_sum(s, lane) * (1.0f / 1024.0f);
  float q = 0.f;
#pragma unroll
  for (int i = 0; i < 4; i++) {
    float a = v[i].x - mean, b2 = v[i].y - mean, c = v[i].z - mean, d = v[i].w - mean;
    q += a * a + b2 * b2 + c * c + d * d;
  }
  float rstd = rsqrtf(wave_sum(q, lane) * (1.0f / 1024.0f) + 1e-5f);
#pragma unroll
  for (int i = 0; i < 4; i++) {
    float4 gg = *(const float4*)(g + i * 256 + lane * 4);
    float4 bb = *(const float4*)(b + i * 256 + lane * 4);
    float4 o;
    o.x = (v[i].x - mean) * rstd * gg.x + bb.x;
    o.y = (v[i].y - mean) * rstd * gg.y + bb.y;
    o.z = (v[i].z - mean) * rstd * gg.z + bb.z;
    o.w = (v[i].w - mean) * rstd * gg.w + bb.w;
    *(float4*)(dst + i * 256 + lane * 4) = o;
    if (dstb) *(uint2*)(dstb + i * 256 + lane * 4) = make_uint2(pk2(o.x, o.y), pk2(o.z, o.w));
  }
}

__device__ __forceinline__ void ln_row2(const float* __restrict__ srcA, const float* __restrict__ srcB, const float* __restrict__ g,
                                        const float* __restrict__ b, float* dstA, float* dstB, int lane, u16* dbA, u16* dbB) {
  float4 va[4], vb[4];
  float sa = 0.f, sb = 0.f;
#pragma unroll
  for (int i = 0; i < 4; i++) {
    va[i] = *(const float4*)(srcA + i * 256 + lane * 4);
    vb[i] = *(const float4*)(srcB + i * 256 + lane * 4);
  }
#pragma unroll
  for (int i = 0; i < 4; i++) {
    sa += va[i].x + va[i].y + va[i].z + va[i].w;
    sb += vb[i].x + vb[i].y + vb[i].z + vb[i].w;
  }
  const float ma = wave_sum(sa, lane) * (1.0f / 1024.0f), mb = wave_sum(sb, lane) * (1.0f / 1024.0f);
  float qa = 0.f, qb = 0.f;
#pragma unroll
  for (int i = 0; i < 4; i++) {
    va[i].x -= ma; va[i].y -= ma; va[i].z -= ma; va[i].w -= ma;
    vb[i].x -= mb; vb[i].y -= mb; vb[i].z -= mb; vb[i].w -= mb;
    qa += va[i].x * va[i].x + va[i].y * va[i].y + va[i].z * va[i].z + va[i].w * va[i].w;
    qb += vb[i].x * vb[i].x + vb[i].y * vb[i].y + vb[i].z * vb[i].z + vb[i].w * vb[i].w;
  }
  const float ra = rsqrtf(wave_sum(qa, lane) * (1.0f / 1024.0f) + 1e-5f), rb = rsqrtf(wave_sum(qb, lane) * (1.0f / 1024.0f) + 1e-5f);
#pragma unroll
  for (int i = 0; i < 4; i++) {
    float4 gg = *(const float4*)(g + i * 256 + lane * 4);
    float4 bb = *(const float4*)(b + i * 256 + lane * 4);
    float4 oa, ob;
    oa.x = va[i].x * ra * gg.x + bb.x; oa.y = va[i].y * ra * gg.y + bb.y; oa.z = va[i].z * ra * gg.z + bb.z; oa.w = va[i].w * ra * gg.w + bb.w;
    ob.x = vb[i].x * rb * gg.x + bb.x; ob.y = vb[i].y * rb * gg.y + bb.y; ob.z = vb[i].z * rb * gg.z + bb.z; ob.w = vb[i].w * rb * gg.w + bb.w;
    *(float4*)(dstA + i * 256 + lane * 4) = oa;
    *(float4*)(dstB + i * 256 + lane * 4) = ob;
    if (dbA) {
      *(uint2*)(dbA + i * 256 + lane * 4) = make_uint2(pk2(oa.x, oa.y), pk2(oa.z, oa.w));
      *(uint2*)(dbB + i * 256 + lane * 4) = make_uint2(pk2(ob.x, ob.y), pk2(ob.z, ob.w));
    }
  }
}

struct ScanIn {
  float kk[16][64], wr[16][64], w[16][64], kt[16][64], kka[16][64], v[16][64], g[16][64];
  float c[16][4];
};
struct ScanRaw { uint2 r, k, v, rp, kp, vp, a, g; float4 dec; };

__device__ __forceinline__ ScanRaw scan_fetch(const u16* __restrict__ P, const float* __restrict__ DEC,
                                              const u16* __restrict__ AA, const u16* __restrict__ GG, int rowbase, int t,
                                              int hc) {
  ScanRaw w;
  size_t row = (size_t)(rowbase + t);
  const u16* pp = P + row * PC_ + hc;
  w.r = *(const uint2*)(pp);
  w.k = *(const uint2*)(pp + 512);
  w.v = *(const uint2*)(pp + 1024);
  if (t > 0) {
    w.rp = *(const uint2*)(pp - PC_);
    w.kp = *(const uint2*)(pp - PC_ + 512);
    w.vp = *(const uint2*)(pp - PC_ + 1024);
  } else {
    w.rp = make_uint2(0, 0); w.kp = make_uint2(0, 0); w.vp = make_uint2(0, 0);
  }
  w.dec = *(const float4*)(DEC + row * 512 + hc);
  w.a = *(const uint2*)(AA + row * 512 + hc);
  w.g = *(const uint2*)(GG + row * 512 + hc);
  return w;
}

__device__ __forceinline__ void unpack4(uint2 u, float (&o)[4]) {
  o[0] = bflo(u.x); o[1] = bfhi(u.x); o[2] = bflo(u.y); o[3] = bfhi(u.y);
}

__device__ __forceinline__ void scan_unit(const Params& p, int l, int bh, char* smem, const int tid) {
  const int lane = tid & 63, wave = tid >> 6;
  const int b = bh >> 3, h = bh & 7;
  const int rowbase = b * T_;
  const u16* P = (const u16*)(p.ws + OFF_P);
  const float* DEC = (const float*)(p.ws + OFF_DEC);
  const u16* AA = (const u16*)(p.ws + OFF_AA);
  const u16* GG = (const u16*)(p.ws + OFF_GG);
  u16* YR = (u16*)(p.ws + OFF_AA);
  ScanIn* in = (ScanIn*)smem;
  float(*ybuf)[64] = (float(*)[64])(smem + 2 * sizeof(ScanIn));
  const int tl = tid >> 4, kq = tid & 15, hc = h * 64 + kq * 4;
  float(*cst)[64] = (float(*)[64])(smem + 2 * sizeof(ScanIn) + 16 * 64 * 4);
  if (tid < 64) {
    const float* mu = p.in[5] + (size_t)l * 1824;
    const int ch = h * 64 + tid;
    cst[0][tid] = mu[ch];
    cst[1][tid] = mu[512 + ch];
    cst[2][tid] = mu[1024 + ch];
    cst[3][tid] = p.in[11][l * 512 + ch];
    float ka_ = p.in[12][l * 512 + ch];
    cst[4][tid] = ka_;
    cst[5][tid] = 1.0f - ka_;
    cst[6][tid] = p.in[13][l * 512 + ch];
    cst[7][tid] = p.in[14][l * 512 + ch];
    cst[8][tid] = p.in[15][l * 512 + ch];
  }
  __syncthreads();
  const int rp = lane >> 3, ks = lane & 7, row0 = wave * 16 + rp * 2;
  typedef float f2s __attribute__((ext_vector_type(2)));
  f2s S2[2][4];
#pragma unroll
  for (int i = 0; i < 2; i++)
#pragma unroll
    for (int e = 0; e < 4; e++) S2[i][e] = f2s{0.f, 0.f};

  auto stage = [&](const ScanRaw& w, ScanIn& dst) {
    float r[4], k[4], v[4], rq[4], kp[4], vp[4], a[4], g[4];
    unpack4(w.r, r); unpack4(w.k, k); unpack4(w.v, v);
    unpack4(w.rp, rq); unpack4(w.kp, kp); unpack4(w.vp, vp);
    unpack4(w.a, a); unpack4(w.g, g);
    float dec[4] = {w.dec.x, w.dec.y, w.dec.z, w.dec.w};
    float mu_r[4], mu_k[4], mu_v[4], kkw[4], kaw[4], omk[4], rkw[4];
    *(float4*)mu_r = *(const float4*)&cst[0][kq * 4]; *(float4*)mu_k = *(const float4*)&cst[1][kq * 4];
    *(float4*)mu_v = *(const float4*)&cst[2][kq * 4]; *(float4*)kkw = *(const float4*)&cst[3][kq * 4];
    *(float4*)kaw = *(const float4*)&cst[4][kq * 4]; *(float4*)omk = *(const float4*)&cst[5][kq * 4];
    *(float4*)rkw = *(const float4*)&cst[6][kq * 4];
    float kkr[4], ss = 0.f;
#pragma unroll
    for (int e = 0; e < 4; e++) {
      r[e] = r[e] + (rq[e] - r[e]) * mu_r[e];
      k[e] = k[e] + (kp[e] - k[e]) * mu_k[e];
      v[e] = v[e] + (vp[e] - v[e]) * mu_v[e];
      kkr[e] = k[e] * kkw[e];
      ss += kkr[e] * kkr[e];
    }
    ss = sum16(ss);
    float inv = rsqrtf(fmaxf(ss, 1e-24f));
    float c1 = 0.f, c2 = 0.f, c3 = 0.f;
    float kk[4], ktl[4], kka[4], wr[4];
#pragma unroll
    for (int e = 0; e < 4; e++) {
      kk[e] = kkr[e] * inv;
      ktl[e] = k[e] * fmaf(a[e], kaw[e], omk[e]);
      kka[e] = kk[e] * a[e];
      wr[e] = dec[e] * r[e];
      c1 += kka[e] * r[e];
      c2 += ktl[e] * r[e];
      c3 += r[e] * ktl[e] * rkw[e];
    }
    c1 = sum16(c1); c2 = sum16(c2); c3 = sum16(c3);
    *(float4*)&dst.kk[tl][kq * 4] = make_float4(kk[0], kk[1], kk[2], kk[3]);
    *(float4*)&dst.wr[tl][kq * 4] = make_float4(wr[0], wr[1], wr[2], wr[3]);
    *(float4*)&dst.w[tl][kq * 4] = make_float4(dec[0], dec[1], dec[2], dec[3]);
    *(float4*)&dst.kt[tl][kq * 4] = make_float4(ktl[0], ktl[1], ktl[2], ktl[3]);
    *(float4*)&dst.kka[tl][kq * 4] = make_float4(kka[0], kka[1], kka[2], kka[3]);
    *(float4*)&dst.v[tl][kq * 4] = make_float4(v[0], v[1], v[2], v[3]);
    *(float4*)&dst.g[tl][kq * 4] = make_float4(g[0], g[1], g[2], g[3]);
    if (kq == 0) *(float4*)&dst.c[tl][0] = make_float4(c1, c2, c3, 0.f);
  };

  {
    ScanRaw w0 = scan_fetch(P, DEC, AA, GG, rowbase, tl, hc);
    stage(w0, in[0]);
  }
  __syncthreads();
  constexpr int NCH = T_ / 16;
  for (int c = 0; c < NCH; c++) {
    ScanIn& cur = in[c & 1];
    ScanRaw nx;
    const bool have_next = (c + 1 < NCH);
    if (have_next) nx = scan_fetch(P, DEC, AA, GG, rowbase, (c + 1) * 16 + tl, hc);
    {
      typedef float f2 __attribute__((ext_vector_type(2)));
      struct StepA { float4 kk0, kk1, wr0, wr1; };
      struct StepIn { float4 kk0, kk1, wr0, wr1, w0, w1, kt0, kt1, ka0, ka1; float2 vv, cc; };
      auto ldA = [&](int s) {
        StepA r;
        r.kk0 = *(const float4*)&cur.kk[s][ks * 8]; r.kk1 = *(const float4*)&cur.kk[s][ks * 8 + 4];
        r.wr0 = *(const float4*)&cur.wr[s][ks * 8]; r.wr1 = *(const float4*)&cur.wr[s][ks * 8 + 4];
        return r;
      };
      StepA nxa = ldA(0);
#pragma unroll 1
      for (int s4 = 0; s4 < 16; s4 += 4) {
      float yv[4][2];
#pragma unroll
      for (int u = 0; u < 4; u++) {
        const int s = s4 + u;
        StepIn in_;
        in_.kk0 = nxa.kk0; in_.kk1 = nxa.kk1; in_.wr0 = nxa.wr0; in_.wr1 = nxa.wr1;
        in_.vv = *(const float2*)&cur.v[s][row0];
        in_.cc = *(const float2*)&cur.c[s][0];
        in_.w0 = *(const float4*)&cur.w[s][ks * 8];   in_.w1 = *(const float4*)&cur.w[s][ks * 8 + 4];
        in_.kt0 = *(const float4*)&cur.kt[s][ks * 8]; in_.kt1 = *(const float4*)&cur.kt[s][ks * 8 + 4];
        in_.ka0 = *(const float4*)&cur.kka[s][ks * 8]; in_.ka1 = *(const float4*)&cur.kka[s][ks * 8 + 4];
        nxa = ldA((s + 1) & 15);
        const f2 kk[4] = {{in_.kk0.x, in_.kk0.y}, {in_.kk0.z, in_.kk0.w}, {in_.kk1.x, in_.kk1.y}, {in_.kk1.z, in_.kk1.w}};
        const f2 wr[4] = {{in_.wr0.x, in_.wr0.y}, {in_.wr0.z, in_.wr0.w}, {in_.wr1.x, in_.wr1.y}, {in_.wr1.z, in_.wr1.w}};
        const f2 w[4] = {{in_.w0.x, in_.w0.y}, {in_.w0.z, in_.w0.w}, {in_.w1.x, in_.w1.y}, {in_.w1.z, in_.w1.w}};
        const f2 kt[4] = {{in_.kt0.x, in_.kt0.y}, {in_.kt0.z, in_.kt0.w}, {in_.kt1.x, in_.kt1.y}, {in_.kt1.z, in_.kt1.w}};
        const f2 ka[4] = {{in_.ka0.x, in_.ka0.y}, {in_.ka0.z, in_.ka0.w}, {in_.ka1.x, in_.ka1.y}, {in_.ka1.z, in_.ka1.w}};
        const float vr[2] = {in_.vv.x, in_.vv.y};
        float d1[2], d2[2];
#pragma unroll
        for (int i = 0; i < 2; i++) {
          f2 a = S2[i][0] * kk[0] + S2[i][1] * kk[1];
          f2 a2 = S2[i][2] * kk[2] + S2[i][3] * kk[3];
          f2 bq = S2[i][0] * wr[0] + S2[i][1] * wr[1];
          f2 b2 = S2[i][2] * wr[2] + S2[i][3] * wr[3];
          a += a2; bq += b2;
          d1[i] = a.x + a.y;
          d2[i] = bq.x + bq.y;
        }
        d1[0] = sum8(d1[0]); d1[1] = sum8(d1[1]); d2[0] = sum8(d2[0]); d2[1] = sum8(d2[1]);
#pragma unroll
        for (int i = 0; i < 2; i++) {
          const float skk = d1[i];
          yv[u][i] = d2[i] - skk * in_.cc.x + vr[i] * in_.cc.y;
          const f2 nsk = {-skk, -skk}, vv2 = {vr[i], vr[i]};
#pragma unroll
          for (int e = 0; e < 4; e++) S2[i][e] = S2[i][e] * w[e] + (nsk * ka[e] + vv2 * kt[e]);
        }
      }
      if (ks == 0) {
#pragma unroll
        for (int u = 0; u < 4; u++) *(float2*)&ybuf[s4 + u][row0] = make_float2(yv[u][0], yv[u][1]);
      }
      }
    }
    __syncthreads();
    {
      float4 y4 = *(const float4*)&ybuf[tl][kq * 4];
      float y[4] = {y4.x, y4.y, y4.z, y4.w};
      float mean = sum16(y[0] + y[1] + y[2] + y[3]) * (1.0f / 64.0f);
      float q = 0.f;
#pragma unroll
      for (int e = 0; e < 4; e++) { y[e] -= mean; q += y[e] * y[e]; }
      float rstd = rsqrtf(sum16(q) * (1.0f / 64.0f) + 64e-5f);
      float c3 = cur.c[tl][2];
      float4 v4 = *(const float4*)&cur.v[tl][kq * 4];
      float4 g4 = *(const float4*)&cur.g[tl][kq * 4];
      float vv[4] = {v4.x, v4.y, v4.z, v4.w};
      float gg[4] = {g4.x, g4.y, g4.z, g4.w};
      float o[4], lg[4], lb[4];
      *(float4*)lg = *(const float4*)&cst[7][kq * 4]; *(float4*)lb = *(const float4*)&cst[8][kq * 4];
#pragma unroll
      for (int e = 0; e < 4; e++) o[e] = (y[e] * rstd * lg[e] + lb[e] + c3 * vv[e]) * gg[e];
      size_t row = (size_t)(rowbase + c * 16 + tl);
      *(uint2*)(YR + row * 512 + hc) = make_uint2(pk2(o[0], o[1]), pk2(o[2], o[3]));
    }
    if (have_next) stage(nx, in[(c + 1) & 1]);
    __syncthreads();
  }
}

constexpr int KLD = 104, VLD = 72;
struct AttnSmem { u16 k[2][64 * KLD]; u16 v[2][64 * VLD]; };

__device__ __forceinline__ void attn_unit(const Params& p, int bh, int qi, char* smem, const int tid) {
  const int lane = tid & 63, wave = tid >> 6;
  const int fr = lane & 15, fq = lane >> 4;
  const int b = bh >> 3, h = bh & 7;
  const int rowbase = b * T_;
  u16* P = (u16*)(p.ws + OFF_P);
  const u16* Q = (const u16*)(p.ws + OFF_Q);
  const u16* KN = (const u16*)p.out;
  const u16* VT = (const u16*)p.out + (size_t)M_ * 512;
  const float2* ROPE = (const float2*)(p.ws + OFF_ROPE);
  AttnSmem* sm = (AttnSmem*)smem;
  const int qs = (qi == 0) ? 0 : 16 + (qi - 1) * 128;
  const int qn = (qi == 0) ? 16 : 128;
  const int q0 = qs + wave * 32;
  const bool wave_valid = (wave * 32 < qn);
  const int nkt = (qs + qn - 1) / 64 + 1;

  bf16x8 qf[2][3];
#pragma unroll
  for (int qb = 0; qb < 2; qb++) {
    int query = min(q0 + qb * 16 + fr, T_ - 1);
    const u16* qp = Q + (size_t)(rowbase + query) * 768 + h * 96;
    uint4 a0 = *(const uint4*)(qp + fq * 8);
    uint4 a1 = *(const uint4*)(qp + 32 + fq * 8);
    uint4 own = *(const uint4*)(qp + 64 + fq * 8);
    uint4 oth = *(const uint4*)(qp + 64 + (fq ^ 2) * 8);
    unsigned ow[4] = {own.x, own.y, own.z, own.w};
    unsigned tw[4] = {oth.x, oth.y, oth.z, oth.w};
    unsigned rw[4];
    const float2* rp = ROPE + (size_t)query * 16 + (fq & 1) * 8;
#pragma unroll
    for (int e = 0; e < 4; e++) {
      float2 cs0 = rp[2 * e], cs1 = rp[2 * e + 1];
      float o0 = bflo(ow[e]), o1 = bfhi(ow[e]);
      float t0 = bflo(tw[e]), t1 = bfhi(tw[e]);
      float r0, r1;
      if (fq < 2) { r0 = o0 * cs0.x - t0 * cs0.y; r1 = o1 * cs1.x - t1 * cs1.y; }
      else { r0 = t0 * cs0.y + o0 * cs0.x; r1 = t1 * cs1.y + o1 * cs1.x; }
      rw[e] = pk2(r0, r1);
    }
    uint4 a2 = make_uint4(rw[0], rw[1], rw[2], rw[3]);
    qf[qb][0] = *(bf16x8*)&a0;
    qf[qb][1] = *(bf16x8*)&a1;
    qf[qb][2] = *(bf16x8*)&a2;
  }

  f32x4 O[4][2];
#pragma unroll
  for (int i = 0; i < 4; i++)
#pragma unroll
    for (int j = 0; j < 2; j++) O[i][j] = f32x4{0.f, 0.f, 0.f, 0.f};
  float mrun[2] = {-1e30f, -1e30f}, lrun[2] = {0.f, 0.f};
  const float sc = 1.4426950408889634f / 9.797958971132712f;

  uint4 rk[3], rv[2];
  auto fetch_tile = [&](int kt) {
#pragma unroll
    for (int i = 0; i < 3; i++) {
      int c = tid + 256 * i;
      int key = c / 12, cc = c % 12;
      int t = kt * 64 + key;
      uint4 val = make_uint4(0, 0, 0, 0);
      if (t < T_) {
        size_t row = (size_t)(rowbase + t);
        if (cc < 8) val = *(const uint4*)(KN + row * 512 + h * 64 + cc * 8);
        else val = *(const uint4*)(P + row * PC_ + PKR_ + (cc - 8) * 8);
      }
      rk[i] = val;
    }
#pragma unroll
    for (int i = 0; i < 2; i++) {
      int c = tid + 256 * i;
      int dv = c >> 3, cc = c & 7;
      int t = kt * 64 + cc * 8;
      uint4 val = make_uint4(0, 0, 0, 0);
      if (t < T_) val = *(const uint4*)(VT + ((size_t)bh * 64 + dv) * T_ + t);
      rv[i] = val;
    }
  };
  auto store_tile = [&](int buf) {
#pragma unroll
    for (int i = 0; i < 3; i++) {
      int c = tid + 256 * i;
      int key = c / 12, cc = c % 12;
      *(uint4*)(&sm->k[buf][key * KLD + cc * 8]) = rk[i];
    }
#pragma unroll
    for (int i = 0; i < 2; i++) {
      int c = tid + 256 * i;
      int dv = c >> 3, cc = c & 7;
      *(uint4*)(&sm->v[buf][dv * VLD + cc * 8]) = rv[i];
    }
  };

  fetch_tile(0);
  for (int kt = 0; kt < nkt; kt++) {
    const int buf = kt & 1;
    store_tile(buf);
    __syncthreads();
    if (kt + 1 < nkt) fetch_tile(kt + 1);
    if (wave_valid && kt * 64 <= q0 + 31) {
      const u16* Ks = sm->k[buf];
      const u16* Vs = sm->v[buf];
      f32x4 s[4][2];
#pragma unroll
      for (int i = 0; i < 4; i++)
#pragma unroll
        for (int j = 0; j < 2; j++) s[i][j] = f32x4{0.f, 0.f, 0.f, 0.f};
#pragma unroll
      for (int ks = 0; ks < 3; ks++)
#pragma unroll
        for (int kb = 0; kb < 4; kb++) {
          bf16x8 kf = *(const bf16x8*)(Ks + (kb * 16 + fr) * KLD + ks * 32 + fq * 8);
#pragma unroll
          for (int qb = 0; qb < 2; qb++) s[kb][qb] = __builtin_amdgcn_mfma_f32_16x16x32_bf16(kf, qf[qb][ks], s[kb][qb], 0, 0, 0);
        }
      const bool need_mask = (kt * 64 + 63 > q0);
      unsigned pfw[2][2][4];
#pragma unroll
      for (int qb = 0; qb < 2; qb++) {
        const int query = q0 + qb * 16 + fr;
        float mx = -1e30f;
        if (need_mask) {
#pragma unroll
          for (int kb = 0; kb < 4; kb++)
#pragma unroll
            for (int j = 0; j < 4; j++) {
              int key = kt * 64 + kb * 16 + fq * 4 + j;
              if (key > query) s[kb][qb][j] = -1e30f;
            }
        }
#pragma unroll
        for (int kb = 0; kb < 4; kb++)
          mx = fmaxf(mx, fmaxf(fmaxf(s[kb][qb][0], s[kb][qb][1]), fmaxf(s[kb][qb][2], s[kb][qb][3])));
        mx = fmaxf(mx, shx(mx, lane, 16));
        mx = fmaxf(mx, shx(mx, lane, 32));
        const float mold = mrun[qb];
        const float mnew = fmaxf(mold, mx * sc);
        mrun[qb] = mnew;
        float ps = 0.f;
#pragma unroll
        for (int kb = 0; kb < 4; kb++) {
          float p0 = __builtin_amdgcn_exp2f(fmaf(s[kb][qb][0], sc, -mnew)), p1 = __builtin_amdgcn_exp2f(fmaf(s[kb][qb][1], sc, -mnew));
          float p2 = __builtin_amdgcn_exp2f(fmaf(s[kb][qb][2], sc, -mnew)), p3 = __builtin_amdgcn_exp2f(fmaf(s[kb][qb][3], sc, -mnew));
          ps += (p0 + p1) + (p2 + p3);
          pfw[qb][kb >> 1][(kb & 1) * 2 + 0] = pk2(p0, p1);
          pfw[qb][kb >> 1][(kb & 1) * 2 + 1] = pk2(p2, p3);
        }
        if (__builtin_amdgcn_ballot_w64(mnew != mold) != 0) {
          const float alpha = __builtin_amdgcn_exp2f(mold - mnew);
          lrun[qb] *= alpha;
#pragma unroll
          for (int dvb = 0; dvb < 4; dvb++) {
            O[dvb][qb][0] *= alpha; O[dvb][qb][1] *= alpha; O[dvb][qb][2] *= alpha; O[dvb][qb][3] *= alpha;
          }
        }
        lrun[qb] += ps;
      }
#pragma unroll
      for (int s2 = 0; s2 < 2; s2++)
#pragma unroll
        for (int dvb = 0; dvb < 4; dvb++) {
          const u16* vp = Vs + (dvb * 16 + fr) * VLD + s2 * 32 + fq * 4;
          uint2 v0 = *(const uint2*)vp;
          uint2 v1 = *(const uint2*)(vp + 16);
          uint4 vv = make_uint4(v0.x, v0.y, v1.x, v1.y);
          bf16x8 vf = *(bf16x8*)&vv;
#pragma unroll
          for (int qb = 0; qb < 2; qb++) {
            uint4 pw = make_uint4(pfw[qb][s2][0], pfw[qb][s2][1], pfw[qb][s2][2], pfw[qb][s2][3]);
            O[dvb][qb] = __builtin_amdgcn_mfma_f32_16x16x32_bf16(vf, *(bf16x8*)&pw, O[dvb][qb], 0, 0, 0);
          }
        }
    }
  }
  __syncthreads();
  if (wave_valid) {
#pragma unroll
    for (int qb = 0; qb < 2; qb++) {
      float l = lrun[qb];
      l += shx(l, lane, 16);
      l += shx(l, lane, 32);
      float inv = 1.0f / l;
      int query = q0 + qb * 16 + fr;
      if (query < qs + qn) {
        u16* op = P + (size_t)(rowbase + query) * PC_ + PMLA_ + h * 64 + fq * 4;
#pragma unroll
        for (int dvb = 0; dvb < 4; dvb++) {
          *(uint2*)(op + dvb * 16) =
              make_uint2(pk2(O[dvb][qb][0] * inv, O[dvb][qb][1] * inv), pk2(O[dvb][qb][2] * inv, O[dvb][qb][3] * inv));
        }
      }
    }
  }
}

#define XB_TMO      128
#define XB_XCNT(j)  (256  + 64 * (j))
#define XB_XSUB(j)  (1280 + 64 * (j))
#define XB_XGEN(j)  (2304 + 64 * (j))
#define XB_TOP      3328
#define XB_TOPGEN   3392
#define XCD_BAR_WORDS 3456
#define XB_SPIN_CAP (1u << 18)
#define LAS __attribute__((address_space(3)))

__device__ __forceinline__ unsigned xb_ld(unsigned* p)              { return __hip_atomic_load(p, __ATOMIC_RELAXED, __HIP_MEMORY_SCOPE_AGENT); }
__device__ __forceinline__ unsigned xb_add(unsigned* p, unsigned v) { return __hip_atomic_fetch_add(p, v, __ATOMIC_RELAXED, __HIP_MEMORY_SCOPE_AGENT); }
__device__ __forceinline__ unsigned xb_xcc_id() { return (unsigned)__builtin_amdgcn_s_getreg((3 << 11) | 20) & 0xFu; }
#define XB_SPIN(cond, bar) do { unsigned _sp = 0; while (cond) { __builtin_amdgcn_s_sleep(1); \
    if ((++_sp & 255u) == 0u) { if (xb_ld(&(bar)[XB_TMO])) break; if (_sp > XB_SPIN_CAP) { atomicAdd(&(bar)[XB_TMO], 1u); break; } } } } while (0)

struct XcdBarrier {
    unsigned* bar; unsigned x;
    volatile LAS unsigned* st;
};

__device__ __forceinline__ XcdBarrier xcd_barrier_post(unsigned* bar, volatile LAS unsigned* st) {
    XcdBarrier b; b.bar = bar; b.x = xb_xcc_id(); b.st = st;
    if (threadIdx.x == 0) (void)xb_add(&bar[XB_XCNT(b.x)], 1u);
    return b;
}
__device__ __forceinline__ void xcd_barrier_complete(unsigned* bar, unsigned x, unsigned& nloc, unsigned& nx) {
    const unsigned G = gridDim.x * gridDim.y * gridDim.z;
    unsigned sum, cnt, mine, sp = 0u;
    for (;;) {
        sum = 0u; cnt = 0u; mine = 0u;
#pragma unroll
        for (unsigned j = 0; j < 16; ++j) { const unsigned c = xb_ld(&bar[XB_XCNT(j)]); sum += c; cnt += (c > 0u) ? 1u : 0u; mine = (j == x) ? c : mine; }
        if (sum == G) break;
        __builtin_amdgcn_s_sleep(1);
        if ((++sp & 255u) == 0u) { if (xb_ld(&bar[XB_TMO])) break; if (sp > XB_SPIN_CAP) { atomicAdd(&bar[XB_TMO], 1u); break; } }
    }
    nloc = mine > 0u ? mine : 1u; nx = cnt > 0u ? cnt : 1u;
}

__device__ __forceinline__ void xcd_barrier(const XcdBarrier& b, const int tid_) {
    asm volatile("s_waitcnt vmcnt(0)" ::: "memory");
    __syncthreads();
    if (tid_ == 0) {
        unsigned* bar = b.bar;
        __builtin_amdgcn_s_waitcnt(0);
        unsigned nloc = b.st[0], nx = b.st[1];
        if (nloc == 0u) { xcd_barrier_complete(bar, b.x, nloc, nx); b.st[0] = nloc; b.st[1] = nx; }
        const unsigned old = xb_add(&bar[XB_XSUB(b.x)], 1u);
        const unsigned gen = old / nloc;
        if (old + 1u == (gen + 1u) * nloc) {
            __builtin_amdgcn_fence(__ATOMIC_RELEASE, "agent");
            asm volatile("s_waitcnt vmcnt(0)" ::: "memory");
            const unsigned og = xb_add(&bar[XB_TOP], 1u);
            const unsigned tg = og / nx;
            if (og + 1u == (tg + 1u) * nx) xb_add(&bar[XB_TOPGEN], 1u);
            else XB_SPIN(xb_ld(&bar[XB_TOPGEN]) == tg, bar);
            __builtin_amdgcn_fence(__ATOMIC_ACQUIRE, "agent");
            xb_add(&bar[XB_XGEN(b.x)], 1u);
            asm volatile("s_waitcnt vmcnt(0)" ::: "memory");
        } else {
            XB_SPIN(xb_ld(&bar[XB_XGEN(b.x)]) == gen, bar);
            __builtin_amdgcn_fence(__ATOMIC_ACQUIRE, "agent");
            asm volatile("s_waitcnt vmcnt(0)" ::: "memory");
        }
    }
    __syncthreads();
}


__global__ void __launch_bounds__(256, 2) mega(Params p) {
  cg::grid_group grid = cg::this_grid();
  __shared__ __attribute__((aligned(16))) char smem[SMEM_BYTES];
  __shared__ int s_unit;
  __shared__ uint4 xb_words;
  if (threadIdx.x == 0) xb_words = make_uint4(0u, 0u, 0u, 0u);
  __syncthreads();
  (void)xcd_barrier_post((unsigned*)(p.ws + OFF_BAR), (volatile LAS unsigned*)&xb_words);
#define XB_SYNC() do { XcdBarrier xb_; xb_.bar = (unsigned*)(p.ws + OFF_BAR); xb_.x = xb_xcc_id(); xb_.st = (volatile LAS unsigned*)&xb_words; xcd_barrier(xb_, wave0 * 64 + fresh_lane()); } while (0)
  int wave0 = __builtin_amdgcn_readfirstlane((int)(threadIdx.x >> 6));
  asm volatile("" : "+s"(wave0));
  const int nblk = gridDim.x;
  float* H = (float*)(p.ws + OFF_H);
  u16* P = (u16*)(p.ws + OFF_P);
  float* DEC = (float*)(p.ws + OFF_DEC);
  u16* AA = (u16*)(p.ws + OFF_AA);
  u16* GG = (u16*)(p.ws + OFF_GG);
  u16* Q = (u16*)(p.ws + OFF_Q);
  u16* MIX = (u16*)(p.ws + OFF_DEC);
  u16* HB1 = (u16*)p.out + (size_t)2 * M_ * 512;
  u16* HB2 = (u16*)(p.ws + OFF_HB2);
  u16* HBH = (u16*)(p.ws + OFF_AA);
  const u16* ZERO = (const u16*)(p.ws + OFF_ZERO);
  u16* ACT = (u16*)(p.ws + OFF_P);
  float2* ROPE = (float2*)(p.ws + OFF_ROPE);
  int* CTR = (int*)(p.ws + OFF_CTR);
  u16* KN = (u16*)p.out;
  u16* VT = KN + (size_t)M_ * 512;
  u16* YR = AA;

  {
  PHASE_TID
  for (int t = blockIdx.x; t < p.nconv; t += nblk) conv_tile(p, t, smem, tid);
  for (int i = blockIdx.x * 256 + tid; i < T_ * 16; i += nblk * 256) {
    int t = i >> 4, f = i & 15;
    double rev = (double)t * ROPE_C[f];
    rev -= floor(rev);
    float r = (float)rev;
    ROPE[i] = make_float2(__builtin_amdgcn_cosf(r), __builtin_amdgcn_sinf(r));
  }
  for (int row = (blockIdx.x * 4 + wave) * 2; row < M_; row += nblk * 8) {
    int b = row / T_, t = row % T_;
    const float* srcA = (t < NMETA_) ? (p.in[1] + (size_t)t * 1024) : (p.in[0] + ((size_t)b * SEQ_ + (t - NMETA_)) * 1024);
    u16* hb = (row < HB_SPLIT) ? HB1 + (size_t)row * 1024 : HB2 + (size_t)(row - HB_SPLIT) * 1024;
    ln_row2(srcA, srcA + 1024, p.in[2], p.in[3], H + (size_t)row * 1024, H + (size_t)(row + 1) * 1024, lane, hb, hb + 1024);
  }
  if (blockIdx.x == 0 && tid < 16) CTR[tid] = 0;
  if (blockIdx.x == 1) { for (int i = tid; i < 2048; i += 256) ((unsigned*)(p.ws + OFF_ZERO))[i] = 0u; }
  }
  grid.sync();

#pragma unroll 1
  for (int ph_ = 0; ph_ < 20; ph_++) {
    const int l = ph_ / 10, kph = ph_ - l * 10;
    const u16* WL = (const u16*)(p.ws + OFF_W) + (size_t)l * W_LAYER;
    if (kph == 0) {
    PHASE_TID
    for (int it_ = 0; it_ * nblk < 257 * 19; it_++) {
      int mt, nt;
      if (!map_tile(it_, nblk, 257, 19, mt, nt)) continue;
      f32x4 acc[8][4];
      zero_acc8(acc);
      ADma al = ADma{(mt < 255) ? HB1 : HB2, 1024, (mt < 255) ? mt * 256 : mt * 256 - HB_SPLIT, 0, ZERO, 0};
      gemm3(acc, al, WL + W_IN, 1024, nt * 128, 1024, smem, tid);
      ACC_COORDS
#pragma unroll
      for (int mi = 0; mi < 8; mi++)
#pragma unroll
        for (int ni = 0; ni < 4; ni++) {
          int col = nt * 128 + wc * 64 + ni * 16 + fq * 4;
          int row = mt * 256 + wr * 128 + mi * 16 + fr;
          if (col < PC_)
            *(uint2*)(P + (size_t)row * PC_ + col) = make_uint2(pk2(acc[mi][ni][0], acc[mi][ni][1]), pk2(acc[mi][ni][2], acc[mi][ni][3]));
        }
    }
    }
    if (kph == 1) {
    PHASE_TID
    {
      const float* qg = p.in[16] + l * 256;
      const float* kvg = p.in[18] + l * 256;
      for (int rbase = (blockIdx.x * 4 + wave) * 4; rbase < M_; rbase += nblk * 16) {
        const int row = rbase + (lane >> 4), sl = lane & 15;
        u16* pr = P + (size_t)row * PC_;
        uint4 q0 = *(const uint4*)(pr + PMLA_ + sl * 16), q1 = *(const uint4*)(pr + PMLA_ + sl * 16 + 8);
        uint4 k0 = *(const uint4*)(pr + PKV_ + sl * 16), k1 = *(const uint4*)(pr + PKV_ + sl * 16 + 8);
        const int t = row % T_;
        float x1 = bf2f(pr[PKR_ + sl]), x2 = bf2f(pr[PKR_ + 16 + sl]);
        float2 cs = ROPE[t * 16 + sl];
        const unsigned qw[8] = {q0.x, q0.y, q0.z, q0.w, q1.x, q1.y, q1.z, q1.w};
        const unsigned kw[8] = {k0.x, k0.y, k0.z, k0.w, k1.x, k1.y, k1.z, k1.w};
        float s1 = 0.f, s2 = 0.f;
#pragma unroll
        for (int e = 0; e < 8; e++) {
          float a0 = bflo(qw[e]), a1 = bfhi(qw[e]), c0 = bflo(kw[e]), c1 = bfhi(kw[e]);
          s1 += a0 * a0 + a1 * a1;
          s2 += c0 * c0 + c1 * c1;
        }
        s1 = sum16(s1);
        s2 = sum16(s2);
        const float r1 = rsqrtf(s1 * (1.0f / 256.0f) + 1e-6f), r2 = rsqrtf(s2 * (1.0f / 256.0f) + 1e-6f);
        unsigned oq[8], ok[8];
#pragma unroll
        for (int e = 0; e < 8; e++) {
          float2 g1 = *(const float2*)(qg + sl * 16 + 2 * e), g2 = *(const float2*)(kvg + sl * 16 + 2 * e);
          oq[e] = pk2(bflo(qw[e]) * r1 * g1.x, bfhi(qw[e]) * r1 * g1.y);
          ok[e] = pk2(bflo(kw[e]) * r2 * g2.x, bfhi(kw[e]) * r2 * g2.y);
        }
        *(uint4*)(pr + PMLA_ + sl * 16) = make_uint4(oq[0], oq[1], oq[2], oq[3]);
        *(uint4*)(pr + PMLA_ + sl * 16 + 8) = make_uint4(oq[4], oq[5], oq[6], oq[7]);
        *(uint4*)(pr + PKV_ + sl * 16) = make_uint4(ok[0], ok[1], ok[2], ok[3]);
        *(uint4*)(pr + PKV_ + sl * 16 + 8) = make_uint4(ok[4], ok[5], ok[6], ok[7]);
        pr[PKR_ + sl] = f2bf(x1 * cs.x - x2 * cs.y);
        pr[PKR_ + 16 + sl] = f2bf(x1 * cs.y + x2 * cs.x);
      }
      const float* mu = p.in[5] + (size_t)l * 1824;
      for (int tile = blockIdx.x; tile < 514 * 12; tile += nblk) {
        int mt = tile / 12, sub = tile % 12, which = sub >> 2, nt = sub & 3;
        f32x4 acc[4][4];
        zero_acc(acc);
        ACC_COORDS
        if (which == 0) {
          AL<3> al{P + 1536, PC_, mt * 128, 0, 64, mu + 1536, 0};
          gemm_loop(acc, al, WL + W_LW, 64, nt * 128, 64, smem, tid);
          const float* w0 = p.in[6] + l * 512;
#pragma unroll
          for (int mi = 0; mi < 4; mi++)
#pragma unroll
            for (int ni = 0; ni < 4; ni++) {
              int col = nt * 128 + wc * 64 + ni * 16 + fr;
              float w0c = w0[col];
#pragma unroll
              for (int j = 0; j < 4; j++) {
                int row = mt * 128 + wr * 64 + mi * 16 + fq * 4 + j;
                float x = -(acc[mi][ni][j] + w0c);
                float sp = fmaxf(x, 0.f) + __logf(1.0f + __expf(-fabsf(x)));
                float wraw = -sp - 0.5f;
                DEC[(size_t)row * 512 + col] = __expf(-__expf(wraw));
              }
            }
        } else if (which == 1) {
          AL<3> al{P + 1600, PC_, mt * 128, 0, 64, mu + 1600, 1};
          gemm_loop(acc, al, WL + W_LA, 64, nt * 128, 64, smem, tid);
          const float* a0 = p.in[8] + l * 512;
#pragma unroll
          for (int mi = 0; mi < 4; mi++)
#pragma unroll
            for (int ni = 0; ni < 4; ni++) {
              int col = nt * 128 + wc * 64 + ni * 16 + fr;
              float a0c = a0[col];
#pragma unroll
              for (int j = 0; j < 4; j++) {
                int row = mt * 128 + wr * 64 + mi * 16 + fq * 4 + j;
                AA[(size_t)row * 512 + col] = f2bf(sigmoidf_(acc[mi][ni][j] + a0c));
              }
            }
        } else {
          AL<3> al{P + 1664, PC_, mt * 128, 0, 160, mu + 1664, 2};
          gemm_loop(acc, al, WL + W_LG, 192, nt * 128, 192, smem, tid);
#pragma unroll
          for (int mi = 0; mi < 4; mi++)
#pragma unroll
            for (int ni = 0; ni < 4; ni++) {
              int col = nt * 128 + wc * 64 + ni * 16 + fr;
#pragma unroll
              for (int j = 0; j < 4; j++) {
                int row = mt * 128 + wr * 64 + mi * 16 + fq * 4 + j;
                GG[(size_t)row * 512 + col] = f2bf(acc[mi][ni][j]);
              }
            }
        }
      }
    }
    }
    if (kph == 2) {
    PHASE_TID
    for (int it_ = 0; it_ * nblk < 257 * 14; it_++) {
      int mt, sub;
      if (!map_tile(it_, nblk, 257, 14, mt, sub)) continue;
      f32x4 acc[8][4];
      zero_acc8(acc);
      ACC_COORDS
      if (sub < 6) {
        ADma al{P + PMLA_, PC_, mt * 256, 0, ZERO, 0};
        gemm3(acc, al, WL + W_UQ, 256, sub * 128, 256, smem, tid);
#pragma unroll
        for (int mi = 0; mi < 8; mi++)
#pragma unroll
          for (int ni = 0; ni < 4; ni++) {
            int col = sub * 128 + wc * 64 + ni * 16 + fq * 4;
            int row = mt * 256 + wr * 128 + mi * 16 + fr;
            *(uint2*)(Q + (size_t)row * 768 + col) = make_uint2(pk2(acc[mi][ni][0], acc[mi][ni][1]), pk2(acc[mi][ni][2], acc[mi][ni][3]));
          }
      } else if (sub < 10) {
        int nt = sub - 6;
        ADma al{P + PKV_, PC_, mt * 256, 0, ZERO, 0};
        gemm3(acc, al, WL + W_UK, 256, nt * 128, 256, smem, tid);
#pragma unroll
        for (int mi = 0; mi < 8; mi++)
#pragma unroll
          for (int ni = 0; ni < 4; ni++) {
            int col = nt * 128 + wc * 64 + ni * 16 + fq * 4;
            int row = mt * 256 + wr * 128 + mi * 16 + fr;
            *(uint2*)(KN + (size_t)row * 512 + col) = make_uint2(pk2(acc[mi][ni][0], acc[mi][ni][1]), pk2(acc[mi][ni][2], acc[mi][ni][3]));
          }
      } else {
        int nt = sub - 10;
        ADma al{P + PKV_, PC_, mt * 256, 0, ZERO, 0};
        gemm3<4, false>(acc, al, WL + W_UV, 256, nt * 128, 256, smem, tid);
#pragma unroll
        for (int mi = 0; mi < 8; mi++)
#pragma unroll
          for (int ni = 0; ni < 4; ni++) {
            int col = nt * 128 + wc * 64 + ni * 16 + fr;
            int row = mt * 256 + wr * 128 + mi * 16 + fq * 4;
            int b = row / T_, t = row % T_;
            size_t o = ((size_t)(b * 512 + col)) * T_ + t;
            *(uint2*)(VT + o) = make_uint2(pk2(acc[mi][ni][0], acc[mi][ni][1]), pk2(acc[mi][ni][2], acc[mi][ni][3]));
          }
      }
    }
    }
    if (kph == 3) {
    PHASE_TID
    {
      const int xcd = blockIdx.x & 7, loc = blockIdx.x >> 3;
      const int total = 16 * 33;
      const bool scan_wg = (loc < 16), partner = (loc >= (nblk >> 4) && loc < (nblk >> 4) + 16);
      if (scan_wg) {
        scan_unit(p, l, xcd * 16 + loc, smem, launder(tid));
        __syncthreads();
      }
      if (!partner) {
        while (true) {
          if (tid == 0) s_unit = atomicAdd(&CTR[l * 8 + xcd], 1);
          __syncthreads();
          int v = s_unit;
          __syncthreads();
          if (v >= total) break;
          const int tidu = launder(tid);
          int g = v / 66, w = v - g * 66;
          attn_unit(p, xcd * 16 + g * 2 + (w & 1), 32 - (w >> 1), smem, tidu);
          __syncthreads();
        }
      }
    }
    }
    if (kph == 4) {
    PHASE_TID
    {
    u16* scr = (u16*)(p.ws + OFF_SCR) + (size_t)blockIdx.x * 32768;
    for (int it_ = 0; it_ * nblk < 256 * 8; it_++) {
      int mt, nt;
      if (!map_tile(it_, nblk, 256, 8, mt, nt)) continue;
      f32x4 acc[8][4];
      ADma alh = ADma{(mt < 255) ? HB1 : HB2, 1024, (mt < 255) ? mt * 256 : mt * 256 - HB_SPLIT, 0, ZERO, 0};
      zero_acc8(acc);
      gemm3(acc, alh, WL + W_G, 1024, nt * 128, 1024, smem, launder(tid));
      { const int tq_ = launder(tid); const int lane = tq_ & 63, wave = tq_ >> 6; ACC_COORDS
#pragma unroll
        for (int mi = 0; mi < 8; mi++)
#pragma unroll
          for (int ni = 0; ni < 4; ni++) {
            int col = nt * 128 + wc * 64 + ni * 16 + fq * 4;
            int row = mt * 256 + wr * 128 + mi * 16 + fr;
            *(uint2*)(MIX + (size_t)row * 1024 + col) = make_uint2(pk2(sigmoidf_(acc[mi][ni][0]), sigmoidf_(acc[mi][ni][1])),
                                                                   pk2(sigmoidf_(acc[mi][ni][2]), sigmoidf_(acc[mi][ni][3])));
          }
      }
      zero_acc8(acc);
      {
        ADma aly{YR, 512, mt * 256, 0, ZERO, 0};
        gemm3(acc, aly, WL + W_PR, 512, nt * 128, 512, smem, launder(tid));
      }
      { const int tq_ = launder(tid); const int lane = tq_ & 63, wave = tq_ >> 6; ACC_COORDS
#pragma unroll
        for (int mi = 0; mi < 8; mi++)
#pragma unroll
          for (int ni = 0; ni < 4; ni++) {
            int col = nt * 128 + wc * 64 + ni * 16 + fq * 4;
            int row = mt * 256 + wr * 128 + mi * 16 + fr;
            u16* mp = MIX + (size_t)row * 1024 + col;
            uint2 s = *(const uint2*)mp;
            *(uint2*)mp = make_uint2(pk2(bflo(s.x) * acc[mi][ni][0], bfhi(s.x) * acc[mi][ni][1]), pk2(bflo(s.y) * acc[mi][ni][2], bfhi(s.y) * acc[mi][ni][3]));
          }
      }
      zero_acc8(acc);
      gemm3(acc, alh, WL + W_G, 1024, 1024 + nt * 128, 1024, smem, launder(tid));
      { const int tq_ = launder(tid); const int lane = tq_ & 63, wave = tq_ >> 6; ACC_COORDS
#pragma unroll
        for (int mi = 0; mi < 8; mi++)
#pragma unroll
          for (int ni = 0; ni < 4; ni++) {
            int cl = wc * 64 + ni * 16 + fq * 4, rl = wr * 128 + mi * 16 + fr;
            *(uint2*)(scr + rl * 128 + cl) = make_uint2(pk2(sigmoidf_(acc[mi][ni][0]), sigmoidf_(acc[mi][ni][1])),
                                                        pk2(sigmoidf_(acc[mi][ni][2]), sigmoidf_(acc[mi][ni][3])));
          }
      }
      zero_acc8(acc);
      {
        ADma alm{P + PMLA_, PC_, mt * 256, 0, ZERO, 0};
        gemm3(acc, alm, WL + W_PM, 512, nt * 128, 512, smem, launder(tid));
      }
      { const int tq_ = launder(tid); const int lane = tq_ & 63, wave = tq_ >> 6; ACC_COORDS
#pragma unroll
        for (int mi = 0; mi < 8; mi++)
#pragma unroll
          for (int ni = 0; ni < 4; ni++) {
            int cl = wc * 64 + ni * 16 + fq * 4, rl = wr * 128 + mi * 16 + fr;
            u16* mp = MIX + (size_t)(mt * 256 + rl) * 1024 + nt * 128 + cl;
            uint2 t1 = *(const uint2*)mp;
            uint2 s = *(const uint2*)(scr + rl * 128 + cl);
            float o0 = bflo(t1.x) + bflo(s.x) * acc[mi][ni][0];
            float o1 = bfhi(t1.x) + bfhi(s.x) * acc[mi][ni][1];
            float o2 = bflo(t1.y) + bflo(s.y) * acc[mi][ni][2];
            float o3 = bfhi(t1.y) + bfhi(s.y) * acc[mi][ni][3];
            *(uint2*)mp = make_uint2(pk2(o0, o1), pk2(o2, o3));
          }
      }
    }
    }
    if (blockIdx.x < 16) {
      const int mt = 256, nt = blockIdx.x;
      f32x4 acc[8][2];
      unsigned sg[8][2][2];
      ADma alh = ADma{(mt < 255) ? HB1 : HB2, 1024, (mt < 255) ? mt * 256 : mt * 256 - HB_SPLIT, 0, ZERO, 0};
      zero_acc8(acc);
      const int tid1 = launder(tid);
      gemm3(acc, alh, WL + W_G, 1024, nt * 64, 1024, smem, tid1);
#pragma unroll
      for (int mi = 0; mi < 8; mi++)
#pragma unroll
        for (int ni = 0; ni < 2; ni++) {
          sg[mi][ni][0] = pk2(sigmoidf_(acc[mi][ni][0]), sigmoidf_(acc[mi][ni][1]));
          sg[mi][ni][1] = pk2(sigmoidf_(acc[mi][ni][2]), sigmoidf_(acc[mi][ni][3]));
        }
      zero_acc8(acc);
      {
        ADma aly{YR, 512, mt * 256, 0, ZERO, 0};
        const int tid2 = launder(tid);
      gemm3(acc, aly, WL + W_PR, 512, nt * 64, 512, smem, tid2);
      }
{ const int tidq = launder(tid); const int lane = tidq & 63, wave = tidq >> 6; ACC_COORDS
#pragma unroll
      for (int mi = 0; mi < 8; mi++)
#pragma unroll
        for (int ni = 0; ni < 2; ni++) {
          int col = nt * 64 + wc * 32 + ni * 16 + fq * 4;
          int row = mt * 256 + wr * 128 + mi * 16 + fr;
          *(uint2*)(MIX + (size_t)row * 1024 + col) = make_uint2(pk2(bflo(sg[mi][ni][0]) * acc[mi][ni][0], bfhi(sg[mi][ni][0]) * acc[mi][ni][1]),
                                                                 pk2(bflo(sg[mi][ni][1]) * acc[mi][ni][2], bfhi(sg[mi][ni][1]) * acc[mi][ni][3]));
        }
      }
      zero_acc8(acc);
      const int tid3 = launder(tid);
      gemm3(acc, alh, WL + W_G, 1024, 1024 + nt * 64, 1024, smem, tid3);
#pragma unroll
      for (int mi = 0; mi < 8; mi++)
#pragma unroll
        for (int ni = 0; ni < 2; ni++) {
          sg[mi][ni][0] = pk2(sigmoidf_(acc[mi][ni][0]), sigmoidf_(acc[mi][ni][1]));
          sg[mi][ni][1] = pk2(sigmoidf_(acc[mi][ni][2]), sigmoidf_(acc[mi][ni][3]));
        }
      zero_acc8(acc);
      {
        ADma alm{P + PMLA_, PC_, mt * 256, 0, ZERO, 0};
        const int tid4 = launder(tid);
      gemm3(acc, alm, WL + W_PM, 512, nt * 64, 512, smem, tid4);
      }
{ const int tidq = launder(tid); const int lane = tidq & 63, wave = tidq >> 6; ACC_COORDS
#pragma unroll
      for (int mi = 0; mi < 8; mi++)
#pragma unroll
        for (int ni = 0; ni < 2; ni++) {
          int col = nt * 64 + wc * 32 + ni * 16 + fq * 4;
          int row = mt * 256 + wr * 128 + mi * 16 + fr;
          uint2 pm = *(const uint2*)(MIX + (size_t)row * 1024 + col);
          float o0 = bflo(pm.x) + bflo(sg[mi][ni][0]) * acc[mi][ni][0];
          float o1 = bfhi(pm.x) + bfhi(sg[mi][ni][0]) * acc[mi][ni][1];
          float o2 = bflo(pm.y) + bflo(sg[mi][ni][1]) * acc[mi][ni][2];
          float o3 = bfhi(pm.y) + bfhi(sg[mi][ni][1]) * acc[mi][ni][3];
          *(uint2*)(MIX + (size_t)row * 1024 + col) = make_uint2(pk2(o0, o1), pk2(o2, o3));
        }
      }
    }
    }
    if (kph == 5) {
    PHASE_TID
    for (int prb_ = (PROBE_FI ? 0 : 1); prb_ < 2; prb_++)
    for (int it_ = 0; it_ * nblk < 256 * 8; it_++) {
      int mt, nt;
      if (!map_tile(it_, nblk, 256, 8, mt, nt)) continue;
      f32x4 acc[8][4];
      zero_acc8(acc);
      ACC_COORDS
      ADma al{MIX, 1024, mt * 256, 0, ZERO, 0};
      gemm3(acc, al, WL + W_OUT, 1024, nt * 128, 1024, smem, tid);
#pragma unroll
      for (int mi = 0; mi < 8; mi++)
#pragma unroll
        for (int ni = 0; ni < 4; ni++) {
          int col = nt * 128 + wc * 64 + ni * 16 + fq * 4;
          int row = mt * 256 + wr * 128 + mi * 16 + fr;
          float* hp = H + (size_t)row * 1024 + col;
          float* dp = (prb_ == 0) ? (p.out + (size_t)(row & 65535) * 1024 + col) : hp;
          float4 hv = *(const float4*)hp;
          hv.x = ALPHA_ * hv.x + acc[mi][ni][0];
          hv.y = ALPHA_ * hv.y + acc[mi][ni][1];
          hv.z = ALPHA_ * hv.z + acc[mi][ni][2];
          hv.w = ALPHA_ * hv.w + acc[mi][ni][3];
          *(float4*)dp = hv;
        }
    }
    if (blockIdx.x < 16) {
      const int mt = 256, n0 = blockIdx.x * 64;
      f32x4 acc[8][2];
      zero_acc8(acc);
      ADma al{MIX, 1024, mt * 256, 0, ZERO, 0};
      gemm3(acc, al, WL + W_OUT, 1024, n0, 1024, smem, launder(tid));
      const int tq_ = launder(tid);
      const int lane = tq_ & 63, wave = tq_ >> 6;
      ACC_COORDS
#pragma unroll
      for (int mi = 0; mi < 8; mi++)
#pragma unroll
        for (int ni = 0; ni < 2; ni++) {
          int col = n0 + wc * 32 + ni * 16 + fq * 4;
          int row = mt * 256 + wr * 128 + mi * 16 + fr;
          float* hp = H + (size_t)row * 1024 + col;
          float4 hv = *(const float4*)hp;
          hv.x = ALPHA_ * hv.x + acc[mi][ni][0];
          hv.y = ALPHA_ * hv.y + acc[mi][ni][1];
          hv.z = ALPHA_ * hv.z + acc[mi][ni][2];
          hv.w = ALPHA_ * hv.w + acc[mi][ni][3];
          *(float4*)hp = hv;
        }
    }
    }
    if (kph == 6) {
    PHASE_TID
    for (int row = (blockIdx.x * 4 + wave) * 2; row < M_; row += nblk * 8)
      ln_row2(H + (size_t)row * 1024, H + (size_t)(row + 1) * 1024, p.in[24] + l * 1024, p.in[25] + l * 1024, H + (size_t)row * 1024, H + (size_t)(row + 1) * 1024, lane, HBH + (size_t)row * 1024, HBH + (size_t)(row + 1) * 1024);
    }
    if (kph == 7) {
    PHASE_TID
    {
      const float* cw = p.in[27] + (size_t)l * 3 * 5632;
      const float* cb = p.in[28] + (size_t)l * 5632;
#if PROBE_HOT
      for (int it_ = 0; it_ * nblk < 272 * 44; it_++) {
        int rest, nt;
        if (!map_tile(it_, nblk, 272, 44, rest, nt)) continue;
        f32x4 acc[8][4];
        zero_acc8(acc);
#if PROBE_HOT == 1
        ADma al{HBH, 1024, 0, 0, ZERO, 1, p.ws};
        gemm3(acc, al, WL + W_UP, 1024, 0, 1024, smem, tid);
#else
        int it = rest % 17, b = rest / 17;
        ADma al{HBH, 1024, b * T_, 254 * it - 2, ZERO, 1, p.ws};
        gemm3(acc, al, WL + W_UP, 1024, nt * 128, 1024, smem, tid);
#endif
        float sacc = 0.f;
#pragma unroll
        for (int mi = 0; mi < 8; mi++)
#pragma unroll
          for (int ni = 0; ni < 4; ni++) sacc += acc[mi][ni][0] + acc[mi][ni][1] + acc[mi][ni][2] + acc[mi][ni][3];
        if (sacc == 12345.678f) ACT[tid] = 0;
      }
#endif
      for (int it_ = 0; it_ * nblk < 272 * 44; it_++) {
        int rest, nt;
        if (!map_tile(it_, nblk, 272, 44, rest, nt)) continue;
        int it = rest % 17, b = rest / 17;
        int t0 = 254 * it - 2;
        f32x4 acc[8][4];
        zero_acc8(acc);
        ADma al{HBH, 1024, b * T_, t0, ZERO, 1, p.ws};
        gemm3(acc, al, WL + W_UP, 1024, nt * 128, 1024, smem, launder(tid));
        ACC_COORDS
        float(*ut)[132] = (float(*)[132])smem;
        const int tidh = launder(tid);
        const int c = tidh & 63, rg = tidh >> 6;
        const int gcol = nt * 64 + c, vcol = DFF_ + nt * 64 + c;
        const float g0 = cw[gcol], g1 = cw[5632 + gcol], g2 = cw[2 * 5632 + gcol], gb = cb[gcol];
        const float v0 = cw[vcol], v1 = cw[5632 + vcol], v2 = cw[2 * 5632 + vcol], vb = cb[vcol];
#pragma unroll 1
        for (int half = 0; half < 2; half++) {
          float carry = 0.f;
          if (half == 1) carry = ut[126 + (tid >> 7)][tid & 127];
          __syncthreads();
          if (half == 1) ut[tid >> 7][tid & 127] = carry;
          if (wr == half) {
#pragma unroll
            for (int mi = 0; mi < 8; mi++)
#pragma unroll
              for (int ni = 0; ni < 4; ni++)
                *(float4*)&ut[half * 2 + mi * 16 + fr][wc * 64 + ni * 16 + fq * 4] = make_float4(acc[mi][ni][0], acc[mi][ni][1], acc[mi][ni][2], acc[mi][ni][3]);
          }
          __syncthreads();
          const int nq = half ? 130 : 128;
          int qs = 2 + rg * 32, qe = min(qs + 32, nq);
          float ga = ut[qs - 2][c], gbp = ut[qs - 1][c];
          float va = ut[qs - 2][64 + c], vbp = ut[qs - 1][64 + c];
#pragma unroll 4
          for (int q = qs; q < qe; q++) {
            float gc = ut[q][c], vc = ut[q][64 + c];
            int t = t0 + half * 126 + q;
            if (t < T_) {
              float gate = g0 * ga + g1 * gbp + g2 * gc + gb;
              float val = v0 * va + v1 * vbp + v2 * vc + vb;
              float av = gate * sigmoidf_(gate) * val;
              ACT[(size_t)(b * T_ + t) * DFF_ + gcol] = f2bf(av);
            }
            ga = gbp; gbp = gc; va = vbp; vbp = vc;
          }
        }
        __syncthreads();
      }
    }
    }
    if (kph == 8) {
    PHASE_TID
    for (int prb_ = (PROBE_FI ? 0 : 1); prb_ < 2; prb_++)
    for (int it_ = 0; it_ * nblk < 256 * 8; it_++) {
      int mt, nt;
      if (!map_tile(it_, nblk, 256, 8, mt, nt)) continue;
      f32x4 acc[8][4];
      zero_acc8(acc);
      ACC_COORDS
      ADma al{ACT, DFF_, mt * 256, 0, ZERO, 0};
      gemm3(acc, al, WL + W_DN, DFF_, nt * 128, DFF_, smem, tid);
#pragma unroll
      for (int mi = 0; mi < 8; mi++)
#pragma unroll
        for (int ni = 0; ni < 4; ni++) {
          int col = nt * 128 + wc * 64 + ni * 16 + fq * 4;
          int row = mt * 256 + wr * 128 + mi * 16 + fr;
          float* hp = H + (size_t)row * 1024 + col;
          float* dp = (prb_ == 0) ? (p.out + (size_t)(row & 65535) * 1024 + col) : hp;
          float4 hv = *(const float4*)hp;
          hv.x = ALPHA_ * hv.x + acc[mi][ni][0];
          hv.y = ALPHA_ * hv.y + acc[mi][ni][1];
          hv.z = ALPHA_ * hv.z + acc[mi][ni][2];
          hv.w = ALPHA_ * hv.w + acc[mi][ni][3];
          *(float4*)dp = hv;
        }
    }
    if (blockIdx.x < 16) {
      const int mt = 256, n0 = blockIdx.x * 64;
      f32x4 acc[8][2];
      zero_acc8(acc);
      ADma al{ACT, DFF_, mt * 256, 0, ZERO, 0};
      gemm3(acc, al, WL + W_DN, DFF_, n0, DFF_, smem, launder(tid));
      const int tq_ = launder(tid);
      const int lane = tq_ & 63, wave = tq_ >> 6;
      ACC_COORDS
#pragma unroll
      for (int mi = 0; mi < 8; mi++)
#pragma unroll
        for (int ni = 0; ni < 2; ni++) {
          int col = n0 + wc * 32 + ni * 16 + fq * 4;
          int row = mt * 256 + wr * 128 + mi * 16 + fr;
          float* hp = H + (size_t)row * 1024 + col;
          float4 hv = *(const float4*)hp;
          hv.x = ALPHA_ * hv.x + acc[mi][ni][0];
          hv.y = ALPHA_ * hv.y + acc[mi][ni][1];
          hv.z = ALPHA_ * hv.z + acc[mi][ni][2];
          hv.w = ALPHA_ * hv.w + acc[mi][ni][3];
          *(float4*)hp = hv;
        }
    }
    }
    if (kph == 9) {
    PHASE_TID
    if (l == 0) {
      for (int row = (blockIdx.x * 4 + wave) * 2; row < M_; row += nblk * 8) {
        u16* hb = (row < HB_SPLIT) ? HB1 + (size_t)row * 1024 : HB2 + (size_t)(row - HB_SPLIT) * 1024;
        ln_row2(H + (size_t)row * 1024, H + (size_t)(row + 1) * 1024, p.in[30], p.in[31], H + (size_t)row * 1024, H + (size_t)(row + 1) * 1024, lane, hb, hb + 1024);
      }
    } else {
      for (int row = (blockIdx.x * 4 + wave) * 2; row < M_; row += nblk * 8) {
        int b = row / T_, t = row % T_;
        if (t >= NMETA_) {
          float* o = p.out + ((size_t)b * SEQ_ + (t - NMETA_)) * 1024;
          ln_row2(H + (size_t)row * 1024, H + (size_t)(row + 1) * 1024, p.in[30] + 1024, p.in[31] + 1024, o, o + 1024, lane, nullptr, nullptr);
        }
      }
    }
    }
    if (ph_ != 19) XB_SYNC();
  }
}

extern "C" void kernel_launch(void* const* d_in, const int* in_sizes, int n_in, void* d_out, int out_size, void* d_ws,
                              size_t ws_size, hipStream_t stream) {
  static int grid_blocks = 0;
  if (!grid_blocks) {
    int dev = 0, cus = 0, per_cu = 0;
    hipGetDevice(&dev);
    hipDeviceGetAttribute(&cus, hipDeviceAttributeMultiprocessorCount, dev);
    hipOccupancyMaxActiveBlocksPerMultiprocessor(&per_cu, mega, 256, 0);
    if (per_cu > 2) per_cu = 2;
    grid_blocks = cus * per_cu;
  }
  if (ws_size < WS_TOTAL) fprintf(stderr, "workspace too small: %zu < %zu\n", ws_size, (size_t)WS_TOTAL);
  Params p;
  memset(&p, 0, sizeof(p));
  for (int i = 0; i < 32; i++) p.in[i] = (const float*)d_in[i];
  p.out = (float*)d_out;
  p.ws = (char*)d_ws;
  u16* wb = (u16*)((char*)d_ws + OFF_W);
  int nj = 0, tiles = 0;
  auto add = [&](const float* src, size_t dst_off, int ld, int c0, int K, int Kpad, int Nv, int Np, int mode) {
    Job& j = p.jobs[nj++];
    j.src = src; j.dst = wb + dst_off; j.ld = ld; j.c0 = c0; j.K = K; j.Kpad = Kpad; j.Nv = Nv; j.Np = Np; j.mode = mode;
    j.tile0 = tiles;
    tiles += (Kpad / 64) * (Np / 64);
  };
  for (int l = 0; l < 2; l++) {
    size_t o = (size_t)l * W_LAYER;
    const float* w_in = (const float*)d_in[4] + (size_t)l * 1024 * 4416;
    add(w_in, o + W_IN, 4416, 0, 1024, 1024, 2368, 2432, 0);
    add(w_in, o + W_G, 4416, 2368, 1024, 1024, 2048, 2048, 0);
    add((const float*)d_in[7] + (size_t)l * 64 * 512, o + W_LW, 512, 0, 64, 64, 512, 512, 0);
    add((const float*)d_in[9] + (size_t)l * 64 * 512, o + W_LA, 512, 0, 64, 64, 512, 512, 0);
    add((const float*)d_in[10] + (size_t)l * 160 * 512, o + W_LG, 512, 0, 160, 192, 512, 512, 0);
    add((const float*)d_in[17] + (size_t)l * 256 * 768, o + W_UQ, 768, 0, 256, 256, 768, 768, 0);
    add((const float*)d_in[19] + (size_t)l * 256 * 512, o + W_UK, 512, 0, 256, 256, 512, 512, 0);
    add((const float*)d_in[20] + (size_t)l * 256 * 512, o + W_UV, 512, 0, 256, 256, 512, 512, 0);
    add((const float*)d_in[21] + (size_t)l * 512 * 1024, o + W_PR, 1024, 0, 512, 512, 1024, 1024, 0);
    add((const float*)d_in[22] + (size_t)l * 512 * 1024, o + W_PM, 1024, 0, 512, 512, 1024, 1024, 0);
    add((const float*)d_in[23] + (size_t)l * 1024 * 1024, o + W_OUT, 1024, 0, 1024, 1024, 1024, 1024, 0);
    add((const float*)d_in[26] + (size_t)l * 1024 * 5632, o + W_UP, 5632, 0, 1024, 1024, 5632, 5632, 1);
    add((const float*)d_in[29] + (size_t)l * 2816 * 1024, o + W_DN, 1024, 0, 2816, 2816, 1024, 1024, 0);
  }
  p.nconv = tiles;
  hipMemsetAsync((char*)d_ws + OFF_BAR, 0, 16384, stream);
  void* args[] = {&p};
  hipError_t e = hipLaunchCooperativeKernel((void*)mega, dim3(grid_blocks), dim3(256), args, 0, stream);
  if (e != hipSuccess) fprintf(stderr, "cooperative launch failed: %s (grid %d)\n", hipGetErrorString(e), grid_blocks);
}
```

```cpp
#include <hip/hip_runtime.h>
#include <hip/hip_cooperative_groups.h>
#include <cstdio>
#include <cstring>
namespace cg = cooperative_groups;

#ifndef PHMASK
#define PHMASK 0xFFFF
#endif
#ifndef PROBE_HOT
#define PROBE_HOT 0
#endif
#ifndef PROBE_FI
#define PROBE_FI 0
#endif
#ifndef REPMASK
#define REPMASK 0
#endif
typedef unsigned short u16;
using bf16x8 = __attribute__((ext_vector_type(8))) short;
using f32x4 = __attribute__((ext_vector_type(4))) float;

constexpr int B_ = 16, SEQ_ = 4096, NMETA_ = 16, T_ = 4112, M_ = B_ * T_, D_ = 1024;
constexpr int PC_ = 2368;
constexpr int PMLA_ = 1824, PKV_ = 2080, PKR_ = 2336;
constexpr int DFF_ = 2816;
constexpr float ALPHA_ = 1.4142135623730951f;

constexpr size_t OFF_H = 0;
constexpr size_t OFF_P = OFF_H + (size_t)M_ * 1024 * 4;
constexpr size_t OFF_DEC = OFF_P + (size_t)M_ * PC_ * 2;
constexpr size_t OFF_AA = OFF_DEC + (size_t)M_ * 512 * 4;
constexpr size_t OFF_GG = OFF_AA + (size_t)M_ * 512 * 2;
constexpr size_t OFF_Q = OFF_GG + (size_t)M_ * 512 * 2;
constexpr size_t OFF_W = OFF_Q + (size_t)M_ * 768 * 2;
constexpr size_t W_IN = 0;
constexpr size_t W_G = W_IN + (size_t)2432 * 1024;
constexpr size_t W_LW = W_G + (size_t)2048 * 1024;
constexpr size_t W_LA = W_LW + (size_t)512 * 64;
constexpr size_t W_LG = W_LA + (size_t)512 * 64;
constexpr size_t W_UQ = W_LG + (size_t)512 * 192;
constexpr size_t W_UK = W_UQ + (size_t)768 * 256;
constexpr size_t W_UV = W_UK + (size_t)512 * 256;
constexpr size_t W_PR = W_UV + (size_t)512 * 256;
constexpr size_t W_PM = W_PR + (size_t)1024 * 512;
constexpr size_t W_OUT = W_PM + (size_t)1024 * 512;
constexpr size_t W_UP = W_OUT + (size_t)1024 * 1024;
constexpr size_t W_DN = W_UP + (size_t)5632 * 1024;
constexpr size_t W_LAYER = W_DN + (size_t)1024 * 2816;
constexpr size_t OFF_ROPE = OFF_W + 2 * W_LAYER * 2;
constexpr size_t OFF_CTR = OFF_ROPE + (size_t)T_ * 16 * 8;
constexpr size_t OFF_ZERO = OFF_CTR + 256;
constexpr size_t OFF_BAR = OFF_ZERO + 8192;
constexpr size_t OFF_HB2 = OFF_BAR + 16384;
constexpr size_t OFF_SCR = OFF_HB2 + (size_t)512 * 1024 * 2;
constexpr size_t WS_TOTAL = OFF_SCR + (size_t)1024 * 65536;
constexpr int HB_SPLIT = 65280;

struct Job { const float* src; u16* dst; int ld, c0, K, Kpad, Nv, Np, mode, tile0; };
struct Params {
  const float* in[32];
  float* out;
  char* ws;
  Job jobs[26];
  int nconv;
  int pad0;
};

__constant__ double ROPE_C[16] = {0.15915494309189535, 0.08949940160889101, 0.050329212104487035, 0.0283021958306234,
                                  0.015915494309189534, 0.008949940160889102, 0.005032921210448704, 0.00283021958306234,
                                  0.0015915494309189536, 0.0008949940160889102, 0.0005032921210448703, 0.00028302195830623395,
                                  0.00015915494309189535, 8.949940160889102e-05, 5.0329212104487035e-05, 2.8302195830623396e-05};

__device__ __forceinline__ int launder(int x) { asm volatile("" : "+v"(x)); return x; }
typedef __bf16 bf16x2_t __attribute__((ext_vector_type(2)));
typedef float f32x2_t __attribute__((ext_vector_type(2)));
__device__ __forceinline__ unsigned pk2(float a, float b) {
  f32x2_t v = {a, b};
  bf16x2_t r = __builtin_convertvector(v, bf16x2_t);
  return *(unsigned*)&r;
}
__device__ __forceinline__ u16 f2bf(float f) { return (u16)(pk2(f, 0.f) & 0xffffu); }
__device__ __forceinline__ float bf2f(unsigned h) { return __uint_as_float(h << 16); }
__device__ __forceinline__ float bflo(unsigned w) { return __uint_as_float(w << 16); }
__device__ __forceinline__ float bfhi(unsigned w) { return __uint_as_float(w & 0xffff0000u); }
__device__ __forceinline__ float sigmoidf_(float x) { return __builtin_amdgcn_rcpf(1.0f + __expf(-x)); }

__device__ __forceinline__ int fresh_lane() { int x; asm volatile("v_mbcnt_lo_u32_b32 %0, -1, 0\n\tv_mbcnt_hi_u32_b32 %0, -1, %0" : "=v"(x)); return x; }
#define PHASE_TID const int tid = wave0 * 64 + fresh_lane(); const int lane = tid & 63, wave = tid >> 6; (void)lane; (void)wave;
template <int CTRL>
__device__ __forceinline__ float dppf(float x) {
  return __int_as_float(__builtin_amdgcn_update_dpp(0, __float_as_int(x), CTRL, 0xF, 0xF, true));
}
__device__ __forceinline__ float sum8(float x) {
  x += dppf<0xB1>(x);
  x += dppf<0x4E>(x);
  x += dppf<0x141>(x);
  return x;
}
__device__ __forceinline__ float sum16(float x) {
  x = sum8(x);
  x += dppf<0x140>(x);
  return x;
}
__device__ __forceinline__ float shx(float x, int lane, int o) {
  return __int_as_float(__builtin_amdgcn_ds_bpermute((lane ^ o) << 2, __float_as_int(x)));
}
__device__ __forceinline__ float wave_sum(float x, int lane) {
  x = sum16(x);
  x += shx(x, lane, 16);
  x += shx(x, lane, 32);
  return x;
}

constexpr int BM = 128, BN = 128, BK = 64, LDT = 64;
constexpr int SMEM_BYTES = 73728;

template <int MODE>
struct AL {
  const void* base;
  int ld;
  int row0;
  int t0;
  int kvalid;
  const float* mu;
  int fn;
  struct Raw { uint4 x, y; };
  __device__ __forceinline__ Raw fetch(int r, int k) const {
    Raw w;
    { unsigned z = (MODE == 3) ? (unsigned)launder(0) : 0u; w.x = make_uint4(z, z, z, z); w.y = w.x; }
    if (MODE == 0) {
      const float* p = (const float*)base + (size_t)(row0 + r) * ld + k;
      w.x = *(const uint4*)p;
      w.y = *(const uint4*)(p + 4);
    } else if (MODE == 1) {
      const u16* p = (const u16*)base + (size_t)(row0 + r) * ld + k;
      w.x = *(const uint4*)p;
    } else if (MODE == 4) {
      const float* p = (const float*)base + (size_t)(row0 + r) * ld + k;
      float4 a = *(const float4*)p, b = *(const float4*)(p + 4);
      w.x = make_uint4(pk2(a.x, a.y), pk2(a.z, a.w), pk2(b.x, b.y), pk2(b.z, b.w));
    } else if (MODE == 2) {
      int t = t0 + r;
      if (t >= 0 && t < T_) {
        const float* p = (const float*)base + (size_t)(row0 + t) * ld + k;
        w.x = *(const uint4*)p;
        w.y = *(const uint4*)(p + 4);
      }
    } else {
      int row = row0 + r;
      int t = row % T_;
      if (k < kvalid) {
        const u16* p = (const u16*)base + (size_t)row * ld + k;
        w.x = *(const uint4*)p;
        if (t > 0) w.y = *(const uint4*)(p - ld);
      }
    }
    return w;
  }
  __device__ __forceinline__ uint4 cvt(const Raw& w, int k) const {
    if (MODE == 0 || MODE == 2) {
      uint4 o;
      o.x = pk2(__uint_as_float(w.x.x), __uint_as_float(w.x.y));
      o.y = pk2(__uint_as_float(w.x.z), __uint_as_float(w.x.w));
      o.z = pk2(__uint_as_float(w.y.x), __uint_as_float(w.y.y));
      o.w = pk2(__uint_as_float(w.y.z), __uint_as_float(w.y.w));
      return o;
    } else if (MODE == 1 || MODE == 4) {
      return w.x;
    } else {
      if (k >= kvalid) { unsigned z = (unsigned)launder(0); return make_uint4(z, z, z, z); }
      unsigned cw[4] = {w.x.x, w.x.y, w.x.z, w.x.w};
      unsigned pw[4] = {w.y.x, w.y.y, w.y.z, w.y.w};
      unsigned ow[4];
#pragma unroll
      for (int e = 0; e < 4; e++) {
        float x0 = bflo(cw[e]), x1 = bfhi(cw[e]);
        float p0 = bflo(pw[e]), p1 = bfhi(pw[e]);
        float v0 = x0 + (p0 - x0) * mu[k + 2 * e];
        float v1 = x1 + (p1 - x1) * mu[k + 2 * e + 1];
        if (fn == 0) {
          v0 = 1.0f - 2.0f * __builtin_amdgcn_rcpf(__expf(2.0f * v0) + 1.0f);
          v1 = 1.0f - 2.0f * __builtin_amdgcn_rcpf(__expf(2.0f * v1) + 1.0f);
        } else if (fn == 2) {
          v0 = sigmoidf_(v0);
          v1 = sigmoidf_(v1);
        }
        ow[e] = pk2(v0, v1);
      }
      return make_uint4(ow[0], ow[1], ow[2], ow[3]);
    }
  }
};

template <int NI>
__device__ __forceinline__ void zero_acc(f32x4 (&acc)[4][NI]) {
#pragma unroll
  for (int i = 0; i < 4; i++)
#pragma unroll
    for (int j = 0; j < NI; j++) acc[i][j] = f32x4{0.f, 0.f, 0.f, 0.f};
}

#define REP4(X) X(0) X(1) X(2) X(3)
template <class ALT, int NI>
__device__ __forceinline__ void gemm_loop(f32x4 (&acc)[4][NI], const ALT& al, const u16* __restrict__ Bt, int ldb, int n0,
                                          int K, char* smem, const int tid) {
  const int lane = tid & 63, wave = tid >> 6;
  const int wr = wave >> 1, wc = wave & 1, fr = lane & 15, fq = lane >> 4;
  const int lr = tid >> 3, lk = (tid & 7) * 8, lsw = ((tid & 7) ^ (lr & 7)) * 8;
  u16* sa = (u16*)smem;
  u16* sb = sa + 2 * BM * LDT;
  typename ALT::Raw ra0, ra1, ra2, ra3;
  uint4 rb0 = make_uint4(0,0,0,0), rb1 = rb0, rb2 = rb0, rb3 = rb0;
  const u16* bp = Bt + (size_t)(n0 + lr) * ldb + lk;
#define GL_FETCH(i) ra##i = al.fetch(lr + 32 * i, kf); if (i < NI) rb##i = *(const uint4*)(bp + (size_t)(32 * i) * ldb + kb);
#define GL_STORE(i) *(uint4*)(a_ + (lr + 32 * i) * LDT + lsw) = al.cvt(ra##i, kt * BK + lk); if (i < NI) *(uint4*)(b_ + (lr + 32 * i) * LDT + lsw) = rb##i;
  {
    const int kf = lk, kb = 0;
    REP4(GL_FETCH)
  }
  const int nk = K / BK;
  for (int kt = 0; kt < nk; kt++) {
    u16* a_ = sa + (kt & 1) * BM * LDT;
    u16* b_ = sb + (kt & 1) * BN * LDT;
    REP4(GL_STORE)
    __syncthreads();
    if (kt + 1 < nk) {
      const int kf = (kt + 1) * BK + lk, kb = (kt + 1) * BK;
      REP4(GL_FETCH)
    }
#pragma unroll
    for (int ks = 0; ks < 2; ks++) {
      bf16x8 af[4], bf[NI];
#pragma unroll
      for (int i = 0; i < 4; i++) af[i] = *(const bf16x8*)(a_ + (wr * 64 + i * 16 + fr) * LDT + (((ks * 4 + fq) ^ (fr & 7)) * 8));
#pragma unroll
      for (int i = 0; i < NI; i++) bf[i] = *(const bf16x8*)(b_ + (wc * (NI * 16) + i * 16 + fr) * LDT + (((ks * 4 + fq) ^ (fr & 7)) * 8));
#pragma unroll
      for (int mi = 0; mi < 4; mi++)
#pragma unroll
        for (int ni = 0; ni < NI; ni++)
          acc[mi][ni] = __builtin_amdgcn_mfma_f32_16x16x32_bf16(af[mi], bf[ni], acc[mi][ni], 0, 0, 0);
    }
  }
  __syncthreads();
#undef GL_FETCH
#undef GL_STORE
}


struct ADma { const u16* base; int ld; int row0; int t0; const u16* zero; int mode; const char* wsb; };
constexpr int G3_STAGE = 12288;

template <int NI, bool SWAP = true>
__device__ __forceinline__ void gemm3(f32x4 (&acc)[8][NI], const ADma& a, const u16* __restrict__ Bt, int ldb, int n0, int K,
                                      char* smem, const int tid) {
  const int lane = tid & 63, wave = tid >> 6;
  const int wr = wave >> 1, wc = wave & 1, fr = lane & 15, fq = lane >> 4;
  const int kc8 = ((lane & 3) ^ ((4 - (lane >> 4)) & 3)) * 8;
  const int psw = (fq ^ ((4 - (fr >> 2)) & 3)) * 8;
  u16* sm = (u16*)smem;
  const u16* ap0 = nullptr;
  unsigned ao0 = 0, ao1 = 0, ao2 = 0, ao3 = 0;
  if (a.mode == 0) {
    ap0 = a.base + (size_t)(a.row0 + wave * 64 + (lane >> 2)) * a.ld + kc8;
  } else {
    const unsigned bo = (unsigned)((const char*)a.base - a.wsb), zo = (unsigned)((const char*)a.zero - a.wsb) + kc8 * 2;
#define G3_AP(j)                                                                          \
    {                                                                                     \
      int t = a.t0 + wave * 64 + j * 16 + (lane >> 2);                                    \
      ao##j = (t >= 0 && t < T_) ? bo + (unsigned)(((a.row0 + t) * a.ld + kc8) * 2) : zo; \
    }
    REP4(G3_AP)
#undef G3_AP
  }
  const u16* bp0 = Bt + (size_t)(n0 + wave * (8 * NI) + (lane >> 2)) * ldb + kc8;
  const size_t astep = (size_t)16 * a.ld;
  const size_t bstep = (size_t)16 * ldb;
#define G3_ISSUE(j)                                                                                                              \
  __builtin_amdgcn_global_load_lds((a.mode == 0) ? (const unsigned*)(ap0 + j * astep + kof) : (const unsigned*)(a.wsb + ao##j + kof * 2), (unsigned*)(st_ + (wave * 64 + j * 16) * 32 + lane * 8), 16, 0, 0); \
  if (2 * j < NI) __builtin_amdgcn_global_load_lds((const unsigned*)(bp0 + j * bstep + kof), (unsigned*)(st_ + 8192 + (wave * (8 * NI) + j * 16) * 32 + lane * 8), 16, 0, 0);
  const int nk = K / 32;
  asm volatile("s_waitcnt vmcnt(0)" ::: "memory");
  {
    const int kof = 0;
    u16* st_ = sm;
    REP4(G3_ISSUE)
  }
  if (nk > 1) {
    const int kof = 32;
    u16* st_ = sm + G3_STAGE;
    REP4(G3_ISSUE)
  }
  int cur = 0, nxt = 2;
  const unsigned lds0 = (unsigned)(size_t)(__attribute__((address_space(3))) char*)smem;
  const unsigned aoff = lds0 + (unsigned)(((wr * 128 + fr) * 32 + psw) * 2);
  const unsigned boff = lds0 + 16384u + (unsigned)(((wc * (NI * 16) + fr) * 32 + psw) * 2);
#define G3_DSR(dst, addr, off) asm volatile("ds_read_b128 %0, %1 offset:" #off : "=v"(dst) : "v"(addr))
  for (int kt = 0; kt < nk; kt++) {
    if (kt + 1 < nk) {
      if (NI == 4) asm volatile("s_waitcnt vmcnt(6)" ::: "memory");
      else asm volatile("s_waitcnt vmcnt(5)" ::: "memory");
    } else {
      asm volatile("s_waitcnt vmcnt(0)" ::: "memory");
    }
    __builtin_amdgcn_s_barrier();
    if (kt + 2 < nk) {
      const int kof = (kt + 2) * 32;
      u16* st_ = sm + nxt * G3_STAGE;
      REP4(G3_ISSUE)
    }
    const unsigned aaddr = aoff + (unsigned)cur * (G3_STAGE * 2);
    const unsigned baddr = boff + (unsigned)cur * (G3_STAGE * 2);
    bf16x8 af[8], bf[NI];
    G3_DSR(af[0], aaddr, 0); G3_DSR(af[1], aaddr, 1024); G3_DSR(af[2], aaddr, 2048); G3_DSR(af[3], aaddr, 3072);
    G3_DSR(bf[0], baddr, 0); G3_DSR(bf[1], baddr, 1024);
    if (NI == 4) { G3_DSR(bf[NI - 2], baddr, 2048); G3_DSR(bf[NI - 1], baddr, 3072); }
    G3_DSR(af[4], aaddr, 4096); G3_DSR(af[5], aaddr, 5120); G3_DSR(af[6], aaddr, 6144); G3_DSR(af[7], aaddr, 7168);
    if (NI == 4) {
      asm volatile("s_waitcnt lgkmcnt(4)"
                   : "+v"(af[0]), "+v"(af[1]), "+v"(af[2]), "+v"(af[3]), "+v"(bf[0]), "+v"(bf[1]), "+v"(bf[NI - 2]), "+v"(bf[NI - 1]));
    } else {
      asm volatile("s_waitcnt lgkmcnt(4)" : "+v"(af[0]), "+v"(af[1]), "+v"(af[2]), "+v"(af[3]), "+v"(bf[0]), "+v"(bf[1]));
    }
#pragma unroll
    for (int mi = 0; mi < 4; mi++)
#pragma unroll
      for (int ni = 0; ni < NI; ni++)
        acc[mi][ni] = SWAP ? __builtin_amdgcn_mfma_f32_16x16x32_bf16(bf[ni], af[mi], acc[mi][ni], 0, 0, 0)
                           : __builtin_amdgcn_mfma_f32_16x16x32_bf16(af[mi], bf[ni], acc[mi][ni], 0, 0, 0);
    asm volatile("s_waitcnt lgkmcnt(0)" : "+v"(af[4]), "+v"(af[5]), "+v"(af[6]), "+v"(af[7]));
#pragma unroll
    for (int mi = 4; mi < 8; mi++)
#pragma unroll
      for (int ni = 0; ni < NI; ni++)
        acc[mi][ni] = SWAP ? __builtin_amdgcn_mfma_f32_16x16x32_bf16(bf[ni], af[mi], acc[mi][ni], 0, 0, 0)
                           : __builtin_amdgcn_mfma_f32_16x16x32_bf16(af[mi], bf[ni], acc[mi][ni], 0, 0, 0);
    cur = (cur == 2) ? 0 : cur + 1;
    nxt = (nxt == 2) ? 0 : nxt + 1;
  }
  asm volatile("s_waitcnt lgkmcnt(0)" ::: "memory");
  __syncthreads();
#undef G3_DSR
#undef G3_ISSUE
}

template <int NI>
__device__ __forceinline__ void zero_acc8(f32x4 (&acc)[8][NI]) {
#pragma unroll
  for (int i = 0; i < 8; i++)
#pragma unroll
    for (int j = 0; j < NI; j++) acc[i][j] = f32x4{0.f, 0.f, 0.f, 0.f};
}


__device__ __forceinline__ bool map_tile(int i, int nblk, int MT, int NT, int& mt, int& nt) {
  const int locs = nblk >> 3;
  const int xcd = blockIdx.x & 7, loc = blockIdx.x >> 3;
  const int q = (i * 8 + xcd) * locs + loc;
  if (q >= MT * NT) return false;
  const int nfull = NT >> 3, per = MT * 8;
  if (q < nfull * per) {
    int pp = q / per, r = q - pp * per;
    mt = r >> 3;
    nt = pp * 8 + (r & 7);
  } else {
    int r = q - nfull * per;
    int w = NT - nfull * 8;
    mt = r / w;
    nt = nfull * 8 + (r - mt * w);
  }
  return true;
}

#define ACC_COORDS const int wr = wave >> 1, wc = wave & 1, fr = lane & 15, fq = lane >> 4;

__device__ __forceinline__ void conv_tile(const Params& p, int t, char* smem, const int tid) {
  int j = 0;
#pragma unroll 1
  for (int i = 1; i < 26; i++)
    if (t >= p.jobs[i].tile0) j = i;
  const Job& jb = p.jobs[j];
  float(*tile)[65] = (float(*)[65])smem;
  int local = t - jb.tile0;
  int nkt = jb.Kpad >> 6;
  int kt = local % nkt, nt = local / nkt;
  int tx = tid & 63, ty = tid >> 6;
  int n = nt * 64 + tx;
  int col;
  if (jb.mode == 0) col = jb.c0 + n;
  else { int jn = n >> 7, i = n & 127; col = (i < 64) ? (64 * jn + i) : (DFF_ + 64 * jn + (i - 64)); }
  const float* sp = jb.src + col;
  const int K = jb.K, ld = jb.ld;
  const bool nok = n < jb.Nv;
#pragma unroll
  for (int i = 0; i < 16; i++) {
    int k = kt * 64 + ty + 4 * i;
    tile[ty + 4 * i][tx] = (nok && k < K) ? sp[(size_t)k * ld] : 0.f;
  }
  __syncthreads();
#pragma unroll
  for (int i = 0; i < 16; i++) {
    int nn = nt * 64 + ty + 4 * i;
    int k = kt * 64 + tx;
    jb.dst[(size_t)nn * jb.Kpad + k] = f2bf(tile[tx][ty + 4 * i]);
  }
  __syncthreads();
}

__device__ __forceinline__ void ln_row(const float* __restrict__ src, const float* __restrict__ g,
                                       const float* __restrict__ b, float* __restrict__ dst, int lane, u16* __restrict__ dstb = nullptr) {
  float4 v[4];
  float s = 0.f;
#pragma unroll
  for (int i = 0; i < 4; i++) {
    v[i] = *(const float4*)(src + i * 256 + lane * 4);
    s += v[i].x + v[i].y + v[i].z + v[i].w;
  }
  float mean = wave_sum(s, lane) * (1.0f / 1024.0f);
  float q = 0.f;
#pragma unroll
  for (int i = 0; i < 4; i++) {
    float a = v[i].x - mean, b2 = v[i].y - mean, c = v[i].z - mean, d = v[i].w - mean;
    q += a * a + b2 * b2 + c * c + d * d;
  }
  float rstd = rsqrtf(wave_sum(q, lane) * (1.0f / 1024.0f) + 1e-5f);
#pragma unroll
  for (int i = 0; i < 4; i++) {
    float4 gg = *(const float4*)(g + i * 256 + lane * 4);
    float4 bb = *(const float4*)(b + i * 256 + lane * 4);
    float4 o;
    o.x = (v[i].x - mean) * rstd * gg.x + bb.x;
    o.y = (v[i].y - mean) * rstd * gg.y + bb.y;
    o.z = (v[i].z - mean) * rstd * gg.z + bb.z;
    o.w = (v[i].w - mean) * rstd * gg.w + bb.w;
    *(float4*)(dst + i * 256 + lane * 4) = o;
    if (dstb) *(uint2*)(dstb + i * 256 + lane * 4) = make_uint2(pk2(o.x, o.y), pk2(o.z, o.w));
  }
}

__device__ __forceinline__ void ln_row2(const float* __restrict__ srcA, const float* __restrict__ srcB, const float* __restrict__ g,
                                        const float* __restrict__ b, float* dstA, float* dstB, int lane, u16* dbA, u16* dbB) {
  float4 va[4], vb[4];
  float sa = 0.f, sb = 0.f;
#pragma unroll
  for (int i = 0; i < 4; i++) {
    va[i] = *(const float4*)(srcA + i * 256 + lane * 4);
    vb[i] = *(const float4*)(srcB + i * 256 + lane * 4);
  }
#pragma unroll
  for (int i = 0; i < 4; i++) {
    sa += va[i].x + va[i].y + va[i].z + va[i].w;
    sb += vb[i].x + vb[i].y + vb[i].z + vb[i].w;
  }
  const float ma = wave_sum(sa, lane) * (1.0f / 1024.0f), mb = wave_sum(sb, lane) * (1.0f / 1024.0f);
  float qa = 0.f, qb = 0.f;
#pragma unroll
  for (int i = 0; i < 4; i++) {
    va[i].x -= ma; va[i].y -= ma; va[i].z -= ma; va[i].w -= ma;
    vb[i].x -= mb; vb[i].y -= mb; vb[i].z -= mb; vb[i].w -= mb;
    qa += va[i].x * va[i].x + va[i].y * va[i].y + va[i].z * va[i].z + va[i].w * va[i].w;
    qb += vb[i].x * vb[i].x + vb[i].y * vb[i].y + vb[i].z * vb[i].z + vb[i].w * vb[i].w;
  }
  const float ra = rsqrtf(wave_sum(qa, lane) * (1.0f / 1024.0f) + 1e-5f), rb = rsqrtf(wave_sum(qb, lane) * (1.0f / 1024.0f) + 1e-5f);
#pragma unroll
  for (int i = 0; i < 4; i++) {
    float4 gg = *(const float4*)(g + i * 256 + lane * 4);
    float4 bb = *(const float4*)(b + i * 256 + lane * 4);
    float4 oa, ob;
    oa.x = va[i].x * ra * gg.x + bb.x; oa.y = va[i].y * ra * gg.y + bb.y; oa.z = va[i].z * ra * gg.z + bb.z; oa.w = va[i].w * ra * gg.w + bb.w;
    ob.x = vb[i].x * rb * gg.x + bb.x; ob.y = vb[i].y * rb * gg.y + bb.y; ob.z = vb[i].z * rb * gg.z + bb.z; ob.w = vb[i].w * rb * gg.w + bb.w;
    *(float4*)(dstA + i * 256 + lane * 4) = oa;
    *(float4*)(dstB + i * 256 + lane * 4) = ob;
    if (dbA) {
      *(uint2*)(dbA + i * 256 + lane * 4) = make_uint2(pk2(oa.x, oa.y), pk2(oa.z, oa.w));
      *(uint2*)(dbB + i * 256 + lane * 4) = make_uint2(pk2(ob.x, ob.y), pk2(ob.z, ob.w));
    }
  }
}

struct ScanIn {
  float kk[16][64], wr[16][64], w[16][64], kt[16][64], kka[16][64], v[16][64], g[16][64];
  float c[16][4];
};
struct ScanRaw { uint2 r, k, v, rp, kp, vp, a, g; float4 dec; };

__device__ __forceinline__ ScanRaw scan_fetch(const u16* __restrict__ P, const float* __restrict__ DEC,
                                              const u16* __restrict__ AA, const u16* __restrict__ GG, int rowbase, int t,
                                              int hc) {
  ScanRaw w;
  size_t row = (size_t)(rowbase + t);
  const u16* pp = P + row * PC_ + hc;
  w.r = *(const uint2*)(pp);
  w.k = *(const uint2*)(pp + 512);
  w.v = *(const uint2*)(pp + 1024);
  if (t > 0) {
    w.rp = *(const uint2*)(pp - PC_);
    w.kp = *(const uint2*)(pp - PC_ + 512);
    w.vp = *(const uint2*)(pp - PC_ + 1024);
  } else {
    w.rp = make_uint2(0, 0); w.kp = make_uint2(0, 0); w.vp = make_uint2(0, 0);
  }
  w.dec = *(const float4*)(DEC + row * 512 + hc);
  w.a = *(const uint2*)(AA + row * 512 + hc);
  w.g = *(const uint2*)(GG + row * 512 + hc);
  return w;
}

__device__ __forceinline__ void unpack4(uint2 u, float (&o)[4]) {
  o[0] = bflo(u.x); o[1] = bfhi(u.x); o[2] = bflo(u.y); o[3] = bfhi(u.y);
}

__device__ __forceinline__ void scan_unit(const Params& p, int l, int bh, char* smem, const int tid) {
  const int lane = tid & 63, wave = tid >> 6;
  const int b = bh >> 3, h = bh & 7;
  const int rowbase = b * T_;
  const u16* P = (const u16*)(p.ws + OFF_P);
  const float* DEC = (const float*)(p.ws + OFF_DEC);
  const u16* AA = (const u16*)(p.ws + OFF_AA);
  const u16* GG = (const u16*)(p.ws + OFF_GG);
  u16* YR = (u16*)(p.ws + OFF_AA);
  ScanIn* in = (ScanIn*)smem;
  float(*ybuf)[64] = (float(*)[64])(smem + 2 * sizeof(ScanIn));
  const int tl = tid >> 4, kq = tid & 15, hc = h * 64 + kq * 4;
  float(*cst)[64] = (float(*)[64])(smem + 2 * sizeof(ScanIn) + 16 * 64 * 4);
  if (tid < 64) {
    const float* mu = p.in[5] + (size_t)l * 1824;
    const int ch = h * 64 + tid;
    cst[0][tid] = mu[ch];
    cst[1][tid] = mu[512 + ch];
    cst[2][tid] = mu[1024 + ch];
    cst[3][tid] = p.in[11][l * 512 + ch];
    float ka_ = p.in[12][l * 512 + ch];
    cst[4][tid] = ka_;
    cst[5][tid] = 1.0f - ka_;
    cst[6][tid] = p.in[13][l * 512 + ch];
    cst[7][tid] = p.in[14][l * 512 + ch];
    cst[8][tid] = p.in[15][l * 512 + ch];
  }
  __syncthreads();
  const int rp = lane >> 3, ks = lane & 7, row0 = wave * 16 + rp * 2;
  typedef float f2s __attribute__((ext_vector_type(2)));
  f2s S2[2][4];
#pragma unroll
  for (int i = 0; i < 2; i++)
#pragma unroll
    for (int e = 0; e < 4; e++) S2[i][e] = f2s{0.f, 0.f};

  auto stage = [&](const ScanRaw& w, ScanIn& dst) {
    float r[4], k[4], v[4], rq[4], kp[4], vp[4], a[4], g[4];
    unpack4(w.r, r); unpack4(w.k, k); unpack4(w.v, v);
    unpack4(w.rp, rq); unpack4(w.kp, kp); unpack4(w.vp, vp);
    unpack4(w.a, a); unpack4(w.g, g);
    float dec[4] = {w.dec.x, w.dec.y, w.dec.z, w.dec.w};
    float mu_r[4], mu_k[4], mu_v[4], kkw[4], kaw[4], omk[4], rkw[4];
    *(float4*)mu_r = *(const float4*)&cst[0][kq * 4]; *(float4*)mu_k = *(const float4*)&cst[1][kq * 4];
    *(float4*)mu_v = *(const float4*)&cst[2][kq * 4]; *(float4*)kkw = *(const float4*)&cst[3][kq * 4];
    *(float4*)kaw = *(const float4*)&cst[4][kq * 4]; *(float4*)omk = *(const float4*)&cst[5][kq * 4];
    *(float4*)rkw = *(const float4*)&cst[6][kq * 4];
    float kkr[4], ss = 0.f;
#pragma unroll
    for (int e = 0; e < 4; e++) {
      r[e] = r[e] + (rq[e] - r[e]) * mu_r[e];
      k[e] = k[e] + (kp[e] - k[e]) * mu_k[e];
      v[e] = v[e] + (vp[e] - v[e]) * mu_v[e];
      kkr[e] = k[e] * kkw[e];
      ss += kkr[e] * kkr[e];
    }
    ss = sum16(ss);
    float inv = rsqrtf(fmaxf(ss, 1e-24f));
    float c1 = 0.f, c2 = 0.f, c3 = 0.f;
    float kk[4], ktl[4], kka[4], wr[4];
#pragma unroll
    for (int e = 0; e < 4; e++) {
      kk[e] = kkr[e] * inv;
      ktl[e] = k[e] * fmaf(a[e], kaw[e], omk[e]);
      kka[e] = kk[e] * a[e];
      wr[e] = dec[e] * r[e];
      c1 += kka[e] * r[e];
      c2 += ktl[e] * r[e];
      c3 += r[e] * ktl[e] * rkw[e];
    }
    c1 = sum16(c1); c2 = sum16(c2); c3 = sum16(c3);
    *(float4*)&dst.kk[tl][kq * 4] = make_float4(kk[0], kk[1], kk[2], kk[3]);
    *(float4*)&dst.wr[tl][kq * 4] = make_float4(wr[0], wr[1], wr[2], wr[3]);
    *(float4*)&dst.w[tl][kq * 4] = make_float4(dec[0], dec[1], dec[2], dec[3]);
    *(float4*)&dst.kt[tl][kq * 4] = make_float4(ktl[0], ktl[1], ktl[2], ktl[3]);
    *(float4*)&dst.kka[tl][kq * 4] = make_float4(kka[0], kka[1], kka[2], kka[3]);
    *(float4*)&dst.v[tl][kq * 4] = make_float4(v[0], v[1], v[2], v[3]);
    *(float4*)&dst.g[tl][kq * 4] = make_float4(g[0], g[1], g[2], g[3]);
    if (kq == 0) *(float4*)&dst.c[tl][0] = make_float4(c1, c2, c3, 0.f);
  };

  {
    ScanRaw w0 = scan_fetch(P, DEC, AA, GG, rowbase, tl, hc);
    stage(w0, in[0]);
  }
  __syncthreads();
  constexpr int NCH = T_ / 16;
  for (int c = 0; c < NCH; c++) {
    ScanIn& cur = in[c & 1];
    ScanRaw nx;
    const bool have_next = (c + 1 < NCH);
    if (have_next) nx = scan_fetch(P, DEC, AA, GG, rowbase, (c + 1) * 16 + tl, hc);
    {
      typedef float f2 __attribute__((ext_vector_type(2)));
      struct StepA { float4 kk0, kk1, wr0, wr1; };
      struct StepIn { float4 kk0, kk1, wr0, wr1, w0, w1, kt0, kt1, ka0, ka1; float2 vv, cc; };
      auto ldA = [&](int s) {
        StepA r;
        r.kk0 = *(const float4*)&cur.kk[s][ks * 8]; r.kk1 = *(const float4*)&cur.kk[s][ks * 8 + 4];
        r.wr0 = *(const float4*)&cur.wr[s][ks * 8]; r.wr1 = *(const float4*)&cur.wr[s][ks * 8 + 4];
        return r;
      };
      StepA nxa = ldA(0);
#pragma unroll 1
      for (int s4 = 0; s4 < 16; s4 += 4) {
      float yv[4][2];
#pragma unroll
      for (int u = 0; u < 4; u++) {
        const int s = s4 + u;
        StepIn in_;
        in_.kk0 = nxa.kk0; in_.kk1 = nxa.kk1; in_.wr0 = nxa.wr0; in_.wr1 = nxa.wr1;
        in_.vv = *(const float2*)&cur.v[s][row0];
        in_.cc = *(const float2*)&cur.c[s][0];
        in_.w0 = *(const float4*)&cur.w[s][ks * 8];   in_.w1 = *(const float4*)&cur.w[s][ks * 8 + 4];
        in_.kt0 = *(const float4*)&cur.kt[s][ks * 8]; in_.kt1 = *(const float4*)&cur.kt[s][ks * 8 + 4];
        in_.ka0 = *(const float4*)&cur.kka[s][ks * 8]; in_.ka1 = *(const float4*)&cur.kka[s][ks * 8 + 4];
        nxa = ldA((s + 1) & 15);
        const f2 kk[4] = {{in_.kk0.x, in_.kk0.y}, {in_.kk0.z, in_.kk0.w}, {in_.kk1.x, in_.kk1.y}, {in_.kk1.z, in_.kk1.w}};
        const f2 wr[4] = {{in_.wr0.x, in_.wr0.y}, {in_.wr0.z, in_.wr0.w}, {in_.wr1.x, in_.wr1.y}, {in_.wr1.z, in_.wr1.w}};
        const f2 w[4] = {{in_.w0.x, in_.w0.y}, {in_.w0.z, in_.w0.w}, {in_.w1.x, in_.w1.y}, {in_.w1.z, in_.w1.w}};
        const f2 kt[4] = {{in_.kt0.x, in_.kt0.y}, {in_.kt0.z, in_.kt0.w}, {in_.kt1.x, in_.kt1.y}, {in_.kt1.z, in_.kt1.w}};
        const f2 ka[4] = {{in_.ka0.x, in_.ka0.y}, {in_.ka0.z, in_.ka0.w}, {in_.ka1.x, in_.ka1.y}, {in_.ka1.z, in_.ka1.w}};
        const float vr[2] = {in_.vv.x, in_.vv.y};
        float d1[2], d2[2];
#pragma unroll
        for (int i = 0; i < 2; i++) {
          f2 a = S2[i][0] * kk[0] + S2[i][1] * kk[1];
          f2 a2 = S2[i][2] * kk[2] + S2[i][3] * kk[3];
          f2 bq = S2[i][0] * wr[0] + S2[i][1] * wr[1];
          f2 b2 = S2[i][2] * wr[2] + S2[i][3] * wr[3];
          a += a2; bq += b2;
          d1[i] = a.x + a.y;
          d2[i] = bq.x + bq.y;
        }
        d1[0] = sum8(d1[0]); d1[1] = sum8(d1[1]); d2[0] = sum8(d2[0]); d2[1] = sum8(d2[1]);
#pragma unroll
        for (int i = 0; i < 2; i++) {
          const float skk = d1[i];
          yv[u][i] = d2[i] - skk * in_.cc.x + vr[i] * in_.cc.y;
          const f2 nsk = {-skk, -skk}, vv2 = {vr[i], vr[i]};
#pragma unroll
          for (int e = 0; e < 4; e++) S2[i][e] = S2[i][e] * w[e] + (nsk * ka[e] + vv2 * kt[e]);
        }
      }
      if (ks == 0) {
#pragma unroll
        for (int u = 0; u < 4; u++) *(float2*)&ybuf[s4 + u][row0] = make_float2(yv[u][0], yv[u][1]);
      }
      }
    }
    __syncthreads();
    {
      float4 y4 = *(const float4*)&ybuf[tl][kq * 4];
      float y[4] = {y4.x, y4.y, y4.z, y4.w};
      float mean = sum16(y[0] + y[1] + y[2] + y[3]) * (1.0f / 64.0f);
      float q = 0.f;
#pragma unroll
      for (int e = 0; e < 4; e++) { y[e] -= mean; q += y[e] * y[e]; }
      float rstd = rsqrtf(sum16(q) * (1.0f / 64.0f) + 64e-5f);
      float c3 = cur.c[tl][2];
      float4 v4 = *(const float4*)&cur.v[tl][kq * 4];
      float4 g4 = *(const float4*)&cur.g[tl][kq * 4];
      float vv[4] = {v4.x, v4.y, v4.z, v4.w};
      float gg[4] = {g4.x, g4.y, g4.z, g4.w};
      float o[4], lg[4], lb[4];
      *(float4*)lg = *(const float4*)&cst[7][kq * 4]; *(float4*)lb = *(const float4*)&cst[8][kq * 4];
#pragma unroll
      for (int e = 0; e < 4; e++) o[e] = (y[e] * rstd * lg[e] + lb[e] + c3 * vv[e]) * gg[e];
      size_t row = (size_t)(rowbase + c * 16 + tl);
      *(uint2*)(YR + row * 512 + hc) = make_uint2(pk2(o[0], o[1]), pk2(o[2], o[3]));
    }
    if (have_next) stage(nx, in[(c + 1) & 1]);
    __syncthreads();
  }
}

constexpr int KLD = 104, VLD = 72;
struct AttnSmem { u16 k[2][64 * KLD]; u16 v[2][64 * VLD]; };

__device__ __forceinline__ void attn_unit(const Params& p, int bh, int qi, char* smem, const int tid) {
  const int lane = tid & 63, wave = tid >> 6;
  const int fr = lane & 15, fq = lane >> 4;
  const int b = bh >> 3, h = bh & 7;
  const int rowbase = b * T_;
  u16* P = (u16*)(p.ws + OFF_P);
  const u16* Q = (const u16*)(p.ws + OFF_Q);
  const u16* KN = (const u16*)p.out;
  const u16* VT = (const u16*)p.out + (size_t)M_ * 512;
  const float2* ROPE = (const float2*)(p.ws + OFF_ROPE);
  AttnSmem* sm = (AttnSmem*)smem;
  const int qs = (qi == 0) ? 0 : 16 + (qi - 1) * 128;
  const int qn = (qi == 0) ? 16 : 128;
  const int q0 = qs + wave * 32;
  const bool wave_valid = (wave * 32 < qn);
  const int nkt = (qs + qn - 1) / 64 + 1;

  bf16x8 qf[2][3];
#pragma unroll
  for (int qb = 0; qb < 2; qb++) {
    int query = min(q0 + qb * 16 + fr, T_ - 1);
    const u16* qp = Q + (size_t)(rowbase + query) * 768 + h * 96;
    uint4 a0 = *(const uint4*)(qp + fq * 8);
    uint4 a1 = *(const uint4*)(qp + 32 + fq * 8);
    uint4 own = *(const uint4*)(qp + 64 + fq * 8);
    uint4 oth = *(const uint4*)(qp + 64 + (fq ^ 2) * 8);
    unsigned ow[4] = {own.x, own.y, own.z, own.w};
    unsigned tw[4] = {oth.x, oth.y, oth.z, oth.w};
    unsigned rw[4];
    const float2* rp = ROPE + (size_t)query * 16 + (fq & 1) * 8;
#pragma unroll
    for (int e = 0; e < 4; e++) {
      float2 cs0 = rp[2 * e], cs1 = rp[2 * e + 1];
      float o0 = bflo(ow[e]), o1 = bfhi(ow[e]);
      float t0 = bflo(tw[e]), t1 = bfhi(tw[e]);
      float r0, r1;
      if (fq < 2) { r0 = o0 * cs0.x - t0 * cs0.y; r1 = o1 * cs1.x - t1 * cs1.y; }
      else { r0 = t0 * cs0.y + o0 * cs0.x; r1 = t1 * cs1.y + o1 * cs1.x; }
      rw[e] = pk2(r0, r1);
    }
    uint4 a2 = make_uint4(rw[0], rw[1], rw[2], rw[3]);
    qf[qb][0] = *(bf16x8*)&a0;
    qf[qb][1] = *(bf16x8*)&a1;
    qf[qb][2] = *(bf16x8*)&a2;
  }

  f32x4 O[4][2];
#pragma unroll
  for (int i = 0; i < 4; i++)
#pragma unroll
    for (int j = 0; j < 2; j++) O[i][j] = f32x4{0.f, 0.f, 0.f, 0.f};
  float mrun[2] = {-1e30f, -1e30f}, lrun[2] = {0.f, 0.f};
  const float sc = 1.4426950408889634f / 9.797958971132712f;

  uint4 rk[3], rv[2];
  auto fetch_tile = [&](int kt) {
#pragma unroll
    for (int i = 0; i < 3; i++) {
      int c = tid + 256 * i;
      int key = c / 12, cc = c % 12;
      int t = kt * 64 + key;
      uint4 val = make_uint4(0, 0, 0, 0);
      if (t < T_) {
        size_t row = (size_t)(rowbase + t);
        if (cc < 8) val = *(const uint4*)(KN + row * 512 + h * 64 + cc * 8);
        else val = *(const uint4*)(P + row * PC_ + PKR_ + (cc - 8) * 8);
      }
      rk[i] = val;
    }
#pragma unroll
    for (int i = 0; i < 2; i++) {
      int c = tid + 256 * i;
      int dv = c >> 3, cc = c & 7;
      int t = kt * 64 + cc * 8;
      uint4 val = make_uint4(0, 0, 0, 0);
      if (t < T_) val = *(const uint4*)(VT + ((size_t)bh * 64 + dv) * T_ + t);
      rv[i] = val;
    }
  };
  auto store_tile = [&](int buf) {
#pragma unroll
    for (int i = 0; i < 3; i++) {
      int c = tid + 256 * i;
      int key = c / 12, cc = c % 12;
      *(uint4*)(&sm->k[buf][key * KLD + cc * 8]) = rk[i];
    }
#pragma unroll
    for (int i = 0; i < 2; i++) {
      int c = tid + 256 * i;
      int dv = c >> 3, cc = c & 7;
      *(uint4*)(&sm->v[buf][dv * VLD + cc * 8]) = rv[i];
    }
  };

  fetch_tile(0);
  for (int kt = 0; kt < nkt; kt++) {
    const int buf = kt & 1;
    store_tile(buf);
    __syncthreads();
    if (kt + 1 < nkt) fetch_tile(kt + 1);
    if (wave_valid && kt * 64 <= q0 + 31) {
      const u16* Ks = sm->k[buf];
      const u16* Vs = sm->v[buf];
      f32x4 s[4][2];
#pragma unroll
      for (int i = 0; i < 4; i++)
#pragma unroll
        for (int j = 0; j < 2; j++) s[i][j] = f32x4{0.f, 0.f, 0.f, 0.f};
#pragma unroll
      for (int ks = 0; ks < 3; ks++)
#pragma unroll
        for (int kb = 0; kb < 4; kb++) {
          bf16x8 kf = *(const bf16x8*)(Ks + (kb * 16 + fr) * KLD + ks * 32 + fq * 8);
#pragma unroll
          for (int qb = 0; qb < 2; qb++) s[kb][qb] = __builtin_amdgcn_mfma_f32_16x16x32_bf16(kf, qf[qb][ks], s[kb][qb], 0, 0, 0);
        }
      const bool need_mask = (kt * 64 + 63 > q0);
      unsigned pfw[2][2][4];
#pragma unroll
      for (int qb = 0; qb < 2; qb++) {
        const int query = q0 + qb * 16 + fr;
        float mx = -1e30f;
        if (need_mask) {
#pragma unroll
          for (int kb = 0; kb < 4; kb++)
#pragma unroll
            for (int j = 0; j < 4; j++) {
              int key = kt * 64 + kb * 16 + fq * 4 + j;
              if (key > query) s[kb][qb][j] = -1e30f;
            }
        }
#pragma unroll
        for (int kb = 0; kb < 4; kb++)
          mx = fmaxf(mx, fmaxf(fmaxf(s[kb][qb][0], s[kb][qb][1]), fmaxf(s[kb][qb][2], s[kb][qb][3])));
        mx = fmaxf(mx, shx(mx, lane, 16));
        mx = fmaxf(mx, shx(mx, lane, 32));
        const float mold = mrun[qb];
        const float mnew = fmaxf(mold, mx * sc);
        mrun[qb] = mnew;
        float ps = 0.f;
#pragma unroll
        for (int kb = 0; kb < 4; kb++) {
          float p0 = __builtin_amdgcn_exp2f(fmaf(s[kb][qb][0], sc, -mnew)), p1 = __builtin_amdgcn_exp2f(fmaf(s[kb][qb][1], sc, -mnew));
          float p2 = __builtin_amdgcn_exp2f(fmaf(s[kb][qb][2], sc, -mnew)), p3 = __builtin_amdgcn_exp2f(fmaf(s[kb][qb][3], sc, -mnew));
          ps += (p0 + p1) + (p2 + p3);
          pfw[qb][kb >> 1][(kb & 1) * 2 + 0] = pk2(p0, p1);
          pfw[qb][kb >> 1][(kb & 1) * 2 + 1] = pk2(p2, p3);
        }
        if (__builtin_amdgcn_ballot_w64(mnew != mold) != 0) {
          const float alpha = __builtin_amdgcn_exp2f(mold - mnew);
          lrun[qb] *= alpha;
#pragma unroll
          for (int dvb = 0; dvb < 4; dvb++) {
            O[dvb][qb][0] *= alpha; O[dvb][qb][1] *= alpha; O[dvb][qb][2] *= alpha; O[dvb][qb][3] *= alpha;
          }
        }
        lrun[qb] += ps;
      }
#pragma unroll
      for (int s2 = 0; s2 < 2; s2++)
#pragma unroll
        for (int dvb = 0; dvb < 4; dvb++) {
          const u16* vp = Vs + (dvb * 16 + fr) * VLD + s2 * 32 + fq * 4;
          uint2 v0 = *(const uint2*)vp;
          uint2 v1 = *(const uint2*)(vp + 16);
          uint4 vv = make_uint4(v0.x, v0.y, v1.x, v1.y);
          bf16x8 vf = *(bf16x8*)&vv;
#pragma unroll
          for (int qb = 0; qb < 2; qb++) {
            uint4 pw = make_uint4(pfw[qb][s2][0], pfw[qb][s2][1], pfw[qb][s2][2], pfw[qb][s2][3]);
            O[dvb][qb] = __builtin_amdgcn_mfma_f32_16x16x32_bf16(vf, *(bf16x8*)&pw, O[dvb][qb], 0, 0, 0);
          }
        }
    }
  }
  __syncthreads();
  if (wave_valid) {
#pragma unroll
    for (int qb = 0; qb < 2; qb++) {
      float l = lrun[qb];
      l += shx(l, lane, 16);
      l += shx(l, lane, 32);
      float inv = 1.0f / l;
      int query = q0 + qb * 16 + fr;
      if (query < qs + qn) {
        u16* op = P + (size_t)(rowbase + query) * PC_ + PMLA_ + h * 64 + fq * 4;
#pragma unroll
        for (int dvb = 0; dvb < 4; dvb++) {
          *(uint2*)(op + dvb * 16) =
              make_uint2(pk2(O[dvb][qb][0] * inv, O[dvb][qb][1] * inv), pk2(O[dvb][qb][2] * inv, O[dvb][qb][3] * inv));
        }
      }
    }
  }
}

#define XB_TMO      128
#define XB_XCNT(j)  (256  + 64 * (j))
#define XB_XSUB(j)  (1280 + 64 * (j))
#define XB_XGEN(j)  (2304 + 64 * (j))
#define XB_TOP      3328
#define XB_TOPGEN   3392
#define XCD_BAR_WORDS 3456
#define XB_SPIN_CAP (1u << 18)
#define LAS __attribute__((address_space(3)))

__device__ __forceinline__ unsigned xb_ld(unsigned* p)              { return __hip_atomic_load(p, __ATOMIC_RELAXED, __HIP_MEMORY_SCOPE_AGENT); }
__device__ __forceinline__ unsigned xb_add(unsigned* p, unsigned v) { return __hip_atomic_fetch_add(p, v, __ATOMIC_RELAXED, __HIP_MEMORY_SCOPE_AGENT); }
__device__ __forceinline__ unsigned xb_xcc_id() { return (unsigned)__builtin_amdgcn_s_getreg((3 << 11) | 20) & 0xFu; }
#define XB_SPIN(cond, bar) do { unsigned _sp = 0; while (cond) { __builtin_amdgcn_s_sleep(1); \
    if ((++_sp & 255u) == 0u) { if (xb_ld(&(bar)[XB_TMO])) break; if (_sp > XB_SPIN_CAP) { atomicAdd(&(bar)[XB_TMO], 1u); break; } } } } while (0)

struct XcdBarrier {
    unsigned* bar; unsigned x;
    volatile LAS unsigned* st;
};

__device__ __forceinline__ XcdBarrier xcd_barrier_post(unsigned* bar, volatile LAS unsigned* st) {
    XcdBarrier b; b.bar = bar; b.x = xb_xcc_id(); b.st = st;
    if (threadIdx.x == 0) (void)xb_add(&bar[XB_XCNT(b.x)], 1u);
    return b;
}
__device__ __forceinline__ void xcd_barrier_complete(unsigned* bar, unsigned x, unsigned& nloc, unsigned& nx) {
    const unsigned G = gridDim.x * gridDim.y * gridDim.z;
    unsigned sum, cnt, mine, sp = 0u;
    for (;;) {
        sum = 0u; cnt = 0u; mine = 0u;
#pragma unroll
        for (unsigned j = 0; j < 16; ++j) { const unsigned c = xb_ld(&bar[XB_XCNT(j)]); sum += c; cnt += (c > 0u) ? 1u : 0u; mine = (j == x) ? c : mine; }
        if (sum == G) break;
        __builtin_amdgcn_s_sleep(1);
        if ((++sp & 255u) == 0u) { if (xb_ld(&bar[XB_TMO])) break; if (sp > XB_SPIN_CAP) { atomicAdd(&bar[XB_TMO], 1u); break; } }
    }
    nloc = mine > 0u ? mine : 1u; nx = cnt > 0u ? cnt : 1u;
}

__device__ __forceinline__ void xcd_barrier(const XcdBarrier& b, const int tid_) {
    asm volatile("s_waitcnt vmcnt(0)" ::: "memory");
    __syncthreads();
    if (tid_ == 0) {
        unsigned* bar = b.bar;
        __builtin_amdgcn_s_waitcnt(0);
        unsigned nloc = b.st[0], nx = b.st[1];
        if (nloc == 0u) { xcd_barrier_complete(bar, b.x, nloc, nx); b.st[0] = nloc; b.st[1] = nx; }
        const unsigned old = xb_add(&bar[XB_XSUB(b.x)], 1u);
        const unsigned gen = old / nloc;
        if (old + 1u == (gen + 1u) * nloc) {
            __builtin_amdgcn_fence(__ATOMIC_RELEASE, "agent");
            asm volatile("s_waitcnt vmcnt(0)" ::: "memory");
            const unsigned og = xb_add(&bar[XB_TOP], 1u);
            const unsigned tg = og / nx;
            if (og + 1u == (tg + 1u) * nx) xb_add(&bar[XB_TOPGEN], 1u);
            else XB_SPIN(xb_ld(&bar[XB_TOPGEN]) == tg, bar);
            __builtin_amdgcn_fence(__ATOMIC_ACQUIRE, "agent");
            xb_add(&bar[XB_XGEN(b.x)], 1u);
            asm volatile("s_waitcnt vmcnt(0)" ::: "memory");
        } else {
            XB_SPIN(xb_ld(&bar[XB_XGEN(b.x)]) == gen, bar);
            __builtin_amdgcn_fence(__ATOMIC_ACQUIRE, "agent");
            asm volatile("s_waitcnt vmcnt(0)" ::: "memory");
        }
    }
    __syncthreads();
}


__global__ void __launch_bounds__(256, 2) mega(Params p) {
  cg::grid_group grid = cg::this_grid();
  __shared__ __attribute__((aligned(16))) char smem[SMEM_BYTES];
  __shared__ int s_unit;
  __shared__ uint4 xb_words;
  if (threadIdx.x == 0) xb_words = make_uint4(0u, 0u, 0u, 0u);
  __syncthreads();
  (void)xcd_barrier_post((unsigned*)(p.ws + OFF_BAR), (volatile LAS unsigned*)&xb_words);
#define XB_SYNC() do { XcdBarrier xb_; xb_.bar = (unsigned*)(p.ws + OFF_BAR); xb_.x = xb_xcc_id(); xb_.st = (volatile LAS unsigned*)&xb_words; xcd_barrier(xb_, wave0 * 64 + fresh_lane()); } while (0)
  int wave0 = __builtin_amdgcn_readfirstlane((int)(threadIdx.x >> 6));
  asm volatile("" : "+s"(wave0));
  const int nblk = gridDim.x;
#define H ((float*)(p.ws + OFF_H))
#define P ((u16*)(p.ws + OFF_P))
#define DEC ((float*)(p.ws + OFF_DEC))
#define AA ((u16*)(p.ws + OFF_AA))
#define GG ((u16*)(p.ws + OFF_GG))
#define Q ((u16*)(p.ws + OFF_Q))
#define MIX ((u16*)(p.ws + OFF_DEC))
#define HB1 ((u16*)p.out + (size_t)2 * M_ * 512)
#define HB2 ((u16*)(p.ws + OFF_HB2))
#define HBH ((u16*)(p.ws + OFF_AA))
#define ZERO ((const u16*)(p.ws + OFF_ZERO))
#define ACT ((u16*)(p.ws + OFF_P))
#define ROPE ((float2*)(p.ws + OFF_ROPE))
#define CTR ((int*)(p.ws + OFF_CTR))
#define KN ((u16*)p.out)
#define VT ((u16*)p.out + (size_t)M_ * 512)
#define YR ((u16*)(p.ws + OFF_AA))

  {
  PHASE_TID
  for (int t = blockIdx.x; t < p.nconv; t += nblk) conv_tile(p, t, smem, tid);
  for (int i = blockIdx.x * 256 + tid; i < T_ * 16; i += nblk * 256) {
    int t = i >> 4, f = i & 15;
    double rev = (double)t * ROPE_C[f];
    rev -= floor(rev);
    float r = (float)rev;
    ROPE[i] = make_float2(__builtin_amdgcn_cosf(r), __builtin_amdgcn_sinf(r));
  }
  for (int row = (blockIdx.x * 4 + wave) * 2; row < M_; row += nblk * 8) {
    int b = row / T_, t = row % T_;
    const float* srcA = (t < NMETA_) ? (p.in[1] + (size_t)t * 1024) : (p.in[0] + ((size_t)b * SEQ_ + (t - NMETA_)) * 1024);
    u16* hb = (row < HB_SPLIT) ? HB1 + (size_t)row * 1024 : HB2 + (size_t)(row - HB_SPLIT) * 1024;
    ln_row2(srcA, srcA + 1024, p.in[2], p.in[3], H + (size_t)row * 1024, H + (size_t)(row + 1) * 1024, lane, hb, hb + 1024);
  }
  if (blockIdx.x == 0 && tid < 16) CTR[tid] = 0;
  if (blockIdx.x == 1) { for (int i = tid; i < 2048; i += 256) ((unsigned*)(p.ws + OFF_ZERO))[i] = 0u; }
  }
  grid.sync();

#pragma unroll 1
  for (int ph_ = 0; ph_ < 20; ph_++) {
    const int l = ph_ / 10, kph = ph_ - l * 10;
    const u16* WL = (const u16*)(p.ws + OFF_W) + (size_t)l * W_LAYER;
    if (kph == 0) {
    PHASE_TID
    for (int it_ = 0; it_ * nblk < 257 * 19; it_++) {
      int mt, nt;
      if (!map_tile(it_, nblk, 257, 19, mt, nt)) continue;
      f32x4 acc[8][4];
      zero_acc8(acc);
      ADma al = ADma{(mt < 255) ? HB1 : HB2, 1024, (mt < 255) ? mt * 256 : mt * 256 - HB_SPLIT, 0, ZERO, 0};
      gemm3(acc, al, WL + W_IN, 1024, nt * 128, 1024, smem, tid);
      ACC_COORDS
#pragma unroll
      for (int mi = 0; mi < 8; mi++)
#pragma unroll
        for (int ni = 0; ni < 4; ni++) {
          int col = nt * 128 + wc * 64 + ni * 16 + fq * 4;
          int row = mt * 256 + wr * 128 + mi * 16 + fr;
          if (col < PC_)
            *(uint2*)(P + (size_t)row * PC_ + col) = make_uint2(pk2(acc[mi][ni][0], acc[mi][ni][1]), pk2(acc[mi][ni][2], acc[mi][ni][3]));
        }
    }
    }
    if (kph == 1) {
    PHASE_TID
    {
      const float* qg = p.in[16] + l * 256;
      const float* kvg = p.in[18] + l * 256;
      for (int rbase = (blockIdx.x * 4 + wave) * 4; rbase < M_; rbase += nblk * 16) {
        const int row = rbase + (lane >> 4), sl = lane & 15;
        u16* pr = P + (size_t)row * PC_;
        uint4 q0 = *(const uint4*)(pr + PMLA_ + sl * 16), q1 = *(const uint4*)(pr + PMLA_ + sl * 16 + 8);
        uint4 k0 = *(const uint4*)(pr + PKV_ + sl * 16), k1 = *(const uint4*)(pr + PKV_ + sl * 16 + 8);
        const int t = row % T_;
        float x1 = bf2f(pr[PKR_ + sl]), x2 = bf2f(pr[PKR_ + 16 + sl]);
        float2 cs = ROPE[t * 16 + sl];
        const unsigned qw[8] = {q0.x, q0.y, q0.z, q0.w, q1.x, q1.y, q1.z, q1.w};
        const unsigned kw[8] = {k0.x, k0.y, k0.z, k0.w, k1.x, k1.y, k1.z, k1.w};
        float s1 = 0.f, s2 = 0.f;
#pragma unroll
        for (int e = 0; e < 8; e++) {
          float a0 = bflo(qw[e]), a1 = bfhi(qw[e]), c0 = bflo(kw[e]), c1 = bfhi(kw[e]);
          s1 += a0 * a0 + a1 * a1;
          s2 += c0 * c0 + c1 * c1;
        }
        s1 = sum16(s1);
        s2 = sum16(s2);
        const float r1 = rsqrtf(s1 * (1.0f / 256.0f) + 1e-6f), r2 = rsqrtf(s2 * (1.0f / 256.0f) + 1e-6f);
        unsigned oq[8], ok[8];
#pragma unroll
        for (int e = 0; e < 8; e++) {
          float2 g1 = *(const float2*)(qg + sl * 16 + 2 * e), g2 = *(const float2*)(kvg + sl * 16 + 2 * e);
          oq[e] = pk2(bflo(qw[e]) * r1 * g1.x, bfhi(qw[e]) * r1 * g1.y);
          ok[e] = pk2(bflo(kw[e]) * r2 * g2.x, bfhi(kw[e]) * r2 * g2.y);
        }
        *(uint4*)(pr + PMLA_ + sl * 16) = make_uint4(oq[0], oq[1], oq[2], oq[3]);
        *(uint4*)(pr + PMLA_ + sl * 16 + 8) = make_uint4(oq[4], oq[5], oq[6], oq[7]);
        *(uint4*)(pr + PKV_ + sl * 16) = make_uint4(ok[0], ok[1], ok[2], ok[3]);
        *(uint4*)(pr + PKV_ + sl * 16 + 8) = make_uint4(ok[4], ok[5], ok[6], ok[7]);
        pr[PKR_ + sl] = f2bf(x1 * cs.x - x2 * cs.y);
        pr[PKR_ + 16 + sl] = f2bf(x1 * cs.y + x2 * cs.x);
      }
      const float* mu = p.in[5] + (size_t)l * 1824;
      for (int tile = blockIdx.x; tile < 514 * 12; tile += nblk) {
        int mt = tile / 12, sub = tile % 12, which = sub >> 2, nt = sub & 3;
        f32x4 acc[4][4];
        zero_acc(acc);
        ACC_COORDS
        if (which == 0) {
          AL<3> al{P + 1536, PC_, mt * 128, 0, 64, mu + 1536, 0};
          gemm_loop(acc, al, WL + W_LW, 64, nt * 128, 64, smem, tid);
          const float* w0 = p.in[6] + l * 512;
#pragma unroll
          for (int mi = 0; mi < 4; mi++)
#pragma unroll
            for (int ni = 0; ni < 4; ni++) {
              int col = nt * 128 + wc * 64 + ni * 16 + fr;
              float w0c = w0[col];
#pragma unroll
              for (int j = 0; j < 4; j++) {
                int row = mt * 128 + wr * 64 + mi * 16 + fq * 4 + j;
                float x = -(acc[mi][ni][j] + w0c);
                float sp = fmaxf(x, 0.f) + __logf(1.0f + __expf(-fabsf(x)));
                float wraw = -sp - 0.5f;
                DEC[(size_t)row * 512 + col] = __expf(-__expf(wraw));
              }
            }
        } else if (which == 1) {
          AL<3> al{P + 1600, PC_, mt * 128, 0, 64, mu + 1600, 1};
          gemm_loop(acc, al, WL + W_LA, 64, nt * 128, 64, smem, tid);
          const float* a0 = p.in[8] + l * 512;
#pragma unroll
          for (int mi = 0; mi < 4; mi++)
#pragma unroll
            for (int ni = 0; ni < 4; ni++) {
              int col = nt * 128 + wc * 64 + ni * 16 + fr;
              float a0c = a0[col];
#pragma unroll
              for (int j = 0; j < 4; j++) {
                int row = mt * 128 + wr * 64 + mi * 16 + fq * 4 + j;
                AA[(size_t)row * 512 + col] = f2bf(sigmoidf_(acc[mi][ni][j] + a0c));
              }
            }
        } else {
          AL<3> al{P + 1664, PC_, mt * 128, 0, 160, mu + 1664, 2};
          gemm_loop(acc, al, WL + W_LG, 192, nt * 128, 192, smem, tid);
#pragma unroll
          for (int mi = 0; mi < 4; mi++)
#pragma unroll
            for (int ni = 0; ni < 4; ni++) {
              int col = nt * 128 + wc * 64 + ni * 16 + fr;
#pragma unroll
              for (int j = 0; j < 4; j++) {
                int row = mt * 128 + wr * 64 + mi * 16 + fq * 4 + j;
                GG[(size_t)row * 512 + col] = f2bf(acc[mi][ni][j]);
              }
            }
        }
      }
    }
    }
    if (kph == 2) {
    PHASE_TID
    for (int it_ = 0; it_ * nblk < 257 * 14; it_++) {
      int mt, sub;
      if (!map_tile(it_, nblk, 257, 14, mt, sub)) continue;
      f32x4 acc[8][4];
      zero_acc8(acc);
      ACC_COORDS
      if (sub < 6) {
        ADma al{P + PMLA_, PC_, mt * 256, 0, ZERO, 0};
        gemm3(acc, al, WL + W_UQ, 256, sub * 128, 256, smem, tid);
#pragma unroll
        for (int mi = 0; mi < 8; mi++)
#pragma unroll
          for (int ni = 0; ni < 4; ni++) {
            int col = sub * 128 + wc * 64 + ni * 16 + fq * 4;
            int row = mt * 256 + wr * 128 + mi * 16 + fr;
            *(uint2*)(Q + (size_t)row * 768 + col) = make_uint2(pk2(acc[mi][ni][0], acc[mi][ni][1]), pk2(acc[mi][ni][2], acc[mi][ni][3]));
          }
      } else if (sub < 10) {
        int nt = sub - 6;
        ADma al{P + PKV_, PC_, mt * 256, 0, ZERO, 0};
        gemm3(acc, al, WL + W_UK, 256, nt * 128, 256, smem, tid);
#pragma unroll
        for (int mi = 0; mi < 8; mi++)
#pragma unroll
          for (int ni = 0; ni < 4; ni++) {
            int col = nt * 128 + wc * 64 + ni * 16 + fq * 4;
            int row = mt * 256 + wr * 128 + mi * 16 + fr;
            *(uint2*)(KN + (size_t)row * 512 + col) = make_uint2(pk2(acc[mi][ni][0], acc[mi][ni][1]), pk2(acc[mi][ni][2], acc[mi][ni][3]));
          }
      } else {
        int nt = sub - 10;
        ADma al{P + PKV_, PC_, mt * 256, 0, ZERO, 0};
        gemm3<4, false>(acc, al, WL + W_UV, 256, nt * 128, 256, smem, tid);
#pragma unroll
        for (int mi = 0; mi < 8; mi++)
#pragma unroll
          for (int ni = 0; ni < 4; ni++) {
            int col = nt * 128 + wc * 64 + ni * 16 + fr;
            int row = mt * 256 + wr * 128 + mi * 16 + fq * 4;
            int b = row / T_, t = row % T_;
            size_t o = ((size_t)(b * 512 + col)) * T_ + t;
            *(uint2*)(VT + o) = make_uint2(pk2(acc[mi][ni][0], acc[mi][ni][1]), pk2(acc[mi][ni][2], acc[mi][ni][3]));
          }
      }
    }
    }
    if (kph == 3) {
    PHASE_TID
    {
      const int xcd = blockIdx.x & 7, loc = blockIdx.x >> 3;
      const int total = 16 * 33;
      const bool scan_wg = (loc < 16), partner = (loc >= (nblk >> 4) && loc < (nblk >> 4) + 16);
      if (scan_wg) {
        scan_unit(p, l, xcd * 16 + loc, smem, launder(tid));
        __syncthreads();
      }
      if (!partner) {
        while (true) {
          if (tid == 0) s_unit = atomicAdd(&CTR[l * 8 + xcd], 1);
          __syncthreads();
          int v = s_unit;
          __syncthreads();
          if (v >= total) break;
          const int tidu = launder(tid);
          int g = v / 66, w = v - g * 66;
          attn_unit(p, xcd * 16 + g * 2 + (w & 1), 32 - (w >> 1), smem, tidu);
          __syncthreads();
        }
      }
    }
    }
    if (kph == 4) {
    PHASE_TID
    {
    u16* scr = (u16*)(p.ws + OFF_SCR) + (size_t)blockIdx.x * 32768;
    for (int it_ = 0; it_ * nblk < 256 * 8; it_++) {
      int mt, nt;
      if (!map_tile(it_, nblk, 256, 8, mt, nt)) continue;
      f32x4 acc[8][4];
      ADma alh = ADma{(mt < 255) ? HB1 : HB2, 1024, (mt < 255) ? mt * 256 : mt * 256 - HB_SPLIT, 0, ZERO, 0};
      zero_acc8(acc);
      gemm3(acc, alh, WL + W_G, 1024, nt * 128, 1024, smem, launder(tid));
      { const int tq_ = launder(tid); const int lane = tq_ & 63, wave = tq_ >> 6; ACC_COORDS
#pragma unroll
        for (int mi = 0; mi < 8; mi++)
#pragma unroll
          for (int ni = 0; ni < 4; ni++) {
            int col = nt * 128 + wc * 64 + ni * 16 + fq * 4;
            int row = mt * 256 + wr * 128 + mi * 16 + fr;
            *(uint2*)(MIX + (size_t)row * 1024 + col) = make_uint2(pk2(sigmoidf_(acc[mi][ni][0]), sigmoidf_(acc[mi][ni][1])),
                                                                   pk2(sigmoidf_(acc[mi][ni][2]), sigmoidf_(acc[mi][ni][3])));
          }
      }
      zero_acc8(acc);
      {
        ADma aly{YR, 512, mt * 256, 0, ZERO, 0};
        gemm3(acc, aly, WL + W_PR, 512, nt * 128, 512, smem, launder(tid));
      }
      { const int tq_ = launder(tid); const int lane = tq_ & 63, wave = tq_ >> 6; ACC_COORDS
#pragma unroll
        for (int mi = 0; mi < 8; mi++)
#pragma unroll
          for (int ni = 0; ni < 4; ni++) {
            int col = nt * 128 + wc * 64 + ni * 16 + fq * 4;
            int row = mt * 256 + wr * 128 + mi * 16 + fr;
            u16* mp = MIX + (size_t)row * 1024 + col;
            uint2 s = *(const uint2*)mp;
            *(uint2*)mp = make_uint2(pk2(bflo(s.x) * acc[mi][ni][0], bfhi(s.x) * acc[mi][ni][1]), pk2(bflo(s.y) * acc[mi][ni][2], bfhi(s.y) * acc[mi][ni][3]));
          }
      }
      zero_acc8(acc);
      gemm3(acc, alh, WL + W_G, 1024, 1024 + nt * 128, 1024, smem, launder(tid));
      { const int tq_ = launder(tid); const int lane = tq_ & 63, wave = tq_ >> 6; ACC_COORDS
#pragma unroll
        for (int mi = 0; mi < 8; mi++)
#pragma unroll
          for (int ni = 0; ni < 4; ni++) {
            int cl = wc * 64 + ni * 16 + fq * 4, rl = wr * 128 + mi * 16 + fr;
            *(uint2*)(scr + rl * 128 + cl) = make_uint2(pk2(sigmoidf_(acc[mi][ni][0]), sigmoidf_(acc[mi][ni][1])),
                                                        pk2(sigmoidf_(acc[mi][ni][2]), sigmoidf_(acc[mi][ni][3])));
          }
      }
      zero_acc8(acc);
      {
        ADma alm{P + PMLA_, PC_, mt * 256, 0, ZERO, 0};
        gemm3(acc, alm, WL + W_PM, 512, nt * 128, 512, smem, launder(tid));
      }
      { const int tq_ = launder(tid); const int lane = tq_ & 63, wave = tq_ >> 6; ACC_COORDS
#pragma unroll
        for (int mi = 0; mi < 8; mi++)
#pragma unroll
          for (int ni = 0; ni < 4; ni++) {
            int cl = wc * 64 + ni * 16 + fq * 4, rl = wr * 128 + mi * 16 + fr;
            u16* mp = MIX + (size_t)(mt * 256 + rl) * 1024 + nt * 128 + cl;
            uint2 t1 = *(const uint2*)mp;
            uint2 s = *(const uint2*)(scr + rl * 128 + cl);
            float o0 = bflo(t1.x) + bflo(s.x) * acc[mi][ni][0];
            float o1 = bfhi(t1.x) + bfhi(s.x) * acc[mi][ni][1];
            float o2 = bflo(t1.y) + bflo(s.y) * acc[mi][ni][2];
            float o3 = bfhi(t1.y) + bfhi(s.y) * acc[mi][ni][3];
            *(uint2*)mp = make_uint2(pk2(o0, o1), pk2(o2, o3));
          }
      }
    }
    }
    if (blockIdx.x < 16) {
      const int mt = 256, nt = blockIdx.x;
      f32x4 acc[8][2];
      unsigned sg[8][2][2];
      ADma alh = ADma{(mt < 255) ? HB1 : HB2, 1024, (mt < 255) ? mt * 256 : mt * 256 - HB_SPLIT, 0, ZERO, 0};
      zero_acc8(acc);
      const int tid1 = launder(tid);
      gemm3(acc, alh, WL + W_G, 1024, nt * 64, 1024, smem, tid1);
#pragma unroll
      for (int mi = 0; mi < 8; mi++)
#pragma unroll
        for (int ni = 0; ni < 2; ni++) {
          sg[mi][ni][0] = pk2(sigmoidf_(acc[mi][ni][0]), sigmoidf_(acc[mi][ni][1]));
          sg[mi][ni][1] = pk2(sigmoidf_(acc[mi][ni][2]), sigmoidf_(acc[mi][ni][3]));
        }
      zero_acc8(acc);
      {
        ADma aly{YR, 512, mt * 256, 0, ZERO, 0};
        const int tid2 = launder(tid);
      gemm3(acc, aly, WL + W_PR, 512, nt * 64, 512, smem, tid2);
      }
{ const int tidq = launder(tid); const int lane = tidq & 63, wave = tidq >> 6; ACC_COORDS
#pragma unroll
      for (int mi = 0; mi < 8; mi++)
#pragma unroll
        for (int ni = 0; ni < 2; ni++) {
          int col = nt * 64 + wc * 32 + ni * 16 + fq * 4;
          int row = mt * 256 + wr * 128 + mi * 16 + fr;
          *(uint2*)(MIX + (size_t)row * 1024 + col) = make_uint2(pk2(bflo(sg[mi][ni][0]) * acc[mi][ni][0], bfhi(sg[mi][ni][0]) * acc[mi][ni][1]),
                                                                 pk2(bflo(sg[mi][ni][1]) * acc[mi][ni][2], bfhi(sg[mi][ni][1]) * acc[mi][ni][3]));
        }
      }
      zero_acc8(acc);
      const int tid3 = launder(tid);
      gemm3(acc, alh, WL + W_G, 1024, 1024 + nt * 64, 1024, smem, tid3);
#pragma unroll
      for (int mi = 0; mi < 8; mi++)
#pragma unroll
        for (int ni = 0; ni < 2; ni++) {
          sg[mi][ni][0] = pk2(sigmoidf_(acc[mi][ni][0]), sigmoidf_(acc[mi][ni][1]));
          sg[mi][ni][1] = pk2(sigmoidf_(acc[mi][ni][2]), sigmoidf_(acc[mi][ni][3]));
        }
      zero_acc8(acc);
      {
        ADma alm{P + PMLA_, PC_, mt * 256, 0, ZERO, 0};
        const int tid4 = launder(tid);
      gemm3(acc, alm, WL + W_PM, 512, nt * 64, 512, smem, tid4);
      }
{ const int tidq = launder(tid); const int lane = tidq & 63, wave = tidq >> 6; ACC_COORDS
#pragma unroll
      for (int mi = 0; mi < 8; mi++)
#pragma unroll
        for (int ni = 0; ni < 2; ni++) {
          int col = nt * 64 + wc * 32 + ni * 16 + fq * 4;
          int row = mt * 256 + wr * 128 + mi * 16 + fr;
          uint2 pm = *(const uint2*)(MIX + (size_t)row * 1024 + col);
          float o0 = bflo(pm.x) + bflo(sg[mi][ni][0]) * acc[mi][ni][0];
          float o1 = bfhi(pm.x) + bfhi(sg[mi][ni][0]) * acc[mi][ni][1];
          float o2 = bflo(pm.y) + bflo(sg[mi][ni][1]) * acc[mi][ni][2];
          float o3 = bfhi(pm.y) + bfhi(sg[mi][ni][1]) * acc[mi][ni][3];
          *(uint2*)(MIX + (size_t)row * 1024 + col) = make_uint2(pk2(o0, o1), pk2(o2, o3));
        }
      }
    }
    }
    if (kph == 5) {
    PHASE_TID
    for (int prb_ = (PROBE_FI ? 0 : 1); prb_ < 2; prb_++)
    for (int it_ = 0; it_ * nblk < 256 * 8; it_++) {
      int mt, nt;
      if (!map_tile(it_, nblk, 256, 8, mt, nt)) continue;
      f32x4 acc[8][4];
      zero_acc8(acc);
      ACC_COORDS
      ADma al{MIX, 1024, mt * 256, 0, ZERO, 0};
      gemm3(acc, al, WL + W_OUT, 1024, nt * 128, 1024, smem, tid);
#pragma unroll
      for (int mi = 0; mi < 8; mi++)
#pragma unroll
        for (int ni = 0; ni < 4; ni++) {
          int col = nt * 128 + wc * 64 + ni * 16 + fq * 4;
          int row = mt * 256 + wr * 128 + mi * 16 + fr;
          float* hp = H + (size_t)row * 1024 + col;
          float* dp = (prb_ == 0) ? (p.out + (size_t)(row & 65535) * 1024 + col) : hp;
          float4 hv = *(const float4*)hp;
          hv.x = ALPHA_ * hv.x + acc[mi][ni][0];
          hv.y = ALPHA_ * hv.y + acc[mi][ni][1];
          hv.z = ALPHA_ * hv.z + acc[mi][ni][2];
          hv.w = ALPHA_ * hv.w + acc[mi][ni][3];
          *(float4*)dp = hv;
        }
    }
    if (blockIdx.x < 16) {
      const int mt = 256, n0 = blockIdx.x * 64;
      f32x4 acc[8][2];
      zero_acc8(acc);
      ADma al{MIX, 1024, mt * 256, 0, ZERO, 0};
      gemm3(acc, al, WL + W_OUT, 1024, n0, 1024, smem, launder(tid));
      const int tq_ = launder(tid);
      const int lane = tq_ & 63, wave = tq_ >> 6;
      ACC_COORDS
#pragma unroll
      for (int mi = 0; mi < 8; mi++)
#pragma unroll
        for (int ni = 0; ni < 2; ni++) {
          int col = n0 + wc * 32 + ni * 16 + fq * 4;
          int row = mt * 256 + wr * 128 + mi * 16 + fr;
          float* hp = H + (size_t)row * 1024 + col;
          float4 hv = *(const float4*)hp;
          hv.x = ALPHA_ * hv.x + acc[mi][ni][0];
          hv.y = ALPHA_ * hv.y + acc[mi][ni][1];
          hv.z = ALPHA_ * hv.z + acc[mi][ni][2];
          hv.w = ALPHA_ * hv.w + acc[mi][ni][3];
          *(float4*)hp = hv;
        }
    }
    }
    if (kph == 6) {
    PHASE_TID
    for (int row = (blockIdx.x * 4 + wave) * 2; row < M_; row += nblk * 8)
      ln_row2(H + (size_t)row * 1024, H + (size_t)(row + 1) * 1024, p.in[24] + l * 1024, p.in[25] + l * 1024, H + (size_t)row * 1024, H + (size_t)(row + 1) * 1024, lane, HBH + (size_t)row * 1024, HBH + (size_t)(row + 1) * 1024);
    }
    if (kph == 7) {
    PHASE_TID
    {
      const float* cw = p.in[27] + (size_t)l * 3 * 5632;
      const float* cb = p.in[28] + (size_t)l * 5632;
#if PROBE_HOT
      for (int it_ = 0; it_ * nblk < 272 * 44; it_++) {
        int rest, nt;
        if (!map_tile(it_, nblk, 272, 44, rest, nt)) continue;
        f32x4 acc[8][4];
        zero_acc8(acc);
#if PROBE_HOT == 1
        ADma al{HBH, 1024, 0, 0, ZERO, 1, p.ws};
        gemm3(acc, al, WL + W_UP, 1024, 0, 1024, smem, tid);
#else
        int it = rest % 17, b = rest / 17;
        ADma al{HBH, 1024, b * T_, 254 * it - 2, ZERO, 1, p.ws};
        gemm3(acc, al, WL + W_UP, 1024, nt * 128, 1024, smem, tid);
#endif
        float sacc = 0.f;
#pragma unroll
        for (int mi = 0; mi < 8; mi++)
#pragma unroll
          for (int ni = 0; ni < 4; ni++) sacc += acc[mi][ni][0] + acc[mi][ni][1] + acc[mi][ni][2] + acc[mi][ni][3];
        if (sacc == 12345.678f) ACT[tid] = 0;
      }
#endif
      for (int it_ = 0; it_ * nblk < 272 * 44; it_++) {
        int rest, nt;
        if (!map_tile(it_, nblk, 272, 44, rest, nt)) continue;
        int it = rest % 17, b = rest / 17;
        int t0 = 254 * it - 2;
        f32x4 acc[8][4];
        zero_acc8(acc);
        ADma al{HBH, 1024, b * T_, t0, ZERO, 1, p.ws};
        gemm3(acc, al, WL + W_UP, 1024, nt * 128, 1024, smem, launder(tid));
        ACC_COORDS
        float(*ut)[132] = (float(*)[132])smem;
        const int tidh = launder(tid);
        const int c = tidh & 63, rg = tidh >> 6;
        const int gcol = nt * 64 + c, vcol = DFF_ + nt * 64 + c;
        const float g0 = cw[gcol], g1 = cw[5632 + gcol], g2 = cw[2 * 5632 + gcol], gb = cb[gcol];
        const float v0 = cw[vcol], v1 = cw[5632 + vcol], v2 = cw[2 * 5632 + vcol], vb = cb[vcol];
#pragma unroll 1
        for (int half = 0; half < 2; half++) {
          float carry = 0.f;
          if (half == 1) carry = ut[126 + (tid >> 7)][tid & 127];
          __syncthreads();
          if (half == 1) ut[tid >> 7][tid & 127] = carry;
          if (wr == half) {
#pragma unroll
            for (int mi = 0; mi < 8; mi++)
#pragma unroll
              for (int ni = 0; ni < 4; ni++)
                *(float4*)&ut[half * 2 + mi * 16 + fr][wc * 64 + ni * 16 + fq * 4] = make_float4(acc[mi][ni][0], acc[mi][ni][1], acc[mi][ni][2], acc[mi][ni][3]);
          }
          __syncthreads();
          const int nq = half ? 130 : 128;
          int qs = 2 + rg * 32, qe = min(qs + 32, nq);
          float ga = ut[qs - 2][c], gbp = ut[qs - 1][c];
          float va = ut[qs - 2][64 + c], vbp = ut[qs - 1][64 + c];
#pragma unroll 4
          for (int q = qs; q < qe; q++) {
            float gc = ut[q][c], vc = ut[q][64 + c];
            int t = t0 + half * 126 + q;
            if (t < T_) {
              float gate = g0 * ga + g1 * gbp + g2 * gc + gb;
              float val = v0 * va + v1 * vbp + v2 * vc + vb;
              float av = gate * sigmoidf_(gate) * val;
              ACT[(size_t)(b * T_ + t) * DFF_ + gcol] = f2bf(av);
            }
            ga = gbp; gbp = gc; va = vbp; vbp = vc;
          }
        }
        __syncthreads();
      }
    }
    }
    if (kph == 8) {
    PHASE_TID
    for (int prb_ = (PROBE_FI ? 0 : 1); prb_ < 2; prb_++)
    for (int it_ = 0; it_ * nblk < 256 * 8; it_++) {
      int mt, nt;
      if (!map_tile(it_, nblk, 256, 8, mt, nt)) continue;
      f32x4 acc[8][4];
      zero_acc8(acc);
      ACC_COORDS
      ADma al{ACT, DFF_, mt * 256, 0, ZERO, 0};
      gemm3(acc, al, WL + W_DN, DFF_, nt * 128, DFF_, smem, tid);
#pragma unroll
      for (int mi = 0; mi < 8; mi++)
#pragma unroll
        for (int ni = 0; ni < 4; ni++) {
          int col = nt * 128 + wc * 64 + ni * 16 + fq * 4;
          int row = mt * 256 + wr * 128 + mi * 16 + fr;
          float* hp = H + (size_t)row * 1024 + col;
          float* dp = (prb_ == 0) ? (p.out + (size_t)(row & 65535) * 1024 + col) : hp;
          float4 hv = *(const float4*)hp;
          hv.x = ALPHA_ * hv.x + acc[mi][ni][0];
          hv.y = ALPHA_ * hv.y + acc[mi][ni][1];
          hv.z = ALPHA_ * hv.z + acc[mi][ni][2];
          hv.w = ALPHA_ * hv.w + acc[mi][ni][3];
          *(float4*)dp = hv;
        }
    }
    if (blockIdx.x < 16) {
      const int mt = 256, n0 = blockIdx.x * 64;
      f32x4 acc[8][2];
      zero_acc8(acc);
      ADma al{ACT, DFF_, mt * 256, 0, ZERO, 0};
      gemm3(acc, al, WL + W_DN, DFF_, n0, DFF_, smem, launder(tid));
      const int tq_ = launder(tid);
      const int lane = tq_ & 63, wave = tq_ >> 6;
      ACC_COORDS
#pragma unroll
      for (int mi = 0; mi < 8; mi++)
#pragma unroll
        for (int ni = 0; ni < 2; ni++) {
          int col = n0 + wc * 32 + ni * 16 + fq * 4;
          int row = mt * 256 + wr * 128 + mi * 16 + fr;
          float* hp = H + (size_t)row * 1024 + col;
          float4 hv = *(const float4*)hp;
          hv.x = ALPHA_ * hv.x + acc[mi][ni][0];
          hv.y = ALPHA_ * hv.y + acc[mi][ni][1];
          hv.z = ALPHA_ * hv.z + acc[mi][ni][2];
          hv.w = ALPHA_ * hv.w + acc[mi][ni][3];
          *(float4*)hp = hv;
        }
    }
    }
    if (kph == 9) {
    PHASE_TID
    if (l == 0) {
      for (int row = (blockIdx.x * 4 + wave) * 2; row < M_; row += nblk * 8) {
        u16* hb = (row < HB_SPLIT) ? HB1 + (size_t)row * 1024 : HB2 + (size_t)(row - HB_SPLIT) * 1024;
        ln_row2(H + (size_t)row * 1024, H + (size_t)(row + 1) * 1024, p.in[30], p.in[31], H + (size_t)row * 1024, H + (size_t)(row + 1) * 1024, lane, hb, hb + 1024);
      }
    } else {
      for (int row = (blockIdx.x * 4 + wave) * 2; row < M_; row += nblk * 8) {
        int b = row / T_, t = row % T_;
        if (t >= NMETA_) {
          float* o = p.out + ((size_t)b * SEQ_ + (t - NMETA_)) * 1024;
          ln_row2(H + (size_t)row * 1024, H + (size_t)(row + 1) * 1024, p.in[30] + 1024, p.in[31] + 1024, o, o + 1024, lane, nullptr, nullptr);
        }
      }
    }
    }
    if (ph_ != 19) XB_SYNC();
  }
}

#undef H
#undef P
#undef DEC
#undef AA
#undef GG
#undef Q
#undef MIX
#undef HB1
#undef HB2
#undef HBH
#undef ZERO
#undef ACT
#undef ROPE
#undef CTR
#undef KN
#undef VT
#undef YR

extern "C" void kernel_launch(void* const* d_in, const int* in_sizes, int n_in, void* d_out, int out_size, void* d_ws,
                              size_t ws_size, hipStream_t stream) {
  static int grid_blocks = 0;
  if (!grid_blocks) {
    int dev = 0, cus = 0, per_cu = 0;
    hipGetDevice(&dev);
    hipDeviceGetAttribute(&cus, hipDeviceAttributeMultiprocessorCount, dev);
    hipOccupancyMaxActiveBlocksPerMultiprocessor(&per_cu, mega, 256, 0);
    if (per_cu > 2) per_cu = 2;
    grid_blocks = cus * per_cu;
  }
  if (ws_size < WS_TOTAL) fprintf(stderr, "workspace too small: %zu < %zu\n", ws_size, (size_t)WS_TOTAL);
  Params p;
  memset(&p, 0, sizeof(p));
  for (int i = 0; i < 32; i++) p.in[i] = (const float*)d_in[i];
  p.out = (float*)d_out;
  p.ws = (char*)d_ws;
  u16* wb = (u16*)((char*)d_ws + OFF_W);
  int nj = 0, tiles = 0;
  auto add = [&](const float* src, size_t dst_off, int ld, int c0, int K, int Kpad, int Nv, int Np, int mode) {
    Job& j = p.jobs[nj++];
    j.src = src; j.dst = wb + dst_off; j.ld = ld; j.c0 = c0; j.K = K; j.Kpad = Kpad; j.Nv = Nv; j.Np = Np; j.mode = mode;
    j.tile0 = tiles;
    tiles += (Kpad / 64) * (Np / 64);
  };
  for (int l = 0; l < 2; l++) {
    size_t o = (size_t)l * W_LAYER;
    const float* w_in = (const float*)d_in[4] + (size_t)l * 1024 * 4416;
    add(w_in, o + W_IN, 4416, 0, 1024, 1024, 2368, 2432, 0);
    add(w_in, o + W_G, 4416, 2368, 1024, 1024, 2048, 2048, 0);
    add((const float*)d_in[7] + (size_t)l * 64 * 512, o + W_LW, 512, 0, 64, 64, 512, 512, 0);
    add((const float*)d_in[9] + (size_t)l * 64 * 512, o + W_LA, 512, 0, 64, 64, 512, 512, 0);
    add((const float*)d_in[10] + (size_t)l * 160 * 512, o + W_LG, 512, 0, 160, 192, 512, 512, 0);
    add((const float*)d_in[17] + (size_t)l * 256 * 768, o + W_UQ, 768, 0, 256, 256, 768, 768, 0);
    add((const float*)d_in[19] + (size_t)l * 256 * 512, o + W_UK, 512, 0, 256, 256, 512, 512, 0);
    add((const float*)d_in[20] + (size_t)l * 256 * 512, o + W_UV, 512, 0, 256, 256, 512, 512, 0);
    add((const float*)d_in[21] + (size_t)l * 512 * 1024, o + W_PR, 1024, 0, 512, 512, 1024, 1024, 0);
    add((const float*)d_in[22] + (size_t)l * 512 * 1024, o + W_PM, 1024, 0, 512, 512, 1024, 1024, 0);
    add((const float*)d_in[23] + (size_t)l * 1024 * 1024, o + W_OUT, 1024, 0, 1024, 1024, 1024, 1024, 0);
    add((const float*)d_in[26] + (size_t)l * 1024 * 5632, o + W_UP, 5632, 0, 1024, 1024, 5632, 5632, 1);
    add((const float*)d_in[29] + (size_t)l * 2816 * 1024, o + W_DN, 1024, 0, 2816, 2816, 1024, 1024, 0);
  }
  p.nconv = tiles;
  hipMemsetAsync((char*)d_ws + OFF_BAR, 0, 16384, stream);
  void* args[] = {&p};
  hipError_t e = hipLaunchCooperativeKernel((void*)mega, dim3(grid_blocks), dim3(256), args, 0, stream);
  if (e != hipSuccess) fprintf(stderr, "cooperative launch failed: %s (grid %d)\n", hipGetErrorString(e), grid_blocks);
}
```

```cpp
#include <hip/hip_runtime.h>
#include <hip/hip_cooperative_groups.h>
#include <cstdio>
#include <cstring>
namespace cg = cooperative_groups;

#ifndef PHMASK
#define PHMASK 0xFFFF
#endif
#ifndef PROBE_HOT
#define PROBE_HOT 0
#endif
#ifndef PROBE_FI
#define PROBE_FI 0
#endif
#ifndef REPMASK
#define REPMASK 0
#endif
typedef unsigned short u16;
using bf16x8 = __attribute__((ext_vector_type(8))) short;
using f32x4 = __attribute__((ext_vector_type(4))) float;

constexpr int B_ = 16, SEQ_ = 4096, NMETA_ = 16, T_ = 4112, M_ = B_ * T_, D_ = 1024;
constexpr int PC_ = 2368;
constexpr int PMLA_ = 1824, PKV_ = 2080, PKR_ = 2336;
constexpr int DFF_ = 2816;
constexpr float ALPHA_ = 1.4142135623730951f;

constexpr size_t OFF_H = 0;
constexpr size_t OFF_P = OFF_H + (size_t)M_ * 1024 * 4;
constexpr size_t OFF_DEC = OFF_P + (size_t)M_ * PC_ * 2;
constexpr size_t OFF_AA = OFF_DEC + (size_t)M_ * 512 * 4;
constexpr size_t OFF_GG = OFF_AA + (size_t)M_ * 512 * 2;
constexpr size_t OFF_Q = OFF_GG + (size_t)M_ * 512 * 2;
constexpr size_t OFF_W = OFF_Q + (size_t)M_ * 768 * 2;
constexpr size_t W_IN = 0;
constexpr size_t W_G = W_IN + (size_t)2432 * 1024;
constexpr size_t W_LW = W_G + (size_t)2048 * 1024;
constexpr size_t W_LA = W_LW + (size_t)512 * 64;
constexpr size_t W_LG = W_LA + (size_t)512 * 64;
constexpr size_t W_UQ = W_LG + (size_t)512 * 192;
constexpr size_t W_UK = W_UQ + (size_t)768 * 256;
constexpr size_t W_UV = W_UK + (size_t)512 * 256;
constexpr size_t W_PR = W_UV + (size_t)512 * 256;
constexpr size_t W_PM = W_PR + (size_t)1024 * 512;
constexpr size_t W_OUT = W_PM + (size_t)1024 * 512;
constexpr size_t W_UP = W_OUT + (size_t)1024 * 1024;
constexpr size_t W_DN = W_UP + (size_t)5632 * 1024;
constexpr size_t W_LAYER = W_DN + (size_t)1024 * 2816;
constexpr size_t OFF_ROPE = OFF_W + 2 * W_LAYER * 2;
constexpr size_t OFF_CTR = OFF_ROPE + (size_t)T_ * 16 * 8;
constexpr size_t OFF_ZERO = OFF_CTR + 256;
constexpr size_t OFF_BAR = OFF_ZERO + 8192;
constexpr size_t OFF_HB2 = OFF_BAR + 16384;
constexpr size_t OFF_SCR = OFF_HB2 + (size_t)512 * 1024 * 2;
constexpr size_t WS_TOTAL = OFF_SCR + (size_t)1024 * 65536;
constexpr int HB_SPLIT = 65280;

struct Job { const float* src; u16* dst; int ld, c0, K, Kpad, Nv, Np, mode, tile0; };
struct Params {
  const float* in[32];
  float* out;
  char* ws;
  Job jobs[26];
  int nconv;
  int pad0;
};

__constant__ double ROPE_C[16] = {0.15915494309189535, 0.08949940160889101, 0.050329212104487035, 0.0283021958306234,
                                  0.015915494309189534, 0.008949940160889102, 0.005032921210448704, 0.00283021958306234,
                                  0.0015915494309189536, 0.0008949940160889102, 0.0005032921210448703, 0.00028302195830623395,
                                  0.00015915494309189535, 8.949940160889102e-05, 5.0329212104487035e-05, 2.8302195830623396e-05};

__device__ __forceinline__ int launder(int x) { asm volatile("" : "+v"(x)); return x; }
typedef __bf16 bf16x2_t __attribute__((ext_vector_type(2)));
typedef float f32x2_t __attribute__((ext_vector_type(2)));
__device__ __forceinline__ unsigned pk2(float a, float b) {
  f32x2_t v = {a, b};
  bf16x2_t r = __builtin_convertvector(v, bf16x2_t);
  return *(unsigned*)&r;
}
__device__ __forceinline__ u16 f2bf(float f) { return (u16)(pk2(f, 0.f) & 0xffffu); }
__device__ __forceinline__ float bf2f(unsigned h) { return __uint_as_float(h << 16); }
__device__ __forceinline__ float bflo(unsigned w) { return __uint_as_float(w << 16); }
__device__ __forceinline__ float bfhi(unsigned w) { return __uint_as_float(w & 0xffff0000u); }
__device__ __forceinline__ float sigmoidf_(float x) { return __builtin_amdgcn_rcpf(1.0f + __expf(-x)); }

__device__ __forceinline__ int fresh_lane() { int x; asm volatile("v_mbcnt_lo_u32_b32 %0, -1, 0\n\tv_mbcnt_hi_u32_b32 %0, -1, %0" : "=v"(x)); return x; }
#define PHASE_TID const int tid = wave0 * 64 + fresh_lane(); const int lane = tid & 63, wave = tid >> 6; (void)lane; (void)wave;
template <int CTRL>
__device__ __forceinline__ float dppf(float x) {
  return __int_as_float(__builtin_amdgcn_update_dpp(0, __float_as_int(x), CTRL, 0xF, 0xF, true));
}
__device__ __forceinline__ float sum8(float x) {
  x += dppf<0xB1>(x);
  x += dppf<0x4E>(x);
  x += dppf<0x141>(x);
  return x;
}
__device__ __forceinline__ float sum16(float x) {
  x = sum8(x);
  x += dppf<0x140>(x);
  return x;
}
__device__ __forceinline__ float shx(float x, int lane, int o) {
  return __int_as_float(__builtin_amdgcn_ds_bpermute((lane ^ o) << 2, __float_as_int(x)));
}
__device__ __forceinline__ float wave_sum(float x, int lane) {
  x = sum16(x);
  x += shx(x, lane, 16);
  x += shx(x, lane, 32);
  return x;
}

constexpr int BM = 128, BN = 128, BK = 64, LDT = 64;
constexpr int SMEM_BYTES = 73728;

template <int MODE>
struct AL {
  const void* base;
  int ld;
  int row0;
  int t0;
  int kvalid;
  const float* mu;
  int fn;
  struct Raw { uint4 x, y; };
  __device__ __forceinline__ Raw fetch(int r, int k) const {
    Raw w;
    { unsigned z = (MODE == 3) ? (unsigned)launder(0) : 0u; w.x = make_uint4(z, z, z, z); w.y = w.x; }
    if (MODE == 0) {
      const float* p = (const float*)base + (size_t)(row0 + r) * ld + k;
      w.x = *(const uint4*)p;
      w.y = *(const uint4*)(p + 4);
    } else if (MODE == 1) {
      const u16* p = (const u16*)base + (size_t)(row0 + r) * ld + k;
      w.x = *(const uint4*)p;
    } else if (MODE == 4) {
      const float* p = (const float*)base + (size_t)(row0 + r) * ld + k;
      float4 a = *(const float4*)p, b = *(const float4*)(p + 4);
      w.x = make_uint4(pk2(a.x, a.y), pk2(a.z, a.w), pk2(b.x, b.y), pk2(b.z, b.w));
    } else if (MODE == 2) {
      int t = t0 + r;
      if (t >= 0 && t < T_) {
        const float* p = (const float*)base + (size_t)(row0 + t) * ld + k;
        w.x = *(const uint4*)p;
        w.y = *(const uint4*)(p + 4);
      }
    } else {
      int row = row0 + r;
      int t = row % T_;
      if (k < kvalid) {
        const u16* p = (const u16*)base + (size_t)row * ld + k;
        w.x = *(const uint4*)p;
        if (t > 0) w.y = *(const uint4*)(p - ld);
      }
    }
    return w;
  }
  __device__ __forceinline__ uint4 cvt(const Raw& w, int k) const {
    if (MODE == 0 || MODE == 2) {
      uint4 o;
      o.x = pk2(__uint_as_float(w.x.x), __uint_as_float(w.x.y));
      o.y = pk2(__uint_as_float(w.x.z), __uint_as_float(w.x.w));
      o.z = pk2(__uint_as_float(w.y.x), __uint_as_float(w.y.y));
      o.w = pk2(__uint_as_float(w.y.z), __uint_as_float(w.y.w));
      return o;
    } else if (MODE == 1 || MODE == 4) {
      return w.x;
    } else {
      if (k >= kvalid) { unsigned z = (unsigned)launder(0); return make_uint4(z, z, z, z); }
      unsigned cw[4] = {w.x.x, w.x.y, w.x.z, w.x.w};
      unsigned pw[4] = {w.y.x, w.y.y, w.y.z, w.y.w};
      unsigned ow[4];
#pragma unroll
      for (int e = 0; e < 4; e++) {
        float x0 = bflo(cw[e]), x1 = bfhi(cw[e]);
        float p0 = bflo(pw[e]), p1 = bfhi(pw[e]);
        float v0 = x0 + (p0 - x0) * mu[k + 2 * e];
        float v1 = x1 + (p1 - x1) * mu[k + 2 * e + 1];
        if (fn == 0) {
          v0 = 1.0f - 2.0f * __builtin_amdgcn_rcpf(__expf(2.0f * v0) + 1.0f);
          v1 = 1.0f - 2.0f * __builtin_amdgcn_rcpf(__expf(2.0f * v1) + 1.0f);
        } else if (fn == 2) {
          v0 = sigmoidf_(v0);
          v1 = sigmoidf_(v1);
        }
        ow[e] = pk2(v0, v1);
      }
      return make_uint4(ow[0], ow[1], ow[2], ow[3]);
    }
  }
};

template <int NI>
__device__ __forceinline__ void zero_acc(f32x4 (&acc)[4][NI]) {
#pragma unroll
  for (int i = 0; i < 4; i++)
#pragma unroll
    for (int j = 0; j < NI; j++) acc[i][j] = f32x4{0.f, 0.f, 0.f, 0.f};
}

#define REP4(X) X(0) X(1) X(2) X(3)
template <class ALT, int NI>
__device__ __forceinline__ void gemm_loop(f32x4 (&acc)[4][NI], const ALT& al, const u16* __restrict__ Bt, int ldb, int n0,
                                          int K, char* smem, const int tid) {
  const int lane = tid & 63, wave = tid >> 6;
  const int wr = wave >> 1, wc = wave & 1, fr = lane & 15, fq = lane >> 4;
  const int lr = tid >> 3, lk = (tid & 7) * 8, lsw = ((tid & 7) ^ (lr & 7)) * 8;
  u16* sa = (u16*)smem;
  u16* sb = sa + 2 * BM * LDT;
  typename ALT::Raw ra0, ra1, ra2, ra3;
  uint4 rb0 = make_uint4(0,0,0,0), rb1 = rb0, rb2 = rb0, rb3 = rb0;
  const u16* bp = Bt + (size_t)(n0 + lr) * ldb + lk;
#define GL_FETCH(i) ra##i = al.fetch(lr + 32 * i, kf); if (i < NI) rb##i = *(const uint4*)(bp + (size_t)(32 * i) * ldb + kb);
#define GL_STORE(i) *(uint4*)(a_ + (lr + 32 * i) * LDT + lsw) = al.cvt(ra##i, kt * BK + lk); if (i < NI) *(uint4*)(b_ + (lr + 32 * i) * LDT + lsw) = rb##i;
  {
    const int kf = lk, kb = 0;
    REP4(GL_FETCH)
  }
  const int nk = K / BK;
  for (int kt = 0; kt < nk; kt++) {
    u16* a_ = sa + (kt & 1) * BM * LDT;
    u16* b_ = sb + (kt & 1) * BN * LDT;
    REP4(GL_STORE)
    __syncthreads();
    if (kt + 1 < nk) {
      const int kf = (kt + 1) * BK + lk, kb = (kt + 1) * BK;
      REP4(GL_FETCH)
    }
#pragma unroll
    for (int ks = 0; ks < 2; ks++) {
      bf16x8 af[4], bf[NI];
#pragma unroll
      for (int i = 0; i < 4; i++) af[i] = *(const bf16x8*)(a_ + (wr * 64 + i * 16 + fr) * LDT + (((ks * 4 + fq) ^ (fr & 7)) * 8));
#pragma unroll
      for (int i = 0; i < NI; i++) bf[i] = *(const bf16x8*)(b_ + (wc * (NI * 16) + i * 16 + fr) * LDT + (((ks * 4 + fq) ^ (fr & 7)) * 8));
#pragma unroll
      for (int mi = 0; mi < 4; mi++)
#pragma unroll
        for (int ni = 0; ni < NI; ni++)
          acc[mi][ni] = __builtin_amdgcn_mfma_f32_16x16x32_bf16(af[mi], bf[ni], acc[mi][ni], 0, 0, 0);
    }
  }
  __syncthreads();
#undef GL_FETCH
#undef GL_STORE
}


struct ADma { const u16* base; int ld; int row0; int t0; const u16* zero; int mode; const char* wsb; };
constexpr int G3_STAGE = 12288;

template <int NI, bool SWAP = true>
__device__ __forceinline__ void gemm3(f32x4 (&acc)[8][NI], const ADma& a, const u16* __restrict__ Bt, int ldb, int n0, int K,
                                      char* smem, const int tid) {
  const int lane = tid & 63, wave = tid >> 6;
  const int wr = wave >> 1, wc = wave & 1, fr = lane & 15, fq = lane >> 4;
  const int kc8 = ((lane & 3) ^ ((4 - (lane >> 4)) & 3)) * 8;
  const int psw = (fq ^ ((4 - (fr >> 2)) & 3)) * 8;
  u16* sm = (u16*)smem;
  const u16* ap0 = nullptr;
  unsigned ao0 = 0, ao1 = 0, ao2 = 0, ao3 = 0;
  if (a.mode == 0) {
    ap0 = a.base + (size_t)(a.row0 + wave * 64 + (lane >> 2)) * a.ld + kc8;
  } else {
    const unsigned bo = (unsigned)((const char*)a.base - a.wsb), zo = (unsigned)((const char*)a.zero - a.wsb) + kc8 * 2;
#define G3_AP(j)                                                                          \
    {                                                                                     \
      int t = a.t0 + wave * 64 + j * 16 + (lane >> 2);                                    \
      ao##j = (t >= 0 && t < T_) ? bo + (unsigned)(((a.row0 + t) * a.ld + kc8) * 2) : zo; \
    }
    REP4(G3_AP)
#undef G3_AP
  }
  const u16* bp0 = Bt + (size_t)(n0 + wave * (8 * NI) + (lane >> 2)) * ldb + kc8;
  const size_t astep = (size_t)16 * a.ld;
  const size_t bstep = (size_t)16 * ldb;
#define G3_ISSUE(j)                                                                                                              \
  __builtin_amdgcn_global_load_lds((a.mode == 0) ? (const unsigned*)(ap0 + j * astep + kof) : (const unsigned*)(a.wsb + ao##j + kof * 2), (unsigned*)(st_ + (wave * 64 + j * 16) * 32 + lane * 8), 16, 0, 0); \
  if (2 * j < NI) __builtin_amdgcn_global_load_lds((const unsigned*)(bp0 + j * bstep + kof), (unsigned*)(st_ + 8192 + (wave * (8 * NI) + j * 16) * 32 + lane * 8), 16, 0, 0);
  const int nk = K / 32;
  {
    const int kof = 0;
    u16* st_ = sm;
    REP4(G3_ISSUE)
  }
  if (nk > 1) {
    const int kof = 32;
    u16* st_ = sm + G3_STAGE;
    REP4(G3_ISSUE)
  }
  int cur = 0, nxt = 2;
  const unsigned lds0 = (unsigned)(size_t)(__attribute__((address_space(3))) char*)smem;
  const unsigned aoff = lds0 + (unsigned)(((wr * 128 + fr) * 32 + psw) * 2);
  const unsigned boff = lds0 + 16384u + (unsigned)(((wc * (NI * 16) + fr) * 32 + psw) * 2);
#define G3_DSR(dst, addr, off) asm volatile("ds_read_b128 %0, %1 offset:" #off : "=v"(dst) : "v"(addr))
  for (int kt = 0; kt < nk; kt++) {
    if (kt + 1 < nk) {
      if (NI == 4) asm volatile("s_waitcnt vmcnt(6)" ::: "memory");
      else asm volatile("s_waitcnt vmcnt(5)" ::: "memory");
    } else {
      asm volatile("s_waitcnt vmcnt(0)" ::: "memory");
    }
    __builtin_amdgcn_s_barrier();
    if (kt + 2 < nk) {
      const int kof = (kt + 2) * 32;
      u16* st_ = sm + nxt * G3_STAGE;
      REP4(G3_ISSUE)
    }
    const unsigned aaddr = aoff + (unsigned)cur * (G3_STAGE * 2);
    const unsigned baddr = boff + (unsigned)cur * (G3_STAGE * 2);
    bf16x8 af[8], bf[NI];
    G3_DSR(af[0], aaddr, 0); G3_DSR(af[1], aaddr, 1024); G3_DSR(af[2], aaddr, 2048); G3_DSR(af[3], aaddr, 3072);
    G3_DSR(bf[0], baddr, 0); G3_DSR(bf[1], baddr, 1024);
    if (NI == 4) { G3_DSR(bf[NI - 2], baddr, 2048); G3_DSR(bf[NI - 1], baddr, 3072); }
    G3_DSR(af[4], aaddr, 4096); G3_DSR(af[5], aaddr, 5120); G3_DSR(af[6], aaddr, 6144); G3_DSR(af[7], aaddr, 7168);
    if (NI == 4) {
      asm volatile("s_waitcnt lgkmcnt(4)"
                   : "+v"(af[0]), "+v"(af[1]), "+v"(af[2]), "+v"(af[3]), "+v"(bf[0]), "+v"(bf[1]), "+v"(bf[NI - 2]), "+v"(bf[NI - 1]));
    } else {
      asm volatile("s_waitcnt lgkmcnt(4)" : "+v"(af[0]), "+v"(af[1]), "+v"(af[2]), "+v"(af[3]), "+v"(bf[0]), "+v"(bf[1]));
    }
#pragma unroll
    for (int mi = 0; mi < 4; mi++)
#pragma unroll
      for (int ni = 0; ni < NI; ni++)
        acc[mi][ni] = SWAP ? __builtin_amdgcn_mfma_f32_16x16x32_bf16(bf[ni], af[mi], acc[mi][ni], 0, 0, 0)
                           : __builtin_amdgcn_mfma_f32_16x16x32_bf16(af[mi], bf[ni], acc[mi][ni], 0, 0, 0);
    asm volatile("s_waitcnt lgkmcnt(0)" : "+v"(af[4]), "+v"(af[5]), "+v"(af[6]), "+v"(af[7]));
#pragma unroll
    for (int mi = 4; mi < 8; mi++)
#pragma unroll
      for (int ni = 0; ni < NI; ni++)
        acc[mi][ni] = SWAP ? __builtin_amdgcn_mfma_f32_16x16x32_bf16(bf[ni], af[mi], acc[mi][ni], 0, 0, 0)
                           : __builtin_amdgcn_mfma_f32_16x16x32_bf16(af[mi], bf[ni], acc[mi][ni], 0, 0, 0);
    cur = (cur == 2) ? 0 : cur + 1;
    nxt = (nxt == 2) ? 0 : nxt + 1;
  }
  asm volatile("s_waitcnt lgkmcnt(0)" ::: "memory");
  __syncthreads();
#undef G3_DSR
#undef G3_ISSUE
}

template <int NI>
__device__ __forceinline__ void zero_acc8(f32x4 (&acc)[8][NI]) {
#pragma unroll
  for (int i = 0; i < 8; i++)
#pragma unroll
    for (int j = 0; j < NI; j++) acc[i][j] = f32x4{0.f, 0.f, 0.f, 0.f};
}


__device__ __forceinline__ bool map_tile(int i, int nblk, int MT, int NT, int& mt, int& nt) {
  const int locs = nblk >> 3;
  const int xcd = blockIdx.x & 7, loc = blockIdx.x >> 3;
  const int q = (i * 8 + xcd) * locs + loc;
  if (q >= MT * NT) return false;
  const int nfull = NT >> 3, per = MT * 8;
  if (q < nfull * per) {
    int pp = q / per, r = q - pp * per;
    mt = r >> 3;
    nt = pp * 8 + (r & 7);
  } else {
    int r = q - nfull * per;
    int w = NT - nfull * 8;
    mt = r / w;
    nt = nfull * 8 + (r - mt * w);
  }
  return true;
}

#define ACC_COORDS const int wr = wave >> 1, wc = wave & 1, fr = lane & 15, fq = lane >> 4;

__device__ __forceinline__ void conv_tile(const Params& p, int t, char* smem, const int tid) {
  int j = 0;
#pragma unroll 1
  for (int i = 1; i < 26; i++)
    if (t >= p.jobs[i].tile0) j = i;
  const Job& jb = p.jobs[j];
  float(*tile)[65] = (float(*)[65])smem;
  int local = t - jb.tile0;
  int nkt = jb.Kpad >> 6;
  int kt = local % nkt, nt = local / nkt;
  int tx = tid & 63, ty = tid >> 6;
  int n = nt * 64 + tx;
  int col;
  if (jb.mode == 0) col = jb.c0 + n;
  else { int jn = n >> 7, i = n & 127; col = (i < 64) ? (64 * jn + i) : (DFF_ + 64 * jn + (i - 64)); }
  const float* sp = jb.src + col;
  const int K = jb.K, ld = jb.ld;
  const bool nok = n < jb.Nv;
#pragma unroll
  for (int i = 0; i < 16; i++) {
    int k = kt * 64 + ty + 4 * i;
    tile[ty + 4 * i][tx] = (nok && k < K) ? sp[(size_t)k * ld] : 0.f;
  }
  __syncthreads();
#pragma unroll
  for (int i = 0; i < 16; i++) {
    int nn = nt * 64 + ty + 4 * i;
    int k = kt * 64 + tx;
    jb.dst[(size_t)nn * jb.Kpad + k] = f2bf(tile[tx][ty + 4 * i]);
  }
  __syncthreads();
}

__device__ __forceinline__ void ln_row(const float* __restrict__ src, const float* __restrict__ g,
                                       const float* __restrict__ b, float* __restrict__ dst, int lane, u16* __restrict__ dstb = nullptr) {
  float4 v[4];
  float s = 0.f;
#pragma unroll
  for (int i = 0; i < 4; i++) {
    v[i] = *(const float4*)(src + i * 256 + lane * 4);
    s += v[i].x + v[i].y + v[i].z + v[i].w;
  }
  float mean = wave_sum(s, lane) * (1.0f / 1024.0f);
  float q = 0.f;
#pragma unroll
  for (int i = 0; i < 4; i++) {
    float a = v[i].x - mean, b2 = v[i].y - mean, c = v[i].z - mean, d = v[i].w - mean;
    q += a * a + b2 * b2 + c * c + d * d;
  }
  float rstd = rsqrtf(wave_sum(q, lane) * (1.0f / 1024.0f) + 1e-5f);
#pragma unroll
  for (int i = 0; i < 4; i++) {
    float4 gg = *(const float4*)(g + i * 256 + lane * 4);
    float4 bb = *(const float4*)(b + i * 256 + lane * 4);
    float4 o;
    o.x = (v[i].x - mean) * rstd * gg.x + bb.x;
    o.y = (v[i].y - mean) * rstd * gg.y + bb.y;
    o.z = (v[i].z - mean) * rstd * gg.z + bb.z;
    o.w = (v[i].w - mean) * rstd * gg.w + bb.w;
    *(float4*)(dst + i * 256 + lane * 4) = o;
    if (dstb) *(uint2*)(dstb + i * 256 + lane * 4) = make_uint2(pk2(o.x, o.y), pk2(o.z, o.w));
  }
}

__device__ __forceinline__ void ln_row2(const float* __restrict__ srcA, const float* __restrict__ srcB, const float* __restrict__ g,
                                        const float* __restrict__ b, float* dstA, float* dstB, int lane, u16* dbA, u16* dbB) {
  float4 va[4], vb[4];
  float sa = 0.f, sb = 0.f;
#pragma unroll
  for (int i = 0; i < 4; i++) {
    va[i] = *(const float4*)(srcA + i * 256 + lane * 4);
    vb[i] = *(const float4*)(srcB + i * 256 + lane * 4);
  }
#pragma unroll
  for (int i = 0; i < 4; i++) {
    sa += va[i].x + va[i].y + va[i].z + va[i].w;
    sb += vb[i].x + vb[i].y + vb[i].z + vb[i].w;
  }
  const float ma = wave_sum(sa, lane) * (1.0f / 1024.0f), mb = wave_sum(sb, lane) * (1.0f / 1024.0f);
  float qa = 0.f, qb = 0.f;
#pragma unroll
  for (int i = 0; i < 4; i++) {
    va[i].x -= ma; va[i].y -= ma; va[i].z -= ma; va[i].w -= ma;
    vb[i].x -= mb; vb[i].y -= mb; vb[i].z -= mb; vb[i].w -= mb;
    qa += va[i].x * va[i].x + va[i].y * va[i].y + va[i].z * va[i].z + va[i].w * va[i].w;
    qb += vb[i].x * vb[i].x + vb[i].y * vb[i].y + vb[i].z * vb[i].z + vb[i].w * vb[i].w;
  }
  const float ra = rsqrtf(wave_sum(qa, lane) * (1.0f / 1024.0f) + 1e-5f), rb = rsqrtf(wave_sum(qb, lane) * (1.0f / 1024.0f) + 1e-5f);
#pragma unroll
  for (int i = 0; i < 4; i++) {
    float4 gg = *(const float4*)(g + i * 256 + lane * 4);
    float4 bb = *(const float4*)(b + i * 256 + lane * 4);
    float4 oa, ob;
    oa.x = va[i].x * ra * gg.x + bb.x; oa.y = va[i].y * ra * gg.y + bb.y; oa.z = va[i].z * ra * gg.z + bb.z; oa.w = va[i].w * ra * gg.w + bb.w;
    ob.x = vb[i].x * rb * gg.x + bb.x; ob.y = vb[i].y * rb * gg.y + bb.y; ob.z = vb[i].z * rb * gg.z + bb.z; ob.w = vb[i].w * rb * gg.w + bb.w;
    *(float4*)(dstA + i * 256 + lane * 4) = oa;
    *(float4*)(dstB + i * 256 + lane * 4) = ob;
    if (dbA) {
      *(uint2*)(dbA + i * 256 + lane * 4) = make_uint2(pk2(oa.x, oa.y), pk2(oa.z, oa.w));
      *(uint2*)(dbB + i * 256 + lane * 4) = make_uint2(pk2(ob.x, ob.y), pk2(ob.z, ob.w));
    }
  }
}

struct ScanIn {
  float kk[16][64], wr[16][64], w[16][64], kt[16][64], kka[16][64], v[16][64], g[16][64];
  float c[16][4];
};
struct ScanRaw { uint2 r, k, v, rp, kp, vp, a, g; float4 dec; };

__device__ __forceinline__ ScanRaw scan_fetch(const u16* __restrict__ P, const float* __restrict__ DEC,
                                              const u16* __restrict__ AA, const u16* __restrict__ GG, int rowbase, int t,
                                              int hc) {
  ScanRaw w;
  size_t row = (size_t)(rowbase + t);
  const u16* pp = P + row * PC_ + hc;
  w.r = *(const uint2*)(pp);
  w.k = *(const uint2*)(pp + 512);
  w.v = *(const uint2*)(pp + 1024);
  if (t > 0) {
    w.rp = *(const uint2*)(pp - PC_);
    w.kp = *(const uint2*)(pp - PC_ + 512);
    w.vp = *(const uint2*)(pp - PC_ + 1024);
  } else {
    w.rp = make_uint2(0, 0); w.kp = make_uint2(0, 0); w.vp = make_uint2(0, 0);
  }
  w.dec = *(const float4*)(DEC + row * 512 + hc);
  w.a = *(const uint2*)(AA + row * 512 + hc);
  w.g = *(const uint2*)(GG + row * 512 + hc);
  return w;
}

__device__ __forceinline__ void unpack4(uint2 u, float (&o)[4]) {
  o[0] = bflo(u.x); o[1] = bfhi(u.x); o[2] = bflo(u.y); o[3] = bfhi(u.y);
}

__device__ __forceinline__ void scan_unit(const Params& p, int l, int bh, char* smem, const int tid) {
  const int lane = tid & 63, wave = tid >> 6;
  const int b = bh >> 3, h = bh & 7;
  const int rowbase = b * T_;
  const u16* P = (const u16*)(p.ws + OFF_P);
  const float* DEC = (const float*)(p.ws + OFF_DEC);
  const u16* AA = (const u16*)(p.ws + OFF_AA);
  const u16* GG = (const u16*)(p.ws + OFF_GG);
  u16* YR = (u16*)(p.ws + OFF_AA);
  ScanIn* in = (ScanIn*)smem;
  float(*ybuf)[64] = (float(*)[64])(smem + 2 * sizeof(ScanIn));
  const int tl = tid >> 4, kq = tid & 15, hc = h * 64 + kq * 4;
  float(*cst)[64] = (float(*)[64])(smem + 2 * sizeof(ScanIn) + 16 * 64 * 4);
  if (tid < 64) {
    const float* mu = p.in[5] + (size_t)l * 1824;
    const int ch = h * 64 + tid;
    cst[0][tid] = mu[ch];
    cst[1][tid] = mu[512 + ch];
    cst[2][tid] = mu[1024 + ch];
    cst[3][tid] = p.in[11][l * 512 + ch];
    float ka_ = p.in[12][l * 512 + ch];
    cst[4][tid] = ka_;
    cst[5][tid] = 1.0f - ka_;
    cst[6][tid] = p.in[13][l * 512 + ch];
    cst[7][tid] = p.in[14][l * 512 + ch];
    cst[8][tid] = p.in[15][l * 512 + ch];
  }
  __syncthreads();
  const int rp = lane >> 3, ks = lane & 7, row0 = wave * 16 + rp * 2;
  typedef float f2s __attribute__((ext_vector_type(2)));
  f2s S2[2][4];
#pragma unroll
  for (int i = 0; i < 2; i++)
#pragma unroll
    for (int e = 0; e < 4; e++) S2[i][e] = f2s{0.f, 0.f};

  auto stage = [&](const ScanRaw& w, ScanIn& dst) {
    float r[4], k[4], v[4], rq[4], kp[4], vp[4], a[4], g[4];
    unpack4(w.r, r); unpack4(w.k, k); unpack4(w.v, v);
    unpack4(w.rp, rq); unpack4(w.kp, kp); unpack4(w.vp, vp);
    unpack4(w.a, a); unpack4(w.g, g);
    float dec[4] = {w.dec.x, w.dec.y, w.dec.z, w.dec.w};
    float mu_r[4], mu_k[4], mu_v[4], kkw[4], kaw[4], omk[4], rkw[4];
    *(float4*)mu_r = *(const float4*)&cst[0][kq * 4]; *(float4*)mu_k = *(const float4*)&cst[1][kq * 4];
    *(float4*)mu_v = *(const float4*)&cst[2][kq * 4]; *(float4*)kkw = *(const float4*)&cst[3][kq * 4];
    *(float4*)kaw = *(const float4*)&cst[4][kq * 4]; *(float4*)omk = *(const float4*)&cst[5][kq * 4];
    *(float4*)rkw = *(const float4*)&cst[6][kq * 4];
    float kkr[4], ss = 0.f;
#pragma unroll
    for (int e = 0; e < 4; e++) {
      r[e] = r[e] + (rq[e] - r[e]) * mu_r[e];
      k[e] = k[e] + (kp[e] - k[e]) * mu_k[e];
      v[e] = v[e] + (vp[e] - v[e]) * mu_v[e];
      kkr[e] = k[e] * kkw[e];
      ss += kkr[e] * kkr[e];
    }
    ss = sum16(ss);
    float inv = rsqrtf(fmaxf(ss, 1e-24f));
    float c1 = 0.f, c2 = 0.f, c3 = 0.f;
    float kk[4], ktl[4], kka[4], wr[4];
#pragma unroll
    for (int e = 0; e < 4; e++) {
      kk[e] = kkr[e] * inv;
      ktl[e] = k[e] * fmaf(a[e], kaw[e], omk[e]);
      kka[e] = kk[e] * a[e];
      wr[e] = dec[e] * r[e];
      c1 += kka[e] * r[e];
      c2 += ktl[e] * r[e];
      c3 += r[e] * ktl[e] * rkw[e];
    }
    c1 = sum16(c1); c2 = sum16(c2); c3 = sum16(c3);
    *(float4*)&dst.kk[tl][kq * 4] = make_float4(kk[0], kk[1], kk[2], kk[3]);
    *(float4*)&dst.wr[tl][kq * 4] = make_float4(wr[0], wr[1], wr[2], wr[3]);
    *(float4*)&dst.w[tl][kq * 4] = make_float4(dec[0], dec[1], dec[2], dec[3]);
    *(float4*)&dst.kt[tl][kq * 4] = make_float4(ktl[0], ktl[1], ktl[2], ktl[3]);
    *(float4*)&dst.kka[tl][kq * 4] = make_float4(kka[0], kka[1], kka[2], kka[3]);
    *(float4*)&dst.v[tl][kq * 4] = make_float4(v[0], v[1], v[2], v[3]);
    *(float4*)&dst.g[tl][kq * 4] = make_float4(g[0], g[1], g[2], g[3]);
    if (kq == 0) *(float4*)&dst.c[tl][0] = make_float4(c1, c2, c3, 0.f);
  };

  {
    ScanRaw w0 = scan_fetch(P, DEC, AA, GG, rowbase, tl, hc);
    stage(w0, in[0]);
  }
  __syncthreads();
  constexpr int NCH = T_ / 16;
  for (int c = 0; c < NCH; c++) {
    ScanIn& cur = in[c & 1];
    ScanRaw nx;
    const bool have_next = (c + 1 < NCH);
    if (have_next) nx = scan_fetch(P, DEC, AA, GG, rowbase, (c + 1) * 16 + tl, hc);
    {
      typedef float f2 __attribute__((ext_vector_type(2)));
      struct StepA { float4 kk0, kk1, wr0, wr1; };
      struct StepIn { float4 kk0, kk1, wr0, wr1, w0, w1, kt0, kt1, ka0, ka1; float2 vv, cc; };
      auto ldA = [&](int s) {
        StepA r;
        r.kk0 = *(const float4*)&cur.kk[s][ks * 8]; r.kk1 = *(const float4*)&cur.kk[s][ks * 8 + 4];
        r.wr0 = *(const float4*)&cur.wr[s][ks * 8]; r.wr1 = *(const float4*)&cur.wr[s][ks * 8 + 4];
        return r;
      };
      StepA nxa = ldA(0);
#pragma unroll 1
      for (int s4 = 0; s4 < 16; s4 += 4) {
      float yv[4][2];
#pragma unroll
      for (int u = 0; u < 4; u++) {
        const int s = s4 + u;
        StepIn in_;
        in_.kk0 = nxa.kk0; in_.kk1 = nxa.kk1; in_.wr0 = nxa.wr0; in_.wr1 = nxa.wr1;
        in_.vv = *(const float2*)&cur.v[s][row0];
        in_.cc = *(const float2*)&cur.c[s][0];
        in_.w0 = *(const float4*)&cur.w[s][ks * 8];   in_.w1 = *(const float4*)&cur.w[s][ks * 8 + 4];
        in_.kt0 = *(const float4*)&cur.kt[s][ks * 8]; in_.kt1 = *(const float4*)&cur.kt[s][ks * 8 + 4];
        in_.ka0 = *(const float4*)&cur.kka[s][ks * 8]; in_.ka1 = *(const float4*)&cur.kka[s][ks * 8 + 4];
        nxa = ldA((s + 1) & 15);
        const f2 kk[4] = {{in_.kk0.x, in_.kk0.y}, {in_.kk0.z, in_.kk0.w}, {in_.kk1.x, in_.kk1.y}, {in_.kk1.z, in_.kk1.w}};
        const f2 wr[4] = {{in_.wr0.x, in_.wr0.y}, {in_.wr0.z, in_.wr0.w}, {in_.wr1.x, in_.wr1.y}, {in_.wr1.z, in_.wr1.w}};
        const f2 w[4] = {{in_.w0.x, in_.w0.y}, {in_.w0.z, in_.w0.w}, {in_.w1.x, in_.w1.y}, {in_.w1.z, in_.w1.w}};
        const f2 kt[4] = {{in_.kt0.x, in_.kt0.y}, {in_.kt0.z, in_.kt0.w}, {in_.kt1.x, in_.kt1.y}, {in_.kt1.z, in_.kt1.w}};
        const f2 ka[4] = {{in_.ka0.x, in_.ka0.y}, {in_.ka0.z, in_.ka0.w}, {in_.ka1.x, in_.ka1.y}, {in_.ka1.z, in_.ka1.w}};
        const float vr[2] = {in_.vv.x, in_.vv.y};
        float d1[2], d2[2];
#pragma unroll
        for (int i = 0; i < 2; i++) {
          f2 a = S2[i][0] * kk[0] + S2[i][1] * kk[1];
          f2 a2 = S2[i][2] * kk[2] + S2[i][3] * kk[3];
          f2 bq = S2[i][0] * wr[0] + S2[i][1] * wr[1];
          f2 b2 = S2[i][2] * wr[2] + S2[i][3] * wr[3];
          a += a2; bq += b2;
          d1[i] = a.x + a.y;
          d2[i] = bq.x + bq.y;
        }
        d1[0] = sum8(d1[0]); d1[1] = sum8(d1[1]); d2[0] = sum8(d2[0]); d2[1] = sum8(d2[1]);
#pragma unroll
        for (int i = 0; i < 2; i++) {
          const float skk = d1[i];
          yv[u][i] = d2[i] - skk * in_.cc.x + vr[i] * in_.cc.y;
          const f2 nsk = {-skk, -skk}, vv2 = {vr[i], vr[i]};
#pragma unroll
          for (int e = 0; e < 4; e++) S2[i][e] = S2[i][e] * w[e] + (nsk * ka[e] + vv2 * kt[e]);
        }
      }
      if (ks == 0) {
#pragma unroll
        for (int u = 0; u < 4; u++) *(float2*)&ybuf[s4 + u][row0] = make_float2(yv[u][0], yv[u][1]);
      }
      }
    }
    __syncthreads();
    {
      float4 y4 = *(const float4*)&ybuf[tl][kq * 4];
      float y[4] = {y4.x, y4.y, y4.z, y4.w};
      float mean = sum16(y[0] + y[1] + y[2] + y[3]) * (1.0f / 64.0f);
      float q = 0.f;
#pragma unroll
      for (int e = 0; e < 4; e++) { y[e] -= mean; q += y[e] * y[e]; }
      float rstd = rsqrtf(sum16(q) * (1.0f / 64.0f) + 64e-5f);
      float c3 = cur.c[tl][2];
      float4 v4 = *(const float4*)&cur.v[tl][kq * 4];
      float4 g4 = *(const float4*)&cur.g[tl][kq * 4];
      float vv[4] = {v4.x, v4.y, v4.z, v4.w};
      float gg[4] = {g4.x, g4.y, g4.z, g4.w};
      float o[4], lg[4], lb[4];
      *(float4*)lg = *(const float4*)&cst[7][kq * 4]; *(float4*)lb = *(const float4*)&cst[8][kq * 4];
#pragma unroll
      for (int e = 0; e < 4; e++) o[e] = (y[e] * rstd * lg[e] + lb[e] + c3 * vv[e]) * gg[e];
      size_t row = (size_t)(rowbase + c * 16 + tl);
      *(uint2*)(YR + row * 512 + hc) = make_uint2(pk2(o[0], o[1]), pk2(o[2], o[3]));
    }
    if (have_next) stage(nx, in[(c + 1) & 1]);
    __syncthreads();
  }
}

constexpr int KLD = 104, VLD = 72;
struct AttnSmem { u16 k[2][64 * KLD]; u16 v[2][64 * VLD]; };

__device__ __forceinline__ void attn_unit(const Params& p, int bh, int qi, char* smem, const int tid) {
  const int lane = tid & 63, wave = tid >> 6;
  const int fr = lane & 15, fq = lane >> 4;
  const int b = bh >> 3, h = bh & 7;
  const int rowbase = b * T_;
  u16* P = (u16*)(p.ws + OFF_P);
  const u16* Q = (const u16*)(p.ws + OFF_Q);
  const u16* KN = (const u16*)p.out;
  const u16* VT = (const u16*)p.out + (size_t)M_ * 512;
  const float2* ROPE = (const float2*)(p.ws + OFF_ROPE);
  AttnSmem* sm = (AttnSmem*)smem;
  const int qs = (qi == 0) ? 0 : 16 + (qi - 1) * 128;
  const int qn = (qi == 0) ? 16 : 128;
  const int q0 = qs + wave * 32;
  const bool wave_valid = (wave * 32 < qn);
  const int nkt = (qs + qn - 1) / 64 + 1;

  bf16x8 qf[2][3];
#pragma unroll
  for (int qb = 0; qb < 2; qb++) {
    int query = min(q0 + qb * 16 + fr, T_ - 1);
    const u16* qp = Q + (size_t)(rowbase + query) * 768 + h * 96;
    uint4 a0 = *(const uint4*)(qp + fq * 8);
    uint4 a1 = *(const uint4*)(qp + 32 + fq * 8);
    uint4 own = *(const uint4*)(qp + 64 + fq * 8);
    uint4 oth = *(const uint4*)(qp + 64 + (fq ^ 2) * 8);
    unsigned ow[4] = {own.x, own.y, own.z, own.w};
    unsigned tw[4] = {oth.x, oth.y, oth.z, oth.w};
    unsigned rw[4];
    const float2* rp = ROPE + (size_t)query * 16 + (fq & 1) * 8;
#pragma unroll
    for (int e = 0; e < 4; e++) {
      float2 cs0 = rp[2 * e], cs1 = rp[2 * e + 1];
      float o0 = bflo(ow[e]), o1 = bfhi(ow[e]);
      float t0 = bflo(tw[e]), t1 = bfhi(tw[e]);
      float r0, r1;
      if (fq < 2) { r0 = o0 * cs0.x - t0 * cs0.y; r1 = o1 * cs1.x - t1 * cs1.y; }
      else { r0 = t0 * cs0.y + o0 * cs0.x; r1 = t1 * cs1.y + o1 * cs1.x; }
      rw[e] = pk2(r0, r1);
    }
    uint4 a2 = make_uint4(rw[0], rw[1], rw[2], rw[3]);
    qf[qb][0] = *(bf16x8*)&a0;
    qf[qb][1] = *(bf16x8*)&a1;
    qf[qb][2] = *(bf16x8*)&a2;
  }

  f32x4 O[4][2];
#pragma unroll
  for (int i = 0; i < 4; i++)
#pragma unroll
    for (int j = 0; j < 2; j++) O[i][j] = f32x4{0.f, 0.f, 0.f, 0.f};
  float mrun[2] = {-1e30f, -1e30f}, lrun[2] = {0.f, 0.f};
  const float sc = 1.4426950408889634f / 9.797958971132712f;

  uint4 rk[3], rv[2];
  auto fetch_tile = [&](int kt) {
#pragma unroll
    for (int i = 0; i < 3; i++) {
      int c = tid + 256 * i;
      int key = c / 12, cc = c % 12;
      int t = kt * 64 + key;
      uint4 val = make_uint4(0, 0, 0, 0);
      if (t < T_) {
        size_t row = (size_t)(rowbase + t);
        if (cc < 8) val = *(const uint4*)(KN + row * 512 + h * 64 + cc * 8);
        else val = *(const uint4*)(P + row * PC_ + PKR_ + (cc - 8) * 8);
      }
      rk[i] = val;
    }
#pragma unroll
    for (int i = 0; i < 2; i++) {
      int c = tid + 256 * i;
      int dv = c >> 3, cc = c & 7;
      int t = kt * 64 + cc * 8;
      uint4 val = make_uint4(0, 0, 0, 0);
      if (t < T_) val = *(const uint4*)(VT + ((size_t)bh * 64 + dv) * T_ + t);
      rv[i] = val;
    }
  };
  auto store_tile = [&](int buf) {
#pragma unroll
    for (int i = 0; i < 3; i++) {
      int c = tid + 256 * i;
      int key = c / 12, cc = c % 12;
      *(uint4*)(&sm->k[buf][key * KLD + cc * 8]) = rk[i];
    }
#pragma unroll
    for (int i = 0; i < 2; i++) {
      int c = tid + 256 * i;
      int dv = c >> 3, cc = c & 7;
      *(uint4*)(&sm->v[buf][dv * VLD + cc * 8]) = rv[i];
    }
  };

  fetch_tile(0);
  for (int kt = 0; kt < nkt; kt++) {
    const int buf = kt & 1;
    store_tile(buf);
    __syncthreads();
    if (kt + 1 < nkt) fetch_tile(kt + 1);
    if (wave_valid && kt * 64 <= q0 + 31) {
      const u16* Ks = sm->k[buf];
      const u16* Vs = sm->v[buf];
      f32x4 s[4][2];
#pragma unroll
      for (int i = 0; i < 4; i++)
#pragma unroll
        for (int j = 0; j < 2; j++) s[i][j] = f32x4{0.f, 0.f, 0.f, 0.f};
#pragma unroll
      for (int ks = 0; ks < 3; ks++)
#pragma unroll
        for (int kb = 0; kb < 4; kb++) {
          bf16x8 kf = *(const bf16x8*)(Ks + (kb * 16 + fr) * KLD + ks * 32 + fq * 8);
#pragma unroll
          for (int qb = 0; qb < 2; qb++) s[kb][qb] = __builtin_amdgcn_mfma_f32_16x16x32_bf16(kf, qf[qb][ks], s[kb][qb], 0, 0, 0);
        }
      const bool need_mask = (kt * 64 + 63 > q0);
      unsigned pfw[2][2][4];
#pragma unroll
      for (int qb = 0; qb < 2; qb++) {
        const int query = q0 + qb * 16 + fr;
        float mx = -1e30f;
        if (need_mask) {
#pragma unroll
          for (int kb = 0; kb < 4; kb++)
#pragma unroll
            for (int j = 0; j < 4; j++) {
              int key = kt * 64 + kb * 16 + fq * 4 + j;
              if (key > query) s[kb][qb][j] = -1e30f;
            }
        }
#pragma unroll
        for (int kb = 0; kb < 4; kb++)
          mx = fmaxf(mx, fmaxf(fmaxf(s[kb][qb][0], s[kb][qb][1]), fmaxf(s[kb][qb][2], s[kb][qb][3])));
        mx = fmaxf(mx, shx(mx, lane, 16));
        mx = fmaxf(mx, shx(mx, lane, 32));
        const float mold = mrun[qb];
        const float mnew = fmaxf(mold, mx * sc);
        mrun[qb] = mnew;
        float ps = 0.f;
#pragma unroll
        for (int kb = 0; kb < 4; kb++) {
          float p0 = __builtin_amdgcn_exp2f(fmaf(s[kb][qb][0], sc, -mnew)), p1 = __builtin_amdgcn_exp2f(fmaf(s[kb][qb][1], sc, -mnew));
          float p2 = __builtin_amdgcn_exp2f(fmaf(s[kb][qb][2], sc, -mnew)), p3 = __builtin_amdgcn_exp2f(fmaf(s[kb][qb][3], sc, -mnew));
          ps += (p0 + p1) + (p2 + p3);
          pfw[qb][kb >> 1][(kb & 1) * 2 + 0] = pk2(p0, p1);
          pfw[qb][kb >> 1][(kb & 1) * 2 + 1] = pk2(p2, p3);
        }
        if (__builtin_amdgcn_ballot_w64(mnew != mold) != 0) {
          const float alpha = __builtin_amdgcn_exp2f(mold - mnew);
          lrun[qb] *= alpha;
#pragma unroll
          for (int dvb = 0; dvb < 4; dvb++) {
            O[dvb][qb][0] *= alpha; O[dvb][qb][1] *= alpha; O[dvb][qb][2] *= alpha; O[dvb][qb][3] *= alpha;
          }
        }
        lrun[qb] += ps;
      }
#pragma unroll
      for (int s2 = 0; s2 < 2; s2++)
#pragma unroll
        for (int dvb = 0; dvb < 4; dvb++) {
          const u16* vp = Vs + (dvb * 16 + fr) * VLD + s2 * 32 + fq * 4;
          uint2 v0 = *(const uint2*)vp;
          uint2 v1 = *(const uint2*)(vp + 16);
          uint4 vv = make_uint4(v0.x, v0.y, v1.x, v1.y);
          bf16x8 vf = *(bf16x8*)&vv;
#pragma unroll
          for (int qb = 0; qb < 2; qb++) {
            uint4 pw = make_uint4(pfw[qb][s2][0], pfw[qb][s2][1], pfw[qb][s2][2], pfw[qb][s2][3]);
            O[dvb][qb] = __builtin_amdgcn_mfma_f32_16x16x32_bf16(vf, *(bf16x8*)&pw, O[dvb][qb], 0, 0, 0);
          }
        }
    }
  }
  __syncthreads();
  if (wave_valid) {
#pragma unroll
    for (int qb = 0; qb < 2; qb++) {
      float l = lrun[qb];
      l += shx(l, lane, 16);
      l += shx(l, lane, 32);
      float inv = 1.0f / l;
      int query = q0 + qb * 16 + fr;
      if (query < qs + qn) {
        u16* op = P + (size_t)(rowbase + query) * PC_ + PMLA_ + h * 64 + fq * 4;
#pragma unroll
        for (int dvb = 0; dvb < 4; dvb++) {
          *(uint2*)(op + dvb * 16) =
              make_uint2(pk2(O[dvb][qb][0] * inv, O[dvb][qb][1] * inv), pk2(O[dvb][qb][2] * inv, O[dvb][qb][3] * inv));
        }
      }
    }
  }
}

#define XB_TMO      128
#define XB_XCNT(j)  (256  + 64 * (j))
#define XB_XSUB(j)  (1280 + 64 * (j))
#define XB_XGEN(j)  (2304 + 64 * (j))
#define XB_TOP      3328
#define XB_TOPGEN   3392
#define XCD_BAR_WORDS 3456
#define XB_SPIN_CAP (1u << 18)
#define LAS __attribute__((address_space(3)))

__device__ __forceinline__ unsigned xb_ld(unsigned* p)              { return __hip_atomic_load(p, __ATOMIC_RELAXED, __HIP_MEMORY_SCOPE_AGENT); }
__device__ __forceinline__ unsigned xb_add(unsigned* p, unsigned v) { return __hip_atomic_fetch_add(p, v, __ATOMIC_RELAXED, __HIP_MEMORY_SCOPE_AGENT); }
__device__ __forceinline__ unsigned xb_xcc_id() { return (unsigned)__builtin_amdgcn_s_getreg((3 << 11) | 20) & 0xFu; }
#define XB_SPIN(cond, bar) do { unsigned _sp = 0; while (cond) { __builtin_amdgcn_s_sleep(1); \
    if ((++_sp & 255u) == 0u) { if (xb_ld(&(bar)[XB_TMO])) break; if (_sp > XB_SPIN_CAP) { atomicAdd(&(bar)[XB_TMO], 1u); break; } } } } while (0)

struct XcdBarrier {
    unsigned* bar; unsigned x;
    volatile LAS unsigned* st;
};

__device__ __forceinline__ XcdBarrier xcd_barrier_post(unsigned* bar, volatile LAS unsigned* st) {
    XcdBarrier b; b.bar = bar; b.x = xb_xcc_id(); b.st = st;
    if (threadIdx.x == 0) (void)xb_add(&bar[XB_XCNT(b.x)], 1u);
    return b;
}
__device__ __forceinline__ void xcd_barrier_complete(unsigned* bar, unsigned x, unsigned& nloc, unsigned& nx) {
    const unsigned G = gridDim.x * gridDim.y * gridDim.z;
    unsigned sum, cnt, mine, sp = 0u;
    for (;;) {
        sum = 0u; cnt = 0u; mine = 0u;
#pragma unroll
        for (unsigned j = 0; j < 16; ++j) { const unsigned c = xb_ld(&bar[XB_XCNT(j)]); sum += c; cnt += (c > 0u) ? 1u : 0u; mine = (j == x) ? c : mine; }
        if (sum == G) break;
        __builtin_amdgcn_s_sleep(1);
        if ((++sp & 255u) == 0u) { if (xb_ld(&bar[XB_TMO])) break; if (sp > XB_SPIN_CAP) { atomicAdd(&bar[XB_TMO], 1u); break; } }
    }
    nloc = mine > 0u ? mine : 1u; nx = cnt > 0u ? cnt : 1u;
}

__device__ __forceinline__ void xcd_barrier(const XcdBarrier& b, const int tid_) {
    asm volatile("s_waitcnt vmcnt(0)" ::: "memory");
    __syncthreads();
    if (tid_ == 0) {
        unsigned* bar = b.bar;
        __builtin_amdgcn_s_waitcnt(0);
        unsigned nloc = b.st[0], nx = b.st[1];
        if (nloc == 0u) { xcd_barrier_complete(bar, b.x, nloc, nx); b.st[0] = nloc; b.st[1] = nx; }
        const unsigned old = xb_add(&bar[XB_XSUB(b.x)], 1u);
        const unsigned gen = old / nloc;
        if (old + 1u == (gen + 1u) * nloc) {
            __builtin_amdgcn_fence(__ATOMIC_RELEASE, "agent");
            asm volatile("s_waitcnt vmcnt(0)" ::: "memory");
            const unsigned og = xb_add(&bar[XB_TOP], 1u);
            const unsigned tg = og / nx;
            if (og + 1u == (tg + 1u) * nx) xb_add(&bar[XB_TOPGEN], 1u);
            else XB_SPIN(xb_ld(&bar[XB_TOPGEN]) == tg, bar);
            __builtin_amdgcn_fence(__ATOMIC_ACQUIRE, "agent");
            xb_add(&bar[XB_XGEN(b.x)], 1u);
            asm volatile("s_waitcnt vmcnt(0)" ::: "memory");
        } else {
            XB_SPIN(xb_ld(&bar[XB_XGEN(b.x)]) == gen, bar);
            __builtin_amdgcn_fence(__ATOMIC_ACQUIRE, "agent");
            asm volatile("s_waitcnt vmcnt(0)" ::: "memory");
        }
    }
    __syncthreads();
}


__global__ void __launch_bounds__(256, 2) mega(Params p) {
  cg::grid_group grid = cg::this_grid();
  __shared__ __attribute__((aligned(16))) char smem[SMEM_BYTES];
  __shared__ int s_unit;
  __shared__ uint4 xb_words;
  if (threadIdx.x == 0) xb_words = make_uint4(0u, 0u, 0u, 0u);
  __syncthreads();
  (void)xcd_barrier_post((unsigned*)(p.ws + OFF_BAR), (volatile LAS unsigned*)&xb_words);
#define XB_SYNC() do { XcdBarrier xb_; xb_.bar = (unsigned*)(p.ws + OFF_BAR); xb_.x = xb_xcc_id(); xb_.st = (volatile LAS unsigned*)&xb_words; xcd_barrier(xb_, wave0 * 64 + fresh_lane()); } while (0)
  int wave0 = __builtin_amdgcn_readfirstlane((int)(threadIdx.x >> 6));
  asm volatile("" : "+s"(wave0));
  const int nblk = gridDim.x;
#define H ((float*)(p.ws + OFF_H))
#define P ((u16*)(p.ws + OFF_P))
#define DEC ((float*)(p.ws + OFF_DEC))
#define AA ((u16*)(p.ws + OFF_AA))
#define GG ((u16*)(p.ws + OFF_GG))
#define Q ((u16*)(p.ws + OFF_Q))
#define MIX ((u16*)(p.ws + OFF_DEC))
#define HB1 ((u16*)p.out + (size_t)2 * M_ * 512)
#define HB2 ((u16*)(p.ws + OFF_HB2))
#define HBH ((u16*)(p.ws + OFF_AA))
#define ZERO ((const u16*)(p.ws + OFF_ZERO))
#define ACT ((u16*)(p.ws + OFF_P))
#define ROPE ((float2*)(p.ws + OFF_ROPE))
#define CTR ((int*)(p.ws + OFF_CTR))
#define KN ((u16*)p.out)
#define VT ((u16*)p.out + (size_t)M_ * 512)
#define YR ((u16*)(p.ws + OFF_AA))

  {
  PHASE_TID
  for (int t = blockIdx.x; t < p.nconv; t += nblk) conv_tile(p, t, smem, tid);
  for (int i = blockIdx.x * 256 + tid; i < T_ * 16; i += nblk * 256) {
    int t = i >> 4, f = i & 15;
    double rev = (double)t * ROPE_C[f];
    rev -= floor(rev);
    float r = (float)rev;
    ROPE[i] = make_float2(__builtin_amdgcn_cosf(r), __builtin_amdgcn_sinf(r));
  }
  for (int row = (blockIdx.x * 4 + wave) * 2; row < M_; row += nblk * 8) {
    int b = row / T_, t = row % T_;
    const float* srcA = (t < NMETA_) ? (p.in[1] + (size_t)t * 1024) : (p.in[0] + ((size_t)b * SEQ_ + (t - NMETA_)) * 1024);
    u16* hb = (row < HB_SPLIT) ? HB1 + (size_t)row * 1024 : HB2 + (size_t)(row - HB_SPLIT) * 1024;
    ln_row2(srcA, srcA + 1024, p.in[2], p.in[3], H + (size_t)row * 1024, H + (size_t)(row + 1) * 1024, lane, hb, hb + 1024);
  }
  if (blockIdx.x == 0 && tid < 16) CTR[tid] = 0;
  if (blockIdx.x == 1) { for (int i = tid; i < 2048; i += 256) ((unsigned*)(p.ws + OFF_ZERO))[i] = 0u; }
  }
  grid.sync();

#pragma unroll 1
  for (int ph_ = 0; ph_ < 20; ph_++) {
    const int l = ph_ / 10, kph = ph_ - l * 10;
    const u16* WL = (const u16*)(p.ws + OFF_W) + (size_t)l * W_LAYER;
    if (kph == 0) {
    PHASE_TID
    for (int it_ = 0; it_ * nblk < 257 * 19; it_++) {
      int mt, nt;
      if (!map_tile(it_, nblk, 257, 19, mt, nt)) continue;
      f32x4 acc[8][4];
      zero_acc8(acc);
      ADma al = ADma{(mt < 255) ? HB1 : HB2, 1024, (mt < 255) ? mt * 256 : mt * 256 - HB_SPLIT, 0, ZERO, 0};
      gemm3(acc, al, WL + W_IN, 1024, nt * 128, 1024, smem, tid);
      ACC_COORDS
#pragma unroll
      for (int mi = 0; mi < 8; mi++)
#pragma unroll
        for (int ni = 0; ni < 4; ni++) {
          int col = nt * 128 + wc * 64 + ni * 16 + fq * 4;
          int row = mt * 256 + wr * 128 + mi * 16 + fr;
          if (col < PC_)
            *(uint2*)(P + (size_t)row * PC_ + col) = make_uint2(pk2(acc[mi][ni][0], acc[mi][ni][1]), pk2(acc[mi][ni][2], acc[mi][ni][3]));
        }
    }
    }
    if (kph == 1) {
    PHASE_TID
    {
      const float* qg = p.in[16] + l * 256;
      const float* kvg = p.in[18] + l * 256;
      for (int rbase = (blockIdx.x * 4 + wave) * 4; rbase < M_; rbase += nblk * 16) {
        const int row = rbase + (lane >> 4), sl = lane & 15;
        u16* pr = P + (size_t)row * PC_;
        uint4 q0 = *(const uint4*)(pr + PMLA_ + sl * 16), q1 = *(const uint4*)(pr + PMLA_ + sl * 16 + 8);
        uint4 k0 = *(const uint4*)(pr + PKV_ + sl * 16), k1 = *(const uint4*)(pr + PKV_ + sl * 16 + 8);
        const int t = row % T_;
        float x1 = bf2f(pr[PKR_ + sl]), x2 = bf2f(pr[PKR_ + 16 + sl]);
        float2 cs = ROPE[t * 16 + sl];
        const unsigned qw[8] = {q0.x, q0.y, q0.z, q0.w, q1.x, q1.y, q1.z, q1.w};
        const unsigned kw[8] = {k0.x, k0.y, k0.z, k0.w, k1.x, k1.y, k1.z, k1.w};
        float s1 = 0.f, s2 = 0.f;
#pragma unroll
        for (int e = 0; e < 8; e++) {
          float a0 = bflo(qw[e]), a1 = bfhi(qw[e]), c0 = bflo(kw[e]), c1 = bfhi(kw[e]);
          s1 += a0 * a0 + a1 * a1;
          s2 += c0 * c0 + c1 * c1;
        }
        s1 = sum16(s1);
        s2 = sum16(s2);
        const float r1 = rsqrtf(s1 * (1.0f / 256.0f) + 1e-6f), r2 = rsqrtf(s2 * (1.0f / 256.0f) + 1e-6f);
        unsigned oq[8], ok[8];
#pragma unroll
        for (int e = 0; e < 8; e++) {
          float2 g1 = *(const float2*)(qg + sl * 16 + 2 * e), g2 = *(const float2*)(kvg + sl * 16 + 2 * e);
          oq[e] = pk2(bflo(qw[e]) * r1 * g1.x, bfhi(qw[e]) * r1 * g1.y);
          ok[e] = pk2(bflo(kw[e]) * r2 * g2.x, bfhi(kw[e]) * r2 * g2.y);
        }
        *(uint4*)(pr + PMLA_ + sl * 16) = make_uint4(oq[0], oq[1], oq[2], oq[3]);
        *(uint4*)(pr + PMLA_ + sl * 16 + 8) = make_uint4(oq[4], oq[5], oq[6], oq[7]);
        *(uint4*)(pr + PKV_ + sl * 16) = make_uint4(ok[0], ok[1], ok[2], ok[3]);
        *(uint4*)(pr + PKV_ + sl * 16 + 8) = make_uint4(ok[4], ok[5], ok[6], ok[7]);
        pr[PKR_ + sl] = f2bf(x1 * cs.x - x2 * cs.y);
        pr[PKR_ + 16 + sl] = f2bf(x1 * cs.y + x2 * cs.x);
      }
      const float* mu = p.in[5] + (size_t)l * 1824;
      for (int tile = blockIdx.x; tile < 514 * 12; tile += nblk) {
        int mt = tile / 12, sub = tile % 12, which = sub >> 2, nt = sub & 3;
        f32x4 acc[4][4];
        zero_acc(acc);
        ACC_COORDS
        if (which == 0) {
          AL<3> al{P + 1536, PC_, mt * 128, 0, 64, mu + 1536, 0};
          gemm_loop(acc, al, WL + W_LW, 64, nt * 128, 64, smem, tid);
          const float* w0 = p.in[6] + l * 512;
#pragma unroll
          for (int mi = 0; mi < 4; mi++)
#pragma unroll
            for (int ni = 0; ni < 4; ni++) {
              int col = nt * 128 + wc * 64 + ni * 16 + fr;
              float w0c = w0[col];
#pragma unroll
              for (int j = 0; j < 4; j++) {
                int row = mt * 128 + wr * 64 + mi * 16 + fq * 4 + j;
                float x = -(acc[mi][ni][j] + w0c);
                float sp = fmaxf(x, 0.f) + __logf(1.0f + __expf(-fabsf(x)));
                float wraw = -sp - 0.5f;
                DEC[(size_t)row * 512 + col] = __expf(-__expf(wraw));
              }
            }
        } else if (which == 1) {
          AL<3> al{P + 1600, PC_, mt * 128, 0, 64, mu + 1600, 1};
          gemm_loop(acc, al, WL + W_LA, 64, nt * 128, 64, smem, tid);
          const float* a0 = p.in[8] + l * 512;
#pragma unroll
          for (int mi = 0; mi < 4; mi++)
#pragma unroll
            for (int ni = 0; ni < 4; ni++) {
              int col = nt * 128 + wc * 64 + ni * 16 + fr;
              float a0c = a0[col];
#pragma unroll
              for (int j = 0; j < 4; j++) {
                int row = mt * 128 + wr * 64 + mi * 16 + fq * 4 + j;
                AA[(size_t)row * 512 + col] = f2bf(sigmoidf_(acc[mi][ni][j] + a0c));
              }
            }
        } else {
          AL<3> al{P + 1664, PC_, mt * 128, 0, 160, mu + 1664, 2};
          gemm_loop(acc, al, WL + W_LG, 192, nt * 128, 192, smem, tid);
#pragma unroll
          for (int mi = 0; mi < 4; mi++)
#pragma unroll
            for (int ni = 0; ni < 4; ni++) {
              int col = nt * 128 + wc * 64 + ni * 16 + fr;
#pragma unroll
              for (int j = 0; j < 4; j++) {
                int row = mt * 128 + wr * 64 + mi * 16 + fq * 4 + j;
                GG[(size_t)row * 512 + col] = f2bf(acc[mi][ni][j]);
              }
            }
        }
      }
    }
    }
    if (kph == 2) {
    PHASE_TID
    for (int it_ = 0; it_ * nblk < 257 * 14; it_++) {
      int mt, sub;
      if (!map_tile(it_, nblk, 257, 14, mt, sub)) continue;
      f32x4 acc[8][4];
      zero_acc8(acc);
      ACC_COORDS
      if (sub < 6) {
        ADma al{P + PMLA_, PC_, mt * 256, 0, ZERO, 0};
        gemm3(acc, al, WL + W_UQ, 256, sub * 128, 256, smem, tid);
#pragma unroll
        for (int mi = 0; mi < 8; mi++)
#pragma unroll
          for (int ni = 0; ni < 4; ni++) {
            int col = sub * 128 + wc * 64 + ni * 16 + fq * 4;
            int row = mt * 256 + wr * 128 + mi * 16 + fr;
            *(uint2*)(Q + (size_t)row * 768 + col) = make_uint2(pk2(acc[mi][ni][0], acc[mi][ni][1]), pk2(acc[mi][ni][2], acc[mi][ni][3]));
          }
      } else if (sub < 10) {
        int nt = sub - 6;
        ADma al{P + PKV_, PC_, mt * 256, 0, ZERO, 0};
        gemm3(acc, al, WL + W_UK, 256, nt * 128, 256, smem, tid);
#pragma unroll
        for (int mi = 0; mi < 8; mi++)
#pragma unroll
          for (int ni = 0; ni < 4; ni++) {
            int col = nt * 128 + wc * 64 + ni * 16 + fq * 4;
            int row = mt * 256 + wr * 128 + mi * 16 + fr;
            *(uint2*)(KN + (size_t)row * 512 + col) = make_uint2(pk2(acc[mi][ni][0], acc[mi][ni][1]), pk2(acc[mi][ni][2], acc[mi][ni][3]));
          }
      } else {
        int nt = sub - 10;
        ADma al{P + PKV_, PC_, mt * 256, 0, ZERO, 0};
        gemm3<4, false>(acc, al, WL + W_UV, 256, nt * 128, 256, smem, tid);
#pragma unroll
        for (int mi = 0; mi < 8; mi++)
#pragma unroll
          for (int ni = 0; ni < 4; ni++) {
            int col = nt * 128 + wc * 64 + ni * 16 + fr;
            int row = mt * 256 + wr * 128 + mi * 16 + fq * 4;
            int b = row / T_, t = row % T_;
            size_t o = ((size_t)(b * 512 + col)) * T_ + t;
            *(uint2*)(VT + o) = make_uint2(pk2(acc[mi][ni][0], acc[mi][ni][1]), pk2(acc[mi][ni][2], acc[mi][ni][3]));
          }
      }
    }
    }
    if (kph == 3) {
    PHASE_TID
    {
      const int xcd = blockIdx.x & 7, loc = blockIdx.x >> 3;
      const int total = 16 * 33;
      const bool scan_wg = (loc < 16), partner = (loc >= (nblk >> 4) && loc < (nblk >> 4) + 16);
      if (scan_wg) {
        scan_unit(p, l, xcd * 16 + loc, smem, launder(tid));
        __syncthreads();
      }
      if (!partner) {
        while (true) {
          if (tid == 0) s_unit = atomicAdd(&CTR[l * 8 + xcd], 1);
          __syncthreads();
          int v = s_unit;
          __syncthreads();
          if (v >= total) break;
          const int tidu = launder(tid);
          int g = v / 66, w = v - g * 66;
          attn_unit(p, xcd * 16 + g * 2 + (w & 1), 32 - (w >> 1), smem, tidu);
          __syncthreads();
        }
      }
    }
    }
    if (kph == 4) {
    PHASE_TID
    {
    u16* scr = (u16*)(p.ws + OFF_SCR) + (size_t)blockIdx.x * 32768;
    for (int it_ = 0; it_ * nblk < 256 * 8; it_++) {
      int mt, nt;
      if (!map_tile(it_, nblk, 256, 8, mt, nt)) continue;
      f32x4 acc[8][4];
      ADma alh = ADma{(mt < 255) ? HB1 : HB2, 1024, (mt < 255) ? mt * 256 : mt * 256 - HB_SPLIT, 0, ZERO, 0};
      zero_acc8(acc);
      gemm3(acc, alh, WL + W_G, 1024, nt * 128, 1024, smem, launder(tid));
      { const int tq_ = launder(tid); const int lane = tq_ & 63, wave = tq_ >> 6; ACC_COORDS
#pragma unroll
        for (int mi = 0; mi < 8; mi++)
#pragma unroll
          for (int ni = 0; ni < 4; ni++) {
            int col = nt * 128 + wc * 64 + ni * 16 + fq * 4;
            int row = mt * 256 + wr * 128 + mi * 16 + fr;
            *(uint2*)(MIX + (size_t)row * 1024 + col) = make_uint2(pk2(sigmoidf_(acc[mi][ni][0]), sigmoidf_(acc[mi][ni][1])),
                                                                   pk2(sigmoidf_(acc[mi][ni][2]), sigmoidf_(acc[mi][ni][3])));
          }
      }
      zero_acc8(acc);
      {
        ADma aly{YR, 512, mt * 256, 0, ZERO, 0};
        gemm3(acc, aly, WL + W_PR, 512, nt * 128, 512, smem, launder(tid));
      }
      { const int tq_ = launder(tid); const int lane = tq_ & 63, wave = tq_ >> 6; ACC_COORDS
#pragma unroll
        for (int mi = 0; mi < 8; mi++)
#pragma unroll
          for (int ni = 0; ni < 4; ni++) {
            int col = nt * 128 + wc * 64 + ni * 16 + fq * 4;
            int row = mt * 256 + wr * 128 + mi * 16 + fr;
            u16* mp = MIX + (size_t)row * 1024 + col;
            uint2 s = *(const uint2*)mp;
            *(uint2*)mp = make_uint2(pk2(bflo(s.x) * acc[mi][ni][0], bfhi(s.x) * acc[mi][ni][1]), pk2(bflo(s.y) * acc[mi][ni][2], bfhi(s.y) * acc[mi][ni][3]));
          }
      }
      zero_acc8(acc);
      gemm3(acc, alh, WL + W_G, 1024, 1024 + nt * 128, 1024, smem, launder(tid));
      { const int tq_ = launder(tid); const int lane = tq_ & 63, wave = tq_ >> 6; ACC_COORDS
#pragma unroll
        for (int mi = 0; mi < 8; mi++)
#pragma unroll
          for (int ni = 0; ni < 4; ni++) {
            int cl = wc * 64 + ni * 16 + fq * 4, rl = wr * 128 + mi * 16 + fr;
            *(uint2*)(scr + rl * 128 + cl) = make_uint2(pk2(sigmoidf_(acc[mi][ni][0]), sigmoidf_(acc[mi][ni][1])),
                                                        pk2(sigmoidf_(acc[mi][ni][2]), sigmoidf_(acc[mi][ni][3])));
          }
      }
      zero_acc8(acc);
      {
        ADma alm{P + PMLA_, PC_, mt * 256, 0, ZERO, 0};
        gemm3(acc, alm, WL + W_PM, 512, nt * 128, 512, smem, launder(tid));
      }
      { const int tq_ = launder(tid); const int lane = tq_ & 63, wave = tq_ >> 6; ACC_COORDS
#pragma unroll
        for (int mi = 0; mi < 8; mi++)
#pragma unroll
          for (int ni = 0; ni < 4; ni++) {
            int cl = wc * 64 + ni * 16 + fq * 4, rl = wr * 128 + mi * 16 + fr;
            u16* mp = MIX + (size_t)(mt * 256 + rl) * 1024 + nt * 128 + cl;
            uint2 t1 = *(const uint2*)mp;
            uint2 s = *(const uint2*)(scr + rl * 128 + cl);
            float o0 = bflo(t1.x) + bflo(s.x) * acc[mi][ni][0];
            float o1 = bfhi(t1.x) + bfhi(s.x) * acc[mi][ni][1];
            float o2 = bflo(t1.y) + bflo(s.y) * acc[mi][ni][2];
            float o3 = bfhi(t1.y) + bfhi(s.y) * acc[mi][ni][3];
            *(uint2*)mp = make_uint2(pk2(o0, o1), pk2(o2, o3));
          }
      }
    }
    }
    if (blockIdx.x < 16) {
      const int mt = 256, nt = blockIdx.x;
      f32x4 acc[8][2];
      unsigned sg[8][2][2];
      ADma alh = ADma{(mt < 255) ? HB1 : HB2, 1024, (mt < 255) ? mt * 256 : mt * 256 - HB_SPLIT, 0, ZERO, 0};
      zero_acc8(acc);
      const int tid1 = launder(tid);
      gemm3(acc, alh, WL + W_G, 1024, nt * 64, 1024, smem, tid1);
#pragma unroll
      for (int mi = 0; mi < 8; mi++)
#pragma unroll
        for (int ni = 0; ni < 2; ni++) {
          sg[mi][ni][0] = pk2(sigmoidf_(acc[mi][ni][0]), sigmoidf_(acc[mi][ni][1]));
          sg[mi][ni][1] = pk2(sigmoidf_(acc[mi][ni][2]), sigmoidf_(acc[mi][ni][3]));
        }
      zero_acc8(acc);
      {
        ADma aly{YR, 512, mt * 256, 0, ZERO, 0};
        const int tid2 = launder(tid);
      gemm3(acc, aly, WL + W_PR, 512, nt * 64, 512, smem, tid2);
      }
{ const int tidq = launder(tid); const int lane = tidq & 63, wave = tidq >> 6; ACC_COORDS
#pragma unroll
      for (int mi = 0; mi < 8; mi++)
#pragma unroll
        for (int ni = 0; ni < 2; ni++) {
          int col = nt * 64 + wc * 32 + ni * 16 + fq * 4;
          int row = mt * 256 + wr * 128 + mi * 16 + fr;
          *(uint2*)(MIX + (size_t)row * 1024 + col) = make_uint2(pk2(bflo(sg[mi][ni][0]) * acc[mi][ni][0], bfhi(sg[mi][ni][0]) * acc[mi][ni][1]),
                                                                 pk2(bflo(sg[mi][ni][1]) * acc[mi][ni][2], bfhi(sg[mi][ni][1]) * acc[mi][ni][3]));
        }
      }
      zero_acc8(acc);
      const int tid3 = launder(tid);
      gemm3(acc, alh, WL + W_G, 1024, 1024 + nt * 64, 1024, smem, tid3);
#pragma unroll
      for (int mi = 0; mi < 8; mi++)
#pragma unroll
        for (int ni = 0; ni < 2; ni++) {
          sg[mi][ni][0] = pk2(sigmoidf_(acc[mi][ni][0]), sigmoidf_(acc[mi][ni][1]));
          sg[mi][ni][1] = pk2(sigmoidf_(acc[mi][ni][2]), sigmoidf_(acc[mi][ni][3]));
        }
      zero_acc8(acc);
      {
        ADma alm{P + PMLA_, PC_, mt * 256, 0, ZERO, 0};
        const int tid4 = launder(tid);
      gemm3(acc, alm, WL + W_PM, 512, nt * 64, 512, smem, tid4);
      }
{ const int tidq = launder(tid); const int lane = tidq & 63, wave = tidq >> 6; ACC_COORDS
#pragma unroll
      for (int mi = 0; mi < 8; mi++)
#pragma unroll
        for (int ni = 0; ni < 2; ni++) {
          int col = nt * 64 + wc * 32 + ni * 16 + fq * 4;
          int row = mt * 256 + wr * 128 + mi * 16 + fr;
          uint2 pm = *(const uint2*)(MIX + (size_t)row * 1024 + col);
          float o0 = bflo(pm.x) + bflo(sg[mi][ni][0]) * acc[mi][ni][0];
          float o1 = bfhi(pm.x) + bfhi(sg[mi][ni][0]) * acc[mi][ni][1];
          float o2 = bflo(pm.y) + bflo(sg[mi][ni][1]) * acc[mi][ni][2];
          float o3 = bfhi(pm.y) + bfhi(sg[mi][ni][1]) * acc[mi][ni][3];
          *(uint2*)(MIX + (size_t)row * 1024 + col) = make_uint2(pk2(o0, o1), pk2(o2, o3));
        }
      }
    }
    }
    if (kph == 5) {
    PHASE_TID
    for (int prb_ = (PROBE_FI ? 0 : 1); prb_ < 2; prb_++)
    for (int it_ = 0; it_ * nblk < 256 * 8; it_++) {
      int mt, nt;
      if (!map_tile(it_, nblk, 256, 8, mt, nt)) continue;
      f32x4 acc[8][4];
      zero_acc8(acc);
      ACC_COORDS
      ADma al{MIX, 1024, mt * 256, 0, ZERO, 0};
      gemm3(acc, al, WL + W_OUT, 1024, nt * 128, 1024, smem, tid);
#pragma unroll
      for (int mi = 0; mi < 8; mi++)
#pragma unroll
        for (int ni = 0; ni < 4; ni++) {
          int col = nt * 128 + wc * 64 + ni * 16 + fq * 4;
          int row = mt * 256 + wr * 128 + mi * 16 + fr;
          float* hp = H + (size_t)row * 1024 + col;
          float* dp = (prb_ == 0) ? (p.out + (size_t)(row & 65535) * 1024 + col) : hp;
          float4 hv = *(const float4*)hp;
          hv.x = ALPHA_ * hv.x + acc[mi][ni][0];
          hv.y = ALPHA_ * hv.y + acc[mi][ni][1];
          hv.z = ALPHA_ * hv.z + acc[mi][ni][2];
          hv.w = ALPHA_ * hv.w + acc[mi][ni][3];
          *(float4*)dp = hv;
        }
    }
    if (blockIdx.x < 16) {
      const int mt = 256, n0 = blockIdx.x * 64;
      f32x4 acc[8][2];
      zero_acc8(acc);
      ADma al{MIX, 1024, mt * 256, 0, ZERO, 0};
      gemm3(acc, al, WL + W_OUT, 1024, n0, 1024, smem, launder(tid));
      const int tq_ = launder(tid);
      const int lane = tq_ & 63, wave = tq_ >> 6;
      ACC_COORDS
#pragma unroll
      for (int mi = 0; mi < 8; mi++)
#pragma unroll
        for (int ni = 0; ni < 2; ni++) {
          int col = n0 + wc * 32 + ni * 16 + fq * 4;
          int row = mt * 256 + wr * 128 + mi * 16 + fr;
          float* hp = H + (size_t)row * 1024 + col;
          float4 hv = *(const float4*)hp;
          hv.x = ALPHA_ * hv.x + acc[mi][ni][0];
          hv.y = ALPHA_ * hv.y + acc[mi][ni][1];
          hv.z = ALPHA_ * hv.z + acc[mi][ni][2];
          hv.w = ALPHA_ * hv.w + acc[mi][ni][3];
          *(float4*)hp = hv;
        }
    }
    }
    if (kph == 6) {
    PHASE_TID
    for (int row = (blockIdx.x * 4 + wave) * 2; row < M_; row += nblk * 8)
      ln_row2(H + (size_t)row * 1024, H + (size_t)(row + 1) * 1024, p.in[24] + l * 1024, p.in[25] + l * 1024, H + (size_t)row * 1024, H + (size_t)(row + 1) * 1024, lane, HBH + (size_t)row * 1024, HBH + (size_t)(row + 1) * 1024);
    }
    if (kph == 7) {
    PHASE_TID
    {
      const float* cw = p.in[27] + (size_t)l * 3 * 5632;
      const float* cb = p.in[28] + (size_t)l * 5632;
#if PROBE_HOT
      for (int it_ = 0; it_ * nblk < 272 * 44; it_++) {
        int rest, nt;
        if (!map_tile(it_, nblk, 272, 44, rest, nt)) continue;
        f32x4 acc[8][4];
        zero_acc8(acc);
#if PROBE_HOT == 1
        ADma al{HBH, 1024, 0, 0, ZERO, 1, p.ws};
        gemm3(acc, al, WL + W_UP, 1024, 0, 1024, smem, tid);
#else
        int it = rest % 17, b = rest / 17;
        ADma al{HBH, 1024, b * T_, 254 * it - 2, ZERO, 1, p.ws};
        gemm3(acc, al, WL + W_UP, 1024, nt * 128, 1024, smem, tid);
#endif
        float sacc = 0.f;
#pragma unroll
        for (int mi = 0; mi < 8; mi++)
#pragma unroll
          for (int ni = 0; ni < 4; ni++) sacc += acc[mi][ni][0] + acc[mi][ni][1] + acc[mi][ni][2] + acc[mi][ni][3];
        if (sacc == 12345.678f) ACT[tid] = 0;
      }
#endif
      for (int it_ = 0; it_ * nblk < 272 * 44; it_++) {
        int rest, nt;
        if (!map_tile(it_, nblk, 272, 44, rest, nt)) continue;
        int it = rest % 17, b = rest / 17;
        int t0 = 254 * it - 2;
        f32x4 acc[8][4];
        zero_acc8(acc);
        ADma al{HBH, 1024, b * T_, t0, ZERO, 1, p.ws};
        gemm3(acc, al, WL + W_UP, 1024, nt * 128, 1024, smem, launder(tid));
        ACC_COORDS
        float(*ut)[132] = (float(*)[132])smem;
        const int tidh = launder(tid);
        const int c = tidh & 63, rg = tidh >> 6;
        const int gcol = nt * 64 + c, vcol = DFF_ + nt * 64 + c;
        const float g0 = cw[gcol], g1 = cw[5632 + gcol], g2 = cw[2 * 5632 + gcol], gb = cb[gcol];
        const float v0 = cw[vcol], v1 = cw[5632 + vcol], v2 = cw[2 * 5632 + vcol], vb = cb[vcol];
#pragma unroll 1
        for (int half = 0; half < 2; half++) {
          float carry = 0.f;
          if (half == 1) carry = ut[126 + (tid >> 7)][tid & 127];
          __syncthreads();
          if (half == 1) ut[tid >> 7][tid & 127] = carry;
          if (wr == half) {
#pragma unroll
            for (int mi = 0; mi < 8; mi++)
#pragma unroll
              for (int ni = 0; ni < 4; ni++)
                *(float4*)&ut[half * 2 + mi * 16 + fr][wc * 64 + ni * 16 + fq * 4] = make_float4(acc[mi][ni][0], acc[mi][ni][1], acc[mi][ni][2], acc[mi][ni][3]);
          }
          __syncthreads();
          const int nq = half ? 130 : 128;
          int qs = 2 + rg * 32, qe = min(qs + 32, nq);
          float ga = ut[qs - 2][c], gbp = ut[qs - 1][c];
          float va = ut[qs - 2][64 + c], vbp = ut[qs - 1][64 + c];
#pragma unroll 4
          for (int q = qs; q < qe; q++) {
            float gc = ut[q][c], vc = ut[q][64 + c];
            int t = t0 + half * 126 + q;
            if (t < T_) {
              float gate = g0 * ga + g1 * gbp + g2 * gc + gb;
              float val = v0 * va + v1 * vbp + v2 * vc + vb;
              float av = gate * sigmoidf_(gate) * val;
              ACT[(size_t)(b * T_ + t) * DFF_ + gcol] = f2bf(av);
            }
            ga = gbp; gbp = gc; va = vbp; vbp = vc;
          }
        }
        __syncthreads();
      }
    }
    }
    if (kph == 8) {
    PHASE_TID
    for (int prb_ = (PROBE_FI ? 0 : 1); prb_ < 2; prb_++)
    for (int it_ = 0; it_ * nblk < 256 * 8; it_++) {
      int mt, nt;
      if (!map_tile(it_, nblk, 256, 8, mt, nt)) continue;
      f32x4 acc[8][4];
      zero_acc8(acc);
      ACC_COORDS
      ADma al{ACT, DFF_, mt * 256, 0, ZERO, 0};
      gemm3(acc, al, WL + W_DN, DFF_, nt * 128, DFF_, smem, tid);
#pragma unroll
      for (int mi = 0; mi < 8; mi++)
#pragma unroll
        for (int ni = 0; ni < 4; ni++) {
          int col = nt * 128 + wc * 64 + ni * 16 + fq * 4;
          int row = mt * 256 + wr * 128 + mi * 16 + fr;
          float* hp = H + (size_t)row * 1024 + col;
          float* dp = (prb_ == 0) ? (p.out + (size_t)(row & 65535) * 1024 + col) : hp;
          float4 hv = *(const float4*)hp;
          hv.x = ALPHA_ * hv.x + acc[mi][ni][0];
          hv.y = ALPHA_ * hv.y + acc[mi][ni][1];
          hv.z = ALPHA_ * hv.z + acc[mi][ni][2];
          hv.w = ALPHA_ * hv.w + acc[mi][ni][3];
          *(float4*)dp = hv;
        }
    }
    if (blockIdx.x < 16) {
      const int mt = 256, n0 = blockIdx.x * 64;
      f32x4 acc[8][2];
      zero_acc8(acc);
      ADma al{ACT, DFF_, mt * 256, 0, ZERO, 0};
      gemm3(acc, al, WL + W_DN, DFF_, n0, DFF_, smem, launder(tid));
      const int tq_ = launder(tid);
      const int lane = tq_ & 63, wave = tq_ >> 6;
      ACC_COORDS
#pragma unroll
      for (int mi = 0; mi < 8; mi++)
#pragma unroll
        for (int ni = 0; ni < 2; ni++) {
          int col = n0 + wc * 32 + ni * 16 + fq * 4;
          int row = mt * 256 + wr * 128 + mi * 16 + fr;
          float* hp = H + (size_t)row * 1024 + col;
          float4 hv = *(const float4*)hp;
          hv.x = ALPHA_ * hv.x + acc[mi][ni][0];
          hv.y = ALPHA_ * hv.y + acc[mi][ni][1];
          hv.z = ALPHA_ * hv.z + acc[mi][ni][2];
          hv.w = ALPHA_ * hv.w + acc[mi][ni][3];
          *(float4*)hp = hv;
        }
    }
    }
    if (kph == 9) {
    PHASE_TID
    if (l == 0) {
      for (int row = (blockIdx.x * 4 + wave) * 2; row < M_; row += nblk * 8) {
        u16* hb = (row < HB_SPLIT) ? HB1 + (size_t)row * 1024 : HB2 + (size_t)(row - HB_SPLIT) * 1024;
        ln_row2(H + (size_t)row * 1024, H + (size_t)(row + 1) * 1024, p.in[30], p.in[31], H + (size_t)row * 1024, H + (size_t)(row + 1) * 1024, lane, hb, hb + 1024);
      }
    } else {
      for (int row = (blockIdx.x * 4 + wave) * 2; row < M_; row += nblk * 8) {
        int b = row / T_, t = row % T_;
        if (t >= NMETA_) {
          float* o = p.out + ((size_t)b * SEQ_ + (t - NMETA_)) * 1024;
          ln_row2(H + (size_t)row * 1024, H + (size_t)(row + 1) * 1024, p.in[30] + 1024, p.in[31] + 1024, o, o + 1024, lane, nullptr, nullptr);
        }
      }
    }
    }
    if (ph_ != 19) XB_SYNC();
  }
}

#undef H
#undef P
#undef DEC
#undef AA
#undef GG
#undef Q
#undef MIX
#undef HB1
#undef HB2
#undef HBH
#undef ZERO
#undef ACT
#undef ROPE
#undef CTR
#undef KN
#undef VT
#undef YR

extern "C" void kernel_launch(void* const* d_in, const int* in_sizes, int n_in, void* d_out, int out_size, void* d_ws,
                              size_t ws_size, hipStream_t stream) {
  static int grid_blocks = 0;
  if (!grid_blocks) {
    int dev = 0, cus = 0, per_cu = 0;
    hipGetDevice(&dev);
    hipDeviceGetAttribute(&cus, hipDeviceAttributeMultiprocessorCount, dev);
    hipOccupancyMaxActiveBlocksPerMultiprocessor(&per_cu, mega, 256, 0);
    if (per_cu > 2) per_cu = 2;
    grid_blocks = cus * per_cu;
  }
  if (ws_size < WS_TOTAL) fprintf(stderr, "workspace too small: %zu < %zu\n", ws_size, (size_t)WS_TOTAL);
  Params p;
  memset(&p, 0, sizeof(p));
  for (int i = 0; i < 32; i++) p.in[i] = (const float*)d_in[i];
  p.out = (float*)d_out;
  p.ws = (char*)d_ws;
  u16* wb = (u16*)((char*)d_ws + OFF_W);
  int nj = 0, tiles = 0;
  auto add = [&](const float* src, size_t dst_off, int ld, int c0, int K, int Kpad, int Nv, int Np, int mode) {
    Job& j = p.jobs[nj++];
    j.src = src; j.dst = wb + dst_off; j.ld = ld; j.c0 = c0; j.K = K; j.Kpad = Kpad; j.Nv = Nv; j.Np = Np; j.mode = mode;
    j.tile0 = tiles;
    tiles += (Kpad / 64) * (Np / 64);
  };
  for (int l = 0; l < 2; l++) {
    size_t o = (size_t)l * W_LAYER;
    const float* w_in = (const float*)d_in[4] + (size_t)l * 1024 * 4416;
    add(w_in, o + W_IN, 4416, 0, 1024, 1024, 2368, 2432, 0);
    add(w_in, o + W_G, 4416, 2368, 1024, 1024, 2048, 2048, 0);
    add((const float*)d_in[7] + (size_t)l * 64 * 512, o + W_LW, 512, 0, 64, 64, 512, 512, 0);
    add((const float*)d_in[9] + (size_t)l * 64 * 512, o + W_LA, 512, 0, 64, 64, 512, 512, 0);
    add((const float*)d_in[10] + (size_t)l * 160 * 512, o + W_LG, 512, 0, 160, 192, 512, 512, 0);
    add((const float*)d_in[17] + (size_t)l * 256 * 768, o + W_UQ, 768, 0, 256, 256, 768, 768, 0);
    add((const float*)d_in[19] + (size_t)l * 256 * 512, o + W_UK, 512, 0, 256, 256, 512, 512, 0);
    add((const float*)d_in[20] + (size_t)l * 256 * 512, o + W_UV, 512, 0, 256, 256, 512, 512, 0);
    add((const float*)d_in[21] + (size_t)l * 512 * 1024, o + W_PR, 1024, 0, 512, 512, 1024, 1024, 0);
    add((const float*)d_in[22] + (size_t)l * 512 * 1024, o + W_PM, 1024, 0, 512, 512, 1024, 1024, 0);
    add((const float*)d_in[23] + (size_t)l * 1024 * 1024, o + W_OUT, 1024, 0, 1024, 1024, 1024, 1024, 0);
    add((const float*)d_in[26] + (size_t)l * 1024 * 5632, o + W_UP, 5632, 0, 1024, 1024, 5632, 5632, 1);
    add((const float*)d_in[29] + (size_t)l * 2816 * 1024, o + W_DN, 1024, 0, 2816, 2816, 1024, 1024, 0);
  }
  p.nconv = tiles;
  hipMemsetAsync((char*)d_ws + OFF_BAR, 0, 16384, stream);
  void* args[] = {&p};
  hipError_t e = hipLaunchCooperativeKernel((void*)mega, dim3(grid_blocks), dim3(256), args, 0, stream);
  if (e != hipSuccess) fprintf(stderr, "cooperative launch failed: %s (grid %d)\n", hipGetErrorString(e), grid_blocks);
}
```

```cpp
#include <hip/hip_runtime.h>
#include <hip/hip_cooperative_groups.h>
#include <cstdio>
#include <cstring>
namespace cg = cooperative_groups;

#ifndef PHMASK
#define PHMASK 0xFFFF
#endif
#ifndef PROBE_HOT
#define PROBE_HOT 0
#endif
#ifndef PROBE_FI
#define PROBE_FI 0
#endif
#ifndef REPMASK
#define REPMASK 0
#endif
typedef unsigned short u16;
using bf16x8 = __attribute__((ext_vector_type(8))) short;
using f32x4 = __attribute__((ext_vector_type(4))) float;

constexpr int B_ = 16, SEQ_ = 4096, NMETA_ = 16, T_ = 4112, M_ = B_ * T_, D_ = 1024;
constexpr int PC_ = 2368;
constexpr int PMLA_ = 1824, PKV_ = 2080, PKR_ = 2336;
constexpr int DFF_ = 2816;
constexpr float ALPHA_ = 1.4142135623730951f;

constexpr size_t OFF_H = 0;
constexpr size_t OFF_P = OFF_H + (size_t)M_ * 1024 * 4;
constexpr size_t OFF_DEC = OFF_P + (size_t)M_ * PC_ * 2;
constexpr size_t OFF_AA = OFF_DEC + (size_t)M_ * 512 * 4;
constexpr size_t OFF_GG = OFF_AA + (size_t)M_ * 512 * 2;
constexpr size_t OFF_Q = OFF_GG + (size_t)M_ * 512 * 2;
constexpr size_t OFF_W = OFF_Q + (size_t)M_ * 768 * 2;
constexpr size_t W_IN = 0;
constexpr size_t W_G = W_IN + (size_t)2432 * 1024;
constexpr size_t W_LW = W_G + (size_t)2048 * 1024;
constexpr size_t W_LA = W_LW + (size_t)512 * 64;
constexpr size_t W_LG = W_LA + (size_t)512 * 64;
constexpr size_t W_UQ = W_LG + (size_t)512 * 192;
constexpr size_t W_UK = W_UQ + (size_t)768 * 256;
constexpr size_t W_UV = W_UK + (size_t)512 * 256;
constexpr size_t W_PR = W_UV + (size_t)512 * 256;
constexpr size_t W_PM = W_PR + (size_t)1024 * 512;
constexpr size_t W_OUT = W_PM + (size_t)1024 * 512;
constexpr size_t W_UP = W_OUT + (size_t)1024 * 1024;
constexpr size_t W_DN = W_UP + (size_t)5632 * 1024;
constexpr size_t W_LAYER = W_DN + (size_t)1024 * 2816;
constexpr size_t OFF_ROPE = OFF_W + 2 * W_LAYER * 2;
constexpr size_t OFF_CTR = OFF_ROPE + (size_t)T_ * 16 * 8;
constexpr size_t OFF_ZERO = OFF_CTR + 256;
constexpr size_t OFF_BAR = OFF_ZERO + 8192;
constexpr size_t OFF_HB2 = OFF_BAR + 16384;
constexpr size_t OFF_SCR = OFF_HB2 + (size_t)512 * 1024 * 2;
constexpr size_t WS_TOTAL = OFF_SCR + (size_t)1024 * 65536;
constexpr int HB_SPLIT = 65280;

struct Job { const float* src; u16* dst; int ld, c0, K, Kpad, Nv, Np, mode, tile0; };
struct Params {
  const float* in[32];
  float* out;
  char* ws;
  Job jobs[26];
  int nconv;
  int pad0;
};

__constant__ double ROPE_C[16] = {0.15915494309189535, 0.08949940160889101, 0.050329212104487035, 0.0283021958306234,
                                  0.015915494309189534, 0.008949940160889102, 0.005032921210448704, 0.00283021958306234,
                                  0.0015915494309189536, 0.0008949940160889102, 0.0005032921210448703, 0.00028302195830623395,
                                  0.00015915494309189535, 8.949940160889102e-05, 5.0329212104487035e-05, 2.8302195830623396e-05};

__device__ __forceinline__ int launder(int x) { asm volatile("" : "+v"(x)); return x; }
typedef __bf16 bf16x2_t __attribute__((ext_vector_type(2)));
typedef float f32x2_t __attribute__((ext_vector_type(2)));
__device__ __forceinline__ unsigned pk2(float a, float b) {
  f32x2_t v = {a, b};
  bf16x2_t r = __builtin_convertvector(v, bf16x2_t);
  return *(unsigned*)&r;
}
__device__ __forceinline__ u16 f2bf(float f) { return (u16)(pk2(f, 0.f) & 0xffffu); }
__device__ __forceinline__ float bf2f(unsigned h) { return __uint_as_float(h << 16); }
__device__ __forceinline__ float bflo(unsigned w) { return __uint_as_float(w << 16); }
__device__ __forceinline__ float bfhi(unsigned w) { return __uint_as_float(w & 0xffff0000u); }
__device__ __forceinline__ float sigmoidf_(float x) { return __builtin_amdgcn_rcpf(1.0f + __expf(-x)); }

__device__ __forceinline__ int fresh_lane() { int x; asm volatile("v_mbcnt_lo_u32_b32 %0, -1, 0\n\tv_mbcnt_hi_u32_b32 %0, -1, %0" : "=v"(x)); return x; }
#define PHASE_TID const int tid = wave0 * 64 + fresh_lane(); const int lane = tid & 63, wave = tid >> 6; (void)lane; (void)wave;
template <int CTRL>
__device__ __forceinline__ float dppf(float x) {
  return __int_as_float(__builtin_amdgcn_update_dpp(0, __float_as_int(x), CTRL, 0xF, 0xF, true));
}
__device__ __forceinline__ float sum8(float x) {
  x += dppf<0xB1>(x);
  x += dppf<0x4E>(x);
  x += dppf<0x141>(x);
  return x;
}
__device__ __forceinline__ float sum16(float x) {
  x = sum8(x);
  x += dppf<0x140>(x);
  return x;
}
__device__ __forceinline__ float shx(float x, int lane, int o) {
  return __int_as_float(__builtin_amdgcn_ds_bpermute((lane ^ o) << 2, __float_as_int(x)));
}
__device__ __forceinline__ float wave_sum(float x, int lane) {
  x = sum16(x);
  x += shx(x, lane, 16);
  x += shx(x, lane, 32);
  return x;
}

constexpr int BM = 128, BN = 128, BK = 64, LDT = 64;
constexpr int SMEM_BYTES = 73728;

template <int MODE>
struct AL {
  const void* base;
  int ld;
  int row0;
  int t0;
  int kvalid;
  const float* mu;
  int fn;
  struct Raw { uint4 x, y; };
  __device__ __forceinline__ Raw fetch(int r, int k) const {
    Raw w;
    { unsigned z = (MODE == 3) ? (unsigned)launder(0) : 0u; w.x = make_uint4(z, z, z, z); w.y = w.x; }
    if (MODE == 0) {
      const float* p = (const float*)base + (size_t)(row0 + r) * ld + k;
      w.x = *(const uint4*)p;
      w.y = *(const uint4*)(p + 4);
    } else if (MODE == 1) {
      const u16* p = (const u16*)base + (size_t)(row0 + r) * ld + k;
      w.x = *(const uint4*)p;
    } else if (MODE == 4) {
      const float* p = (const float*)base + (size_t)(row0 + r) * ld + k;
      float4 a = *(const float4*)p, b = *(const float4*)(p + 4);
      w.x = make_uint4(pk2(a.x, a.y), pk2(a.z, a.w), pk2(b.x, b.y), pk2(b.z, b.w));
    } else if (MODE == 2) {
      int t = t0 + r;
      if (t >= 0 && t < T_) {
        const float* p = (const float*)base + (size_t)(row0 + t) * ld + k;
        w.x = *(const uint4*)p;
        w.y = *(const uint4*)(p + 4);
      }
    } else {
      int row = row0 + r;
      int t = row % T_;
      if (k < kvalid) {
        const u16* p = (const u16*)base + (size_t)row * ld + k;
        w.x = *(const uint4*)p;
        if (t > 0) w.y = *(const uint4*)(p - ld);
      }
    }
    return w;
  }
  __device__ __forceinline__ uint4 cvt(const Raw& w, int k) const {
    if (MODE == 0 || MODE == 2) {
      uint4 o;
      o.x = pk2(__uint_as_float(w.x.x), __uint_as_float(w.x.y));
      o.y = pk2(__uint_as_float(w.x.z), __uint_as_float(w.x.w));
      o.z = pk2(__uint_as_float(w.y.x), __uint_as_float(w.y.y));
      o.w = pk2(__uint_as_float(w.y.z), __uint_as_float(w.y.w));
      return o;
    } else if (MODE == 1 || MODE == 4) {
      return w.x;
    } else {
      if (k >= kvalid) { unsigned z = (unsigned)launder(0); return make_uint4(z, z, z, z); }
      unsigned cw[4] = {w.x.x, w.x.y, w.x.z, w.x.w};
      unsigned pw[4] = {w.y.x, w.y.y, w.y.z, w.y.w};
      unsigned ow[4];
#pragma unroll
      for (int e = 0; e < 4; e++) {
        float x0 = bflo(cw[e]), x1 = bfhi(cw[e]);
        float p0 = bflo(pw[e]), p1 = bfhi(pw[e]);
        float v0 = x0 + (p0 - x0) * mu[k + 2 * e];
        float v1 = x1 + (p1 - x1) * mu[k + 2 * e + 1];
        if (fn == 0) {
          v0 = 1.0f - 2.0f * __builtin_amdgcn_rcpf(__expf(2.0f * v0) + 1.0f);
          v1 = 1.0f - 2.0f * __builtin_amdgcn_rcpf(__expf(2.0f * v1) + 1.0f);
        } else if (fn == 2) {
          v0 = sigmoidf_(v0);
          v1 = sigmoidf_(v1);
        }
        ow[e] = pk2(v0, v1);
      }
      return make_uint4(ow[0], ow[1], ow[2], ow[3]);
    }
  }
};

template <int NI>
__device__ __forceinline__ void zero_acc(f32x4 (&acc)[4][NI]) {
#pragma unroll
  for (int i = 0; i < 4; i++)
#pragma unroll
    for (int j = 0; j < NI; j++) acc[i][j] = f32x4{0.f, 0.f, 0.f, 0.f};
}

#define REP4(X) X(0) X(1) X(2) X(3)
template <class ALT, int NI>
__device__ __forceinline__ void gemm_loop(f32x4 (&acc)[4][NI], const ALT& al, const u16* __restrict__ Bt, int ldb, int n0,
                                          int K, char* smem, const int tid) {
  const int lane = tid & 63, wave = tid >> 6;
  const int wr = wave >> 1, wc = wave & 1, fr = lane & 15, fq = lane >> 4;
  const int lr = tid >> 3, lk = (tid & 7) * 8, lsw = ((tid & 7) ^ (lr & 7)) * 8;
  u16* sa = (u16*)smem;
  u16* sb = sa + 2 * BM * LDT;
  typename ALT::Raw ra0, ra1, ra2, ra3;
  uint4 rb0 = make_uint4(0,0,0,0), rb1 = rb0, rb2 = rb0, rb3 = rb0;
  const u16* bp = Bt + (size_t)(n0 + lr) * ldb + lk;
#define GL_FETCH(i) ra##i = al.fetch(lr + 32 * i, kf); if (i < NI) rb##i = *(const uint4*)(bp + (size_t)(32 * i) * ldb + kb);
#define GL_STORE(i) *(uint4*)(a_ + (lr + 32 * i) * LDT + lsw) = al.cvt(ra##i, kt * BK + lk); if (i < NI) *(uint4*)(b_ + (lr + 32 * i) * LDT + lsw) = rb##i;
  {
    const int kf = lk, kb = 0;
    REP4(GL_FETCH)
  }
  const int nk = K / BK;
  for (int kt = 0; kt < nk; kt++) {
    u16* a_ = sa + (kt & 1) * BM * LDT;
    u16* b_ = sb + (kt & 1) * BN * LDT;
    REP4(GL_STORE)
    __syncthreads();
    if (kt + 1 < nk) {
      const int kf = (kt + 1) * BK + lk, kb = (kt + 1) * BK;
      REP4(GL_FETCH)
    }
#pragma unroll
    for (int ks = 0; ks < 2; ks++) {
      bf16x8 af[4], bf[NI];
#pragma unroll
      for (int i = 0; i < 4; i++) af[i] = *(const bf16x8*)(a_ + (wr * 64 + i * 16 + fr) * LDT + (((ks * 4 + fq) ^ (fr & 7)) * 8));
#pragma unroll
      for (int i = 0; i < NI; i++) bf[i] = *(const bf16x8*)(b_ + (wc * (NI * 16) + i * 16 + fr) * LDT + (((ks * 4 + fq) ^ (fr & 7)) * 8));
#pragma unroll
      for (int mi = 0; mi < 4; mi++)
#pragma unroll
        for (int ni = 0; ni < NI; ni++)
          acc[mi][ni] = __builtin_amdgcn_mfma_f32_16x16x32_bf16(af[mi], bf[ni], acc[mi][ni], 0, 0, 0);
    }
  }
  __syncthreads();
#undef GL_FETCH
#undef GL_STORE
}


struct ADma { const u16* base; int ld; int row0; int t0; const u16* zero; int mode; const char* wsb; };
constexpr int G3_STAGE = 12288;

template <int NI, bool SWAP = true>
__device__ __forceinline__ void gemm3(f32x4 (&acc)[8][NI], const ADma& a, const u16* __restrict__ Bt, int ldb, int n0, int K,
                                      char* smem, const int tid) {
  const int lane = tid & 63, wave = tid >> 6;
  const int wr = wave >> 1, wc = wave & 1, fr = lane & 15, fq = lane >> 4;
  const int kc8 = ((lane & 3) ^ ((4 - (lane >> 4)) & 3)) * 8;
  const int psw = (fq ^ ((4 - (fr >> 2)) & 3)) * 8;
  u16* sm = (u16*)smem;
  const u16* ap0 = nullptr;
  unsigned ao0 = 0, ao1 = 0, ao2 = 0, ao3 = 0;
  if (a.mode == 0) {
    ap0 = a.base + (size_t)(a.row0 + wave * 64 + (lane >> 2)) * a.ld + kc8;
  } else {
    const unsigned bo = (unsigned)((const char*)a.base - a.wsb), zo = (unsigned)((const char*)a.zero - a.wsb) + kc8 * 2;
#define G3_AP(j)                                                                          \
    {                                                                                     \
      int t = a.t0 + wave * 64 + j * 16 + (lane >> 2);                                    \
      ao##j = (t >= 0 && t < T_) ? bo + (unsigned)(((a.row0 + t) * a.ld + kc8) * 2) : zo; \
    }
    REP4(G3_AP)
#undef G3_AP
  }
  const u16* bp0 = Bt + (size_t)(n0 + wave * (8 * NI) + (lane >> 2)) * ldb + kc8;
  const size_t astep = (size_t)16 * a.ld;
  const size_t bstep = (size_t)16 * ldb;
#define G3_ISSUE(j)                                                                                                              \
  __builtin_amdgcn_global_load_lds((a.mode == 0) ? (const unsigned*)(ap0 + j * astep + kof) : (const unsigned*)(a.wsb + ao##j + kof * 2), (unsigned*)(st_ + (wave * 64 + j * 16) * 32 + lane * 8), 16, 0, 0); \
  if (2 * j < NI) __builtin_amdgcn_global_load_lds((const unsigned*)(bp0 + j * bstep + kof), (unsigned*)(st_ + 8192 + (wave * (8 * NI) + j * 16) * 32 + lane * 8), 16, 0, 0);
  const int nk = K / 32;
  {
    const int kof = 0;
    u16* st_ = sm;
    REP4(G3_ISSUE)
  }
  if (nk > 1) {
    const int kof = 32;
    u16* st_ = sm + G3_STAGE;
    REP4(G3_ISSUE)
  }
  int cur = 0, nxt = 2;
  const unsigned lds0 = (unsigned)(size_t)(__attribute__((address_space(3))) char*)smem;
  const unsigned aoff = lds0 + (unsigned)(((wr * 128 + fr) * 32 + psw) * 2);
  const unsigned boff = lds0 + 16384u + (unsigned)(((wc * (NI * 16) + fr) * 32 + psw) * 2);
#define G3_DSR(dst, addr, off) asm volatile("ds_read_b128 %0, %1 offset:" #off : "=v"(dst) : "v"(addr))
  for (int kt = 0; kt < nk; kt++) {
    if (kt + 1 < nk) {
      if (NI == 4) asm volatile("s_waitcnt vmcnt(6)" ::: "memory");
      else asm volatile("s_waitcnt vmcnt(5)" ::: "memory");
    } else {
      asm volatile("s_waitcnt vmcnt(0)" ::: "memory");
    }
    __builtin_amdgcn_s_barrier();
    if (kt + 2 < nk) {
      const int kof = (kt + 2) * 32;
      u16* st_ = sm + nxt * G3_STAGE;
      REP4(G3_ISSUE)
    }
    const unsigned aaddr = aoff + (unsigned)cur * (G3_STAGE * 2);
    const unsigned baddr = boff + (unsigned)cur * (G3_STAGE * 2);
    bf16x8 af[8], bf[NI];
    G3_DSR(af[0], aaddr, 0); G3_DSR(af[1], aaddr, 1024); G3_DSR(af[2], aaddr, 2048); G3_DSR(af[3], aaddr, 3072);
    G3_DSR(bf[0], baddr, 0); G3_DSR(bf[1], baddr, 1024);
    if (NI == 4) { G3_DSR(bf[NI - 2], baddr, 2048); G3_DSR(bf[NI - 1], baddr, 3072); }
    G3_DSR(af[4], aaddr, 4096); G3_DSR(af[5], aaddr, 5120); G3_DSR(af[6], aaddr, 6144); G3_DSR(af[7], aaddr, 7168);
    if (NI == 4) {
      asm volatile("s_waitcnt lgkmcnt(4)"
                   : "+v"(af[0]), "+v"(af[1]), "+v"(af[2]), "+v"(af[3]), "+v"(bf[0]), "+v"(bf[1]), "+v"(bf[NI - 2]), "+v"(bf[NI - 1]));
    } else {
      asm volatile("s_waitcnt lgkmcnt(4)" : "+v"(af[0]), "+v"(af[1]), "+v"(af[2]), "+v"(af[3]), "+v"(bf[0]), "+v"(bf[1]));
    }
#pragma unroll
    for (int mi = 0; mi < 4; mi++)
#pragma unroll
      for (int ni = 0; ni < NI; ni++)
        acc[mi][ni] = SWAP ? __builtin_amdgcn_mfma_f32_16x16x32_bf16(bf[ni], af[mi], acc[mi][ni], 0, 0, 0)
                           : __builtin_amdgcn_mfma_f32_16x16x32_bf16(af[mi], bf[ni], acc[mi][ni], 0, 0, 0);
    asm volatile("s_waitcnt lgkmcnt(0)" : "+v"(af[4]), "+v"(af[5]), "+v"(af[6]), "+v"(af[7]));
#pragma unroll
    for (int mi = 4; mi < 8; mi++)
#pragma unroll
      for (int ni = 0; ni < NI; ni++)
        acc[mi][ni] = SWAP ? __builtin_amdgcn_mfma_f32_16x16x32_bf16(bf[ni], af[mi], acc[mi][ni], 0, 0, 0)
                           : __builtin_amdgcn_mfma_f32_16x16x32_bf16(af[mi], bf[ni], acc[mi][ni], 0, 0, 0);
    cur = (cur == 2) ? 0 : cur + 1;
    nxt = (nxt == 2) ? 0 : nxt + 1;
  }
  asm volatile("s_waitcnt lgkmcnt(0)" ::: "memory");
  __syncthreads();
#undef G3_DSR
#undef G3_ISSUE
}

template <int NI>
__device__ __forceinline__ void zero_acc8(f32x4 (&acc)[8][NI]) {
#pragma unroll
  for (int i = 0; i < 8; i++)
#pragma unroll
    for (int j = 0; j < NI; j++) acc[i][j] = f32x4{0.f, 0.f, 0.f, 0.f};
}


__device__ __forceinline__ bool map_tile(int i, int nblk, int MT, int NT, int& mt, int& nt) {
  const int locs = nblk >> 3;
  const int xcd = blockIdx.x & 7, loc = blockIdx.x >> 3;
  const int q = (i * 8 + xcd) * locs + loc;
  if (q >= MT * NT) return false;
  const int nfull = NT >> 3, per = MT * 8;
  if (q < nfull * per) {
    int pp = q / per, r = q - pp * per;
    mt = r >> 3;
    nt = pp * 8 + (r & 7);
  } else {
    int r = q - nfull * per;
    int w = NT - nfull * 8;
    mt = r / w;
    nt = nfull * 8 + (r - mt * w);
  }
  return true;
}

#define ACC_COORDS const int wr = wave >> 1, wc = wave & 1, fr = lane & 15, fq = lane >> 4;

__device__ __forceinline__ void conv_tile(const Params& p, int t, char* smem, const int tid) {
  int j = 0;
#pragma unroll 1
  for (int i = 1; i < 26; i++)
    if (t >= p.jobs[i].tile0) j = i;
  const Job& jb = p.jobs[j];
  float(*tile)[65] = (float(*)[65])smem;
  int local = t - jb.tile0;
  int nkt = jb.Kpad >> 6;
  int kt = local % nkt, nt = local / nkt;
  int tx = tid & 63, ty = tid >> 6;
  int n = nt * 64 + tx;
  int col;
  if (jb.mode == 0) col = jb.c0 + n;
  else { int jn = n >> 7, i = n & 127; col = (i < 64) ? (64 * jn + i) : (DFF_ + 64 * jn + (i - 64)); }
  const float* sp = jb.src + col;
  const int K = jb.K, ld = jb.ld;
  const bool nok = n < jb.Nv;
#pragma unroll
  for (int i = 0; i < 16; i++) {
    int k = kt * 64 + ty + 4 * i;
    tile[ty + 4 * i][tx] = (nok && k < K) ? sp[(size_t)k * ld] : 0.f;
  }
  __syncthreads();
#pragma unroll
  for (int i = 0; i < 16; i++) {
    int nn = nt * 64 + ty + 4 * i;
    int k = kt * 64 + tx;
    jb.dst[(size_t)nn * jb.Kpad + k] = f2bf(tile[tx][ty + 4 * i]);
  }
  __syncthreads();
}

__device__ __forceinline__ void ln_row(const float* __restrict__ src, const float* __restrict__ g,
                                       const float* __restrict__ b, float* __restrict__ dst, int lane, u16* __restrict__ dstb = nullptr) {
  float4 v[4];
  float s = 0.f;
#pragma unroll
  for (int i = 0; i < 4; i++) {
    v[i] = *(const float4*)(src + i * 256 + lane * 4);
    s += v[i].x + v[i].y + v[i].z + v[i].w;
  }
  float mean = wave_sum(s, lane) * (1.0f / 1024.0f);
  float q = 0.f;
#pragma unroll
  for (int i = 0; i < 4; i++) {
    float a = v[i].x - mean, b2 = v[i].y - mean, c = v[i].z - mean, d = v[i].w - mean;
    q += a * a + b2 * b2 + c * c + d * d;
  }
  float rstd = rsqrtf(wave_sum(q, lane) * (1.0f / 1024.0f) + 1e-5f);
#pragma unroll
  for (int i = 0; i < 4; i++) {
    float4 gg = *(const float4*)(g + i * 256 + lane * 4);
    float4 bb = *(const float4*)(b + i * 256 + lane * 4);
    float4 o;
    o.x = (v[i].x - mean) * rstd * gg.x + bb.x;
    o.y = (v[i].y - mean) * rstd * gg.y + bb.y;
    o.z = (v[i].z - mean) * rstd * gg.z + bb.z;
    o.w = (v[i].w - mean) * rstd * gg.w + bb.w;
    *(float4*)(dst + i * 256 + lane * 4) = o;
    if (dstb) *(uint2*)(dstb + i * 256 + lane * 4) = make_uint2(pk2(o.x, o.y), pk2(o.z, o.w));
  }
}

__device__ __forceinline__ void ln_row2(const float* __restrict__ srcA, const float* __restrict__ srcB, const float* __restrict__ g,
                                        const float* __restrict__ b, float* dstA, float* dstB, int lane, u16* dbA, u16* dbB) {
  float4 va[4], vb[4];
  float sa = 0.f, sb = 0.f;
#pragma unroll
  for (int i = 0; i < 4; i++) {
    va[i] = *(const float4*)(srcA + i * 256 + lane * 4);
    vb[i] = *(const float4*)(srcB + i * 256 + lane * 4);
  }
#pragma unroll
  for (int i = 0; i < 4; i++) {
    sa += va[i].x + va[i].y + va[i].z + va[i].w;
    sb += vb[i].x + vb[i].y + vb[i].z + vb[i].w;
  }
  const float ma = wave_sum(sa, lane) * (1.0f / 1024.0f), mb = wave_sum(sb, lane) * (1.0f / 1024.0f);
  float qa = 0.f, qb = 0.f;
#pragma unroll
  for (int i = 0; i < 4; i++) {
    va[i].x -= ma; va[i].y -= ma; va[i].z -= ma; va[i].w -= ma;
    vb[i].x -= mb; vb[i].y -= mb; vb[i].z -= mb; vb[i].w -= mb;
    qa += va[i].x * va[i].x + va[i].y * va[i].y + va[i].z * va[i].z + va[i].w * va[i].w;
    qb += vb[i].x * vb[i].x + vb[i].y * vb[i].y + vb[i].z * vb[i].z + vb[i].w * vb[i].w;
  }
  const float ra = rsqrtf(wave_sum(qa, lane) * (1.0f / 1024.0f) + 1e-5f), rb = rsqrtf(wave_sum(qb, lane) * (1.0f / 1024.0f) + 1e-5f);
#pragma unroll
  for (int i = 0; i < 4; i++) {
    float4 gg = *(const float4*)(g + i * 256 + lane * 4);
    float4 bb = *(const float4*)(b + i * 256 + lane * 4);
    float4 oa, ob;
    oa.x = va[i].x * ra * gg.x + bb.x; oa.y = va[i].y * ra * gg.y + bb.y; oa.z = va[i].z * ra * gg.z + bb.z; oa.w = va[i].w * ra * gg.w + bb.w;
    ob.x = vb[i].x * rb * gg.x + bb.x; ob.y = vb[i].y * rb * gg.y + bb.y; ob.z = vb[i].z * rb * gg.z + bb.z; ob.w = vb[i].w * rb * gg.w + bb.w;
    *(float4*)(dstA + i * 256 + lane * 4) = oa;
    *(float4*)(dstB + i * 256 + lane * 4) = ob;
    if (dbA) {
      *(uint2*)(dbA + i * 256 + lane * 4) = make_uint2(pk2(oa.x, oa.y), pk2(oa.z, oa.w));
      *(uint2*)(dbB + i * 256 + lane * 4) = make_uint2(pk2(ob.x, ob.y), pk2(ob.z, ob.w));
    }
  }
}

struct ScanIn {
  float kk[16][64], wr[16][64], w[16][64], kt[16][64], kka[16][64], v[16][64], g[16][64];
  float c[16][4];
};
struct ScanRaw { uint2 r, k, v, rp, kp, vp, a, g; float4 dec; };

__device__ __forceinline__ ScanRaw scan_fetch(const u16* __restrict__ P, const float* __restrict__ DEC,
                                              const u16* __restrict__ AA, const u16* __restrict__ GG, int rowbase, int t,
                                              int hc) {
  ScanRaw w;
  size_t row = (size_t)(rowbase + t);
  const u16* pp = P + row * PC_ + hc;
  w.r = *(const uint2*)(pp);
  w.k = *(const uint2*)(pp + 512);
  w.v = *(const uint2*)(pp + 1024);
  if (t > 0) {
    w.rp = *(const uint2*)(pp - PC_);
    w.kp = *(const uint2*)(pp - PC_ + 512);
    w.vp = *(const uint2*)(pp - PC_ + 1024);
  } else {
    w.rp = make_uint2(0, 0); w.kp = make_uint2(0, 0); w.vp = make_uint2(0, 0);
  }
  w.dec = *(const float4*)(DEC + row * 512 + hc);
  w.a = *(const uint2*)(AA + row * 512 + hc);
  w.g = *(const uint2*)(GG + row * 512 + hc);
  return w;
}

__device__ __forceinline__ void unpack4(uint2 u, float (&o)[4]) {
  o[0] = bflo(u.x); o[1] = bfhi(u.x); o[2] = bflo(u.y); o[3] = bfhi(u.y);
}

__device__ __forceinline__ void scan_unit(const Params& p, int l, int bh, char* smem, const int tid) {
  const int lane = tid & 63, wave = tid >> 6;
  const int b = bh >> 3, h = bh & 7;
  const int rowbase = b * T_;
  const u16* P = (const u16*)(p.ws + OFF_P);
  const float* DEC = (const float*)(p.ws + OFF_DEC);
  const u16* AA = (const u16*)(p.ws + OFF_AA);
  const u16* GG = (const u16*)(p.ws + OFF_GG);
  u16* YR = (u16*)(p.ws + OFF_AA);
  ScanIn* in = (ScanIn*)smem;
  float(*ybuf)[64] = (float(*)[64])(smem + 2 * sizeof(ScanIn));
  const int tl = tid >> 4, kq = tid & 15, hc = h * 64 + kq * 4;
  float(*cst)[64] = (float(*)[64])(smem + 2 * sizeof(ScanIn) + 16 * 64 * 4);
  if (tid < 64) {
    const float* mu = p.in[5] + (size_t)l * 1824;
    const int ch = h * 64 + tid;
    cst[0][tid] = mu[ch];
    cst[1][tid] = mu[512 + ch];
    cst[2][tid] = mu[1024 + ch];
    cst[3][tid] = p.in[11][l * 512 + ch];
    float ka_ = p.in[12][l * 512 + ch];
    cst[4][tid] = ka_;
    cst[5][tid] = 1.0f - ka_;
    cst[6][tid] = p.in[13][l * 512 + ch];
    cst[7][tid] = p.in[14][l * 512 + ch];
    cst[8][tid] = p.in[15][l * 512 + ch];
  }
  __syncthreads();
  const int rp = lane >> 3, ks = lane & 7, row0 = wave * 16 + rp * 2;
  typedef float f2s __attribute__((ext_vector_type(2)));
  f2s S2[2][4];
#pragma unroll
  for (int i = 0; i < 2; i++)
#pragma unroll
    for (int e = 0; e < 4; e++) S2[i][e] = f2s{0.f, 0.f};

  auto stage = [&](const ScanRaw& w, ScanIn& dst) {
    float r[4], k[4], v[4], rq[4], kp[4], vp[4], a[4], g[4];
    unpack4(w.r, r); unpack4(w.k, k); unpack4(w.v, v);
    unpack4(w.rp, rq); unpack4(w.kp, kp); unpack4(w.vp, vp);
    unpack4(w.a, a); unpack4(w.g, g);
    float dec[4] = {w.dec.x, w.dec.y, w.dec.z, w.dec.w};
    float mu_r[4], mu_k[4], mu_v[4], kkw[4], kaw[4], omk[4], rkw[4];
    *(float4*)mu_r = *(const float4*)&cst[0][kq * 4]; *(float4*)mu_k = *(const float4*)&cst[1][kq * 4];
    *(float4*)mu_v = *(const float4*)&cst[2][kq * 4]; *(float4*)kkw = *(const float4*)&cst[3][kq * 4];
    *(float4*)kaw = *(const float4*)&cst[4][kq * 4]; *(float4*)omk = *(const float4*)&cst[5][kq * 4];
    *(float4*)rkw = *(const float4*)&cst[6][kq * 4];
    float kkr[4], ss = 0.f;
#pragma unroll
    for (int e = 0; e < 4; e++) {
      r[e] = r[e] + (rq[e] - r[e]) * mu_r[e];
      k[e] = k[e] + (kp[e] - k[e]) * mu_k[e];
      v[e] = v[e] + (vp[e] - v[e]) * mu_v[e];
      kkr[e] = k[e] * kkw[e];
      ss += kkr[e] * kkr[e];
    }
    ss = sum16(ss);
    float inv = rsqrtf(fmaxf(ss, 1e-24f));
    float c1 = 0.f, c2 = 0.f, c3 = 0.f;
    float kk[4], ktl[4], kka[4], wr[4];
#pragma unroll
    for (int e = 0; e < 4; e++) {
      kk[e] = kkr[e] * inv;
      ktl[e] = k[e] * fmaf(a[e], kaw[e], omk[e]);
      kka[e] = kk[e] * a[e];
      wr[e] = dec[e] * r[e];
      c1 += kka[e] * r[e];
      c2 += ktl[e] * r[e];
      c3 += r[e] * ktl[e] * rkw[e];
    }
    c1 = sum16(c1); c2 = sum16(c2); c3 = sum16(c3);
    *(float4*)&dst.kk[tl][kq * 4] = make_float4(kk[0], kk[1], kk[2], kk[3]);
    *(float4*)&dst.wr[tl][kq * 4] = make_float4(wr[0], wr[1], wr[2], wr[3]);
    *(float4*)&dst.w[tl][kq * 4] = make_float4(dec[0], dec[1], dec[2], dec[3]);
    *(float4*)&dst.kt[tl][kq * 4] = make_float4(ktl[0], ktl[1], ktl[2], ktl[3]);
    *(float4*)&dst.kka[tl][kq * 4] = make_float4(kka[0], kka[1], kka[2], kka[3]);
    *(float4*)&dst.v[tl][kq * 4] = make_float4(v[0], v[1], v[2], v[3]);
    *(float4*)&dst.g[tl][kq * 4] = make_float4(g[0], g[1], g[2], g[3]);
    if (kq == 0) *(float4*)&dst.c[tl][0] = make_float4(c1, c2, c3, 0.f);
  };

  {
    ScanRaw w0 = scan_fetch(P, DEC, AA, GG, rowbase, tl, hc);
    stage(w0, in[0]);
  }
  __syncthreads();
  constexpr int NCH = T_ / 16;
  for (int c = 0; c < NCH; c++) {
    ScanIn& cur = in[c & 1];
    ScanRaw nx;
    const bool have_next = (c + 1 < NCH);
    if (have_next) nx = scan_fetch(P, DEC, AA, GG, rowbase, (c + 1) * 16 + tl, hc);
    {
      typedef float f2 __attribute__((ext_vector_type(2)));
      struct StepA { float4 kk0, kk1, wr0, wr1; };
      struct StepIn { float4 kk0, kk1, wr0, wr1, w0, w1, kt0, kt1, ka0, ka1; float2 vv, cc; };
      auto ldA = [&](int s) {
        StepA r;
        r.kk0 = *(const float4*)&cur.kk[s][ks * 8]; r.kk1 = *(const float4*)&cur.kk[s][ks * 8 + 4];
        r.wr0 = *(const float4*)&cur.wr[s][ks * 8]; r.wr1 = *(const float4*)&cur.wr[s][ks * 8 + 4];
        return r;
      };
      StepA nxa = ldA(0);
#pragma unroll 1
      for (int s4 = 0; s4 < 16; s4 += 4) {
      float yv[4][2];
#pragma unroll
      for (int u = 0; u < 4; u++) {
        const int s = s4 + u;
        StepIn in_;
        in_.kk0 = nxa.kk0; in_.kk1 = nxa.kk1; in_.wr0 = nxa.wr0; in_.wr1 = nxa.wr1;
        in_.vv = *(const float2*)&cur.v[s][row0];
        in_.cc = *(const float2*)&cur.c[s][0];
        in_.w0 = *(const float4*)&cur.w[s][ks * 8];   in_.w1 = *(const float4*)&cur.w[s][ks * 8 + 4];
        in_.kt0 = *(const float4*)&cur.kt[s][ks * 8]; in_.kt1 = *(const float4*)&cur.kt[s][ks * 8 + 4];
        in_.ka0 = *(const float4*)&cur.kka[s][ks * 8]; in_.ka1 = *(const float4*)&cur.kka[s][ks * 8 + 4];
        nxa = ldA((s + 1) & 15);
        const f2 kk[4] = {{in_.kk0.x, in_.kk0.y}, {in_.kk0.z, in_.kk0.w}, {in_.kk1.x, in_.kk1.y}, {in_.kk1.z, in_.kk1.w}};
        const f2 wr[4] = {{in_.wr0.x, in_.wr0.y}, {in_.wr0.z, in_.wr0.w}, {in_.wr1.x, in_.wr1.y}, {in_.wr1.z, in_.wr1.w}};
        const f2 w[4] = {{in_.w0.x, in_.w0.y}, {in_.w0.z, in_.w0.w}, {in_.w1.x, in_.w1.y}, {in_.w1.z, in_.w1.w}};
        const f2 kt[4] = {{in_.kt0.x, in_.kt0.y}, {in_.kt0.z, in_.kt0.w}, {in_.kt1.x, in_.kt1.y}, {in_.kt1.z, in_.kt1.w}};
        const f2 ka[4] = {{in_.ka0.x, in_.ka0.y}, {in_.ka0.z, in_.ka0.w}, {in_.ka1.x, in_.ka1.y}, {in_.ka1.z, in_.ka1.w}};
        const float vr[2] = {in_.vv.x, in_.vv.y};
        float d1[2], d2[2];
#pragma unroll
        for (int i = 0; i < 2; i++) {
          f2 a = S2[i][0] * kk[0] + S2[i][1] * kk[1];
          f2 a2 = S2[i][2] * kk[2] + S2[i][3] * kk[3];
          f2 bq = S2[i][0] * wr[0] + S2[i][1] * wr[1];
          f2 b2 = S2[i][2] * wr[2] + S2[i][3] * wr[3];
          a += a2; bq += b2;
          d1[i] = a.x + a.y;
          d2[i] = bq.x + bq.y;
        }
        d1[0] = sum8(d1[0]); d1[1] = sum8(d1[1]); d2[0] = sum8(d2[0]); d2[1] = sum8(d2[1]);
#pragma unroll
        for (int i = 0; i < 2; i++) {
          const float skk = d1[i];
          yv[u][i] = d2[i] - skk * in_.cc.x + vr[i] * in_.cc.y;
          const f2 nsk = {-skk, -skk}, vv2 = {vr[i], vr[i]};
#pragma unroll
          for (int e = 0; e < 4; e++) S2[i][e] = S2[i][e] * w[e] + (nsk * ka[e] + vv2 * kt[e]);
        }
      }
      if (ks == 0) {
#pragma unroll
        for (int u = 0; u < 4; u++) *(float2*)&ybuf[s4 + u][row0] = make_float2(yv[u][0], yv[u][1]);
      }
      }
    }
    __syncthreads();
    {
      float4 y4 = *(const float4*)&ybuf[tl][kq * 4];
      float y[4] = {y4.x, y4.y, y4.z, y4.w};
      float mean = sum16(y[0] + y[1] + y[2] + y[3]) * (1.0f / 64.0f);
      float q = 0.f;
#pragma unroll
      for (int e = 0; e < 4; e++) { y[e] -= mean; q += y[e] * y[e]; }
      float rstd = rsqrtf(sum16(q) * (1.0f / 64.0f) + 64e-5f);
      float c3 = cur.c[tl][2];
      float4 v4 = *(const float4*)&cur.v[tl][kq * 4];
      float4 g4 = *(const float4*)&cur.g[tl][kq * 4];
      float vv[4] = {v4.x, v4.y, v4.z, v4.w};
      float gg[4] = {g4.x, g4.y, g4.z, g4.w};
      float o[4], lg[4], lb[4];
      *(float4*)lg = *(const float4*)&cst[7][kq * 4]; *(float4*)lb = *(const float4*)&cst[8][kq * 4];
#pragma unroll
      for (int e = 0; e < 4; e++) o[e] = (y[e] * rstd * lg[e] + lb[e] + c3 * vv[e]) * gg[e];
      size_t row = (size_t)(rowbase + c * 16 + tl);
      *(uint2*)(YR + row * 512 + hc) = make_uint2(pk2(o[0], o[1]), pk2(o[2], o[3]));
    }
    if (have_next) stage(nx, in[(c + 1) & 1]);
    __syncthreads();
  }
}

constexpr int KLD = 104, VLD = 72;
struct AttnSmem { u16 k[2][64 * KLD]; u16 v[2][64 * VLD]; };

__device__ __forceinline__ void attn_unit(const Params& p, int bh, int qi, char* smem, const int tid) {
  const int lane = tid & 63, wave = tid >> 6;
  const int fr = lane & 15, fq = lane >> 4;
  const int b = bh >> 3, h = bh & 7;
  const int rowbase = b * T_;
  u16* P = (u16*)(p.ws + OFF_P);
  const u16* Q = (const u16*)(p.ws + OFF_Q);
  const u16* KN = (const u16*)p.out;
  const u16* VT = (const u16*)p.out + (size_t)M_ * 512;
  const float2* ROPE = (const float2*)(p.ws + OFF_ROPE);
  AttnSmem* sm = (AttnSmem*)smem;
  const int qs = (qi == 0) ? 0 : 16 + (qi - 1) * 128;
  const int qn = (qi == 0) ? 16 : 128;
  const int q0 = qs + wave * 32;
  const bool wave_valid = (wave * 32 < qn);
  const int nkt = (qs + qn - 1) / 64 + 1;

  bf16x8 qf[2][3];
#pragma unroll
  for (int qb = 0; qb < 2; qb++) {
    int query = min(q0 + qb * 16 + fr, T_ - 1);
    const u16* qp = Q + (size_t)(rowbase + query) * 768 + h * 96;
    uint4 a0 = *(const uint4*)(qp + fq * 8);
    uint4 a1 = *(const uint4*)(qp + 32 + fq * 8);
    uint4 own = *(const uint4*)(qp + 64 + fq * 8);
    uint4 oth = *(const uint4*)(qp + 64 + (fq ^ 2) * 8);
    unsigned ow[4] = {own.x, own.y, own.z, own.w};
    unsigned tw[4] = {oth.x, oth.y, oth.z, oth.w};
    unsigned rw[4];
    const float2* rp = ROPE + (size_t)query * 16 + (fq & 1) * 8;
#pragma unroll
    for (int e = 0; e < 4; e++) {
      float2 cs0 = rp[2 * e], cs1 = rp[2 * e + 1];
      float o0 = bflo(ow[e]), o1 = bfhi(ow[e]);
      float t0 = bflo(tw[e]), t1 = bfhi(tw[e]);
      float r0, r1;
      if (fq < 2) { r0 = o0 * cs0.x - t0 * cs0.y; r1 = o1 * cs1.x - t1 * cs1.y; }
      else { r0 = t0 * cs0.y + o0 * cs0.x; r1 = t1 * cs1.y + o1 * cs1.x; }
      rw[e] = pk2(r0, r1);
    }
    uint4 a2 = make_uint4(rw[0], rw[1], rw[2], rw[3]);
    qf[qb][0] = *(bf16x8*)&a0;
    qf[qb][1] = *(bf16x8*)&a1;
    qf[qb][2] = *(bf16x8*)&a2;
  }

  f32x4 O[4][2];
#pragma unroll
  for (int i = 0; i < 4; i++)
#pragma unroll
    for (int j = 0; j < 2; j++) O[i][j] = f32x4{0.f, 0.f, 0.f, 0.f};
  float mrun[2] = {-1e30f, -1e30f}, lrun[2] = {0.f, 0.f};
  const float sc = 1.4426950408889634f / 9.797958971132712f;

  uint4 rk[3], rv[2];
  auto fetch_tile = [&](int kt) {
#pragma unroll
    for (int i = 0; i < 3; i++) {
      int c = tid + 256 * i;
      int key = c / 12, cc = c % 12;
      int t = kt * 64 + key;
      uint4 val = make_uint4(0, 0, 0, 0);
      if (t < T_) {
        size_t row = (size_t)(rowbase + t);
        if (cc < 8) val = *(const uint4*)(KN + row * 512 + h * 64 + cc * 8);
        else val = *(const uint4*)(P + row * PC_ + PKR_ + (cc - 8) * 8);
      }
      rk[i] = val;
    }
#pragma unroll
    for (int i = 0; i < 2; i++) {
      int c = tid + 256 * i;
      int dv = c >> 3, cc = c & 7;
      int t = kt * 64 + cc * 8;
      uint4 val = make_uint4(0, 0, 0, 0);
      if (t < T_) val = *(const uint4*)(VT + ((size_t)bh * 64 + dv) * T_ + t);
      rv[i] = val;
    }
  };
  auto store_tile = [&](int buf) {
#pragma unroll
    for (int i = 0; i < 3; i++) {
      int c = tid + 256 * i;
      int key = c / 12, cc = c % 12;
      *(uint4*)(&sm->k[buf][key * KLD + cc * 8]) = rk[i];
    }
#pragma unroll
    for (int i = 0; i < 2; i++) {
      int c = tid + 256 * i;
      int dv = c >> 3, cc = c & 7;
      *(uint4*)(&sm->v[buf][dv * VLD + cc * 8]) = rv[i];
    }
  };

  fetch_tile(0);
  for (int kt = 0; kt < nkt; kt++) {
    const int buf = kt & 1;
    store_tile(buf);
    __syncthreads();
    if (kt + 1 < nkt) fetch_tile(kt + 1);
    if (wave_valid && kt * 64 <= q0 + 31) {
      const u16* Ks = sm->k[buf];
      const u16* Vs = sm->v[buf];
      f32x4 s[4][2];
#pragma unroll
      for (int i = 0; i < 4; i++)
#pragma unroll
        for (int j = 0; j < 2; j++) s[i][j] = f32x4{0.f, 0.f, 0.f, 0.f};
#pragma unroll
      for (int ks = 0; ks < 3; ks++)
#pragma unroll
        for (int kb = 0; kb < 4; kb++) {
          bf16x8 kf = *(const bf16x8*)(Ks + (kb * 16 + fr) * KLD + ks * 32 + fq * 8);
#pragma unroll
          for (int qb = 0; qb < 2; qb++) s[kb][qb] = __builtin_amdgcn_mfma_f32_16x16x32_bf16(kf, qf[qb][ks], s[kb][qb], 0, 0, 0);
        }
      const bool need_mask = (kt * 64 + 63 > q0);
      unsigned pfw[2][2][4];
#pragma unroll
      for (int qb = 0; qb < 2; qb++) {
        const int query = q0 + qb * 16 + fr;
        float mx = -1e30f;
        if (need_mask) {
#pragma unroll
          for (int kb = 0; kb < 4; kb++)
#pragma unroll
            for (int j = 0; j < 4; j++) {
              int key = kt * 64 + kb * 16 + fq * 4 + j;
              if (key > query) s[kb][qb][j] = -1e30f;
            }
        }
#pragma unroll
        for (int kb = 0; kb < 4; kb++)
          mx = fmaxf(mx, fmaxf(fmaxf(s[kb][qb][0], s[kb][qb][1]), fmaxf(s[kb][qb][2], s[kb][qb][3])));
        mx = fmaxf(mx, shx(mx, lane, 16));
        mx = fmaxf(mx, shx(mx, lane, 32));
        const float mold = mrun[qb];
        const float mnew = fmaxf(mold, mx * sc);
        mrun[qb] = mnew;
        float ps = 0.f;
#pragma unroll
        for (int kb = 0; kb < 4; kb++) {
          float p0 = __builtin_amdgcn_exp2f(fmaf(s[kb][qb][0], sc, -mnew)), p1 = __builtin_amdgcn_exp2f(fmaf(s[kb][qb][1], sc, -mnew));
          float p2 = __builtin_amdgcn_exp2f(fmaf(s[kb][qb][2], sc, -mnew)), p3 = __builtin_amdgcn_exp2f(fmaf(s[kb][qb][3], sc, -mnew));
          ps += (p0 + p1) + (p2 + p3);
          pfw[qb][kb >> 1][(kb & 1) * 2 + 0] = pk2(p0, p1);
          pfw[qb][kb >> 1][(kb & 1) * 2 + 1] = pk2(p2, p3);
        }
        if (__builtin_amdgcn_ballot_w64(mnew != mold) != 0) {
          const float alpha = __builtin_amdgcn_exp2f(mold - mnew);
          lrun[qb] *= alpha;
#pragma unroll
          for (int dvb = 0; dvb < 4; dvb++) {
            O[dvb][qb][0] *= alpha; O[dvb][qb][1] *= alpha; O[dvb][qb][2] *= alpha; O[dvb][qb][3] *= alpha;
          }
        }
        lrun[qb] += ps;
      }
#pragma unroll
      for (int s2 = 0; s2 < 2; s2++)
#pragma unroll
        for (int dvb = 0; dvb < 4; dvb++) {
          const u16* vp = Vs + (dvb * 16 + fr) * VLD + s2 * 32 + fq * 4;
          uint2 v0 = *(const uint2*)vp;
          uint2 v1 = *(const uint2*)(vp + 16);
          uint4 vv = make_uint4(v0.x, v0.y, v1.x, v1.y);
          bf16x8 vf = *(bf16x8*)&vv;
#pragma unroll
          for (int qb = 0; qb < 2; qb++) {
            uint4 pw = make_uint4(pfw[qb][s2][0], pfw[qb][s2][1], pfw[qb][s2][2], pfw[qb][s2][3]);
            O[dvb][qb] = __builtin_amdgcn_mfma_f32_16x16x32_bf16(vf, *(bf16x8*)&pw, O[dvb][qb], 0, 0, 0);
          }
        }
    }
  }
  __syncthreads();
  if (wave_valid) {
#pragma unroll
    for (int qb = 0; qb < 2; qb++) {
      float l = lrun[qb];
      l += shx(l, lane, 16);
      l += shx(l, lane, 32);
      float inv = 1.0f / l;
      int query = q0 + qb * 16 + fr;
      if (query < qs + qn) {
        u16* op = P + (size_t)(rowbase + query) * PC_ + PMLA_ + h * 64 + fq * 4;
#pragma unroll
        for (int dvb = 0; dvb < 4; dvb++) {
          *(uint2*)(op + dvb * 16) =
              make_uint2(pk2(O[dvb][qb][0] * inv, O[dvb][qb][1] * inv), pk2(O[dvb][qb][2] * inv, O[dvb][qb][3] * inv));
        }
      }
    }
  }
}

#define XB_TMO      128
#define XB_XCNT(j)  (256  + 64 * (j))
#define XB_XSUB(j)  (1280 + 64 * (j))
#define XB_XGEN(j)  (2304 + 64 * (j))
#define XB_TOP      3328
#define XB_TOPGEN   3392
#define XCD_BAR_WORDS 3456
#define XB_SPIN_CAP (1u << 18)
#define LAS __attribute__((address_space(3)))

__device__ __forceinline__ unsigned xb_ld(unsigned* p)              { return __hip_atomic_load(p, __ATOMIC_RELAXED, __HIP_MEMORY_SCOPE_AGENT); }
__device__ __forceinline__ unsigned xb_add(unsigned* p, unsigned v) { return __hip_atomic_fetch_add(p, v, __ATOMIC_RELAXED, __HIP_MEMORY_SCOPE_AGENT); }
__device__ __forceinline__ unsigned xb_xcc_id() { return (unsigned)__builtin_amdgcn_s_getreg((3 << 11) | 20) & 0xFu; }
#define XB_SPIN(cond, bar) do { unsigned _sp = 0; while (cond) { __builtin_amdgcn_s_sleep(1); \
    if ((++_sp & 255u) == 0u) { if (xb_ld(&(bar)[XB_TMO])) break; if (_sp > XB_SPIN_CAP) { atomicAdd(&(bar)[XB_TMO], 1u); break; } } } } while (0)

struct XcdBarrier {
    unsigned* bar; unsigned x;
    volatile LAS unsigned* st;
};

__device__ __forceinline__ XcdBarrier xcd_barrier_post(unsigned* bar, volatile LAS unsigned* st) {
    XcdBarrier b; b.bar = bar; b.x = xb_xcc_id(); b.st = st;
    if (threadIdx.x == 0) (void)xb_add(&bar[XB_XCNT(b.x)], 1u);
    return b;
}
__device__ __forceinline__ void xcd_barrier_complete(unsigned* bar, unsigned x, unsigned& nloc, unsigned& nx) {
    const unsigned G = gridDim.x * gridDim.y * gridDim.z;
    unsigned sum, cnt, mine, sp = 0u;
    for (;;) {
        sum = 0u; cnt = 0u; mine = 0u;
#pragma unroll
        for (unsigned j = 0; j < 16; ++j) { const unsigned c = xb_ld(&bar[XB_XCNT(j)]); sum += c; cnt += (c > 0u) ? 1u : 0u; mine = (j == x) ? c : mine; }
        if (sum == G) break;
        __builtin_amdgcn_s_sleep(1);
        if ((++sp & 255u) == 0u) { if (xb_ld(&bar[XB_TMO])) break; if (sp > XB_SPIN_CAP) { atomicAdd(&bar[XB_TMO], 1u); break; } }
    }
    nloc = mine > 0u ? mine : 1u; nx = cnt > 0u ? cnt : 1u;
}

__device__ __forceinline__ void xcd_barrier(const XcdBarrier& b, const int tid_) {
    asm volatile("s_waitcnt vmcnt(0)" ::: "memory");
    __syncthreads();
    if (tid_ == 0) {
        unsigned* bar = b.bar;
        __builtin_amdgcn_s_waitcnt(0);
        unsigned nloc = b.st[0], nx = b.st[1];
        if (nloc == 0u) { xcd_barrier_complete(bar, b.x, nloc, nx); b.st[0] = nloc; b.st[1] = nx; }
        const unsigned old = xb_add(&bar[XB_XSUB(b.x)], 1u);
        const unsigned gen = old / nloc;
        if (old + 1u == (gen + 1u) * nloc) {
            __builtin_amdgcn_fence(__ATOMIC_RELEASE, "agent");
            asm volatile("s_waitcnt vmcnt(0)" ::: "memory");
            const unsigned og = xb_add(&bar[XB_TOP], 1u);
            const unsigned tg = og / nx;
            if (og + 1u == (tg + 1u) * nx) xb_add(&bar[XB_TOPGEN], 1u);
            else XB_SPIN(xb_ld(&bar[XB_TOPGEN]) == tg, bar);
            __builtin_amdgcn_fence(__ATOMIC_ACQUIRE, "agent");
            xb_add(&bar[XB_XGEN(b.x)], 1u);
            asm volatile("s_waitcnt vmcnt(0)" ::: "memory");
        } else {
            XB_SPIN(xb_ld(&bar[XB_XGEN(b.x)]) == gen, bar);
            __builtin_amdgcn_fence(__ATOMIC_ACQUIRE, "agent");
            asm volatile("s_waitcnt vmcnt(0)" ::: "memory");
        }
    }
    __syncthreads();
}


__global__ void __launch_bounds__(256, 2) mega(Params p) {
  cg::grid_group grid = cg::this_grid();
  __shared__ __attribute__((aligned(16))) char smem[SMEM_BYTES];
  __shared__ int s_unit;
  __shared__ uint4 xb_words;
  if (threadIdx.x == 0) xb_words = make_uint4(0u, 0u, 0u, 0u);
  __syncthreads();
  (void)xcd_barrier_post((unsigned*)(p.ws + OFF_BAR), (volatile LAS unsigned*)&xb_words);
#define XB_SYNC() do { XcdBarrier xb_; xb_.bar = (unsigned*)(p.ws + OFF_BAR); xb_.x = xb_xcc_id(); xb_.st = (volatile LAS unsigned*)&xb_words; xcd_barrier(xb_, wave0 * 64 + fresh_lane()); } while (0)
  int wave0 = __builtin_amdgcn_readfirstlane((int)(threadIdx.x >> 6));
  asm volatile("" : "+s"(wave0));
  const int nblk = gridDim.x;
#define H ((float*)(p.ws + OFF_H))
#define P ((u16*)(p.ws + OFF_P))
#define DEC ((float*)(p.ws + OFF_DEC))
#define AA ((u16*)(p.ws + OFF_AA))
#define GG ((u16*)(p.ws + OFF_GG))
#define Q ((u16*)(p.ws + OFF_Q))
#define MIX ((u16*)(p.ws + OFF_DEC))
#define HB1 ((u16*)p.out + (size_t)2 * M_ * 512)
#define HB2 ((u16*)(p.ws + OFF_HB2))
#define HBH ((u16*)(p.ws + OFF_AA))
#define ZERO ((const u16*)(p.ws + OFF_ZERO))
#define ACT ((u16*)(p.ws + OFF_P))
#define ROPE ((float2*)(p.ws + OFF_ROPE))
#define CTR ((int*)(p.ws + OFF_CTR))
#define KN ((u16*)p.out)
#define VT ((u16*)p.out + (size_t)M_ * 512)
#define YR ((u16*)(p.ws + OFF_AA))

  {
  PHASE_TID
  for (int t = blockIdx.x; t < p.nconv; t += nblk) conv_tile(p, t, smem, tid);
  for (int i = blockIdx.x * 256 + tid; i < T_ * 16; i += nblk * 256) {
    int t = i >> 4, f = i & 15;
    double rev = (double)t * ROPE_C[f];
    rev -= floor(rev);
    float r = (float)rev;
    ROPE[i] = make_float2(__builtin_amdgcn_cosf(r), __builtin_amdgcn_sinf(r));
  }
  for (int row = (blockIdx.x * 4 + wave) * 2; row < M_; row += nblk * 8) {
    int b = row / T_, t = row % T_;
    const float* srcA = (t < NMETA_) ? (p.in[1] + (size_t)t * 1024) : (p.in[0] + ((size_t)b * SEQ_ + (t - NMETA_)) * 1024);
    u16* hb = (row < HB_SPLIT) ? HB1 + (size_t)row * 1024 : HB2 + (size_t)(row - HB_SPLIT) * 1024;
    ln_row2(srcA, srcA + 1024, p.in[2], p.in[3], H + (size_t)row * 1024, H + (size_t)(row + 1) * 1024, lane, hb, hb + 1024);
  }
  if (blockIdx.x == 0 && tid < 16) CTR[tid] = 0;
  if (blockIdx.x == 1) { for (int i = tid; i < 2048; i += 256) ((unsigned*)(p.ws + OFF_ZERO))[i] = 0u; }
  }
  grid.sync();

#pragma unroll 1
  for (int ph_ = 0; ph_ < 20; ph_++) {
    const int l = ph_ / 10, kph = ph_ - l * 10;
    const u16* WL = (const u16*)(p.ws + OFF_W) + (size_t)l * W_LAYER;
    if (kph == 0) {
    PHASE_TID
    for (int it_ = 0; it_ * nblk < 257 * 19; it_++) {
      int mt, nt;
      if (!map_tile(it_, nblk, 257, 19, mt, nt)) continue;
      f32x4 acc[8][4];
      zero_acc8(acc);
      ADma al = ADma{(mt < 255) ? HB1 : HB2, 1024, (mt < 255) ? mt * 256 : mt * 256 - HB_SPLIT, 0, ZERO, 0};
      gemm3(acc, al, WL + W_IN, 1024, nt * 128, 1024, smem, tid);
      ACC_COORDS
#pragma unroll
      for (int mi = 0; mi < 8; mi++)
#pragma unroll
        for (int ni = 0; ni < 4; ni++) {
          int col = nt * 128 + wc * 64 + ni * 16 + fq * 4;
          int row = mt * 256 + wr * 128 + mi * 16 + fr;
          if (col < PC_)
            *(uint2*)(P + (size_t)row * PC_ + col) = make_uint2(pk2(acc[mi][ni][0], acc[mi][ni][1]), pk2(acc[mi][ni][2], acc[mi][ni][3]));
        }
    }
    }
    if (kph == 1) {
    PHASE_TID
    {
      const float* qg = p.in[16] + l * 256;
      const float* kvg = p.in[18] + l * 256;
      for (int rbase = (blockIdx.x * 4 + wave) * 4; rbase < M_; rbase += nblk * 16) {
        const int row = rbase + (lane >> 4), sl = lane & 15;
        u16* pr = P + (size_t)row * PC_;
        uint4 q0 = *(const uint4*)(pr + PMLA_ + sl * 16), q1 = *(const uint4*)(pr + PMLA_ + sl * 16 + 8);
        uint4 k0 = *(const uint4*)(pr + PKV_ + sl * 16), k1 = *(const uint4*)(pr + PKV_ + sl * 16 + 8);
        const int t = row % T_;
        float x1 = bf2f(pr[PKR_ + sl]), x2 = bf2f(pr[PKR_ + 16 + sl]);
        float2 cs = ROPE[t * 16 + sl];
        const unsigned qw[8] = {q0.x, q0.y, q0.z, q0.w, q1.x, q1.y, q1.z, q1.w};
        const unsigned kw[8] = {k0.x, k0.y, k0.z, k0.w, k1.x, k1.y, k1.z, k1.w};
        float s1 = 0.f, s2 = 0.f;
#pragma unroll
        for (int e = 0; e < 8; e++) {
          float a0 = bflo(qw[e]), a1 = bfhi(qw[e]), c0 = bflo(kw[e]), c1 = bfhi(kw[e]);
          s1 += a0 * a0 + a1 * a1;
          s2 += c0 * c0 + c1 * c1;
        }
        s1 = sum16(s1);
        s2 = sum16(s2);
        const float r1 = rsqrtf(s1 * (1.0f / 256.0f) + 1e-6f), r2 = rsqrtf(s2 * (1.0f / 256.0f) + 1e-6f);
        unsigned oq[8], ok[8];
#pragma unroll
        for (int e = 0; e < 8; e++) {
          float2 g1 = *(const float2*)(qg + sl * 16 + 2 * e), g2 = *(const float2*)(kvg + sl * 16 + 2 * e);
          oq[e] = pk2(bflo(qw[e]) * r1 * g1.x, bfhi(qw[e]) * r1 * g1.y);
          ok[e] = pk2(bflo(kw[e]) * r2 * g2.x, bfhi(kw[e]) * r2 * g2.y);
        }
        *(uint4*)(pr + PMLA_ + sl * 16) = make_uint4(oq[0], oq[1], oq[2], oq[3]);
        *(uint4*)(pr + PMLA_ + sl * 16 + 8) = make_uint4(oq[4], oq[5], oq[6], oq[7]);
        *(uint4*)(pr + PKV_ + sl * 16) = make_uint4(ok[0], ok[1], ok[2], ok[3]);
        *(uint4*)(pr + PKV_ + sl * 16 + 8) = make_uint4(ok[4], ok[5], ok[6], ok[7]);
        pr[PKR_ + sl] = f2bf(x1 * cs.x - x2 * cs.y);
        pr[PKR_ + 16 + sl] = f2bf(x1 * cs.y + x2 * cs.x);
      }
      const float* mu = p.in[5] + (size_t)l * 1824;
      for (int tile = blockIdx.x; tile < 514 * 12; tile += nblk) {
        int mt = tile / 12, sub = tile % 12, which = sub >> 2, nt = sub & 3;
        f32x4 acc[4][4];
        zero_acc(acc);
        ACC_COORDS
        if (which == 0) {
          AL<3> al{P + 1536, PC_, mt * 128, 0, 64, mu + 1536, 0};
          gemm_loop(acc, al, WL + W_LW, 64, nt * 128, 64, smem, tid);
          const float* w0 = p.in[6] + l * 512;
#pragma unroll
          for (int mi = 0; mi < 4; mi++)
#pragma unroll
            for (int ni = 0; ni < 4; ni++) {
              int col = nt * 128 + wc * 64 + ni * 16 + fr;
              float w0c = w0[col];
#pragma unroll
              for (int j = 0; j < 4; j++) {
                int row = mt * 128 + wr * 64 + mi * 16 + fq * 4 + j;
                float x = -(acc[mi][ni][j] + w0c);
                float sp = fmaxf(x, 0.f) + __logf(1.0f + __expf(-fabsf(x)));
                float wraw = -sp - 0.5f;
                DEC[(size_t)row * 512 + col] = __expf(-__expf(wraw));
              }
            }
        } else if (which == 1) {
          AL<3> al{P + 1600, PC_, mt * 128, 0, 64, mu + 1600, 1};
          gemm_loop(acc, al, WL + W_LA, 64, nt * 128, 64, smem, tid);
          const float* a0 = p.in[8] + l * 512;
#pragma unroll
          for (int mi = 0; mi < 4; mi++)
#pragma unroll
            for (int ni = 0; ni < 4; ni++) {
              int col = nt * 128 + wc * 64 + ni * 16 + fr;
              float a0c = a0[col];
#pragma unroll
              for (int j = 0; j < 4; j++) {
                int row = mt * 128 + wr * 64 + mi * 16 + fq * 4 + j;
                AA[(size_t)row * 512 + col] = f2bf(sigmoidf_(acc[mi][ni][j] + a0c));
              }
            }
        } else {
          AL<3> al{P + 1664, PC_, mt * 128, 0, 160, mu + 1664, 2};
          gemm_loop(acc, al, WL + W_LG, 192, nt * 128, 192, smem, tid);
#pragma unroll
          for (int mi = 0; mi < 4; mi++)
#pragma unroll
            for (int ni = 0; ni < 4; ni++) {
              int col = nt * 128 + wc * 64 + ni * 16 + fr;
#pragma unroll
              for (int j = 0; j < 4; j++) {
                int row = mt * 128 + wr * 64 + mi * 16 + fq * 4 + j;
                GG[(size_t)row * 512 + col] = f2bf(acc[mi][ni][j]);
              }
            }
        }
      }
    }
    }
    if (kph == 2) {
    PHASE_TID
    for (int it_ = 0; it_ * nblk < 257 * 14; it_++) {
      int mt, sub;
      if (!map_tile(it_, nblk, 257, 14, mt, sub)) continue;
      f32x4 acc[8][4];
      zero_acc8(acc);
      ACC_COORDS
      if (sub < 6) {
        ADma al{P + PMLA_, PC_, mt * 256, 0, ZERO, 0};
        gemm3(acc, al, WL + W_UQ, 256, sub * 128, 256, smem, tid);
#pragma unroll
        for (int mi = 0; mi < 8; mi++)
#pragma unroll
          for (int ni = 0; ni < 4; ni++) {
            int col = sub * 128 + wc * 64 + ni * 16 + fq * 4;
            int row = mt * 256 + wr * 128 + mi * 16 + fr;
            *(uint2*)(Q + (size_t)row * 768 + col) = make_uint2(pk2(acc[mi][ni][0], acc[mi][ni][1]), pk2(acc[mi][ni][2], acc[mi][ni][3]));
          }
      } else if (sub < 10) {
        int nt = sub - 6;
        ADma al{P + PKV_, PC_, mt * 256, 0, ZERO, 0};
        gemm3(acc, al, WL + W_UK, 256, nt * 128, 256, smem, tid);
#pragma unroll
        for (int mi = 0; mi < 8; mi++)
#pragma unroll
          for (int ni = 0; ni < 4; ni++) {
            int col = nt * 128 + wc * 64 + ni * 16 + fq * 4;
            int row = mt * 256 + wr * 128 + mi * 16 + fr;
            *(uint2*)(KN + (size_t)row * 512 + col) = make_uint2(pk2(acc[mi][ni][0], acc[mi][ni][1]), pk2(acc[mi][ni][2], acc[mi][ni][3]));
          }
      } else {
        int nt = sub - 10;
        ADma al{P + PKV_, PC_, mt * 256, 0, ZERO, 0};
        gemm3<4, false>(acc, al, WL + W_UV, 256, nt * 128, 256, smem, tid);
#pragma unroll
        for (int mi = 0; mi < 8; mi++)
#pragma unroll
          for (int ni = 0; ni < 4; ni++) {
            int col = nt * 128 + wc * 64 + ni * 16 + fr;
            int row = mt * 256 + wr * 128 + mi * 16 + fq * 4;
            int b = row / T_, t = row % T_;
            size_t o = ((size_t)(b * 512 + col)) * T_ + t;
            *(uint2*)(VT + o) = make_uint2(pk2(acc[mi][ni][0], acc[mi][ni][1]), pk2(acc[mi][ni][2], acc[mi][ni][3]));
          }
      }
    }
    }
    if (kph == 3) {
    PHASE_TID
    {
      const int xcd = blockIdx.x & 7, loc = blockIdx.x >> 3;
      const int total = 16 * 33;
      const bool scan_wg = (loc < 16), partner = (loc >= (nblk >> 4) && loc < (nblk >> 4) + 16);
      if (scan_wg) {
        scan_unit(p, l, xcd * 16 + loc, smem, launder(tid));
        __syncthreads();
      }
      if (!partner) {
        while (true) {
          if (tid == 0) s_unit = atomicAdd(&CTR[l * 8 + xcd], 1);
          __syncthreads();
          int v = s_unit;
          __syncthreads();
          if (v >= total) break;
          const int tidu = launder(tid);
          int g = v / 66, w = v - g * 66;
          attn_unit(p, xcd * 16 + g * 2 + (w & 1), 32 - (w >> 1), smem, tidu);
          __syncthreads();
        }
      }
    }
    }
    if (kph == 4) {
    PHASE_TID
    {
    u16* scr = (u16*)(p.ws + OFF_SCR) + (size_t)blockIdx.x * 32768;
    for (int it_ = 0; it_ * nblk < 256 * 8; it_++) {
      int mt, nt;
      if (!map_tile(it_, nblk, 256, 8, mt, nt)) continue;
      f32x4 acc[8][4];
      ADma alh = ADma{(mt < 255) ? HB1 : HB2, 1024, (mt < 255) ? mt * 256 : mt * 256 - HB_SPLIT, 0, ZERO, 0};
      zero_acc8(acc);
      gemm3(acc, alh, WL + W_G, 1024, nt * 128, 1024, smem, launder(tid));
      { const int tq_ = launder(tid); const int lane = tq_ & 63, wave = tq_ >> 6; ACC_COORDS
#pragma unroll
        for (int mi = 0; mi < 8; mi++)
#pragma unroll
          for (int ni = 0; ni < 4; ni++) {
            int col = nt * 128 + wc * 64 + ni * 16 + fq * 4;
            int row = mt * 256 + wr * 128 + mi * 16 + fr;
            *(uint2*)(MIX + (size_t)row * 1024 + col) = make_uint2(pk2(sigmoidf_(acc[mi][ni][0]), sigmoidf_(acc[mi][ni][1])),
                                                                   pk2(sigmoidf_(acc[mi][ni][2]), sigmoidf_(acc[mi][ni][3])));
          }
      }
      zero_acc8(acc);
      {
        ADma aly{YR, 512, mt * 256, 0, ZERO, 0};
        gemm3(acc, aly, WL + W_PR, 512, nt * 128, 512, smem, launder(tid));
      }
      { const int tq_ = launder(tid); const int lane = tq_ & 63, wave = tq_ >> 6; ACC_COORDS
#pragma unroll
        for (int mi = 0; mi < 8; mi++)
#pragma unroll
          for (int ni = 0; ni < 4; ni++) {
            int col = nt * 128 + wc * 64 + ni * 16 + fq * 4;
            int row = mt * 256 + wr * 128 + mi * 16 + fr;
            u16* mp = MIX + (size_t)row * 1024 + col;
            uint2 s = *(const uint2*)mp;
            *(uint2*)mp = make_uint2(pk2(bflo(s.x) * acc[mi][ni][0], bfhi(s.x) * acc[mi][ni][1]), pk2(bflo(s.y) * acc[mi][ni][2], bfhi(s.y) * acc[mi][ni][3]));
          }
      }
      zero_acc8(acc);
      gemm3(acc, alh, WL + W_G, 1024, 1024 + nt * 128, 1024, smem, launder(tid));
      { const int tq_ = launder(tid); const int lane = tq_ & 63, wave = tq_ >> 6; ACC_COORDS
#pragma unroll
        for (int mi = 0; mi < 8; mi++)
#pragma unroll
          for (int ni = 0; ni < 4; ni++) {
            int cl = wc * 64 + ni * 16 + fq * 4, rl = wr * 128 + mi * 16 + fr;
            *(uint2*)(scr + rl * 128 + cl) = make_uint2(pk2(sigmoidf_(acc[mi][ni][0]), sigmoidf_(acc[mi][ni][1])),
                                                        pk2(sigmoidf_(acc[mi][ni][2]), sigmoidf_(acc[mi][ni][3])));
          }
      }
      zero_acc8(acc);
      {
        ADma alm{P + PMLA_, PC_, mt * 256, 0, ZERO, 0};
        gemm3(acc, alm, WL + W_PM, 512, nt * 128, 512, smem, launder(tid));
      }
      { const int tq_ = launder(tid); const int lane = tq_ & 63, wave = tq_ >> 6; ACC_COORDS
#pragma unroll
        for (int mi = 0; mi < 8; mi++)
#pragma unroll
          for (int ni = 0; ni < 4; ni++) {
            int cl = wc * 64 + ni * 16 + fq * 4, rl = wr * 128 + mi * 16 + fr;
            u16* mp = MIX + (size_t)(mt * 256 + rl) * 1024 + nt * 128 + cl;
            uint2 t1 = *(const uint2*)mp;
            uint2 s = *(const uint2*)(scr + rl * 128 + cl);
            float o0 = bflo(t1.x) + bflo(s.x) * acc[mi][ni][0];
            float o1 = bfhi(t1.x) + bfhi(s.x) * acc[mi][ni][1];
            float o2 = bflo(t1.y) + bflo(s.y) * acc[mi][ni][2];
            float o3 = bfhi(t1.y) + bfhi(s.y) * acc[mi][ni][3];
            *(uint2*)mp = make_uint2(pk2(o0, o1), pk2(o2, o3));
          }
      }
    }
    }
    if (blockIdx.x < 16) {
      const int mt = 256, nt = blockIdx.x;
      f32x4 acc[8][2];
      unsigned sg[8][2][2];
      ADma alh = ADma{(mt < 255) ? HB1 : HB2, 1024, (mt < 255) ? mt * 256 : mt * 256 - HB_SPLIT, 0, ZERO, 0};
      zero_acc8(acc);
      const int tid1 = launder(tid);
      gemm3(acc, alh, WL + W_G, 1024, nt * 64, 1024, smem, tid1);
#pragma unroll
      for (int mi = 0; mi < 8; mi++)
#pragma unroll
        for (int ni = 0; ni < 2; ni++) {
          sg[mi][ni][0] = pk2(sigmoidf_(acc[mi][ni][0]), sigmoidf_(acc[mi][ni][1]));
          sg[mi][ni][1] = pk2(sigmoidf_(acc[mi][ni][2]), sigmoidf_(acc[mi][ni][3]));
        }
      zero_acc8(acc);
      {
        ADma aly{YR, 512, mt * 256, 0, ZERO, 0};
        const int tid2 = launder(tid);
      gemm3(acc, aly, WL + W_PR, 512, nt * 64, 512, smem, tid2);
      }
{ const int tidq = launder(tid); const int lane = tidq & 63, wave = tidq >> 6; ACC_COORDS
#pragma unroll
      for (int mi = 0; mi < 8; mi++)
#pragma unroll
        for (int ni = 0; ni < 2; ni++) {
          int col = nt * 64 + wc * 32 + ni * 16 + fq * 4;
          int row = mt * 256 + wr * 128 + mi * 16 + fr;
          *(uint2*)(MIX + (size_t)row * 1024 + col) = make_uint2(pk2(bflo(sg[mi][ni][0]) * acc[mi][ni][0], bfhi(sg[mi][ni][0]) * acc[mi][ni][1]),
                                                                 pk2(bflo(sg[mi][ni][1]) * acc[mi][ni][2], bfhi(sg[mi][ni][1]) * acc[mi][ni][3]));
        }
      }
      zero_acc8(acc);
      const int tid3 = launder(tid);
      gemm3(acc, alh, WL + W_G, 1024, 1024 + nt * 64, 1024, smem, tid3);
#pragma unroll
      for (int mi = 0; mi < 8; mi++)
#pragma unroll
        for (int ni = 0; ni < 2; ni++) {
          sg[mi][ni][0] = pk2(sigmoidf_(acc[mi][ni][0]), sigmoidf_(acc[mi][ni][1]));
          sg[mi][ni][1] = pk2(sigmoidf_(acc[mi][ni][2]), sigmoidf_(acc[mi][ni][3]));
        }
      zero_acc8(acc);
      {
        ADma alm{P + PMLA_, PC_, mt * 256, 0, ZERO, 0};
        const int tid4 = launder(tid);
      gemm3(acc, alm, WL + W_PM, 512, nt * 64, 512, smem, tid4);
      }
{ const int tidq = launder(tid); const int lane = tidq & 63, wave = tidq >> 6; ACC_COORDS
#pragma unroll
      for (int mi = 0; mi < 8; mi++)
#pragma unroll
        for (int ni = 0; ni < 2; ni++) {
          int col = nt * 64 + wc * 32 + ni * 16 + fq * 4;
          int row = mt * 256 + wr * 128 + mi * 16 + fr;
          uint2 pm = *(const uint2*)(MIX + (size_t)row * 1024 + col);
          float o0 = bflo(pm.x) + bflo(sg[mi][ni][0]) * acc[mi][ni][0];
          float o1 = bfhi(pm.x) + bfhi(sg[mi][ni][0]) * acc[mi][ni][1];
          float o2 = bflo(pm.y) + bflo(sg[mi][ni][1]) * acc[mi][ni][2];
          float o3 = bfhi(pm.y) + bfhi(sg[mi][ni][1]) * acc[mi][ni][3];
          *(uint2*)(MIX + (size_t)row * 1024 + col) = make_uint2(pk2(o0, o1), pk2(o2, o3));
        }
      }
    }
    }
    if (kph == 5) {
    PHASE_TID
    for (int prb_ = (PROBE_FI ? 0 : 1); prb_ < 2; prb_++)
    for (int it_ = 0; it_ * nblk < 256 * 8; it_++) {
      int mt, nt;
      if (!map_tile(it_, nblk, 256, 8, mt, nt)) continue;
      f32x4 acc[8][4];
      zero_acc8(acc);
      ACC_COORDS
      ADma al{MIX, 1024, mt * 256, 0, ZERO, 0};
      gemm3(acc, al, WL + W_OUT, 1024, nt * 128, 1024, smem, tid);
#pragma unroll
      for (int mi = 0; mi < 8; mi++)
#pragma unroll
        for (int ni = 0; ni < 4; ni++) {
          int col = nt * 128 + wc * 64 + ni * 16 + fq * 4;
          int row = mt * 256 + wr * 128 + mi * 16 + fr;
          float* hp = H + (size_t)row * 1024 + col;
          float* dp = (prb_ == 0) ? (p.out + (size_t)(row & 65535) * 1024 + col) : hp;
          float4 hv = *(const float4*)hp;
          hv.x = ALPHA_ * hv.x + acc[mi][ni][0];
          hv.y = ALPHA_ * hv.y + acc[mi][ni][1];
          hv.z = ALPHA_ * hv.z + acc[mi][ni][2];
          hv.w = ALPHA_ * hv.w + acc[mi][ni][3];
          *(float4*)dp = hv;
        }
    }
    if (blockIdx.x < 16) {
      const int mt = 256, n0 = blockIdx.x * 64;
      f32x4 acc[8][2];
      zero_acc8(acc);
      ADma al{MIX, 1024, mt * 256, 0, ZERO, 0};
      gemm3(acc, al, WL + W_OUT, 1024, n0, 1024, smem, launder(tid));
      const int tq_ = launder(tid);
      const int lane = tq_ & 63, wave = tq_ >> 6;
      ACC_COORDS
#pragma unroll
      for (int mi = 0; mi < 8; mi++)
#pragma unroll
        for (int ni = 0; ni < 2; ni++) {
          int col = n0 + wc * 32 + ni * 16 + fq * 4;
          int row = mt * 256 + wr * 128 + mi * 16 + fr;
          float* hp = H + (size_t)row * 1024 + col;
          float4 hv = *(const float4*)hp;
          hv.x = ALPHA_ * hv.x + acc[mi][ni][0];
          hv.y = ALPHA_ * hv.y + acc[mi][ni][1];
          hv.z = ALPHA_ * hv.z + acc[mi][ni][2];
          hv.w = ALPHA_ * hv.w + acc[mi][ni][3];
          *(float4*)hp = hv;
        }
    }
    }
    if (kph == 6) {
    PHASE_TID
    for (int row = (blockIdx.x * 4 + wave) * 2; row < M_; row += nblk * 8)
      ln_row2(H + (size_t)row * 1024, H + (size_t)(row + 1) * 1024, p.in[24] + l * 1024, p.in[25] + l * 1024, H + (size_t)row * 1024, H + (size_t)(row + 1) * 1024, lane, HBH + (size_t)row * 1024, HBH + (size_t)(row + 1) * 1024);
    }
    if (kph == 7) {
    PHASE_TID
    {
      const float* cw = p.in[27] + (size_t)l * 3 * 5632;
      const float* cb = p.in[28] + (size_t)l * 5632;
#if PROBE_HOT
      for (int it_ = 0; it_ * nblk < 272 * 44; it_++) {
        int rest, nt;
        if (!map_tile(it_, nblk, 272, 44, rest, nt)) continue;
        f32x4 acc[8][4];
        zero_acc8(acc);
#if PROBE_HOT == 1
        ADma al{HBH, 1024, 0, 0, ZERO, 1, p.ws};
        gemm3(acc, al, WL + W_UP, 1024, 0, 1024, smem, tid);
#else
        int it = rest % 17, b = rest / 17;
        ADma al{HBH, 1024, b * T_, 254 * it - 2, ZERO, 1, p.ws};
        gemm3(acc, al, WL + W_UP, 1024, nt * 128, 1024, smem, tid);
#endif
        float sacc = 0.f;
#pragma unroll
        for (int mi = 0; mi < 8; mi++)
#pragma unroll
          for (int ni = 0; ni < 4; ni++) sacc += acc[mi][ni][0] + acc[mi][ni][1] + acc[mi][ni][2] + acc[mi][ni][3];
        if (sacc == 12345.678f) ACT[tid] = 0;
      }
#endif
      for (int it_ = 0; it_ * nblk < 272 * 44; it_++) {
        int rest, nt;
        if (!map_tile(it_, nblk, 272, 44, rest, nt)) continue;
        int it = rest % 17, b = rest / 17;
        int t0 = 254 * it - 2;
        f32x4 acc[8][4];
        zero_acc8(acc);
        ADma al{HBH, 1024, b * T_, t0, ZERO, 1, p.ws};
        gemm3(acc, al, WL + W_UP, 1024, nt * 128, 1024, smem, launder(tid));
        ACC_COORDS
        float(*ut)[132] = (float(*)[132])smem;
        const int tidh = launder(tid);
        typedef float f2c __attribute__((ext_vector_type(2)));
        const int c2 = (tidh & 31) * 2, rg = tidh >> 5;
        const int gcol = nt * 64 + c2, vcol = DFF_ + nt * 64 + c2;
        const f2c g0 = *(const f2c*)(cw + gcol), g1 = *(const f2c*)(cw + 5632 + gcol), g2 = *(const f2c*)(cw + 2 * 5632 + gcol), gb = *(const f2c*)(cb + gcol);
        const f2c v0 = *(const f2c*)(cw + vcol), v1 = *(const f2c*)(cw + 5632 + vcol), v2 = *(const f2c*)(cw + 2 * 5632 + vcol), vb = *(const f2c*)(cb + vcol);
#pragma unroll 1
        for (int half = 0; half < 2; half++) {
          float carry = 0.f;
          if (half == 1) carry = ut[126 + (tid >> 7)][tid & 127];
          __syncthreads();
          if (half == 1) ut[tid >> 7][tid & 127] = carry;
          if (wr == half) {
#pragma unroll
            for (int mi = 0; mi < 8; mi++)
#pragma unroll
              for (int ni = 0; ni < 4; ni++)
                *(float4*)&ut[half * 2 + mi * 16 + fr][wc * 64 + ni * 16 + fq * 4] = make_float4(acc[mi][ni][0], acc[mi][ni][1], acc[mi][ni][2], acc[mi][ni][3]);
          }
          __syncthreads();
          const int nq = half ? 130 : 128;
          int qs = 2 + rg * 16, qe = min(qs + 16, nq);
          f2c ga = *(const f2c*)&ut[qs - 2][c2], gbp = *(const f2c*)&ut[qs - 1][c2];
          f2c va = *(const f2c*)&ut[qs - 2][64 + c2], vbp = *(const f2c*)&ut[qs - 1][64 + c2];
#pragma unroll 4
          for (int q = qs; q < qe; q++) {
            f2c gc = *(const f2c*)&ut[q][c2], vc = *(const f2c*)&ut[q][64 + c2];
            int t = t0 + half * 126 + q;
            if (t < T_) {
              f2c gate = g0 * ga + g1 * gbp + g2 * gc + gb;
              f2c val = v0 * va + v1 * vbp + v2 * vc + vb;
              float a0 = gate.x * sigmoidf_(gate.x) * val.x, a1 = gate.y * sigmoidf_(gate.y) * val.y;
              *(unsigned*)(ACT + (size_t)(b * T_ + t) * DFF_ + gcol) = pk2(a0, a1);
            }
            ga = gbp; gbp = gc; va = vbp; vbp = vc;
          }
        }
        __syncthreads();
      }
    }
    }
    if (kph == 8) {
    PHASE_TID
    for (int prb_ = (PROBE_FI ? 0 : 1); prb_ < 2; prb_++)
    for (int it_ = 0; it_ * nblk < 256 * 8; it_++) {
      int mt, nt;
      if (!map_tile(it_, nblk, 256, 8, mt, nt)) continue;
      f32x4 acc[8][4];
      zero_acc8(acc);
      ACC_COORDS
      ADma al{ACT, DFF_, mt * 256, 0, ZERO, 0};
      gemm3(acc, al, WL + W_DN, DFF_, nt * 128, DFF_, smem, tid);
#pragma unroll
      for (int mi = 0; mi < 8; mi++)
#pragma unroll
        for (int ni = 0; ni < 4; ni++) {
          int col = nt * 128 + wc * 64 + ni * 16 + fq * 4;
          int row = mt * 256 + wr * 128 + mi * 16 + fr;
          float* hp = H + (size_t)row * 1024 + col;
          float* dp = (prb_ == 0) ? (p.out + (size_t)(row & 65535) * 1024 + col) : hp;
          float4 hv = *(const float4*)hp;
          hv.x = ALPHA_ * hv.x + acc[mi][ni][0];
          hv.y = ALPHA_ * hv.y + acc[mi][ni][1];
          hv.z = ALPHA_ * hv.z + acc[mi][ni][2];
          hv.w = ALPHA_ * hv.w + acc[mi][ni][3];
          *(float4*)dp = hv;
        }
    }
    if (blockIdx.x < 16) {
      const int mt = 256, n0 = blockIdx.x * 64;
      f32x4 acc[8][2];
      zero_acc8(acc);
      ADma al{ACT, DFF_, mt * 256, 0, ZERO, 0};
      gemm3(acc, al, WL + W_DN, DFF_, n0, DFF_, smem, launder(tid));
      const int tq_ = launder(tid);
      const int lane = tq_ & 63, wave = tq_ >> 6;
      ACC_COORDS
#pragma unroll
      for (int mi = 0; mi < 8; mi++)
#pragma unroll
        for (int ni = 0; ni < 2; ni++) {
          int col = n0 + wc * 32 + ni * 16 + fq * 4;
          int row = mt * 256 + wr * 128 + mi * 16 + fr;
          float* hp = H + (size_t)row * 1024 + col;
          float4 hv = *(const float4*)hp;
          hv.x = ALPHA_ * hv.x + acc[mi][ni][0];
          hv.y = ALPHA_ * hv.y + acc[mi][ni][1];
          hv.z = ALPHA_ * hv.z + acc[mi][ni][2];
          hv.w = ALPHA_ * hv.w + acc[mi][ni][3];
          *(float4*)hp = hv;
        }
    }
    }
    if (kph == 9) {
    PHASE_TID
    if (l == 0) {
      for (int row = (blockIdx.x * 4 + wave) * 2; row < M_; row += nblk * 8) {
        u16* hb = (row < HB_SPLIT) ? HB1 + (size_t)row * 1024 : HB2 + (size_t)(row - HB_SPLIT) * 1024;
        ln_row2(H + (size_t)row * 1024, H + (size_t)(row + 1) * 1024, p.in[30], p.in[31], H + (size_t)row * 1024, H + (size_t)(row + 1) * 1024, lane, hb, hb + 1024);
      }
    } else {
      for (int row = (blockIdx.x * 4 + wave) * 2; row < M_; row += nblk * 8) {
        int b = row / T_, t = row % T_;
        if (t >= NMETA_) {
          float* o = p.out + ((size_t)b * SEQ_ + (t - NMETA_)) * 1024;
          ln_row2(H + (size_t)row * 1024, H + (size_t)(row + 1) * 1024, p.in[30] + 1024, p.in[31] + 1024, o, o + 1024, lane, nullptr, nullptr);
        }
      }
    }
    }
    if (ph_ != 19) XB_SYNC();
  }
}

#undef H
#undef P
#undef DEC
#undef AA
#undef GG
#undef Q
#undef MIX
#undef HB1
#undef HB2
#undef HBH
#undef ZERO
#undef ACT
#undef ROPE
#undef CTR
#undef KN
#undef VT
#undef YR

extern "C" void kernel_launch(void* const* d_in, const int* in_sizes, int n_in, void* d_out, int out_size, void* d_ws,
                              size_t ws_size, hipStream_t stream) {
  static int grid_blocks = 0;
  if (!grid_blocks) {
    int dev = 0, cus = 0, per_cu = 0;
    hipGetDevice(&dev);
    hipDeviceGetAttribute(&cus, hipDeviceAttributeMultiprocessorCount, dev);
    hipOccupancyMaxActiveBlocksPerMultiprocessor(&per_cu, mega, 256, 0);
    if (per_cu > 2) per_cu = 2;
    grid_blocks = cus * per_cu;
  }
  if (ws_size < WS_TOTAL) fprintf(stderr, "workspace too small: %zu < %zu\n", ws_size, (size_t)WS_TOTAL);
  Params p;
  memset(&p, 0, sizeof(p));
  for (int i = 0; i < 32; i++) p.in[i] = (const float*)d_in[i];
  p.out = (float*)d_out;
  p.ws = (char*)d_ws;
  u16* wb = (u16*)((char*)d_ws + OFF_W);
  int nj = 0, tiles = 0;
  auto add = [&](const float* src, size_t dst_off, int ld, int c0, int K, int Kpad, int Nv, int Np, int mode) {
    Job& j = p.jobs[nj++];
    j.src = src; j.dst = wb + dst_off; j.ld = ld; j.c0 = c0; j.K = K; j.Kpad = Kpad; j.Nv = Nv; j.Np = Np; j.mode = mode;
    j.tile0 = tiles;
    tiles += (Kpad / 64) * (Np / 64);
  };
  for (int l = 0; l < 2; l++) {
    size_t o = (size_t)l * W_LAYER;
    const float* w_in = (const float*)d_in[4] + (size_t)l * 1024 * 4416;
    add(w_in, o + W_IN, 4416, 0, 1024, 1024, 2368, 2432, 0);
    add(w_in, o + W_G, 4416, 2368, 1024, 1024, 2048, 2048, 0);
    add((const float*)d_in[7] + (size_t)l * 64 * 512, o + W_LW, 512, 0, 64, 64, 512, 512, 0);
    add((const float*)d_in[9] + (size_t)l * 64 * 512, o + W_LA, 512, 0, 64, 64, 512, 512, 0);
    add((const float*)d_in[10] + (size_t)l * 160 * 512, o + W_LG, 512, 0, 160, 192, 512, 512, 0);
    add((const float*)d_in[17] + (size_t)l * 256 * 768, o + W_UQ, 768, 0, 256, 256, 768, 768, 0);
    add((const float*)d_in[19] + (size_t)l * 256 * 512, o + W_UK, 512, 0, 256, 256, 512, 512, 0);
    add((const float*)d_in[20] + (size_t)l * 256 * 512, o + W_UV, 512, 0, 256, 256, 512, 512, 0);
    add((const float*)d_in[21] + (size_t)l * 512 * 1024, o + W_PR, 1024, 0, 512, 512, 1024, 1024, 0);
    add((const float*)d_in[22] + (size_t)l * 512 * 1024, o + W_PM, 1024, 0, 512, 512, 1024, 1024, 0);
    add((const float*)d_in[23] + (size_t)l * 1024 * 1024, o + W_OUT, 1024, 0, 1024, 1024, 1024, 1024, 0);
    add((const float*)d_in[26] + (size_t)l * 1024 * 5632, o + W_UP, 5632, 0, 1024, 1024, 5632, 5632, 1);
    add((const float*)d_in[29] + (size_t)l * 2816 * 1024, o + W_DN, 1024, 0, 2816, 2816, 1024, 1024, 0);
  }
  p.nconv = tiles;
  hipMemsetAsync((char*)d_ws + OFF_BAR, 0, 16384, stream);
  void* args[] = {&p};
  hipError_t e = hipLaunchCooperativeKernel((void*)mega, dim3(grid_blocks), dim3(256), args, 0, stream);
  if (e != hipSuccess) fprintf(stderr, "cooperative launch failed: %s (grid %d)\n", hipGetErrorString(e), grid_blocks);
}
```

```cpp
#include <hip/hip_runtime.h>
#include <hip/hip_cooperative_groups.h>
#include <cstdio>
#include <cstring>
namespace cg = cooperative_groups;

#ifndef PHMASK
#define PHMASK 0xFFFF
#endif
#ifndef PROBE_HOT
#define PROBE_HOT 0
#endif
#ifndef PROBE_FI
#define PROBE_FI 0
#endif
#ifndef REPMASK
#define REPMASK 0
#endif
typedef unsigned short u16;
using bf16x8 = __attribute__((ext_vector_type(8))) short;
using f32x4 = __attribute__((ext_vector_type(4))) float;

constexpr int B_ = 16, SEQ_ = 4096, NMETA_ = 16, T_ = 4112, M_ = B_ * T_, D_ = 1024;
constexpr int PC_ = 2368;
constexpr int PMLA_ = 1824, PKV_ = 2080, PKR_ = 2336;
constexpr int DFF_ = 2816;
constexpr float ALPHA_ = 1.4142135623730951f;

constexpr size_t OFF_H = 0;
constexpr size_t OFF_P = OFF_H + (size_t)M_ * 1024 * 4;
constexpr size_t OFF_DEC = OFF_P + (size_t)M_ * PC_ * 2;
constexpr size_t OFF_AA = OFF_DEC + (size_t)M_ * 512 * 4;
constexpr size_t OFF_GG = OFF_AA + (size_t)M_ * 512 * 2;
constexpr size_t OFF_Q = OFF_GG + (size_t)M_ * 512 * 2;
constexpr size_t OFF_W = OFF_Q + (size_t)M_ * 768 * 2;
constexpr size_t W_IN = 0;
constexpr size_t W_G = W_IN + (size_t)2432 * 1024;
constexpr size_t W_LW = W_G + (size_t)2048 * 1024;
constexpr size_t W_LA = W_LW + (size_t)512 * 64;
constexpr size_t W_LG = W_LA + (size_t)512 * 64;
constexpr size_t W_UQ = W_LG + (size_t)512 * 192;
constexpr size_t W_UK = W_UQ + (size_t)768 * 256;
constexpr size_t W_UV = W_UK + (size_t)512 * 256;
constexpr size_t W_PR = W_UV + (size_t)512 * 256;
constexpr size_t W_PM = W_PR + (size_t)1024 * 512;
constexpr size_t W_OUT = W_PM + (size_t)1024 * 512;
constexpr size_t W_UP = W_OUT + (size_t)1024 * 1024;
constexpr size_t W_DN = W_UP + (size_t)5632 * 1024;
constexpr size_t W_LAYER = W_DN + (size_t)1024 * 2816;
constexpr size_t OFF_ROPE = OFF_W + 2 * W_LAYER * 2;
constexpr size_t OFF_CTR = OFF_ROPE + (size_t)T_ * 16 * 8;
constexpr size_t OFF_ZERO = OFF_CTR + 256;
constexpr size_t OFF_BAR = OFF_ZERO + 8192;
constexpr size_t OFF_HB2 = OFF_BAR + 16384;
constexpr size_t OFF_SCR = OFF_HB2 + (size_t)512 * 1024 * 2;
constexpr size_t WS_TOTAL = OFF_SCR + (size_t)1024 * 65536;
constexpr int HB_SPLIT = 65280;

struct Job { const float* src; u16* dst; int ld, c0, K, Kpad, Nv, Np, mode, tile0; };
struct Params {
  const float* in[32];
  float* out;
  char* ws;
  Job jobs[26];
  int nconv;
  int pad0;
};

__constant__ double ROPE_C[16] = {0.15915494309189535, 0.08949940160889101, 0.050329212104487035, 0.0283021958306234,
                                  0.015915494309189534, 0.008949940160889102, 0.005032921210448704, 0.00283021958306234,
                                  0.0015915494309189536, 0.0008949940160889102, 0.0005032921210448703, 0.00028302195830623395,
                                  0.00015915494309189535, 8.949940160889102e-05, 5.0329212104487035e-05, 2.8302195830623396e-05};

__device__ __forceinline__ int launder(int x) { asm volatile("" : "+v"(x)); return x; }
typedef __bf16 bf16x2_t __attribute__((ext_vector_type(2)));
typedef float f32x2_t __attribute__((ext_vector_type(2)));
__device__ __forceinline__ unsigned pk2(float a, float b) {
  f32x2_t v = {a, b};
  bf16x2_t r = __builtin_convertvector(v, bf16x2_t);
  return *(unsigned*)&r;
}
__device__ __forceinline__ u16 f2bf(float f) { return (u16)(pk2(f, 0.f) & 0xffffu); }
__device__ __forceinline__ float bf2f(unsigned h) { return __uint_as_float(h << 16); }
__device__ __forceinline__ float bflo(unsigned w) { return __uint_as_float(w << 16); }
__device__ __forceinline__ float bfhi(unsigned w) { return __uint_as_float(w & 0xffff0000u); }
__device__ __forceinline__ float sigmoidf_(float x) { return __builtin_amdgcn_rcpf(1.0f + __expf(-x)); }

__device__ __forceinline__ int fresh_lane() { int x; asm volatile("v_mbcnt_lo_u32_b32 %0, -1, 0\n\tv_mbcnt_hi_u32_b32 %0, -1, %0" : "=v"(x)); return x; }
#define PHASE_TID const int tid = wave0 * 64 + fresh_lane(); const int lane = tid & 63, wave = tid >> 6; (void)lane; (void)wave;
template <int CTRL>
__device__ __forceinline__ float dppf(float x) {
  return __int_as_float(__builtin_amdgcn_update_dpp(0, __float_as_int(x), CTRL, 0xF, 0xF, true));
}
__device__ __forceinline__ float sum8(float x) {
  x += dppf<0xB1>(x);
  x += dppf<0x4E>(x);
  x += dppf<0x141>(x);
  return x;
}
__device__ __forceinline__ float sum16(float x) {
  x = sum8(x);
  x += dppf<0x140>(x);
  return x;
}
__device__ __forceinline__ float shx(float x, int lane, int o) {
  return __int_as_float(__builtin_amdgcn_ds_bpermute((lane ^ o) << 2, __float_as_int(x)));
}
__device__ __forceinline__ float wave_sum(float x, int lane) {
  x = sum16(x);
  x += shx(x, lane, 16);
  x += shx(x, lane, 32);
  return x;
}

constexpr int BM = 128, BN = 128, BK = 64, LDT = 64;
constexpr int SMEM_BYTES = 73728;

template <int MODE>
struct AL {
  const void* base;
  int ld;
  int row0;
  int t0;
  int kvalid;
  const float* mu;
  int fn;
  struct Raw { uint4 x, y; };
  __device__ __forceinline__ Raw fetch(int r, int k) const {
    Raw w;
    { unsigned z = (MODE == 3) ? (unsigned)launder(0) : 0u; w.x = make_uint4(z, z, z, z); w.y = w.x; }
    if (MODE == 0) {
      const float* p = (const float*)base + (size_t)(row0 + r) * ld + k;
      w.x = *(const uint4*)p;
      w.y = *(const uint4*)(p + 4);
    } else if (MODE == 1) {
      const u16* p = (const u16*)base + (size_t)(row0 + r) * ld + k;
      w.x = *(const uint4*)p;
    } else if (MODE == 4) {
      const float* p = (const float*)base + (size_t)(row0 + r) * ld + k;
      float4 a = *(const float4*)p, b = *(const float4*)(p + 4);
      w.x = make_uint4(pk2(a.x, a.y), pk2(a.z, a.w), pk2(b.x, b.y), pk2(b.z, b.w));
    } else if (MODE == 2) {
      int t = t0 + r;
      if (t >= 0 && t < T_) {
        const float* p = (const float*)base + (size_t)(row0 + t) * ld + k;
        w.x = *(const uint4*)p;
        w.y = *(const uint4*)(p + 4);
      }
    } else {
      int row = row0 + r;
      int t = row % T_;
      if (k < kvalid) {
        const u16* p = (const u16*)base + (size_t)row * ld + k;
        w.x = *(const uint4*)p;
        if (t > 0) w.y = *(const uint4*)(p - ld);
      }
    }
    return w;
  }
  __device__ __forceinline__ uint4 cvt(const Raw& w, int k) const {
    if (MODE == 0 || MODE == 2) {
      uint4 o;
      o.x = pk2(__uint_as_float(w.x.x), __uint_as_float(w.x.y));
      o.y = pk2(__uint_as_float(w.x.z), __uint_as_float(w.x.w));
      o.z = pk2(__uint_as_float(w.y.x), __uint_as_float(w.y.y));
      o.w = pk2(__uint_as_float(w.y.z), __uint_as_float(w.y.w));
      return o;
    } else if (MODE == 1 || MODE == 4) {
      return w.x;
    } else {
      if (k >= kvalid) { unsigned z = (unsigned)launder(0); return make_uint4(z, z, z, z); }
      unsigned cw[4] = {w.x.x, w.x.y, w.x.z, w.x.w};
      unsigned pw[4] = {w.y.x, w.y.y, w.y.z, w.y.w};
      unsigned ow[4];
#pragma unroll
      for (int e = 0; e < 4; e++) {
        float x0 = bflo(cw[e]), x1 = bfhi(cw[e]);
        float p0 = bflo(pw[e]), p1 = bfhi(pw[e]);
        float v0 = x0 + (p0 - x0) * mu[k + 2 * e];
        float v1 = x1 + (p1 - x1) * mu[k + 2 * e + 1];
        if (fn == 0) {
          v0 = 1.0f - 2.0f * __builtin_amdgcn_rcpf(__expf(2.0f * v0) + 1.0f);
          v1 = 1.0f - 2.0f * __builtin_amdgcn_rcpf(__expf(2.0f * v1) + 1.0f);
        } else if (fn == 2) {
          v0 = sigmoidf_(v0);
          v1 = sigmoidf_(v1);
        }
        ow[e] = pk2(v0, v1);
      }
      return make_uint4(ow[0], ow[1], ow[2], ow[3]);
    }
  }
};

template <int NI>
__device__ __forceinline__ void zero_acc(f32x4 (&acc)[4][NI]) {
#pragma unroll
  for (int i = 0; i < 4; i++)
#pragma unroll
    for (int j = 0; j < NI; j++) acc[i][j] = f32x4{0.f, 0.f, 0.f, 0.f};
}

#define REP4(X) X(0) X(1) X(2) X(3)
template <class ALT, int NI>
__device__ __forceinline__ void gemm_loop(f32x4 (&acc)[4][NI], const ALT& al, const u16* __restrict__ Bt, int ldb, int n0,
                                          int K, char* smem, const int tid) {
  const int lane = tid & 63, wave = tid >> 6;
  const int wr = wave >> 1, wc = wave & 1, fr = lane & 15, fq = lane >> 4;
  const int lr = tid >> 3, lk = (tid & 7) * 8, lsw = ((tid & 7) ^ (lr & 7)) * 8;
  u16* sa = (u16*)smem;
  u16* sb = sa + 2 * BM * LDT;
  typename ALT::Raw ra0, ra1, ra2, ra3;
  uint4 rb0 = make_uint4(0,0,0,0), rb1 = rb0, rb2 = rb0, rb3 = rb0;
  const u16* bp = Bt + (size_t)(n0 + lr) * ldb + lk;
#define GL_FETCH(i) ra##i = al.fetch(lr + 32 * i, kf); if (i < NI) rb##i = *(const uint4*)(bp + (size_t)(32 * i) * ldb + kb);
#define GL_STORE(i) *(uint4*)(a_ + (lr + 32 * i) * LDT + lsw) = al.cvt(ra##i, kt * BK + lk); if (i < NI) *(uint4*)(b_ + (lr + 32 * i) * LDT + lsw) = rb##i;
  {
    const int kf = lk, kb = 0;
    REP4(GL_FETCH)
  }
  const int nk = K / BK;
  for (int kt = 0; kt < nk; kt++) {
    u16* a_ = sa + (kt & 1) * BM * LDT;
    u16* b_ = sb + (kt & 1) * BN * LDT;
    REP4(GL_STORE)
    __syncthreads();
    if (kt + 1 < nk) {
      const int kf = (kt + 1) * BK + lk, kb = (kt + 1) * BK;
      REP4(GL_FETCH)
    }
#pragma unroll
    for (int ks = 0; ks < 2; ks++) {
      bf16x8 af[4], bf[NI];
#pragma unroll
      for (int i = 0; i < 4; i++) af[i] = *(const bf16x8*)(a_ + (wr * 64 + i * 16 + fr) * LDT + (((ks * 4 + fq) ^ (fr & 7)) * 8));
#pragma unroll
      for (int i = 0; i < NI; i++) bf[i] = *(const bf16x8*)(b_ + (wc * (NI * 16) + i * 16 + fr) * LDT + (((ks * 4 + fq) ^ (fr & 7)) * 8));
#pragma unroll
      for (int mi = 0; mi < 4; mi++)
#pragma unroll
        for (int ni = 0; ni < NI; ni++)
          acc[mi][ni] = __builtin_amdgcn_mfma_f32_16x16x32_bf16(af[mi], bf[ni], acc[mi][ni], 0, 0, 0);
    }
  }
  __syncthreads();
#undef GL_FETCH
#undef GL_STORE
}


struct ADma { const u16* base; int ld; int row0; int t0; const u16* zero; int mode; const char* wsb; };
constexpr int G3_STAGE = 12288;

template <int NI, bool SWAP = true>
__device__ __forceinline__ void gemm3(f32x4 (&acc)[8][NI], const ADma& a, const u16* __restrict__ Bt, int ldb, int n0, int K,
                                      char* smem, const int tid) {
  const int lane = tid & 63, wave = tid >> 6;
  const int wr = wave >> 1, wc = wave & 1, fr = lane & 15, fq = lane >> 4;
  const int kc8 = ((lane & 3) ^ ((4 - (lane >> 4)) & 3)) * 8;
  const int psw = (fq ^ ((4 - (fr >> 2)) & 3)) * 8;
  u16* sm = (u16*)smem;
  const u16* ap0 = nullptr;
  unsigned ao0 = 0, ao1 = 0, ao2 = 0, ao3 = 0;
  if (a.mode == 0) {
    ap0 = a.base + (size_t)(a.row0 + wave * 64 + (lane >> 2)) * a.ld + kc8;
  } else {
    const unsigned bo = (unsigned)((const char*)a.base - a.wsb), zo = (unsigned)((const char*)a.zero - a.wsb) + kc8 * 2;
#define G3_AP(j)                                                                          \
    {                                                                                     \
      int t = a.t0 + wave * 64 + j * 16 + (lane >> 2);                                    \
      ao##j = (t >= 0 && t < T_) ? bo + (unsigned)(((a.row0 + t) * a.ld + kc8) * 2) : zo; \
    }
    REP4(G3_AP)
#undef G3_AP
  }
  const u16* bp0 = Bt + (size_t)(n0 + wave * (8 * NI) + (lane >> 2)) * ldb + kc8;
  const size_t astep = (size_t)16 * a.ld;
  const size_t bstep = (size_t)16 * ldb;
#define G3_ISSUE(j)                                                                                                              \
  __builtin_amdgcn_global_load_lds((a.mode == 0) ? (const unsigned*)(ap0 + j * astep + kof) : (const unsigned*)(a.wsb + ao##j + kof * 2), (unsigned*)(st_ + (wave * 64 + j * 16) * 32 + lane * 8), 16, 0, 0); \
  if (2 * j < NI) __builtin_amdgcn_global_load_lds((const unsigned*)(bp0 + j * bstep + kof), (unsigned*)(st_ + 8192 + (wave * (8 * NI) + j * 16) * 32 + lane * 8), 16, 0, 0);
  const int nk = K / 32;
  {
    const int kof = 0;
    u16* st_ = sm;
    REP4(G3_ISSUE)
  }
  if (nk > 1) {
    const int kof = 32;
    u16* st_ = sm + G3_STAGE;
    REP4(G3_ISSUE)
  }
  int cur = 0, nxt = 2;
  const unsigned lds0 = (unsigned)(size_t)(__attribute__((address_space(3))) char*)smem;
  const unsigned aoff = lds0 + (unsigned)(((wr * 128 + fr) * 32 + psw) * 2);
  const unsigned boff = lds0 + 16384u + (unsigned)(((wc * (NI * 16) + fr) * 32 + psw) * 2);
#define G3_DSR(dst, addr, off) asm volatile("ds_read_b128 %0, %1 offset:" #off : "=v"(dst) : "v"(addr))
  for (int kt = 0; kt < nk; kt++) {
    if (kt + 1 < nk) {
      if (NI == 4) asm volatile("s_waitcnt vmcnt(6)" ::: "memory");
      else asm volatile("s_waitcnt vmcnt(5)" ::: "memory");
    } else {
      asm volatile("s_waitcnt vmcnt(0)" ::: "memory");
    }
    __builtin_amdgcn_s_barrier();
    if (kt + 2 < nk) {
      const int kof = (kt + 2) * 32;
      u16* st_ = sm + nxt * G3_STAGE;
      REP4(G3_ISSUE)
    }
    const unsigned aaddr = aoff + (unsigned)cur * (G3_STAGE * 2);
    const unsigned baddr = boff + (unsigned)cur * (G3_STAGE * 2);
    bf16x8 af[8], bf[NI];
    G3_DSR(af[0], aaddr, 0); G3_DSR(af[1], aaddr, 1024); G3_DSR(af[2], aaddr, 2048); G3_DSR(af[3], aaddr, 3072);
    G3_DSR(bf[0], baddr, 0); G3_DSR(bf[1], baddr, 1024);
    if (NI == 4) { G3_DSR(bf[NI - 2], baddr, 2048); G3_DSR(bf[NI - 1], baddr, 3072); }
    G3_DSR(af[4], aaddr, 4096); G3_DSR(af[5], aaddr, 5120); G3_DSR(af[6], aaddr, 6144); G3_DSR(af[7], aaddr, 7168);
    if (NI == 4) {
      asm volatile("s_waitcnt lgkmcnt(4)"
                   : "+v"(af[0]), "+v"(af[1]), "+v"(af[2]), "+v"(af[3]), "+v"(bf[0]), "+v"(bf[1]), "+v"(bf[NI - 2]), "+v"(bf[NI - 1]));
    } else {
      asm volatile("s_waitcnt lgkmcnt(4)" : "+v"(af[0]), "+v"(af[1]), "+v"(af[2]), "+v"(af[3]), "+v"(bf[0]), "+v"(bf[1]));
    }
#pragma unroll
    for (int mi = 0; mi < 4; mi++)
#pragma unroll
      for (int ni = 0; ni < NI; ni++)
        acc[mi][ni] = SWAP ? __builtin_amdgcn_mfma_f32_16x16x32_bf16(bf[ni], af[mi], acc[mi][ni], 0, 0, 0)
                           : __builtin_amdgcn_mfma_f32_16x16x32_bf16(af[mi], bf[ni], acc[mi][ni], 0, 0, 0);
    asm volatile("s_waitcnt lgkmcnt(0)" : "+v"(af[4]), "+v"(af[5]), "+v"(af[6]), "+v"(af[7]));
#pragma unroll
    for (int mi = 4; mi < 8; mi++)
#pragma unroll
      for (int ni = 0; ni < NI; ni++)
        acc[mi][ni] = SWAP ? __builtin_amdgcn_mfma_f32_16x16x32_bf16(bf[ni], af[mi], acc[mi][ni], 0, 0, 0)
                           : __builtin_amdgcn_mfma_f32_16x16x32_bf16(af[mi], bf[ni], acc[mi][ni], 0, 0, 0);
    cur = (cur == 2) ? 0 : cur + 1;
    nxt = (nxt == 2) ? 0 : nxt + 1;
  }
  asm volatile("s_waitcnt lgkmcnt(0)" ::: "memory");
  __syncthreads();
#undef G3_DSR
#undef G3_ISSUE
}

template <int NI>
__device__ __forceinline__ void zero_acc8(f32x4 (&acc)[8][NI]) {
#pragma unroll
  for (int i = 0; i < 8; i++)
#pragma unroll
    for (int j = 0; j < NI; j++) acc[i][j] = f32x4{0.f, 0.f, 0.f, 0.f};
}


__device__ __forceinline__ bool map_tile(int i, int nblk, int MT, int NT, int& mt, int& nt) {
  const int locs = nblk >> 3;
  const int xcd = blockIdx.x & 7, loc = blockIdx.x >> 3;
  const int q = (i * 8 + xcd) * locs + loc;
  if (q >= MT * NT) return false;
  const int nfull = NT >> 3, per = MT * 8;
  if (q < nfull * per) {
    int pp = q / per, r = q - pp * per;
    mt = r >> 3;
    nt = pp * 8 + (r & 7);
  } else {
    int r = q - nfull * per;
    int w = NT - nfull * 8;
    mt = r / w;
    nt = nfull * 8 + (r - mt * w);
  }
  return true;
}

#define ACC_COORDS const int wr = wave >> 1, wc = wave & 1, fr = lane & 15, fq = lane >> 4;

__device__ __forceinline__ void conv_tile(const Params& p, int t, char* smem, const int tid) {
  int j = 0;
#pragma unroll 1
  for (int i = 1; i < 26; i++)
    if (t >= p.jobs[i].tile0) j = i;
  const Job& jb = p.jobs[j];
  float(*tile)[65] = (float(*)[65])smem;
  int local = t - jb.tile0;
  int nkt = jb.Kpad >> 6;
  int kt = local % nkt, nt = local / nkt;
  int tx = tid & 63, ty = tid >> 6;
  int n = nt * 64 + tx;
  int col;
  if (jb.mode == 0) col = jb.c0 + n;
  else { int jn = n >> 7, i = n & 127; col = (i < 64) ? (64 * jn + i) : (DFF_ + 64 * jn + (i - 64)); }
  const float* sp = jb.src + col;
  const int K = jb.K, ld = jb.ld;
  const bool nok = n < jb.Nv;
#pragma unroll
  for (int i = 0; i < 16; i++) {
    int k = kt * 64 + ty + 4 * i;
    tile[ty + 4 * i][tx] = (nok && k < K) ? sp[(size_t)k * ld] : 0.f;
  }
  __syncthreads();
#pragma unroll
  for (int i = 0; i < 16; i++) {
    int nn = nt * 64 + ty + 4 * i;
    int k = kt * 64 + tx;
    jb.dst[(size_t)nn * jb.Kpad + k] = f2bf(tile[tx][ty + 4 * i]);
  }
  __syncthreads();
}

__device__ __forceinline__ void ln_row(const float* __restrict__ src, const float* __restrict__ g,
                                       const float* __restrict__ b, float* __restrict__ dst, int lane, u16* __restrict__ dstb = nullptr) {
  float4 v[4];
  float s = 0.f;
#pragma unroll
  for (int i = 0; i < 4; i++) {
    v[i] = *(const float4*)(src + i * 256 + lane * 4);
    s += v[i].x + v[i].y + v[i].z + v[i].w;
  }
  float mean = wave_sum(s, lane) * (1.0f / 1024.0f);
  float q = 0.f;
#pragma unroll
  for (int i = 0; i < 4; i++) {
    float a = v[i].x - mean, b2 = v[i].y - mean, c = v[i].z - mean, d = v[i].w - mean;
    q += a * a + b2 * b2 + c * c + d * d;
  }
  float rstd = rsqrtf(wave_sum(q, lane) * (1.0f / 1024.0f) + 1e-5f);
#pragma unroll
  for (int i = 0; i < 4; i++) {
    float4 gg = *(const float4*)(g + i * 256 + lane * 4);
    float4 bb = *(const float4*)(b + i * 256 + lane * 4);
    float4 o;
    o.x = (v[i].x - mean) * rstd * gg.x + bb.x;
    o.y = (v[i].y - mean) * rstd * gg.y + bb.y;
    o.z = (v[i].z - mean) * rstd * gg.z + bb.z;
    o.w = (v[i].w - mean) * rstd * gg.w + bb.w;
    *(float4*)(dst + i * 256 + lane * 4) = o;
    if (dstb) *(uint2*)(dstb + i * 256 + lane * 4) = make_uint2(pk2(o.x, o.y), pk2(o.z, o.w));
  }
}

__device__ __forceinline__ void ln_row2(const float* __restrict__ srcA, const float* __restrict__ srcB, const float* __restrict__ g,
                                        const float* __restrict__ b, float* dstA, float* dstB, int lane, u16* dbA, u16* dbB) {
  float4 va[4], vb[4];
  float sa = 0.f, sb = 0.f;
#pragma unroll
  for (int i = 0; i < 4; i++) {
    va[i] = *(const float4*)(srcA + i * 256 + lane * 4);
    vb[i] = *(const float4*)(srcB + i * 256 + lane * 4);
  }
#pragma unroll
  for (int i = 0; i < 4; i++) {
    sa += va[i].x + va[i].y + va[i].z + va[i].w;
    sb += vb[i].x + vb[i].y + vb[i].z + vb[i].w;
  }
  const float ma = wave_sum(sa, lane) * (1.0f / 1024.0f), mb = wave_sum(sb, lane) * (1.0f / 1024.0f);
  float qa = 0.f, qb = 0.f;
#pragma unroll
  for (int i = 0; i < 4; i++) {
    va[i].x -= ma; va[i].y -= ma; va[i].z -= ma; va[i].w -= ma;
    vb[i].x -= mb; vb[i].y -= mb; vb[i].z -= mb; vb[i].w -= mb;
    qa += va[i].x * va[i].x + va[i].y * va[i].y + va[i].z * va[i].z + va[i].w * va[i].w;
    qb += vb[i].x * vb[i].x + vb[i].y * vb[i].y + vb[i].z * vb[i].z + vb[i].w * vb[i].w;
  }
  const float ra = rsqrtf(wave_sum(qa, lane) * (1.0f / 1024.0f) + 1e-5f), rb = rsqrtf(wave_sum(qb, lane) * (1.0f / 1024.0f) + 1e-5f);
#pragma unroll
  for (int i = 0; i < 4; i++) {
    float4 gg = *(const float4*)(g + i * 256 + lane * 4);
    float4 bb = *(const float4*)(b + i * 256 + lane * 4);
    float4 oa, ob;
    oa.x = va[i].x * ra * gg.x + bb.x; oa.y = va[i].y * ra * gg.y + bb.y; oa.z = va[i].z * ra * gg.z + bb.z; oa.w = va[i].w * ra * gg.w + bb.w;
    ob.x = vb[i].x * rb * gg.x + bb.x; ob.y = vb[i].y * rb * gg.y + bb.y; ob.z = vb[i].z * rb * gg.z + bb.z; ob.w = vb[i].w * rb * gg.w + bb.w;
    *(float4*)(dstA + i * 256 + lane * 4) = oa;
    *(float4*)(dstB + i * 256 + lane * 4) = ob;
    if (dbA) {
      *(uint2*)(dbA + i * 256 + lane * 4) = make_uint2(pk2(oa.x, oa.y), pk2(oa.z, oa.w));
      *(uint2*)(dbB + i * 256 + lane * 4) = make_uint2(pk2(ob.x, ob.y), pk2(ob.z, ob.w));
    }
  }
}

struct ScanIn {
  float kk[16][64], wr[16][64], w[16][64], kt[16][64], kka[16][64], v[16][64], g[16][64];
  float c[16][4];
};
struct ScanRaw { uint2 r, k, v, rp, kp, vp, a, g; float4 dec; };

__device__ __forceinline__ ScanRaw scan_fetch(const u16* __restrict__ P, const float* __restrict__ DEC,
                                              const u16* __restrict__ AA, const u16* __restrict__ GG, int rowbase, int t,
                                              int hc) {
  ScanRaw w;
  size_t row = (size_t)(rowbase + t);
  const u16* pp = P + row * PC_ + hc;
  w.r = *(const uint2*)(pp);
  w.k = *(const uint2*)(pp + 512);
  w.v = *(const uint2*)(pp + 1024);
  if (t > 0) {
    w.rp = *(const uint2*)(pp - PC_);
    w.kp = *(const uint2*)(pp - PC_ + 512);
    w.vp = *(const uint2*)(pp - PC_ + 1024);
  } else {
    w.rp = make_uint2(0, 0); w.kp = make_uint2(0, 0); w.vp = make_uint2(0, 0);
  }
  w.dec = *(const float4*)(DEC + row * 512 + hc);
  w.a = *(const uint2*)(AA + row * 512 + hc);
  w.g = *(const uint2*)(GG + row * 512 + hc);
  return w;
}

__device__ __forceinline__ void unpack4(uint2 u, float (&o)[4]) {
  o[0] = bflo(u.x); o[1] = bfhi(u.x); o[2] = bflo(u.y); o[3] = bfhi(u.y);
}

__device__ __forceinline__ void scan_unit(const Params& p, int l, int bh, char* smem, const int tid) {
  const int lane = tid & 63, wave = tid >> 6;
  const int b = bh >> 3, h = bh & 7;
  const int rowbase = b * T_;
  const u16* P = (const u16*)(p.ws + OFF_P);
  const float* DEC = (const float*)(p.ws + OFF_DEC);
  const u16* AA = (const u16*)(p.ws + OFF_AA);
  const u16* GG = (const u16*)(p.ws + OFF_GG);
  u16* YR = (u16*)(p.ws + OFF_AA);
  ScanIn* in = (ScanIn*)smem;
  float(*ybuf)[64] = (float(*)[64])(smem + 2 * sizeof(ScanIn));
  const int tl = tid >> 4, kq = tid & 15, hc = h * 64 + kq * 4;
  float(*cst)[64] = (float(*)[64])(smem + 2 * sizeof(ScanIn) + 16 * 64 * 4);
  if (tid < 64) {
    const float* mu = p.in[5] + (size_t)l * 1824;
    const int ch = h * 64 + tid;
    cst[0][tid] = mu[ch];
    cst[1][tid] = mu[512 + ch];
    cst[2][tid] = mu[1024 + ch];
    cst[3][tid] = p.in[11][l * 512 + ch];
    float ka_ = p.in[12][l * 512 + ch];
    cst[4][tid] = ka_;
    cst[5][tid] = 1.0f - ka_;
    cst[6][tid] = p.in[13][l * 512 + ch];
    cst[7][tid] = p.in[14][l * 512 + ch];
    cst[8][tid] = p.in[15][l * 512 + ch];
  }
  __syncthreads();
  const int rp = lane >> 3, ks = lane & 7, row0 = wave * 16 + rp * 2;
  typedef float f2s __attribute__((ext_vector_type(2)));
  f2s S2[2][4];
#pragma unroll
  for (int i = 0; i < 2; i++)
#pragma unroll
    for (int e = 0; e < 4; e++) S2[i][e] = f2s{0.f, 0.f};

  auto stage = [&](const ScanRaw& w, ScanIn& dst) {
    float r[4], k[4], v[4], rq[4], kp[4], vp[4], a[4], g[4];
    unpack4(w.r, r); unpack4(w.k, k); unpack4(w.v, v);
    unpack4(w.rp, rq); unpack4(w.kp, kp); unpack4(w.vp, vp);
    unpack4(w.a, a); unpack4(w.g, g);
    float dec[4] = {w.dec.x, w.dec.y, w.dec.z, w.dec.w};
    float mu_r[4], mu_k[4], mu_v[4], kkw[4], kaw[4], omk[4], rkw[4];
    *(float4*)mu_r = *(const float4*)&cst[0][kq * 4]; *(float4*)mu_k = *(const float4*)&cst[1][kq * 4];
    *(float4*)mu_v = *(const float4*)&cst[2][kq * 4]; *(float4*)kkw = *(const float4*)&cst[3][kq * 4];
    *(float4*)kaw = *(const float4*)&cst[4][kq * 4]; *(float4*)omk = *(const float4*)&cst[5][kq * 4];
    *(float4*)rkw = *(const float4*)&cst[6][kq * 4];
    float kkr[4], ss = 0.f;
#pragma unroll
    for (int e = 0; e < 4; e++) {
      r[e] = r[e] + (rq[e] - r[e]) * mu_r[e];
      k[e] = k[e] + (kp[e] - k[e]) * mu_k[e];
      v[e] = v[e] + (vp[e] - v[e]) * mu_v[e];
      kkr[e] = k[e] * kkw[e];
      ss += kkr[e] * kkr[e];
    }
    ss = sum16(ss);
    float inv = rsqrtf(fmaxf(ss, 1e-24f));
    float c1 = 0.f, c2 = 0.f, c3 = 0.f;
    float kk[4], ktl[4], kka[4], wr[4];
#pragma unroll
    for (int e = 0; e < 4; e++) {
      kk[e] = kkr[e] * inv;
      ktl[e] = k[e] * fmaf(a[e], kaw[e], omk[e]);
      kka[e] = kk[e] * a[e];
      wr[e] = dec[e] * r[e];
      c1 += kka[e] * r[e];
      c2 += ktl[e] * r[e];
      c3 += r[e] * ktl[e] * rkw[e];
    }
    c1 = sum16(c1); c2 = sum16(c2); c3 = sum16(c3);
    *(float4*)&dst.kk[tl][kq * 4] = make_float4(kk[0], kk[1], kk[2], kk[3]);
    *(float4*)&dst.wr[tl][kq * 4] = make_float4(wr[0], wr[1], wr[2], wr[3]);
    *(float4*)&dst.w[tl][kq * 4] = make_float4(dec[0], dec[1], dec[2], dec[3]);
    *(float4*)&dst.kt[tl][kq * 4] = make_float4(ktl[0], ktl[1], ktl[2], ktl[3]);
    *(float4*)&dst.kka[tl][kq * 4] = make_float4(kka[0], kka[1], kka[2], kka[3]);
    *(float4*)&dst.v[tl][kq * 4] = make_float4(v[0], v[1], v[2], v[3]);
    *(float4*)&dst.g[tl][kq * 4] = make_float4(g[0], g[1], g[2], g[3]);
    if (kq == 0) *(float4*)&dst.c[tl][0] = make_float4(c1, c2, c3, 0.f);
  };

  {
    ScanRaw w0 = scan_fetch(P, DEC, AA, GG, rowbase, tl, hc);
    stage(w0, in[0]);
  }
  __syncthreads();
  constexpr int NCH = T_ / 16;
  for (int c = 0; c < NCH; c++) {
    ScanIn& cur = in[c & 1];
    ScanRaw nx;
    const bool have_next = (c + 1 < NCH);
    if (have_next) nx = scan_fetch(P, DEC, AA, GG, rowbase, (c + 1) * 16 + tl, hc);
    {
      typedef float f2 __attribute__((ext_vector_type(2)));
      struct StepA { float4 kk0, kk1, wr0, wr1; };
      struct StepIn { float4 kk0, kk1, wr0, wr1, w0, w1, kt0, kt1, ka0, ka1; float2 vv, cc; };
      auto ldA = [&](int s) {
        StepA r;
        r.kk0 = *(const float4*)&cur.kk[s][ks * 8]; r.kk1 = *(const float4*)&cur.kk[s][ks * 8 + 4];
        r.wr0 = *(const float4*)&cur.wr[s][ks * 8]; r.wr1 = *(const float4*)&cur.wr[s][ks * 8 + 4];
        return r;
      };
      StepA nxa = ldA(0);
#pragma unroll 1
      for (int s4 = 0; s4 < 16; s4 += 4) {
      float yv[4][2];
#pragma unroll
      for (int u = 0; u < 4; u++) {
        const int s = s4 + u;
        StepIn in_;
        in_.kk0 = nxa.kk0; in_.kk1 = nxa.kk1; in_.wr0 = nxa.wr0; in_.wr1 = nxa.wr1;
        in_.vv = *(const float2*)&cur.v[s][row0];
        in_.cc = *(const float2*)&cur.c[s][0];
        in_.w0 = *(const float4*)&cur.w[s][ks * 8];   in_.w1 = *(const float4*)&cur.w[s][ks * 8 + 4];
        in_.kt0 = *(const float4*)&cur.kt[s][ks * 8]; in_.kt1 = *(const float4*)&cur.kt[s][ks * 8 + 4];
        in_.ka0 = *(const float4*)&cur.kka[s][ks * 8]; in_.ka1 = *(const float4*)&cur.kka[s][ks * 8 + 4];
        nxa = ldA((s + 1) & 15);
        const f2 kk[4] = {{in_.kk0.x, in_.kk0.y}, {in_.kk0.z, in_.kk0.w}, {in_.kk1.x, in_.kk1.y}, {in_.kk1.z, in_.kk1.w}};
        const f2 wr[4] = {{in_.wr0.x, in_.wr0.y}, {in_.wr0.z, in_.wr0.w}, {in_.wr1.x, in_.wr1.y}, {in_.wr1.z, in_.wr1.w}};
        const f2 w[4] = {{in_.w0.x, in_.w0.y}, {in_.w0.z, in_.w0.w}, {in_.w1.x, in_.w1.y}, {in_.w1.z, in_.w1.w}};
        const f2 kt[4] = {{in_.kt0.x, in_.kt0.y}, {in_.kt0.z, in_.kt0.w}, {in_.kt1.x, in_.kt1.y}, {in_.kt1.z, in_.kt1.w}};
        const f2 ka[4] = {{in_.ka0.x, in_.ka0.y}, {in_.ka0.z, in_.ka0.w}, {in_.ka1.x, in_.ka1.y}, {in_.ka1.z, in_.ka1.w}};
        const float vr[2] = {in_.vv.x, in_.vv.y};
        float d1[2], d2[2];
#pragma unroll
        for (int i = 0; i < 2; i++) {
          f2 a = S2[i][0] * kk[0] + S2[i][1] * kk[1];
          f2 a2 = S2[i][2] * kk[2] + S2[i][3] * kk[3];
          f2 bq = S2[i][0] * wr[0] + S2[i][1] * wr[1];
          f2 b2 = S2[i][2] * wr[2] + S2[i][3] * wr[3];
          a += a2; bq += b2;
          d1[i] = a.x + a.y;
          d2[i] = bq.x + bq.y;
        }
        d1[0] = sum8(d1[0]); d1[1] = sum8(d1[1]); d2[0] = sum8(d2[0]); d2[1] = sum8(d2[1]);
#pragma unroll
        for (int i = 0; i < 2; i++) {
          const float skk = d1[i];
          yv[u][i] = d2[i] - skk * in_.cc.x + vr[i] * in_.cc.y;
          const f2 nsk = {-skk, -skk}, vv2 = {vr[i], vr[i]};
#pragma unroll
          for (int e = 0; e < 4; e++) S2[i][e] = S2[i][e] * w[e] + (nsk * ka[e] + vv2 * kt[e]);
        }
      }
      if (ks == 0) {
#pragma unroll
        for (int u = 0; u < 4; u++) *(float2*)&ybuf[s4 + u][row0] = make_float2(yv[u][0], yv[u][1]);
      }
      }
    }
    __syncthreads();
    {
      float4 y4 = *(const float4*)&ybuf[tl][kq * 4];
      float y[4] = {y4.x, y4.y, y4.z, y4.w};
      float mean = sum16(y[0] + y[1] + y[2] + y[3]) * (1.0f / 64.0f);
      float q = 0.f;
#pragma unroll
      for (int e = 0; e < 4; e++) { y[e] -= mean; q += y[e] * y[e]; }
      float rstd = rsqrtf(sum16(q) * (1.0f / 64.0f) + 64e-5f);
      float c3 = cur.c[tl][2];
      float4 v4 = *(const float4*)&cur.v[tl][kq * 4];
      float4 g4 = *(const float4*)&cur.g[tl][kq * 4];
      float vv[4] = {v4.x, v4.y, v4.z, v4.w};
      float gg[4] = {g4.x, g4.y, g4.z, g4.w};
      float o[4], lg[4], lb[4];
      *(float4*)lg = *(const float4*)&cst[7][kq * 4]; *(float4*)lb = *(const float4*)&cst[8][kq * 4];
#pragma unroll
      for (int e = 0; e < 4; e++) o[e] = (y[e] * rstd * lg[e] + lb[e] + c3 * vv[e]) * gg[e];
      size_t row = (size_t)(rowbase + c * 16 + tl);
      *(uint2*)(YR + row * 512 + hc) = make_uint2(pk2(o[0], o[1]), pk2(o[2], o[3]));
    }
    if (have_next) stage(nx, in[(c + 1) & 1]);
    __syncthreads();
  }
}

constexpr int KLD = 104, VLD = 72;
struct AttnSmem { u16 k[2][64 * KLD]; u16 v[2][64 * VLD]; };

__device__ __forceinline__ void attn_unit(const Params& p, int bh, int qi, char* smem, const int tid) {
  const int lane = tid & 63, wave = tid >> 6;
  const int fr = lane & 15, fq = lane >> 4;
  const int b = bh >> 3, h = bh & 7;
  const int rowbase = b * T_;
  u16* P = (u16*)(p.ws + OFF_P);
  const u16* Q = (const u16*)(p.ws + OFF_Q);
  const u16* KN = (const u16*)p.out;
  const u16* VT = (const u16*)p.out + (size_t)M_ * 512;
  const float2* ROPE = (const float2*)(p.ws + OFF_ROPE);
  AttnSmem* sm = (AttnSmem*)smem;
  const int qs = (qi == 0) ? 0 : 16 + (qi - 1) * 128;
  const int qn = (qi == 0) ? 16 : 128;
  const int q0 = qs + wave * 32;
  const bool wave_valid = (wave * 32 < qn);
  const int nkt = (qs + qn - 1) / 64 + 1;

  bf16x8 qf[2][3];
#pragma unroll
  for (int qb = 0; qb < 2; qb++) {
    int query = min(q0 + qb * 16 + fr, T_ - 1);
    const u16* qp = Q + (size_t)(rowbase + query) * 768 + h * 96;
    uint4 a0 = *(const uint4*)(qp + fq * 8);
    uint4 a1 = *(const uint4*)(qp + 32 + fq * 8);
    uint4 own = *(const uint4*)(qp + 64 + fq * 8);
    uint4 oth = *(const uint4*)(qp + 64 + (fq ^ 2) * 8);
    unsigned ow[4] = {own.x, own.y, own.z, own.w};
    unsigned tw[4] = {oth.x, oth.y, oth.z, oth.w};
    unsigned rw[4];
    const float2* rp = ROPE + (size_t)query * 16 + (fq & 1) * 8;
#pragma unroll
    for (int e = 0; e < 4; e++) {
      float2 cs0 = rp[2 * e], cs1 = rp[2 * e + 1];
      float o0 = bflo(ow[e]), o1 = bfhi(ow[e]);
      float t0 = bflo(tw[e]), t1 = bfhi(tw[e]);
      float r0, r1;
      if (fq < 2) { r0 = o0 * cs0.x - t0 * cs0.y; r1 = o1 * cs1.x - t1 * cs1.y; }
      else { r0 = t0 * cs0.y + o0 * cs0.x; r1 = t1 * cs1.y + o1 * cs1.x; }
      rw[e] = pk2(r0, r1);
    }
    uint4 a2 = make_uint4(rw[0], rw[1], rw[2], rw[3]);
    qf[qb][0] = *(bf16x8*)&a0;
    qf[qb][1] = *(bf16x8*)&a1;
    qf[qb][2] = *(bf16x8*)&a2;
  }

  f32x4 O[4][2];
#pragma unroll
  for (int i = 0; i < 4; i++)
#pragma unroll
    for (int j = 0; j < 2; j++) O[i][j] = f32x4{0.f, 0.f, 0.f, 0.f};
  float mrun[2] = {-1e30f, -1e30f}, lrun[2] = {0.f, 0.f};
  const float sc = 1.4426950408889634f / 9.797958971132712f;

  uint4 rk[3], rv[2];
  auto fetch_tile = [&](int kt) {
#pragma unroll
    for (int i = 0; i < 3; i++) {
      int c = tid + 256 * i;
      int key = c / 12, cc = c % 12;
      int t = kt * 64 + key;
      uint4 val = make_uint4(0, 0, 0, 0);
      if (t < T_) {
        size_t row = (size_t)(rowbase + t);
        if (cc < 8) val = *(const uint4*)(KN + row * 512 + h * 64 + cc * 8);
        else val = *(const uint4*)(P + row * PC_ + PKR_ + (cc - 8) * 8);
      }
      rk[i] = val;
    }
#pragma unroll
    for (int i = 0; i < 2; i++) {
      int c = tid + 256 * i;
      int dv = c >> 3, cc = c & 7;
      int t = kt * 64 + cc * 8;
      uint4 val = make_uint4(0, 0, 0, 0);
      if (t < T_) val = *(const uint4*)(VT + ((size_t)bh * 64 + dv) * T_ + t);
      rv[i] = val;
    }
  };
  auto store_tile = [&](int buf) {
#pragma unroll
    for (int i = 0; i < 3; i++) {
      int c = tid + 256 * i;
      int key = c / 12, cc = c % 12;
      *(uint4*)(&sm->k[buf][key * KLD + cc * 8]) = rk[i];
    }
#pragma unroll
    for (int i = 0; i < 2; i++) {
      int c = tid + 256 * i;
      int dv = c >> 3, cc = c & 7;
      *(uint4*)(&sm->v[buf][dv * VLD + cc * 8]) = rv[i];
    }
  };

  fetch_tile(0);
  for (int kt = 0; kt < nkt; kt++) {
    const int buf = kt & 1;
    store_tile(buf);
    __syncthreads();
    if (kt + 1 < nkt) fetch_tile(kt + 1);
    if (wave_valid && kt * 64 <= q0 + 31) {
      const u16* Ks = sm->k[buf];
      const u16* Vs = sm->v[buf];
      f32x4 s[4][2];
#pragma unroll
      for (int i = 0; i < 4; i++)
#pragma unroll
        for (int j = 0; j < 2; j++) s[i][j] = f32x4{0.f, 0.f, 0.f, 0.f};
#pragma unroll
      for (int ks = 0; ks < 3; ks++)
#pragma unroll
        for (int kb = 0; kb < 4; kb++) {
          bf16x8 kf = *(const bf16x8*)(Ks + (kb * 16 + fr) * KLD + ks * 32 + fq * 8);
#pragma unroll
          for (int qb = 0; qb < 2; qb++) s[kb][qb] = __builtin_amdgcn_mfma_f32_16x16x32_bf16(kf, qf[qb][ks], s[kb][qb], 0, 0, 0);
        }
      const bool need_mask = (kt * 64 + 63 > q0);
      unsigned pfw[2][2][4];
#pragma unroll
      for (int qb = 0; qb < 2; qb++) {
        const int query = q0 + qb * 16 + fr;
        float mx = -1e30f;
        if (need_mask) {
#pragma unroll
          for (int kb = 0; kb < 4; kb++)
#pragma unroll
            for (int j = 0; j < 4; j++) {
              int key = kt * 64 + kb * 16 + fq * 4 + j;
              if (key > query) s[kb][qb][j] = -1e30f;
            }
        }
#pragma unroll
        for (int kb = 0; kb < 4; kb++)
          mx = fmaxf(mx, fmaxf(fmaxf(s[kb][qb][0], s[kb][qb][1]), fmaxf(s[kb][qb][2], s[kb][qb][3])));
        mx = fmaxf(mx, shx(mx, lane, 16));
        mx = fmaxf(mx, shx(mx, lane, 32));
        const float mold = mrun[qb];
        const float mnew = fmaxf(mold, mx * sc);
        mrun[qb] = mnew;
        float ps = 0.f;
#pragma unroll
        for (int kb = 0; kb < 4; kb++) {
          float p0 = __builtin_amdgcn_exp2f(fmaf(s[kb][qb][0], sc, -mnew)), p1 = __builtin_amdgcn_exp2f(fmaf(s[kb][qb][1], sc, -mnew));
          float p2 = __builtin_amdgcn_exp2f(fmaf(s[kb][qb][2], sc, -mnew)), p3 = __builtin_amdgcn_exp2f(fmaf(s[kb][qb][3], sc, -mnew));
          ps += (p0 + p1) + (p2 + p3);
          pfw[qb][kb >> 1][(kb & 1) * 2 + 0] = pk2(p0, p1);
          pfw[qb][kb >> 1][(kb & 1) * 2 + 1] = pk2(p2, p3);
        }
        if (__builtin_amdgcn_ballot_w64(mnew != mold) != 0) {
          const float alpha = __builtin_amdgcn_exp2f(mold - mnew);
          lrun[qb] *= alpha;
#pragma unroll
          for (int dvb = 0; dvb < 4; dvb++) {
            O[dvb][qb][0] *= alpha; O[dvb][qb][1] *= alpha; O[dvb][qb][2] *= alpha; O[dvb][qb][3] *= alpha;
          }
        }
        lrun[qb] += ps;
      }
#pragma unroll
      for (int s2 = 0; s2 < 2; s2++)
#pragma unroll
        for (int dvb = 0; dvb < 4; dvb++) {
          const u16* vp = Vs + (dvb * 16 + fr) * VLD + s2 * 32 + fq * 4;
          uint2 v0 = *(const uint2*)vp;
          uint2 v1 = *(const uint2*)(vp + 16);
          uint4 vv = make_uint4(v0.x, v0.y, v1.x, v1.y);
          bf16x8 vf = *(bf16x8*)&vv;
#pragma unroll
          for (int qb = 0; qb < 2; qb++) {
            uint4 pw = make_uint4(pfw[qb][s2][0], pfw[qb][s2][1], pfw[qb][s2][2], pfw[qb][s2][3]);
            O[dvb][qb] = __builtin_amdgcn_mfma_f32_16x16x32_bf16(vf, *(bf16x8*)&pw, O[dvb][qb], 0, 0, 0);
          }
        }
    }
  }
  __syncthreads();
  if (wave_valid) {
#pragma unroll
    for (int qb = 0; qb < 2; qb++) {
      float l = lrun[qb];
      l += shx(l, lane, 16);
      l += shx(l, lane, 32);
      float inv = 1.0f / l;
      int query = q0 + qb * 16 + fr;
      if (query < qs + qn) {
        u16* op = P + (size_t)(rowbase + query) * PC_ + PMLA_ + h * 64 + fq * 4;
#pragma unroll
        for (int dvb = 0; dvb < 4; dvb++) {
          *(uint2*)(op + dvb * 16) =
              make_uint2(pk2(O[dvb][qb][0] * inv, O[dvb][qb][1] * inv), pk2(O[dvb][qb][2] * inv, O[dvb][qb][3] * inv));
        }
      }
    }
  }
}

#define XB_TMO      128
#define XB_XCNT(j)  (256  + 64 * (j))
#define XB_XSUB(j)  (1280 + 64 * (j))
#define XB_XGEN(j)  (2304 + 64 * (j))
#define XB_TOP      3328
#define XB_TOPGEN   3392
#define XCD_BAR_WORDS 3456
#define XB_SPIN_CAP (1u << 18)
#define LAS __attribute__((address_space(3)))

__device__ __forceinline__ unsigned xb_ld(unsigned* p)              { return __hip_atomic_load(p, __ATOMIC_RELAXED, __HIP_MEMORY_SCOPE_AGENT); }
__device__ __forceinline__ unsigned xb_add(unsigned* p, unsigned v) { return __hip_atomic_fetch_add(p, v, __ATOMIC_RELAXED, __HIP_MEMORY_SCOPE_AGENT); }
__device__ __forceinline__ unsigned xb_xcc_id() { return (unsigned)__builtin_amdgcn_s_getreg((3 << 11) | 20) & 0xFu; }
#define XB_SPIN(cond, bar) do { unsigned _sp = 0; while (cond) { __builtin_amdgcn_s_sleep(1); \
    if ((++_sp & 255u) == 0u) { if (xb_ld(&(bar)[XB_TMO])) break; if (_sp > XB_SPIN_CAP) { atomicAdd(&(bar)[XB_TMO], 1u); break; } } } } while (0)

struct XcdBarrier {
    unsigned* bar; unsigned x;
    volatile LAS unsigned* st;
};

__device__ __forceinline__ XcdBarrier xcd_barrier_post(unsigned* bar, volatile LAS unsigned* st) {
    XcdBarrier b; b.bar = bar; b.x = xb_xcc_id(); b.st = st;
    if (threadIdx.x == 0) (void)xb_add(&bar[XB_XCNT(b.x)], 1u);
    return b;
}
__device__ __forceinline__ void xcd_barrier_complete(unsigned* bar, unsigned x, unsigned& nloc, unsigned& nx) {
    const unsigned G = gridDim.x * gridDim.y * gridDim.z;
    unsigned sum, cnt, mine, sp = 0u;
    for (;;) {
        sum = 0u; cnt = 0u; mine = 0u;
#pragma unroll
        for (unsigned j = 0; j < 16; ++j) { const unsigned c = xb_ld(&bar[XB_XCNT(j)]); sum += c; cnt += (c > 0u) ? 1u : 0u; mine = (j == x) ? c : mine; }
        if (sum == G) break;
        __builtin_amdgcn_s_sleep(1);
        if ((++sp & 255u) == 0u) { if (xb_ld(&bar[XB_TMO])) break; if (sp > XB_SPIN_CAP) { atomicAdd(&bar[XB_TMO], 1u); break; } }
    }
    nloc = mine > 0u ? mine : 1u; nx = cnt > 0u ? cnt : 1u;
}

__device__ __forceinline__ void xcd_barrier(const XcdBarrier& b, const int tid_) {
    asm volatile("s_waitcnt vmcnt(0)" ::: "memory");
    __syncthreads();
    if (tid_ == 0) {
        unsigned* bar = b.bar;
        __builtin_amdgcn_s_waitcnt(0);
        unsigned nloc = b.st[0], nx = b.st[1];
        if (nloc == 0u) { xcd_barrier_complete(bar, b.x, nloc, nx); b.st[0] = nloc; b.st[1] = nx; }
        const unsigned old = xb_add(&bar[XB_XSUB(b.x)], 1u);
        const unsigned gen = old / nloc;
        if (old + 1u == (gen + 1u) * nloc) {
            __builtin_amdgcn_fence(__ATOMIC_RELEASE, "agent");
            asm volatile("s_waitcnt vmcnt(0)" ::: "memory");
            const unsigned og = xb_add(&bar[XB_TOP], 1u);
            const unsigned tg = og / nx;
            if (og + 1u == (tg + 1u) * nx) xb_add(&bar[XB_TOPGEN], 1u);
            else XB_SPIN(xb_ld(&bar[XB_TOPGEN]) == tg, bar);
            __builtin_amdgcn_fence(__ATOMIC_ACQUIRE, "agent");
            xb_add(&bar[XB_XGEN(b.x)], 1u);
            asm volatile("s_waitcnt vmcnt(0)" ::: "memory");
        } else {
            XB_SPIN(xb_ld(&bar[XB_XGEN(b.x)]) == gen, bar);
            __builtin_amdgcn_fence(__ATOMIC_ACQUIRE, "agent");
            asm volatile("s_waitcnt vmcnt(0)" ::: "memory");
        }
    }
    __syncthreads();
}


__global__ void __launch_bounds__(256, 2) mega(Params p) {
  cg::grid_group grid = cg::this_grid();
  __shared__ __attribute__((aligned(16))) char smem[SMEM_BYTES];
  __shared__ int s_unit;
  __shared__ uint4 xb_words;
  if (threadIdx.x == 0) xb_words = make_uint4(0u, 0u, 0u, 0u);
  __syncthreads();
  (void)xcd_barrier_post((unsigned*)(p.ws + OFF_BAR), (volatile LAS unsigned*)&xb_words);
#define XB_SYNC() do { XcdBarrier xb_; xb_.bar = (unsigned*)(p.ws + OFF_BAR); xb_.x = xb_xcc_id(); xb_.st = (volatile LAS unsigned*)&xb_words; xcd_barrier(xb_, wave0 * 64 + fresh_lane()); } while (0)
  int wave0 = __builtin_amdgcn_readfirstlane((int)(threadIdx.x >> 6));
  asm volatile("" : "+s"(wave0));
  const int nblk = gridDim.x;
#define H ((float*)(p.ws + OFF_H))
#define P ((u16*)(p.ws + OFF_P))
#define DEC ((float*)(p.ws + OFF_DEC))
#define AA ((u16*)(p.ws + OFF_AA))
#define GG ((u16*)(p.ws + OFF_GG))
#define Q ((u16*)(p.ws + OFF_Q))
#define MIX ((u16*)(p.ws + OFF_DEC))
#define HB1 ((u16*)p.out + (size_t)2 * M_ * 512)
#define HB2 ((u16*)(p.ws + OFF_HB2))
#define HBH ((u16*)(p.ws + OFF_AA))
#define ZERO ((const u16*)(p.ws + OFF_ZERO))
#define ACT ((u16*)(p.ws + OFF_P))
#define ROPE ((float2*)(p.ws + OFF_ROPE))
#define CTR ((int*)(p.ws + OFF_CTR))
#define KN ((u16*)p.out)
#define VT ((u16*)p.out + (size_t)M_ * 512)
#define YR ((u16*)(p.ws + OFF_AA))

  {
  PHASE_TID
  for (int t = blockIdx.x; t < p.jobs[13].tile0; t += nblk) conv_tile(p, t, smem, tid);
  for (int i = blockIdx.x * 256 + tid; i < T_ * 16; i += nblk * 256) {
    int t = i >> 4, f = i & 15;
    double rev = (double)t * ROPE_C[f];
    rev -= floor(rev);
    float r = (float)rev;
    ROPE[i] = make_float2(__builtin_amdgcn_cosf(r), __builtin_amdgcn_sinf(r));
  }
  for (int row = (blockIdx.x * 4 + wave) * 2; row < M_; row += nblk * 8) {
    int b = row / T_, t = row % T_;
    const float* srcA = (t < NMETA_) ? (p.in[1] + (size_t)t * 1024) : (p.in[0] + ((size_t)b * SEQ_ + (t - NMETA_)) * 1024);
    u16* hb = (row < HB_SPLIT) ? HB1 + (size_t)row * 1024 : HB2 + (size_t)(row - HB_SPLIT) * 1024;
    ln_row2(srcA, srcA + 1024, p.in[2], p.in[3], H + (size_t)row * 1024, H + (size_t)(row + 1) * 1024, lane, hb, hb + 1024);
  }
  if (blockIdx.x == 0 && tid < 16) CTR[tid] = 0;
  if (blockIdx.x == 1) { for (int i = tid; i < 2048; i += 256) ((unsigned*)(p.ws + OFF_ZERO))[i] = 0u; }
  }
  grid.sync();

#pragma unroll 1
  for (int ph_ = 0; ph_ < 20; ph_++) {
    const int l = ph_ / 10, kph = ph_ - l * 10;
    const u16* WL = (const u16*)(p.ws + OFF_W) + (size_t)l * W_LAYER;
    if (kph == 0) {
    PHASE_TID
    for (int it_ = 0; it_ * nblk < 257 * 19; it_++) {
      int mt, nt;
      if (!map_tile(it_, nblk, 257, 19, mt, nt)) continue;
      f32x4 acc[8][4];
      zero_acc8(acc);
      ADma al = ADma{(mt < 255) ? HB1 : HB2, 1024, (mt < 255) ? mt * 256 : mt * 256 - HB_SPLIT, 0, ZERO, 0};
      gemm3(acc, al, WL + W_IN, 1024, nt * 128, 1024, smem, tid);
      ACC_COORDS
#pragma unroll
      for (int mi = 0; mi < 8; mi++)
#pragma unroll
        for (int ni = 0; ni < 4; ni++) {
          int col = nt * 128 + wc * 64 + ni * 16 + fq * 4;
          int row = mt * 256 + wr * 128 + mi * 16 + fr;
          if (col < PC_)
            *(uint2*)(P + (size_t)row * PC_ + col) = make_uint2(pk2(acc[mi][ni][0], acc[mi][ni][1]), pk2(acc[mi][ni][2], acc[mi][ni][3]));
        }
    }
    }
    if (kph == 1) {
    PHASE_TID
    {
      const float* qg = p.in[16] + l * 256;
      const float* kvg = p.in[18] + l * 256;
      for (int rbase = (blockIdx.x * 4 + wave) * 4; rbase < M_; rbase += nblk * 16) {
        const int row = rbase + (lane >> 4), sl = lane & 15;
        u16* pr = P + (size_t)row * PC_;
        uint4 q0 = *(const uint4*)(pr + PMLA_ + sl * 16), q1 = *(const uint4*)(pr + PMLA_ + sl * 16 + 8);
        uint4 k0 = *(const uint4*)(pr + PKV_ + sl * 16), k1 = *(const uint4*)(pr + PKV_ + sl * 16 + 8);
        const int t = row % T_;
        float x1 = bf2f(pr[PKR_ + sl]), x2 = bf2f(pr[PKR_ + 16 + sl]);
        float2 cs = ROPE[t * 16 + sl];
        const unsigned qw[8] = {q0.x, q0.y, q0.z, q0.w, q1.x, q1.y, q1.z, q1.w};
        const unsigned kw[8] = {k0.x, k0.y, k0.z, k0.w, k1.x, k1.y, k1.z, k1.w};
        float s1 = 0.f, s2 = 0.f;
#pragma unroll
        for (int e = 0; e < 8; e++) {
          float a0 = bflo(qw[e]), a1 = bfhi(qw[e]), c0 = bflo(kw[e]), c1 = bfhi(kw[e]);
          s1 += a0 * a0 + a1 * a1;
          s2 += c0 * c0 + c1 * c1;
        }
        s1 = sum16(s1);
        s2 = sum16(s2);
        const float r1 = rsqrtf(s1 * (1.0f / 256.0f) + 1e-6f), r2 = rsqrtf(s2 * (1.0f / 256.0f) + 1e-6f);
        unsigned oq[8], ok[8];
#pragma unroll
        for (int e = 0; e < 8; e++) {
          float2 g1 = *(const float2*)(qg + sl * 16 + 2 * e), g2 = *(const float2*)(kvg + sl * 16 + 2 * e);
          oq[e] = pk2(bflo(qw[e]) * r1 * g1.x, bfhi(qw[e]) * r1 * g1.y);
          ok[e] = pk2(bflo(kw[e]) * r2 * g2.x, bfhi(kw[e]) * r2 * g2.y);
        }
        *(uint4*)(pr + PMLA_ + sl * 16) = make_uint4(oq[0], oq[1], oq[2], oq[3]);
        *(uint4*)(pr + PMLA_ + sl * 16 + 8) = make_uint4(oq[4], oq[5], oq[6], oq[7]);
        *(uint4*)(pr + PKV_ + sl * 16) = make_uint4(ok[0], ok[1], ok[2], ok[3]);
        *(uint4*)(pr + PKV_ + sl * 16 + 8) = make_uint4(ok[4], ok[5], ok[6], ok[7]);
        pr[PKR_ + sl] = f2bf(x1 * cs.x - x2 * cs.y);
        pr[PKR_ + 16 + sl] = f2bf(x1 * cs.y + x2 * cs.x);
      }
      const float* mu = p.in[5] + (size_t)l * 1824;
      for (int tile = blockIdx.x; tile < 514 * 12; tile += nblk) {
        int mt = tile / 12, sub = tile % 12, which = sub >> 2, nt = sub & 3;
        f32x4 acc[4][4];
        zero_acc(acc);
        ACC_COORDS
        if (which == 0) {
          AL<3> al{P + 1536, PC_, mt * 128, 0, 64, mu + 1536, 0};
          gemm_loop(acc, al, WL + W_LW, 64, nt * 128, 64, smem, tid);
          const float* w0 = p.in[6] + l * 512;
#pragma unroll
          for (int mi = 0; mi < 4; mi++)
#pragma unroll
            for (int ni = 0; ni < 4; ni++) {
              int col = nt * 128 + wc * 64 + ni * 16 + fr;
              float w0c = w0[col];
#pragma unroll
              for (int j = 0; j < 4; j++) {
                int row = mt * 128 + wr * 64 + mi * 16 + fq * 4 + j;
                float x = -(acc[mi][ni][j] + w0c);
                float sp = fmaxf(x, 0.f) + __logf(1.0f + __expf(-fabsf(x)));
                float wraw = -sp - 0.5f;
                DEC[(size_t)row * 512 + col] = __expf(-__expf(wraw));
              }
            }
        } else if (which == 1) {
          AL<3> al{P + 1600, PC_, mt * 128, 0, 64, mu + 1600, 1};
          gemm_loop(acc, al, WL + W_LA, 64, nt * 128, 64, smem, tid);
          const float* a0 = p.in[8] + l * 512;
#pragma unroll
          for (int mi = 0; mi < 4; mi++)
#pragma unroll
            for (int ni = 0; ni < 4; ni++) {
              int col = nt * 128 + wc * 64 + ni * 16 + fr;
              float a0c = a0[col];
#pragma unroll
              for (int j = 0; j < 4; j++) {
                int row = mt * 128 + wr * 64 + mi * 16 + fq * 4 + j;
                AA[(size_t)row * 512 + col] = f2bf(sigmoidf_(acc[mi][ni][j] + a0c));
              }
            }
        } else {
          AL<3> al{P + 1664, PC_, mt * 128, 0, 160, mu + 1664, 2};
          gemm_loop(acc, al, WL + W_LG, 192, nt * 128, 192, smem, tid);
#pragma unroll
          for (int mi = 0; mi < 4; mi++)
#pragma unroll
            for (int ni = 0; ni < 4; ni++) {
              int col = nt * 128 + wc * 64 + ni * 16 + fr;
#pragma unroll
              for (int j = 0; j < 4; j++) {
                int row = mt * 128 + wr * 64 + mi * 16 + fq * 4 + j;
                GG[(size_t)row * 512 + col] = f2bf(acc[mi][ni][j]);
              }
            }
        }
      }
    }
    }
    if (kph == 2) {
    PHASE_TID
    for (int it_ = 0; it_ * nblk < 257 * 14; it_++) {
      int mt, sub;
      if (!map_tile(it_, nblk, 257, 14, mt, sub)) continue;
      f32x4 acc[8][4];
      zero_acc8(acc);
      ACC_COORDS
      if (sub < 6) {
        ADma al{P + PMLA_, PC_, mt * 256, 0, ZERO, 0};
        gemm3(acc, al, WL + W_UQ, 256, sub * 128, 256, smem, tid);
#pragma unroll
        for (int mi = 0; mi < 8; mi++)
#pragma unroll
          for (int ni = 0; ni < 4; ni++) {
            int col = sub * 128 + wc * 64 + ni * 16 + fq * 4;
            int row = mt * 256 + wr * 128 + mi * 16 + fr;
            *(uint2*)(Q + (size_t)row * 768 + col) = make_uint2(pk2(acc[mi][ni][0], acc[mi][ni][1]), pk2(acc[mi][ni][2], acc[mi][ni][3]));
          }
      } else if (sub < 10) {
        int nt = sub - 6;
        ADma al{P + PKV_, PC_, mt * 256, 0, ZERO, 0};
        gemm3(acc, al, WL + W_UK, 256, nt * 128, 256, smem, tid);
#pragma unroll
        for (int mi = 0; mi < 8; mi++)
#pragma unroll
          for (int ni = 0; ni < 4; ni++) {
            int col = nt * 128 + wc * 64 + ni * 16 + fq * 4;
            int row = mt * 256 + wr * 128 + mi * 16 + fr;
            *(uint2*)(KN + (size_t)row * 512 + col) = make_uint2(pk2(acc[mi][ni][0], acc[mi][ni][1]), pk2(acc[mi][ni][2], acc[mi][ni][3]));
          }
      } else {
        int nt = sub - 10;
        ADma al{P + PKV_, PC_, mt * 256, 0, ZERO, 0};
        gemm3<4, false>(acc, al, WL + W_UV, 256, nt * 128, 256, smem, tid);
#pragma unroll
        for (int mi = 0; mi < 8; mi++)
#pragma unroll
          for (int ni = 0; ni < 4; ni++) {
            int col = nt * 128 + wc * 64 + ni * 16 + fr;
            int row = mt * 256 + wr * 128 + mi * 16 + fq * 4;
            int b = row / T_, t = row % T_;
            size_t o = ((size_t)(b * 512 + col)) * T_ + t;
            *(uint2*)(VT + o) = make_uint2(pk2(acc[mi][ni][0], acc[mi][ni][1]), pk2(acc[mi][ni][2], acc[mi][ni][3]));
          }
      }
    }
    }
    if (kph == 3) {
    PHASE_TID
    {
      const int xcd = blockIdx.x & 7, loc = blockIdx.x >> 3;
      const int total = 16 * 33;
      const bool scan_wg = (loc < 16), partner = (loc >= (nblk >> 4) && loc < (nblk >> 4) + 16);
      if (scan_wg) {
        scan_unit(p, l, xcd * 16 + loc, smem, launder(tid));
        __syncthreads();
      }
      if (partner && l == 0) {
        const int pidx = (loc - (nblk >> 4)) * 8 + xcd;
        for (int t = p.jobs[13].tile0 + pidx; t < p.nconv; t += 128) conv_tile(p, t, smem, launder(tid));
      }
      if (!partner) {
        while (true) {
          if (tid == 0) s_unit = atomicAdd(&CTR[l * 8 + xcd], 1);
          __syncthreads();
          int v = s_unit;
          __syncthreads();
          if (v >= total) break;
          const int tidu = launder(tid);
          int g = v / 66, w = v - g * 66;
          attn_unit(p, xcd * 16 + g * 2 + (w & 1), 32 - (w >> 1), smem, tidu);
          __syncthreads();
        }
      }
    }
    }
    if (kph == 4) {
    PHASE_TID
    {
    u16* scr = (u16*)(p.ws + OFF_SCR) + (size_t)blockIdx.x * 32768;
    for (int it_ = 0; it_ * nblk < 256 * 8; it_++) {
      int mt, nt;
      if (!map_tile(it_, nblk, 256, 8, mt, nt)) continue;
      f32x4 acc[8][4];
      ADma alh = ADma{(mt < 255) ? HB1 : HB2, 1024, (mt < 255) ? mt * 256 : mt * 256 - HB_SPLIT, 0, ZERO, 0};
      zero_acc8(acc);
      gemm3(acc, alh, WL + W_G, 1024, nt * 128, 1024, smem, launder(tid));
      { const int tq_ = launder(tid); const int lane = tq_ & 63, wave = tq_ >> 6; ACC_COORDS
#pragma unroll
        for (int mi = 0; mi < 8; mi++)
#pragma unroll
          for (int ni = 0; ni < 4; ni++) {
            int col = nt * 128 + wc * 64 + ni * 16 + fq * 4;
            int row = mt * 256 + wr * 128 + mi * 16 + fr;
            *(uint2*)(MIX + (size_t)row * 1024 + col) = make_uint2(pk2(sigmoidf_(acc[mi][ni][0]), sigmoidf_(acc[mi][ni][1])),
                                                                   pk2(sigmoidf_(acc[mi][ni][2]), sigmoidf_(acc[mi][ni][3])));
          }
      }
      zero_acc8(acc);
      {
        ADma aly{YR, 512, mt * 256, 0, ZERO, 0};
        gemm3(acc, aly, WL + W_PR, 512, nt * 128, 512, smem, launder(tid));
      }
      { const int tq_ = launder(tid); const int lane = tq_ & 63, wave = tq_ >> 6; ACC_COORDS
#pragma unroll
        for (int mi = 0; mi < 8; mi++)
#pragma unroll
          for (int ni = 0; ni < 4; ni++) {
            int col = nt * 128 + wc * 64 + ni * 16 + fq * 4;
            int row = mt * 256 + wr * 128 + mi * 16 + fr;
            u16* mp = MIX + (size_t)row * 1024 + col;
            uint2 s = *(const uint2*)mp;
            *(uint2*)mp = make_uint2(pk2(bflo(s.x) * acc[mi][ni][0], bfhi(s.x) * acc[mi][ni][1]), pk2(bflo(s.y) * acc[mi][ni][2], bfhi(s.y) * acc[mi][ni][3]));
          }
      }
      zero_acc8(acc);
      gemm3(acc, alh, WL + W_G, 1024, 1024 + nt * 128, 1024, smem, launder(tid));
      { const int tq_ = launder(tid); const int lane = tq_ & 63, wave = tq_ >> 6; ACC_COORDS
#pragma unroll
        for (int mi = 0; mi < 8; mi++)
#pragma unroll
          for (int ni = 0; ni < 4; ni++) {
            int cl = wc * 64 + ni * 16 + fq * 4, rl = wr * 128 + mi * 16 + fr;
            *(uint2*)(scr + rl * 128 + cl) = make_uint2(pk2(sigmoidf_(acc[mi][ni][0]), sigmoidf_(acc[mi][ni][1])),
                                                        pk2(sigmoidf_(acc[mi][ni][2]), sigmoidf_(acc[mi][ni][3])));
          }
      }
      zero_acc8(acc);
      {
        ADma alm{P + PMLA_, PC_, mt * 256, 0, ZERO, 0};
        gemm3(acc, alm, WL + W_PM, 512, nt * 128, 512, smem, launder(tid));
      }
      { const int tq_ = launder(tid); const int lane = tq_ & 63, wave = tq_ >> 6; ACC_COORDS
#pragma unroll
        for (int mi = 0; mi < 8; mi++)
#pragma unroll
          for (int ni = 0; ni < 4; ni++) {
            int cl = wc * 64 + ni * 16 + fq * 4, rl = wr * 128 + mi * 16 + fr;
            u16* mp = MIX + (size_t)(mt * 256 + rl) * 1024 + nt * 128 + cl;
            uint2 t1 = *(const uint2*)mp;
            uint2 s = *(const uint2*)(scr + rl * 128 + cl);
            float o0 = bflo(t1.x) + bflo(s.x) * acc[mi][ni][0];
            float o1 = bfhi(t1.x) + bfhi(s.x) * acc[mi][ni][1];
            float o2 = bflo(t1.y) + bflo(s.y) * acc[mi][ni][2];
            float o3 = bfhi(t1.y) + bfhi(s.y) * acc[mi][ni][3];
            *(uint2*)mp = make_uint2(pk2(o0, o1), pk2(o2, o3));
          }
      }
    }
    }
    if (blockIdx.x < 16) {
      const int mt = 256, nt = blockIdx.x;
      f32x4 acc[8][2];
      unsigned sg[8][2][2];
      ADma alh = ADma{(mt < 255) ? HB1 : HB2, 1024, (mt < 255) ? mt * 256 : mt * 256 - HB_SPLIT, 0, ZERO, 0};
      zero_acc8(acc);
      const int tid1 = launder(tid);
      gemm3(acc, alh, WL + W_G, 1024, nt * 64, 1024, smem, tid1);
#pragma unroll
      for (int mi = 0; mi < 8; mi++)
#pragma unroll
        for (int ni = 0; ni < 2; ni++) {
          sg[mi][ni][0] = pk2(sigmoidf_(acc[mi][ni][0]), sigmoidf_(acc[mi][ni][1]));
          sg[mi][ni][1] = pk2(sigmoidf_(acc[mi][ni][2]), sigmoidf_(acc[mi][ni][3]));
        }
      zero_acc8(acc);
      {
        ADma aly{YR, 512, mt * 256, 0, ZERO, 0};
        const int tid2 = launder(tid);
      gemm3(acc, aly, WL + W_PR, 512, nt * 64, 512, smem, tid2);
      }
{ const int tidq = launder(tid); const int lane = tidq & 63, wave = tidq >> 6; ACC_COORDS
#pragma unroll
      for (int mi = 0; mi < 8; mi++)
#pragma unroll
        for (int ni = 0; ni < 2; ni++) {
          int col = nt * 64 + wc * 32 + ni * 16 + fq * 4;
          int row = mt * 256 + wr * 128 + mi * 16 + fr;
          *(uint2*)(MIX + (size_t)row * 1024 + col) = make_uint2(pk2(bflo(sg[mi][ni][0]) * acc[mi][ni][0], bfhi(sg[mi][ni][0]) * acc[mi][ni][1]),
                                                                 pk2(bflo(sg[mi][ni][1]) * acc[mi][ni][2], bfhi(sg[mi][ni][1]) * acc[mi][ni][3]));
        }
      }
      zero_acc8(acc);
      const int tid3 = launder(tid);
      gemm3(acc, alh, WL + W_G, 1024, 1024 + nt * 64, 1024, smem, tid3);
#pragma unroll
      for (int mi = 0; mi < 8; mi++)
#pragma unroll
        for (int ni = 0; ni < 2; ni++) {
          sg[mi][ni][0] = pk2(sigmoidf_(acc[mi][ni][0]), sigmoidf_(acc[mi][ni][1]));
          sg[mi][ni][1] = pk2(sigmoidf_(acc[mi][ni][2]), sigmoidf_(acc[mi][ni][3]));
        }
      zero_acc8(acc);
      {
        ADma alm{P + PMLA_, PC_, mt * 256, 0, ZERO, 0};
        const int tid4 = launder(tid);
      gemm3(acc, alm, WL + W_PM, 512, nt * 64, 512, smem, tid4);
      }
{ const int tidq = launder(tid); const int lane = tidq & 63, wave = tidq >> 6; ACC_COORDS
#pragma unroll
      for (int mi = 0; mi < 8; mi++)
#pragma unroll
        for (int ni = 0; ni < 2; ni++) {
          int col = nt * 64 + wc * 32 + ni * 16 + fq * 4;
          int row = mt * 256 + wr * 128 + mi * 16 + fr;
          uint2 pm = *(const uint2*)(MIX + (size_t)row * 1024 + col);
          float o0 = bflo(pm.x) + bflo(sg[mi][ni][0]) * acc[mi][ni][0];
          float o1 = bfhi(pm.x) + bfhi(sg[mi][ni][0]) * acc[mi][ni][1];
          float o2 = bflo(pm.y) + bflo(sg[mi][ni][1]) * acc[mi][ni][2];
          float o3 = bfhi(pm.y) + bfhi(sg[mi][ni][1]) * acc[mi][ni][3];
          *(uint2*)(MIX + (size_t)row * 1024 + col) = make_uint2(pk2(o0, o1), pk2(o2, o3));
        }
      }
    }
    }
    if (kph == 5) {
    PHASE_TID
    for (int prb_ = (PROBE_FI ? 0 : 1); prb_ < 2; prb_++)
    for (int it_ = 0; it_ * nblk < 256 * 8; it_++) {
      int mt, nt;
      if (!map_tile(it_, nblk, 256, 8, mt, nt)) continue;
      f32x4 acc[8][4];
      zero_acc8(acc);
      ACC_COORDS
      ADma al{MIX, 1024, mt * 256, 0, ZERO, 0};
      gemm3(acc, al, WL + W_OUT, 1024, nt * 128, 1024, smem, tid);
#pragma unroll
      for (int mi = 0; mi < 8; mi++)
#pragma unroll
        for (int ni = 0; ni < 4; ni++) {
          int col = nt * 128 + wc * 64 + ni * 16 + fq * 4;
          int row = mt * 256 + wr * 128 + mi * 16 + fr;
          float* hp = H + (size_t)row * 1024 + col;
          float* dp = (prb_ == 0) ? (p.out + (size_t)(row & 65535) * 1024 + col) : hp;
          float4 hv = *(const float4*)hp;
          hv.x = ALPHA_ * hv.x + acc[mi][ni][0];
          hv.y = ALPHA_ * hv.y + acc[mi][ni][1];
          hv.z = ALPHA_ * hv.z + acc[mi][ni][2];
          hv.w = ALPHA_ * hv.w + acc[mi][ni][3];
          *(float4*)dp = hv;
        }
    }
    if (blockIdx.x < 16) {
      const int mt = 256, n0 = blockIdx.x * 64;
      f32x4 acc[8][2];
      zero_acc8(acc);
      ADma al{MIX, 1024, mt * 256, 0, ZERO, 0};
      gemm3(acc, al, WL + W_OUT, 1024, n0, 1024, smem, launder(tid));
      const int tq_ = launder(tid);
      const int lane = tq_ & 63, wave = tq_ >> 6;
      ACC_COORDS
#pragma unroll
      for (int mi = 0; mi < 8; mi++)
#pragma unroll
        for (int ni = 0; ni < 2; ni++) {
          int col = n0 + wc * 32 + ni * 16 + fq * 4;
          int row = mt * 256 + wr * 128 + mi * 16 + fr;
          float* hp = H + (size_t)row * 1024 + col;
          float4 hv = *(const float4*)hp;
          hv.x = ALPHA_ * hv.x + acc[mi][ni][0];
          hv.y = ALPHA_ * hv.y + acc[mi][ni][1];
          hv.z = ALPHA_ * hv.z + acc[mi][ni][2];
          hv.w = ALPHA_ * hv.w + acc[mi][ni][3];
          *(float4*)hp = hv;
        }
    }
    }
    if (kph == 6) {
    PHASE_TID
    for (int row = (blockIdx.x * 4 + wave) * 2; row < M_; row += nblk * 8)
      ln_row2(H + (size_t)row * 1024, H + (size_t)(row + 1) * 1024, p.in[24] + l * 1024, p.in[25] + l * 1024, H + (size_t)row * 1024, H + (size_t)(row + 1) * 1024, lane, HBH + (size_t)row * 1024, HBH + (size_t)(row + 1) * 1024);
    }
    if (kph == 7) {
    PHASE_TID
    {
      const float* cw = p.in[27] + (size_t)l * 3 * 5632;
      const float* cb = p.in[28] + (size_t)l * 5632;
#if PROBE_HOT
      for (int it_ = 0; it_ * nblk < 272 * 44; it_++) {
        int rest, nt;
        if (!map_tile(it_, nblk, 272, 44, rest, nt)) continue;
        f32x4 acc[8][4];
        zero_acc8(acc);
#if PROBE_HOT == 1
        ADma al{HBH, 1024, 0, 0, ZERO, 1, p.ws};
        gemm3(acc, al, WL + W_UP, 1024, 0, 1024, smem, tid);
#else
        int it = rest % 17, b = rest / 17;
        ADma al{HBH, 1024, b * T_, 254 * it - 2, ZERO, 1, p.ws};
        gemm3(acc, al, WL + W_UP, 1024, nt * 128, 1024, smem, tid);
#endif
        float sacc = 0.f;
#pragma unroll
        for (int mi = 0; mi < 8; mi++)
#pragma unroll
          for (int ni = 0; ni < 4; ni++) sacc += acc[mi][ni][0] + acc[mi][ni][1] + acc[mi][ni][2] + acc[mi][ni][3];
        if (sacc == 12345.678f) ACT[tid] = 0;
      }
#endif
      for (int it_ = 0; it_ * nblk < 272 * 44; it_++) {
        int rest, nt;
        if (!map_tile(it_, nblk, 272, 44, rest, nt)) continue;
        int it = rest % 17, b = rest / 17;
        int t0 = 254 * it - 2;
        f32x4 acc[8][4];
        zero_acc8(acc);
        ADma al{HBH, 1024, b * T_, t0, ZERO, 1, p.ws};
        gemm3(acc, al, WL + W_UP, 1024, nt * 128, 1024, smem, launder(tid));
        ACC_COORDS
        float(*ut)[132] = (float(*)[132])smem;
        const int tidh = launder(tid);
        typedef float f2c __attribute__((ext_vector_type(2)));
        const int c2 = (tidh & 31) * 2, rg = tidh >> 5;
        const int gcol = nt * 64 + c2, vcol = DFF_ + nt * 64 + c2;
        const f2c g0 = *(const f2c*)(cw + gcol), g1 = *(const f2c*)(cw + 5632 + gcol), g2 = *(const f2c*)(cw + 2 * 5632 + gcol), gb = *(const f2c*)(cb + gcol);
        const f2c v0 = *(const f2c*)(cw + vcol), v1 = *(const f2c*)(cw + 5632 + vcol), v2 = *(const f2c*)(cw + 2 * 5632 + vcol), vb = *(const f2c*)(cb + vcol);
#pragma unroll 1
        for (int half = 0; half < 2; half++) {
          float carry = 0.f;
          if (half == 1) carry = ut[126 + (tid >> 7)][tid & 127];
          __syncthreads();
          if (half == 1) ut[tid >> 7][tid & 127] = carry;
          if (wr == half) {
#pragma unroll
            for (int mi = 0; mi < 8; mi++)
#pragma unroll
              for (int ni = 0; ni < 4; ni++)
                *(float4*)&ut[half * 2 + mi * 16 + fr][wc * 64 + ni * 16 + fq * 4] = make_float4(acc[mi][ni][0], acc[mi][ni][1], acc[mi][ni][2], acc[mi][ni][3]);
          }
          __syncthreads();
          const int nq = half ? 130 : 128;
          int qs = 2 + rg * 16, qe = min(qs + 16, nq);
          f2c ga = *(const f2c*)&ut[qs - 2][c2], gbp = *(const f2c*)&ut[qs - 1][c2];
          f2c va = *(const f2c*)&ut[qs - 2][64 + c2], vbp = *(const f2c*)&ut[qs - 1][64 + c2];
#pragma unroll 4
          for (int q = qs; q < qe; q++) {
            f2c gc = *(const f2c*)&ut[q][c2], vc = *(const f2c*)&ut[q][64 + c2];
            int t = t0 + half * 126 + q;
            if (t < T_) {
              f2c gate = g0 * ga + g1 * gbp + g2 * gc + gb;
              f2c val = v0 * va + v1 * vbp + v2 * vc + vb;
              float a0 = gate.x * sigmoidf_(gate.x) * val.x, a1 = gate.y * sigmoidf_(gate.y) * val.y;
              *(unsigned*)(ACT + (size_t)(b * T_ + t) * DFF_ + gcol) = pk2(a0, a1);
            }
            ga = gbp; gbp = gc; va = vbp; vbp = vc;
          }
        }
        __syncthreads();
      }
    }
    }
    if (kph == 8) {
    PHASE_TID
    for (int prb_ = (PROBE_FI ? 0 : 1); prb_ < 2; prb_++)
    for (int it_ = 0; it_ * nblk < 256 * 8; it_++) {
      int mt, nt;
      if (!map_tile(it_, nblk, 256, 8, mt, nt)) continue;
      f32x4 acc[8][4];
      zero_acc8(acc);
      ACC_COORDS
      ADma al{ACT, DFF_, mt * 256, 0, ZERO, 0};
      gemm3(acc, al, WL + W_DN, DFF_, nt * 128, DFF_, smem, tid);
#pragma unroll
      for (int mi = 0; mi < 8; mi++)
#pragma unroll
        for (int ni = 0; ni < 4; ni++) {
          int col = nt * 128 + wc * 64 + ni * 16 + fq * 4;
          int row = mt * 256 + wr * 128 + mi * 16 + fr;
          float* hp = H + (size_t)row * 1024 + col;
          float* dp = (prb_ == 0) ? (p.out + (size_t)(row & 65535) * 1024 + col) : hp;
          float4 hv = *(const float4*)hp;
          hv.x = ALPHA_ * hv.x + acc[mi][ni][0];
          hv.y = ALPHA_ * hv.y + acc[mi][ni][1];
          hv.z = ALPHA_ * hv.z + acc[mi][ni][2];
          hv.w = ALPHA_ * hv.w + acc[mi][ni][3];
          *(float4*)dp = hv;
        }
    }
    if (blockIdx.x < 16) {
      const int mt = 256, n0 = blockIdx.x * 64;
      f32x4 acc[8][2];
      zero_acc8(acc);
      ADma al{ACT, DFF_, mt * 256, 0, ZERO, 0};
      gemm3(acc, al, WL + W_DN, DFF_, n0, DFF_, smem, launder(tid));
      const int tq_ = launder(tid);
      const int lane = tq_ & 63, wave = tq_ >> 6;
      ACC_COORDS
#pragma unroll
      for (int mi = 0; mi < 8; mi++)
#pragma unroll
        for (int ni = 0; ni < 2; ni++) {
          int col = n0 + wc * 32 + ni * 16 + fq * 4;
          int row = mt * 256 + wr * 128 + mi * 16 + fr;
          float* hp = H + (size_t)row * 1024 + col;
          float4 hv = *(const float4*)hp;
          hv.x = ALPHA_ * hv.x + acc[mi][ni][0];
          hv.y = ALPHA_ * hv.y + acc[mi][ni][1];
          hv.z = ALPHA_ * hv.z + acc[mi][ni][2];
          hv.w = ALPHA_ * hv.w + acc[mi][ni][3];
          *(float4*)hp = hv;
        }
    }
    }
    if (kph == 9) {
    PHASE_TID
    if (l == 0) {
      for (int row = (blockIdx.x * 4 + wave) * 2; row < M_; row += nblk * 8) {
        u16* hb = (row < HB_SPLIT) ? HB1 + (size_t)row * 1024 : HB2 + (size_t)(row - HB_SPLIT) * 1024;
        ln_row2(H + (size_t)row * 1024, H + (size_t)(row + 1) * 1024, p.in[30], p.in[31], H + (size_t)row * 1024, H + (size_t)(row + 1) * 1024, lane, hb, hb + 1024);
      }
    } else {
      for (int row = (blockIdx.x * 4 + wave) * 2; row < M_; row += nblk * 8) {
        int b = row / T_, t = row % T_;
        if (t >= NMETA_) {
          float* o = p.out + ((size_t)b * SEQ_ + (t - NMETA_)) * 1024;
          ln_row2(H + (size_t)row * 1024, H + (size_t)(row + 1) * 1024, p.in[30] + 1024, p.in[31] + 1024, o, o + 1024, lane, nullptr, nullptr);
        }
      }
    }
    }
    if (ph_ != 19) XB_SYNC();
  }
}

#undef H
#undef P
#undef DEC
#undef AA
#undef GG
#undef Q
#undef MIX
#undef HB1
#undef HB2
#undef HBH
#undef ZERO
#undef ACT
#undef ROPE
#undef CTR
#undef KN
#undef VT
#undef YR

extern "C" void kernel_launch(void* const* d_in, const int* in_sizes, int n_in, void* d_out, int out_size, void* d_ws,
                              size_t ws_size, hipStream_t stream) {
  static int grid_blocks = 0;
  if (!grid_blocks) {
    int dev = 0, cus = 0, per_cu = 0;
    hipGetDevice(&dev);
    hipDeviceGetAttribute(&cus, hipDeviceAttributeMultiprocessorCount, dev);
    hipOccupancyMaxActiveBlocksPerMultiprocessor(&per_cu, mega, 256, 0);
    if (per_cu > 2) per_cu = 2;
    grid_blocks = cus * per_cu;
  }
  if (ws_size < WS_TOTAL) fprintf(stderr, "workspace too small: %zu < %zu\n", ws_size, (size_t)WS_TOTAL);
  Params p;
  memset(&p, 0, sizeof(p));
  for (int i = 0; i < 32; i++) p.in[i] = (const float*)d_in[i];
  p.out = (float*)d_out;
  p.ws = (char*)d_ws;
  u16* wb = (u16*)((char*)d_ws + OFF_W);
  int nj = 0, tiles = 0;
  auto add = [&](const float* src, size_t dst_off, int ld, int c0, int K, int Kpad, int Nv, int Np, int mode) {
    Job& j = p.jobs[nj++];
    j.src = src; j.dst = wb + dst_off; j.ld = ld; j.c0 = c0; j.K = K; j.Kpad = Kpad; j.Nv = Nv; j.Np = Np; j.mode = mode;
    j.tile0 = tiles;
    tiles += (Kpad / 64) * (Np / 64);
  };
  for (int l = 0; l < 2; l++) {
    size_t o = (size_t)l * W_LAYER;
    const float* w_in = (const float*)d_in[4] + (size_t)l * 1024 * 4416;
    add(w_in, o + W_IN, 4416, 0, 1024, 1024, 2368, 2432, 0);
    add(w_in, o + W_G, 4416, 2368, 1024, 1024, 2048, 2048, 0);
    add((const float*)d_in[7] + (size_t)l * 64 * 512, o + W_LW, 512, 0, 64, 64, 512, 512, 0);
    add((const float*)d_in[9] + (size_t)l * 64 * 512, o + W_LA, 512, 0, 64, 64, 512, 512, 0);
    add((const float*)d_in[10] + (size_t)l * 160 * 512, o + W_LG, 512, 0, 160, 192, 512, 512, 0);
    add((const float*)d_in[17] + (size_t)l * 256 * 768, o + W_UQ, 768, 0, 256, 256, 768, 768, 0);
    add((const float*)d_in[19] + (size_t)l * 256 * 512, o + W_UK, 512, 0, 256, 256, 512, 512, 0);
    add((const float*)d_in[20] + (size_t)l * 256 * 512, o + W_UV, 512, 0, 256, 256, 512, 512, 0);
    add((const float*)d_in[21] + (size_t)l * 512 * 1024, o + W_PR, 1024, 0, 512, 512, 1024, 1024, 0);
    add((const float*)d_in[22] + (size_t)l * 512 * 1024, o + W_PM, 1024, 0, 512, 512, 1024, 1024, 0);
    add((const float*)d_in[23] + (size_t)l * 1024 * 1024, o + W_OUT, 1024, 0, 1024, 1024, 1024, 1024, 0);
    add((const float*)d_in[26] + (size_t)l * 1024 * 5632, o + W_UP, 5632, 0, 1024, 1024, 5632, 5632, 1);
    add((const float*)d_in[29] + (size_t)l * 2816 * 1024, o + W_DN, 1024, 0, 2816, 2816, 1024, 1024, 0);
  }
  p.nconv = tiles;
  hipMemsetAsync((char*)d_ws + OFF_BAR, 0, 16384, stream);
  void* args[] = {&p};
  hipError_t e = hipLaunchCooperativeKernel((void*)mega, dim3(grid_blocks), dim3(256), args, 0, stream);
  if (e != hipSuccess) fprintf(stderr, "cooperative launch failed: %s (grid %d)\n", hipGetErrorString(e), grid_blocks);
}
```

```cpp
#include <hip/hip_runtime.h>
#include <hip/hip_cooperative_groups.h>
#include <cstdio>
#include <cstring>
namespace cg = cooperative_groups;

#ifndef PHMASK
#define PHMASK 0xFFFF
#endif
#ifndef PROBE_HOT
#define PROBE_HOT 0
#endif
#ifndef PROBE_FI
#define PROBE_FI 0
#endif
#ifndef REPMASK
#define REPMASK 0
#endif
typedef unsigned short u16;
using bf16x8 = __attribute__((ext_vector_type(8))) short;
using f32x4 = __attribute__((ext_vector_type(4))) float;

constexpr int B_ = 16, SEQ_ = 4096, NMETA_ = 16, T_ = 4112, M_ = B_ * T_, D_ = 1024;
constexpr int PC_ = 2368;
constexpr int PMLA_ = 1824, PKV_ = 2080, PKR_ = 2336;
constexpr int DFF_ = 2816;
constexpr float ALPHA_ = 1.4142135623730951f;

constexpr size_t OFF_H = 0;
constexpr size_t OFF_P = OFF_H + (size_t)M_ * 1024 * 4;
constexpr size_t OFF_DEC = OFF_P + (size_t)M_ * PC_ * 2;
constexpr size_t OFF_AA = OFF_DEC + (size_t)M_ * 512 * 4;
constexpr size_t OFF_GG = OFF_AA + (size_t)M_ * 512 * 2;
constexpr size_t OFF_Q = OFF_GG + (size_t)M_ * 512 * 2;
constexpr size_t OFF_W = OFF_Q + (size_t)M_ * 768 * 2;
constexpr size_t W_IN = 0;
constexpr size_t W_G = W_IN + (size_t)2432 * 1024;
constexpr size_t W_LW = W_G + (size_t)2048 * 1024;
constexpr size_t W_LA = W_LW + (size_t)512 * 64;
constexpr size_t W_LG = W_LA + (size_t)512 * 64;
constexpr size_t W_UQ = W_LG + (size_t)512 * 192;
constexpr size_t W_UK = W_UQ + (size_t)768 * 256;
constexpr size_t W_UV = W_UK + (size_t)512 * 256;
constexpr size_t W_PR = W_UV + (size_t)512 * 256;
constexpr size_t W_PM = W_PR + (size_t)1024 * 512;
constexpr size_t W_OUT = W_PM + (size_t)1024 * 512;
constexpr size_t W_UP = W_OUT + (size_t)1024 * 1024;
constexpr size_t W_DN = W_UP + (size_t)5632 * 1024;
constexpr size_t W_LAYER = W_DN + (size_t)1024 * 2816;
constexpr size_t OFF_ROPE = OFF_W + 2 * W_LAYER * 2;
constexpr size_t OFF_CTR = OFF_ROPE + (size_t)T_ * 16 * 8;
constexpr size_t OFF_ZERO = OFF_CTR + 256;
constexpr size_t OFF_BAR = OFF_ZERO + 8192;
constexpr size_t OFF_HB2 = OFF_BAR + 16384;
constexpr size_t OFF_SCR = OFF_HB2 + (size_t)512 * 1024 * 2;
constexpr size_t WS_TOTAL = OFF_SCR + (size_t)1024 * 65536;
constexpr int HB_SPLIT = 65280;

struct Job { const float* src; u16* dst; int ld, c0, K, Kpad, Nv, Np, mode, tile0; };
struct Params {
  const float* in[32];
  float* out;
  char* ws;
  Job jobs[26];
  int nconv;
  int pad0;
};

__constant__ double ROPE_C[16] = {0.15915494309189535, 0.08949940160889101, 0.050329212104487035, 0.0283021958306234,
                                  0.015915494309189534, 0.008949940160889102, 0.005032921210448704, 0.00283021958306234,
                                  0.0015915494309189536, 0.0008949940160889102, 0.0005032921210448703, 0.00028302195830623395,
                                  0.00015915494309189535, 8.949940160889102e-05, 5.0329212104487035e-05, 2.8302195830623396e-05};

__device__ __forceinline__ int launder(int x) { asm volatile("" : "+v"(x)); return x; }
typedef __bf16 bf16x2_t __attribute__((ext_vector_type(2)));
typedef float f32x2_t __attribute__((ext_vector_type(2)));
__device__ __forceinline__ unsigned pk2(float a, float b) {
  f32x2_t v = {a, b};
  bf16x2_t r = __builtin_convertvector(v, bf16x2_t);
  return *(unsigned*)&r;
}
__device__ __forceinline__ u16 f2bf(float f) { return (u16)(pk2(f, 0.f) & 0xffffu); }
__device__ __forceinline__ float bf2f(unsigned h) { return __uint_as_float(h << 16); }
__device__ __forceinline__ float bflo(unsigned w) { return __uint_as_float(w << 16); }
__device__ __forceinline__ float bfhi(unsigned w) { return __uint_as_float(w & 0xffff0000u); }
__device__ __forceinline__ float sigmoidf_(float x) { return __builtin_amdgcn_rcpf(1.0f + __expf(-x)); }

__device__ __forceinline__ int fresh_lane() { int x; asm volatile("v_mbcnt_lo_u32_b32 %0, -1, 0\n\tv_mbcnt_hi_u32_b32 %0, -1, %0" : "=v"(x)); return x; }
#define PHASE_TID const int tid = wave0 * 64 + fresh_lane(); const int lane = tid & 63, wave = tid >> 6; (void)lane; (void)wave;
template <int CTRL>
__device__ __forceinline__ float dppf(float x) {
  return __int_as_float(__builtin_amdgcn_update_dpp(0, __float_as_int(x), CTRL, 0xF, 0xF, true));
}
__device__ __forceinline__ float sum8(float x) {
  x += dppf<0xB1>(x);
  x += dppf<0x4E>(x);
  x += dppf<0x141>(x);
  return x;
}
__device__ __forceinline__ float sum16(float x) {
  x = sum8(x);
  x += dppf<0x140>(x);
  return x;
}
__device__ __forceinline__ float shx(float x, int lane, int o) {
  return __int_as_float(__builtin_amdgcn_ds_bpermute((lane ^ o) << 2, __float_as_int(x)));
}
__device__ __forceinline__ float wave_sum(float x, int lane) {
  x = sum16(x);
  x += shx(x, lane, 16);
  x += shx(x, lane, 32);
  return x;
}

constexpr int BM = 128, BN = 128, BK = 64, LDT = 64;
constexpr int SMEM_BYTES = 73728;

template <int MODE>
struct AL {
  const void* base;
  int ld;
  int row0;
  int t0;
  int kvalid;
  const float* mu;
  int fn;
  struct Raw { uint4 x, y; };
  __device__ __forceinline__ Raw fetch(int r, int k) const {
    Raw w;
    { unsigned z = (MODE == 3) ? (unsigned)launder(0) : 0u; w.x = make_uint4(z, z, z, z); w.y = w.x; }
    if (MODE == 0) {
      const float* p = (const float*)base + (size_t)(row0 + r) * ld + k;
      w.x = *(const uint4*)p;
      w.y = *(const uint4*)(p + 4);
    } else if (MODE == 1) {
      const u16* p = (const u16*)base + (size_t)(row0 + r) * ld + k;
      w.x = *(const uint4*)p;
    } else if (MODE == 4) {
      const float* p = (const float*)base + (size_t)(row0 + r) * ld + k;
      float4 a = *(const float4*)p, b = *(const float4*)(p + 4);
      w.x = make_uint4(pk2(a.x, a.y), pk2(a.z, a.w), pk2(b.x, b.y), pk2(b.z, b.w));
    } else if (MODE == 2) {
      int t = t0 + r;
      if (t >= 0 && t < T_) {
        const float* p = (const float*)base + (size_t)(row0 + t) * ld + k;
        w.x = *(const uint4*)p;
        w.y = *(const uint4*)(p + 4);
      }
    } else {
      int row = row0 + r;
      int t = row % T_;
      if (k < kvalid) {
        const u16* p = (const u16*)base + (size_t)row * ld + k;
        w.x = *(const uint4*)p;
        if (t > 0) w.y = *(const uint4*)(p - ld);
      }
    }
    return w;
  }
  __device__ __forceinline__ uint4 cvt(const Raw& w, int k) const {
    if (MODE == 0 || MODE == 2) {
      uint4 o;
      o.x = pk2(__uint_as_float(w.x.x), __uint_as_float(w.x.y));
      o.y = pk2(__uint_as_float(w.x.z), __uint_as_float(w.x.w));
      o.z = pk2(__uint_as_float(w.y.x), __uint_as_float(w.y.y));
      o.w = pk2(__uint_as_float(w.y.z), __uint_as_float(w.y.w));
      return o;
    } else if (MODE == 1 || MODE == 4) {
      return w.x;
    } else {
      if (k >= kvalid) { unsigned z = (unsigned)launder(0); return make_uint4(z, z, z, z); }
      unsigned cw[4] = {w.x.x, w.x.y, w.x.z, w.x.w};
      unsigned pw[4] = {w.y.x, w.y.y, w.y.z, w.y.w};
      unsigned ow[4];
#pragma unroll
      for (int e = 0; e < 4; e++) {
        float x0 = bflo(cw[e]), x1 = bfhi(cw[e]);
        float p0 = bflo(pw[e]), p1 = bfhi(pw[e]);
        float v0 = x0 + (p0 - x0) * mu[k + 2 * e];
        float v1 = x1 + (p1 - x1) * mu[k + 2 * e + 1];
        if (fn == 0) {
          v0 = 1.0f - 2.0f * __builtin_amdgcn_rcpf(__expf(2.0f * v0) + 1.0f);
          v1 = 1.0f - 2.0f * __builtin_amdgcn_rcpf(__expf(2.0f * v1) + 1.0f);
        } else if (fn == 2) {
          v0 = sigmoidf_(v0);
          v1 = sigmoidf_(v1);
        }
        ow[e] = pk2(v0, v1);
      }
      return make_uint4(ow[0], ow[1], ow[2], ow[3]);
    }
  }
};

template <int NI>
__device__ __forceinline__ void zero_acc(f32x4 (&acc)[4][NI]) {
#pragma unroll
  for (int i = 0; i < 4; i++)
#pragma unroll
    for (int j = 0; j < NI; j++) acc[i][j] = f32x4{0.f, 0.f, 0.f, 0.f};
}

#define REP4(X) X(0) X(1) X(2) X(3)
template <class ALT, int NI>
__device__ __forceinline__ void gemm_loop(f32x4 (&acc)[4][NI], const ALT& al, const u16* __restrict__ Bt, int ldb, int n0,
                                          int K, char* smem, const int tid) {
  const int lane = tid & 63, wave = tid >> 6;
  const int wr = wave >> 1, wc = wave & 1, fr = lane & 15, fq = lane >> 4;
  const int lr = tid >> 3, lk = (tid & 7) * 8, lsw = ((tid & 7) ^ (lr & 7)) * 8;
  u16* sa = (u16*)smem;
  u16* sb = sa + 2 * BM * LDT;
  typename ALT::Raw ra0, ra1, ra2, ra3;
  uint4 rb0 = make_uint4(0,0,0,0), rb1 = rb0, rb2 = rb0, rb3 = rb0;
  const u16* bp = Bt + (size_t)(n0 + lr) * ldb + lk;
#define GL_FETCH(i) ra##i = al.fetch(lr + 32 * i, kf); if (i < NI) rb##i = *(const uint4*)(bp + (size_t)(32 * i) * ldb + kb);
#define GL_STORE(i) *(uint4*)(a_ + (lr + 32 * i) * LDT + lsw) = al.cvt(ra##i, kt * BK + lk); if (i < NI) *(uint4*)(b_ + (lr + 32 * i) * LDT + lsw) = rb##i;
  {
    const int kf = lk, kb = 0;
    REP4(GL_FETCH)
  }
  const int nk = K / BK;
  for (int kt = 0; kt < nk; kt++) {
    u16* a_ = sa + (kt & 1) * BM * LDT;
    u16* b_ = sb + (kt & 1) * BN * LDT;
    REP4(GL_STORE)
    __syncthreads();
    if (kt + 1 < nk) {
      const int kf = (kt + 1) * BK + lk, kb = (kt + 1) * BK;
      REP4(GL_FETCH)
    }
#pragma unroll
    for (int ks = 0; ks < 2; ks++) {
      bf16x8 af[4], bf[NI];
#pragma unroll
      for (int i = 0; i < 4; i++) af[i] = *(const bf16x8*)(a_ + (wr * 64 + i * 16 + fr) * LDT + (((ks * 4 + fq) ^ (fr & 7)) * 8));
#pragma unroll
      for (int i = 0; i < NI; i++) bf[i] = *(const bf16x8*)(b_ + (wc * (NI * 16) + i * 16 + fr) * LDT + (((ks * 4 + fq) ^ (fr & 7)) * 8));
#pragma unroll
      for (int mi = 0; mi < 4; mi++)
#pragma unroll
        for (int ni = 0; ni < NI; ni++)
          acc[mi][ni] = __builtin_amdgcn_mfma_f32_16x16x32_bf16(af[mi], bf[ni], acc[mi][ni], 0, 0, 0);
    }
  }
  __syncthreads();
#undef GL_FETCH
#undef GL_STORE
}


struct ADma { const u16* base; int ld; int row0; int t0; const u16* zero; int mode; const char* wsb; };
constexpr int G3_STAGE = 12288;

template <int NI, bool SWAP = true>
__device__ __forceinline__ void gemm3(f32x4 (&acc)[8][NI], const ADma& a, const u16* __restrict__ Bt, int ldb, int n0, int K,
                                      char* smem, const int tid) {
  const int lane = tid & 63, wave = tid >> 6;
  const int wr = wave >> 1, wc = wave & 1, fr = lane & 15, fq = lane >> 4;
  const int kc8 = ((lane & 3) ^ ((4 - (lane >> 4)) & 3)) * 8;
  const int psw = (fq ^ ((4 - (fr >> 2)) & 3)) * 8;
  u16* sm = (u16*)smem;
  const u16* ap0 = nullptr;
  unsigned ao0 = 0, ao1 = 0, ao2 = 0, ao3 = 0;
  if (a.mode == 0) {
    ap0 = a.base + (size_t)(a.row0 + wave * 64 + (lane >> 2)) * a.ld + kc8;
  } else {
    const unsigned bo = (unsigned)((const char*)a.base - a.wsb), zo = (unsigned)((const char*)a.zero - a.wsb) + kc8 * 2;
#define G3_AP(j)                                                                          \
    {                                                                                     \
      int t = a.t0 + wave * 64 + j * 16 + (lane >> 2);                                    \
      ao##j = (t >= 0 && t < T_) ? bo + (unsigned)(((a.row0 + t) * a.ld + kc8) * 2) : zo; \
    }
    REP4(G3_AP)
#undef G3_AP
  }
  const u16* bp0 = Bt + (size_t)(n0 + wave * (8 * NI) + (lane >> 2)) * ldb + kc8;
  const size_t astep = (size_t)16 * a.ld;
  const size_t bstep = (size_t)16 * ldb;
#define G3_ISSUE(j)                                                                                                              \
  __builtin_amdgcn_global_load_lds((a.mode == 0) ? (const unsigned*)(ap0 + j * astep + kof) : (const unsigned*)(a.wsb + ao##j + kof * 2), (unsigned*)(st_ + (wave * 64 + j * 16) * 32 + lane * 8), 16, 0, 0); \
  if (2 * j < NI) __builtin_amdgcn_global_load_lds((const unsigned*)(bp0 + j * bstep + kof), (unsigned*)(st_ + 8192 + (wave * (8 * NI) + j * 16) * 32 + lane * 8), 16, 0, 0);
  const int nk = K / 32;
  {
    const int kof = 0;
    u16* st_ = sm;
    REP4(G3_ISSUE)
  }
  if (nk > 1) {
    const int kof = 32;
    u16* st_ = sm + G3_STAGE;
    REP4(G3_ISSUE)
  }
  int cur = 0, nxt = 2;
  const unsigned lds0 = (unsigned)(size_t)(__attribute__((address_space(3))) char*)smem;
  const unsigned aoff = lds0 + (unsigned)(((wr * 128 + fr) * 32 + psw) * 2);
  const unsigned boff = lds0 + 16384u + (unsigned)(((wc * (NI * 16) + fr) * 32 + psw) * 2);
#define G3_DSR(dst, addr, off) asm volatile("ds_read_b128 %0, %1 offset:" #off : "=v"(dst) : "v"(addr))
  for (int kt = 0; kt < nk; kt++) {
    if (kt + 1 < nk) {
      if (NI == 4) asm volatile("s_waitcnt vmcnt(6)" ::: "memory");
      else asm volatile("s_waitcnt vmcnt(5)" ::: "memory");
    } else {
      asm volatile("s_waitcnt vmcnt(0)" ::: "memory");
    }
    __builtin_amdgcn_s_barrier();
    if (kt + 2 < nk) {
      const int kof = (kt + 2) * 32;
      u16* st_ = sm + nxt * G3_STAGE;
      REP4(G3_ISSUE)
    }
    const unsigned aaddr = aoff + (unsigned)cur * (G3_STAGE * 2);
    const unsigned baddr = boff + (unsigned)cur * (G3_STAGE * 2);
    bf16x8 af[8], bf[NI];
    G3_DSR(af[0], aaddr, 0); G3_DSR(af[1], aaddr, 1024); G3_DSR(af[2], aaddr, 2048); G3_DSR(af[3], aaddr, 3072);
    G3_DSR(bf[0], baddr, 0); G3_DSR(bf[1], baddr, 1024);
    if (NI == 4) { G3_DSR(bf[NI - 2], baddr, 2048); G3_DSR(bf[NI - 1], baddr, 3072); }
    G3_DSR(af[4], aaddr, 4096); G3_DSR(af[5], aaddr, 5120); G3_DSR(af[6], aaddr, 6144); G3_DSR(af[7], aaddr, 7168);
    if (NI == 4) {
      asm volatile("s_waitcnt lgkmcnt(4)"
                   : "+v"(af[0]), "+v"(af[1]), "+v"(af[2]), "+v"(af[3]), "+v"(bf[0]), "+v"(bf[1]), "+v"(bf[NI - 2]), "+v"(bf[NI - 1]));
    } else {
      asm volatile("s_waitcnt lgkmcnt(4)" : "+v"(af[0]), "+v"(af[1]), "+v"(af[2]), "+v"(af[3]), "+v"(bf[0]), "+v"(bf[1]));
    }
#pragma unroll
    for (int mi = 0; mi < 4; mi++)
#pragma unroll
      for (int ni = 0; ni < NI; ni++)
        acc[mi][ni] = SWAP ? __builtin_amdgcn_mfma_f32_16x16x32_bf16(bf[ni], af[mi], acc[mi][ni], 0, 0, 0)
                           : __builtin_amdgcn_mfma_f32_16x16x32_bf16(af[mi], bf[ni], acc[mi][ni], 0, 0, 0);
    asm volatile("s_waitcnt lgkmcnt(0)" : "+v"(af[4]), "+v"(af[5]), "+v"(af[6]), "+v"(af[7]));
#pragma unroll
    for (int mi = 4; mi < 8; mi++)
#pragma unroll
      for (int ni = 0; ni < NI; ni++)
        acc[mi][ni] = SWAP ? __builtin_amdgcn_mfma_f32_16x16x32_bf16(bf[ni], af[mi], acc[mi][ni], 0, 0, 0)
                           : __builtin_amdgcn_mfma_f32_16x16x32_bf16(af[mi], bf[ni], acc[mi][ni], 0, 0, 0);
    cur = (cur == 2) ? 0 : cur + 1;
    nxt = (nxt == 2) ? 0 : nxt + 1;
  }
  asm volatile("s_waitcnt lgkmcnt(0)" ::: "memory");
  __syncthreads();
#undef G3_DSR
#undef G3_ISSUE
}

template <int NI>
__device__ __forceinline__ void zero_acc8(f32x4 (&acc)[8][NI]) {
#pragma unroll
  for (int i = 0; i < 8; i++)
#pragma unroll
    for (int j = 0; j < NI; j++) acc[i][j] = f32x4{0.f, 0.f, 0.f, 0.f};
}


__device__ __forceinline__ bool map_tile(int i, int nblk, int MT, int NT, int& mt, int& nt) {
  const int locs = nblk >> 3;
  const int xcd = blockIdx.x & 7, loc = blockIdx.x >> 3;
  const int q = (i * 8 + xcd) * locs + loc;
  if (q >= MT * NT) return false;
  const int nfull = NT >> 3, per = MT * 8;
  if (q < nfull * per) {
    int pp = q / per, r = q - pp * per;
    mt = r >> 3;
    nt = pp * 8 + (r & 7);
  } else {
    int r = q - nfull * per;
    int w = NT - nfull * 8;
    mt = r / w;
    nt = nfull * 8 + (r - mt * w);
  }
  return true;
}

#define ACC_COORDS const int wr = wave >> 1, wc = wave & 1, fr = lane & 15, fq = lane >> 4;

__device__ __forceinline__ void conv_tile(const Params& p, int t, char* smem, const int tid) {
  int j = 0;
#pragma unroll 1
  for (int i = 1; i < 26; i++)
    if (t >= p.jobs[i].tile0) j = i;
  const Job& jb = p.jobs[j];
  float(*tile)[65] = (float(*)[65])smem;
  int local = t - jb.tile0;
  int nkt = jb.Kpad >> 6;
  int kt = local % nkt, nt = local / nkt;
  int tx = tid & 63, ty = tid >> 6;
  int n = nt * 64 + tx;
  int col;
  if (jb.mode == 0) col = jb.c0 + n;
  else { int jn = n >> 7, i = n & 127; col = (i < 64) ? (64 * jn + i) : (DFF_ + 64 * jn + (i - 64)); }
  const float* sp = jb.src + col;
  const int K = jb.K, ld = jb.ld;
  const bool nok = n < jb.Nv;
#pragma unroll
  for (int i = 0; i < 16; i++) {
    int k = kt * 64 + ty + 4 * i;
    tile[ty + 4 * i][tx] = (nok && k < K) ? sp[(size_t)k * ld] : 0.f;
  }
  __syncthreads();
#pragma unroll
  for (int i = 0; i < 16; i++) {
    int nn = nt * 64 + ty + 4 * i;
    int k = kt * 64 + tx;
    jb.dst[(size_t)nn * jb.Kpad + k] = f2bf(tile[tx][ty + 4 * i]);
  }
  __syncthreads();
}

__device__ __forceinline__ void ln_row(const float* __restrict__ src, const float* __restrict__ g,
                                       const float* __restrict__ b, float* __restrict__ dst, int lane, u16* __restrict__ dstb = nullptr) {
  float4 v[4];
  float s = 0.f;
#pragma unroll
  for (int i = 0; i < 4; i++) {
    v[i] = *(const float4*)(src + i * 256 + lane * 4);
    s += v[i].x + v[i].y + v[i].z + v[i].w;
  }
  float mean = wave_sum(s, lane) * (1.0f / 1024.0f);
  float q = 0.f;
#pragma unroll
  for (int i = 0; i < 4; i++) {
    float a = v[i].x - mean, b2 = v[i].y - mean, c = v[i].z - mean, d = v[i].w - mean;
    q += a * a + b2 * b2 + c * c + d * d;
  }
  float rstd = rsqrtf(wave_sum(q, lane) * (1.0f / 1024.0f) + 1e-5f);
#pragma unroll
  for (int i = 0; i < 4; i++) {
    float4 gg = *(const float4*)(g + i * 256 + lane * 4);
    float4 bb = *(const float4*)(b + i * 256 + lane * 4);
    float4 o;
    o.x = (v[i].x - mean) * rstd * gg.x + bb.x;
    o.y = (v[i].y - mean) * rstd * gg.y + bb.y;
    o.z = (v[i].z - mean) * rstd * gg.z + bb.z;
    o.w = (v[i].w - mean) * rstd * gg.w + bb.w;
    *(float4*)(dst + i * 256 + lane * 4) = o;
    if (dstb) *(uint2*)(dstb + i * 256 + lane * 4) = make_uint2(pk2(o.x, o.y), pk2(o.z, o.w));
  }
}

__device__ __forceinline__ void ln_row2(const float* __restrict__ srcA, const float* __restrict__ srcB, const float* __restrict__ g,
                                        const float* __restrict__ b, float* dstA, float* dstB, int lane, u16* dbA, u16* dbB) {
  float4 va[4], vb[4];
  float sa = 0.f, sb = 0.f;
#pragma unroll
  for (int i = 0; i < 4; i++) {
    va[i] = *(const float4*)(srcA + i * 256 + lane * 4);
    vb[i] = *(const float4*)(srcB + i * 256 + lane * 4);
  }
#pragma unroll
  for (int i = 0; i < 4; i++) {
    sa += va[i].x + va[i].y + va[i].z + va[i].w;
    sb += vb[i].x + vb[i].y + vb[i].z + vb[i].w;
  }
  const float ma = wave_sum(sa, lane) * (1.0f / 1024.0f), mb = wave_sum(sb, lane) * (1.0f / 1024.0f);
  float qa = 0.f, qb = 0.f;
#pragma unroll
  for (int i = 0; i < 4; i++) {
    va[i].x -= ma; va[i].y -= ma; va[i].z -= ma; va[i].w -= ma;
    vb[i].x -= mb; vb[i].y -= mb; vb[i].z -= mb; vb[i].w -= mb;
    qa += va[i].x * va[i].x + va[i].y * va[i].y + va[i].z * va[i].z + va[i].w * va[i].w;
    qb += vb[i].x * vb[i].x + vb[i].y * vb[i].y + vb[i].z * vb[i].z + vb[i].w * vb[i].w;
  }
  const float ra = rsqrtf(wave_sum(qa, lane) * (1.0f / 1024.0f) + 1e-5f), rb = rsqrtf(wave_sum(qb, lane) * (1.0f / 1024.0f) + 1e-5f);
#pragma unroll
  for (int i = 0; i < 4; i++) {
    float4 gg = *(const float4*)(g + i * 256 + lane * 4);
    float4 bb = *(const float4*)(b + i * 256 + lane * 4);
    float4 oa, ob;
    oa.x = va[i].x * ra * gg.x + bb.x; oa.y = va[i].y * ra * gg.y + bb.y; oa.z = va[i].z * ra * gg.z + bb.z; oa.w = va[i].w * ra * gg.w + bb.w;
    ob.x = vb[i].x * rb * gg.x + bb.x; ob.y = vb[i].y * rb * gg.y + bb.y; ob.z = vb[i].z * rb * gg.z + bb.z; ob.w = vb[i].w * rb * gg.w + bb.w;
    *(float4*)(dstA + i * 256 + lane * 4) = oa;
    *(float4*)(dstB + i * 256 + lane * 4) = ob;
    if (dbA) {
      *(uint2*)(dbA + i * 256 + lane * 4) = make_uint2(pk2(oa.x, oa.y), pk2(oa.z, oa.w));
      *(uint2*)(dbB + i * 256 + lane * 4) = make_uint2(pk2(ob.x, ob.y), pk2(ob.z, ob.w));
    }
  }
}

struct ScanIn {
  float kk[16][64], wr[16][64], w[16][64], kt[16][64], kka[16][64], v[16][64], g[16][64];
  float c[16][4];
};
struct ScanRaw { uint2 r, k, v, rp, kp, vp, a, g; float4 dec; };

__device__ __forceinline__ ScanRaw scan_fetch(const u16* __restrict__ P, const float* __restrict__ DEC,
                                              const u16* __restrict__ AA, const u16* __restrict__ GG, int rowbase, int t,
                                              int hc) {
  ScanRaw w;
  size_t row = (size_t)(rowbase + t);
  const u16* pp = P + row * PC_ + hc;
  w.r = *(const uint2*)(pp);
  w.k = *(const uint2*)(pp + 512);
  w.v = *(const uint2*)(pp + 1024);
  if (t > 0) {
    w.rp = *(const uint2*)(pp - PC_);
    w.kp = *(const uint2*)(pp - PC_ + 512);
    w.vp = *(const uint2*)(pp - PC_ + 1024);
  } else {
    w.rp = make_uint2(0, 0); w.kp = make_uint2(0, 0); w.vp = make_uint2(0, 0);
  }
  w.dec = *(const float4*)(DEC + row * 512 + hc);
  w.a = *(const uint2*)(AA + row * 512 + hc);
  w.g = *(const uint2*)(GG + row * 512 + hc);
  return w;
}

__device__ __forceinline__ void unpack4(uint2 u, float (&o)[4]) {
  o[0] = bflo(u.x); o[1] = bfhi(u.x); o[2] = bflo(u.y); o[3] = bfhi(u.y);
}

__device__ __forceinline__ void scan_unit(const Params& p, int l, int bh, char* smem, const int tid) {
  const int lane = tid & 63, wave = tid >> 6;
  const int b = bh >> 3, h = bh & 7;
  const int rowbase = b * T_;
  const u16* P = (const u16*)(p.ws + OFF_P);
  const float* DEC = (const float*)(p.ws + OFF_DEC);
  const u16* AA = (const u16*)(p.ws + OFF_AA);
  const u16* GG = (const u16*)(p.ws + OFF_GG);
  u16* YR = (u16*)(p.ws + OFF_AA);
  ScanIn* in = (ScanIn*)smem;
  float(*ybuf)[64] = (float(*)[64])(smem + 2 * sizeof(ScanIn));
  const int tl = tid >> 4, kq = tid & 15, hc = h * 64 + kq * 4;
  float(*cst)[64] = (float(*)[64])(smem + 2 * sizeof(ScanIn) + 16 * 64 * 4);
  if (tid < 64) {
    const float* mu = p.in[5] + (size_t)l * 1824;
    const int ch = h * 64 + tid;
    cst[0][tid] = mu[ch];
    cst[1][tid] = mu[512 + ch];
    cst[2][tid] = mu[1024 + ch];
    cst[3][tid] = p.in[11][l * 512 + ch];
    float ka_ = p.in[12][l * 512 + ch];
    cst[4][tid] = ka_;
    cst[5][tid] = 1.0f - ka_;
    cst[6][tid] = p.in[13][l * 512 + ch];
    cst[7][tid] = p.in[14][l * 512 + ch];
    cst[8][tid] = p.in[15][l * 512 + ch];
  }
  __syncthreads();
  const int rp = lane >> 3, ks = lane & 7, row0 = wave * 16 + rp * 2;
  typedef float f2s __attribute__((ext_vector_type(2)));
  f2s S2[2][4];
#pragma unroll
  for (int i = 0; i < 2; i++)
#pragma unroll
    for (int e = 0; e < 4; e++) S2[i][e] = f2s{0.f, 0.f};

  auto stage = [&](const ScanRaw& w, ScanIn& dst) {
    float r[4], k[4], v[4], rq[4], kp[4], vp[4], a[4], g[4];
    unpack4(w.r, r); unpack4(w.k, k); unpack4(w.v, v);
    unpack4(w.rp, rq); unpack4(w.kp, kp); unpack4(w.vp, vp);
    unpack4(w.a, a); unpack4(w.g, g);
    float dec[4] = {w.dec.x, w.dec.y, w.dec.z, w.dec.w};
    float mu_r[4], mu_k[4], mu_v[4], kkw[4], kaw[4], omk[4], rkw[4];
    *(float4*)mu_r = *(const float4*)&cst[0][kq * 4]; *(float4*)mu_k = *(const float4*)&cst[1][kq * 4];
    *(float4*)mu_v = *(const float4*)&cst[2][kq * 4]; *(float4*)kkw = *(const float4*)&cst[3][kq * 4];
    *(float4*)kaw = *(const float4*)&cst[4][kq * 4]; *(float4*)omk = *(const float4*)&cst[5][kq * 4];
    *(float4*)rkw = *(const float4*)&cst[6][kq * 4];
    float kkr[4], ss = 0.f;
#pragma unroll
    for (int e = 0; e < 4; e++) {
      r[e] = r[e] + (rq[e] - r[e]) * mu_r[e];
      k[e] = k[e] + (kp[e] - k[e]) * mu_k[e];
      v[e] = v[e] + (vp[e] - v[e]) * mu_v[e];
      kkr[e] = k[e] * kkw[e];
      ss += kkr[e] * kkr[e];
    }
    ss = sum16(ss);
    float inv = rsqrtf(fmaxf(ss, 1e-24f));
    float c1 = 0.f, c2 = 0.f, c3 = 0.f;
    float kk[4], ktl[4], kka[4], wr[4];
#pragma unroll
    for (int e = 0; e < 4; e++) {
      kk[e] = kkr[e] * inv;
      ktl[e] = k[e] * fmaf(a[e], kaw[e], omk[e]);
      kka[e] = kk[e] * a[e];
      wr[e] = dec[e] * r[e];
      c1 += kka[e] * r[e];
      c2 += ktl[e] * r[e];
      c3 += r[e] * ktl[e] * rkw[e];
    }
    c1 = sum16(c1); c2 = sum16(c2); c3 = sum16(c3);
    *(float4*)&dst.kk[tl][kq * 4] = make_float4(kk[0], kk[1], kk[2], kk[3]);
    *(float4*)&dst.wr[tl][kq * 4] = make_float4(wr[0], wr[1], wr[2], wr[3]);
    *(float4*)&dst.w[tl][kq * 4] = make_float4(dec[0], dec[1], dec[2], dec[3]);
    *(float4*)&dst.kt[tl][kq * 4] = make_float4(ktl[0], ktl[1], ktl[2], ktl[3]);
    *(float4*)&dst.kka[tl][kq * 4] = make_float4(kka[0], kka[1], kka[2], kka[3]);
    *(float4*)&dst.v[tl][kq * 4] = make_float4(v[0], v[1], v[2], v[3]);
    *(float4*)&dst.g[tl][kq * 4] = make_float4(g[0], g[1], g[2], g[3]);
    if (kq == 0) *(float4*)&dst.c[tl][0] = make_float4(c1, c2, c3, 0.f);
  };

  {
    ScanRaw w0 = scan_fetch(P, DEC, AA, GG, rowbase, tl, hc);
    stage(w0, in[0]);
  }
  __syncthreads();
  constexpr int NCH = T_ / 16;
  for (int c = 0; c < NCH; c++) {
    ScanIn& cur = in[c & 1];
    ScanRaw nx;
    const bool have_next = (c + 1 < NCH);
    if (have_next) nx = scan_fetch(P, DEC, AA, GG, rowbase, (c + 1) * 16 + tl, hc);
    {
      typedef float f2 __attribute__((ext_vector_type(2)));
      struct StepA { float4 kk0, kk1, wr0, wr1; };
      struct StepIn { float4 kk0, kk1, wr0, wr1, w0, w1, kt0, kt1, ka0, ka1; float2 vv, cc; };
      auto ldA = [&](int s) {
        StepA r;
        r.kk0 = *(const float4*)&cur.kk[s][ks * 8]; r.kk1 = *(const float4*)&cur.kk[s][ks * 8 + 4];
        r.wr0 = *(const float4*)&cur.wr[s][ks * 8]; r.wr1 = *(const float4*)&cur.wr[s][ks * 8 + 4];
        return r;
      };
      StepA nxa = ldA(0);
#pragma unroll 1
      for (int s4 = 0; s4 < 16; s4 += 4) {
      float yv[4][2];
#pragma unroll
      for (int u = 0; u < 4; u++) {
        const int s = s4 + u;
        StepIn in_;
        in_.kk0 = nxa.kk0; in_.kk1 = nxa.kk1; in_.wr0 = nxa.wr0; in_.wr1 = nxa.wr1;
        in_.vv = *(const float2*)&cur.v[s][row0];
        in_.cc = *(const float2*)&cur.c[s][0];
        in_.w0 = *(const float4*)&cur.w[s][ks * 8];   in_.w1 = *(const float4*)&cur.w[s][ks * 8 + 4];
        in_.kt0 = *(const float4*)&cur.kt[s][ks * 8]; in_.kt1 = *(const float4*)&cur.kt[s][ks * 8 + 4];
        in_.ka0 = *(const float4*)&cur.kka[s][ks * 8]; in_.ka1 = *(const float4*)&cur.kka[s][ks * 8 + 4];
        nxa = ldA((s + 1) & 15);
        const f2 kk[4] = {{in_.kk0.x, in_.kk0.y}, {in_.kk0.z, in_.kk0.w}, {in_.kk1.x, in_.kk1.y}, {in_.kk1.z, in_.kk1.w}};
        const f2 wr[4] = {{in_.wr0.x, in_.wr0.y}, {in_.wr0.z, in_.wr0.w}, {in_.wr1.x, in_.wr1.y}, {in_.wr1.z, in_.wr1.w}};
        const f2 w[4] = {{in_.w0.x, in_.w0.y}, {in_.w0.z, in_.w0.w}, {in_.w1.x, in_.w1.y}, {in_.w1.z, in_.w1.w}};
        const f2 kt[4] = {{in_.kt0.x, in_.kt0.y}, {in_.kt0.z, in_.kt0.w}, {in_.kt1.x, in_.kt1.y}, {in_.kt1.z, in_.kt1.w}};
        const f2 ka[4] = {{in_.ka0.x, in_.ka0.y}, {in_.ka0.z, in_.ka0.w}, {in_.ka1.x, in_.ka1.y}, {in_.ka1.z, in_.ka1.w}};
        const float vr[2] = {in_.vv.x, in_.vv.y};
        float d1[2], d2[2];
#pragma unroll
        for (int i = 0; i < 2; i++) {
          f2 a = S2[i][0] * kk[0] + S2[i][1] * kk[1];
          f2 a2 = S2[i][2] * kk[2] + S2[i][3] * kk[3];
          f2 bq = S2[i][0] * wr[0] + S2[i][1] * wr[1];
          f2 b2 = S2[i][2] * wr[2] + S2[i][3] * wr[3];
          a += a2; bq += b2;
          d1[i] = a.x + a.y;
          d2[i] = bq.x + bq.y;
        }
        d1[0] = sum8(d1[0]); d1[1] = sum8(d1[1]); d2[0] = sum8(d2[0]); d2[1] = sum8(d2[1]);
#pragma unroll
        for (int i = 0; i < 2; i++) {
          const float skk = d1[i];
          yv[u][i] = d2[i] - skk * in_.cc.x + vr[i] * in_.cc.y;
          const f2 nsk = {-skk, -skk}, vv2 = {vr[i], vr[i]};
#pragma unroll
          for (int e = 0; e < 4; e++) S2[i][e] = S2[i][e] * w[e] + (nsk * ka[e] + vv2 * kt[e]);
        }
      }
      if (ks == 0) {
#pragma unroll
        for (int u = 0; u < 4; u++) *(float2*)&ybuf[s4 + u][row0] = make_float2(yv[u][0], yv[u][1]);
      }
      }
    }
    __syncthreads();
    {
      float4 y4 = *(const float4*)&ybuf[tl][kq * 4];
      float y[4] = {y4.x, y4.y, y4.z, y4.w};
      float mean = sum16(y[0] + y[1] + y[2] + y[3]) * (1.0f / 64.0f);
      float q = 0.f;
#pragma unroll
      for (int e = 0; e < 4; e++) { y[e] -= mean; q += y[e] * y[e]; }
      float rstd = rsqrtf(sum16(q) * (1.0f / 64.0f) + 64e-5f);
      float c3 = cur.c[tl][2];
      float4 v4 = *(const float4*)&cur.v[tl][kq * 4];
      float4 g4 = *(const float4*)&cur.g[tl][kq * 4];
      float vv[4] = {v4.x, v4.y, v4.z, v4.w};
      float gg[4] = {g4.x, g4.y, g4.z, g4.w};
      float o[4], lg[4], lb[4];
      *(float4*)lg = *(const float4*)&cst[7][kq * 4]; *(float4*)lb = *(const float4*)&cst[8][kq * 4];
#pragma unroll
      for (int e = 0; e < 4; e++) o[e] = (y[e] * rstd * lg[e] + lb[e] + c3 * vv[e]) * gg[e];
      size_t row = (size_t)(rowbase + c * 16 + tl);
      *(uint2*)(YR + row * 512 + hc) = make_uint2(pk2(o[0], o[1]), pk2(o[2], o[3]));
    }
    if (have_next) stage(nx, in[(c + 1) & 1]);
    __syncthreads();
  }
}

constexpr int KLD = 104, VLD = 72;
struct AttnSmem { u16 k[2][64 * KLD]; u16 v[2][64 * VLD]; };

__device__ __forceinline__ void attn_unit(const Params& p, int bh, int qi, char* smem, const int tid) {
  const int lane = tid & 63, wave = tid >> 6;
  const int fr = lane & 15, fq = lane >> 4;
  const int b = bh >> 3, h = bh & 7;
  const int rowbase = b * T_;
  u16* P = (u16*)(p.ws + OFF_P);
  const u16* Q = (const u16*)(p.ws + OFF_Q);
  const u16* KN = (const u16*)p.out;
  const u16* VT = (const u16*)p.out + (size_t)M_ * 512;
  const float2* ROPE = (const float2*)(p.ws + OFF_ROPE);
  AttnSmem* sm = (AttnSmem*)smem;
  const int qs = (qi == 0) ? 0 : 16 + (qi - 1) * 128;
  const int qn = (qi == 0) ? 16 : 128;
  const int q0 = qs + wave * 32;
  const bool wave_valid = (wave * 32 < qn);
  const int nkt = (qs + qn - 1) / 64 + 1;

  bf16x8 qf[2][3];
#pragma unroll
  for (int qb = 0; qb < 2; qb++) {
    int query = min(q0 + qb * 16 + fr, T_ - 1);
    const u16* qp = Q + (size_t)(rowbase + query) * 768 + h * 96;
    uint4 a0 = *(const uint4*)(qp + fq * 8);
    uint4 a1 = *(const uint4*)(qp + 32 + fq * 8);
    uint4 own = *(const uint4*)(qp + 64 + fq * 8);
    uint4 oth = *(const uint4*)(qp + 64 + (fq ^ 2) * 8);
    unsigned ow[4] = {own.x, own.y, own.z, own.w};
    unsigned tw[4] = {oth.x, oth.y, oth.z, oth.w};
    unsigned rw[4];
    const float2* rp = ROPE + (size_t)query * 16 + (fq & 1) * 8;
#pragma unroll
    for (int e = 0; e < 4; e++) {
      float2 cs0 = rp[2 * e], cs1 = rp[2 * e + 1];
      float o0 = bflo(ow[e]), o1 = bfhi(ow[e]);
      float t0 = bflo(tw[e]), t1 = bfhi(tw[e]);
      float r0, r1;
      if (fq < 2) { r0 = o0 * cs0.x - t0 * cs0.y; r1 = o1 * cs1.x - t1 * cs1.y; }
      else { r0 = t0 * cs0.y + o0 * cs0.x; r1 = t1 * cs1.y + o1 * cs1.x; }
      rw[e] = pk2(r0, r1);
    }
    uint4 a2 = make_uint4(rw[0], rw[1], rw[2], rw[3]);
    qf[qb][0] = *(bf16x8*)&a0;
    qf[qb][1] = *(bf16x8*)&a1;
    qf[qb][2] = *(bf16x8*)&a2;
  }

  f32x4 O[4][2];
#pragma unroll
  for (int i = 0; i < 4; i++)
#pragma unroll
    for (int j = 0; j < 2; j++) O[i][j] = f32x4{0.f, 0.f, 0.f, 0.f};
  float mrun[2] = {-1e30f, -1e30f}, lrun[2] = {0.f, 0.f};
  const float sc = 1.4426950408889634f / 9.797958971132712f;

  uint4 rk[3], rv[2];
  auto fetch_tile = [&](int kt) {
#pragma unroll
    for (int i = 0; i < 3; i++) {
      int c = tid + 256 * i;
      int key = c / 12, cc = c % 12;
      int t = kt * 64 + key;
      uint4 val = make_uint4(0, 0, 0, 0);
      if (t < T_) {
        size_t row = (size_t)(rowbase + t);
        if (cc < 8) val = *(const uint4*)(KN + row * 512 + h * 64 + cc * 8);
        else val = *(const uint4*)(P + row * PC_ + PKR_ + (cc - 8) * 8);
      }
      rk[i] = val;
    }
#pragma unroll
    for (int i = 0; i < 2; i++) {
      int c = tid + 256 * i;
      int dv = c >> 3, cc = c & 7;
      int t = kt * 64 + cc * 8;
      uint4 val = make_uint4(0, 0, 0, 0);
      if (t < T_) val = *(const uint4*)(VT + ((size_t)bh * 64 + dv) * T_ + t);
      rv[i] = val;
    }
  };
  auto store_tile = [&](int buf) {
#pragma unroll
    for (int i = 0; i < 3; i++) {
      int c = tid + 256 * i;
      int key = c / 12, cc = c % 12;
      *(uint4*)(&sm->k[buf][key * KLD + cc * 8]) = rk[i];
    }
#pragma unroll
    for (int i = 0; i < 2; i++) {
      int c = tid + 256 * i;
      int dv = c >> 3, cc = c & 7;
      *(uint4*)(&sm->v[buf][dv * VLD + cc * 8]) = rv[i];
    }
  };

  fetch_tile(0);
  for (int kt = 0; kt < nkt; kt++) {
    const int buf = kt & 1;
    store_tile(buf);
    __syncthreads();
    if (kt + 1 < nkt) fetch_tile(kt + 1);
    if (wave_valid && kt * 64 <= q0 + 31) {
      const u16* Ks = sm->k[buf];
      const u16* Vs = sm->v[buf];
      f32x4 s[4][2];
#pragma unroll
      for (int i = 0; i < 4; i++)
#pragma unroll
        for (int j = 0; j < 2; j++) s[i][j] = f32x4{0.f, 0.f, 0.f, 0.f};
#pragma unroll
      for (int ks = 0; ks < 3; ks++)
#pragma unroll
        for (int kb = 0; kb < 4; kb++) {
          bf16x8 kf = *(const bf16x8*)(Ks + (kb * 16 + fr) * KLD + ks * 32 + fq * 8);
#pragma unroll
          for (int qb = 0; qb < 2; qb++) s[kb][qb] = __builtin_amdgcn_mfma_f32_16x16x32_bf16(kf, qf[qb][ks], s[kb][qb], 0, 0, 0);
        }
      const bool need_mask = (kt * 64 + 63 > q0);
      unsigned pfw[2][2][4];
#pragma unroll
      for (int qb = 0; qb < 2; qb++) {
        const int query = q0 + qb * 16 + fr;
        float mx = -1e30f;
        if (need_mask) {
#pragma unroll
          for (int kb = 0; kb < 4; kb++)
#pragma unroll
            for (int j = 0; j < 4; j++) {
              int key = kt * 64 + kb * 16 + fq * 4 + j;
              if (key > query) s[kb][qb][j] = -1e30f;
            }
        }
#pragma unroll
        for (int kb = 0; kb < 4; kb++)
          mx = fmaxf(mx, fmaxf(fmaxf(s[kb][qb][0], s[kb][qb][1]), fmaxf(s[kb][qb][2], s[kb][qb][3])));
        mx = fmaxf(mx, shx(mx, lane, 16));
        mx = fmaxf(mx, shx(mx, lane, 32));
        const float mold = mrun[qb];
        const float mnew = fmaxf(mold, mx * sc);
        mrun[qb] = mnew;
        float ps = 0.f;
#pragma unroll
        for (int kb = 0; kb < 4; kb++) {
          float p0 = __builtin_amdgcn_exp2f(fmaf(s[kb][qb][0], sc, -mnew)), p1 = __builtin_amdgcn_exp2f(fmaf(s[kb][qb][1], sc, -mnew));
          float p2 = __builtin_amdgcn_exp2f(fmaf(s[kb][qb][2], sc, -mnew)), p3 = __builtin_amdgcn_exp2f(fmaf(s[kb][qb][3], sc, -mnew));
          ps += (p0 + p1) + (p2 + p3);
          pfw[qb][kb >> 1][(kb & 1) * 2 + 0] = pk2(p0, p1);
          pfw[qb][kb >> 1][(kb & 1) * 2 + 1] = pk2(p2, p3);
        }
        if (__builtin_amdgcn_ballot_w64(mnew != mold) != 0) {
          const float alpha = __builtin_amdgcn_exp2f(mold - mnew);
          lrun[qb] *= alpha;
#pragma unroll
          for (int dvb = 0; dvb < 4; dvb++) {
            O[dvb][qb][0] *= alpha; O[dvb][qb][1] *= alpha; O[dvb][qb][2] *= alpha; O[dvb][qb][3] *= alpha;
          }
        }
        lrun[qb] += ps;
      }
#pragma unroll
      for (int s2 = 0; s2 < 2; s2++)
#pragma unroll
        for (int dvb = 0; dvb < 4; dvb++) {
          const u16* vp = Vs + (dvb * 16 + fr) * VLD + s2 * 32 + fq * 4;
          uint2 v0 = *(const uint2*)vp;
          uint2 v1 = *(const uint2*)(vp + 16);
          uint4 vv = make_uint4(v0.x, v0.y, v1.x, v1.y);
          bf16x8 vf = *(bf16x8*)&vv;
#pragma unroll
          for (int qb = 0; qb < 2; qb++) {
            uint4 pw = make_uint4(pfw[qb][s2][0], pfw[qb][s2][1], pfw[qb][s2][2], pfw[qb][s2][3]);
            O[dvb][qb] = __builtin_amdgcn_mfma_f32_16x16x32_bf16(vf, *(bf16x8*)&pw, O[dvb][qb], 0, 0, 0);
          }
        }
    }
  }
  __syncthreads();
  if (wave_valid) {
#pragma unroll
    for (int qb = 0; qb < 2; qb++) {
      float l = lrun[qb];
      l += shx(l, lane, 16);
      l += shx(l, lane, 32);
      float inv = 1.0f / l;
      int query = q0 + qb * 16 + fr;
      if (query < qs + qn) {
        u16* op = P + (size_t)(rowbase + query) * PC_ + PMLA_ + h * 64 + fq * 4;
#pragma unroll
        for (int dvb = 0; dvb < 4; dvb++) {
          *(uint2*)(op + dvb * 16) =
              make_uint2(pk2(O[dvb][qb][0] * inv, O[dvb][qb][1] * inv), pk2(O[dvb][qb][2] * inv, O[dvb][qb][3] * inv));
        }
      }
    }
  }
}

#define XB_TMO      128
#define XB_XCNT(j)  (256  + 64 * (j))
#define XB_XSUB(j)  (1280 + 64 * (j))
#define XB_XGEN(j)  (2304 + 64 * (j))
#define XB_TOP      3328
#define XB_TOPGEN   3392
#define XCD_BAR_WORDS 3456
#define XB_SPIN_CAP (1u << 18)
#define LAS __attribute__((address_space(3)))

__device__ __forceinline__ unsigned xb_ld(unsigned* p)              { return __hip_atomic_load(p, __ATOMIC_RELAXED, __HIP_MEMORY_SCOPE_AGENT); }
__device__ __forceinline__ unsigned xb_add(unsigned* p, unsigned v) { return __hip_atomic_fetch_add(p, v, __ATOMIC_RELAXED, __HIP_MEMORY_SCOPE_AGENT); }
__device__ __forceinline__ unsigned xb_xcc_id() { return (unsigned)__builtin_amdgcn_s_getreg((3 << 11) | 20) & 0xFu; }
#define XB_SPIN(cond, bar) do { unsigned _sp = 0; while (cond) { __builtin_amdgcn_s_sleep(1); \
    if ((++_sp & 255u) == 0u) { if (xb_ld(&(bar)[XB_TMO])) break; if (_sp > XB_SPIN_CAP) { atomicAdd(&(bar)[XB_TMO], 1u); break; } } } } while (0)

struct XcdBarrier {
    unsigned* bar; unsigned x;
    volatile LAS unsigned* st;
};

__device__ __forceinline__ XcdBarrier xcd_barrier_post(unsigned* bar, volatile LAS unsigned* st) {
    XcdBarrier b; b.bar = bar; b.x = xb_xcc_id(); b.st = st;
    if (threadIdx.x == 0) (void)xb_add(&bar[XB_XCNT(b.x)], 1u);
    return b;
}
__device__ __forceinline__ void xcd_barrier_complete(unsigned* bar, unsigned x, unsigned& nloc, unsigned& nx) {
    const unsigned G = gridDim.x * gridDim.y * gridDim.z;
    unsigned sum, cnt, mine, sp = 0u;
    for (;;) {
        sum = 0u; cnt = 0u; mine = 0u;
#pragma unroll
        for (unsigned j = 0; j < 16; ++j) { const unsigned c = xb_ld(&bar[XB_XCNT(j)]); sum += c; cnt += (c > 0u) ? 1u : 0u; mine = (j == x) ? c : mine; }
        if (sum == G) break;
        __builtin_amdgcn_s_sleep(1);
        if ((++sp & 255u) == 0u) { if (xb_ld(&bar[XB_TMO])) break; if (sp > XB_SPIN_CAP) { atomicAdd(&bar[XB_TMO], 1u); break; } }
    }
    nloc = mine > 0u ? mine : 1u; nx = cnt > 0u ? cnt : 1u;
}

__device__ __forceinline__ void xcd_barrier(const XcdBarrier& b, const int tid_) {
    asm volatile("s_waitcnt vmcnt(0)" ::: "memory");
    __syncthreads();
    if (tid_ == 0) {
        unsigned* bar = b.bar;
        __builtin_amdgcn_s_waitcnt(0);
        unsigned nloc = b.st[0], nx = b.st[1];
        if (nloc == 0u) { xcd_barrier_complete(bar, b.x, nloc, nx); b.st[0] = nloc; b.st[1] = nx; }
        const unsigned old = xb_add(&bar[XB_XSUB(b.x)], 1u);
        const unsigned gen = old / nloc;
        if (old + 1u == (gen + 1u) * nloc) {
            __builtin_amdgcn_fence(__ATOMIC_RELEASE, "agent");
            asm volatile("s_waitcnt vmcnt(0)" ::: "memory");
            const unsigned og = xb_add(&bar[XB_TOP], 1u);
            const unsigned tg = og / nx;
            if (og + 1u == (tg + 1u) * nx) xb_add(&bar[XB_TOPGEN], 1u);
            else XB_SPIN(xb_ld(&bar[XB_TOPGEN]) == tg, bar);
            __builtin_amdgcn_fence(__ATOMIC_ACQUIRE, "agent");
            xb_add(&bar[XB_XGEN(b.x)], 1u);
            asm volatile("s_waitcnt vmcnt(0)" ::: "memory");
        } else {
            XB_SPIN(xb_ld(&bar[XB_XGEN(b.x)]) == gen, bar);
            __builtin_amdgcn_fence(__ATOMIC_ACQUIRE, "agent");
            asm volatile("s_waitcnt vmcnt(0)" ::: "memory");
        }
    }
    __syncthreads();
}


__global__ void __launch_bounds__(256, 2) mega(Params p) {
  cg::grid_group grid = cg::this_grid();
  __shared__ __attribute__((aligned(16))) char smem[SMEM_BYTES];
  __shared__ int s_unit;
  __shared__ uint4 xb_words;
  if (threadIdx.x == 0) xb_words = make_uint4(0u, 0u, 0u, 0u);
  __syncthreads();
  (void)xcd_barrier_post((unsigned*)(p.ws + OFF_BAR), (volatile LAS unsigned*)&xb_words);
#define XB_SYNC() do { XcdBarrier xb_; xb_.bar = (unsigned*)(p.ws + OFF_BAR); xb_.x = xb_xcc_id(); xb_.st = (volatile LAS unsigned*)&xb_words; xcd_barrier(xb_, wave0 * 64 + fresh_lane()); } while (0)
  int wave0 = __builtin_amdgcn_readfirstlane((int)(threadIdx.x >> 6));
  asm volatile("" : "+s"(wave0));
  const int nblk = gridDim.x;
#define H ((float*)(p.ws + OFF_H))
#define P ((u16*)(p.ws + OFF_P))
#define DEC ((float*)(p.ws + OFF_DEC))
#define AA ((u16*)(p.ws + OFF_AA))
#define GG ((u16*)(p.ws + OFF_GG))
#define Q ((u16*)(p.ws + OFF_Q))
#define MIX ((u16*)(p.ws + OFF_DEC))
#define HB1 ((u16*)p.out + (size_t)2 * M_ * 512)
#define HB2 ((u16*)(p.ws + OFF_HB2))
#define HBH ((u16*)(p.ws + OFF_AA))
#define ZERO ((const u16*)(p.ws + OFF_ZERO))
#define ACT ((u16*)(p.ws + OFF_P))
#define ROPE ((float2*)(p.ws + OFF_ROPE))
#define CTR ((int*)(p.ws + OFF_CTR))
#define KN ((u16*)p.out)
#define VT ((u16*)p.out + (size_t)M_ * 512)
#define YR ((u16*)(p.ws + OFF_AA))

  {
  PHASE_TID
  for (int t = blockIdx.x; t < p.jobs[7].tile0; t += nblk) conv_tile(p, t, smem, tid);
  for (int i = blockIdx.x * 256 + tid; i < T_ * 16; i += nblk * 256) {
    int t = i >> 4, f = i & 15;
    double rev = (double)t * ROPE_C[f];
    rev -= floor(rev);
    float r = (float)rev;
    ROPE[i] = make_float2(__builtin_amdgcn_cosf(r), __builtin_amdgcn_sinf(r));
  }
  for (int row = (blockIdx.x * 4 + wave) * 2; row < M_; row += nblk * 8) {
    int b = row / T_, t = row % T_;
    const float* srcA = (t < NMETA_) ? (p.in[1] + (size_t)t * 1024) : (p.in[0] + ((size_t)b * SEQ_ + (t - NMETA_)) * 1024);
    u16* hb = (row < HB_SPLIT) ? HB1 + (size_t)row * 1024 : HB2 + (size_t)(row - HB_SPLIT) * 1024;
    ln_row2(srcA, srcA + 1024, p.in[2], p.in[3], H + (size_t)row * 1024, H + (size_t)(row + 1) * 1024, lane, hb, hb + 1024);
  }
  if (blockIdx.x == 0 && tid < 16) CTR[tid] = 0;
  if (blockIdx.x == 1) { for (int i = tid; i < 2048; i += 256) ((unsigned*)(p.ws + OFF_ZERO))[i] = 0u; }
  }
  grid.sync();

#pragma unroll 1
  for (int ph_ = 0; ph_ < 20; ph_++) {
    const int l = ph_ / 10, kph = ph_ - l * 10;
    const u16* WL = (const u16*)(p.ws + OFF_W) + (size_t)l * W_LAYER;
    if (kph == 0) {
    PHASE_TID
    for (int it_ = 0; it_ * nblk < 257 * 19; it_++) {
      int mt, nt;
      if (!map_tile(it_, nblk, 257, 19, mt, nt)) continue;
      f32x4 acc[8][4];
      zero_acc8(acc);
      ADma al = ADma{(mt < 255) ? HB1 : HB2, 1024, (mt < 255) ? mt * 256 : mt * 256 - HB_SPLIT, 0, ZERO, 0};
      gemm3(acc, al, WL + W_IN, 1024, nt * 128, 1024, smem, tid);
      ACC_COORDS
#pragma unroll
      for (int mi = 0; mi < 8; mi++)
#pragma unroll
        for (int ni = 0; ni < 4; ni++) {
          int col = nt * 128 + wc * 64 + ni * 16 + fq * 4;
          int row = mt * 256 + wr * 128 + mi * 16 + fr;
          if (col < PC_)
            *(uint2*)(P + (size_t)row * PC_ + col) = make_uint2(pk2(acc[mi][ni][0], acc[mi][ni][1]), pk2(acc[mi][ni][2], acc[mi][ni][3]));
        }
    }
    }
    if (kph == 1) {
    PHASE_TID
    {
      const float* qg = p.in[16] + l * 256;
      const float* kvg = p.in[18] + l * 256;
      for (int rbase = (blockIdx.x * 4 + wave) * 4; rbase < M_; rbase += nblk * 16) {
        const int row = rbase + (lane >> 4), sl = lane & 15;
        u16* pr = P + (size_t)row * PC_;
        uint4 q0 = *(const uint4*)(pr + PMLA_ + sl * 16), q1 = *(const uint4*)(pr + PMLA_ + sl * 16 + 8);
        uint4 k0 = *(const uint4*)(pr + PKV_ + sl * 16), k1 = *(const uint4*)(pr + PKV_ + sl * 16 + 8);
        const int t = row % T_;
        float x1 = bf2f(pr[PKR_ + sl]), x2 = bf2f(pr[PKR_ + 16 + sl]);
        float2 cs = ROPE[t * 16 + sl];
        const unsigned qw[8] = {q0.x, q0.y, q0.z, q0.w, q1.x, q1.y, q1.z, q1.w};
        const unsigned kw[8] = {k0.x, k0.y, k0.z, k0.w, k1.x, k1.y, k1.z, k1.w};
        float s1 = 0.f, s2 = 0.f;
#pragma unroll
        for (int e = 0; e < 8; e++) {
          float a0 = bflo(qw[e]), a1 = bfhi(qw[e]), c0 = bflo(kw[e]), c1 = bfhi(kw[e]);
          s1 += a0 * a0 + a1 * a1;
          s2 += c0 * c0 + c1 * c1;
        }
        s1 = sum16(s1);
        s2 = sum16(s2);
        const float r1 = rsqrtf(s1 * (1.0f / 256.0f) + 1e-6f), r2 = rsqrtf(s2 * (1.0f / 256.0f) + 1e-6f);
        unsigned oq[8], ok[8];
#pragma unroll
        for (int e = 0; e < 8; e++) {
          float2 g1 = *(const float2*)(qg + sl * 16 + 2 * e), g2 = *(const float2*)(kvg + sl * 16 + 2 * e);
          oq[e] = pk2(bflo(qw[e]) * r1 * g1.x, bfhi(qw[e]) * r1 * g1.y);
          ok[e] = pk2(bflo(kw[e]) * r2 * g2.x, bfhi(kw[e]) * r2 * g2.y);
        }
        *(uint4*)(pr + PMLA_ + sl * 16) = make_uint4(oq[0], oq[1], oq[2], oq[3]);
        *(uint4*)(pr + PMLA_ + sl * 16 + 8) = make_uint4(oq[4], oq[5], oq[6], oq[7]);
        *(uint4*)(pr + PKV_ + sl * 16) = make_uint4(ok[0], ok[1], ok[2], ok[3]);
        *(uint4*)(pr + PKV_ + sl * 16 + 8) = make_uint4(ok[4], ok[5], ok[6], ok[7]);
        pr[PKR_ + sl] = f2bf(x1 * cs.x - x2 * cs.y);
        pr[PKR_ + 16 + sl] = f2bf(x1 * cs.y + x2 * cs.x);
      }
      const float* mu = p.in[5] + (size_t)l * 1824;
      for (int tile = blockIdx.x; tile < 514 * 12; tile += nblk) {
        int mt = tile / 12, sub = tile % 12, which = sub >> 2, nt = sub & 3;
        f32x4 acc[4][4];
        zero_acc(acc);
        ACC_COORDS
        if (which == 0) {
          AL<3> al{P + 1536, PC_, mt * 128, 0, 64, mu + 1536, 0};
          gemm_loop(acc, al, WL + W_LW, 64, nt * 128, 64, smem, tid);
          const float* w0 = p.in[6] + l * 512;
#pragma unroll
          for (int mi = 0; mi < 4; mi++)
#pragma unroll
            for (int ni = 0; ni < 4; ni++) {
              int col = nt * 128 + wc * 64 + ni * 16 + fr;
              float w0c = w0[col];
#pragma unroll
              for (int j = 0; j < 4; j++) {
                int row = mt * 128 + wr * 64 + mi * 16 + fq * 4 + j;
                float x = -(acc[mi][ni][j] + w0c);
                float sp = fmaxf(x, 0.f) + __logf(1.0f + __expf(-fabsf(x)));
                float wraw = -sp - 0.5f;
                DEC[(size_t)row * 512 + col] = __expf(-__expf(wraw));
              }
            }
        } else if (which == 1) {
          AL<3> al{P + 1600, PC_, mt * 128, 0, 64, mu + 1600, 1};
          gemm_loop(acc, al, WL + W_LA, 64, nt * 128, 64, smem, tid);
          const float* a0 = p.in[8] + l * 512;
#pragma unroll
          for (int mi = 0; mi < 4; mi++)
#pragma unroll
            for (int ni = 0; ni < 4; ni++) {
              int col = nt * 128 + wc * 64 + ni * 16 + fr;
              float a0c = a0[col];
#pragma unroll
              for (int j = 0; j < 4; j++) {
                int row = mt * 128 + wr * 64 + mi * 16 + fq * 4 + j;
                AA[(size_t)row * 512 + col] = f2bf(sigmoidf_(acc[mi][ni][j] + a0c));
              }
            }
        } else {
          AL<3> al{P + 1664, PC_, mt * 128, 0, 160, mu + 1664, 2};
          gemm_loop(acc, al, WL + W_LG, 192, nt * 128, 192, smem, tid);
#pragma unroll
          for (int mi = 0; mi < 4; mi++)
#pragma unroll
            for (int ni = 0; ni < 4; ni++) {
              int col = nt * 128 + wc * 64 + ni * 16 + fr;
#pragma unroll
              for (int j = 0; j < 4; j++) {
                int row = mt * 128 + wr * 64 + mi * 16 + fq * 4 + j;
                GG[(size_t)row * 512 + col] = f2bf(acc[mi][ni][j]);
              }
            }
        }
      }
    }
    }
    if (kph == 2) {
    PHASE_TID
    for (int it_ = 0; it_ * nblk < 257 * 14; it_++) {
      int mt, sub;
      if (!map_tile(it_, nblk, 257, 14, mt, sub)) continue;
      f32x4 acc[8][4];
      zero_acc8(acc);
      ACC_COORDS
      if (sub < 6) {
        ADma al{P + PMLA_, PC_, mt * 256, 0, ZERO, 0};
        gemm3(acc, al, WL + W_UQ, 256, sub * 128, 256, smem, tid);
#pragma unroll
        for (int mi = 0; mi < 8; mi++)
#pragma unroll
          for (int ni = 0; ni < 4; ni++) {
            int col = sub * 128 + wc * 64 + ni * 16 + fq * 4;
            int row = mt * 256 + wr * 128 + mi * 16 + fr;
            *(uint2*)(Q + (size_t)row * 768 + col) = make_uint2(pk2(acc[mi][ni][0], acc[mi][ni][1]), pk2(acc[mi][ni][2], acc[mi][ni][3]));
          }
      } else if (sub < 10) {
        int nt = sub - 6;
        ADma al{P + PKV_, PC_, mt * 256, 0, ZERO, 0};
        gemm3(acc, al, WL + W_UK, 256, nt * 128, 256, smem, tid);
#pragma unroll
        for (int mi = 0; mi < 8; mi++)
#pragma unroll
          for (int ni = 0; ni < 4; ni++) {
            int col = nt * 128 + wc * 64 + ni * 16 + fq * 4;
            int row = mt * 256 + wr * 128 + mi * 16 + fr;
            *(uint2*)(KN + (size_t)row * 512 + col) = make_uint2(pk2(acc[mi][ni][0], acc[mi][ni][1]), pk2(acc[mi][ni][2], acc[mi][ni][3]));
          }
      } else {
        int nt = sub - 10;
        ADma al{P + PKV_, PC_, mt * 256, 0, ZERO, 0};
        gemm3<4, false>(acc, al, WL + W_UV, 256, nt * 128, 256, smem, tid);
#pragma unroll
        for (int mi = 0; mi < 8; mi++)
#pragma unroll
          for (int ni = 0; ni < 4; ni++) {
            int col = nt * 128 + wc * 64 + ni * 16 + fr;
            int row = mt * 256 + wr * 128 + mi * 16 + fq * 4;
            int b = row / T_, t = row % T_;
            size_t o = ((size_t)(b * 512 + col)) * T_ + t;
            *(uint2*)(VT + o) = make_uint2(pk2(acc[mi][ni][0], acc[mi][ni][1]), pk2(acc[mi][ni][2], acc[mi][ni][3]));
          }
      }
    }
    }
    if (kph == 3) {
    PHASE_TID
    {
      const int xcd = blockIdx.x & 7, loc = blockIdx.x >> 3;
      const int total = 16 * 33;
      const bool scan_wg = (loc < 16), partner = (loc >= (nblk >> 4) && loc < (nblk >> 4) + 16);
      if (scan_wg) {
        scan_unit(p, l, xcd * 16 + loc, smem, launder(tid));
        __syncthreads();
      }
      if (partner) {
        const int pidx = (loc - (nblk >> 4)) * 8 + xcd;
        const int tb_ = (l == 0) ? p.jobs[7].tile0 : p.jobs[20].tile0, te_ = (l == 0) ? p.jobs[20].tile0 : p.nconv;
        for (int t = tb_ + pidx; t < te_; t += 128) conv_tile(p, t, smem, launder(tid));
      }
      if (!partner) {
        while (true) {
          if (tid == 0) s_unit = atomicAdd(&CTR[l * 8 + xcd], 1);
          __syncthreads();
          int v = s_unit;
          __syncthreads();
          if (v >= total) break;
          const int tidu = launder(tid);
          int g = v / 66, w = v - g * 66;
          attn_unit(p, xcd * 16 + g * 2 + (w & 1), 32 - (w >> 1), smem, tidu);
          __syncthreads();
        }
      }
    }
    }
    if (kph == 4) {
    PHASE_TID
    {
    u16* scr = (u16*)(p.ws + OFF_SCR) + (size_t)blockIdx.x * 32768;
    for (int it_ = 0; it_ * nblk < 256 * 8; it_++) {
      int mt, nt;
      if (!map_tile(it_, nblk, 256, 8, mt, nt)) continue;
      f32x4 acc[8][4];
      ADma alh = ADma{(mt < 255) ? HB1 : HB2, 1024, (mt < 255) ? mt * 256 : mt * 256 - HB_SPLIT, 0, ZERO, 0};
      zero_acc8(acc);
      gemm3(acc, alh, WL + W_G, 1024, nt * 128, 1024, smem, launder(tid));
      { const int tq_ = launder(tid); const int lane = tq_ & 63, wave = tq_ >> 6; ACC_COORDS
#pragma unroll
        for (int mi = 0; mi < 8; mi++)
#pragma unroll
          for (int ni = 0; ni < 4; ni++) {
            int col = nt * 128 + wc * 64 + ni * 16 + fq * 4;
            int row = mt * 256 + wr * 128 + mi * 16 + fr;
            *(uint2*)(MIX + (size_t)row * 1024 + col) = make_uint2(pk2(sigmoidf_(acc[mi][ni][0]), sigmoidf_(acc[mi][ni][1])),
                                                                   pk2(sigmoidf_(acc[mi][ni][2]), sigmoidf_(acc[mi][ni][3])));
          }
      }
      zero_acc8(acc);
      {
        ADma aly{YR, 512, mt * 256, 0, ZERO, 0};
        gemm3(acc, aly, WL + W_PR, 512, nt * 128, 512, smem, launder(tid));
      }
      { const int tq_ = launder(tid); const int lane = tq_ & 63, wave = tq_ >> 6; ACC_COORDS
#pragma unroll
        for (int mi = 0; mi < 8; mi++)
#pragma unroll
          for (int ni = 0; ni < 4; ni++) {
            int col = nt * 128 + wc * 64 + ni * 16 + fq * 4;
            int row = mt * 256 + wr * 128 + mi * 16 + fr;
            u16* mp = MIX + (size_t)row * 1024 + col;
            uint2 s = *(const uint2*)mp;
            *(uint2*)mp = make_uint2(pk2(bflo(s.x) * acc[mi][ni][0], bfhi(s.x) * acc[mi][ni][1]), pk2(bflo(s.y) * acc[mi][ni][2], bfhi(s.y) * acc[mi][ni][3]));
          }
      }
      zero_acc8(acc);
      gemm3(acc, alh, WL + W_G, 1024, 1024 + nt * 128, 1024, smem, launder(tid));
      { const int tq_ = launder(tid); const int lane = tq_ & 63, wave = tq_ >> 6; ACC_COORDS
#pragma unroll
        for (int mi = 0; mi < 8; mi++)
#pragma unroll
          for (int ni = 0; ni < 4; ni++) {
            int cl = wc * 64 + ni * 16 + fq * 4, rl = wr * 128 + mi * 16 + fr;
            *(uint2*)(scr + rl * 128 + cl) = make_uint2(pk2(sigmoidf_(acc[mi][ni][0]), sigmoidf_(acc[mi][ni][1])),
                                                        pk2(sigmoidf_(acc[mi][ni][2]), sigmoidf_(acc[mi][ni][3])));
          }
      }
      zero_acc8(acc);
      {
        ADma alm{P + PMLA_, PC_, mt * 256, 0, ZERO, 0};
        gemm3(acc, alm, WL + W_PM, 512, nt * 128, 512, smem, launder(tid));
      }
      { const int tq_ = launder(tid); const int lane = tq_ & 63, wave = tq_ >> 6; ACC_COORDS
#pragma unroll
        for (int mi = 0; mi < 8; mi++)
#pragma unroll
          for (int ni = 0; ni < 4; ni++) {
            int cl = wc * 64 + ni * 16 + fq * 4, rl = wr * 128 + mi * 16 + fr;
            u16* mp = MIX + (size_t)(mt * 256 + rl) * 1024 + nt * 128 + cl;
            uint2 t1 = *(const uint2*)mp;
            uint2 s = *(const uint2*)(scr + rl * 128 + cl);
            float o0 = bflo(t1.x) + bflo(s.x) * acc[mi][ni][0];
            float o1 = bfhi(t1.x) + bfhi(s.x) * acc[mi][ni][1];
            float o2 = bflo(t1.y) + bflo(s.y) * acc[mi][ni][2];
            float o3 = bfhi(t1.y) + bfhi(s.y) * acc[mi][ni][3];
            *(uint2*)mp = make_uint2(pk2(o0, o1), pk2(o2, o3));
          }
      }
    }
    }
    if (blockIdx.x < 16) {
      const int mt = 256, nt = blockIdx.x;
      f32x4 acc[8][2];
      unsigned sg[8][2][2];
      ADma alh = ADma{(mt < 255) ? HB1 : HB2, 1024, (mt < 255) ? mt * 256 : mt * 256 - HB_SPLIT, 0, ZERO, 0};
      zero_acc8(acc);
      const int tid1 = launder(tid);
      gemm3(acc, alh, WL + W_G, 1024, nt * 64, 1024, smem, tid1);
#pragma unroll
      for (int mi = 0; mi < 8; mi++)
#pragma unroll
        for (int ni = 0; ni < 2; ni++) {
          sg[mi][ni][0] = pk2(sigmoidf_(acc[mi][ni][0]), sigmoidf_(acc[mi][ni][1]));
          sg[mi][ni][1] = pk2(sigmoidf_(acc[mi][ni][2]), sigmoidf_(acc[mi][ni][3]));
        }
      zero_acc8(acc);
      {
        ADma aly{YR, 512, mt * 256, 0, ZERO, 0};
        const int tid2 = launder(tid);
      gemm3(acc, aly, WL + W_PR, 512, nt * 64, 512, smem, tid2);
      }
{ const int tidq = launder(tid); const int lane = tidq & 63, wave = tidq >> 6; ACC_COORDS
#pragma unroll
      for (int mi = 0; mi < 8; mi++)
#pragma unroll
        for (int ni = 0; ni < 2; ni++) {
          int col = nt * 64 + wc * 32 + ni * 16 + fq * 4;
          int row = mt * 256 + wr * 128 + mi * 16 + fr;
          *(uint2*)(MIX + (size_t)row * 1024 + col) = make_uint2(pk2(bflo(sg[mi][ni][0]) * acc[mi][ni][0], bfhi(sg[mi][ni][0]) * acc[mi][ni][1]),
                                                                 pk2(bflo(sg[mi][ni][1]) * acc[mi][ni][2], bfhi(sg[mi][ni][1]) * acc[mi][ni][3]));
        }
      }
      zero_acc8(acc);
      const int tid3 = launder(tid);
      gemm3(acc, alh, WL + W_G, 1024, 1024 + nt * 64, 1024, smem, tid3);
#pragma unroll
      for (int mi = 0; mi < 8; mi++)
#pragma unroll
        for (int ni = 0; ni < 2; ni++) {
          sg[mi][ni][0] = pk2(sigmoidf_(acc[mi][ni][0]), sigmoidf_(acc[mi][ni][1]));
          sg[mi][ni][1] = pk2(sigmoidf_(acc[mi][ni][2]), sigmoidf_(acc[mi][ni][3]));
        }
      zero_acc8(acc);
      {
        ADma alm{P + PMLA_, PC_, mt * 256, 0, ZERO, 0};
        const int tid4 = launder(tid);
      gemm3(acc, alm, WL + W_PM, 512, nt * 64, 512, smem, tid4);
      }
{ const int tidq = launder(tid); const int lane = tidq & 63, wave = tidq >> 6; ACC_COORDS
#pragma unroll
      for (int mi = 0; mi < 8; mi++)
#pragma unroll
        for (int ni = 0; ni < 2; ni++) {
          int col = nt * 64 + wc * 32 + ni * 16 + fq * 4;
          int row = mt * 256 + wr * 128 + mi * 16 + fr;
          uint2 pm = *(const uint2*)(MIX + (size_t)row * 1024 + col);
          float o0 = bflo(pm.x) + bflo(sg[mi][ni][0]) * acc[mi][ni][0];
          float o1 = bfhi(pm.x) + bfhi(sg[mi][ni][0]) * acc[mi][ni][1];
          float o2 = bflo(pm.y) + bflo(sg[mi][ni][1]) * acc[mi][ni][2];
          float o3 = bfhi(pm.y) + bfhi(sg[mi][ni][1]) * acc[mi][ni][3];
          *(uint2*)(MIX + (size_t)row * 1024 + col) = make_uint2(pk2(o0, o1), pk2(o2, o3));
        }
      }
    }
    }
    if (kph == 5) {
    PHASE_TID
    for (int prb_ = (PROBE_FI ? 0 : 1); prb_ < 2; prb_++)
    for (int it_ = 0; it_ * nblk < 256 * 8; it_++) {
      int mt, nt;
      if (!map_tile(it_, nblk, 256, 8, mt, nt)) continue;
      f32x4 acc[8][4];
      zero_acc8(acc);
      ACC_COORDS
      ADma al{MIX, 1024, mt * 256, 0, ZERO, 0};
      gemm3(acc, al, WL + W_OUT, 1024, nt * 128, 1024, smem, tid);
#pragma unroll
      for (int mi = 0; mi < 8; mi++)
#pragma unroll
        for (int ni = 0; ni < 4; ni++) {
          int col = nt * 128 + wc * 64 + ni * 16 + fq * 4;
          int row = mt * 256 + wr * 128 + mi * 16 + fr;
          float* hp = H + (size_t)row * 1024 + col;
          float* dp = (prb_ == 0) ? (p.out + (size_t)(row & 65535) * 1024 + col) : hp;
          float4 hv = *(const float4*)hp;
          hv.x = ALPHA_ * hv.x + acc[mi][ni][0];
          hv.y = ALPHA_ * hv.y + acc[mi][ni][1];
          hv.z = ALPHA_ * hv.z + acc[mi][ni][2];
          hv.w = ALPHA_ * hv.w + acc[mi][ni][3];
          *(float4*)dp = hv;
        }
    }
    if (blockIdx.x < 16) {
      const int mt = 256, n0 = blockIdx.x * 64;
      f32x4 acc[8][2];
      zero_acc8(acc);
      ADma al{MIX, 1024, mt * 256, 0, ZERO, 0};
      gemm3(acc, al, WL + W_OUT, 1024, n0, 1024, smem, launder(tid));
      const int tq_ = launder(tid);
      const int lane = tq_ & 63, wave = tq_ >> 6;
      ACC_COORDS
#pragma unroll
      for (int mi = 0; mi < 8; mi++)
#pragma unroll
        for (int ni = 0; ni < 2; ni++) {
          int col = n0 + wc * 32 + ni * 16 + fq * 4;
          int row = mt * 256 + wr * 128 + mi * 16 + fr;
          float* hp = H + (size_t)row * 1024 + col;
          float4 hv = *(const float4*)hp;
          hv.x = ALPHA_ * hv.x + acc[mi][ni][0];
          hv.y = ALPHA_ * hv.y + acc[mi][ni][1];
          hv.z = ALPHA_ * hv.z + acc[mi][ni][2];
          hv.w = ALPHA_ * hv.w + acc[mi][ni][3];
          *(float4*)hp = hv;
        }
    }
    }
    if (kph == 6) {
    PHASE_TID
    for (int row = (blockIdx.x * 4 + wave) * 2; row < M_; row += nblk * 8)
      ln_row2(H + (size_t)row * 1024, H + (size_t)(row + 1) * 1024, p.in[24] + l * 1024, p.in[25] + l * 1024, H + (size_t)row * 1024, H + (size_t)(row + 1) * 1024, lane, HBH + (size_t)row * 1024, HBH + (size_t)(row + 1) * 1024);
    }
    if (kph == 7) {
    PHASE_TID
    {
      const float* cw = p.in[27] + (size_t)l * 3 * 5632;
      const float* cb = p.in[28] + (size_t)l * 5632;
#if PROBE_HOT
      for (int it_ = 0; it_ * nblk < 272 * 44; it_++) {
        int rest, nt;
        if (!map_tile(it_, nblk, 272, 44, rest, nt)) continue;
        f32x4 acc[8][4];
        zero_acc8(acc);
#if PROBE_HOT == 1
        ADma al{HBH, 1024, 0, 0, ZERO, 1, p.ws};
        gemm3(acc, al, WL + W_UP, 1024, 0, 1024, smem, tid);
#else
        int it = rest % 17, b = rest / 17;
        ADma al{HBH, 1024, b * T_, 254 * it - 2, ZERO, 1, p.ws};
        gemm3(acc, al, WL + W_UP, 1024, nt * 128, 1024, smem, tid);
#endif
        float sacc = 0.f;
#pragma unroll
        for (int mi = 0; mi < 8; mi++)
#pragma unroll
          for (int ni = 0; ni < 4; ni++) sacc += acc[mi][ni][0] + acc[mi][ni][1] + acc[mi][ni][2] + acc[mi][ni][3];
        if (sacc == 12345.678f) ACT[tid] = 0;
      }
#endif
      for (int it_ = 0; it_ * nblk < 272 * 44; it_++) {
        int rest, nt;
        if (!map_tile(it_, nblk, 272, 44, rest, nt)) continue;
        int it = rest % 17, b = rest / 17;
        int t0 = 254 * it - 2;
        f32x4 acc[8][4];
        zero_acc8(acc);
        ADma al{HBH, 1024, b * T_, t0, ZERO, 1, p.ws};
        gemm3(acc, al, WL + W_UP, 1024, nt * 128, 1024, smem, launder(tid));
        ACC_COORDS
        float(*ut)[132] = (float(*)[132])smem;
        const int tidh = launder(tid);
        typedef float f2c __attribute__((ext_vector_type(2)));
        const int c2 = (tidh & 31) * 2, rg = tidh >> 5;
        const int gcol = nt * 64 + c2, vcol = DFF_ + nt * 64 + c2;
        const f2c g0 = *(const f2c*)(cw + gcol), g1 = *(const f2c*)(cw + 5632 + gcol), g2 = *(const f2c*)(cw + 2 * 5632 + gcol), gb = *(const f2c*)(cb + gcol);
        const f2c v0 = *(const f2c*)(cw + vcol), v1 = *(const f2c*)(cw + 5632 + vcol), v2 = *(const f2c*)(cw + 2 * 5632 + vcol), vb = *(const f2c*)(cb + vcol);
#pragma unroll 1
        for (int half = 0; half < 2; half++) {
          float carry = 0.f;
          if (half == 1) carry = ut[126 + (tid >> 7)][tid & 127];
          __syncthreads();
          if (half == 1) ut[tid >> 7][tid & 127] = carry;
          if (wr == half) {
#pragma unroll
            for (int mi = 0; mi < 8; mi++)
#pragma unroll
              for (int ni = 0; ni < 4; ni++)
                *(float4*)&ut[half * 2 + mi * 16 + fr][wc * 64 + ni * 16 + fq * 4] = make_float4(acc[mi][ni][0], acc[mi][ni][1], acc[mi][ni][2], acc[mi][ni][3]);
          }
          __syncthreads();
          const int nq = half ? 130 : 128;
          int qs = 2 + rg * 16, qe = min(qs + 16, nq);
          f2c ga = *(const f2c*)&ut[qs - 2][c2], gbp = *(const f2c*)&ut[qs - 1][c2];
          f2c va = *(const f2c*)&ut[qs - 2][64 + c2], vbp = *(const f2c*)&ut[qs - 1][64 + c2];
#pragma unroll 4
          for (int q = qs; q < qe; q++) {
            f2c gc = *(const f2c*)&ut[q][c2], vc = *(const f2c*)&ut[q][64 + c2];
            int t = t0 + half * 126 + q;
            if (t < T_) {
              f2c gate = g0 * ga + g1 * gbp + g2 * gc + gb;
              f2c val = v0 * va + v1 * vbp + v2 * vc + vb;
              float a0 = gate.x * sigmoidf_(gate.x) * val.x, a1 = gate.y * sigmoidf_(gate.y) * val.y;
              *(unsigned*)(ACT + (size_t)(b * T_ + t) * DFF_ + gcol) = pk2(a0, a1);
            }
            ga = gbp; gbp = gc; va = vbp; vbp = vc;
          }
        }
        __syncthreads();
      }
    }
    }
    if (kph == 8) {
    PHASE_TID
    for (int prb_ = (PROBE_FI ? 0 : 1); prb_ < 2; prb_++)
    for (int it_ = 0; it_ * nblk < 256 * 8; it_++) {
      int mt, nt;
      if (!map_tile(it_, nblk, 256, 8, mt, nt)) continue;
      f32x4 acc[8][4];
      zero_acc8(acc);
      ACC_COORDS
      ADma al{ACT, DFF_, mt * 256, 0, ZERO, 0};
      gemm3(acc, al, WL + W_DN, DFF_, nt * 128, DFF_, smem, tid);
#pragma unroll
      for (int mi = 0; mi < 8; mi++)
#pragma unroll
        for (int ni = 0; ni < 4; ni++) {
          int col = nt * 128 + wc * 64 + ni * 16 + fq * 4;
          int row = mt * 256 + wr * 128 + mi * 16 + fr;
          float* hp = H + (size_t)row * 1024 + col;
          float* dp = (prb_ == 0) ? (p.out + (size_t)(row & 65535) * 1024 + col) : hp;
          float4 hv = *(const float4*)hp;
          hv.x = ALPHA_ * hv.x + acc[mi][ni][0];
          hv.y = ALPHA_ * hv.y + acc[mi][ni][1];
          hv.z = ALPHA_ * hv.z + acc[mi][ni][2];
          hv.w = ALPHA_ * hv.w + acc[mi][ni][3];
          *(float4*)dp = hv;
        }
    }
    if (blockIdx.x < 16) {
      const int mt = 256, n0 = blockIdx.x * 64;
      f32x4 acc[8][2];
      zero_acc8(acc);
      ADma al{ACT, DFF_, mt * 256, 0, ZERO, 0};
      gemm3(acc, al, WL + W_DN, DFF_, n0, DFF_, smem, launder(tid));
      const int tq_ = launder(tid);
      const int lane = tq_ & 63, wave = tq_ >> 6;
      ACC_COORDS
#pragma unroll
      for (int mi = 0; mi < 8; mi++)
#pragma unroll
        for (int ni = 0; ni < 2; ni++) {
          int col = n0 + wc * 32 + ni * 16 + fq * 4;
          int row = mt * 256 + wr * 128 + mi * 16 + fr;
          float* hp = H + (size_t)row * 1024 + col;
          float4 hv = *(const float4*)hp;
          hv.x = ALPHA_ * hv.x + acc[mi][ni][0];
          hv.y = ALPHA_ * hv.y + acc[mi][ni][1];
          hv.z = ALPHA_ * hv.z + acc[mi][ni][2];
          hv.w = ALPHA_ * hv.w + acc[mi][ni][3];
          *(float4*)hp = hv;
        }
    }
    }
    if (kph == 9) {
    PHASE_TID
    if (l == 0) {
      for (int row = (blockIdx.x * 4 + wave) * 2; row < M_; row += nblk * 8) {
        u16* hb = (row < HB_SPLIT) ? HB1 + (size_t)row * 1024 : HB2 + (size_t)(row - HB_SPLIT) * 1024;
        ln_row2(H + (size_t)row * 1024, H + (size_t)(row + 1) * 1024, p.in[30], p.in[31], H + (size_t)row * 1024, H + (size_t)(row + 1) * 1024, lane, hb, hb + 1024);
      }
    } else {
      for (int row = (blockIdx.x * 4 + wave) * 2; row < M_; row += nblk * 8) {
        int b = row / T_, t = row % T_;
        if (t >= NMETA_) {
          float* o = p.out + ((size_t)b * SEQ_ + (t - NMETA_)) * 1024;
          ln_row2(H + (size_t)row * 1024, H + (size_t)(row + 1) * 1024, p.in[30] + 1024, p.in[31] + 1024, o, o + 1024, lane, nullptr, nullptr);
        }
      }
    }
    }
    if (ph_ != 19) XB_SYNC();
  }
}

#undef H
#undef P
#undef DEC
#undef AA
#undef GG
#undef Q
#undef MIX
#undef HB1
#undef HB2
#undef HBH
#undef ZERO
#undef ACT
#undef ROPE
#undef CTR
#undef KN
#undef VT
#undef YR

extern "C" void kernel_launch(void* const* d_in, const int* in_sizes, int n_in, void* d_out, int out_size, void* d_ws,
                              size_t ws_size, hipStream_t stream) {
  static int grid_blocks = 0;
  if (!grid_blocks) {
    int dev = 0, cus = 0, per_cu = 0;
    hipGetDevice(&dev);
    hipDeviceGetAttribute(&cus, hipDeviceAttributeMultiprocessorCount, dev);
    hipOccupancyMaxActiveBlocksPerMultiprocessor(&per_cu, mega, 256, 0);
    if (per_cu > 2) per_cu = 2;
    grid_blocks = cus * per_cu;
  }
  if (ws_size < WS_TOTAL) fprintf(stderr, "workspace too small: %zu < %zu\n", ws_size, (size_t)WS_TOTAL);
  Params p;
  memset(&p, 0, sizeof(p));
  for (int i = 0; i < 32; i++) p.in[i] = (const float*)d_in[i];
  p.out = (float*)d_out;
  p.ws = (char*)d_ws;
  u16* wb = (u16*)((char*)d_ws + OFF_W);
  int nj = 0, tiles = 0;
  auto add = [&](const float* src, size_t dst_off, int ld, int c0, int K, int Kpad, int Nv, int Np, int mode) {
    Job& j = p.jobs[nj++];
    j.src = src; j.dst = wb + dst_off; j.ld = ld; j.c0 = c0; j.K = K; j.Kpad = Kpad; j.Nv = Nv; j.Np = Np; j.mode = mode;
    j.tile0 = tiles;
    tiles += (Kpad / 64) * (Np / 64);
  };
  for (int l = 0; l < 2; l++) {
    size_t o = (size_t)l * W_LAYER;
    const float* w_in = (const float*)d_in[4] + (size_t)l * 1024 * 4416;
    add(w_in, o + W_IN, 4416, 0, 1024, 1024, 2368, 2432, 0);
    add((const float*)d_in[7] + (size_t)l * 64 * 512, o + W_LW, 512, 0, 64, 64, 512, 512, 0);
    add((const float*)d_in[9] + (size_t)l * 64 * 512, o + W_LA, 512, 0, 64, 64, 512, 512, 0);
    add((const float*)d_in[10] + (size_t)l * 160 * 512, o + W_LG, 512, 0, 160, 192, 512, 512, 0);
    add((const float*)d_in[17] + (size_t)l * 256 * 768, o + W_UQ, 768, 0, 256, 256, 768, 768, 0);
    add((const float*)d_in[19] + (size_t)l * 256 * 512, o + W_UK, 512, 0, 256, 256, 512, 512, 0);
    add((const float*)d_in[20] + (size_t)l * 256 * 512, o + W_UV, 512, 0, 256, 256, 512, 512, 0);
    add(w_in, o + W_G, 4416, 2368, 1024, 1024, 2048, 2048, 0);
    add((const float*)d_in[21] + (size_t)l * 512 * 1024, o + W_PR, 1024, 0, 512, 512, 1024, 1024, 0);
    add((const float*)d_in[22] + (size_t)l * 512 * 1024, o + W_PM, 1024, 0, 512, 512, 1024, 1024, 0);
    add((const float*)d_in[23] + (size_t)l * 1024 * 1024, o + W_OUT, 1024, 0, 1024, 1024, 1024, 1024, 0);
    add((const float*)d_in[26] + (size_t)l * 1024 * 5632, o + W_UP, 5632, 0, 1024, 1024, 5632, 5632, 1);
    add((const float*)d_in[29] + (size_t)l * 2816 * 1024, o + W_DN, 1024, 0, 2816, 2816, 1024, 1024, 0);
  }
  p.nconv = tiles;
  hipMemsetAsync((char*)d_ws + OFF_BAR, 0, 16384, stream);
  void* args[] = {&p};
  hipError_t e = hipLaunchCooperativeKernel((void*)mega, dim3(grid_blocks), dim3(256), args, 0, stream);
  if (e != hipSuccess) fprintf(stderr, "cooperative launch failed: %s (grid %d)\n", hipGetErrorString(e), grid_blocks);
}
```
